# Optimizing an MI355X kernel written in HIP

```python
import math
import jax, jax.numpy as jnp
from jax import lax
import numpy as np

D_MODEL = 1024
BATCH = 8
SEQ = 2048
DEPTH = 2

N_MIXERS = 2
N_A_LAYERS = (DEPTH + 1) // 2
N_B_LAYERS = DEPTH // 2
RMS_EPS = 1e-6

D_FF = 2816
FFN_RES = 0.5

D_RNN = 1280
N_RNN_BLOCKS = 10
RNN_BLOCK = D_RNN // N_RNN_BLOCKS
CONV_WIDTH = 4
LRU_C = 8.0

HEAD_DIM = 64
HEADS_PER_GROUP = D_MODEL // HEAD_DIM
DILATION_GROUPS = ((128, 1), (512, 4), (2048, 16))
N_GROUPS = len(DILATION_GROUPS)
N_ATT_HEADS = N_GROUPS * HEADS_PER_GROUP
QKV_WIDTH = 3 * N_ATT_HEADS * HEAD_DIM
ATT_OUT_WIDTH = HEADS_PER_GROUP * HEAD_DIM
N_BUCKETS = 32
MAX_DISTANCE = 2048

kernel_name = 'hybrid_rglru_dilated_attn_macaron'


def rms_norm(x, g):
    xf = x.astype(jnp.float32)
    y = xf * lax.rsqrt(jnp.mean(xf * xf, axis=-1, keepdims=True) + RMS_EPS)
    return (y * g.astype(jnp.float32)).astype(x.dtype)


def swiglu(x, w_in, w_out):
    gate, up = jnp.split(x @ w_in, 2, axis=-1)
    return (jax.nn.silu(gate) * up) @ w_out


def rglru_mixer(x, w_in, conv_w, conv_b, w_a, b_a, w_x, b_x, lam, w_out):
    B, S, _ = x.shape
    gate, u = jnp.split(x @ w_in, 2, axis=-1)
    up = jnp.pad(u, ((0, 0), (CONV_WIDTH - 1, 0), (0, 0)))
    conv = conv_b
    for k in range(CONV_WIDTH):
        conv = conv + up[:, k:k + S] * conv_w[k]
    uf = conv.astype(jnp.float32)
    ub = uf.reshape(B, S, N_RNN_BLOCKS, RNN_BLOCK)
    r = jax.nn.sigmoid(jnp.einsum('bsnc,ncd->bsnd', ub, w_a.astype(jnp.float32)).reshape(B, S, D_RNN) + b_a.astype(jnp.float32))
    i = jax.nn.sigmoid(jnp.einsum('bsnc,ncd->bsnd', ub, w_x.astype(jnp.float32)).reshape(B, S, D_RNN) + b_x.astype(jnp.float32))
    log_a = -LRU_C * r * jax.nn.softplus(-lam.astype(jnp.float32))
    a = jnp.exp(log_a)
    b = jnp.sqrt(-jnp.expm1(2.0 * log_a)) * (i * uf)

    def combine(left, right):
        a1, b1 = left
        a2, b2 = right
        return a1 * a2, a2 * b1 + b2

    _, h = lax.associative_scan(combine, (a, b), axis=1)
    y = h.astype(x.dtype) * jax.nn.gelu(gate)
    return y @ w_out


def t5_causal_bucket(dist):
    max_exact = N_BUCKETS // 2
    n = jnp.maximum(dist, 0)
    nf = jnp.maximum(n, 1).astype(jnp.float32)
    large = max_exact + (jnp.log(nf / max_exact) / math.log(MAX_DISTANCE / max_exact) * (N_BUCKETS - max_exact)).astype(jnp.int32)
    large = jnp.minimum(large, N_BUCKETS - 1)
    return jnp.where(n < max_exact, n, large)


def dilated_group(q, k, v, bias_tbl, window, dilation):
    B, S, H, Dh = q.shape
    d = dilation
    blk = window // dilation
    span = d * blk
    Sp = ((S + span - 1) // span) * span
    pad = ((0, 0), (0, Sp - S), (0, 0), (0, 0))
    L = Sp // d
    nb = L // blk

    def to_sub(t):
        t = jnp.pad(t, pad).reshape(B, L, d, H, Dh).transpose(0, 2, 1, 3, 4)
        return t.reshape(B, d, nb, blk, H, Dh)

    def with_prev(t):
        prev = jnp.pad(t, ((0, 0), (0, 0), (1, 0), (0, 0), (0, 0), (0, 0)))[:, :, :-1]
        return jnp.concatenate([prev, t], axis=3)

    qs = to_sub(q).astype(jnp.float32)
    ks = with_prev(to_sub(k)).astype(jnp.float32)
    vs = with_prev(to_sub(v))
    scores = jnp.einsum('brnqhc,brnkhc->brnhqk', qs, ks) * (HEAD_DIM ** -0.5)

    qi = jnp.arange(blk)[:, None]
    kj = jnp.arange(2 * blk)[None, :]
    dist = qi - kj + blk
    band = (dist >= 0) & (dist <= blk)
    key_exists = (jnp.arange(nb)[:, None, None] > 0) | (kj[None] >= blk)
    mask = (band[None] & key_exists)[:, None]
    bias = bias_tbl.astype(jnp.float32)[t5_causal_bucket(dist * d)].transpose(2, 0, 1)
    scores = jnp.where(mask, scores + bias, -jnp.inf)
    lse = jax.nn.logsumexp(scores, axis=-1)
    p = jnp.exp(scores - lse[..., None])
    o = jnp.einsum('brnhqk,brnkhc->brnqhc', p, vs.astype(jnp.float32))
    o = o.reshape(B, d, L, H, Dh).transpose(0, 2, 1, 3, 4).reshape(B, Sp, H, Dh)[:, :S]
    lse = lse.transpose(0, 1, 2, 4, 3).reshape(B, d, L, H).transpose(0, 2, 1, 3).reshape(B, Sp, H)[:, :S]
    return o, lse


def dilated_attention(x, w_qkv, q_gain, k_gain, rel_bias, w_o):
    B, S, _ = x.shape
    qkv = (x @ w_qkv).reshape(B, S, 3, N_GROUPS, HEADS_PER_GROUP, HEAD_DIM)
    q = rms_norm(qkv[:, :, 0], q_gain)
    k = rms_norm(qkv[:, :, 1], k_gain)
    v = qkv[:, :, 2]
    outs, lses = [], []
    for g, (window, dilation) in enumerate(DILATION_GROUPS):
        tbl = rel_bias[:, g * HEADS_PER_GROUP:(g + 1) * HEADS_PER_GROUP]
        o, lse = dilated_group(q[:, :, g], k[:, :, g], v[:, :, g], tbl, window, dilation)
        outs.append(o)
        lses.append(lse)
    wts = jax.nn.softmax(jnp.stack(lses, axis=0), axis=0)
    o = jnp.einsum('gbsh,gbshc->bshc', wts, jnp.stack(outs, axis=0))
    return o.reshape(B, S, ATT_OUT_WIDTH).astype(x.dtype) @ w_o


def setup_inputs(seed: int = 0) -> dict:
    key = jax.random.key(seed)
    ks = jax.random.split(key, 24)
    nrm = jax.random.normal
    f32 = jnp.float32
    x = nrm(ks[0], (BATCH, SEQ, D_MODEL), f32)
    norm_g = 1.0 + 0.05 * nrm(ks[1], (DEPTH, 3, D_MODEL), f32)
    ffn_w_in = nrm(ks[2], (DEPTH, 2, D_MODEL, 2 * D_FF), f32) * D_MODEL ** -0.5
    ffn_w_out = nrm(ks[3], (DEPTH, 2, D_FF, D_MODEL), f32) * D_FF ** -0.5
    rnn_w_in = nrm(ks[4], (N_A_LAYERS, D_MODEL, 2 * D_RNN), f32) * D_MODEL ** -0.5
    rnn_conv_w = nrm(ks[5], (N_A_LAYERS, CONV_WIDTH, D_RNN), f32) * CONV_WIDTH ** -0.5
    rnn_conv_b = 0.02 * nrm(ks[6], (N_A_LAYERS, D_RNN), f32)
    rnn_w_a = nrm(ks[7], (N_A_LAYERS, N_RNN_BLOCKS, RNN_BLOCK, RNN_BLOCK), f32) * RNN_BLOCK ** -0.5
    rnn_b_a = 0.02 * nrm(ks[8], (N_A_LAYERS, D_RNN), f32)
    rnn_w_x = nrm(ks[9], (N_A_LAYERS, N_RNN_BLOCKS, RNN_BLOCK, RNN_BLOCK), f32) * RNN_BLOCK ** -0.5
    rnn_b_x = 0.02 * nrm(ks[10], (N_A_LAYERS, D_RNN), f32)
    a_c = jax.random.uniform(ks[11], (N_A_LAYERS, D_RNN), f32, 0.9, 0.999)
    a_base = a_c ** (1.0 / LRU_C)
    rnn_lambda = jnp.log(a_base) - jnp.log1p(-a_base)
    rnn_w_out = nrm(ks[12], (N_A_LAYERS, D_RNN, D_MODEL), f32) * D_RNN ** -0.5
    att_w_qkv = nrm(ks[13], (N_B_LAYERS, D_MODEL, QKV_WIDTH), f32) * D_MODEL ** -0.5
    att_q_gain = 1.0 + 0.05 * nrm(ks[14], (N_B_LAYERS, HEAD_DIM), f32)
    att_k_gain = 1.0 + 0.05 * nrm(ks[15], (N_B_LAYERS, HEAD_DIM), f32)
    att_w_o = nrm(ks[16], (N_B_LAYERS, ATT_OUT_WIDTH, D_MODEL), f32) * ATT_OUT_WIDTH ** -0.5
    rel_bias = 0.5 * nrm(ks[17], (N_BUCKETS, N_ATT_HEADS), f32)
    return {'x': x, 'norm_g': norm_g, 'ffn_w_in': ffn_w_in, 'ffn_w_out': ffn_w_out,
            'rnn_w_in': rnn_w_in, 'rnn_conv_w': rnn_conv_w, 'rnn_conv_b': rnn_conv_b,
            'rnn_w_a': rnn_w_a, 'rnn_b_a': rnn_b_a, 'rnn_w_x': rnn_w_x, 'rnn_b_x': rnn_b_x,
            'rnn_lambda': rnn_lambda, 'rnn_w_out': rnn_w_out,
            'att_w_qkv': att_w_qkv, 'att_q_gain': att_q_gain, 'att_k_gain': att_k_gain,
            'att_w_o': att_w_o, 'rel_bias': rel_bias}


def reference(x, norm_g, ffn_w_in, ffn_w_out, rnn_w_in, rnn_conv_w, rnn_conv_b,
              rnn_w_a, rnn_b_a, rnn_w_x, rnn_b_x, rnn_lambda, rnn_w_out,
              att_w_qkv, att_q_gain, att_k_gain, att_w_o, rel_bias):
    for layer in range(DEPTH):
        g = norm_g[layer]
        x = x + FFN_RES * swiglu(rms_norm(x, g[0]), ffn_w_in[layer, 0], ffn_w_out[layer, 0])
        h = rms_norm(x, g[1])
        j = layer // N_MIXERS
        if layer % N_MIXERS == 0:
            x = x + rglru_mixer(h, rnn_w_in[j], rnn_conv_w[j], rnn_conv_b[j], rnn_w_a[j], rnn_b_a[j],
                                rnn_w_x[j], rnn_b_x[j], rnn_lambda[j], rnn_w_out[j])
        else:
            x = x + dilated_attention(h, att_w_qkv[j], att_q_gain[j], att_k_gain[j], rel_bias, att_w_o[j])
        x = x + FFN_RES * swiglu(rms_norm(x, g[2]), ffn_w_in[layer, 1], ffn_w_out[layer, 1])
    return x
```

```cpp
#include <hip/hip_runtime.h>
#include <cstdio>
#include <cstdint>

#ifndef SINGLE_LAUNCH
#define SINGLE_LAUNCH 0
#endif

namespace pg8 {
#define PG8_LAS __attribute__((address_space(3)))
typedef unsigned short bf16_t;
typedef short bf16x8 __attribute__((ext_vector_type(8)));
typedef float f32x4 __attribute__((ext_vector_type(4)));
typedef unsigned u32x4 __attribute__((ext_vector_type(4)));
constexpr int BM = 256, BK = 64, HALF = 128, HTB = HALF * BK * 2, STAGE_BYTES = 8 * HTB, NXCD = 8, WGM = 8;

__host__ __device__ __forceinline__ int lds_byte(int r, int c) { const int st = (r >> 4) * 2 + (c >> 5), rr = r & 15, cc = c & 31, ob = rr * 64 + cc * 2; return st * 1024 + (ob ^ (((ob >> 9) & 1) << 5)); }
__host__ __device__ __forceinline__ void stage_rc(int b, int& R, int& C) { const int st = b / 1024, sb = b % 1024, swz = sb ^ (((sb >> 9) & 1) << 5); R = (st >> 1) * 16 + swz / 64; C = (st & 1) * 32 + (swz % 64) / 2; }
__host__ __device__ __forceinline__ int perm32(int rho) { const int n = rho >> 4, i = rho & 15; return 8 * (i >> 2) + 4 * n + (i & 3); }

struct Unit { int pm, pn; };
struct Gemm { const bf16_t* A; const bf16_t* Bt; int M, N, K; };

struct StaticOrder {
    int nM, nN, nwg, G, c;
    __host__ __device__ void init(int M, int N, int G_, int c_) { nM = M / BM; nN = N / BM; nwg = nM * nN; G = G_; c = c_; }
    __host__ __device__ bool next(int i, Unit& u) const {
        const long L = (long)i * G + c; if (L >= nwg) return false;
        int wgid = (int)L; { const int q = nwg / NXCD, r = nwg % NXCD, xcd = wgid % NXCD, off = wgid / NXCD; wgid = (xcd < r ? xcd * (q + 1) : r * (q + 1) + (xcd - r) * q) + off; }
        const int nig = WGM * nN, gid = wgid / nig, fm = gid * WGM, gsz = (nM - fm) < WGM ? (nM - fm) : WGM;
        u.pm = fm + ((wgid % nig) % gsz); u.pn = (wgid % nig) / gsz; return true;
    }
    __device__ __forceinline__ void a_ready(const Unit&) const {}
    __device__ __forceinline__ void done(const Unit&) const {}
};

__device__ __forceinline__ unsigned cvt_pk_bf16(float lo, float hi) { unsigned r; asm volatile("v_cvt_pk_bf16_f32 %0, %1, %2" : "=v"(r) : "v"(lo), "v"(hi)); return r; }

template <class Epi, class Sched, bool ALIGN_EPI = false, bool SP2 = false>
__device__ __forceinline__ void gemm_phase(PG8_LAS unsigned char* lds, const Gemm g, const Sched& S, const Epi& E) {
    int tid_ = threadIdx.x; asm volatile("" : "+v"(tid_));
    const int tid = tid_, wid = __builtin_amdgcn_readfirstlane(tid >> 6), lane = tid & 63, wr = wid >> 2, wc = wid & 3, fr = lane & 15, fq = lane >> 4;
    const int K = g.K, nt = K / BK;
    unsigned voffA[2], voffB[2];
#pragma unroll
    for (int i = 0; i < 2; ++i) { int R, C; stage_rc(tid * 16 + i * 8192, R, C); const int Rb = Epi::PERM ? ((R & ~31) + perm32(R & 31)) : R;
        voffA[i] = (unsigned)(R * K + C) * 2u; voffB[i] = (unsigned)(Rb * K + C) * 2u; }
    const size_t kstep = (size_t)(BK * 2);
    const size_t hstep = (size_t)HALF * K * 2;
    const size_t tstep = 2 * hstep;
    const unsigned ldsw = (unsigned)wid * 1024u;
    const int aoff = lds_byte(wr * 64 + fr, fq * 8), boff = lds_byte(wc * 32 + fr, fq * 8);
#define PG8_SA(b, h) (((b) * 2 + (h)) * HTB)
#define PG8_SB(b, h) ((4 + (b) * 2 + (h)) * HTB)
#define PG8_STAGE(bufoff, gbase, voff) do { _Pragma("unroll") for (int _i = 0; _i < 2; ++_i) \
        __builtin_amdgcn_global_load_lds((const unsigned*)((const char*)(gbase) + (voff)[_i]), (PG8_LAS unsigned*)(lds + (bufoff) + ldsw + _i * 8192), 16, 0, 0); } while (0)
#define PG8_LDA(dst, b, h) do { _Pragma("unroll") for (int m = 0; m < 4; ++m) _Pragma("unroll") for (int k = 0; k < 2; ++k) dst[m][k] = *(const PG8_LAS bf16x8*)(lds + PG8_SA(b, h) + aoff + m * 2048 + k * 1024); } while (0)
#define PG8_LDB(dst, b, h) do { _Pragma("unroll") for (int n = 0; n < 2; ++n) _Pragma("unroll") for (int k = 0; k < 2; ++k) dst[n][k] = *(const PG8_LAS bf16x8*)(lds + PG8_SB(b, h) + boff + n * 2048 + k * 1024); } while (0)
#define PG8_MMA(ai, bj, At, Bt) do { __builtin_amdgcn_s_setprio(1); _Pragma("unroll") for (int m = 0; m < 4; ++m) _Pragma("unroll") for (int n = 0; n < 2; ++n) _Pragma("unroll") for (int k = 0; k < 2; ++k) \
        acc[ai][bj][m][n] = __builtin_amdgcn_mfma_f32_16x16x32_bf16(Bt[n][k], At[m][k], acc[ai][bj][m][n], 0, 0, 0); __builtin_amdgcn_s_setprio(0); } while (0)
#define PG8_WAIT_V(n) asm volatile("s_waitcnt vmcnt(" #n ")" ::: "memory")
#define PG8_WAIT_L(n) asm volatile("s_waitcnt lgkmcnt(" #n ")" ::: "memory")
#define PG8_BAR __builtin_amdgcn_s_barrier()
#define PG8_SCHED __builtin_amdgcn_sched_barrier(0)
    Unit cur, nxt; int ui = 0;
    if (!S.next(0, cur)) return;
    f32x4 acc[2][2][4][2];
#pragma unroll
    for (int a = 0; a < 2; ++a)
#pragma unroll
        for (int b = 0; b < 2; ++b)
#pragma unroll
            for (int m = 0; m < 4; ++m)
#pragma unroll
                for (int n = 0; n < 2; ++n) acc[a][b][m][n] = (f32x4){0.f, 0.f, 0.f, 0.f};
    bf16x8 At[4][2], B0[2][2], B1[2][2];
    const char* cA = (const char*)g.A + (size_t)cur.pm * tstep; const char* cB = (const char*)g.Bt + (size_t)cur.pn * tstep;
    S.a_ready(cur);
    if constexpr (SP2) {
        PG8_STAGE(PG8_SB(0, 0), cB, voffB); PG8_STAGE(PG8_SB(0, 1), cB + hstep, voffB); PG8_STAGE(PG8_SA(0, 0), cA, voffA); PG8_STAGE(PG8_SA(0, 1), cA + hstep, voffA);
        if (wr == 1) PG8_BAR;
        PG8_WAIT_V(2); PG8_BAR;
        PG8_STAGE(PG8_SB(1, 0), cB + kstep, voffB); PG8_STAGE(PG8_SA(1, 0), cA + kstep, voffA); PG8_STAGE(PG8_SB(1, 1), cB + hstep + kstep, voffB);
        PG8_WAIT_V(6); PG8_BAR;
    } else {
        PG8_STAGE(PG8_SB(0, 0), cB, voffB); PG8_STAGE(PG8_SA(0, 0), cA, voffA); PG8_STAGE(PG8_SB(0, 1), cB + hstep, voffB); PG8_STAGE(PG8_SA(0, 1), cA + hstep, voffA);
        if (wr == 1) PG8_BAR;
        PG8_WAIT_V(4); PG8_BAR;
        PG8_STAGE(PG8_SB(1, 0), cB + kstep, voffB); PG8_STAGE(PG8_SA(1, 0), cA + kstep, voffA); PG8_STAGE(PG8_SB(1, 1), cB + hstep + kstep, voffB);
        PG8_WAIT_V(6); PG8_BAR;
    }
    for (;;) {
        const bool has_next = S.next(ui + 1, nxt);
        const char* nA = has_next ? (const char*)g.A + (size_t)nxt.pm * tstep : cA; const char* nB = has_next ? (const char*)g.Bt + (size_t)nxt.pn * tstep : cB;
        for (int t = 0; t < nt; t += 2) {
            const bool last = (t == nt - 2);
            const char* a1 = cA + (size_t)(t + 1) * kstep;
            const char* a2 = last ? nA : cA + (size_t)(t + 2) * kstep; const char* b2 = last ? nB : cB + (size_t)(t + 2) * kstep;
            const char* a3 = a2 + kstep; const char* b3 = b2 + kstep;
            if (last && has_next) S.a_ready(nxt);
            if constexpr (SP2) {
            PG8_LDB(B0, 0, 0); PG8_LDB(B1, 0, 1); PG8_SCHED; PG8_LDA(At, 0, 0); PG8_STAGE(PG8_SA(1, 1), a1 + hstep, voffA);
            PG8_WAIT_V(8); PG8_WAIT_L(0); PG8_BAR; PG8_MMA(0, 0, At, B0); PG8_MMA(0, 1, At, B1); PG8_BAR; PG8_SCHED;
            PG8_LDA(At, 0, 1); PG8_STAGE(PG8_SB(0, 0), b2, voffB); PG8_STAGE(PG8_SB(0, 1), b2 + hstep, voffB); PG8_STAGE(PG8_SA(0, 0), a2, voffA);
            PG8_WAIT_V(8); PG8_WAIT_L(0); PG8_BAR; PG8_MMA(1, 0, At, B0); PG8_MMA(1, 1, At, B1); PG8_BAR; PG8_SCHED;
            PG8_LDB(B0, 1, 0); PG8_LDB(B1, 1, 1); PG8_SCHED; PG8_LDA(At, 1, 0); PG8_STAGE(PG8_SA(0, 1), a2 + hstep, voffA);
            PG8_WAIT_V(8); PG8_WAIT_L(0); PG8_BAR; PG8_MMA(0, 0, At, B0); PG8_MMA(0, 1, At, B1); PG8_BAR; PG8_SCHED;
            PG8_LDA(At, 1, 1); PG8_STAGE(PG8_SB(1, 0), b3, voffB); PG8_STAGE(PG8_SB(1, 1), b3 + hstep, voffB); PG8_STAGE(PG8_SA(1, 0), a3, voffA);
            PG8_WAIT_V(8); PG8_WAIT_L(0); PG8_BAR; PG8_MMA(1, 0, At, B0); PG8_MMA(1, 1, At, B1); PG8_BAR; PG8_SCHED;
            } else {
            PG8_LDB(B0, 0, 0); PG8_SCHED; PG8_LDA(At, 0, 0); PG8_STAGE(PG8_SA(1, 1), a1 + hstep, voffA);
            PG8_WAIT_L(8); PG8_BAR; PG8_WAIT_L(0); PG8_MMA(0, 0, At, B0); PG8_BAR; PG8_SCHED;
            PG8_LDB(B1, 0, 1); PG8_STAGE(PG8_SB(0, 0), b2, voffB);
            PG8_BAR; PG8_WAIT_L(0); PG8_MMA(0, 1, At, B1); PG8_BAR;
            PG8_LDA(At, 0, 1); PG8_STAGE(PG8_SA(0, 0), a2, voffA);
            PG8_BAR; PG8_WAIT_L(0); PG8_MMA(1, 0, At, B0); PG8_BAR; PG8_SCHED;
            PG8_STAGE(PG8_SB(0, 1), b2 + hstep, voffB);
            PG8_WAIT_V(6); PG8_BAR; PG8_MMA(1, 1, At, B1); PG8_BAR;
            PG8_LDB(B0, 1, 0); PG8_SCHED; PG8_LDA(At, 1, 0); PG8_STAGE(PG8_SA(0, 1), a2 + hstep, voffA);
            PG8_WAIT_L(8); PG8_BAR; PG8_WAIT_L(0); PG8_MMA(0, 0, At, B0); PG8_BAR; PG8_SCHED;
            PG8_LDB(B1, 1, 1); PG8_STAGE(PG8_SB(1, 0), b3, voffB);
            PG8_BAR; PG8_WAIT_L(0); PG8_MMA(0, 1, At, B1); PG8_BAR;
            PG8_LDA(At, 1, 1); PG8_STAGE(PG8_SA(1, 0), a3, voffA);
            PG8_BAR; PG8_WAIT_L(0); PG8_MMA(1, 0, At, B0); PG8_BAR; PG8_SCHED;
            PG8_STAGE(PG8_SB(1, 1), b3 + hstep, voffB);
            PG8_WAIT_V(6); PG8_BAR; PG8_MMA(1, 1, At, B1); PG8_BAR;
            }
        }
        if constexpr (ALIGN_EPI) { if (wr == 0) PG8_BAR; }
        E(acc, cur, wr, wc, fr, fq); S.done(cur);
        if (!has_next) break;
#pragma unroll
        for (int a = 0; a < 2; ++a)
#pragma unroll
            for (int b = 0; b < 2; ++b)
#pragma unroll
                for (int m = 0; m < 4; ++m)
#pragma unroll
                    for (int n = 0; n < 2; ++n) acc[a][b][m][n] = (f32x4){0.f, 0.f, 0.f, 0.f};
        cur = nxt; cA = nA; cB = nB; ++ui;
        if constexpr (ALIGN_EPI) { if (wr == 1) PG8_BAR; }
    }
    PG8_WAIT_V(0);
    if constexpr (!ALIGN_EPI) { if (wr == 0) PG8_BAR; }
    PG8_BAR;
#undef PG8_SA
#undef PG8_SB
#undef PG8_STAGE
#undef PG8_LDA
#undef PG8_LDB
#undef PG8_MMA
#undef PG8_WAIT_V
#undef PG8_WAIT_L
#undef PG8_BAR
#undef PG8_SCHED
}
}

constexpr int BATCH = 8, SEQ = 2048, D = 1024, M = BATCH * SEQ;
constexpr int FF = 2816, DRNN = 1280, NBLK = 10, RBLK = 128, CONVW = 4;
constexpr int NHEAD = 16, HD = 64, NGRP = 3, NQKV = 9216;
constexpr float RMS_EPS = 1e-6f;
constexpr float LOG2E = 1.4426950408889634f;
constexpr int NWAVES = 8;

typedef unsigned short bf16;
typedef unsigned v4u __attribute__((ext_vector_type(4)));
typedef unsigned v2u __attribute__((ext_vector_type(2)));
typedef float f32x4 __attribute__((ext_vector_type(4)));
#define GAS __attribute__((address_space(1)))
#define LAS __attribute__((address_space(3)))
typedef GAS unsigned gu32;
#define RLX_AGENT __ATOMIC_RELAXED, __HIP_MEMORY_SCOPE_AGENT
#define LDS_WAIT() asm volatile("s_waitcnt lgkmcnt(0)" ::: "memory")

constexpr size_t MiB = 1u << 20;
constexpr size_t WS_CTL = 0, CTL_ZERO_BYTES = 1 * MiB;
constexpr size_t WS_SSQ = 1 * MiB;
constexpr size_t WS_BIAS = 2 * MiB;
constexpr size_t WS_XB = 3 * MiB;
constexpr size_t WS_WO = 35 * MiB;
constexpr size_t WS_WQKV = 37 * MiB;
constexpr size_t WS_QKV = 55 * MiB;
constexpr size_t QKV_SLAB = (size_t)M * 1024 * 2;
constexpr size_t WS_LSE = 343 * MiB;
constexpr size_t WS_END = 346 * MiB;
constexpr size_t WS_WIN0 = 55 * MiB, WS_WOUT0 = 66 * MiB, WS_WIN1 = 72 * MiB, WS_WOUT1 = 83 * MiB, WS_WIN2 = 89 * MiB, WS_WOUT2 = 100 * MiB;
constexpr size_t WS_WRIN = 106 * MiB, WS_WROUT = 111 * MiB, WS_WA = 114 * MiB, WS_WX = 114 * MiB + 512 * 1024;
constexpr size_t WS_ACT = 115 * MiB;
constexpr size_t WS_G = 203 * MiB, WS_U = 243 * MiB, WS_Y = 283 * MiB;
constexpr size_t WS_AF = 115 * MiB, WS_BF = 155 * MiB;
constexpr size_t WS_ATT = WS_QKV + 3 * QKV_SLAB;
constexpr size_t WS_WIN3 = WS_QKV + 6 * QKV_SLAB, WS_WOUT3 = WS_WIN3 + 11 * MiB;
constexpr size_t WS_ACT3 = WS_QKV;
static_assert(WS_Y + (size_t)M * DRNN * 2 <= WS_LSE && WS_ACT + (size_t)M * FF * 2 <= WS_G && WS_WX + 327680 <= WS_ACT, "ws map");
static_assert(WS_QKV + 9 * QKV_SLAB == WS_LSE && WS_LSE + (size_t)3 * M * 16 * 4 <= WS_END, "ws map");
constexpr int CW_BAR = 4096;

constexpr int RING_BYTES = 131072, LDSCTL_OFF = RING_BYTES, MISC_OFF = LDSCTL_OFF + 320;
constexpr int LDS_BYTES = 147456;

#define XB_TMO      128
#define XB_XCNT(j)  (256  + 64 * (j))
#define XB_XSUB(j)  (1280 + 64 * (j))
#define XB_XGEN(j)  (2304 + 64 * (j))
#define XB_TOP      3328
#define XB_TOPGEN   3392
#define XCD_BAR_WORDS 3456
#define XB_SPIN_CAP (1u << 18)
__device__ __forceinline__ unsigned xb_ld(unsigned* p)              { return __hip_atomic_load(p, __ATOMIC_RELAXED, __HIP_MEMORY_SCOPE_AGENT); }
__device__ __forceinline__ unsigned xb_add(unsigned* p, unsigned v) { return __hip_atomic_fetch_add(p, v, __ATOMIC_RELAXED, __HIP_MEMORY_SCOPE_AGENT); }
__device__ __forceinline__ unsigned xb_xcc_id() { return (unsigned)__builtin_amdgcn_s_getreg((3 << 11) | 20) & 0xFu; }
#define XB_SPIN(cond, bar) do { unsigned _sp = 0; while (cond) { __builtin_amdgcn_s_sleep(1); \
    if ((++_sp & 255u) == 0u) { if (xb_ld(&(bar)[XB_TMO])) break; if (_sp > XB_SPIN_CAP) { atomicAdd(&(bar)[XB_TMO], 1u); break; } } } } while (0)
struct XcdBarrier { unsigned* bar; unsigned x; volatile LAS unsigned* st; };
__device__ __forceinline__ XcdBarrier xcd_barrier_post(unsigned* bar, volatile LAS unsigned* st) {
    XcdBarrier b; b.bar = bar; b.x = xb_xcc_id(); b.st = st;
    if (threadIdx.x == 0) (void)xb_add(&bar[XB_XCNT(b.x)], 1u);
    return b;
}
__device__ __forceinline__ void xcd_barrier_complete(unsigned* bar, unsigned x, unsigned& nloc, unsigned& nx) {
    const unsigned G = gridDim.x * gridDim.y * gridDim.z;
    unsigned sum, cnt, mine, sp = 0u;
    for (;;) {
        sum = 0u; cnt = 0u; mine = 0u;
#pragma unroll
        for (unsigned j = 0; j < 16; ++j) { const unsigned c = xb_ld(&bar[XB_XCNT(j)]); sum += c; cnt += (c > 0u) ? 1u : 0u; mine = (j == x) ? c : mine; }
        if (sum == G) break;
        __builtin_amdgcn_s_sleep(1);
        if ((++sp & 255u) == 0u) { if (xb_ld(&bar[XB_TMO])) break; if (sp > XB_SPIN_CAP) { atomicAdd(&bar[XB_TMO], 1u); break; } }
    }
    nloc = mine > 0u ? mine : 1u; nx = cnt > 0u ? cnt : 1u;
}
__device__ __forceinline__ void xcd_barrier(const XcdBarrier& b) {
    asm volatile("s_waitcnt vmcnt(0)" ::: "memory");
    __syncthreads();
    if (threadIdx.x == 0) {
        unsigned* bar = b.bar;
        __builtin_amdgcn_s_waitcnt(0);
        unsigned nloc = b.st[0], nx = b.st[1];
        if (nloc == 0u) { xcd_barrier_complete(bar, b.x, nloc, nx); b.st[0] = nloc; b.st[1] = nx; }
        const unsigned old = xb_add(&bar[XB_XSUB(b.x)], 1u);
        const unsigned gen = old / nloc;
        if (old + 1u == (gen + 1u) * nloc) {
            __builtin_amdgcn_fence(__ATOMIC_RELEASE, "agent");
            asm volatile("s_waitcnt vmcnt(0)" ::: "memory");
            const unsigned og = xb_add(&bar[XB_TOP], 1u);
            const unsigned tg = og / nx;
            if (og + 1u == (tg + 1u) * nx) xb_add(&bar[XB_TOPGEN], 1u);
            else XB_SPIN(xb_ld(&bar[XB_TOPGEN]) == tg, bar);
            __builtin_amdgcn_fence(__ATOMIC_ACQUIRE, "agent");
            xb_add(&bar[XB_XGEN(b.x)], 1u);
            asm volatile("s_waitcnt vmcnt(0)" ::: "memory");
        } else {
            XB_SPIN(xb_ld(&bar[XB_XGEN(b.x)]) == gen, bar);
            __builtin_amdgcn_fence(__ATOMIC_ACQUIRE, "agent");
            asm volatile("s_waitcnt vmcnt(0)" ::: "memory");
        }
    }
    __syncthreads();
}

__device__ __forceinline__ unsigned f2bf(float f) { unsigned u = __builtin_bit_cast(unsigned, f); return (u + 0x7fffu + ((u >> 16) & 1u)) >> 16; }
__device__ __forceinline__ unsigned pk2(float lo, float hi) { return f2bf(lo) | (f2bf(hi) << 16); }
__device__ __forceinline__ float bf_lo(unsigned w) { return __builtin_bit_cast(float, w << 16); }
__device__ __forceinline__ float bf_hi(unsigned w) { return __builtin_bit_cast(float, w & 0xffff0000u); }
__device__ __forceinline__ float bf2f(bf16 v) { return __builtin_bit_cast(float, (unsigned)v << 16); }
__device__ __forceinline__ float wave_sum(float v) {
#pragma unroll
    for (int o = 1; o < 64; o <<= 1) v += __shfl_xor(v, o);
    return v;
}
__device__ __forceinline__ float fast_sigmoid(float x) { return __builtin_amdgcn_rcpf(1.f + __builtin_amdgcn_exp2f(-LOG2E * x)); }
__device__ __forceinline__ float row_rstd(const float* ssq, int row) {
    const f32x4* p = (const f32x4*)(ssq + (size_t)row * 16); const f32x4 a = p[0], b = p[1], c = p[2], d = p[3];
    const float s = ((a.x + a.y) + (a.z + a.w)) + ((b.x + b.y) + (b.z + b.w)) + ((c.x + c.y) + (c.z + c.w)) + ((d.x + d.y) + (d.z + d.w));
    return rsqrtf(s * (1.0f / D) + RMS_EPS);
}

using pg8::Unit;
struct EpiSwiGLU {
    static constexpr bool PERM = true;
    const float* ssq; bf16* act;
    __device__ __forceinline__ void operator()(const f32x4 (&acc)[2][2][4][2], const Unit& u, int wr, int wc, int fr, int fq) const {
#pragma unroll
        for (int ai = 0; ai < 2; ++ai)
#pragma unroll
            for (int m = 0; m < 4; ++m) {
                const int row = u.pm * 256 + ai * 128 + wr * 64 + m * 16 + fr;
                const float rs = row_rstd(ssq, row);
                float v[8];
#pragma unroll
                for (int n = 0; n < 2; ++n)
#pragma unroll
                    for (int e = 0; e < 4; ++e) { const float g = acc[ai][0][m][n][e] * rs, up = acc[ai][1][m][n][e] * rs; v[n * 4 + e] = g * fast_sigmoid(g) * up; }
                v4u w; w.x = pg8::cvt_pk_bf16(v[0], v[1]); w.y = pg8::cvt_pk_bf16(v[2], v[3]); w.z = pg8::cvt_pk_bf16(v[4], v[5]); w.w = pg8::cvt_pk_bf16(v[6], v[7]);
                *(v4u*)(act + (size_t)row * FF + u.pn * 128 + wc * 32 + 8 * fq) = w;
                asm volatile("" ::: "memory");
            }
    }
};
struct EpiRes {
    static constexpr bool PERM = true;
    const float* xin; float* xout; bf16* xb; float* ssq; float scale;
    __device__ __forceinline__ void operator()(const f32x4 (&acc)[2][2][4][2], const Unit& u, int wr, int wc, int fr, int fq) const {
#pragma unroll
        for (int ai = 0; ai < 2; ++ai)
#pragma unroll
            for (int m = 0; m < 4; ++m) {
                const int row = u.pm * 256 + ai * 128 + wr * 64 + m * 16 + fr;
                float ss = 0.f;
#pragma unroll
                for (int bj = 0; bj < 2; ++bj) {
                    const size_t off = (size_t)row * D + u.pn * 256 + bj * 128 + wc * 32 + 8 * fq;
                    const f32x4 x0 = *(const f32x4*)(xin + off), x1 = *(const f32x4*)(xin + off + 4);
                    const f32x4 y0 = x0 + acc[ai][bj][m][0] * scale, y1 = x1 + acc[ai][bj][m][1] * scale;
                    *(f32x4*)(xout + off) = y0; *(f32x4*)(xout + off + 4) = y1;
                    v4u w; w.x = pg8::cvt_pk_bf16(y0[0], y0[1]); w.y = pg8::cvt_pk_bf16(y0[2], y0[3]); w.z = pg8::cvt_pk_bf16(y1[0], y1[1]); w.w = pg8::cvt_pk_bf16(y1[2], y1[3]);
                    *(v4u*)(xb + off) = w;
                    ss += (y0[0] * y0[0] + y0[1] * y0[1]) + (y0[2] * y0[2] + y0[3] * y0[3]) + (y1[0] * y1[0] + y1[1] * y1[1]) + (y1[2] * y1[2] + y1[3] * y1[3]);
                }
                ss += __shfl_xor(ss, 16); ss += __shfl_xor(ss, 32);
                if (fq == 0) ssq[(size_t)row * 16 + u.pn * 4 + wc] = ss;
                asm volatile("" ::: "memory");
            }
    }
};
struct EpiRnnIn {
    static constexpr bool PERM = true;
    const float* ssq; bf16* Gb; bf16* Ub;
    __device__ __forceinline__ void operator()(const f32x4 (&acc)[2][2][4][2], const Unit& u, int wr, int wc, int fr, int fq) const {
        const bool is_gate = u.pn < 5; bf16* dstb = is_gate ? Gb : Ub; const int pc = is_gate ? u.pn : u.pn - 5;
#pragma unroll
        for (int ai = 0; ai < 2; ++ai)
#pragma unroll
            for (int m = 0; m < 4; ++m) {
                const int row = u.pm * 256 + ai * 128 + wr * 64 + m * 16 + fr;
                const float rs = row_rstd(ssq, row);
#pragma unroll
                for (int bj = 0; bj < 2; ++bj) {
                    float v[8];
#pragma unroll
                    for (int n = 0; n < 2; ++n)
#pragma unroll
                        for (int e = 0; e < 4; ++e) { float x = acc[ai][bj][m][n][e] * rs;
                            if (is_gate) { const float z = 1.5957691216057308f * (x + 0.044715f * x * x * x); x = x * fast_sigmoid(z); }
                            v[n * 4 + e] = x; }
                    v4u w; w.x = pg8::cvt_pk_bf16(v[0], v[1]); w.y = pg8::cvt_pk_bf16(v[2], v[3]); w.z = pg8::cvt_pk_bf16(v[4], v[5]); w.w = pg8::cvt_pk_bf16(v[6], v[7]);
                    *(v4u*)(dstb + (size_t)row * DRNN + pc * 256 + bj * 128 + wc * 32 + 8 * fq) = w;
                }
                asm volatile("" ::: "memory");
            }
    }
};
struct EpiQKV {
    static constexpr bool PERM = true;
    const float* ssq; const float* qgain; const float* kgain; bf16* qkv;
    __device__ __forceinline__ void operator()(const f32x4 (&acc)[2][2][4][2], const Unit& u, int wr, int wc, int fr, int fq) const {
        const int hs = u.pn * 4 + wc, kind = hs / 48, gh = hs - kind * 48, g = gh >> 4, h = gh & 15, l2d = 2 * g;
        const float* gain = (kind == 0) ? qgain : kgain; const float gsc = (kind == 0) ? 0.125f * LOG2E : 1.f;
        bf16* slab = qkv + (size_t)(kind * 3 + g) * ((size_t)M * 1024);
#pragma unroll
        for (int ai = 0; ai < 2; ++ai)
#pragma unroll
            for (int m = 0; m < 4; ++m) {
                const int row = u.pm * 256 + ai * 128 + wr * 64 + m * 16 + fr;
                const float rs = row_rstd(ssq, row);
                f32x4 v[2][2]; float ss = 0.f;
#pragma unroll
                for (int bj = 0; bj < 2; ++bj)
#pragma unroll
                    for (int n = 0; n < 2; ++n) { v[bj][n] = acc[ai][bj][m][n] * rs; const f32x4 t = v[bj][n]; ss += (t[0] * t[0] + t[1] * t[1]) + (t[2] * t[2] + t[3] * t[3]); }
                ss += __shfl_xor(ss, 16); ss += __shfl_xor(ss, 32);
                const float rn = (kind < 2) ? rsqrtf(ss * (1.0f / HD) + RMS_EPS) : 1.f;
                const int b = row >> 11, t = row & 2047, rres = t & ((1 << l2d) - 1), l = t >> l2d, L = 2048 >> l2d;
                bf16* dst = slab + ((size_t)(b * 16 + h) * 2048 + rres * L + l) * 64 + 8 * fq;
#pragma unroll
                for (int bj = 0; bj < 2; ++bj) {
                    f32x4 g0 = (f32x4){1.f, 1.f, 1.f, 1.f}, g1 = g0;
                    if (kind < 2) { g0 = *(const f32x4*)(gain + 32 * bj + 8 * fq) * gsc; g1 = *(const f32x4*)(gain + 32 * bj + 8 * fq + 4) * gsc; }
                    const f32x4 a0 = v[bj][0] * g0 * rn, a1 = v[bj][1] * g1 * rn;
                    v4u w; w.x = pg8::cvt_pk_bf16(a0[0], a0[1]); w.y = pg8::cvt_pk_bf16(a0[2], a0[3]); w.z = pg8::cvt_pk_bf16(a1[0], a1[1]); w.w = pg8::cvt_pk_bf16(a1[2], a1[3]);
                    *(v4u*)(dst + 32 * bj) = w;
                }
                asm volatile("" ::: "memory");
            }
    }
};

struct Args { const float* in[18]; float* out; unsigned char* ws; int ph_lo, ph_hi; };
enum { I_X = 0, I_NORMG, I_FFN_WIN, I_FFN_WOUT, I_RNN_WIN, I_CONV_W, I_CONV_B, I_WA, I_BA, I_WX, I_BX, I_LAM, I_RNN_WOUT, I_WQKV, I_QGAIN, I_KGAIN, I_WO, I_RELB };

struct Ctx { LAS unsigned char* lds; int tid, lane, wave, G, vcu; unsigned char* ws; };

enum { CM_NONE = 0, CM_FFN = 1, CM_QKV = 2 };
__device__ __forceinline__ int colmap(int mode, int vr) {
    if (mode == CM_FFN) { const int pn = vr >> 8, w = vr & 255; return (w >> 7) * FF + 128 * pn + (w & 127); }
    if (mode == CM_QKV) { const int pn = vr >> 8, w = vr & 255, bj = w >> 7, wc = (w >> 5) & 3, j = w & 31; return 256 * pn + 64 * wc + 32 * bj + j; }
    return vr;
}
__device__ __forceinline__ void transpose_item(const float* W, int K, int N, const float* gvec, bf16* WT, int mode, LAS float* scr, int item, int lane) {
    const int nblk = N / 32, kb = item / nblk, nb = item - kb * nblk, k0 = 64 * kb, vr0 = 32 * nb, n0 = colmap(mode, vr0);
#pragma unroll 8
    for (int i = 0; i < 32; ++i) { const int kk = 2 * i + (lane >> 5); float w = W[(size_t)(k0 + kk) * N + n0 + (lane & 31)]; if (gvec) w *= gvec[k0 + kk]; scr[kk * 33 + (lane & 31)] = w; }
    LDS_WAIT(); asm volatile("" ::: "memory");
    const int c = lane & 7;
#pragma unroll
    for (int j = 0; j < 4; ++j) { const int n = (lane >> 3) + 8 * j; const LAS float* s = scr + (8 * c) * 33 + n;
        v4u o; o.x = pk2(s[0 * 33], s[1 * 33]); o.y = pk2(s[2 * 33], s[3 * 33]); o.z = pk2(s[4 * 33], s[5 * 33]); o.w = pk2(s[6 * 33], s[7 * 33]);
        *(GAS v4u*)(WT + (size_t)(vr0 + n) * K + k0 + 8 * c) = o; }
    LDS_WAIT(); asm volatile("" ::: "memory");
}
struct MatJob { const float* W; int K, N; const float* g; bf16* WT; int mode; };
__device__ __forceinline__ MatJob mat_job(const Ctx& C, const Args& a, int idx) {
    unsigned char* ws = C.ws; const float* ng = a.in[I_NORMG]; MatJob j;
    switch (idx) {
    case 0: j = MatJob{a.in[I_FFN_WIN] + (size_t)0 * D * 2 * FF, D, 2 * FF, ng + 0 * D, (bf16*)(ws + WS_WIN0), CM_FFN}; break;
    case 1: j = MatJob{a.in[I_FFN_WOUT] + (size_t)0 * FF * D, FF, D, nullptr, (bf16*)(ws + WS_WOUT0), CM_NONE}; break;
    case 2: j = MatJob{a.in[I_RNN_WIN], D, 2 * DRNN, ng + 1 * D, (bf16*)(ws + WS_WRIN), CM_NONE}; break;
    case 3: j = MatJob{a.in[I_RNN_WOUT], DRNN, D, nullptr, (bf16*)(ws + WS_WROUT), CM_NONE}; break;
    case 4: j = MatJob{a.in[I_FFN_WIN] + (size_t)1 * D * 2 * FF, D, 2 * FF, ng + 2 * D, (bf16*)(ws + WS_WIN1), CM_FFN}; break;
    case 5: j = MatJob{a.in[I_FFN_WOUT] + (size_t)1 * FF * D, FF, D, nullptr, (bf16*)(ws + WS_WOUT1), CM_NONE}; break;
    case 6: j = MatJob{a.in[I_FFN_WIN] + (size_t)2 * D * 2 * FF, D, 2 * FF, ng + 3 * D, (bf16*)(ws + WS_WIN2), CM_FFN}; break;
    case 7: j = MatJob{a.in[I_FFN_WOUT] + (size_t)2 * FF * D, FF, D, nullptr, (bf16*)(ws + WS_WOUT2), CM_NONE}; break;
    case 8: j = MatJob{a.in[I_WQKV], D, NQKV, ng + 4 * D, (bf16*)(ws + WS_WQKV), CM_QKV}; break;
    case 9: j = MatJob{a.in[I_WO], D, D, nullptr, (bf16*)(ws + WS_WO), CM_NONE}; break;
    case 10: j = MatJob{a.in[I_FFN_WIN] + (size_t)3 * D * 2 * FF, D, 2 * FF, ng + 5 * D, (bf16*)(ws + WS_WIN3), CM_FFN}; break;
    default: j = MatJob{a.in[I_FFN_WOUT] + (size_t)3 * FF * D, FF, D, nullptr, (bf16*)(ws + WS_WOUT3), CM_NONE}; break;
    }
    return j;
}
__device__ __forceinline__ void convert_mats(const Ctx& C, const Args& a, int first, int last) {
    LAS float* scr = (LAS float*)(C.lds + C.wave * 16384);
    const int gw = C.vcu * NWAVES + C.wave, NGW = C.G * NWAVES;
    int base = 0;
    for (int mi = first; mi < last; ++mi) {
        const MatJob j = mat_job(C, a, mi); const int cnt = (j.K / 64) * (j.N / 32);
        int it = (gw - base) % NGW; if (it < 0) it += NGW;
        for (; it < cnt; it += NGW) transpose_item(j.W, j.K, j.N, j.g, j.WT, j.mode, scr, it, C.lane);
        base += cnt;
    }
}
__device__ __forceinline__ int t5_bucket(int n) {
    if (n < 16) return n;
    int b = 16;
    b += (n >= 22) + (n >= 30) + (n >= 40) + (n >= 54) + (n >= 73) + (n >= 99) + (n >= 134) + (n >= 182) + (n >= 246) + (n >= 332) + (n >= 450) + (n >= 609) + (n >= 825) + (n >= 1117) + (n >= 1513);
    return b;
}
__device__ __forceinline__ void p_prologue(const Ctx& C, const Args& a) {
    convert_mats(C, a, 0, 10);
    const int gw = C.vcu * NWAVES + C.wave, NGW = C.G * NWAVES;
    {   LAS float* scr = (LAS float*)(C.lds + C.wave * 16384);
        for (int it = gw; it < 2 * NBLK * 8; it += NGW) { const int which = it / (NBLK * 8), r = it % (NBLK * 8), blk = r >> 3, sub = r & 7;
            const float* W = (which ? a.in[I_WX] : a.in[I_WA]) + (size_t)blk * RBLK * RBLK; bf16* WT = (bf16*)(C.ws + (which ? WS_WX : WS_WA)) + (size_t)blk * RBLK * RBLK;
            transpose_item(W, RBLK, RBLK, nullptr, WT, CM_NONE, scr, sub, C.lane); } }
    const float* x = a.in[I_X]; bf16* xb = (bf16*)(C.ws + WS_XB); float* ssq = (float*)(C.ws + WS_SSQ);
    for (int m = gw; m < M; m += NGW) {
        const GAS f32x4* xr = (const GAS f32x4*)(x + (size_t)m * D) + C.lane; f32x4 v[4]; float s = 0.f;
#pragma unroll
        for (int j = 0; j < 4; ++j) { v[j] = xr[64 * j]; s += (v[j].x * v[j].x + v[j].y * v[j].y) + (v[j].z * v[j].z + v[j].w * v[j].w); }
        s = wave_sum(s);
        GAS v2u* o8 = (GAS v2u*)(xb + (size_t)m * D) + C.lane;
#pragma unroll
        for (int j = 0; j < 4; ++j) { v2u w; w.x = pk2(v[j].x, v[j].y); w.y = pk2(v[j].z, v[j].w); o8[64 * j] = w; }
        if (C.lane < 16) ssq[(size_t)m * 16 + C.lane] = (C.lane == 0) ? s : 0.f;
    }
    float* bt = (float*)(C.ws + WS_BIAS); const float* rb = a.in[I_RELB];
    for (int i = blockIdx.x * 512 + C.tid; i < 48 * 129; i += C.G * 512) { const int gh = i / 129, dist = i - gh * 129, g = gh >> 4;
        bt[gh * 132 + dist] = rb[t5_bucket(dist << (2 * g)) * 48 + gh] * LOG2E; }
}

__device__ __forceinline__ void p_rnn_ab(const Ctx& C, const Args& a, int half) {
    const bf16* U = (const bf16*)(C.ws + WS_U); float* AF = (float*)(C.ws + WS_AF); float* BF = (float*)(C.ws + WS_BF);
    LAS float* ufs = (LAS float*)C.lds;
    const float* cw = a.in[I_CONV_W]; const float* cb = a.in[I_CONV_B];
    const int d = C.tid & 127, tq = __builtin_amdgcn_readfirstlane(C.tid >> 7);
    for (int item = blockIdx.x; item < 256 * NBLK; item += C.G) {
        const int tt = item / NBLK, n = item - tt * NBLK, tok0 = half * (M / 2) + tt * 32;
        for (int e = C.tid; e < 32 * 128; e += 512) { const int t = e >> 7, c = e & 127, tok = tok0 + t, tpos = tok & (SEQ - 1), ch = n * 128 + c;
            float acc = cb[ch];
#pragma unroll
            for (int k = 0; k < CONVW; ++k) { const int tp = tpos - (CONVW - 1) + k; if (tp >= 0) acc += bf2f(U[(size_t)(tok - (CONVW - 1) + k) * DRNN + ch]) * cw[k * DRNN + ch]; }
            ufs[e] = acc; }
        __syncthreads();
        float accA[8], accX[8];
#pragma unroll
        for (int j = 0; j < 8; ++j) { accA[j] = 0.f; accX[j] = 0.f; }
        const float* wa = a.in[I_WA] + (size_t)n * RBLK * RBLK + d; const float* wx = a.in[I_WX] + (size_t)n * RBLK * RBLK + d;
        for (int c = 0; c < 128; ++c) { const float va = wa[c * 128], vx = wx[c * 128];
#pragma unroll
            for (int j = 0; j < 8; ++j) { const float uu = ufs[(tq * 8 + j) * 128 + c]; accA[j] += uu * va; accX[j] += uu * vx; } }
        const int ch = n * 128 + d; const float ba = a.in[I_BA][ch], bx = a.in[I_BX][ch], lam = a.in[I_LAM][ch];
        const float sp = log1pf(expf(-lam));
#pragma unroll
        for (int j = 0; j < 8; ++j) { const int t = tq * 8 + j; const float r = 1.f / (1.f + expf(-(accA[j] + ba))), ii = 1.f / (1.f + expf(-(accX[j] + bx)));
            const float la = -8.0f * r * sp, av = expf(la), bv = sqrtf(-expm1f(2.f * la)) * (ii * ufs[t * 128 + d]);
            const size_t o = (size_t)(tt * 32 + t) * DRNN + ch; AF[o] = av; BF[o] = bv; }
        __syncthreads();
    }
}
__device__ __forceinline__ void p_rnn_scan(const Ctx& C, int half) {
    const float* AF = (const float*)(C.ws + WS_AF); const float* BF = (const float*)(C.ws + WS_BF);
    const bf16* Gb = (const bf16*)(C.ws + WS_G); bf16* Y = (bf16*)(C.ws + WS_Y);
    for (int gid = blockIdx.x * 512 + C.tid; gid < 4 * DRNN; gid += C.G * 512) {
        const int bl = gid / DRNN, ch = gid - bl * DRNN; float h = 0.f;
        const size_t lo = (size_t)bl * SEQ * DRNN + ch, go = ((size_t)(half * 4 + bl) * SEQ) * DRNN + ch;
#pragma unroll 8
        for (int t = 0; t < SEQ; ++t) { const size_t i = lo + (size_t)t * DRNN, o = go + (size_t)t * DRNN; h = AF[i] * h + BF[i]; Y[o] = (bf16)f2bf(h * bf2f(Gb[o])); }
    }
}
__device__ __forceinline__ void p_attn(const Ctx& C) {
    bf16* QKV = (bf16*)(C.ws + WS_QKV); float* LSE = (float*)(C.ws + WS_LSE); const float* bt = (const float*)(C.ws + WS_BIAS);
    for (int qid = blockIdx.x * 512 + C.tid; qid < NGRP * BATCH * NHEAD * SEQ; qid += C.G * 512) {
        const int llin = qid & (SEQ - 1), bh = (qid >> 11) & 127, g = qid >> 18, l2d = 2 * g, L = SEQ >> l2d, l = llin & (L - 1);
        bf16* qrow = QKV + (size_t)g * ((size_t)M * 1024) + ((size_t)bh * SEQ + llin) * HD;
        const bf16* krow = qrow + 3 * (size_t)M * 1024; const bf16* vrow = qrow + 6 * (size_t)M * 1024;
        const float* btab = bt + (g * 16 + (bh & 15)) * 132;
        float q[64], o[64];
#pragma unroll
        for (int c = 0; c < 8; ++c) { const v4u w = *(const v4u*)(qrow + 8 * c);
            q[8 * c + 0] = bf_lo(w.x); q[8 * c + 1] = bf_hi(w.x); q[8 * c + 2] = bf_lo(w.y); q[8 * c + 3] = bf_hi(w.y); q[8 * c + 4] = bf_lo(w.z); q[8 * c + 5] = bf_hi(w.z); q[8 * c + 6] = bf_lo(w.w); q[8 * c + 7] = bf_hi(w.w); }
#pragma unroll
        for (int c = 0; c < 64; ++c) o[c] = 0.f;
        float mx = -INFINITY, lsum = 0.f;
        const int nk = l < 128 ? l : 128;
        for (int dist = 0; dist <= nk; ++dist) {
            const bf16* kr = krow - (size_t)dist * HD; const bf16* vr = vrow - (size_t)dist * HD;
            float s0 = 0.f, s1 = 0.f;
#pragma unroll
            for (int c = 0; c < 8; ++c) { const v4u w = *(const v4u*)(kr + 8 * c);
                s0 += q[8 * c + 0] * bf_lo(w.x) + q[8 * c + 2] * bf_lo(w.y) + q[8 * c + 4] * bf_lo(w.z) + q[8 * c + 6] * bf_lo(w.w);
                s1 += q[8 * c + 1] * bf_hi(w.x) + q[8 * c + 3] * bf_hi(w.y) + q[8 * c + 5] * bf_hi(w.z) + q[8 * c + 7] * bf_hi(w.w); }
            const float s = s0 + s1 + btab[dist];
            const float mn = fmaxf(mx, s), f = exp2f(mx - mn), p = exp2f(s - mn);
            lsum = lsum * f + p; mx = mn;
#pragma unroll
            for (int c = 0; c < 8; ++c) { const v4u w = *(const v4u*)(vr + 8 * c);
                o[8 * c + 0] = o[8 * c + 0] * f + p * bf_lo(w.x); o[8 * c + 1] = o[8 * c + 1] * f + p * bf_hi(w.x); o[8 * c + 2] = o[8 * c + 2] * f + p * bf_lo(w.y); o[8 * c + 3] = o[8 * c + 3] * f + p * bf_hi(w.y);
                o[8 * c + 4] = o[8 * c + 4] * f + p * bf_lo(w.z); o[8 * c + 5] = o[8 * c + 5] * f + p * bf_hi(w.z); o[8 * c + 6] = o[8 * c + 6] * f + p * bf_lo(w.w); o[8 * c + 7] = o[8 * c + 7] * f + p * bf_hi(w.w); }
        }
        const float inv = 1.f / lsum;
#pragma unroll
        for (int c = 0; c < 8; ++c) { v4u w; w.x = pk2(o[8 * c] * inv, o[8 * c + 1] * inv); w.y = pk2(o[8 * c + 2] * inv, o[8 * c + 3] * inv); w.z = pk2(o[8 * c + 4] * inv, o[8 * c + 5] * inv); w.w = pk2(o[8 * c + 6] * inv, o[8 * c + 7] * inv);
            *(v4u*)(qrow + 8 * c) = w; }
        const int rres = llin >> (11 - l2d), t = (l << l2d) + rres, row = (bh >> 4) * SEQ + t;
        LSE[((size_t)g * M + row) * 16 + (bh & 15)] = mx + log2f(lsum);
    }
}
__device__ __forceinline__ void p_merge(const Ctx& C, const Args& a) {
    const bf16* QKV = (const bf16*)(C.ws + WS_QKV); const float* LSE = (const float*)(C.ws + WS_LSE); bf16* ATT = (bf16*)(C.ws + WS_ATT);
    for (int idx = blockIdx.x * 512 + C.tid; idx < M * 16 * 8; idx += C.G * 512) {
        const int ch = idx & 7, h = (idx >> 3) & 15, row = idx >> 7, b = row >> 11, t = row & 2047;
        float ls[3], mxl = -INFINITY;
#pragma unroll
        for (int g = 0; g < 3; ++g) { ls[g] = LSE[((size_t)g * M + row) * 16 + h]; mxl = fmaxf(mxl, ls[g]); }
        float acc[8], wsum = 0.f;
#pragma unroll
        for (int e = 0; e < 8; ++e) acc[e] = 0.f;
#pragma unroll
        for (int g = 0; g < 3; ++g) { const float w = exp2f(ls[g] - mxl); wsum += w; const int l2d = 2 * g, rres = t & ((1 << l2d) - 1), l = t >> l2d, L = SEQ >> l2d;
            const v4u v = *(const v4u*)(QKV + (size_t)g * ((size_t)M * 1024) + ((size_t)(b * 16 + h) * SEQ + rres * L + l) * HD + 8 * ch);
            acc[0] += w * bf_lo(v.x); acc[1] += w * bf_hi(v.x); acc[2] += w * bf_lo(v.y); acc[3] += w * bf_hi(v.y); acc[4] += w * bf_lo(v.z); acc[5] += w * bf_hi(v.z); acc[6] += w * bf_lo(v.w); acc[7] += w * bf_hi(v.w); }
        const float inv = 1.f / wsum; v4u o; o.x = pk2(acc[0] * inv, acc[1] * inv); o.y = pk2(acc[2] * inv, acc[3] * inv); o.z = pk2(acc[4] * inv, acc[5] * inv); o.w = pk2(acc[6] * inv, acc[7] * inv);
        *(v4u*)(ATT + (size_t)row * 1024 + h * 64 + 8 * ch) = o;
    }
    convert_mats(C, a, 10, 12);
}

enum { PH_PROLOGUE = 0, PH_FFN_IN_0, PH_FFN_OUT_0, PH_RNN_IN, PH_RNN_AB0, PH_RNN_SCAN0, PH_RNN_AB1, PH_RNN_SCAN1, PH_RNN_OUT, PH_FFN_IN_1, PH_FFN_OUT_1,
       PH_FFN_IN_2, PH_FFN_OUT_2, PH_QKV, PH_ATTN, PH_MERGE, PH_WO, PH_FFN_IN_3, PH_FFN_OUT_3, NPHASE };

__global__ void __launch_bounds__(NWAVES * 64, 2) fwd_kernel(Args args) {
    extern __shared__ __attribute__((aligned(16))) unsigned char lds_raw[];
    Ctx C; C.lds = (LAS unsigned char*)lds_raw; C.tid = threadIdx.x; C.lane = C.tid & 63; C.wave = __builtin_amdgcn_readfirstlane(C.tid >> 6);
    C.G = gridDim.x; { const int bx = blockIdx.x; C.vcu = (C.G % 8 == 0) ? (bx % 8) * (C.G / 8) + bx / 8 : bx; }
    C.ws = args.ws;
    volatile LAS unsigned* MISC = (volatile LAS unsigned*)(C.lds + MISC_OFF);
    for (int u = C.tid; u < (LDS_BYTES - LDSCTL_OFF) / 4; u += NWAVES * 64) ((LAS unsigned*)(C.lds + LDSCTL_OFF))[u] = 0u;
    __syncthreads();
    unsigned* ctl = (unsigned*)args.ws;
    XcdBarrier bar; bar.bar = ctl + CW_BAR; bar.x = 0; bar.st = nullptr;
    const bool multi = (args.ph_hi - args.ph_lo) > 1;
    if (multi) bar = xcd_barrier_post(ctl + CW_BAR, MISC + 8);
    unsigned char* ws = args.ws;
    float* ssq = (float*)(ws + WS_SSQ); bf16* xb = (bf16*)(ws + WS_XB);
    for (int ph = args.ph_lo; ph < args.ph_hi; ++ph) {
        { int t_ = threadIdx.x; asm volatile("" : "+v"(t_)); C.tid = t_; C.lane = t_ & 63; }
        switch (ph) {
        case PH_PROLOGUE: p_prologue(C, args); break;
        case PH_FFN_IN_0: case PH_FFN_IN_1: case PH_FFN_IN_2: case PH_FFN_IN_3: {
            const bf16* Bt = (const bf16*)(ws + (ph == PH_FFN_IN_0 ? WS_WIN0 : ph == PH_FFN_IN_1 ? WS_WIN1 : ph == PH_FFN_IN_2 ? WS_WIN2 : WS_WIN3));
            bf16* act = (bf16*)(ws + (ph == PH_FFN_IN_3 ? WS_ACT3 : WS_ACT));
            pg8::Gemm g{xb, Bt, M, 2 * FF, D}; pg8::StaticOrder S; S.init(M, 2 * FF, C.G, (int)blockIdx.x);
            EpiSwiGLU E{ssq, act};
            pg8::gemm_phase<EpiSwiGLU, pg8::StaticOrder, true, true>(C.lds, g, S, E);
        } break;
        case PH_FFN_OUT_0: case PH_FFN_OUT_1: case PH_FFN_OUT_2: case PH_FFN_OUT_3: case PH_RNN_OUT: case PH_WO: {
            const bf16* A; const bf16* Bt; int K; float scale = 0.5f; const float* xin = args.out;
            if (ph == PH_FFN_OUT_0) { A = (const bf16*)(ws + WS_ACT); Bt = (const bf16*)(ws + WS_WOUT0); K = FF; xin = args.in[I_X]; }
            else if (ph == PH_FFN_OUT_1) { A = (const bf16*)(ws + WS_ACT); Bt = (const bf16*)(ws + WS_WOUT1); K = FF; }
            else if (ph == PH_FFN_OUT_2) { A = (const bf16*)(ws + WS_ACT); Bt = (const bf16*)(ws + WS_WOUT2); K = FF; }
            else if (ph == PH_FFN_OUT_3) { A = (const bf16*)(ws + WS_ACT3); Bt = (const bf16*)(ws + WS_WOUT3); K = FF; }
            else if (ph == PH_RNN_OUT) { A = (const bf16*)(ws + WS_Y); Bt = (const bf16*)(ws + WS_WROUT); K = DRNN; scale = 1.f; }
            else { A = (const bf16*)(ws + WS_ATT); Bt = (const bf16*)(ws + WS_WO); K = D; scale = 1.f; }
            pg8::Gemm g{A, Bt, M, D, K}; pg8::StaticOrder S; S.init(M, D, C.G, (int)blockIdx.x);
            EpiRes E{xin, args.out, xb, ssq, scale};
            pg8::gemm_phase<EpiRes, pg8::StaticOrder, false, true>(C.lds, g, S, E);
        } break;
        case PH_RNN_IN: {
            pg8::Gemm g{xb, (const bf16*)(ws + WS_WRIN), M, 2 * DRNN, D}; pg8::StaticOrder S; S.init(M, 2 * DRNN, C.G, (int)blockIdx.x);
            EpiRnnIn E{ssq, (bf16*)(ws + WS_G), (bf16*)(ws + WS_U)};
            pg8::gemm_phase<EpiRnnIn, pg8::StaticOrder, true, true>(C.lds, g, S, E);
        } break;
        case PH_RNN_AB0: p_rnn_ab(C, args, 0); break;
        case PH_RNN_SCAN0: p_rnn_scan(C, 0); break;
        case PH_RNN_AB1: p_rnn_ab(C, args, 1); break;
        case PH_RNN_SCAN1: p_rnn_scan(C, 1); break;
        case PH_QKV: {
            pg8::Gemm g{xb, (const bf16*)(ws + WS_WQKV), M, NQKV, D}; pg8::StaticOrder S; S.init(M, NQKV, C.G, (int)blockIdx.x);
            EpiQKV E{ssq, args.in[I_QGAIN], args.in[I_KGAIN], (bf16*)(ws + WS_QKV)};
            pg8::gemm_phase<EpiQKV, pg8::StaticOrder, true, true>(C.lds, g, S, E);
        } break;
        case PH_ATTN: p_attn(C); break;
        case PH_MERGE: p_merge(C, args); break;
        default: break;
        }
        if (ph + 1 < args.ph_hi) xcd_barrier(bar);
    }
}

extern "C" void kernel_launch(void* const* d_in, const int* in_sizes, int n_in, void* d_out, int out_size, void* d_ws, size_t ws_size, hipStream_t stream) {
    static int grid = 0;
    if (grid == 0) {
        if (n_in != 18 || in_sizes[0] != M * D || out_size != M * D || ws_size < WS_END) { fprintf(stderr, "kernel_launch: unexpected shapes (n_in %d, in0 %d, out %d, ws %zu)\n", n_in, n_in > 0 ? in_sizes[0] : -1, out_size, ws_size); grid = -1; return; }
        int dev = 0, cus = 0, per_cu = 0;
        if (hipGetDevice(&dev) != hipSuccess || hipDeviceGetAttribute(&cus, hipDeviceAttributeMultiprocessorCount, dev) != hipSuccess) { fprintf(stderr, "kernel_launch: device query failed\n"); grid = -1; return; }
        if (hipFuncSetAttribute((const void*)fwd_kernel, hipFuncAttributeMaxDynamicSharedMemorySize, LDS_BYTES) != hipSuccess) { fprintf(stderr, "kernel_launch: hipFuncSetAttribute failed\n"); grid = -1; return; }
        if (hipOccupancyMaxActiveBlocksPerMultiprocessor(&per_cu, (const void*)fwd_kernel, NWAVES * 64, LDS_BYTES) != hipSuccess || per_cu < 1) { fprintf(stderr, "kernel_launch: occupancy query says %d blocks per CU\n", per_cu); (void)hipGetLastError(); grid = -1; return; }
        grid = cus;
    }
    if (grid < 0) return;
    if (hipMemsetAsync(d_ws, 0, CTL_ZERO_BYTES, stream) != hipSuccess) { fprintf(stderr, "kernel_launch: memset failed\n"); return; }
    Args a{};
    for (int i = 0; i < 18; ++i) a.in[i] = (const float*)d_in[i];
    a.out = (float*)d_out; a.ws = (unsigned char*)d_ws;
#if SINGLE_LAUNCH
    a.ph_lo = 0; a.ph_hi = NPHASE;
    hipLaunchKernelGGL(fwd_kernel, dim3(grid), dim3(NWAVES * 64), LDS_BYTES, stream, a);
#else
    for (int ph = 0; ph < NPHASE; ++ph) { a.ph_lo = ph; a.ph_hi = ph + 1; hipLaunchKernelGGL(fwd_kernel, dim3(grid), dim3(NWAVES * 64), LDS_BYTES, stream, a); }
#endif
}
```

```cpp
#include <hip/hip_runtime.h>
#include <cstdio>
#include <cstdint>

#ifndef SINGLE_LAUNCH
#define SINGLE_LAUNCH 1
#endif

namespace pg8 {
#define PG8_LAS __attribute__((address_space(3)))
typedef unsigned short bf16_t;
typedef short bf16x8 __attribute__((ext_vector_type(8)));
typedef float f32x4 __attribute__((ext_vector_type(4)));
typedef unsigned u32x4 __attribute__((ext_vector_type(4)));
constexpr int BM = 256, BK = 64, HALF = 128, HTB = HALF * BK * 2, STAGE_BYTES = 8 * HTB, NXCD = 8, WGM = 8;

__host__ __device__ __forceinline__ int lds_byte(int r, int c) { const int st = (r >> 4) * 2 + (c >> 5), rr = r & 15, cc = c & 31, ob = rr * 64 + cc * 2; return st * 1024 + (ob ^ (((ob >> 9) & 1) << 5)); }
__host__ __device__ __forceinline__ void stage_rc(int b, int& R, int& C) { const int st = b / 1024, sb = b % 1024, swz = sb ^ (((sb >> 9) & 1) << 5); R = (st >> 1) * 16 + swz / 64; C = (st & 1) * 32 + (swz % 64) / 2; }
__host__ __device__ __forceinline__ int perm32(int rho) { const int n = rho >> 4, i = rho & 15; return 8 * (i >> 2) + 4 * n + (i & 3); }

struct Unit { int pm, pn; };
struct Gemm { const bf16_t* A; const bf16_t* Bt; int M, N, K; };

struct StaticOrder {
    int nM, nN, nwg, G, c;
    __host__ __device__ void init(int M, int N, int G_, int c_) { nM = M / BM; nN = N / BM; nwg = nM * nN; G = G_; c = c_; }
    __host__ __device__ bool next(int i, Unit& u) const {
        const long L = (long)i * G + c; if (L >= nwg) return false;
        int wgid = (int)L; { const int q = nwg / NXCD, r = nwg % NXCD, xcd = wgid % NXCD, off = wgid / NXCD; wgid = (xcd < r ? xcd * (q + 1) : r * (q + 1) + (xcd - r) * q) + off; }
        const int nig = WGM * nN, gid = wgid / nig, fm = gid * WGM, gsz = (nM - fm) < WGM ? (nM - fm) : WGM;
        u.pm = fm + ((wgid % nig) % gsz); u.pn = (wgid % nig) / gsz; return true;
    }
    __device__ __forceinline__ void a_ready(const Unit&) const {}
    __device__ __forceinline__ void done(const Unit&) const {}
};

__device__ __forceinline__ unsigned cvt_pk_bf16(float lo, float hi) { unsigned r; asm volatile("v_cvt_pk_bf16_f32 %0, %1, %2" : "=v"(r) : "v"(lo), "v"(hi)); return r; }

template <class Epi, class Sched, bool ALIGN_EPI = false, bool SP2 = false>
__device__ __forceinline__ void gemm_phase(PG8_LAS unsigned char* lds, const Gemm g, const Sched& S, const Epi& E) {
    int tid_ = threadIdx.x; asm volatile("" : "+v"(tid_));
    const int tid = tid_, wid = __builtin_amdgcn_readfirstlane(tid >> 6), lane = tid & 63, wr = wid >> 2, wc = wid & 3, fr = lane & 15, fq = lane >> 4;
    const int K = g.K, nt = K / BK;
    unsigned voffA[2], voffB[2];
#pragma unroll
    for (int i = 0; i < 2; ++i) { int R, C; stage_rc(tid * 16 + i * 8192, R, C); const int Rb = Epi::PERM ? ((R & ~31) + perm32(R & 31)) : R;
        voffA[i] = (unsigned)(R * K + C) * 2u; voffB[i] = (unsigned)(Rb * K + C) * 2u; }
    const size_t kstep = (size_t)(BK * 2);
    const size_t hstep = (size_t)HALF * K * 2;
    const size_t tstep = 2 * hstep;
    const unsigned ldsw = (unsigned)wid * 1024u;
    const int aoff = lds_byte(wr * 64 + fr, fq * 8), boff = lds_byte(wc * 32 + fr, fq * 8);
#define PG8_SA(b, h) (((b) * 2 + (h)) * HTB)
#define PG8_SB(b, h) ((4 + (b) * 2 + (h)) * HTB)
#define PG8_STAGE(bufoff, gbase, voff) do { _Pragma("unroll") for (int _i = 0; _i < 2; ++_i) \
        __builtin_amdgcn_global_load_lds((const unsigned*)((const char*)(gbase) + (voff)[_i]), (PG8_LAS unsigned*)(lds + (bufoff) + ldsw + _i * 8192), 16, 0, 0); } while (0)
#define PG8_LDA(dst, b, h) do { _Pragma("unroll") for (int m = 0; m < 4; ++m) _Pragma("unroll") for (int k = 0; k < 2; ++k) dst[m][k] = *(const PG8_LAS bf16x8*)(lds + PG8_SA(b, h) + aoff + m * 2048 + k * 1024); } while (0)
#define PG8_LDB(dst, b, h) do { _Pragma("unroll") for (int n = 0; n < 2; ++n) _Pragma("unroll") for (int k = 0; k < 2; ++k) dst[n][k] = *(const PG8_LAS bf16x8*)(lds + PG8_SB(b, h) + boff + n * 2048 + k * 1024); } while (0)
#define PG8_MMA(ai, bj, At, Bt) do { __builtin_amdgcn_s_setprio(1); _Pragma("unroll") for (int m = 0; m < 4; ++m) _Pragma("unroll") for (int n = 0; n < 2; ++n) _Pragma("unroll") for (int k = 0; k < 2; ++k) \
        acc[ai][bj][m][n] = __builtin_amdgcn_mfma_f32_16x16x32_bf16(Bt[n][k], At[m][k], acc[ai][bj][m][n], 0, 0, 0); __builtin_amdgcn_s_setprio(0); } while (0)
#define PG8_WAIT_V(n) asm volatile("s_waitcnt vmcnt(" #n ")" ::: "memory")
#define PG8_WAIT_L(n) asm volatile("s_waitcnt lgkmcnt(" #n ")" ::: "memory")
#define PG8_BAR __builtin_amdgcn_s_barrier()
#define PG8_SCHED __builtin_amdgcn_sched_barrier(0)
    Unit cur, nxt; int ui = 0;
    if (!S.next(0, cur)) return;
    f32x4 acc[2][2][4][2];
#pragma unroll
    for (int a = 0; a < 2; ++a)
#pragma unroll
        for (int b = 0; b < 2; ++b)
#pragma unroll
            for (int m = 0; m < 4; ++m)
#pragma unroll
                for (int n = 0; n < 2; ++n) acc[a][b][m][n] = (f32x4){0.f, 0.f, 0.f, 0.f};
    bf16x8 At[4][2], B0[2][2], B1[2][2];
    const char* cA = (const char*)g.A + (size_t)cur.pm * tstep; const char* cB = (const char*)g.Bt + (size_t)cur.pn * tstep;
    S.a_ready(cur);
    if constexpr (SP2) {
        PG8_STAGE(PG8_SB(0, 0), cB, voffB); PG8_STAGE(PG8_SB(0, 1), cB + hstep, voffB); PG8_STAGE(PG8_SA(0, 0), cA, voffA); PG8_STAGE(PG8_SA(0, 1), cA + hstep, voffA);
        if (wr == 1) PG8_BAR;
        PG8_WAIT_V(2); PG8_BAR;
        PG8_STAGE(PG8_SB(1, 0), cB + kstep, voffB); PG8_STAGE(PG8_SA(1, 0), cA + kstep, voffA); PG8_STAGE(PG8_SB(1, 1), cB + hstep + kstep, voffB);
        PG8_WAIT_V(6); PG8_BAR;
    } else {
        PG8_STAGE(PG8_SB(0, 0), cB, voffB); PG8_STAGE(PG8_SA(0, 0), cA, voffA); PG8_STAGE(PG8_SB(0, 1), cB + hstep, voffB); PG8_STAGE(PG8_SA(0, 1), cA + hstep, voffA);
        if (wr == 1) PG8_BAR;
        PG8_WAIT_V(4); PG8_BAR;
        PG8_STAGE(PG8_SB(1, 0), cB + kstep, voffB); PG8_STAGE(PG8_SA(1, 0), cA + kstep, voffA); PG8_STAGE(PG8_SB(1, 1), cB + hstep + kstep, voffB);
        PG8_WAIT_V(6); PG8_BAR;
    }
    for (;;) {
        const bool has_next = S.next(ui + 1, nxt);
        const char* nA = has_next ? (const char*)g.A + (size_t)nxt.pm * tstep : cA; const char* nB = has_next ? (const char*)g.Bt + (size_t)nxt.pn * tstep : cB;
        for (int t = 0; t < nt; t += 2) {
            const bool last = (t == nt - 2);
            const char* a1 = cA + (size_t)(t + 1) * kstep;
            const char* a2 = last ? nA : cA + (size_t)(t + 2) * kstep; const char* b2 = last ? nB : cB + (size_t)(t + 2) * kstep;
            const char* a3 = a2 + kstep; const char* b3 = b2 + kstep;
            if (last && has_next) S.a_ready(nxt);
            if constexpr (SP2) {
            PG8_LDB(B0, 0, 0); PG8_LDB(B1, 0, 1); PG8_SCHED; PG8_LDA(At, 0, 0); PG8_STAGE(PG8_SA(1, 1), a1 + hstep, voffA);
            PG8_WAIT_V(8); PG8_WAIT_L(0); PG8_BAR; PG8_MMA(0, 0, At, B0); PG8_MMA(0, 1, At, B1); PG8_BAR; PG8_SCHED;
            PG8_LDA(At, 0, 1); PG8_STAGE(PG8_SB(0, 0), b2, voffB); PG8_STAGE(PG8_SB(0, 1), b2 + hstep, voffB); PG8_STAGE(PG8_SA(0, 0), a2, voffA);
            PG8_WAIT_V(8); PG8_WAIT_L(0); PG8_BAR; PG8_MMA(1, 0, At, B0); PG8_MMA(1, 1, At, B1); PG8_BAR; PG8_SCHED;
            PG8_LDB(B0, 1, 0); PG8_LDB(B1, 1, 1); PG8_SCHED; PG8_LDA(At, 1, 0); PG8_STAGE(PG8_SA(0, 1), a2 + hstep, voffA);
            PG8_WAIT_V(8); PG8_WAIT_L(0); PG8_BAR; PG8_MMA(0, 0, At, B0); PG8_MMA(0, 1, At, B1); PG8_BAR; PG8_SCHED;
            PG8_LDA(At, 1, 1); PG8_STAGE(PG8_SB(1, 0), b3, voffB); PG8_STAGE(PG8_SB(1, 1), b3 + hstep, voffB); PG8_STAGE(PG8_SA(1, 0), a3, voffA);
            PG8_WAIT_V(8); PG8_WAIT_L(0); PG8_BAR; PG8_MMA(1, 0, At, B0); PG8_MMA(1, 1, At, B1); PG8_BAR; PG8_SCHED;
            } else {
            PG8_LDB(B0, 0, 0); PG8_SCHED; PG8_LDA(At, 0, 0); PG8_STAGE(PG8_SA(1, 1), a1 + hstep, voffA);
            PG8_WAIT_L(8); PG8_BAR; PG8_WAIT_L(0); PG8_MMA(0, 0, At, B0); PG8_BAR; PG8_SCHED;
            PG8_LDB(B1, 0, 1); PG8_STAGE(PG8_SB(0, 0), b2, voffB);
            PG8_BAR; PG8_WAIT_L(0); PG8_MMA(0, 1, At, B1); PG8_BAR;
            PG8_LDA(At, 0, 1); PG8_STAGE(PG8_SA(0, 0), a2, voffA);
            PG8_BAR; PG8_WAIT_L(0); PG8_MMA(1, 0, At, B0); PG8_BAR; PG8_SCHED;
            PG8_STAGE(PG8_SB(0, 1), b2 + hstep, voffB);
            PG8_WAIT_V(6); PG8_BAR; PG8_MMA(1, 1, At, B1); PG8_BAR;
            PG8_LDB(B0, 1, 0); PG8_SCHED; PG8_LDA(At, 1, 0); PG8_STAGE(PG8_SA(0, 1), a2 + hstep, voffA);
            PG8_WAIT_L(8); PG8_BAR; PG8_WAIT_L(0); PG8_MMA(0, 0, At, B0); PG8_BAR; PG8_SCHED;
            PG8_LDB(B1, 1, 1); PG8_STAGE(PG8_SB(1, 0), b3, voffB);
            PG8_BAR; PG8_WAIT_L(0); PG8_MMA(0, 1, At, B1); PG8_BAR;
            PG8_LDA(At, 1, 1); PG8_STAGE(PG8_SA(1, 0), a3, voffA);
            PG8_BAR; PG8_WAIT_L(0); PG8_MMA(1, 0, At, B0); PG8_BAR; PG8_SCHED;
            PG8_STAGE(PG8_SB(1, 1), b3 + hstep, voffB);
            PG8_WAIT_V(6); PG8_BAR; PG8_MMA(1, 1, At, B1); PG8_BAR;
            }
        }
        if constexpr (ALIGN_EPI) { if (wr == 0) PG8_BAR; }
        E(acc, cur, wr, wc, fr, fq); S.done(cur);
        if (!has_next) break;
#pragma unroll
        for (int a = 0; a < 2; ++a)
#pragma unroll
            for (int b = 0; b < 2; ++b)
#pragma unroll
                for (int m = 0; m < 4; ++m)
#pragma unroll
                    for (int n = 0; n < 2; ++n) acc[a][b][m][n] = (f32x4){0.f, 0.f, 0.f, 0.f};
        cur = nxt; cA = nA; cB = nB; ++ui;
        if constexpr (ALIGN_EPI) { if (wr == 1) PG8_BAR; }
    }
    PG8_WAIT_V(0);
    if constexpr (!ALIGN_EPI) { if (wr == 0) PG8_BAR; }
    PG8_BAR;
#undef PG8_SA
#undef PG8_SB
#undef PG8_STAGE
#undef PG8_LDA
#undef PG8_LDB
#undef PG8_MMA
#undef PG8_WAIT_V
#undef PG8_WAIT_L
#undef PG8_BAR
#undef PG8_SCHED
}
}

constexpr int BATCH = 8, SEQ = 2048, D = 1024, M = BATCH * SEQ;
constexpr int FF = 2816, DRNN = 1280, NBLK = 10, RBLK = 128, CONVW = 4;
constexpr int NHEAD = 16, HD = 64, NGRP = 3, NQKV = 9216;
constexpr float RMS_EPS = 1e-6f;
constexpr float LOG2E = 1.4426950408889634f;
constexpr int NWAVES = 8;

typedef unsigned short bf16;
typedef unsigned v4u __attribute__((ext_vector_type(4)));
typedef unsigned v2u __attribute__((ext_vector_type(2)));
typedef float f32x4 __attribute__((ext_vector_type(4)));
#define GAS __attribute__((address_space(1)))
#define LAS __attribute__((address_space(3)))
typedef GAS unsigned gu32;
#define RLX_AGENT __ATOMIC_RELAXED, __HIP_MEMORY_SCOPE_AGENT
#define LDS_WAIT() asm volatile("s_waitcnt lgkmcnt(0)" ::: "memory")

constexpr size_t MiB = 1u << 20;
constexpr size_t WS_CTL = 0, CTL_ZERO_BYTES = 1 * MiB;
constexpr size_t WS_SSQ = 1 * MiB;
constexpr size_t WS_BIAS = 2 * MiB;
constexpr size_t WS_XB = 3 * MiB;
constexpr size_t WS_WO = 35 * MiB;
constexpr size_t WS_WQKV = 37 * MiB;
constexpr size_t WS_QKV = 55 * MiB;
constexpr size_t QKV_SLAB = (size_t)M * 1024 * 2;
constexpr size_t WS_LSE = 343 * MiB;
constexpr size_t WS_END = 346 * MiB;
constexpr size_t WS_WIN0 = 55 * MiB, WS_WOUT0 = 66 * MiB, WS_WIN1 = 72 * MiB, WS_WOUT1 = 83 * MiB, WS_WIN2 = 89 * MiB, WS_WOUT2 = 100 * MiB;
constexpr size_t WS_WRIN = 106 * MiB, WS_WROUT = 111 * MiB, WS_WA = 114 * MiB, WS_WX = 114 * MiB + 512 * 1024;
constexpr size_t WS_ACT = 115 * MiB;
constexpr size_t WS_G = 203 * MiB, WS_U = 243 * MiB, WS_Y = 283 * MiB;
constexpr size_t WS_AF = 115 * MiB, WS_BF = 155 * MiB;
constexpr size_t WS_ATT = WS_QKV + 3 * QKV_SLAB;
constexpr size_t WS_WIN3 = WS_QKV + 6 * QKV_SLAB, WS_WOUT3 = WS_WIN3 + 11 * MiB;
constexpr size_t WS_ACT3 = WS_QKV;
static_assert(WS_Y + (size_t)M * DRNN * 2 <= WS_LSE && WS_ACT + (size_t)M * FF * 2 <= WS_G && WS_WX + 327680 <= WS_ACT, "ws map");
static_assert(WS_QKV + 9 * QKV_SLAB == WS_LSE && WS_LSE + (size_t)3 * M * 16 * 4 <= WS_END, "ws map");
constexpr int CW_BAR = 4096;

constexpr int RING_BYTES = 131072, LDSCTL_OFF = RING_BYTES, MISC_OFF = LDSCTL_OFF + 320;
constexpr int LDS_BYTES = 147456;

#define XB_TMO      128
#define XB_XCNT(j)  (256  + 64 * (j))
#define XB_XSUB(j)  (1280 + 64 * (j))
#define XB_XGEN(j)  (2304 + 64 * (j))
#define XB_TOP      3328
#define XB_TOPGEN   3392
#define XCD_BAR_WORDS 3456
#define XB_SPIN_CAP (1u << 18)
__device__ __forceinline__ unsigned xb_ld(unsigned* p)              { return __hip_atomic_load(p, __ATOMIC_RELAXED, __HIP_MEMORY_SCOPE_AGENT); }
__device__ __forceinline__ unsigned xb_add(unsigned* p, unsigned v) { return __hip_atomic_fetch_add(p, v, __ATOMIC_RELAXED, __HIP_MEMORY_SCOPE_AGENT); }
__device__ __forceinline__ unsigned xb_xcc_id() { return (unsigned)__builtin_amdgcn_s_getreg((3 << 11) | 20) & 0xFu; }
#define XB_SPIN(cond, bar) do { unsigned _sp = 0; while (cond) { __builtin_amdgcn_s_sleep(1); \
    if ((++_sp & 255u) == 0u) { if (xb_ld(&(bar)[XB_TMO])) break; if (_sp > XB_SPIN_CAP) { atomicAdd(&(bar)[XB_TMO], 1u); break; } } } } while (0)
struct XcdBarrier { unsigned* bar; unsigned x; volatile LAS unsigned* st; };
__device__ __forceinline__ XcdBarrier xcd_barrier_post(unsigned* bar, volatile LAS unsigned* st) {
    XcdBarrier b; b.bar = bar; b.x = xb_xcc_id(); b.st = st;
    if (threadIdx.x == 0) (void)xb_add(&bar[XB_XCNT(b.x)], 1u);
    return b;
}
__device__ __forceinline__ void xcd_barrier_complete(unsigned* bar, unsigned x, unsigned& nloc, unsigned& nx) {
    const unsigned G = gridDim.x * gridDim.y * gridDim.z;
    unsigned sum, cnt, mine, sp = 0u;
    for (;;) {
        sum = 0u; cnt = 0u; mine = 0u;
#pragma unroll
        for (unsigned j = 0; j < 16; ++j) { const unsigned c = xb_ld(&bar[XB_XCNT(j)]); sum += c; cnt += (c > 0u) ? 1u : 0u; mine = (j == x) ? c : mine; }
        if (sum == G) break;
        __builtin_amdgcn_s_sleep(1);
        if ((++sp & 255u) == 0u) { if (xb_ld(&bar[XB_TMO])) break; if (sp > XB_SPIN_CAP) { atomicAdd(&bar[XB_TMO], 1u); break; } }
    }
    nloc = mine > 0u ? mine : 1u; nx = cnt > 0u ? cnt : 1u;
}
__device__ __forceinline__ void xcd_barrier(const XcdBarrier& b) {
    asm volatile("s_waitcnt vmcnt(0)" ::: "memory");
    __syncthreads();
    if (threadIdx.x == 0) {
        unsigned* bar = b.bar;
        __builtin_amdgcn_s_waitcnt(0);
        unsigned nloc = b.st[0], nx = b.st[1];
        if (nloc == 0u) { xcd_barrier_complete(bar, b.x, nloc, nx); b.st[0] = nloc; b.st[1] = nx; }
        const unsigned old = xb_add(&bar[XB_XSUB(b.x)], 1u);
        const unsigned gen = old / nloc;
        if (old + 1u == (gen + 1u) * nloc) {
            __builtin_amdgcn_fence(__ATOMIC_RELEASE, "agent");
            asm volatile("s_waitcnt vmcnt(0)" ::: "memory");
            const unsigned og = xb_add(&bar[XB_TOP], 1u);
            const unsigned tg = og / nx;
            if (og + 1u == (tg + 1u) * nx) xb_add(&bar[XB_TOPGEN], 1u);
            else XB_SPIN(xb_ld(&bar[XB_TOPGEN]) == tg, bar);
            __builtin_amdgcn_fence(__ATOMIC_ACQUIRE, "agent");
            xb_add(&bar[XB_XGEN(b.x)], 1u);
            asm volatile("s_waitcnt vmcnt(0)" ::: "memory");
        } else {
            XB_SPIN(xb_ld(&bar[XB_XGEN(b.x)]) == gen, bar);
            __builtin_amdgcn_fence(__ATOMIC_ACQUIRE, "agent");
            asm volatile("s_waitcnt vmcnt(0)" ::: "memory");
        }
    }
    __syncthreads();
}

__device__ __forceinline__ unsigned f2bf(float f) { unsigned u = __builtin_bit_cast(unsigned, f); return (u + 0x7fffu + ((u >> 16) & 1u)) >> 16; }
__device__ __forceinline__ unsigned pk2(float lo, float hi) { return f2bf(lo) | (f2bf(hi) << 16); }
__device__ __forceinline__ float bf_lo(unsigned w) { return __builtin_bit_cast(float, w << 16); }
__device__ __forceinline__ float bf_hi(unsigned w) { return __builtin_bit_cast(float, w & 0xffff0000u); }
__device__ __forceinline__ float bf2f(bf16 v) { return __builtin_bit_cast(float, (unsigned)v << 16); }
__device__ __forceinline__ float wave_sum(float v) {
#pragma unroll
    for (int o = 1; o < 64; o <<= 1) v += __shfl_xor(v, o);
    return v;
}
__device__ __forceinline__ float fast_sigmoid(float x) { return __builtin_amdgcn_rcpf(1.f + __builtin_amdgcn_exp2f(-LOG2E * x)); }
__device__ __forceinline__ float row_rstd(const float* ssq, int row) {
    const f32x4* p = (const f32x4*)(ssq + (size_t)row * 16); const f32x4 a = p[0], b = p[1], c = p[2], d = p[3];
    const float s = ((a.x + a.y) + (a.z + a.w)) + ((b.x + b.y) + (b.z + b.w)) + ((c.x + c.y) + (c.z + c.w)) + ((d.x + d.y) + (d.z + d.w));
    return rsqrtf(s * (1.0f / D) + RMS_EPS);
}

using pg8::Unit;
struct EpiSwiGLU {
    static constexpr bool PERM = true;
    const float* ssq; bf16* act;
    __device__ __forceinline__ void operator()(const f32x4 (&acc)[2][2][4][2], const Unit& u, int wr, int wc, int fr, int fq) const {
#pragma unroll
        for (int ai = 0; ai < 2; ++ai)
#pragma unroll
            for (int m = 0; m < 4; ++m) {
                const int row = u.pm * 256 + ai * 128 + wr * 64 + m * 16 + fr;
                const float rs = row_rstd(ssq, row);
                float v[8];
#pragma unroll
                for (int n = 0; n < 2; ++n)
#pragma unroll
                    for (int e = 0; e < 4; ++e) { const float g = acc[ai][0][m][n][e] * rs, up = acc[ai][1][m][n][e] * rs; v[n * 4 + e] = g * fast_sigmoid(g) * up; }
                v4u w; w.x = pg8::cvt_pk_bf16(v[0], v[1]); w.y = pg8::cvt_pk_bf16(v[2], v[3]); w.z = pg8::cvt_pk_bf16(v[4], v[5]); w.w = pg8::cvt_pk_bf16(v[6], v[7]);
                *(v4u*)(act + (size_t)row * FF + u.pn * 128 + wc * 32 + 8 * fq) = w;
                asm volatile("" ::: "memory");
            }
    }
};
struct EpiRes {
    static constexpr bool PERM = true;
    const float* xin; float* xout; bf16* xb; float* ssq; float scale;
    __device__ __forceinline__ void operator()(const f32x4 (&acc)[2][2][4][2], const Unit& u, int wr, int wc, int fr, int fq) const {
#pragma unroll
        for (int ai = 0; ai < 2; ++ai)
#pragma unroll
            for (int m = 0; m < 4; ++m) {
                const int row = u.pm * 256 + ai * 128 + wr * 64 + m * 16 + fr;
                float ss = 0.f;
#pragma unroll
                for (int bj = 0; bj < 2; ++bj) {
                    const size_t off = (size_t)row * D + u.pn * 256 + bj * 128 + wc * 32 + 8 * fq;
                    const f32x4 x0 = *(const f32x4*)(xin + off), x1 = *(const f32x4*)(xin + off + 4);
                    const f32x4 y0 = x0 + acc[ai][bj][m][0] * scale, y1 = x1 + acc[ai][bj][m][1] * scale;
                    *(f32x4*)(xout + off) = y0; *(f32x4*)(xout + off + 4) = y1;
                    v4u w; w.x = pg8::cvt_pk_bf16(y0[0], y0[1]); w.y = pg8::cvt_pk_bf16(y0[2], y0[3]); w.z = pg8::cvt_pk_bf16(y1[0], y1[1]); w.w = pg8::cvt_pk_bf16(y1[2], y1[3]);
                    *(v4u*)(xb + off) = w;
                    ss += (y0[0] * y0[0] + y0[1] * y0[1]) + (y0[2] * y0[2] + y0[3] * y0[3]) + (y1[0] * y1[0] + y1[1] * y1[1]) + (y1[2] * y1[2] + y1[3] * y1[3]);
                }
                ss += __shfl_xor(ss, 16); ss += __shfl_xor(ss, 32);
                if (fq == 0) ssq[(size_t)row * 16 + u.pn * 4 + wc] = ss;
                asm volatile("" ::: "memory");
            }
    }
};
struct EpiRnnIn {
    static constexpr bool PERM = true;
    const float* ssq; bf16* Gb; bf16* Ub;
    __device__ __forceinline__ void operator()(const f32x4 (&acc)[2][2][4][2], const Unit& u, int wr, int wc, int fr, int fq) const {
        const bool is_gate = u.pn < 5; bf16* dstb = is_gate ? Gb : Ub; const int pc = is_gate ? u.pn : u.pn - 5;
#pragma unroll
        for (int ai = 0; ai < 2; ++ai)
#pragma unroll
            for (int m = 0; m < 4; ++m) {
                const int row = u.pm * 256 + ai * 128 + wr * 64 + m * 16 + fr;
                const float rs = row_rstd(ssq, row);
#pragma unroll
                for (int bj = 0; bj < 2; ++bj) {
                    float v[8];
#pragma unroll
                    for (int n = 0; n < 2; ++n)
#pragma unroll
                        for (int e = 0; e < 4; ++e) { float x = acc[ai][bj][m][n][e] * rs;
                            if (is_gate) { const float z = 1.5957691216057308f * (x + 0.044715f * x * x * x); x = x * fast_sigmoid(z); }
                            v[n * 4 + e] = x; }
                    v4u w; w.x = pg8::cvt_pk_bf16(v[0], v[1]); w.y = pg8::cvt_pk_bf16(v[2], v[3]); w.z = pg8::cvt_pk_bf16(v[4], v[5]); w.w = pg8::cvt_pk_bf16(v[6], v[7]);
                    *(v4u*)(dstb + (size_t)row * DRNN + pc * 256 + bj * 128 + wc * 32 + 8 * fq) = w;
                }
                asm volatile("" ::: "memory");
            }
    }
};
struct EpiQKV {
    static constexpr bool PERM = true;
    const float* ssq; const float* qgain; const float* kgain; bf16* qkv;
    __device__ __forceinline__ void operator()(const f32x4 (&acc)[2][2][4][2], const Unit& u, int wr, int wc, int fr, int fq) const {
        const int hs = u.pn * 4 + wc, kind = hs / 48, gh = hs - kind * 48, g = gh >> 4, h = gh & 15, l2d = 2 * g;
        const float* gain = (kind == 0) ? qgain : kgain; const float gsc = (kind == 0) ? 0.125f * LOG2E : 1.f;
        bf16* slab = qkv + (size_t)(kind * 3 + g) * ((size_t)M * 1024);
#pragma unroll
        for (int ai = 0; ai < 2; ++ai)
#pragma unroll
            for (int m = 0; m < 4; ++m) {
                const int row = u.pm * 256 + ai * 128 + wr * 64 + m * 16 + fr;
                const float rs = row_rstd(ssq, row);
                f32x4 v[2][2]; float ss = 0.f;
#pragma unroll
                for (int bj = 0; bj < 2; ++bj)
#pragma unroll
                    for (int n = 0; n < 2; ++n) { v[bj][n] = acc[ai][bj][m][n] * rs; const f32x4 t = v[bj][n]; ss += (t[0] * t[0] + t[1] * t[1]) + (t[2] * t[2] + t[3] * t[3]); }
                ss += __shfl_xor(ss, 16); ss += __shfl_xor(ss, 32);
                const float rn = (kind < 2) ? rsqrtf(ss * (1.0f / HD) + RMS_EPS) : 1.f;
                const int b = row >> 11, t = row & 2047, rres = t & ((1 << l2d) - 1), l = t >> l2d, L = 2048 >> l2d;
                bf16* dst = slab + ((size_t)(b * 16 + h) * 2048 + rres * L + l) * 64 + 8 * fq;
#pragma unroll
                for (int bj = 0; bj < 2; ++bj) {
                    f32x4 g0 = (f32x4){1.f, 1.f, 1.f, 1.f}, g1 = g0;
                    if (kind < 2) { g0 = *(const f32x4*)(gain + 32 * bj + 8 * fq) * gsc; g1 = *(const f32x4*)(gain + 32 * bj + 8 * fq + 4) * gsc; }
                    const f32x4 a0 = v[bj][0] * g0 * rn, a1 = v[bj][1] * g1 * rn;
                    v4u w; w.x = pg8::cvt_pk_bf16(a0[0], a0[1]); w.y = pg8::cvt_pk_bf16(a0[2], a0[3]); w.z = pg8::cvt_pk_bf16(a1[0], a1[1]); w.w = pg8::cvt_pk_bf16(a1[2], a1[3]);
                    *(v4u*)(dst + 32 * bj) = w;
                }
                asm volatile("" ::: "memory");
            }
    }
};

struct Args { const float* in[18]; float* out; unsigned char* ws; int ph_lo, ph_hi; };
enum { I_X = 0, I_NORMG, I_FFN_WIN, I_FFN_WOUT, I_RNN_WIN, I_CONV_W, I_CONV_B, I_WA, I_BA, I_WX, I_BX, I_LAM, I_RNN_WOUT, I_WQKV, I_QGAIN, I_KGAIN, I_WO, I_RELB };

struct Ctx { LAS unsigned char* lds; int tid, lane, wave, G, vcu; unsigned char* ws; };

enum { CM_NONE = 0, CM_FFN = 1, CM_QKV = 2 };
__device__ __forceinline__ int colmap(int mode, int vr) {
    if (mode == CM_FFN) { const int pn = vr >> 8, w = vr & 255; return (w >> 7) * FF + 128 * pn + (w & 127); }
    if (mode == CM_QKV) { const int pn = vr >> 8, w = vr & 255, bj = w >> 7, wc = (w >> 5) & 3, j = w & 31; return 256 * pn + 64 * wc + 32 * bj + j; }
    return vr;
}
__device__ __forceinline__ void transpose_item(const float* W, int K, int N, const float* gvec, bf16* WT, int mode, LAS float* scr, int item, int lane) {
    const int nblk = N / 32, kb = item / nblk, nb = item - kb * nblk, k0 = 64 * kb, vr0 = 32 * nb, n0 = colmap(mode, vr0);
#pragma unroll 8
    for (int i = 0; i < 32; ++i) { const int kk = 2 * i + (lane >> 5); float w = W[(size_t)(k0 + kk) * N + n0 + (lane & 31)]; if (gvec) w *= gvec[k0 + kk]; scr[kk * 33 + (lane & 31)] = w; }
    LDS_WAIT(); asm volatile("" ::: "memory");
    const int c = lane & 7;
#pragma unroll
    for (int j = 0; j < 4; ++j) { const int n = (lane >> 3) + 8 * j; const LAS float* s = scr + (8 * c) * 33 + n;
        v4u o; o.x = pk2(s[0 * 33], s[1 * 33]); o.y = pk2(s[2 * 33], s[3 * 33]); o.z = pk2(s[4 * 33], s[5 * 33]); o.w = pk2(s[6 * 33], s[7 * 33]);
        *(GAS v4u*)(WT + (size_t)(vr0 + n) * K + k0 + 8 * c) = o; }
    LDS_WAIT(); asm volatile("" ::: "memory");
}
struct MatJob { const float* W; int K, N; const float* g; bf16* WT; int mode; };
__device__ __forceinline__ MatJob mat_job(const Ctx& C, const Args& a, int idx) {
    unsigned char* ws = C.ws; const float* ng = a.in[I_NORMG]; MatJob j;
    switch (idx) {
    case 0: j = MatJob{a.in[I_FFN_WIN] + (size_t)0 * D * 2 * FF, D, 2 * FF, ng + 0 * D, (bf16*)(ws + WS_WIN0), CM_FFN}; break;
    case 1: j = MatJob{a.in[I_FFN_WOUT] + (size_t)0 * FF * D, FF, D, nullptr, (bf16*)(ws + WS_WOUT0), CM_NONE}; break;
    case 2: j = MatJob{a.in[I_RNN_WIN], D, 2 * DRNN, ng + 1 * D, (bf16*)(ws + WS_WRIN), CM_NONE}; break;
    case 3: j = MatJob{a.in[I_RNN_WOUT], DRNN, D, nullptr, (bf16*)(ws + WS_WROUT), CM_NONE}; break;
    case 4: j = MatJob{a.in[I_FFN_WIN] + (size_t)1 * D * 2 * FF, D, 2 * FF, ng + 2 * D, (bf16*)(ws + WS_WIN1), CM_FFN}; break;
    case 5: j = MatJob{a.in[I_FFN_WOUT] + (size_t)1 * FF * D, FF, D, nullptr, (bf16*)(ws + WS_WOUT1), CM_NONE}; break;
    case 6: j = MatJob{a.in[I_FFN_WIN] + (size_t)2 * D * 2 * FF, D, 2 * FF, ng + 3 * D, (bf16*)(ws + WS_WIN2), CM_FFN}; break;
    case 7: j = MatJob{a.in[I_FFN_WOUT] + (size_t)2 * FF * D, FF, D, nullptr, (bf16*)(ws + WS_WOUT2), CM_NONE}; break;
    case 8: j = MatJob{a.in[I_WQKV], D, NQKV, ng + 4 * D, (bf16*)(ws + WS_WQKV), CM_QKV}; break;
    case 9: j = MatJob{a.in[I_WO], D, D, nullptr, (bf16*)(ws + WS_WO), CM_NONE}; break;
    case 10: j = MatJob{a.in[I_FFN_WIN] + (size_t)3 * D * 2 * FF, D, 2 * FF, ng + 5 * D, (bf16*)(ws + WS_WIN3), CM_FFN}; break;
    default: j = MatJob{a.in[I_FFN_WOUT] + (size_t)3 * FF * D, FF, D, nullptr, (bf16*)(ws + WS_WOUT3), CM_NONE}; break;
    }
    return j;
}
__device__ __forceinline__ void convert_mats(const Ctx& C, const Args& a, int first, int last) {
    LAS float* scr = (LAS float*)(C.lds + C.wave * 16384);
    const int gw = C.vcu * NWAVES + C.wave, NGW = C.G * NWAVES;
    int base = 0;
    for (int mi = first; mi < last; ++mi) {
        const MatJob j = mat_job(C, a, mi); const int cnt = (j.K / 64) * (j.N / 32);
        int it = (gw - base) % NGW; if (it < 0) it += NGW;
        for (; it < cnt; it += NGW) transpose_item(j.W, j.K, j.N, j.g, j.WT, j.mode, scr, it, C.lane);
        base += cnt;
    }
}
__device__ __forceinline__ int t5_bucket(int n) {
    if (n < 16) return n;
    int b = 16;
    b += (n >= 22) + (n >= 30) + (n >= 40) + (n >= 54) + (n >= 73) + (n >= 99) + (n >= 134) + (n >= 182) + (n >= 246) + (n >= 332) + (n >= 450) + (n >= 609) + (n >= 825) + (n >= 1117) + (n >= 1513);
    return b;
}
__device__ __forceinline__ void p_prologue(const Ctx& C, const Args& a) {
    convert_mats(C, a, 0, 10);
    const int gw = C.vcu * NWAVES + C.wave, NGW = C.G * NWAVES;
    {   LAS float* scr = (LAS float*)(C.lds + C.wave * 16384);
        for (int it = gw; it < 2 * NBLK * 8; it += NGW) { const int which = it / (NBLK * 8), r = it % (NBLK * 8), blk = r >> 3, sub = r & 7;
            const float* W = (which ? a.in[I_WX] : a.in[I_WA]) + (size_t)blk * RBLK * RBLK; bf16* WT = (bf16*)(C.ws + (which ? WS_WX : WS_WA)) + (size_t)blk * RBLK * RBLK;
            transpose_item(W, RBLK, RBLK, nullptr, WT, CM_NONE, scr, sub, C.lane); } }
    const float* x = a.in[I_X]; bf16* xb = (bf16*)(C.ws + WS_XB); float* ssq = (float*)(C.ws + WS_SSQ);
    for (int m = gw; m < M; m += NGW) {
        const GAS f32x4* xr = (const GAS f32x4*)(x + (size_t)m * D) + C.lane; f32x4 v[4]; float s = 0.f;
#pragma unroll
        for (int j = 0; j < 4; ++j) { v[j] = xr[64 * j]; s += (v[j].x * v[j].x + v[j].y * v[j].y) + (v[j].z * v[j].z + v[j].w * v[j].w); }
        s = wave_sum(s);
        GAS v2u* o8 = (GAS v2u*)(xb + (size_t)m * D) + C.lane;
#pragma unroll
        for (int j = 0; j < 4; ++j) { v2u w; w.x = pk2(v[j].x, v[j].y); w.y = pk2(v[j].z, v[j].w); o8[64 * j] = w; }
        if (C.lane < 16) ssq[(size_t)m * 16 + C.lane] = (C.lane == 0) ? s : 0.f;
    }
    float* bt = (float*)(C.ws + WS_BIAS); const float* rb = a.in[I_RELB];
    for (int i = blockIdx.x * 512 + C.tid; i < 48 * 129; i += C.G * 512) { const int gh = i / 129, dist = i - gh * 129, g = gh >> 4;
        bt[gh * 132 + dist] = rb[t5_bucket(dist << (2 * g)) * 48 + gh] * LOG2E; }
}

__device__ __forceinline__ void p_rnn_ab(const Ctx& C, const Args& a, int half) {
    const bf16* U = (const bf16*)(C.ws + WS_U); float* AF = (float*)(C.ws + WS_AF); float* BF = (float*)(C.ws + WS_BF);
    LAS float* ufs = (LAS float*)C.lds;
    const float* cw = a.in[I_CONV_W]; const float* cb = a.in[I_CONV_B];
    const int d = C.tid & 127, tq = __builtin_amdgcn_readfirstlane(C.tid >> 7);
    for (int item = blockIdx.x; item < 256 * NBLK; item += C.G) {
        const int tt = item / NBLK, n = item - tt * NBLK, tok0 = half * (M / 2) + tt * 32;
        for (int e = C.tid; e < 32 * 128; e += 512) { const int t = e >> 7, c = e & 127, tok = tok0 + t, tpos = tok & (SEQ - 1), ch = n * 128 + c;
            float acc = cb[ch];
#pragma unroll
            for (int k = 0; k < CONVW; ++k) { const int tp = tpos - (CONVW - 1) + k; if (tp >= 0) acc += bf2f(U[(size_t)(tok - (CONVW - 1) + k) * DRNN + ch]) * cw[k * DRNN + ch]; }
            ufs[e] = acc; }
        __syncthreads();
        float accA[8], accX[8];
#pragma unroll
        for (int j = 0; j < 8; ++j) { accA[j] = 0.f; accX[j] = 0.f; }
        const float* wa = a.in[I_WA] + (size_t)n * RBLK * RBLK + d; const float* wx = a.in[I_WX] + (size_t)n * RBLK * RBLK + d;
        for (int c = 0; c < 128; ++c) { const float va = wa[c * 128], vx = wx[c * 128];
#pragma unroll
            for (int j = 0; j < 8; ++j) { const float uu = ufs[(tq * 8 + j) * 128 + c]; accA[j] += uu * va; accX[j] += uu * vx; } }
        const int ch = n * 128 + d; const float ba = a.in[I_BA][ch], bx = a.in[I_BX][ch], lam = a.in[I_LAM][ch];
        const float sp = log1pf(expf(-lam));
#pragma unroll
        for (int j = 0; j < 8; ++j) { const int t = tq * 8 + j; const float r = 1.f / (1.f + expf(-(accA[j] + ba))), ii = 1.f / (1.f + expf(-(accX[j] + bx)));
            const float la = -8.0f * r * sp, av = expf(la), bv = sqrtf(-expm1f(2.f * la)) * (ii * ufs[t * 128 + d]);
            const size_t o = (size_t)(tt * 32 + t) * DRNN + ch; AF[o] = av; BF[o] = bv; }
        __syncthreads();
    }
}
__device__ __forceinline__ void p_rnn_scan(const Ctx& C, int half) {
    const float* AF = (const float*)(C.ws + WS_AF); const float* BF = (const float*)(C.ws + WS_BF);
    const bf16* Gb = (const bf16*)(C.ws + WS_G); bf16* Y = (bf16*)(C.ws + WS_Y);
    for (int gid = blockIdx.x * 512 + C.tid; gid < 4 * DRNN; gid += C.G * 512) {
        const int bl = gid / DRNN, ch = gid - bl * DRNN; float h = 0.f;
        const size_t lo = (size_t)bl * SEQ * DRNN + ch, go = ((size_t)(half * 4 + bl) * SEQ) * DRNN + ch;
#pragma unroll 8
        for (int t = 0; t < SEQ; ++t) { const size_t i = lo + (size_t)t * DRNN, o = go + (size_t)t * DRNN; h = AF[i] * h + BF[i]; Y[o] = (bf16)f2bf(h * bf2f(Gb[o])); }
    }
}
__device__ __forceinline__ void p_attn(const Ctx& C) {
    bf16* QKV = (bf16*)(C.ws + WS_QKV); float* LSE = (float*)(C.ws + WS_LSE); const float* bt = (const float*)(C.ws + WS_BIAS);
    for (int qid = blockIdx.x * 512 + C.tid; qid < NGRP * BATCH * NHEAD * SEQ; qid += C.G * 512) {
        const int llin = qid & (SEQ - 1), bh = (qid >> 11) & 127, g = qid >> 18, l2d = 2 * g, L = SEQ >> l2d, l = llin & (L - 1);
        bf16* qrow = QKV + (size_t)g * ((size_t)M * 1024) + ((size_t)bh * SEQ + llin) * HD;
        const bf16* krow = qrow + 3 * (size_t)M * 1024; const bf16* vrow = qrow + 6 * (size_t)M * 1024;
        const float* btab = bt + (g * 16 + (bh & 15)) * 132;
        float q[64], o[64];
#pragma unroll
        for (int c = 0; c < 8; ++c) { const v4u w = *(const v4u*)(qrow + 8 * c);
            q[8 * c + 0] = bf_lo(w.x); q[8 * c + 1] = bf_hi(w.x); q[8 * c + 2] = bf_lo(w.y); q[8 * c + 3] = bf_hi(w.y); q[8 * c + 4] = bf_lo(w.z); q[8 * c + 5] = bf_hi(w.z); q[8 * c + 6] = bf_lo(w.w); q[8 * c + 7] = bf_hi(w.w); }
#pragma unroll
        for (int c = 0; c < 64; ++c) o[c] = 0.f;
        float mx = -INFINITY, lsum = 0.f;
        const int nk = l < 128 ? l : 128;
        for (int dist = 0; dist <= nk; ++dist) {
            const bf16* kr = krow - (size_t)dist * HD; const bf16* vr = vrow - (size_t)dist * HD;
            float s0 = 0.f, s1 = 0.f;
#pragma unroll
            for (int c = 0; c < 8; ++c) { const v4u w = *(const v4u*)(kr + 8 * c);
                s0 += q[8 * c + 0] * bf_lo(w.x) + q[8 * c + 2] * bf_lo(w.y) + q[8 * c + 4] * bf_lo(w.z) + q[8 * c + 6] * bf_lo(w.w);
                s1 += q[8 * c + 1] * bf_hi(w.x) + q[8 * c + 3] * bf_hi(w.y) + q[8 * c + 5] * bf_hi(w.z) + q[8 * c + 7] * bf_hi(w.w); }
            const float s = s0 + s1 + btab[dist];
            const float mn = fmaxf(mx, s), f = exp2f(mx - mn), p = exp2f(s - mn);
            lsum = lsum * f + p; mx = mn;
#pragma unroll
            for (int c = 0; c < 8; ++c) { const v4u w = *(const v4u*)(vr + 8 * c);
                o[8 * c + 0] = o[8 * c + 0] * f + p * bf_lo(w.x); o[8 * c + 1] = o[8 * c + 1] * f + p * bf_hi(w.x); o[8 * c + 2] = o[8 * c + 2] * f + p * bf_lo(w.y); o[8 * c + 3] = o[8 * c + 3] * f + p * bf_hi(w.y);
                o[8 * c + 4] = o[8 * c + 4] * f + p * bf_lo(w.z); o[8 * c + 5] = o[8 * c + 5] * f + p * bf_hi(w.z); o[8 * c + 6] = o[8 * c + 6] * f + p * bf_lo(w.w); o[8 * c + 7] = o[8 * c + 7] * f + p * bf_hi(w.w); }
        }
        const float inv = 1.f / lsum;
#pragma unroll
        for (int c = 0; c < 8; ++c) { v4u w; w.x = pk2(o[8 * c] * inv, o[8 * c + 1] * inv); w.y = pk2(o[8 * c + 2] * inv, o[8 * c + 3] * inv); w.z = pk2(o[8 * c + 4] * inv, o[8 * c + 5] * inv); w.w = pk2(o[8 * c + 6] * inv, o[8 * c + 7] * inv);
            *(v4u*)(qrow + 8 * c) = w; }
        const int rres = llin >> (11 - l2d), t = (l << l2d) + rres, row = (bh >> 4) * SEQ + t;
        LSE[((size_t)g * M + row) * 16 + (bh & 15)] = mx + log2f(lsum);
    }
}
__device__ __forceinline__ void p_merge(const Ctx& C, const Args& a) {
    const bf16* QKV = (const bf16*)(C.ws + WS_QKV); const float* LSE = (const float*)(C.ws + WS_LSE); bf16* ATT = (bf16*)(C.ws + WS_ATT);
    for (int idx = blockIdx.x * 512 + C.tid; idx < M * 16 * 8; idx += C.G * 512) {
        const int ch = idx & 7, h = (idx >> 3) & 15, row = idx >> 7, b = row >> 11, t = row & 2047;
        float ls[3], mxl = -INFINITY;
#pragma unroll
        for (int g = 0; g < 3; ++g) { ls[g] = LSE[((size_t)g * M + row) * 16 + h]; mxl = fmaxf(mxl, ls[g]); }
        float acc[8], wsum = 0.f;
#pragma unroll
        for (int e = 0; e < 8; ++e) acc[e] = 0.f;
#pragma unroll
        for (int g = 0; g < 3; ++g) { const float w = exp2f(ls[g] - mxl); wsum += w; const int l2d = 2 * g, rres = t & ((1 << l2d) - 1), l = t >> l2d, L = SEQ >> l2d;
            const v4u v = *(const v4u*)(QKV + (size_t)g * ((size_t)M * 1024) + ((size_t)(b * 16 + h) * SEQ + rres * L + l) * HD + 8 * ch);
            acc[0] += w * bf_lo(v.x); acc[1] += w * bf_hi(v.x); acc[2] += w * bf_lo(v.y); acc[3] += w * bf_hi(v.y); acc[4] += w * bf_lo(v.z); acc[5] += w * bf_hi(v.z); acc[6] += w * bf_lo(v.w); acc[7] += w * bf_hi(v.w); }
        const float inv = 1.f / wsum; v4u o; o.x = pk2(acc[0] * inv, acc[1] * inv); o.y = pk2(acc[2] * inv, acc[3] * inv); o.z = pk2(acc[4] * inv, acc[5] * inv); o.w = pk2(acc[6] * inv, acc[7] * inv);
        *(v4u*)(ATT + (size_t)row * 1024 + h * 64 + 8 * ch) = o;
    }
    convert_mats(C, a, 10, 12);
}

enum { PH_PROLOGUE = 0, PH_FFN_IN_0, PH_FFN_OUT_0, PH_RNN_IN, PH_RNN_AB0, PH_RNN_SCAN0, PH_RNN_AB1, PH_RNN_SCAN1, PH_RNN_OUT, PH_FFN_IN_1, PH_FFN_OUT_1,
       PH_FFN_IN_2, PH_FFN_OUT_2, PH_QKV, PH_ATTN, PH_MERGE, PH_WO, PH_FFN_IN_3, PH_FFN_OUT_3, NPHASE };

__global__ void __launch_bounds__(NWAVES * 64, 2) fwd_kernel(Args args) {
    extern __shared__ __attribute__((aligned(16))) unsigned char lds_raw[];
    Ctx C; C.lds = (LAS unsigned char*)lds_raw; C.tid = threadIdx.x; C.lane = C.tid & 63; C.wave = __builtin_amdgcn_readfirstlane(C.tid >> 6);
    C.G = gridDim.x; { const int bx = blockIdx.x; C.vcu = (C.G % 8 == 0) ? (bx % 8) * (C.G / 8) + bx / 8 : bx; }
    C.ws = args.ws;
    volatile LAS unsigned* MISC = (volatile LAS unsigned*)(C.lds + MISC_OFF);
    for (int u = C.tid; u < (LDS_BYTES - LDSCTL_OFF) / 4; u += NWAVES * 64) ((LAS unsigned*)(C.lds + LDSCTL_OFF))[u] = 0u;
    __syncthreads();
    unsigned* ctl = (unsigned*)args.ws;
    XcdBarrier bar; bar.bar = ctl + CW_BAR; bar.x = 0; bar.st = nullptr;
    const bool multi = (args.ph_hi - args.ph_lo) > 1;
    if (multi) bar = xcd_barrier_post(ctl + CW_BAR, MISC + 8);
    unsigned char* ws = args.ws;
    float* ssq = (float*)(ws + WS_SSQ); bf16* xb = (bf16*)(ws + WS_XB);
    for (int ph = args.ph_lo; ph < args.ph_hi; ++ph) {
        { int t_ = threadIdx.x; asm volatile("" : "+v"(t_)); C.tid = t_; C.lane = t_ & 63; }
        switch (ph) {
        case PH_PROLOGUE: p_prologue(C, args); break;
        case PH_FFN_IN_0: case PH_FFN_IN_1: case PH_FFN_IN_2: case PH_FFN_IN_3: {
            const bf16* Bt = (const bf16*)(ws + (ph == PH_FFN_IN_0 ? WS_WIN0 : ph == PH_FFN_IN_1 ? WS_WIN1 : ph == PH_FFN_IN_2 ? WS_WIN2 : WS_WIN3));
            bf16* act = (bf16*)(ws + (ph == PH_FFN_IN_3 ? WS_ACT3 : WS_ACT));
            pg8::Gemm g{xb, Bt, M, 2 * FF, D}; pg8::StaticOrder S; S.init(M, 2 * FF, C.G, (int)blockIdx.x);
            EpiSwiGLU E{ssq, act};
            pg8::gemm_phase<EpiSwiGLU, pg8::StaticOrder, true, true>(C.lds, g, S, E);
        } break;
        case PH_FFN_OUT_0: case PH_FFN_OUT_1: case PH_FFN_OUT_2: case PH_FFN_OUT_3: case PH_RNN_OUT: case PH_WO: {
            const bf16* A; const bf16* Bt; int K; float scale = 0.5f; const float* xin = args.out;
            if (ph == PH_FFN_OUT_0) { A = (const bf16*)(ws + WS_ACT); Bt = (const bf16*)(ws + WS_WOUT0); K = FF; xin = args.in[I_X]; }
            else if (ph == PH_FFN_OUT_1) { A = (const bf16*)(ws + WS_ACT); Bt = (const bf16*)(ws + WS_WOUT1); K = FF; }
            else if (ph == PH_FFN_OUT_2) { A = (const bf16*)(ws + WS_ACT); Bt = (const bf16*)(ws + WS_WOUT2); K = FF; }
            else if (ph == PH_FFN_OUT_3) { A = (const bf16*)(ws + WS_ACT3); Bt = (const bf16*)(ws + WS_WOUT3); K = FF; }
            else if (ph == PH_RNN_OUT) { A = (const bf16*)(ws + WS_Y); Bt = (const bf16*)(ws + WS_WROUT); K = DRNN; scale = 1.f; }
            else { A = (const bf16*)(ws + WS_ATT); Bt = (const bf16*)(ws + WS_WO); K = D; scale = 1.f; }
            pg8::Gemm g{A, Bt, M, D, K}; pg8::StaticOrder S; S.init(M, D, C.G, (int)blockIdx.x);
            EpiRes E{xin, args.out, xb, ssq, scale};
            pg8::gemm_phase<EpiRes, pg8::StaticOrder, false, true>(C.lds, g, S, E);
        } break;
        case PH_RNN_IN: {
            pg8::Gemm g{xb, (const bf16*)(ws + WS_WRIN), M, 2 * DRNN, D}; pg8::StaticOrder S; S.init(M, 2 * DRNN, C.G, (int)blockIdx.x);
            EpiRnnIn E{ssq, (bf16*)(ws + WS_G), (bf16*)(ws + WS_U)};
            pg8::gemm_phase<EpiRnnIn, pg8::StaticOrder, true, true>(C.lds, g, S, E);
        } break;
        case PH_RNN_AB0: p_rnn_ab(C, args, 0); break;
        case PH_RNN_SCAN0: p_rnn_scan(C, 0); break;
        case PH_RNN_AB1: p_rnn_ab(C, args, 1); break;
        case PH_RNN_SCAN1: p_rnn_scan(C, 1); break;
        case PH_QKV: {
            pg8::Gemm g{xb, (const bf16*)(ws + WS_WQKV), M, NQKV, D}; pg8::StaticOrder S; S.init(M, NQKV, C.G, (int)blockIdx.x);
            EpiQKV E{ssq, args.in[I_QGAIN], args.in[I_KGAIN], (bf16*)(ws + WS_QKV)};
            pg8::gemm_phase<EpiQKV, pg8::StaticOrder, true, true>(C.lds, g, S, E);
        } break;
        case PH_ATTN: p_attn(C); break;
        case PH_MERGE: p_merge(C, args); break;
        default: break;
        }
        if (ph + 1 < args.ph_hi) xcd_barrier(bar);
    }
}

extern "C" void kernel_launch(void* const* d_in, const int* in_sizes, int n_in, void* d_out, int out_size, void* d_ws, size_t ws_size, hipStream_t stream) {
    static int grid = 0;
    if (grid == 0) {
        if (n_in != 18 || in_sizes[0] != M * D || out_size != M * D || ws_size < WS_END) { fprintf(stderr, "kernel_launch: unexpected shapes (n_in %d, in0 %d, out %d, ws %zu)\n", n_in, n_in > 0 ? in_sizes[0] : -1, out_size, ws_size); grid = -1; return; }
        int dev = 0, cus = 0, per_cu = 0;
        if (hipGetDevice(&dev) != hipSuccess || hipDeviceGetAttribute(&cus, hipDeviceAttributeMultiprocessorCount, dev) != hipSuccess) { fprintf(stderr, "kernel_launch: device query failed\n"); grid = -1; return; }
        if (hipFuncSetAttribute((const void*)fwd_kernel, hipFuncAttributeMaxDynamicSharedMemorySize, LDS_BYTES) != hipSuccess) { fprintf(stderr, "kernel_launch: hipFuncSetAttribute failed\n"); grid = -1; return; }
        if (hipOccupancyMaxActiveBlocksPerMultiprocessor(&per_cu, (const void*)fwd_kernel, NWAVES * 64, LDS_BYTES) != hipSuccess || per_cu < 1) { fprintf(stderr, "kernel_launch: occupancy query says %d blocks per CU\n", per_cu); (void)hipGetLastError(); grid = -1; return; }
        grid = cus;
    }
    if (grid < 0) return;
    if (hipMemsetAsync(d_ws, 0, CTL_ZERO_BYTES, stream) != hipSuccess) { fprintf(stderr, "kernel_launch: memset failed\n"); return; }
    Args a{};
    for (int i = 0; i < 18; ++i) a.in[i] = (const float*)d_in[i];
    a.out = (float*)d_out; a.ws = (unsigned char*)d_ws;
#if SINGLE_LAUNCH
    a.ph_lo = 0; a.ph_hi = NPHASE;
    hipLaunchKernelGGL(fwd_kernel, dim3(grid), dim3(NWAVES * 64), LDS_BYTES, stream, a);
#else
    for (int ph = 0; ph < NPHASE; ++ph) { a.ph_lo = ph; a.ph_hi = ph + 1; hipLaunchKernelGGL(fwd_kernel, dim3(grid), dim3(NWAVES * 64), LDS_BYTES, stream, a); }
#endif
}
```

```cpp
#include <hip/hip_runtime.h>
#include <cstdio>
#include <cstdint>

#ifndef SINGLE_LAUNCH
#define SINGLE_LAUNCH 1
#endif

namespace pg8 {
#define PG8_LAS __attribute__((address_space(3)))
typedef unsigned short bf16_t;
typedef short bf16x8 __attribute__((ext_vector_type(8)));
typedef float f32x4 __attribute__((ext_vector_type(4)));
typedef unsigned u32x4 __attribute__((ext_vector_type(4)));
constexpr int BM = 256, BK = 64, HALF = 128, HTB = HALF * BK * 2, STAGE_BYTES = 8 * HTB, NXCD = 8, WGM = 8;

__host__ __device__ __forceinline__ int lds_byte(int r, int c) { const int st = (r >> 4) * 2 + (c >> 5), rr = r & 15, cc = c & 31, ob = rr * 64 + cc * 2; return st * 1024 + (ob ^ (((ob >> 9) & 1) << 5)); }
__host__ __device__ __forceinline__ void stage_rc(int b, int& R, int& C) { const int st = b / 1024, sb = b % 1024, swz = sb ^ (((sb >> 9) & 1) << 5); R = (st >> 1) * 16 + swz / 64; C = (st & 1) * 32 + (swz % 64) / 2; }
__host__ __device__ __forceinline__ int perm32(int rho) { const int n = rho >> 4, i = rho & 15; return 8 * (i >> 2) + 4 * n + (i & 3); }

struct Unit { int pm, pn; };
struct Gemm { const bf16_t* A; const bf16_t* Bt; int M, N, K; };

struct StaticOrder {
    int nM, nN, nwg, G, c;
    __host__ __device__ void init(int M, int N, int G_, int c_) { nM = M / BM; nN = N / BM; nwg = nM * nN; G = G_; c = c_; }
    __host__ __device__ bool next(int i, Unit& u) const {
        const long L = (long)i * G + c; if (L >= nwg) return false;
        int wgid = (int)L; { const int q = nwg / NXCD, r = nwg % NXCD, xcd = wgid % NXCD, off = wgid / NXCD; wgid = (xcd < r ? xcd * (q + 1) : r * (q + 1) + (xcd - r) * q) + off; }
        const int nig = WGM * nN, gid = wgid / nig, fm = gid * WGM, gsz = (nM - fm) < WGM ? (nM - fm) : WGM;
        u.pm = fm + ((wgid % nig) % gsz); u.pn = (wgid % nig) / gsz; return true;
    }
    __device__ __forceinline__ void a_ready(const Unit&) const {}
    __device__ __forceinline__ void done(const Unit&) const {}
};

__device__ __forceinline__ unsigned cvt_pk_bf16(float lo, float hi) { unsigned r; asm volatile("v_cvt_pk_bf16_f32 %0, %1, %2" : "=v"(r) : "v"(lo), "v"(hi)); return r; }

template <class Epi, class Sched, bool ALIGN_EPI = false, bool SP2 = false>
__device__ __forceinline__ void gemm_phase(PG8_LAS unsigned char* lds, const Gemm g, const Sched& S, const Epi& E) {
    int tid_ = threadIdx.x; asm volatile("" : "+v"(tid_));
    const int tid = tid_, wid = __builtin_amdgcn_readfirstlane(tid >> 6), lane = tid & 63, wr = wid >> 2, wc = wid & 3, fr = lane & 15, fq = lane >> 4;
    const int K = g.K, nt = K / BK;
    unsigned voffA[2], voffB[2];
#pragma unroll
    for (int i = 0; i < 2; ++i) { int R, C; stage_rc(tid * 16 + i * 8192, R, C); const int Rb = Epi::PERM ? ((R & ~31) + perm32(R & 31)) : R;
        voffA[i] = (unsigned)(R * K + C) * 2u; voffB[i] = (unsigned)(Rb * K + C) * 2u; }
    const size_t kstep = (size_t)(BK * 2);
    const size_t hstep = (size_t)HALF * K * 2;
    const size_t tstep = 2 * hstep;
    const unsigned ldsw = (unsigned)wid * 1024u;
    const int aoff = lds_byte(wr * 64 + fr, fq * 8), boff = lds_byte(wc * 32 + fr, fq * 8);
#define PG8_SA(b, h) (((b) * 2 + (h)) * HTB)
#define PG8_SB(b, h) ((4 + (b) * 2 + (h)) * HTB)
#define PG8_STAGE(bufoff, gbase, voff) do { _Pragma("unroll") for (int _i = 0; _i < 2; ++_i) \
        __builtin_amdgcn_global_load_lds((const unsigned*)((const char*)(gbase) + (voff)[_i]), (PG8_LAS unsigned*)(lds + (bufoff) + ldsw + _i * 8192), 16, 0, 0); } while (0)
#define PG8_LDA(dst, b, h) do { _Pragma("unroll") for (int m = 0; m < 4; ++m) _Pragma("unroll") for (int k = 0; k < 2; ++k) dst[m][k] = *(const PG8_LAS bf16x8*)(lds + PG8_SA(b, h) + aoff + m * 2048 + k * 1024); } while (0)
#define PG8_LDB(dst, b, h) do { _Pragma("unroll") for (int n = 0; n < 2; ++n) _Pragma("unroll") for (int k = 0; k < 2; ++k) dst[n][k] = *(const PG8_LAS bf16x8*)(lds + PG8_SB(b, h) + boff + n * 2048 + k * 1024); } while (0)
#define PG8_MMA(ai, bj, At, Bt) do { __builtin_amdgcn_s_setprio(1); _Pragma("unroll") for (int m = 0; m < 4; ++m) _Pragma("unroll") for (int n = 0; n < 2; ++n) _Pragma("unroll") for (int k = 0; k < 2; ++k) \
        acc[ai][bj][m][n] = __builtin_amdgcn_mfma_f32_16x16x32_bf16(Bt[n][k], At[m][k], acc[ai][bj][m][n], 0, 0, 0); __builtin_amdgcn_s_setprio(0); } while (0)
#define PG8_WAIT_V(n) asm volatile("s_waitcnt vmcnt(" #n ")" ::: "memory")
#define PG8_WAIT_L(n) asm volatile("s_waitcnt lgkmcnt(" #n ")" ::: "memory")
#define PG8_BAR __builtin_amdgcn_s_barrier()
#define PG8_SCHED __builtin_amdgcn_sched_barrier(0)
    Unit cur, nxt; int ui = 0;
    if (!S.next(0, cur)) return;
    f32x4 acc[2][2][4][2];
#pragma unroll
    for (int a = 0; a < 2; ++a)
#pragma unroll
        for (int b = 0; b < 2; ++b)
#pragma unroll
            for (int m = 0; m < 4; ++m)
#pragma unroll
                for (int n = 0; n < 2; ++n) acc[a][b][m][n] = (f32x4){0.f, 0.f, 0.f, 0.f};
    bf16x8 At[4][2], B0[2][2], B1[2][2];
    const char* cA = (const char*)g.A + (size_t)cur.pm * tstep; const char* cB = (const char*)g.Bt + (size_t)cur.pn * tstep;
    S.a_ready(cur);
    if constexpr (SP2) {
        PG8_STAGE(PG8_SB(0, 0), cB, voffB); PG8_STAGE(PG8_SB(0, 1), cB + hstep, voffB); PG8_STAGE(PG8_SA(0, 0), cA, voffA); PG8_STAGE(PG8_SA(0, 1), cA + hstep, voffA);
        if (wr == 1) PG8_BAR;
        PG8_WAIT_V(2); PG8_BAR;
        PG8_STAGE(PG8_SB(1, 0), cB + kstep, voffB); PG8_STAGE(PG8_SA(1, 0), cA + kstep, voffA); PG8_STAGE(PG8_SB(1, 1), cB + hstep + kstep, voffB);
        PG8_WAIT_V(6); PG8_BAR;
    } else {
        PG8_STAGE(PG8_SB(0, 0), cB, voffB); PG8_STAGE(PG8_SA(0, 0), cA, voffA); PG8_STAGE(PG8_SB(0, 1), cB + hstep, voffB); PG8_STAGE(PG8_SA(0, 1), cA + hstep, voffA);
        if (wr == 1) PG8_BAR;
        PG8_WAIT_V(4); PG8_BAR;
        PG8_STAGE(PG8_SB(1, 0), cB + kstep, voffB); PG8_STAGE(PG8_SA(1, 0), cA + kstep, voffA); PG8_STAGE(PG8_SB(1, 1), cB + hstep + kstep, voffB);
        PG8_WAIT_V(6); PG8_BAR;
    }
    for (;;) {
        const bool has_next = S.next(ui + 1, nxt);
        const char* nA = has_next ? (const char*)g.A + (size_t)nxt.pm * tstep : cA; const char* nB = has_next ? (const char*)g.Bt + (size_t)nxt.pn * tstep : cB;
        for (int t = 0; t < nt; t += 2) {
            const bool last = (t == nt - 2);
            const char* a1 = cA + (size_t)(t + 1) * kstep;
            const char* a2 = last ? nA : cA + (size_t)(t + 2) * kstep; const char* b2 = last ? nB : cB + (size_t)(t + 2) * kstep;
            const char* a3 = a2 + kstep; const char* b3 = b2 + kstep;
            if (last && has_next) S.a_ready(nxt);
            if constexpr (SP2) {
            PG8_LDB(B0, 0, 0); PG8_LDB(B1, 0, 1); PG8_SCHED; PG8_LDA(At, 0, 0); PG8_STAGE(PG8_SA(1, 1), a1 + hstep, voffA);
            PG8_WAIT_V(8); PG8_WAIT_L(0); PG8_BAR; PG8_MMA(0, 0, At, B0); PG8_MMA(0, 1, At, B1); PG8_BAR; PG8_SCHED;
            PG8_LDA(At, 0, 1); PG8_STAGE(PG8_SB(0, 0), b2, voffB); PG8_STAGE(PG8_SB(0, 1), b2 + hstep, voffB); PG8_STAGE(PG8_SA(0, 0), a2, voffA);
            PG8_WAIT_V(8); PG8_WAIT_L(0); PG8_BAR; PG8_MMA(1, 0, At, B0); PG8_MMA(1, 1, At, B1); PG8_BAR; PG8_SCHED;
            PG8_LDB(B0, 1, 0); PG8_LDB(B1, 1, 1); PG8_SCHED; PG8_LDA(At, 1, 0); PG8_STAGE(PG8_SA(0, 1), a2 + hstep, voffA);
            PG8_WAIT_V(8); PG8_WAIT_L(0); PG8_BAR; PG8_MMA(0, 0, At, B0); PG8_MMA(0, 1, At, B1); PG8_BAR; PG8_SCHED;
            PG8_LDA(At, 1, 1); PG8_STAGE(PG8_SB(1, 0), b3, voffB); PG8_STAGE(PG8_SB(1, 1), b3 + hstep, voffB); PG8_STAGE(PG8_SA(1, 0), a3, voffA);
            PG8_WAIT_V(8); PG8_WAIT_L(0); PG8_BAR; PG8_MMA(1, 0, At, B0); PG8_MMA(1, 1, At, B1); PG8_BAR; PG8_SCHED;
            } else {
            PG8_LDB(B0, 0, 0); PG8_SCHED; PG8_LDA(At, 0, 0); PG8_STAGE(PG8_SA(1, 1), a1 + hstep, voffA);
            PG8_WAIT_L(8); PG8_BAR; PG8_WAIT_L(0); PG8_MMA(0, 0, At, B0); PG8_BAR; PG8_SCHED;
            PG8_LDB(B1, 0, 1); PG8_STAGE(PG8_SB(0, 0), b2, voffB);
            PG8_BAR; PG8_WAIT_L(0); PG8_MMA(0, 1, At, B1); PG8_BAR;
            PG8_LDA(At, 0, 1); PG8_STAGE(PG8_SA(0, 0), a2, voffA);
            PG8_BAR; PG8_WAIT_L(0); PG8_MMA(1, 0, At, B0); PG8_BAR; PG8_SCHED;
            PG8_STAGE(PG8_SB(0, 1), b2 + hstep, voffB);
            PG8_WAIT_V(6); PG8_BAR; PG8_MMA(1, 1, At, B1); PG8_BAR;
            PG8_LDB(B0, 1, 0); PG8_SCHED; PG8_LDA(At, 1, 0); PG8_STAGE(PG8_SA(0, 1), a2 + hstep, voffA);
            PG8_WAIT_L(8); PG8_BAR; PG8_WAIT_L(0); PG8_MMA(0, 0, At, B0); PG8_BAR; PG8_SCHED;
            PG8_LDB(B1, 1, 1); PG8_STAGE(PG8_SB(1, 0), b3, voffB);
            PG8_BAR; PG8_WAIT_L(0); PG8_MMA(0, 1, At, B1); PG8_BAR;
            PG8_LDA(At, 1, 1); PG8_STAGE(PG8_SA(1, 0), a3, voffA);
            PG8_BAR; PG8_WAIT_L(0); PG8_MMA(1, 0, At, B0); PG8_BAR; PG8_SCHED;
            PG8_STAGE(PG8_SB(1, 1), b3 + hstep, voffB);
            PG8_WAIT_V(6); PG8_BAR; PG8_MMA(1, 1, At, B1); PG8_BAR;
            }
        }
        if constexpr (ALIGN_EPI) { if (wr == 0) PG8_BAR; }
        E(acc, cur, wr, wc, fr, fq); S.done(cur);
        if (!has_next) break;
#pragma unroll
        for (int a = 0; a < 2; ++a)
#pragma unroll
            for (int b = 0; b < 2; ++b)
#pragma unroll
                for (int m = 0; m < 4; ++m)
#pragma unroll
                    for (int n = 0; n < 2; ++n) acc[a][b][m][n] = (f32x4){0.f, 0.f, 0.f, 0.f};
        cur = nxt; cA = nA; cB = nB; ++ui;
        if constexpr (ALIGN_EPI) { if (wr == 1) PG8_BAR; }
    }
    PG8_WAIT_V(0);
    if constexpr (!ALIGN_EPI) { if (wr == 0) PG8_BAR; }
    PG8_BAR;
#undef PG8_SA
#undef PG8_SB
#undef PG8_STAGE
#undef PG8_LDA
#undef PG8_LDB
#undef PG8_MMA
#undef PG8_WAIT_V
#undef PG8_WAIT_L
#undef PG8_BAR
#undef PG8_SCHED
}
}

constexpr int BATCH = 8, SEQ = 2048, D = 1024, M = BATCH * SEQ;
constexpr int FF = 2816, DRNN = 1280, NBLK = 10, RBLK = 128, CONVW = 4;
constexpr int NHEAD = 16, HD = 64, NGRP = 3, NQKV = 9216;
constexpr float RMS_EPS = 1e-6f;
constexpr float LOG2E = 1.4426950408889634f;
constexpr int NWAVES = 8;

typedef unsigned short bf16;
typedef unsigned v4u __attribute__((ext_vector_type(4)));
typedef unsigned v2u __attribute__((ext_vector_type(2)));
typedef float f32x4 __attribute__((ext_vector_type(4)));
#define GAS __attribute__((address_space(1)))
#define LAS __attribute__((address_space(3)))
typedef GAS unsigned gu32;
#define RLX_AGENT __ATOMIC_RELAXED, __HIP_MEMORY_SCOPE_AGENT
#define LDS_WAIT() asm volatile("s_waitcnt lgkmcnt(0)" ::: "memory")

constexpr size_t MiB = 1u << 20;
constexpr size_t WS_CTL = 0, CTL_ZERO_BYTES = 1 * MiB;
constexpr size_t WS_SSQ = 1 * MiB;
constexpr size_t WS_BIAS = 2 * MiB;
constexpr size_t WS_XB = 3 * MiB;
constexpr size_t WS_WO = 35 * MiB;
constexpr size_t WS_WQKV = 37 * MiB;
constexpr size_t WS_QKV = 55 * MiB;
constexpr size_t QKV_SLAB = (size_t)M * 1024 * 2;
constexpr size_t WS_LSE = 343 * MiB;
constexpr size_t WS_END = 346 * MiB;
constexpr size_t WS_WIN0 = 55 * MiB, WS_WOUT0 = 66 * MiB, WS_WIN1 = 72 * MiB, WS_WOUT1 = 83 * MiB, WS_WIN2 = 89 * MiB, WS_WOUT2 = 100 * MiB;
constexpr size_t WS_WRIN = 106 * MiB, WS_WROUT = 111 * MiB, WS_WA = 114 * MiB, WS_WX = 114 * MiB + 512 * 1024;
constexpr size_t WS_ACT = 115 * MiB;
constexpr size_t WS_G = 203 * MiB, WS_U = 243 * MiB, WS_Y = 283 * MiB;
constexpr size_t WS_ATT = WS_QKV + 3 * QKV_SLAB;
constexpr size_t WS_WIN3 = WS_QKV + 6 * QKV_SLAB, WS_WOUT3 = WS_WIN3 + 11 * MiB;
constexpr size_t WS_ACT3 = WS_QKV;
static_assert(WS_Y + (size_t)M * DRNN * 2 <= WS_LSE && WS_ACT + (size_t)M * FF * 2 <= WS_G && WS_WX + 327680 <= WS_ACT, "ws map");
static_assert(WS_QKV + 9 * QKV_SLAB == WS_LSE && WS_LSE + (size_t)3 * M * 16 * 4 <= WS_END, "ws map");
constexpr int CW_BAR = 4096;

constexpr int RING_BYTES = 131072, LDSCTL_OFF = RING_BYTES, MISC_OFF = LDSCTL_OFF + 320;
constexpr int LDS_BYTES = 147456;

#define XB_TMO      128
#define XB_XCNT(j)  (256  + 64 * (j))
#define XB_XSUB(j)  (1280 + 64 * (j))
#define XB_XGEN(j)  (2304 + 64 * (j))
#define XB_TOP      3328
#define XB_TOPGEN   3392
#define XCD_BAR_WORDS 3456
#define XB_SPIN_CAP (1u << 18)
__device__ __forceinline__ unsigned xb_ld(unsigned* p)              { return __hip_atomic_load(p, __ATOMIC_RELAXED, __HIP_MEMORY_SCOPE_AGENT); }
__device__ __forceinline__ unsigned xb_add(unsigned* p, unsigned v) { return __hip_atomic_fetch_add(p, v, __ATOMIC_RELAXED, __HIP_MEMORY_SCOPE_AGENT); }
__device__ __forceinline__ unsigned xb_xcc_id() { return (unsigned)__builtin_amdgcn_s_getreg((3 << 11) | 20) & 0xFu; }
#define XB_SPIN(cond, bar) do { unsigned _sp = 0; while (cond) { __builtin_amdgcn_s_sleep(1); \
    if ((++_sp & 255u) == 0u) { if (xb_ld(&(bar)[XB_TMO])) break; if (_sp > XB_SPIN_CAP) { atomicAdd(&(bar)[XB_TMO], 1u); break; } } } } while (0)
struct XcdBarrier { unsigned* bar; unsigned x; volatile LAS unsigned* st; };
__device__ __forceinline__ XcdBarrier xcd_barrier_post(unsigned* bar, volatile LAS unsigned* st) {
    XcdBarrier b; b.bar = bar; b.x = xb_xcc_id(); b.st = st;
    if (threadIdx.x == 0) (void)xb_add(&bar[XB_XCNT(b.x)], 1u);
    return b;
}
__device__ __forceinline__ void xcd_barrier_complete(unsigned* bar, unsigned x, unsigned& nloc, unsigned& nx) {
    const unsigned G = gridDim.x * gridDim.y * gridDim.z;
    unsigned sum, cnt, mine, sp = 0u;
    for (;;) {
        sum = 0u; cnt = 0u; mine = 0u;
#pragma unroll
        for (unsigned j = 0; j < 16; ++j) { const unsigned c = xb_ld(&bar[XB_XCNT(j)]); sum += c; cnt += (c > 0u) ? 1u : 0u; mine = (j == x) ? c : mine; }
        if (sum == G) break;
        __builtin_amdgcn_s_sleep(1);
        if ((++sp & 255u) == 0u) { if (xb_ld(&bar[XB_TMO])) break; if (sp > XB_SPIN_CAP) { atomicAdd(&bar[XB_TMO], 1u); break; } }
    }
    nloc = mine > 0u ? mine : 1u; nx = cnt > 0u ? cnt : 1u;
}
__device__ __forceinline__ void xcd_barrier(const XcdBarrier& b) {
    asm volatile("s_waitcnt vmcnt(0)" ::: "memory");
    __syncthreads();
    if (threadIdx.x == 0) {
        unsigned* bar = b.bar;
        __builtin_amdgcn_s_waitcnt(0);
        unsigned nloc = b.st[0], nx = b.st[1];
        if (nloc == 0u) { xcd_barrier_complete(bar, b.x, nloc, nx); b.st[0] = nloc; b.st[1] = nx; }
        const unsigned old = xb_add(&bar[XB_XSUB(b.x)], 1u);
        const unsigned gen = old / nloc;
        if (old + 1u == (gen + 1u) * nloc) {
            __builtin_amdgcn_fence(__ATOMIC_RELEASE, "agent");
            asm volatile("s_waitcnt vmcnt(0)" ::: "memory");
            const unsigned og = xb_add(&bar[XB_TOP], 1u);
            const unsigned tg = og / nx;
            if (og + 1u == (tg + 1u) * nx) xb_add(&bar[XB_TOPGEN], 1u);
            else XB_SPIN(xb_ld(&bar[XB_TOPGEN]) == tg, bar);
            __builtin_amdgcn_fence(__ATOMIC_ACQUIRE, "agent");
            xb_add(&bar[XB_XGEN(b.x)], 1u);
            asm volatile("s_waitcnt vmcnt(0)" ::: "memory");
        } else {
            XB_SPIN(xb_ld(&bar[XB_XGEN(b.x)]) == gen, bar);
            __builtin_amdgcn_fence(__ATOMIC_ACQUIRE, "agent");
            asm volatile("s_waitcnt vmcnt(0)" ::: "memory");
        }
    }
    __syncthreads();
}

__device__ __forceinline__ unsigned f2bf(float f) { unsigned u = __builtin_bit_cast(unsigned, f); return (u + 0x7fffu + ((u >> 16) & 1u)) >> 16; }
__device__ __forceinline__ unsigned pk2(float lo, float hi) { return f2bf(lo) | (f2bf(hi) << 16); }
__device__ __forceinline__ float bf_lo(unsigned w) { return __builtin_bit_cast(float, w << 16); }
__device__ __forceinline__ float bf_hi(unsigned w) { return __builtin_bit_cast(float, w & 0xffff0000u); }
__device__ __forceinline__ float bf2f(bf16 v) { return __builtin_bit_cast(float, (unsigned)v << 16); }
__device__ __forceinline__ float wave_sum(float v) {
#pragma unroll
    for (int o = 1; o < 64; o <<= 1) v += __shfl_xor(v, o);
    return v;
}
__device__ __forceinline__ float fast_sigmoid(float x) { return __builtin_amdgcn_rcpf(1.f + __builtin_amdgcn_exp2f(-LOG2E * x)); }
__device__ __forceinline__ float row_rstd(const float* ssq, int row) {
    const f32x4* p = (const f32x4*)(ssq + (size_t)row * 16); const f32x4 a = p[0], b = p[1], c = p[2], d = p[3];
    const float s = ((a.x + a.y) + (a.z + a.w)) + ((b.x + b.y) + (b.z + b.w)) + ((c.x + c.y) + (c.z + c.w)) + ((d.x + d.y) + (d.z + d.w));
    return rsqrtf(s * (1.0f / D) + RMS_EPS);
}

using pg8::Unit;
struct EpiSwiGLU {
    static constexpr bool PERM = true;
    const float* ssq; bf16* act;
    __device__ __forceinline__ void operator()(const f32x4 (&acc)[2][2][4][2], const Unit& u, int wr, int wc, int fr, int fq) const {
#pragma unroll
        for (int ai = 0; ai < 2; ++ai)
#pragma unroll
            for (int m = 0; m < 4; ++m) {
                const int row = u.pm * 256 + ai * 128 + wr * 64 + m * 16 + fr;
                const float rs = row_rstd(ssq, row);
                float v[8];
#pragma unroll
                for (int n = 0; n < 2; ++n)
#pragma unroll
                    for (int e = 0; e < 4; ++e) { const float g = acc[ai][0][m][n][e] * rs, up = acc[ai][1][m][n][e] * rs; v[n * 4 + e] = g * fast_sigmoid(g) * up; }
                v4u w; w.x = pg8::cvt_pk_bf16(v[0], v[1]); w.y = pg8::cvt_pk_bf16(v[2], v[3]); w.z = pg8::cvt_pk_bf16(v[4], v[5]); w.w = pg8::cvt_pk_bf16(v[6], v[7]);
                *(v4u*)(act + (size_t)row * FF + u.pn * 128 + wc * 32 + 8 * fq) = w;
                asm volatile("" ::: "memory");
            }
    }
};
struct EpiRes {
    static constexpr bool PERM = true;
    const float* xin; float* xout; bf16* xb; float* ssq; float scale;
    __device__ __forceinline__ void operator()(const f32x4 (&acc)[2][2][4][2], const Unit& u, int wr, int wc, int fr, int fq) const {
#pragma unroll
        for (int ai = 0; ai < 2; ++ai)
#pragma unroll
            for (int m = 0; m < 4; ++m) {
                const int row = u.pm * 256 + ai * 128 + wr * 64 + m * 16 + fr;
                float ss = 0.f;
#pragma unroll
                for (int bj = 0; bj < 2; ++bj) {
                    const size_t off = (size_t)row * D + u.pn * 256 + bj * 128 + wc * 32 + 8 * fq;
                    const f32x4 x0 = *(const f32x4*)(xin + off), x1 = *(const f32x4*)(xin + off + 4);
                    const f32x4 y0 = x0 + acc[ai][bj][m][0] * scale, y1 = x1 + acc[ai][bj][m][1] * scale;
                    *(f32x4*)(xout + off) = y0; *(f32x4*)(xout + off + 4) = y1;
                    v4u w; w.x = pg8::cvt_pk_bf16(y0[0], y0[1]); w.y = pg8::cvt_pk_bf16(y0[2], y0[3]); w.z = pg8::cvt_pk_bf16(y1[0], y1[1]); w.w = pg8::cvt_pk_bf16(y1[2], y1[3]);
                    *(v4u*)(xb + off) = w;
                    ss += (y0[0] * y0[0] + y0[1] * y0[1]) + (y0[2] * y0[2] + y0[3] * y0[3]) + (y1[0] * y1[0] + y1[1] * y1[1]) + (y1[2] * y1[2] + y1[3] * y1[3]);
                }
                ss += __shfl_xor(ss, 16); ss += __shfl_xor(ss, 32);
                if (fq == 0) ssq[(size_t)row * 16 + u.pn * 4 + wc] = ss;
                asm volatile("" ::: "memory");
            }
    }
};
struct EpiRnnIn {
    static constexpr bool PERM = true;
    const float* ssq; bf16* Gb; bf16* Ub;
    __device__ __forceinline__ void operator()(const f32x4 (&acc)[2][2][4][2], const Unit& u, int wr, int wc, int fr, int fq) const {
        const bool is_gate = u.pn < 5; bf16* dstb = is_gate ? Gb : Ub; const int pc = is_gate ? u.pn : u.pn - 5;
#pragma unroll
        for (int ai = 0; ai < 2; ++ai)
#pragma unroll
            for (int m = 0; m < 4; ++m) {
                const int row = u.pm * 256 + ai * 128 + wr * 64 + m * 16 + fr;
                const float rs = row_rstd(ssq, row);
#pragma unroll
                for (int bj = 0; bj < 2; ++bj) {
                    float v[8];
#pragma unroll
                    for (int n = 0; n < 2; ++n)
#pragma unroll
                        for (int e = 0; e < 4; ++e) { float x = acc[ai][bj][m][n][e] * rs;
                            if (is_gate) { const float z = 1.5957691216057308f * (x + 0.044715f * x * x * x); x = x * fast_sigmoid(z); }
                            v[n * 4 + e] = x; }
                    v4u w; w.x = pg8::cvt_pk_bf16(v[0], v[1]); w.y = pg8::cvt_pk_bf16(v[2], v[3]); w.z = pg8::cvt_pk_bf16(v[4], v[5]); w.w = pg8::cvt_pk_bf16(v[6], v[7]);
                    *(v4u*)(dstb + (size_t)row * DRNN + pc * 256 + bj * 128 + wc * 32 + 8 * fq) = w;
                }
                asm volatile("" ::: "memory");
            }
    }
};
struct EpiQKV {
    static constexpr bool PERM = true;
    const float* ssq; const float* qgain; const float* kgain; bf16* qkv;
    __device__ __forceinline__ void operator()(const f32x4 (&acc)[2][2][4][2], const Unit& u, int wr, int wc, int fr, int fq) const {
        const int hs = u.pn * 4 + wc, kind = hs / 48, gh = hs - kind * 48, g = gh >> 4, h = gh & 15, l2d = 2 * g;
        const float* gain = (kind == 0) ? qgain : kgain; const float gsc = (kind == 0) ? 0.125f * LOG2E : 1.f;
        bf16* slab = qkv + (size_t)(kind * 3 + g) * ((size_t)M * 1024);
#pragma unroll
        for (int ai = 0; ai < 2; ++ai)
#pragma unroll
            for (int m = 0; m < 4; ++m) {
                const int row = u.pm * 256 + ai * 128 + wr * 64 + m * 16 + fr;
                const float rs = row_rstd(ssq, row);
                f32x4 v[2][2]; float ss = 0.f;
#pragma unroll
                for (int bj = 0; bj < 2; ++bj)
#pragma unroll
                    for (int n = 0; n < 2; ++n) { v[bj][n] = acc[ai][bj][m][n] * rs; const f32x4 t = v[bj][n]; ss += (t[0] * t[0] + t[1] * t[1]) + (t[2] * t[2] + t[3] * t[3]); }
                ss += __shfl_xor(ss, 16); ss += __shfl_xor(ss, 32);
                const float rn = (kind < 2) ? rsqrtf(ss * (1.0f / HD) + RMS_EPS) : 1.f;
                const int b = row >> 11, t = row & 2047, rres = t & ((1 << l2d) - 1), l = t >> l2d, L = 2048 >> l2d;
                bf16* dst = slab + ((size_t)(b * 16 + h) * 2048 + rres * L + l) * 64 + 8 * fq;
#pragma unroll
                for (int bj = 0; bj < 2; ++bj) {
                    f32x4 g0 = (f32x4){1.f, 1.f, 1.f, 1.f}, g1 = g0;
                    if (kind < 2) { g0 = *(const f32x4*)(gain + 32 * bj + 8 * fq) * gsc; g1 = *(const f32x4*)(gain + 32 * bj + 8 * fq + 4) * gsc; }
                    const f32x4 a0 = v[bj][0] * g0 * rn, a1 = v[bj][1] * g1 * rn;
                    v4u w; w.x = pg8::cvt_pk_bf16(a0[0], a0[1]); w.y = pg8::cvt_pk_bf16(a0[2], a0[3]); w.z = pg8::cvt_pk_bf16(a1[0], a1[1]); w.w = pg8::cvt_pk_bf16(a1[2], a1[3]);
                    *(v4u*)(dst + 32 * bj) = w;
                }
                asm volatile("" ::: "memory");
            }
    }
};

struct Args { const float* in[18]; float* out; unsigned char* ws; int ph_lo, ph_hi; };
enum { I_X = 0, I_NORMG, I_FFN_WIN, I_FFN_WOUT, I_RNN_WIN, I_CONV_W, I_CONV_B, I_WA, I_BA, I_WX, I_BX, I_LAM, I_RNN_WOUT, I_WQKV, I_QGAIN, I_KGAIN, I_WO, I_RELB };

struct Ctx { LAS unsigned char* lds; int tid, lane, wave, G, vcu; unsigned char* ws; };

enum { CM_NONE = 0, CM_FFN = 1, CM_QKV = 2 };
__device__ __forceinline__ int colmap(int mode, int vr) {
    if (mode == CM_FFN) { const int pn = vr >> 8, w = vr & 255; return (w >> 7) * FF + 128 * pn + (w & 127); }
    if (mode == CM_QKV) { const int pn = vr >> 8, w = vr & 255, bj = w >> 7, wc = (w >> 5) & 3, j = w & 31; return 256 * pn + 64 * wc + 32 * bj + j; }
    return vr;
}
__device__ __forceinline__ void transpose_item(const float* W, int K, int N, const float* gvec, bf16* WT, int mode, LAS float* scr, int item, int lane) {
    const int nblk = N / 32, kb = item / nblk, nb = item - kb * nblk, k0 = 64 * kb, vr0 = 32 * nb, n0 = colmap(mode, vr0);
#pragma unroll 8
    for (int i = 0; i < 32; ++i) { const int kk = 2 * i + (lane >> 5); float w = W[(size_t)(k0 + kk) * N + n0 + (lane & 31)]; if (gvec) w *= gvec[k0 + kk]; scr[kk * 33 + (lane & 31)] = w; }
    LDS_WAIT(); asm volatile("" ::: "memory");
    const int c = lane & 7;
#pragma unroll
    for (int j = 0; j < 4; ++j) { const int n = (lane >> 3) + 8 * j; const LAS float* s = scr + (8 * c) * 33 + n;
        v4u o; o.x = pk2(s[0 * 33], s[1 * 33]); o.y = pk2(s[2 * 33], s[3 * 33]); o.z = pk2(s[4 * 33], s[5 * 33]); o.w = pk2(s[6 * 33], s[7 * 33]);
        *(GAS v4u*)(WT + (size_t)(vr0 + n) * K + k0 + 8 * c) = o; }
    LDS_WAIT(); asm volatile("" ::: "memory");
}
struct MatJob { const float* W; int K, N; const float* g; bf16* WT; int mode; };
__device__ __forceinline__ MatJob mat_job(const Ctx& C, const Args& a, int idx) {
    unsigned char* ws = C.ws; const float* ng = a.in[I_NORMG]; MatJob j;
    switch (idx) {
    case 0: j = MatJob{a.in[I_FFN_WIN] + (size_t)0 * D * 2 * FF, D, 2 * FF, ng + 0 * D, (bf16*)(ws + WS_WIN0), CM_FFN}; break;
    case 1: j = MatJob{a.in[I_FFN_WOUT] + (size_t)0 * FF * D, FF, D, nullptr, (bf16*)(ws + WS_WOUT0), CM_NONE}; break;
    case 2: j = MatJob{a.in[I_RNN_WIN], D, 2 * DRNN, ng + 1 * D, (bf16*)(ws + WS_WRIN), CM_NONE}; break;
    case 3: j = MatJob{a.in[I_RNN_WOUT], DRNN, D, nullptr, (bf16*)(ws + WS_WROUT), CM_NONE}; break;
    case 4: j = MatJob{a.in[I_FFN_WIN] + (size_t)1 * D * 2 * FF, D, 2 * FF, ng + 2 * D, (bf16*)(ws + WS_WIN1), CM_FFN}; break;
    case 5: j = MatJob{a.in[I_FFN_WOUT] + (size_t)1 * FF * D, FF, D, nullptr, (bf16*)(ws + WS_WOUT1), CM_NONE}; break;
    case 6: j = MatJob{a.in[I_FFN_WIN] + (size_t)2 * D * 2 * FF, D, 2 * FF, ng + 3 * D, (bf16*)(ws + WS_WIN2), CM_FFN}; break;
    case 7: j = MatJob{a.in[I_FFN_WOUT] + (size_t)2 * FF * D, FF, D, nullptr, (bf16*)(ws + WS_WOUT2), CM_NONE}; break;
    case 8: j = MatJob{a.in[I_WQKV], D, NQKV, ng + 4 * D, (bf16*)(ws + WS_WQKV), CM_QKV}; break;
    case 9: j = MatJob{a.in[I_WO], D, D, nullptr, (bf16*)(ws + WS_WO), CM_NONE}; break;
    case 10: j = MatJob{a.in[I_FFN_WIN] + (size_t)3 * D * 2 * FF, D, 2 * FF, ng + 5 * D, (bf16*)(ws + WS_WIN3), CM_FFN}; break;
    default: j = MatJob{a.in[I_FFN_WOUT] + (size_t)3 * FF * D, FF, D, nullptr, (bf16*)(ws + WS_WOUT3), CM_NONE}; break;
    }
    return j;
}
__device__ __forceinline__ void convert_mats(const Ctx& C, const Args& a, int first, int last) {
    LAS float* scr = (LAS float*)(C.lds + C.wave * 16384);
    const int gw = C.vcu * NWAVES + C.wave, NGW = C.G * NWAVES;
    int base = 0;
    for (int mi = first; mi < last; ++mi) {
        const MatJob j = mat_job(C, a, mi); const int cnt = (j.K / 64) * (j.N / 32);
        int it = (gw - base) % NGW; if (it < 0) it += NGW;
        for (; it < cnt; it += NGW) transpose_item(j.W, j.K, j.N, j.g, j.WT, j.mode, scr, it, C.lane);
        base += cnt;
    }
}
__device__ __forceinline__ int t5_bucket(int n) {
    if (n < 16) return n;
    int b = 16;
    b += (n >= 22) + (n >= 30) + (n >= 40) + (n >= 54) + (n >= 73) + (n >= 99) + (n >= 134) + (n >= 182) + (n >= 246) + (n >= 332) + (n >= 450) + (n >= 609) + (n >= 825) + (n >= 1117) + (n >= 1513);
    return b;
}
__device__ __forceinline__ void p_prologue(const Ctx& C, const Args& a) {
    convert_mats(C, a, 0, 10);
    const int gw = C.vcu * NWAVES + C.wave, NGW = C.G * NWAVES;
    {   LAS float* scr = (LAS float*)(C.lds + C.wave * 16384);
        for (int it = gw; it < 2 * NBLK * 8; it += NGW) { const int which = it / (NBLK * 8), r = it % (NBLK * 8), blk = r >> 3, sub = r & 7;
            const float* W = (which ? a.in[I_WX] : a.in[I_WA]) + (size_t)blk * RBLK * RBLK; bf16* WT = (bf16*)(C.ws + (which ? WS_WX : WS_WA)) + (size_t)blk * RBLK * RBLK;
            transpose_item(W, RBLK, RBLK, nullptr, WT, CM_NONE, scr, sub, C.lane); } }
    const float* x = a.in[I_X]; bf16* xb = (bf16*)(C.ws + WS_XB); float* ssq = (float*)(C.ws + WS_SSQ);
    for (int m = gw; m < M; m += NGW) {
        const GAS f32x4* xr = (const GAS f32x4*)(x + (size_t)m * D) + C.lane; f32x4 v[4]; float s = 0.f;
#pragma unroll
        for (int j = 0; j < 4; ++j) { v[j] = xr[64 * j]; s += (v[j].x * v[j].x + v[j].y * v[j].y) + (v[j].z * v[j].z + v[j].w * v[j].w); }
        s = wave_sum(s);
        GAS v2u* o8 = (GAS v2u*)(xb + (size_t)m * D) + C.lane;
#pragma unroll
        for (int j = 0; j < 4; ++j) { v2u w; w.x = pk2(v[j].x, v[j].y); w.y = pk2(v[j].z, v[j].w); o8[64 * j] = w; }
        if (C.lane < 16) ssq[(size_t)m * 16 + C.lane] = (C.lane == 0) ? s : 0.f;
    }
    float* bt = (float*)(C.ws + WS_BIAS); const float* rb = a.in[I_RELB];
    for (int i = blockIdx.x * 512 + C.tid; i < 48 * 129; i += C.G * 512) { const int gh = i / 129, dist = i - gh * 129, g = gh >> 4;
        bt[gh * 132 + dist] = rb[t5_bucket(dist << (2 * g)) * 48 + gh] * LOG2E; }
}

typedef float f32x16 __attribute__((ext_vector_type(16)));
typedef short bf16x8v __attribute__((ext_vector_type(8)));
constexpr int RM_WB = 0, RM_WB_GATE = 64 * 272, RM_UF = 36864, RM_UF_ROW = 272, RM_CW = RM_UF + 256 * RM_UF_ROW, RM_CMP = RM_CW + 2560, RM_END = RM_CMP + 2 * 2 * 8 * 64 * 4;
static_assert(RM_WB + 2 * RM_WB_GATE <= RM_UF && RM_END <= RING_BYTES, "rnn-mid LDS map");
__device__ __forceinline__ bf16x8v pack8(const float (&v)[8]) {
    v4u w; w.x = pg8::cvt_pk_bf16(v[0], v[1]); w.y = pg8::cvt_pk_bf16(v[2], v[3]); w.z = pg8::cvt_pk_bf16(v[4], v[5]); w.w = pg8::cvt_pk_bf16(v[6], v[7]);
    return __builtin_bit_cast(bf16x8v, w);
}
__device__ __forceinline__ void p_rnn_mid(const Ctx& C, const Args& a) {
    const bf16* U = (const bf16*)(C.ws + WS_U); const bf16* Gb = (const bf16*)(C.ws + WS_G); bf16* Y = (bf16*)(C.ws + WS_Y);
    const bf16* WAb = (const bf16*)(C.ws + WS_WA); const bf16* WXb = (const bf16*)(C.ws + WS_WX);
    LAS unsigned char* L = C.lds;
    LAS float* CW = (LAS float*)(L + RM_CW); LAS float* CMP = (LAS float*)(L + RM_CMP);
    const int lane = C.lane, r32 = lane & 31, hh = lane >> 5, wave = C.wave, tid = C.tid;
    for (int item = blockIdx.x; item < BATCH * NBLK * 2; item += C.G) {
        const int b = item / (NBLK * 2), n = (item % (NBLK * 2)) >> 1, half = item & 1;
        __syncthreads();
#pragma unroll
        for (int p = 0; p < 4; ++p) { const int idx = p * 512 + tid, gate = idx >> 10, rem = idx & 1023, row = rem >> 4, c16 = rem & 15;
            const v4u w = *(const v4u*)((gate ? WXb : WAb) + (size_t)(n * 128 + 64 * half + row) * 128 + c16 * 8);
            *(LAS v4u*)(L + RM_WB + gate * RM_WB_GATE + row * 272 + c16 * 16) = w; }
        for (int e = tid; e < 640; e += 512) { const int k = e >> 7, c = e & 127; CW[e] = (k < 4) ? a.in[I_CONV_W][k * DRNN + n * 128 + c] : a.in[I_CONV_B][n * 128 + c]; }
        __syncthreads();
        float ba[2], bx[2], spl[2], Ht[2];
#pragma unroll
        for (int cb = 0; cb < 2; ++cb) { const int ch = n * 128 + 64 * half + 32 * cb + r32; ba[cb] = a.in[I_BA][ch]; bx[cb] = a.in[I_BX][ch];
            spl[cb] = -8.0f * LOG2E * log1pf(expf(-a.in[I_LAM][ch])); Ht[cb] = 0.f; }
        for (int tile = 0; tile < 8; ++tile) {
            const int tposw = tile * 256 + wave * 32;
            const size_t tok0 = (size_t)b * SEQ + tposw;
            bf16x8v af[8];
#pragma unroll
            for (int s = 0; s < 8; ++s) {
                const int c0 = 16 * s + 8 * hh; const bf16* up = U + (tok0 + r32) * DRNN + n * 128 + c0; const int tp = tposw + r32;
                v4u uu[4];
#pragma unroll
                for (int k = 0; k < 4; ++k) { uu[k] = (v4u){0u, 0u, 0u, 0u}; if (tp - (3 - k) >= 0) uu[k] = *(const v4u*)(up - (size_t)(3 - k) * DRNN); }
                float v[8];
                { const f32x4 b0 = *(const LAS f32x4*)(CW + 512 + c0), b1 = *(const LAS f32x4*)(CW + 512 + c0 + 4);
                  v[0] = b0[0]; v[1] = b0[1]; v[2] = b0[2]; v[3] = b0[3]; v[4] = b1[0]; v[5] = b1[1]; v[6] = b1[2]; v[7] = b1[3]; }
#pragma unroll
                for (int k = 0; k < 4; ++k) { const f32x4 w0 = *(const LAS f32x4*)(CW + k * 128 + c0), w1 = *(const LAS f32x4*)(CW + k * 128 + c0 + 4);
                    v[0] += w0[0] * bf_lo(uu[k].x); v[1] += w0[1] * bf_hi(uu[k].x); v[2] += w0[2] * bf_lo(uu[k].y); v[3] += w0[3] * bf_hi(uu[k].y);
                    v[4] += w1[0] * bf_lo(uu[k].z); v[5] += w1[1] * bf_hi(uu[k].z); v[6] += w1[2] * bf_lo(uu[k].w); v[7] += w1[3] * bf_hi(uu[k].w); }
                af[s] = pack8(v);
                if ((s >> 2) == half) { LAS float* d = (LAS float*)(L + RM_UF + (wave * 32 + r32) * RM_UF_ROW) + (c0 - 64 * half);
                    *(LAS f32x4*)d = (f32x4){v[0], v[1], v[2], v[3]}; *(LAS f32x4*)(d + 4) = (f32x4){v[4], v[5], v[6], v[7]}; }
            }
            f32x16 acc[2][2];
#pragma unroll
            for (int gt = 0; gt < 2; ++gt)
#pragma unroll
                for (int cb = 0; cb < 2; ++cb)
#pragma unroll
                    for (int e = 0; e < 16; ++e) acc[gt][cb][e] = 0.f;
#pragma unroll
            for (int s = 0; s < 8; ++s)
#pragma unroll
                for (int gt = 0; gt < 2; ++gt)
#pragma unroll
                    for (int cb = 0; cb < 2; ++cb) {
                        const bf16x8v bfr = *(const LAS bf16x8v*)(L + RM_WB + gt * RM_WB_GATE + (32 * cb + r32) * 272 + (16 * s + 8 * hh) * 2);
                        acc[gt][cb] = __builtin_amdgcn_mfma_f32_32x32x16_bf16(af[s], bfr, acc[gt][cb], 0, 0, 0);
                    }
            float gv[2][16];
#pragma unroll
            for (int cb = 0; cb < 2; ++cb)
#pragma unroll
                for (int e = 0; e < 16; ++e) {
                    const int tl = (e & 3) + 8 * (e >> 2) + 4 * hh;
                    const float uf = *((const LAS float*)(L + RM_UF + (wave * 32 + tl) * RM_UF_ROW) + 32 * cb + r32);
                    const float r = fast_sigmoid(acc[0][cb][e] + ba[cb]), ii = fast_sigmoid(acc[1][cb][e] + bx[cb]);
                    const float av = __builtin_amdgcn_exp2f(r * spl[cb]);
                    const float bv = __builtin_amdgcn_sqrtf(fmaxf(1.f - av * av, 0.f)) * (ii * uf);
                    acc[0][cb][e] = av; acc[1][cb][e] = bv;
                    gv[cb][e] = bf2f(Gb[(tok0 + tl) * DRNN + n * 128 + 64 * half + 32 * cb + r32]);
                }
            float A0[2][4], B0[2][4], A1[2][4], B1[2][4];
            const int par = tile & 1;
#pragma unroll
            for (int cb = 0; cb < 2; ++cb) {
                float Aw = 1.f, Bw = 0.f;
#pragma unroll
                for (int q = 0; q < 4; ++q) {
                    const float a0 = acc[0][cb][4 * q], a1 = acc[0][cb][4 * q + 1], a2 = acc[0][cb][4 * q + 2], a3 = acc[0][cb][4 * q + 3];
                    const float Ag = (a0 * a1) * (a2 * a3);
                    const float Bg = ((acc[1][cb][4 * q] * a1 + acc[1][cb][4 * q + 1]) * a2 + acc[1][cb][4 * q + 2]) * a3 + acc[1][cb][4 * q + 3];
                    const float pA = __shfl_xor(Ag, 32), pB = __shfl_xor(Bg, 32);
                    A0[cb][q] = hh ? pA : Ag; B0[cb][q] = hh ? pB : Bg; A1[cb][q] = hh ? Ag : pA; B1[cb][q] = hh ? Bg : pB;
                    Bw = Bw * A0[cb][q] + B0[cb][q]; Aw *= A0[cb][q]; Bw = Bw * A1[cb][q] + B1[cb][q]; Aw *= A1[cb][q];
                }
                if (hh == 0) { CMP[((par * 2 + 0) * 8 + wave) * 64 + 32 * cb + r32] = Aw; CMP[((par * 2 + 1) * 8 + wave) * 64 + 32 * cb + r32] = Bw; }
            }
            __syncthreads();
#pragma unroll
            for (int cb = 0; cb < 2; ++cb) {
                float h = Ht[cb], hin = 0.f;
#pragma unroll
                for (int v = 0; v < 8; ++v) { const float Av = CMP[((par * 2 + 0) * 8 + v) * 64 + 32 * cb + r32], Bv = CMP[((par * 2 + 1) * 8 + v) * 64 + 32 * cb + r32];
                    hin = (v == wave) ? h : hin; h = Av * h + Bv; }
                Ht[cb] = h;
                float hc = hin;
#pragma unroll
                for (int q = 0; q < 4; ++q) {
                    const float c0 = hc; hc = A0[cb][q] * hc + B0[cb][q]; const float c1 = hc; hc = A1[cb][q] * hc + B1[cb][q];
                    float hv = hh ? c1 : c0;
#pragma unroll
                    for (int i = 0; i < 4; ++i) { const int e = 4 * q + i; hv = acc[0][cb][e] * hv + acc[1][cb][e];
                        const int tl = (e & 3) + 8 * (e >> 2) + 4 * hh;
                        Y[(tok0 + tl) * DRNN + n * 128 + 64 * half + 32 * cb + r32] = (bf16)f2bf(hv * gv[cb][e]); }
                }
            }
        }
    }
}
typedef short v4i16_t __attribute__((ext_vector_type(4)));
__device__ __forceinline__ v4i16_t vtr16(const LAS unsigned char* p) { return __builtin_amdgcn_ds_read_tr16_b64_v4i16((LAS v4i16_t*)p); }
constexpr int AT_EXT = 0, AT_VT = 1024;
__device__ __forceinline__ void p_attn(const Ctx& C) {
    bf16* QKV = (bf16*)(C.ws + WS_QKV); float* LSE = (float*)(C.ws + WS_LSE); const float* bt = (const float*)(C.ws + WS_BIAS);
    const size_t SLAB = (size_t)M * 1024;
    LAS float* ext = (LAS float*)(C.lds + AT_EXT);
    LAS unsigned char* vt = C.lds + AT_VT + C.wave * 4096;
    const int lane = C.lane, r32 = lane & 31, hh = lane >> 5, wave = C.wave, tid = C.tid;
    const int vtr_off = (4 * hh + ((lane & 15) >> 2)) * 64 + ((lane >> 4) & 1) * 32 + (lane & 3) * 8;
    for (int it = blockIdx.x; it < NGRP * BATCH * NHEAD * 8; it += C.G) {
        const int g = it >> 10, rem = it & 1023, bh = rem >> 3, chunk = (rem + (it >> 8)) & 7, l2d = 2 * g, L = SEQ >> l2d;
        const int llin0 = chunk * 256 + wave * 32, l0 = llin0 & (L - 1);
        bf16* qbase = QKV + (size_t)g * SLAB + ((size_t)bh * SEQ + llin0) * HD;
        const bf16* kres = qbase + 3 * SLAB - (size_t)l0 * HD; const bf16* vres = qbase + 6 * SLAB - (size_t)l0 * HD;
        __syncthreads();
        if (tid < 192) { const int dist = tid - 32; ext[tid] = (dist >= 0 && dist <= 128) ? bt[(g * 16 + (bh & 15)) * 132 + dist] : -1e30f; }
        __syncthreads();
        bf16x8v qf[4];
#pragma unroll
        for (int s = 0; s < 4; ++s) qf[s] = *(const bf16x8v*)(qbase + r32 * HD + 16 * s + 8 * hh);
        f32x16 o0, o1;
#pragma unroll
        for (int e = 0; e < 16; ++e) { o0[e] = 0.f; o1[e] = 0.f; }
        float mrow = -1e30f, lsum = 0.f;
        const int kb_lo = (l0 - 128) > 0 ? (l0 - 128) : 0;
        for (int kb = l0; kb >= kb_lo; kb -= 32) {
            const bf16* kblk = kres + (size_t)kb * HD; const bf16* vblk = vres + (size_t)kb * HD;
            v4u vv[4];
#pragma unroll
            for (int i = 0; i < 4; ++i) vv[i] = *(const v4u*)(vblk + (lane >> 1) * HD + (lane & 1) * 32 + 8 * i);
            bf16x8v kf[4];
#pragma unroll
            for (int s = 0; s < 4; ++s) kf[s] = *(const bf16x8v*)(kblk + r32 * HD + 16 * s + 8 * hh);
#pragma unroll
            for (int i = 0; i < 4; ++i) *(LAS v4u*)(vt + (lane & 1) * 2048 + (lane >> 1) * 64 + 16 * i) = vv[i];
            f32x16 p;
#pragma unroll
            for (int e = 0; e < 16; ++e) p[e] = 0.f;
#pragma unroll
            for (int s = 0; s < 4; ++s) p = __builtin_amdgcn_mfma_f32_32x32x16_bf16(kf[s], qf[s], p, 0, 0, 0);
            const int eb = l0 + r32 - kb - 4 * hh + 32;
            float bm = -1e30f;
#pragma unroll
            for (int e = 0; e < 16; ++e) { p[e] += ext[eb - ((e & 3) + 8 * (e >> 2))]; bm = fmaxf(bm, p[e]); }
            bm = fmaxf(bm, __shfl_xor(bm, 32));
            const float mn = fmaxf(mrow, bm), alpha = __builtin_amdgcn_exp2f(mrow - mn); mrow = mn;
            float ps = 0.f;
#pragma unroll
            for (int e = 0; e < 16; ++e) { p[e] = __builtin_amdgcn_exp2f(p[e] - mn); ps += p[e]; }
            lsum = lsum * alpha + ps;
#pragma unroll
            for (int e = 0; e < 16; ++e) { o0[e] *= alpha; o1[e] *= alpha; }
            bf16x8v pf[2];
#pragma unroll
            for (int s = 0; s < 2; ++s) { const float t8[8] = {p[8 * s], p[8 * s + 1], p[8 * s + 2], p[8 * s + 3], p[8 * s + 4], p[8 * s + 5], p[8 * s + 6], p[8 * s + 7]}; pf[s] = pack8(t8); }
#pragma unroll
            for (int s = 0; s < 2; ++s) {
                const v4i16_t a00 = vtr16(vt + 0 * 2048 + (16 * s) * 64 + vtr_off), a01 = vtr16(vt + 0 * 2048 + (16 * s + 8) * 64 + vtr_off);
                const v4i16_t a10 = vtr16(vt + 1 * 2048 + (16 * s) * 64 + vtr_off), a11 = vtr16(vt + 1 * 2048 + (16 * s + 8) * 64 + vtr_off);
                const bf16x8v va0 = (bf16x8v){a00[0], a00[1], a00[2], a00[3], a01[0], a01[1], a01[2], a01[3]};
                const bf16x8v va1 = (bf16x8v){a10[0], a10[1], a10[2], a10[3], a11[0], a11[1], a11[2], a11[3]};
                o0 = __builtin_amdgcn_mfma_f32_32x32x16_bf16(va0, pf[s], o0, 0, 0, 0);
                o1 = __builtin_amdgcn_mfma_f32_32x32x16_bf16(va1, pf[s], o1, 0, 0, 0);
            }
        }
        const float ltot = lsum + __shfl_xor(lsum, 32), inv = 1.f / ltot;
        bf16* orow = qbase + r32 * HD;
#pragma unroll
        for (int q = 0; q < 4; ++q) {
            v2u w0, w1;
            w0.x = pg8::cvt_pk_bf16(o0[4 * q] * inv, o0[4 * q + 1] * inv); w0.y = pg8::cvt_pk_bf16(o0[4 * q + 2] * inv, o0[4 * q + 3] * inv);
            w1.x = pg8::cvt_pk_bf16(o1[4 * q] * inv, o1[4 * q + 1] * inv); w1.y = pg8::cvt_pk_bf16(o1[4 * q + 2] * inv, o1[4 * q + 3] * inv);
            *(v2u*)(orow + 8 * q + 4 * hh) = w0; *(v2u*)(orow + 32 + 8 * q + 4 * hh) = w1;
        }
        if (hh == 0) { const int llin = llin0 + r32, rres = llin >> (11 - l2d), l = llin & (L - 1), t = (l << l2d) + rres, row = (bh >> 4) * SEQ + t;
            LSE[((size_t)g * M + row) * 16 + (bh & 15)] = mrow + log2f(ltot); }
    }
}
__device__ __forceinline__ void p_merge(const Ctx& C, const Args& a) {
    const bf16* QKV = (const bf16*)(C.ws + WS_QKV); const float* LSE = (const float*)(C.ws + WS_LSE); bf16* ATT = (bf16*)(C.ws + WS_ATT);
    for (int idx = blockIdx.x * 512 + C.tid; idx < M * 16 * 8; idx += C.G * 512) {
        const int ch = idx & 7, h = (idx >> 3) & 15, row = idx >> 7, b = row >> 11, t = row & 2047;
        float ls[3], mxl = -INFINITY;
#pragma unroll
        for (int g = 0; g < 3; ++g) { ls[g] = LSE[((size_t)g * M + row) * 16 + h]; mxl = fmaxf(mxl, ls[g]); }
        float acc[8], wsum = 0.f;
#pragma unroll
        for (int e = 0; e < 8; ++e) acc[e] = 0.f;
#pragma unroll
        for (int g = 0; g < 3; ++g) { const float w = exp2f(ls[g] - mxl); wsum += w; const int l2d = 2 * g, rres = t & ((1 << l2d) - 1), l = t >> l2d, L = SEQ >> l2d;
            const v4u v = *(const v4u*)(QKV + (size_t)g * ((size_t)M * 1024) + ((size_t)(b * 16 + h) * SEQ + rres * L + l) * HD + 8 * ch);
            acc[0] += w * bf_lo(v.x); acc[1] += w * bf_hi(v.x); acc[2] += w * bf_lo(v.y); acc[3] += w * bf_hi(v.y); acc[4] += w * bf_lo(v.z); acc[5] += w * bf_hi(v.z); acc[6] += w * bf_lo(v.w); acc[7] += w * bf_hi(v.w); }
        const float inv = 1.f / wsum; v4u o; o.x = pk2(acc[0] * inv, acc[1] * inv); o.y = pk2(acc[2] * inv, acc[3] * inv); o.z = pk2(acc[4] * inv, acc[5] * inv); o.w = pk2(acc[6] * inv, acc[7] * inv);
        *(v4u*)(ATT + (size_t)row * 1024 + h * 64 + 8 * ch) = o;
    }
    convert_mats(C, a, 10, 12);
}

enum { PH_PROLOGUE = 0, PH_FFN_IN_0, PH_FFN_OUT_0, PH_RNN_IN, PH_RNN_MID, PH_RNN_OUT, PH_FFN_IN_1, PH_FFN_OUT_1,
       PH_FFN_IN_2, PH_FFN_OUT_2, PH_QKV, PH_ATTN, PH_MERGE, PH_WO, PH_FFN_IN_3, PH_FFN_OUT_3, NPHASE };

__global__ void __launch_bounds__(NWAVES * 64, 2) fwd_kernel(Args args) {
    extern __shared__ __attribute__((aligned(16))) unsigned char lds_raw[];
    Ctx C; C.lds = (LAS unsigned char*)lds_raw; C.tid = threadIdx.x; C.lane = C.tid & 63; C.wave = __builtin_amdgcn_readfirstlane(C.tid >> 6);
    C.G = gridDim.x; { const int bx = blockIdx.x; C.vcu = (C.G % 8 == 0) ? (bx % 8) * (C.G / 8) + bx / 8 : bx; }
    C.ws = args.ws;
    volatile LAS unsigned* MISC = (volatile LAS unsigned*)(C.lds + MISC_OFF);
    for (int u = C.tid; u < (LDS_BYTES - LDSCTL_OFF) / 4; u += NWAVES * 64) ((LAS unsigned*)(C.lds + LDSCTL_OFF))[u] = 0u;
    __syncthreads();
    unsigned* ctl = (unsigned*)args.ws;
    XcdBarrier bar; bar.bar = ctl + CW_BAR; bar.x = 0; bar.st = nullptr;
    const bool multi = (args.ph_hi - args.ph_lo) > 1;
    if (multi) bar = xcd_barrier_post(ctl + CW_BAR, MISC + 8);
    unsigned char* ws = args.ws;
    float* ssq = (float*)(ws + WS_SSQ); bf16* xb = (bf16*)(ws + WS_XB);
    for (int ph = args.ph_lo; ph < args.ph_hi; ++ph) {
        { int t_ = threadIdx.x; asm volatile("" : "+v"(t_)); C.tid = t_; C.lane = t_ & 63; }
        switch (ph) {
        case PH_PROLOGUE: p_prologue(C, args); break;
        case PH_FFN_IN_0: case PH_FFN_IN_1: case PH_FFN_IN_2: case PH_FFN_IN_3: {
            const bf16* Bt = (const bf16*)(ws + (ph == PH_FFN_IN_0 ? WS_WIN0 : ph == PH_FFN_IN_1 ? WS_WIN1 : ph == PH_FFN_IN_2 ? WS_WIN2 : WS_WIN3));
            bf16* act = (bf16*)(ws + (ph == PH_FFN_IN_3 ? WS_ACT3 : WS_ACT));
            pg8::Gemm g{xb, Bt, M, 2 * FF, D}; pg8::StaticOrder S; S.init(M, 2 * FF, C.G, (int)blockIdx.x);
            EpiSwiGLU E{ssq, act};
            pg8::gemm_phase<EpiSwiGLU, pg8::StaticOrder, true, true>(C.lds, g, S, E);
        } break;
        case PH_FFN_OUT_0: case PH_FFN_OUT_1: case PH_FFN_OUT_2: case PH_FFN_OUT_3: case PH_RNN_OUT: case PH_WO: {
            const bf16* A; const bf16* Bt; int K; float scale = 0.5f; const float* xin = args.out;
            if (ph == PH_FFN_OUT_0) { A = (const bf16*)(ws + WS_ACT); Bt = (const bf16*)(ws + WS_WOUT0); K = FF; xin = args.in[I_X]; }
            else if (ph == PH_FFN_OUT_1) { A = (const bf16*)(ws + WS_ACT); Bt = (const bf16*)(ws + WS_WOUT1); K = FF; }
            else if (ph == PH_FFN_OUT_2) { A = (const bf16*)(ws + WS_ACT); Bt = (const bf16*)(ws + WS_WOUT2); K = FF; }
            else if (ph == PH_FFN_OUT_3) { A = (const bf16*)(ws + WS_ACT3); Bt = (const bf16*)(ws + WS_WOUT3); K = FF; }
            else if (ph == PH_RNN_OUT) { A = (const bf16*)(ws + WS_Y); Bt = (const bf16*)(ws + WS_WROUT); K = DRNN; scale = 1.f; }
            else { A = (const bf16*)(ws + WS_ATT); Bt = (const bf16*)(ws + WS_WO); K = D; scale = 1.f; }
            pg8::Gemm g{A, Bt, M, D, K}; pg8::StaticOrder S; S.init(M, D, C.G, (int)blockIdx.x);
            EpiRes E{xin, args.out, xb, ssq, scale};
            pg8::gemm_phase<EpiRes, pg8::StaticOrder, false, true>(C.lds, g, S, E);
        } break;
        case PH_RNN_IN: {
            pg8::Gemm g{xb, (const bf16*)(ws + WS_WRIN), M, 2 * DRNN, D}; pg8::StaticOrder S; S.init(M, 2 * DRNN, C.G, (int)blockIdx.x);
            EpiRnnIn E{ssq, (bf16*)(ws + WS_G), (bf16*)(ws + WS_U)};
            pg8::gemm_phase<EpiRnnIn, pg8::StaticOrder, true, true>(C.lds, g, S, E);
        } break;
        case PH_RNN_MID: p_rnn_mid(C, args); break;
        case PH_QKV: {
            pg8::Gemm g{xb, (const bf16*)(ws + WS_WQKV), M, NQKV, D}; pg8::StaticOrder S; S.init(M, NQKV, C.G, (int)blockIdx.x);
            EpiQKV E{ssq, args.in[I_QGAIN], args.in[I_KGAIN], (bf16*)(ws + WS_QKV)};
            pg8::gemm_phase<EpiQKV, pg8::StaticOrder, true, true>(C.lds, g, S, E);
        } break;
        case PH_ATTN: p_attn(C); break;
        case PH_MERGE: p_merge(C, args); break;
        default: break;
        }
        if (ph + 1 < args.ph_hi) xcd_barrier(bar);
    }
}

extern "C" void kernel_launch(void* const* d_in, const int* in_sizes, int n_in, void* d_out, int out_size, void* d_ws, size_t ws_size, hipStream_t stream) {
    static int grid = 0;
    if (grid == 0) {
        if (n_in != 18 || in_sizes[0] != M * D || out_size != M * D || ws_size < WS_END) { fprintf(stderr, "kernel_launch: unexpected shapes (n_in %d, in0 %d, out %d, ws %zu)\n", n_in, n_in > 0 ? in_sizes[0] : -1, out_size, ws_size); grid = -1; return; }
        int dev = 0, cus = 0, per_cu = 0;
        if (hipGetDevice(&dev) != hipSuccess || hipDeviceGetAttribute(&cus, hipDeviceAttributeMultiprocessorCount, dev) != hipSuccess) { fprintf(stderr, "kernel_launch: device query failed\n"); grid = -1; return; }
        if (hipFuncSetAttribute((const void*)fwd_kernel, hipFuncAttributeMaxDynamicSharedMemorySize, LDS_BYTES) != hipSuccess) { fprintf(stderr, "kernel_launch: hipFuncSetAttribute failed\n"); grid = -1; return; }
        if (hipOccupancyMaxActiveBlocksPerMultiprocessor(&per_cu, (const void*)fwd_kernel, NWAVES * 64, LDS_BYTES) != hipSuccess || per_cu < 1) { fprintf(stderr, "kernel_launch: occupancy query says %d blocks per CU\n", per_cu); (void)hipGetLastError(); grid = -1; return; }
        grid = cus;
    }
    if (grid < 0) return;
    if (hipMemsetAsync(d_ws, 0, CTL_ZERO_BYTES, stream) != hipSuccess) { fprintf(stderr, "kernel_launch: memset failed\n"); return; }
    Args a{};
    for (int i = 0; i < 18; ++i) a.in[i] = (const float*)d_in[i];
    a.out = (float*)d_out; a.ws = (unsigned char*)d_ws;
#if SINGLE_LAUNCH
    a.ph_lo = 0; a.ph_hi = NPHASE;
    hipLaunchKernelGGL(fwd_kernel, dim3(grid), dim3(NWAVES * 64), LDS_BYTES, stream, a);
#else
    for (int ph = 0; ph < NPHASE; ++ph) { a.ph_lo = ph; a.ph_hi = ph + 1; hipLaunchKernelGGL(fwd_kernel, dim3(grid), dim3(NWAVES * 64), LDS_BYTES, stream, a); }
#endif
}
```

```cpp
#include <hip/hip_runtime.h>
#include <cstdio>
#include <cstdint>

#ifndef SINGLE_LAUNCH
#define SINGLE_LAUNCH 1
#define DUP_MASK 0u
#define DUP_N 1
#endif

namespace pg8 {
#define PG8_LAS __attribute__((address_space(3)))
typedef unsigned short bf16_t;
typedef short bf16x8 __attribute__((ext_vector_type(8)));
typedef float f32x4 __attribute__((ext_vector_type(4)));
typedef unsigned u32x4 __attribute__((ext_vector_type(4)));
constexpr int BM = 256, BK = 64, HALF = 128, HTB = HALF * BK * 2, STAGE_BYTES = 8 * HTB, NXCD = 8, WGM = 8;

__host__ __device__ __forceinline__ int lds_byte(int r, int c) { const int st = (r >> 4) * 2 + (c >> 5), rr = r & 15, cc = c & 31, ob = rr * 64 + cc * 2; return st * 1024 + (ob ^ (((ob >> 9) & 1) << 5)); }
__host__ __device__ __forceinline__ void stage_rc(int b, int& R, int& C) { const int st = b / 1024, sb = b % 1024, swz = sb ^ (((sb >> 9) & 1) << 5); R = (st >> 1) * 16 + swz / 64; C = (st & 1) * 32 + (swz % 64) / 2; }
__host__ __device__ __forceinline__ int perm32(int rho) { const int n = rho >> 4, i = rho & 15; return 8 * (i >> 2) + 4 * n + (i & 3); }

struct Unit { int pm, pn; };
struct Gemm { const bf16_t* A; const bf16_t* Bt; int M, N, K; };

struct StaticOrder {
    int nM, nN, nwg, G, c;
    __host__ __device__ void init(int M, int N, int G_, int c_) { nM = M / BM; nN = N / BM; nwg = nM * nN; G = G_; c = c_; }
    __host__ __device__ bool next(int i, Unit& u) const {
        const long L = (long)i * G + c; if (L >= nwg) return false;
        int wgid = (int)L; { const int q = nwg / NXCD, r = nwg % NXCD, xcd = wgid % NXCD, off = wgid / NXCD; wgid = (xcd < r ? xcd * (q + 1) : r * (q + 1) + (xcd - r) * q) + off; }
        const int nig = WGM * nN, gid = wgid / nig, fm = gid * WGM, gsz = (nM - fm) < WGM ? (nM - fm) : WGM;
        u.pm = fm + ((wgid % nig) % gsz); u.pn = (wgid % nig) / gsz; return true;
    }
    __device__ __forceinline__ void a_ready(const Unit&) const {}
    __device__ __forceinline__ void done(const Unit&) const {}
};

__device__ __forceinline__ unsigned cvt_pk_bf16(float lo, float hi) { unsigned r; asm volatile("v_cvt_pk_bf16_f32 %0, %1, %2" : "=v"(r) : "v"(lo), "v"(hi)); return r; }

template <class Epi, class Sched, bool ALIGN_EPI = false, bool SP2 = false>
__device__ __forceinline__ void gemm_phase(PG8_LAS unsigned char* lds, const Gemm g, const Sched& S, const Epi& E) {
    int tid_ = threadIdx.x; asm volatile("" : "+v"(tid_));
    const int tid = tid_, wid = __builtin_amdgcn_readfirstlane(tid >> 6), lane = tid & 63, wr = wid >> 2, wc = wid & 3, fr = lane & 15, fq = lane >> 4;
    const int K = g.K, nt = K / BK;
    unsigned voffA[2], voffB[2];
#pragma unroll
    for (int i = 0; i < 2; ++i) { int R, C; stage_rc(tid * 16 + i * 8192, R, C); const int Rb = Epi::PERM ? ((R & ~31) + perm32(R & 31)) : R;
        voffA[i] = (unsigned)(R * K + C) * 2u; voffB[i] = (unsigned)(Rb * K + C) * 2u; }
    const size_t kstep = (size_t)(BK * 2);
    const size_t hstep = (size_t)HALF * K * 2;
    const size_t tstep = 2 * hstep;
    const unsigned ldsw = (unsigned)wid * 1024u;
    const int aoff = lds_byte(wr * 64 + fr, fq * 8), boff = lds_byte(wc * 32 + fr, fq * 8);
#define PG8_SA(b, h) (((b) * 2 + (h)) * HTB)
#define PG8_SB(b, h) ((4 + (b) * 2 + (h)) * HTB)
#define PG8_STAGE(bufoff, gbase, voff) do { _Pragma("unroll") for (int _i = 0; _i < 2; ++_i) \
        __builtin_amdgcn_global_load_lds((const unsigned*)((const char*)(gbase) + (voff)[_i]), (PG8_LAS unsigned*)(lds + (bufoff) + ldsw + _i * 8192), 16, 0, 0); } while (0)
#define PG8_LDA(dst, b, h) do { _Pragma("unroll") for (int m = 0; m < 4; ++m) _Pragma("unroll") for (int k = 0; k < 2; ++k) dst[m][k] = *(const PG8_LAS bf16x8*)(lds + PG8_SA(b, h) + aoff + m * 2048 + k * 1024); } while (0)
#define PG8_LDB(dst, b, h) do { _Pragma("unroll") for (int n = 0; n < 2; ++n) _Pragma("unroll") for (int k = 0; k < 2; ++k) dst[n][k] = *(const PG8_LAS bf16x8*)(lds + PG8_SB(b, h) + boff + n * 2048 + k * 1024); } while (0)
#define PG8_MMA(ai, bj, At, Bt) do { __builtin_amdgcn_s_setprio(1); _Pragma("unroll") for (int m = 0; m < 4; ++m) _Pragma("unroll") for (int n = 0; n < 2; ++n) _Pragma("unroll") for (int k = 0; k < 2; ++k) \
        acc[ai][bj][m][n] = __builtin_amdgcn_mfma_f32_16x16x32_bf16(Bt[n][k], At[m][k], acc[ai][bj][m][n], 0, 0, 0); __builtin_amdgcn_s_setprio(0); } while (0)
#define PG8_WAIT_V(n) asm volatile("s_waitcnt vmcnt(" #n ")" ::: "memory")
#define PG8_WAIT_L(n) asm volatile("s_waitcnt lgkmcnt(" #n ")" ::: "memory")
#define PG8_BAR __builtin_amdgcn_s_barrier()
#define PG8_SCHED __builtin_amdgcn_sched_barrier(0)
    Unit cur, nxt; int ui = 0;
    if (!S.next(0, cur)) return;
    f32x4 acc[2][2][4][2];
#pragma unroll
    for (int a = 0; a < 2; ++a)
#pragma unroll
        for (int b = 0; b < 2; ++b)
#pragma unroll
            for (int m = 0; m < 4; ++m)
#pragma unroll
                for (int n = 0; n < 2; ++n) acc[a][b][m][n] = (f32x4){0.f, 0.f, 0.f, 0.f};
    bf16x8 At[4][2], B0[2][2], B1[2][2];
    const char* cA = (const char*)g.A + (size_t)cur.pm * tstep; const char* cB = (const char*)g.Bt + (size_t)cur.pn * tstep;
    S.a_ready(cur);
    if constexpr (SP2) {
        PG8_STAGE(PG8_SB(0, 0), cB, voffB); PG8_STAGE(PG8_SB(0, 1), cB + hstep, voffB); PG8_STAGE(PG8_SA(0, 0), cA, voffA); PG8_STAGE(PG8_SA(0, 1), cA + hstep, voffA);
        if (wr == 1) PG8_BAR;
        PG8_WAIT_V(2); PG8_BAR;
        PG8_STAGE(PG8_SB(1, 0), cB + kstep, voffB); PG8_STAGE(PG8_SA(1, 0), cA + kstep, voffA); PG8_STAGE(PG8_SB(1, 1), cB + hstep + kstep, voffB);
        PG8_WAIT_V(6); PG8_BAR;
    } else {
        PG8_STAGE(PG8_SB(0, 0), cB, voffB); PG8_STAGE(PG8_SA(0, 0), cA, voffA); PG8_STAGE(PG8_SB(0, 1), cB + hstep, voffB); PG8_STAGE(PG8_SA(0, 1), cA + hstep, voffA);
        if (wr == 1) PG8_BAR;
        PG8_WAIT_V(4); PG8_BAR;
        PG8_STAGE(PG8_SB(1, 0), cB + kstep, voffB); PG8_STAGE(PG8_SA(1, 0), cA + kstep, voffA); PG8_STAGE(PG8_SB(1, 1), cB + hstep + kstep, voffB);
        PG8_WAIT_V(6); PG8_BAR;
    }
    for (;;) {
        const bool has_next = S.next(ui + 1, nxt);
        const char* nA = has_next ? (const char*)g.A + (size_t)nxt.pm * tstep : cA; const char* nB = has_next ? (const char*)g.Bt + (size_t)nxt.pn * tstep : cB;
        for (int t = 0; t < nt; t += 2) {
            const bool last = (t == nt - 2);
            const char* a1 = cA + (size_t)(t + 1) * kstep;
            const char* a2 = last ? nA : cA + (size_t)(t + 2) * kstep; const char* b2 = last ? nB : cB + (size_t)(t + 2) * kstep;
            const char* a3 = a2 + kstep; const char* b3 = b2 + kstep;
            if (last && has_next) S.a_ready(nxt);
            if constexpr (SP2) {
            PG8_LDB(B0, 0, 0); PG8_LDB(B1, 0, 1); PG8_SCHED; PG8_LDA(At, 0, 0); PG8_STAGE(PG8_SA(1, 1), a1 + hstep, voffA);
            PG8_WAIT_V(8); PG8_WAIT_L(0); PG8_BAR; PG8_MMA(0, 0, At, B0); PG8_MMA(0, 1, At, B1); PG8_BAR; PG8_SCHED;
            PG8_LDA(At, 0, 1); PG8_STAGE(PG8_SB(0, 0), b2, voffB); PG8_STAGE(PG8_SB(0, 1), b2 + hstep, voffB); PG8_STAGE(PG8_SA(0, 0), a2, voffA);
            PG8_WAIT_V(8); PG8_WAIT_L(0); PG8_BAR; PG8_MMA(1, 0, At, B0); PG8_MMA(1, 1, At, B1); PG8_BAR; PG8_SCHED;
            PG8_LDB(B0, 1, 0); PG8_LDB(B1, 1, 1); PG8_SCHED; PG8_LDA(At, 1, 0); PG8_STAGE(PG8_SA(0, 1), a2 + hstep, voffA);
            PG8_WAIT_V(8); PG8_WAIT_L(0); PG8_BAR; PG8_MMA(0, 0, At, B0); PG8_MMA(0, 1, At, B1); PG8_BAR; PG8_SCHED;
            PG8_LDA(At, 1, 1); PG8_STAGE(PG8_SB(1, 0), b3, voffB); PG8_STAGE(PG8_SB(1, 1), b3 + hstep, voffB); PG8_STAGE(PG8_SA(1, 0), a3, voffA);
            PG8_WAIT_V(8); PG8_WAIT_L(0); PG8_BAR; PG8_MMA(1, 0, At, B0); PG8_MMA(1, 1, At, B1); PG8_BAR; PG8_SCHED;
            } else {
            PG8_LDB(B0, 0, 0); PG8_SCHED; PG8_LDA(At, 0, 0); PG8_STAGE(PG8_SA(1, 1), a1 + hstep, voffA);
            PG8_WAIT_L(8); PG8_BAR; PG8_WAIT_L(0); PG8_MMA(0, 0, At, B0); PG8_BAR; PG8_SCHED;
            PG8_LDB(B1, 0, 1); PG8_STAGE(PG8_SB(0, 0), b2, voffB);
            PG8_BAR; PG8_WAIT_L(0); PG8_MMA(0, 1, At, B1); PG8_BAR;
            PG8_LDA(At, 0, 1); PG8_STAGE(PG8_SA(0, 0), a2, voffA);
            PG8_BAR; PG8_WAIT_L(0); PG8_MMA(1, 0, At, B0); PG8_BAR; PG8_SCHED;
            PG8_STAGE(PG8_SB(0, 1), b2 + hstep, voffB);
            PG8_WAIT_V(6); PG8_BAR; PG8_MMA(1, 1, At, B1); PG8_BAR;
            PG8_LDB(B0, 1, 0); PG8_SCHED; PG8_LDA(At, 1, 0); PG8_STAGE(PG8_SA(0, 1), a2 + hstep, voffA);
            PG8_WAIT_L(8); PG8_BAR; PG8_WAIT_L(0); PG8_MMA(0, 0, At, B0); PG8_BAR; PG8_SCHED;
            PG8_LDB(B1, 1, 1); PG8_STAGE(PG8_SB(1, 0), b3, voffB);
            PG8_BAR; PG8_WAIT_L(0); PG8_MMA(0, 1, At, B1); PG8_BAR;
            PG8_LDA(At, 1, 1); PG8_STAGE(PG8_SA(1, 0), a3, voffA);
            PG8_BAR; PG8_WAIT_L(0); PG8_MMA(1, 0, At, B0); PG8_BAR; PG8_SCHED;
            PG8_STAGE(PG8_SB(1, 1), b3 + hstep, voffB);
            PG8_WAIT_V(6); PG8_BAR; PG8_MMA(1, 1, At, B1); PG8_BAR;
            }
        }
        if constexpr (ALIGN_EPI) { if (wr == 0) PG8_BAR; }
        E(acc, cur, wr, wc, fr, fq); S.done(cur);
        if (!has_next) break;
#pragma unroll
        for (int a = 0; a < 2; ++a)
#pragma unroll
            for (int b = 0; b < 2; ++b)
#pragma unroll
                for (int m = 0; m < 4; ++m)
#pragma unroll
                    for (int n = 0; n < 2; ++n) acc[a][b][m][n] = (f32x4){0.f, 0.f, 0.f, 0.f};
        cur = nxt; cA = nA; cB = nB; ++ui;
        if constexpr (ALIGN_EPI) { if (wr == 1) PG8_BAR; }
    }
    PG8_WAIT_V(0);
    if constexpr (!ALIGN_EPI) { if (wr == 0) PG8_BAR; }
    PG8_BAR;
#undef PG8_SA
#undef PG8_SB
#undef PG8_STAGE
#undef PG8_LDA
#undef PG8_LDB
#undef PG8_MMA
#undef PG8_WAIT_V
#undef PG8_WAIT_L
#undef PG8_BAR
#undef PG8_SCHED
}
}

constexpr int BATCH = 8, SEQ = 2048, D = 1024, M = BATCH * SEQ;
constexpr int FF = 2816, DRNN = 1280, NBLK = 10, RBLK = 128, CONVW = 4;
constexpr int NHEAD = 16, HD = 64, NGRP = 3, NQKV = 9216;
constexpr float RMS_EPS = 1e-6f;
constexpr float LOG2E = 1.4426950408889634f;
constexpr int NWAVES = 8;

typedef unsigned short bf16;
typedef unsigned v4u __attribute__((ext_vector_type(4)));
typedef unsigned v2u __attribute__((ext_vector_type(2)));
typedef float f32x4 __attribute__((ext_vector_type(4)));
#define GAS __attribute__((address_space(1)))
#define LAS __attribute__((address_space(3)))
typedef GAS unsigned gu32;
#define RLX_AGENT __ATOMIC_RELAXED, __HIP_MEMORY_SCOPE_AGENT
#define LDS_WAIT() asm volatile("s_waitcnt lgkmcnt(0)" ::: "memory")

constexpr size_t MiB = 1u << 20;
constexpr size_t WS_CTL = 0, CTL_ZERO_BYTES = 1 * MiB;
constexpr size_t WS_SSQ = 1 * MiB;
constexpr size_t WS_BIAS = 2 * MiB;
constexpr size_t WS_XB = 3 * MiB;
constexpr size_t WS_WO = 35 * MiB;
constexpr size_t WS_WQKV = 37 * MiB;
constexpr size_t WS_QKV = 55 * MiB;
constexpr size_t QKV_SLAB = (size_t)M * 1024 * 2;
constexpr size_t WS_LSE = 343 * MiB;
constexpr size_t WS_END = 346 * MiB;
constexpr size_t WS_WIN0 = 55 * MiB, WS_WOUT0 = 66 * MiB, WS_WIN1 = 72 * MiB, WS_WOUT1 = 83 * MiB, WS_WIN2 = 89 * MiB, WS_WOUT2 = 100 * MiB;
constexpr size_t WS_WRIN = 106 * MiB, WS_WROUT = 111 * MiB, WS_WA = 114 * MiB, WS_WX = 114 * MiB + 512 * 1024;
constexpr size_t WS_ACT = 115 * MiB;
constexpr size_t WS_G = 203 * MiB, WS_U = 243 * MiB, WS_Y = 283 * MiB;
constexpr size_t WS_ATT = WS_QKV + 3 * QKV_SLAB;
constexpr size_t WS_WIN3 = WS_QKV + 6 * QKV_SLAB, WS_WOUT3 = WS_WIN3 + 11 * MiB;
constexpr size_t WS_ACT3 = WS_QKV;
static_assert(WS_Y + (size_t)M * DRNN * 2 <= WS_LSE && WS_ACT + (size_t)M * FF * 2 <= WS_G && WS_WX + 327680 <= WS_ACT, "ws map");
static_assert(WS_QKV + 9 * QKV_SLAB == WS_LSE && WS_LSE + (size_t)3 * M * 16 * 4 <= WS_END, "ws map");
constexpr int CW_BAR = 4096;

constexpr int RING_BYTES = 131072, LDSCTL_OFF = RING_BYTES, MISC_OFF = LDSCTL_OFF + 320;
constexpr int LDS_BYTES = 147456;

#define XB_TMO      128
#define XB_XCNT(j)  (256  + 64 * (j))
#define XB_XSUB(j)  (1280 + 64 * (j))
#define XB_XGEN(j)  (2304 + 64 * (j))
#define XB_TOP      3328
#define XB_TOPGEN   3392
#define XCD_BAR_WORDS 3456
#define XB_SPIN_CAP (1u << 18)
__device__ __forceinline__ unsigned xb_ld(unsigned* p)              { return __hip_atomic_load(p, __ATOMIC_RELAXED, __HIP_MEMORY_SCOPE_AGENT); }
__device__ __forceinline__ unsigned xb_add(unsigned* p, unsigned v) { return __hip_atomic_fetch_add(p, v, __ATOMIC_RELAXED, __HIP_MEMORY_SCOPE_AGENT); }
__device__ __forceinline__ unsigned xb_xcc_id() { return (unsigned)__builtin_amdgcn_s_getreg((3 << 11) | 20) & 0xFu; }
#define XB_SPIN(cond, bar) do { unsigned _sp = 0; while (cond) { __builtin_amdgcn_s_sleep(1); \
    if ((++_sp & 255u) == 0u) { if (xb_ld(&(bar)[XB_TMO])) break; if (_sp > XB_SPIN_CAP) { atomicAdd(&(bar)[XB_TMO], 1u); break; } } } } while (0)
struct XcdBarrier { unsigned* bar; unsigned x; volatile LAS unsigned* st; };
__device__ __forceinline__ XcdBarrier xcd_barrier_post(unsigned* bar, volatile LAS unsigned* st) {
    XcdBarrier b; b.bar = bar; b.x = xb_xcc_id(); b.st = st;
    if (threadIdx.x == 0) (void)xb_add(&bar[XB_XCNT(b.x)], 1u);
    return b;
}
__device__ __forceinline__ void xcd_barrier_complete(unsigned* bar, unsigned x, unsigned& nloc, unsigned& nx) {
    const unsigned G = gridDim.x * gridDim.y * gridDim.z;
    unsigned sum, cnt, mine, sp = 0u;
    for (;;) {
        sum = 0u; cnt = 0u; mine = 0u;
#pragma unroll
        for (unsigned j = 0; j < 16; ++j) { const unsigned c = xb_ld(&bar[XB_XCNT(j)]); sum += c; cnt += (c > 0u) ? 1u : 0u; mine = (j == x) ? c : mine; }
        if (sum == G) break;
        __builtin_amdgcn_s_sleep(1);
        if ((++sp & 255u) == 0u) { if (xb_ld(&bar[XB_TMO])) break; if (sp > XB_SPIN_CAP) { atomicAdd(&bar[XB_TMO], 1u); break; } }
    }
    nloc = mine > 0u ? mine : 1u; nx = cnt > 0u ? cnt : 1u;
}
__device__ __forceinline__ void xcd_barrier(const XcdBarrier& b) {
    asm volatile("s_waitcnt vmcnt(0)" ::: "memory");
    __syncthreads();
    if (threadIdx.x == 0) {
        unsigned* bar = b.bar;
        __builtin_amdgcn_s_waitcnt(0);
        unsigned nloc = b.st[0], nx = b.st[1];
        if (nloc == 0u) { xcd_barrier_complete(bar, b.x, nloc, nx); b.st[0] = nloc; b.st[1] = nx; }
        const unsigned old = xb_add(&bar[XB_XSUB(b.x)], 1u);
        const unsigned gen = old / nloc;
        if (old + 1u == (gen + 1u) * nloc) {
            __builtin_amdgcn_fence(__ATOMIC_RELEASE, "agent");
            asm volatile("s_waitcnt vmcnt(0)" ::: "memory");
            const unsigned og = xb_add(&bar[XB_TOP], 1u);
            const unsigned tg = og / nx;
            if (og + 1u == (tg + 1u) * nx) xb_add(&bar[XB_TOPGEN], 1u);
            else XB_SPIN(xb_ld(&bar[XB_TOPGEN]) == tg, bar);
            __builtin_amdgcn_fence(__ATOMIC_ACQUIRE, "agent");
            xb_add(&bar[XB_XGEN(b.x)], 1u);
            asm volatile("s_waitcnt vmcnt(0)" ::: "memory");
        } else {
            XB_SPIN(xb_ld(&bar[XB_XGEN(b.x)]) == gen, bar);
            __builtin_amdgcn_fence(__ATOMIC_ACQUIRE, "agent");
            asm volatile("s_waitcnt vmcnt(0)" ::: "memory");
        }
    }
    __syncthreads();
}

__device__ __forceinline__ unsigned f2bf(float f) { unsigned u = __builtin_bit_cast(unsigned, f); return (u + 0x7fffu + ((u >> 16) & 1u)) >> 16; }
__device__ __forceinline__ unsigned pk2(float lo, float hi) { return f2bf(lo) | (f2bf(hi) << 16); }
__device__ __forceinline__ float bf_lo(unsigned w) { return __builtin_bit_cast(float, w << 16); }
__device__ __forceinline__ float bf_hi(unsigned w) { return __builtin_bit_cast(float, w & 0xffff0000u); }
__device__ __forceinline__ float bf2f(bf16 v) { return __builtin_bit_cast(float, (unsigned)v << 16); }
__device__ __forceinline__ float wave_sum(float v) {
#pragma unroll
    for (int o = 1; o < 64; o <<= 1) v += __shfl_xor(v, o);
    return v;
}
__device__ __forceinline__ float fast_sigmoid(float x) { return __builtin_amdgcn_rcpf(1.f + __builtin_amdgcn_exp2f(-LOG2E * x)); }
__device__ __forceinline__ float row_rstd(const float* ssq, int row) {
    const f32x4* p = (const f32x4*)(ssq + (size_t)row * 16); const f32x4 a = p[0], b = p[1], c = p[2], d = p[3];
    const float s = ((a.x + a.y) + (a.z + a.w)) + ((b.x + b.y) + (b.z + b.w)) + ((c.x + c.y) + (c.z + c.w)) + ((d.x + d.y) + (d.z + d.w));
    return rsqrtf(s * (1.0f / D) + RMS_EPS);
}

__device__ __forceinline__ void rows_rstd(const float* ssq, int row0  , int fq, float (&rs)[2][4]) {
    f32x4 part[2][4];
#pragma unroll
    for (int ai = 0; ai < 2; ++ai)
#pragma unroll
        for (int m = 0; m < 4; ++m) part[ai][m] = *(const f32x4*)(ssq + (size_t)(row0 + ai * 128 + m * 16) * 16 + 4 * fq);
#pragma unroll
    for (int ai = 0; ai < 2; ++ai)
#pragma unroll
        for (int m = 0; m < 4; ++m) { float t = (part[ai][m][0] + part[ai][m][1]) + (part[ai][m][2] + part[ai][m][3]); t += __shfl_xor(t, 16); t += __shfl_xor(t, 32);
            rs[ai][m] = rsqrtf(t * (1.0f / D) + RMS_EPS); }
}
using pg8::Unit;
struct EpiSwiGLU {
    static constexpr bool PERM = true;
    const float* ssq; bf16* act;
    __device__ __forceinline__ void operator()(const f32x4 (&acc)[2][2][4][2], const Unit& u, int wr, int wc, int fr, int fq) const {
        float rsv[2][4]; rows_rstd(ssq, u.pm * 256 + wr * 64 + fr, fq, rsv);
#pragma unroll
        for (int ai = 0; ai < 2; ++ai)
#pragma unroll
            for (int m = 0; m < 4; ++m) {
                const int row = u.pm * 256 + ai * 128 + wr * 64 + m * 16 + fr;
                const float rs = rsv[ai][m];
                float v[8];
#pragma unroll
                for (int n = 0; n < 2; ++n)
#pragma unroll
                    for (int e = 0; e < 4; ++e) { const float g = acc[ai][0][m][n][e] * rs, up = acc[ai][1][m][n][e] * rs; v[n * 4 + e] = g * fast_sigmoid(g) * up; }
                v4u w; w.x = pg8::cvt_pk_bf16(v[0], v[1]); w.y = pg8::cvt_pk_bf16(v[2], v[3]); w.z = pg8::cvt_pk_bf16(v[4], v[5]); w.w = pg8::cvt_pk_bf16(v[6], v[7]);
                *(v4u*)(act + (size_t)row * FF + u.pn * 128 + wc * 32 + 8 * fq) = w;
            }
    }
};
struct EpiRes {
    static constexpr bool PERM = true;
    const float* xin; float* xout; bf16* xb; float* ssq; float scale;
    __device__ __forceinline__ void operator()(const f32x4 (&acc)[2][2][4][2], const Unit& u, int wr, int wc, int fr, int fq) const {
#pragma unroll
        for (int ai = 0; ai < 2; ++ai) {
            f32x4 xv[4][2][2];
#pragma unroll
            for (int m = 0; m < 4; ++m)
#pragma unroll
                for (int bj = 0; bj < 2; ++bj) { const size_t off = (size_t)(u.pm * 256 + ai * 128 + wr * 64 + m * 16 + fr) * D + u.pn * 256 + bj * 128 + wc * 32 + 8 * fq;
                    xv[m][bj][0] = *(const f32x4*)(xin + off); xv[m][bj][1] = *(const f32x4*)(xin + off + 4); }
#pragma unroll
            for (int m = 0; m < 4; ++m) {
                const int row = u.pm * 256 + ai * 128 + wr * 64 + m * 16 + fr;
                float ss = 0.f;
#pragma unroll
                for (int bj = 0; bj < 2; ++bj) {
                    const size_t off = (size_t)row * D + u.pn * 256 + bj * 128 + wc * 32 + 8 * fq;
                    const f32x4 y0 = xv[m][bj][0] + acc[ai][bj][m][0] * scale, y1 = xv[m][bj][1] + acc[ai][bj][m][1] * scale;
                    *(f32x4*)(xout + off) = y0; *(f32x4*)(xout + off + 4) = y1;
                    v4u w; w.x = pg8::cvt_pk_bf16(y0[0], y0[1]); w.y = pg8::cvt_pk_bf16(y0[2], y0[3]); w.z = pg8::cvt_pk_bf16(y1[0], y1[1]); w.w = pg8::cvt_pk_bf16(y1[2], y1[3]);
                    *(v4u*)(xb + off) = w;
                    ss += (y0[0] * y0[0] + y0[1] * y0[1]) + (y0[2] * y0[2] + y0[3] * y0[3]) + (y1[0] * y1[0] + y1[1] * y1[1]) + (y1[2] * y1[2] + y1[3] * y1[3]);
                }
                ss += __shfl_xor(ss, 16); ss += __shfl_xor(ss, 32);
                if (fq == 0) ssq[(size_t)row * 16 + u.pn * 4 + wc] = ss;
            }
            asm volatile("" ::: "memory");
        }
    }
};
struct EpiRnnIn {
    static constexpr bool PERM = true;
    const float* ssq; bf16* Gb; bf16* Ub;
    __device__ __forceinline__ void operator()(const f32x4 (&acc)[2][2][4][2], const Unit& u, int wr, int wc, int fr, int fq) const {
        const bool is_gate = u.pn < 5; bf16* dstb = is_gate ? Gb : Ub; const int pc = is_gate ? u.pn : u.pn - 5;
        float rsv[2][4]; rows_rstd(ssq, u.pm * 256 + wr * 64 + fr, fq, rsv);
#pragma unroll
        for (int ai = 0; ai < 2; ++ai)
#pragma unroll
            for (int m = 0; m < 4; ++m) {
                const int row = u.pm * 256 + ai * 128 + wr * 64 + m * 16 + fr;
                const float rs = rsv[ai][m];
#pragma unroll
                for (int bj = 0; bj < 2; ++bj) {
                    float v[8];
#pragma unroll
                    for (int n = 0; n < 2; ++n)
#pragma unroll
                        for (int e = 0; e < 4; ++e) { float x = acc[ai][bj][m][n][e] * rs;
                            if (is_gate) { const float z = 1.5957691216057308f * (x + 0.044715f * x * x * x); x = x * fast_sigmoid(z); }
                            v[n * 4 + e] = x; }
                    v4u w; w.x = pg8::cvt_pk_bf16(v[0], v[1]); w.y = pg8::cvt_pk_bf16(v[2], v[3]); w.z = pg8::cvt_pk_bf16(v[4], v[5]); w.w = pg8::cvt_pk_bf16(v[6], v[7]);
                    *(v4u*)(dstb + (size_t)row * DRNN + pc * 256 + bj * 128 + wc * 32 + 8 * fq) = w;
                }
            }
    }
};
struct EpiQKV {
    static constexpr bool PERM = true;
    const float* ssq; const float* qgain; const float* kgain; bf16* qkv;
    __device__ __forceinline__ void operator()(const f32x4 (&acc)[2][2][4][2], const Unit& u, int wr, int wc, int fr, int fq) const {
        const int hs = u.pn * 4 + wc, kind = hs / 48, gh = hs - kind * 48, g = gh >> 4, h = gh & 15, l2d = 2 * g;
        const float* gain = (kind == 0) ? qgain : kgain; const float gsc = (kind == 0) ? 0.125f * LOG2E : 1.f;
        bf16* slab = qkv + (size_t)(kind * 3 + g) * ((size_t)M * 1024);
        float rsv[2][4]; rows_rstd(ssq, u.pm * 256 + wr * 64 + fr, fq, rsv);
        f32x4 gv[2][2];
#pragma unroll
        for (int bj = 0; bj < 2; ++bj)
#pragma unroll
            for (int n = 0; n < 2; ++n) { gv[bj][n] = (f32x4){1.f, 1.f, 1.f, 1.f}; if (kind < 2) gv[bj][n] = *(const f32x4*)(gain + 32 * bj + 8 * fq + 4 * n) * gsc; }
#pragma unroll
        for (int ai = 0; ai < 2; ++ai)
#pragma unroll
            for (int m = 0; m < 4; ++m) {
                const int row = u.pm * 256 + ai * 128 + wr * 64 + m * 16 + fr;
                const float rs = rsv[ai][m];
                f32x4 v[2][2]; float ss = 0.f;
#pragma unroll
                for (int bj = 0; bj < 2; ++bj)
#pragma unroll
                    for (int n = 0; n < 2; ++n) { v[bj][n] = acc[ai][bj][m][n] * rs; const f32x4 t = v[bj][n]; ss += (t[0] * t[0] + t[1] * t[1]) + (t[2] * t[2] + t[3] * t[3]); }
                ss += __shfl_xor(ss, 16); ss += __shfl_xor(ss, 32);
                const float rn = (kind < 2) ? rsqrtf(ss * (1.0f / HD) + RMS_EPS) : 1.f;
                const int b = row >> 11, t = row & 2047, rres = t & ((1 << l2d) - 1), l = t >> l2d, L = 2048 >> l2d;
                bf16* dst = slab + ((size_t)(b * 16 + h) * 2048 + rres * L + l) * 64 + 8 * fq;
#pragma unroll
                for (int bj = 0; bj < 2; ++bj) {
                    const f32x4 a0 = v[bj][0] * gv[bj][0] * rn, a1 = v[bj][1] * gv[bj][1] * rn;
                    v4u w; w.x = pg8::cvt_pk_bf16(a0[0], a0[1]); w.y = pg8::cvt_pk_bf16(a0[2], a0[3]); w.z = pg8::cvt_pk_bf16(a1[0], a1[1]); w.w = pg8::cvt_pk_bf16(a1[2], a1[3]);
                    *(v4u*)(dst + 32 * bj) = w;
                }
            }
    }
};

struct Args { const float* in[18]; float* out; unsigned char* ws; int ph_lo, ph_hi; };
enum { I_X = 0, I_NORMG, I_FFN_WIN, I_FFN_WOUT, I_RNN_WIN, I_CONV_W, I_CONV_B, I_WA, I_BA, I_WX, I_BX, I_LAM, I_RNN_WOUT, I_WQKV, I_QGAIN, I_KGAIN, I_WO, I_RELB };

struct Ctx { LAS unsigned char* lds; int tid, lane, wave, G, vcu; unsigned char* ws; };

typedef short v4i16_t __attribute__((ext_vector_type(4)));
__device__ __forceinline__ v4i16_t vtr16(const LAS unsigned char* p) { return __builtin_amdgcn_ds_read_tr16_b64_v4i16((LAS v4i16_t*)p); }
enum { CM_NONE = 0, CM_FFN = 1, CM_QKV = 2 };
__device__ __forceinline__ int colmap(int mode, int vr) {
    if (mode == CM_FFN) { const int pn = vr >> 8, w = vr & 255; return (w >> 7) * FF + 128 * pn + (w & 127); }
    if (mode == CM_QKV) { const int pn = vr >> 8, w = vr & 255, bj = w >> 7, wc = (w >> 5) & 3, j = w & 31; return 256 * pn + 64 * wc + 32 * bj + j; }
    return vr;
}
__device__ __forceinline__ void transpose_item(const float* W, int K, int N, const float* gvec, bf16* WT, int mode, LAS unsigned char* scr, int item, int lane) {
    const int nblk = N / 64, kb = item / nblk, nb = item - kb * nblk, k0 = 64 * kb, vr0 = 64 * nb;
    const int col4 = lane & 15, rsub = lane >> 4, nsrc = colmap(mode, vr0 + 32 * (col4 >> 3)) + (col4 & 7) * 4;
    const float* src = W + (size_t)(k0 + rsub) * N + nsrc;
    f32x4 w[16];
#pragma unroll
    for (int i = 0; i < 16; ++i) w[i] = *(const GAS f32x4*)(src + (size_t)(4 * i) * N);
    if (gvec) {
#pragma unroll
        for (int i = 0; i < 16; ++i) w[i] = w[i] * gvec[k0 + 4 * i + rsub];
    }
#pragma unroll
    for (int i = 0; i < 16; ++i) { v2u p; p.x = pg8::cvt_pk_bf16(w[i][0], w[i][1]); p.y = pg8::cvt_pk_bf16(w[i][2], w[i][3]);
        *(LAS v2u*)(scr + (col4 >> 3) * 4096 + (4 * i + rsub) * 64 + (col4 & 7) * 8) = p; }
    const int q = (lane & 15) >> 2, p4 = lane & 3, gidx = lane >> 4;
#pragma unroll
    for (int r = 0; r < 8; ++r) { const int nb16 = r >> 1, kh = r & 1, kbase = 32 * kh + 8 * gidx;
        const LAS unsigned char* a = scr + (nb16 >> 1) * 4096 + (kbase + q) * 64 + ((nb16 & 1) * 16 + 4 * p4) * 2;
        const v4i16_t lo = vtr16(a), hi = vtr16(a + 4 * 64);
        v4u o; { const v2u l2 = __builtin_bit_cast(v2u, lo), h2 = __builtin_bit_cast(v2u, hi); o.x = l2.x; o.y = l2.y; o.z = h2.x; o.w = h2.y; }
        *(GAS v4u*)(WT + (size_t)(vr0 + nb16 * 16 + (lane & 15)) * K + k0 + kbase) = o; }
}
struct MatJob { const float* W; int K, N; const float* g; bf16* WT; int mode; };
__device__ __forceinline__ MatJob mat_job(const Ctx& C, const Args& a, int idx) {
    unsigned char* ws = C.ws; const float* ng = a.in[I_NORMG]; MatJob j;
    switch (idx) {
    case 0: j = MatJob{a.in[I_FFN_WIN] + (size_t)0 * D * 2 * FF, D, 2 * FF, ng + 0 * D, (bf16*)(ws + WS_WIN0), CM_FFN}; break;
    case 1: j = MatJob{a.in[I_FFN_WOUT] + (size_t)0 * FF * D, FF, D, nullptr, (bf16*)(ws + WS_WOUT0), CM_NONE}; break;
    case 2: j = MatJob{a.in[I_RNN_WIN], D, 2 * DRNN, ng + 1 * D, (bf16*)(ws + WS_WRIN), CM_NONE}; break;
    case 3: j = MatJob{a.in[I_RNN_WOUT], DRNN, D, nullptr, (bf16*)(ws + WS_WROUT), CM_NONE}; break;
    case 4: j = MatJob{a.in[I_FFN_WIN] + (size_t)1 * D * 2 * FF, D, 2 * FF, ng + 2 * D, (bf16*)(ws + WS_WIN1), CM_FFN}; break;
    case 5: j = MatJob{a.in[I_FFN_WOUT] + (size_t)1 * FF * D, FF, D, nullptr, (bf16*)(ws + WS_WOUT1), CM_NONE}; break;
    case 6: j = MatJob{a.in[I_FFN_WIN] + (size_t)2 * D * 2 * FF, D, 2 * FF, ng + 3 * D, (bf16*)(ws + WS_WIN2), CM_FFN}; break;
    case 7: j = MatJob{a.in[I_FFN_WOUT] + (size_t)2 * FF * D, FF, D, nullptr, (bf16*)(ws + WS_WOUT2), CM_NONE}; break;
    case 8: j = MatJob{a.in[I_WQKV], D, NQKV, ng + 4 * D, (bf16*)(ws + WS_WQKV), CM_QKV}; break;
    case 9: j = MatJob{a.in[I_WO], D, D, nullptr, (bf16*)(ws + WS_WO), CM_NONE}; break;
    case 10: j = MatJob{a.in[I_FFN_WIN] + (size_t)3 * D * 2 * FF, D, 2 * FF, ng + 5 * D, (bf16*)(ws + WS_WIN3), CM_FFN}; break;
    default: j = MatJob{a.in[I_FFN_WOUT] + (size_t)3 * FF * D, FF, D, nullptr, (bf16*)(ws + WS_WOUT3), CM_NONE}; break;
    }
    return j;
}
__device__ __forceinline__ void convert_mats(const Ctx& C, const Args& a, int first, int last) {
    LAS unsigned char* scr = C.lds + C.wave * 8192;
    const int gw = C.vcu * NWAVES + C.wave, NGW = C.G * NWAVES;
    int base = 0;
    for (int mi = first; mi < last; ++mi) {
        const MatJob j = mat_job(C, a, mi); const int cnt = (j.K / 64) * (j.N / 64);
        int it = (gw - base) % NGW; if (it < 0) it += NGW;
        for (; it < cnt; it += NGW) transpose_item(j.W, j.K, j.N, j.g, j.WT, j.mode, scr, it, C.lane);
        base += cnt;
    }
}
__device__ __forceinline__ int t5_bucket(int n) {
    if (n < 16) return n;
    int b = 16;
    b += (n >= 22) + (n >= 30) + (n >= 40) + (n >= 54) + (n >= 73) + (n >= 99) + (n >= 134) + (n >= 182) + (n >= 246) + (n >= 332) + (n >= 450) + (n >= 609) + (n >= 825) + (n >= 1117) + (n >= 1513);
    return b;
}
__device__ __forceinline__ void p_prologue(const Ctx& C, const Args& a) {
    convert_mats(C, a, 0, 10);
    const int gw = C.vcu * NWAVES + C.wave, NGW = C.G * NWAVES;
    {   LAS unsigned char* scr = C.lds + C.wave * 8192;
        for (int it = gw; it < 2 * NBLK * 4; it += NGW) { const int which = it / (NBLK * 4), r = it % (NBLK * 4), blk = r >> 2, sub = r & 3;
            const float* W = (which ? a.in[I_WX] : a.in[I_WA]) + (size_t)blk * RBLK * RBLK; bf16* WT = (bf16*)(C.ws + (which ? WS_WX : WS_WA)) + (size_t)blk * RBLK * RBLK;
            transpose_item(W, RBLK, RBLK, nullptr, WT, CM_NONE, scr, sub, C.lane); } }
    const float* x = a.in[I_X]; bf16* xb = (bf16*)(C.ws + WS_XB); float* ssq = (float*)(C.ws + WS_SSQ);
    for (int m = gw; m < M; m += NGW) {
        const GAS f32x4* xr = (const GAS f32x4*)(x + (size_t)m * D) + C.lane; f32x4 v[4]; float s = 0.f;
#pragma unroll
        for (int j = 0; j < 4; ++j) { v[j] = xr[64 * j]; s += (v[j].x * v[j].x + v[j].y * v[j].y) + (v[j].z * v[j].z + v[j].w * v[j].w); }
        s = wave_sum(s);
        GAS v2u* o8 = (GAS v2u*)(xb + (size_t)m * D) + C.lane;
#pragma unroll
        for (int j = 0; j < 4; ++j) { v2u w; w.x = pk2(v[j].x, v[j].y); w.y = pk2(v[j].z, v[j].w); o8[64 * j] = w; }
        if (C.lane < 16) ssq[(size_t)m * 16 + C.lane] = (C.lane == 0) ? s : 0.f;
    }
    float* bt = (float*)(C.ws + WS_BIAS); const float* rb = a.in[I_RELB];
    for (int i = blockIdx.x * 512 + C.tid; i < 48 * 129; i += C.G * 512) { const int gh = i / 129, dist = i - gh * 129, g = gh >> 4;
        bt[gh * 132 + dist] = rb[t5_bucket(dist << (2 * g)) * 48 + gh] * LOG2E; }
}

typedef float f32x16 __attribute__((ext_vector_type(16)));
typedef short bf16x8v __attribute__((ext_vector_type(8)));
constexpr int RM_WB = 0, RM_WB_GATE = 64 * 272, RM_UF = 36864, RM_UF_ROW = 272, RM_CW = RM_UF + 256 * RM_UF_ROW, RM_CMP = RM_CW + 2560, RM_END = RM_CMP + 2 * 2 * 8 * 64 * 4;
static_assert(RM_WB + 2 * RM_WB_GATE <= RM_UF && RM_END <= RING_BYTES, "rnn-mid LDS map");
__device__ __forceinline__ bf16x8v pack8(const float (&v)[8]) {
    v4u w; w.x = pg8::cvt_pk_bf16(v[0], v[1]); w.y = pg8::cvt_pk_bf16(v[2], v[3]); w.z = pg8::cvt_pk_bf16(v[4], v[5]); w.w = pg8::cvt_pk_bf16(v[6], v[7]);
    return __builtin_bit_cast(bf16x8v, w);
}
__device__ __forceinline__ void p_rnn_mid(const Ctx& C, const Args& a) {
    const bf16* U = (const bf16*)(C.ws + WS_U); const bf16* Gb = (const bf16*)(C.ws + WS_G); bf16* Y = (bf16*)(C.ws + WS_Y);
    const bf16* WAb = (const bf16*)(C.ws + WS_WA); const bf16* WXb = (const bf16*)(C.ws + WS_WX);
    LAS unsigned char* L = C.lds;
    LAS float* CW = (LAS float*)(L + RM_CW); LAS float* CMP = (LAS float*)(L + RM_CMP);
    const int lane = C.lane, r32 = lane & 31, hh = lane >> 5, wave = C.wave, tid = C.tid;
    for (int item = blockIdx.x; item < BATCH * NBLK * 2; item += C.G) {
        const int b = item / (NBLK * 2), n = (item % (NBLK * 2)) >> 1, half = item & 1;
        __syncthreads();
#pragma unroll
        for (int p = 0; p < 4; ++p) { const int idx = p * 512 + tid, gate = idx >> 10, rem = idx & 1023, row = rem >> 4, c16 = rem & 15;
            const v4u w = *(const v4u*)((gate ? WXb : WAb) + (size_t)(n * 128 + 64 * half + row) * 128 + c16 * 8);
            *(LAS v4u*)(L + RM_WB + gate * RM_WB_GATE + row * 272 + c16 * 16) = w; }
        CW[tid] = a.in[I_CONV_W][(tid >> 7) * DRNN + n * 128 + (tid & 127)];
        if (tid < 128) CW[512 + tid] = a.in[I_CONV_B][n * 128 + tid];
        __syncthreads();
        float ba[2], bx[2], spl[2], Ht[2];
#pragma unroll
        for (int cb = 0; cb < 2; ++cb) { const int ch = n * 128 + 64 * half + 32 * cb + r32; ba[cb] = a.in[I_BA][ch]; bx[cb] = a.in[I_BX][ch];
            spl[cb] = -8.0f * LOG2E * log1pf(expf(-a.in[I_LAM][ch])); Ht[cb] = 0.f; }
        for (int tile = 0; tile < 8; ++tile) {
            const int tposw = tile * 256 + wave * 32;
            const size_t tok0 = (size_t)b * SEQ + tposw;
            bf16x8v af[8];
#pragma unroll
            for (int s = 0; s < 8; ++s) {
                const int c0 = 16 * s + 8 * hh; const bf16* up = U + (tok0 + r32) * DRNN + n * 128 + c0; const int tp = tposw + r32;
                v4u uu[4];
#pragma unroll
                for (int k = 0; k < 4; ++k) { uu[k] = (v4u){0u, 0u, 0u, 0u}; if (tp - (3 - k) >= 0) uu[k] = *(const v4u*)(up - (size_t)(3 - k) * DRNN); }
                float v[8];
                { const f32x4 b0 = *(const LAS f32x4*)(CW + 512 + c0), b1 = *(const LAS f32x4*)(CW + 512 + c0 + 4);
                  v[0] = b0[0]; v[1] = b0[1]; v[2] = b0[2]; v[3] = b0[3]; v[4] = b1[0]; v[5] = b1[1]; v[6] = b1[2]; v[7] = b1[3]; }
#pragma unroll
                for (int k = 0; k < 4; ++k) { const f32x4 w0 = *(const LAS f32x4*)(CW + k * 128 + c0), w1 = *(const LAS f32x4*)(CW + k * 128 + c0 + 4);
                    v[0] += w0[0] * bf_lo(uu[k].x); v[1] += w0[1] * bf_hi(uu[k].x); v[2] += w0[2] * bf_lo(uu[k].y); v[3] += w0[3] * bf_hi(uu[k].y);
                    v[4] += w1[0] * bf_lo(uu[k].z); v[5] += w1[1] * bf_hi(uu[k].z); v[6] += w1[2] * bf_lo(uu[k].w); v[7] += w1[3] * bf_hi(uu[k].w); }
                af[s] = pack8(v);
                if ((s >> 2) == half) { LAS float* d = (LAS float*)(L + RM_UF + (wave * 32 + r32) * RM_UF_ROW) + (c0 - 64 * half);
                    *(LAS f32x4*)d = (f32x4){v[0], v[1], v[2], v[3]}; *(LAS f32x4*)(d + 4) = (f32x4){v[4], v[5], v[6], v[7]}; }
            }
            f32x16 acc[2][2];
#pragma unroll
            for (int gt = 0; gt < 2; ++gt)
#pragma unroll
                for (int cb = 0; cb < 2; ++cb)
#pragma unroll
                    for (int e = 0; e < 16; ++e) acc[gt][cb][e] = 0.f;
#pragma unroll
            for (int s = 0; s < 8; ++s)
#pragma unroll
                for (int gt = 0; gt < 2; ++gt)
#pragma unroll
                    for (int cb = 0; cb < 2; ++cb) {
                        const bf16x8v bfr = *(const LAS bf16x8v*)(L + RM_WB + gt * RM_WB_GATE + (32 * cb + r32) * 272 + (16 * s + 8 * hh) * 2);
                        acc[gt][cb] = __builtin_amdgcn_mfma_f32_32x32x16_bf16(af[s], bfr, acc[gt][cb], 0, 0, 0);
                    }
            float gv[2][16];
#pragma unroll
            for (int cb = 0; cb < 2; ++cb)
#pragma unroll
                for (int e = 0; e < 16; ++e) {
                    const int tl = (e & 3) + 8 * (e >> 2) + 4 * hh;
                    const float uf = *((const LAS float*)(L + RM_UF + (wave * 32 + tl) * RM_UF_ROW) + 32 * cb + r32);
                    const float r = fast_sigmoid(acc[0][cb][e] + ba[cb]), ii = fast_sigmoid(acc[1][cb][e] + bx[cb]);
                    const float av = __builtin_amdgcn_exp2f(r * spl[cb]);
                    const float bv = __builtin_amdgcn_sqrtf(fmaxf(1.f - av * av, 0.f)) * (ii * uf);
                    acc[0][cb][e] = av; acc[1][cb][e] = bv;
                    gv[cb][e] = bf2f(Gb[(tok0 + tl) * DRNN + n * 128 + 64 * half + 32 * cb + r32]);
                }
            float A0[2][4], B0[2][4], A1[2][4], B1[2][4];
            const int par = tile & 1;
#pragma unroll
            for (int cb = 0; cb < 2; ++cb) {
                float Aw = 1.f, Bw = 0.f;
#pragma unroll
                for (int q = 0; q < 4; ++q) {
                    const float a0 = acc[0][cb][4 * q], a1 = acc[0][cb][4 * q + 1], a2 = acc[0][cb][4 * q + 2], a3 = acc[0][cb][4 * q + 3];
                    const float Ag = (a0 * a1) * (a2 * a3);
                    const float Bg = ((acc[1][cb][4 * q] * a1 + acc[1][cb][4 * q + 1]) * a2 + acc[1][cb][4 * q + 2]) * a3 + acc[1][cb][4 * q + 3];
                    const float pA = __shfl_xor(Ag, 32), pB = __shfl_xor(Bg, 32);
                    A0[cb][q] = hh ? pA : Ag; B0[cb][q] = hh ? pB : Bg; A1[cb][q] = hh ? Ag : pA; B1[cb][q] = hh ? Bg : pB;
                    Bw = Bw * A0[cb][q] + B0[cb][q]; Aw *= A0[cb][q]; Bw = Bw * A1[cb][q] + B1[cb][q]; Aw *= A1[cb][q];
                }
                if (hh == 0) { CMP[((par * 2 + 0) * 8 + wave) * 64 + 32 * cb + r32] = Aw; CMP[((par * 2 + 1) * 8 + wave) * 64 + 32 * cb + r32] = Bw; }
            }
            __syncthreads();
#pragma unroll
            for (int cb = 0; cb < 2; ++cb) {
                float h = Ht[cb], hin = 0.f;
#pragma unroll
                for (int v = 0; v < 8; ++v) { const float Av = CMP[((par * 2 + 0) * 8 + v) * 64 + 32 * cb + r32], Bv = CMP[((par * 2 + 1) * 8 + v) * 64 + 32 * cb + r32];
                    hin = (v == wave) ? h : hin; h = Av * h + Bv; }
                Ht[cb] = h;
                float hc = hin;
#pragma unroll
                for (int q = 0; q < 4; ++q) {
                    const float c0 = hc; hc = A0[cb][q] * hc + B0[cb][q]; const float c1 = hc; hc = A1[cb][q] * hc + B1[cb][q];
                    float hv = hh ? c1 : c0;
#pragma unroll
                    for (int i = 0; i < 4; ++i) { const int e = 4 * q + i; hv = acc[0][cb][e] * hv + acc[1][cb][e];
                        const int tl = (e & 3) + 8 * (e >> 2) + 4 * hh;
                        Y[(tok0 + tl) * DRNN + n * 128 + 64 * half + 32 * cb + r32] = (bf16)f2bf(hv * gv[cb][e]); }
                }
            }
        }
    }
}
constexpr int AT_EXT = 0, AT_VT = 1024;
__device__ __forceinline__ void p_attn(const Ctx& C, const bool dry) {
    bf16* QKV = (bf16*)(C.ws + WS_QKV); float* LSE = (float*)(C.ws + WS_LSE); const float* bt = (const float*)(C.ws + WS_BIAS);
    const size_t SLAB = (size_t)M * 1024;
    LAS float* ext = (LAS float*)(C.lds + AT_EXT);
    LAS unsigned char* vt = C.lds + AT_VT + C.wave * 4096;
    const int lane = C.lane, r32 = lane & 31, hh = lane >> 5, wave = C.wave, tid = C.tid;
    const int vtr_off = (4 * hh + ((lane & 15) >> 2)) * 64 + ((lane >> 4) & 1) * 32 + (lane & 3) * 8;
    for (int it = blockIdx.x; it < NGRP * BATCH * NHEAD * 8; it += C.G) {
        const int g = it >> 10, rem = it & 1023, bh = rem >> 3, chunk = (rem + (it >> 8)) & 7, l2d = 2 * g, L = SEQ >> l2d;
        const int llin0 = chunk * 256 + wave * 32, l0 = llin0 & (L - 1);
        bf16* qbase = QKV + (size_t)g * SLAB + ((size_t)bh * SEQ + llin0) * HD;
        const bf16* kres = qbase + 3 * SLAB - (size_t)l0 * HD; const bf16* vres = qbase + 6 * SLAB - (size_t)l0 * HD;
        __syncthreads();
        if (tid < 192) { const int dist = tid - 32; ext[tid] = (dist >= 0 && dist <= 128) ? bt[(g * 16 + (bh & 15)) * 132 + dist] : -1e30f; }
        __syncthreads();
        bf16x8v qf[4];
#pragma unroll
        for (int s = 0; s < 4; ++s) qf[s] = *(const bf16x8v*)(qbase + r32 * HD + 16 * s + 8 * hh);
        f32x16 o0, o1;
#pragma unroll
        for (int e = 0; e < 16; ++e) { o0[e] = 0.f; o1[e] = 0.f; }
        float mrow = -1e30f, lsum = 0.f;
        const int kb_lo = (l0 - 128) > 0 ? (l0 - 128) : 0;
        for (int kb = l0; kb >= kb_lo; kb -= 32) {
            const bf16* kblk = kres + (size_t)kb * HD; const bf16* vblk = vres + (size_t)kb * HD;
            v4u vv[4];
#pragma unroll
            for (int i = 0; i < 4; ++i) vv[i] = *(const v4u*)(vblk + (lane >> 1) * HD + (lane & 1) * 32 + 8 * i);
            bf16x8v kf[4];
#pragma unroll
            for (int s = 0; s < 4; ++s) kf[s] = *(const bf16x8v*)(kblk + r32 * HD + 16 * s + 8 * hh);
#pragma unroll
            for (int i = 0; i < 4; ++i) *(LAS v4u*)(vt + (lane & 1) * 2048 + (lane >> 1) * 64 + 16 * i) = vv[i];
            f32x16 p;
#pragma unroll
            for (int e = 0; e < 16; ++e) p[e] = 0.f;
#pragma unroll
            for (int s = 0; s < 4; ++s) p = __builtin_amdgcn_mfma_f32_32x32x16_bf16(kf[s], qf[s], p, 0, 0, 0);
            const int eb = l0 + r32 - kb - 4 * hh + 32;
            float bm = -1e30f;
#pragma unroll
            for (int e = 0; e < 16; ++e) { p[e] += ext[eb - ((e & 3) + 8 * (e >> 2))]; bm = fmaxf(bm, p[e]); }
            bm = fmaxf(bm, __shfl_xor(bm, 32));
            const float mn = fmaxf(mrow, bm), alpha = __builtin_amdgcn_exp2f(mrow - mn); mrow = mn;
            float ps = 0.f;
#pragma unroll
            for (int e = 0; e < 16; ++e) { p[e] = __builtin_amdgcn_exp2f(p[e] - mn); ps += p[e]; }
            lsum = lsum * alpha + ps;
#pragma unroll
            for (int e = 0; e < 16; ++e) { o0[e] *= alpha; o1[e] *= alpha; }
            bf16x8v pf[2];
#pragma unroll
            for (int s = 0; s < 2; ++s) { const float t8[8] = {p[8 * s], p[8 * s + 1], p[8 * s + 2], p[8 * s + 3], p[8 * s + 4], p[8 * s + 5], p[8 * s + 6], p[8 * s + 7]}; pf[s] = pack8(t8); }
#pragma unroll
            for (int s = 0; s < 2; ++s) {
                const v4i16_t a00 = vtr16(vt + 0 * 2048 + (16 * s) * 64 + vtr_off), a01 = vtr16(vt + 0 * 2048 + (16 * s + 8) * 64 + vtr_off);
                const v4i16_t a10 = vtr16(vt + 1 * 2048 + (16 * s) * 64 + vtr_off), a11 = vtr16(vt + 1 * 2048 + (16 * s + 8) * 64 + vtr_off);
                const bf16x8v va0 = (bf16x8v){a00[0], a00[1], a00[2], a00[3], a01[0], a01[1], a01[2], a01[3]};
                const bf16x8v va1 = (bf16x8v){a10[0], a10[1], a10[2], a10[3], a11[0], a11[1], a11[2], a11[3]};
                o0 = __builtin_amdgcn_mfma_f32_32x32x16_bf16(va0, pf[s], o0, 0, 0, 0);
                o1 = __builtin_amdgcn_mfma_f32_32x32x16_bf16(va1, pf[s], o1, 0, 0, 0);
            }
        }
        const float ltot = lsum + __shfl_xor(lsum, 32), inv = 1.f / ltot;
        bf16* orow = qbase + r32 * HD;
        if (!dry)
#pragma unroll
        for (int q = 0; q < 4; ++q) {
            v2u w0, w1;
            w0.x = pg8::cvt_pk_bf16(o0[4 * q] * inv, o0[4 * q + 1] * inv); w0.y = pg8::cvt_pk_bf16(o0[4 * q + 2] * inv, o0[4 * q + 3] * inv);
            w1.x = pg8::cvt_pk_bf16(o1[4 * q] * inv, o1[4 * q + 1] * inv); w1.y = pg8::cvt_pk_bf16(o1[4 * q + 2] * inv, o1[4 * q + 3] * inv);
            *(v2u*)(orow + 8 * q + 4 * hh) = w0; *(v2u*)(orow + 32 + 8 * q + 4 * hh) = w1;
        }
        if (hh == 0) { const int llin = llin0 + r32, rres = llin >> (11 - l2d), l = llin & (L - 1), t = (l << l2d) + rres, row = (bh >> 4) * SEQ + t;
            LSE[((size_t)g * M + row) * 16 + (bh & 15)] = mrow + log2f(ltot); }
    }
}
__device__ __forceinline__ void p_merge(const Ctx& C, const Args& a) {
    const bf16* QKV = (const bf16*)(C.ws + WS_QKV); const float* LSE = (const float*)(C.ws + WS_LSE); bf16* ATT = (bf16*)(C.ws + WS_ATT);
    for (int idx = blockIdx.x * 512 + C.tid; idx < M * 16 * 8; idx += C.G * 512) {
        const int ch = idx & 7, h = (idx >> 3) & 15, row = idx >> 7, b = row >> 11, t = row & 2047;
        float ls[3], mxl = -INFINITY;
#pragma unroll
        for (int g = 0; g < 3; ++g) { ls[g] = LSE[((size_t)g * M + row) * 16 + h]; mxl = fmaxf(mxl, ls[g]); }
        float acc[8], wsum = 0.f;
#pragma unroll
        for (int e = 0; e < 8; ++e) acc[e] = 0.f;
#pragma unroll
        for (int g = 0; g < 3; ++g) { const float w = exp2f(ls[g] - mxl); wsum += w; const int l2d = 2 * g, rres = t & ((1 << l2d) - 1), l = t >> l2d, L = SEQ >> l2d;
            const v4u v = *(const v4u*)(QKV + (size_t)g * ((size_t)M * 1024) + ((size_t)(b * 16 + h) * SEQ + rres * L + l) * HD + 8 * ch);
            acc[0] += w * bf_lo(v.x); acc[1] += w * bf_hi(v.x); acc[2] += w * bf_lo(v.y); acc[3] += w * bf_hi(v.y); acc[4] += w * bf_lo(v.z); acc[5] += w * bf_hi(v.z); acc[6] += w * bf_lo(v.w); acc[7] += w * bf_hi(v.w); }
        const float inv = 1.f / wsum; v4u o; o.x = pk2(acc[0] * inv, acc[1] * inv); o.y = pk2(acc[2] * inv, acc[3] * inv); o.z = pk2(acc[4] * inv, acc[5] * inv); o.w = pk2(acc[6] * inv, acc[7] * inv);
        *(v4u*)(ATT + (size_t)row * 1024 + h * 64 + 8 * ch) = o;
    }
    convert_mats(C, a, 10, 12);
}

enum { PH_PROLOGUE = 0, PH_FFN_IN_0, PH_FFN_OUT_0, PH_RNN_IN, PH_RNN_MID, PH_RNN_OUT, PH_FFN_IN_1, PH_FFN_OUT_1,
       PH_FFN_IN_2, PH_FFN_OUT_2, PH_QKV, PH_ATTN, PH_MERGE, PH_WO, PH_FFN_IN_3, PH_FFN_OUT_3, NPHASE };

__global__ void __launch_bounds__(NWAVES * 64, 2) fwd_kernel(Args args) {
    extern __shared__ __attribute__((aligned(16))) unsigned char lds_raw[];
    Ctx C; C.lds = (LAS unsigned char*)lds_raw; C.tid = threadIdx.x; C.lane = C.tid & 63; C.wave = __builtin_amdgcn_readfirstlane(C.tid >> 6);
    C.G = gridDim.x; { const int bx = blockIdx.x; C.vcu = (C.G % 8 == 0) ? (bx % 8) * (C.G / 8) + bx / 8 : bx; }
    C.ws = args.ws;
    volatile LAS unsigned* MISC = (volatile LAS unsigned*)(C.lds + MISC_OFF);
    for (int u = C.tid; u < (LDS_BYTES - LDSCTL_OFF) / 4; u += NWAVES * 64) ((LAS unsigned*)(C.lds + LDSCTL_OFF))[u] = 0u;
    __syncthreads();
    unsigned* ctl = (unsigned*)args.ws;
    XcdBarrier bar; bar.bar = ctl + CW_BAR; bar.x = 0; bar.st = nullptr;
    const bool multi = (args.ph_hi - args.ph_lo) > 1;
    if (multi) bar = xcd_barrier_post(ctl + CW_BAR, MISC + 8);
    unsigned char* ws = args.ws;
    float* ssq = (float*)(ws + WS_SSQ); bf16* xb = (bf16*)(ws + WS_XB);
    for (int ph = args.ph_lo; ph < args.ph_hi; ++ph) {
        for (int rep = ((DUP_MASK >> ph) & 1u) ? DUP_N : 0; rep >= 0; --rep) {
        const bool dry = rep > 0;
        { int t_ = threadIdx.x; asm volatile("" : "+v"(t_)); C.tid = t_; C.lane = t_ & 63; }
        switch (ph) {
        case PH_PROLOGUE: p_prologue(C, args); break;
        case PH_FFN_IN_0: case PH_FFN_IN_1: case PH_FFN_IN_2: case PH_FFN_IN_3: {
            const bf16* Bt = (const bf16*)(ws + (ph == PH_FFN_IN_0 ? WS_WIN0 : ph == PH_FFN_IN_1 ? WS_WIN1 : ph == PH_FFN_IN_2 ? WS_WIN2 : WS_WIN3));
            bf16* act = (bf16*)(ws + (ph == PH_FFN_IN_3 ? WS_ACT3 : WS_ACT));
            pg8::Gemm g{xb, Bt, M, 2 * FF, D}; pg8::StaticOrder S; S.init(M, 2 * FF, C.G, (int)blockIdx.x);
            EpiSwiGLU E{ssq, act};
            pg8::gemm_phase<EpiSwiGLU, pg8::StaticOrder, true, true>(C.lds, g, S, E);
        } break;
        case PH_FFN_OUT_0: case PH_FFN_OUT_1: case PH_FFN_OUT_2: case PH_FFN_OUT_3: case PH_RNN_OUT: case PH_WO: {
            const bf16* A; const bf16* Bt; int K; float scale = 0.5f; const float* xin = args.out;
            if (ph == PH_FFN_OUT_0) { A = (const bf16*)(ws + WS_ACT); Bt = (const bf16*)(ws + WS_WOUT0); K = FF; xin = args.in[I_X]; }
            else if (ph == PH_FFN_OUT_1) { A = (const bf16*)(ws + WS_ACT); Bt = (const bf16*)(ws + WS_WOUT1); K = FF; }
            else if (ph == PH_FFN_OUT_2) { A = (const bf16*)(ws + WS_ACT); Bt = (const bf16*)(ws + WS_WOUT2); K = FF; }
            else if (ph == PH_FFN_OUT_3) { A = (const bf16*)(ws + WS_ACT3); Bt = (const bf16*)(ws + WS_WOUT3); K = FF; }
            else if (ph == PH_RNN_OUT) { A = (const bf16*)(ws + WS_Y); Bt = (const bf16*)(ws + WS_WROUT); K = DRNN; scale = 1.f; }
            else { A = (const bf16*)(ws + WS_ATT); Bt = (const bf16*)(ws + WS_WO); K = D; scale = 1.f; }
            if (dry && ph != PH_FFN_OUT_0) scale = 0.f;
            pg8::Gemm g{A, Bt, M, D, K}; pg8::StaticOrder S; S.init(M, D, C.G, (int)blockIdx.x);
            EpiRes E{xin, args.out, xb, ssq, scale};
            pg8::gemm_phase<EpiRes, pg8::StaticOrder, false, true>(C.lds, g, S, E);
        } break;
        case PH_RNN_IN: {
            pg8::Gemm g{xb, (const bf16*)(ws + WS_WRIN), M, 2 * DRNN, D}; pg8::StaticOrder S; S.init(M, 2 * DRNN, C.G, (int)blockIdx.x);
            EpiRnnIn E{ssq, (bf16*)(ws + WS_G), (bf16*)(ws + WS_U)};
            pg8::gemm_phase<EpiRnnIn, pg8::StaticOrder, true, true>(C.lds, g, S, E);
        } break;
        case PH_RNN_MID: p_rnn_mid(C, args); break;
        case PH_QKV: {
            pg8::Gemm g{xb, (const bf16*)(ws + WS_WQKV), M, NQKV, D}; pg8::StaticOrder S; S.init(M, NQKV, C.G, (int)blockIdx.x);
            EpiQKV E{ssq, args.in[I_QGAIN], args.in[I_KGAIN], (bf16*)(ws + WS_QKV)};
            pg8::gemm_phase<EpiQKV, pg8::StaticOrder, true, true>(C.lds, g, S, E);
        } break;
        case PH_ATTN: p_attn(C, dry); break;
        case PH_MERGE: p_merge(C, args); break;
        default: break;
        }
        if (dry || ph + 1 < args.ph_hi) xcd_barrier(bar);
        }
    }
}

extern "C" void kernel_launch(void* const* d_in, const int* in_sizes, int n_in, void* d_out, int out_size, void* d_ws, size_t ws_size, hipStream_t stream) {
    static int grid = 0;
    if (grid == 0) {
        if (n_in != 18 || in_sizes[0] != M * D || out_size != M * D || ws_size < WS_END) { fprintf(stderr, "kernel_launch: unexpected shapes (n_in %d, in0 %d, out %d, ws %zu)\n", n_in, n_in > 0 ? in_sizes[0] : -1, out_size, ws_size); grid = -1; return; }
        int dev = 0, cus = 0, per_cu = 0;
        if (hipGetDevice(&dev) != hipSuccess || hipDeviceGetAttribute(&cus, hipDeviceAttributeMultiprocessorCount, dev) != hipSuccess) { fprintf(stderr, "kernel_launch: device query failed\n"); grid = -1; return; }
        if (hipFuncSetAttribute((const void*)fwd_kernel, hipFuncAttributeMaxDynamicSharedMemorySize, LDS_BYTES) != hipSuccess) { fprintf(stderr, "kernel_launch: hipFuncSetAttribute failed\n"); grid = -1; return; }
        if (hipOccupancyMaxActiveBlocksPerMultiprocessor(&per_cu, (const void*)fwd_kernel, NWAVES * 64, LDS_BYTES) != hipSuccess || per_cu < 1) { fprintf(stderr, "kernel_launch: occupancy query says %d blocks per CU\n", per_cu); (void)hipGetLastError(); grid = -1; return; }
        grid = cus;
    }
    if (grid < 0) return;
    if (hipMemsetAsync(d_ws, 0, CTL_ZERO_BYTES, stream) != hipSuccess) { fprintf(stderr, "kernel_launch: memset failed\n"); return; }
    Args a{};
    for (int i = 0; i < 18; ++i) a.in[i] = (const float*)d_in[i];
    a.out = (float*)d_out; a.ws = (unsigned char*)d_ws;
#if SINGLE_LAUNCH
    a.ph_lo = 0; a.ph_hi = NPHASE;
    hipLaunchKernelGGL(fwd_kernel, dim3(grid), dim3(NWAVES * 64), LDS_BYTES, stream, a);
#else
    for (int ph = 0; ph < NPHASE; ++ph) { a.ph_lo = ph; a.ph_hi = ph + 1; hipLaunchKernelGGL(fwd_kernel, dim3(grid), dim3(NWAVES * 64), LDS_BYTES, stream, a); }
#endif
}
```

```cpp
#include <hip/hip_runtime.h>
#include <cstdio>
#include <cstdint>

#ifndef SINGLE_LAUNCH
#define SINGLE_LAUNCH 1
#define DUP_MASK 0u
#define DUP_N 1
#define DUP_SKIP_EPI 0
#endif

namespace pg8 {
#define PG8_LAS __attribute__((address_space(3)))
typedef unsigned short bf16_t;
typedef short bf16x8 __attribute__((ext_vector_type(8)));
typedef float f32x4 __attribute__((ext_vector_type(4)));
typedef unsigned u32x4 __attribute__((ext_vector_type(4)));
constexpr int BM = 256, BK = 64, HALF = 128, HTB = HALF * BK * 2, STAGE_BYTES = 8 * HTB, NXCD = 8, WGM = 8;

__host__ __device__ __forceinline__ int lds_byte(int r, int c) { const int st = (r >> 4) * 2 + (c >> 5), rr = r & 15, cc = c & 31, ob = rr * 64 + cc * 2; return st * 1024 + (ob ^ (((ob >> 9) & 1) << 5)); }
__host__ __device__ __forceinline__ void stage_rc(int b, int& R, int& C) { const int st = b / 1024, sb = b % 1024, swz = sb ^ (((sb >> 9) & 1) << 5); R = (st >> 1) * 16 + swz / 64; C = (st & 1) * 32 + (swz % 64) / 2; }
__host__ __device__ __forceinline__ int perm32(int rho) { const int n = rho >> 4, i = rho & 15; return 8 * (i >> 2) + 4 * n + (i & 3); }

struct Unit { int pm, pn; };
struct Gemm { const bf16_t* A; const bf16_t* Bt; int M, N, K; };

struct StaticOrder {
    int nM, nN, nwg, G, c;
    __host__ __device__ void init(int M, int N, int G_, int c_) { nM = M / BM; nN = N / BM; nwg = nM * nN; G = G_; c = c_; }
    __host__ __device__ bool next(int i, Unit& u) const {
        const long L = (long)i * G + c; if (L >= nwg) return false;
        int wgid = (int)L; { const int q = nwg / NXCD, r = nwg % NXCD, xcd = wgid % NXCD, off = wgid / NXCD; wgid = (xcd < r ? xcd * (q + 1) : r * (q + 1) + (xcd - r) * q) + off; }
        const int nig = WGM * nN, gid = wgid / nig, fm = gid * WGM, gsz = (nM - fm) < WGM ? (nM - fm) : WGM;
        u.pm = fm + ((wgid % nig) % gsz); u.pn = (wgid % nig) / gsz; return true;
    }
    __device__ __forceinline__ void a_ready(const Unit&) const {}
    __device__ __forceinline__ void done(const Unit&) const {}
};

__device__ __forceinline__ unsigned cvt_pk_bf16(float lo, float hi) { unsigned r; asm volatile("v_cvt_pk_bf16_f32 %0, %1, %2" : "=v"(r) : "v"(lo), "v"(hi)); return r; }

template <class Epi, class Sched, bool ALIGN_EPI = false, bool SP2 = false>
__device__ __forceinline__ void gemm_phase(PG8_LAS unsigned char* lds, const Gemm g, const Sched& S, const Epi& E) {
    int tid_ = threadIdx.x; asm volatile("" : "+v"(tid_));
    const int tid = tid_, wid = __builtin_amdgcn_readfirstlane(tid >> 6), lane = tid & 63, wr = wid >> 2, wc = wid & 3, fr = lane & 15, fq = lane >> 4;
    const int K = g.K, nt = K / BK;
    unsigned voffA[2], voffB[2];
#pragma unroll
    for (int i = 0; i < 2; ++i) { int R, C; stage_rc(tid * 16 + i * 8192, R, C); const int Rb = Epi::PERM ? ((R & ~31) + perm32(R & 31)) : R;
        voffA[i] = (unsigned)(R * K + C) * 2u; voffB[i] = (unsigned)(Rb * K + C) * 2u; }
    const size_t kstep = (size_t)(BK * 2);
    const size_t hstep = (size_t)HALF * K * 2;
    const size_t tstep = 2 * hstep;
    const unsigned ldsw = (unsigned)wid * 1024u;
    const int aoff = lds_byte(wr * 64 + fr, fq * 8), boff = lds_byte(wc * 32 + fr, fq * 8);
#define PG8_SA(b, h) (((b) * 2 + (h)) * HTB)
#define PG8_SB(b, h) ((4 + (b) * 2 + (h)) * HTB)
#define PG8_STAGE(bufoff, gbase, voff) do { _Pragma("unroll") for (int _i = 0; _i < 2; ++_i) \
        __builtin_amdgcn_global_load_lds((const unsigned*)((const char*)(gbase) + (voff)[_i]), (PG8_LAS unsigned*)(lds + (bufoff) + ldsw + _i * 8192), 16, 0, 0); } while (0)
#define PG8_LDA(dst, b, h) do { _Pragma("unroll") for (int m = 0; m < 4; ++m) _Pragma("unroll") for (int k = 0; k < 2; ++k) dst[m][k] = *(const PG8_LAS bf16x8*)(lds + PG8_SA(b, h) + aoff + m * 2048 + k * 1024); } while (0)
#define PG8_LDB(dst, b, h) do { _Pragma("unroll") for (int n = 0; n < 2; ++n) _Pragma("unroll") for (int k = 0; k < 2; ++k) dst[n][k] = *(const PG8_LAS bf16x8*)(lds + PG8_SB(b, h) + boff + n * 2048 + k * 1024); } while (0)
#define PG8_MMA(ai, bj, At, Bt) do { __builtin_amdgcn_s_setprio(1); _Pragma("unroll") for (int m = 0; m < 4; ++m) _Pragma("unroll") for (int n = 0; n < 2; ++n) _Pragma("unroll") for (int k = 0; k < 2; ++k) \
        acc[ai][bj][m][n] = __builtin_amdgcn_mfma_f32_16x16x32_bf16(Bt[n][k], At[m][k], acc[ai][bj][m][n], 0, 0, 0); __builtin_amdgcn_s_setprio(0); } while (0)
#define PG8_WAIT_V(n) asm volatile("s_waitcnt vmcnt(" #n ")" ::: "memory")
#define PG8_WAIT_L(n) asm volatile("s_waitcnt lgkmcnt(" #n ")" ::: "memory")
#define PG8_BAR __builtin_amdgcn_s_barrier()
#define PG8_SCHED __builtin_amdgcn_sched_barrier(0)
    Unit cur, nxt; int ui = 0;
    if (!S.next(0, cur)) return;
    f32x4 acc[2][2][4][2];
#pragma unroll
    for (int a = 0; a < 2; ++a)
#pragma unroll
        for (int b = 0; b < 2; ++b)
#pragma unroll
            for (int m = 0; m < 4; ++m)
#pragma unroll
                for (int n = 0; n < 2; ++n) acc[a][b][m][n] = (f32x4){0.f, 0.f, 0.f, 0.f};
    bf16x8 At[4][2], B0[2][2], B1[2][2];
    const char* cA = (const char*)g.A + (size_t)cur.pm * tstep; const char* cB = (const char*)g.Bt + (size_t)cur.pn * tstep;
    S.a_ready(cur);
    if constexpr (SP2) {
        PG8_STAGE(PG8_SB(0, 0), cB, voffB); PG8_STAGE(PG8_SB(0, 1), cB + hstep, voffB); PG8_STAGE(PG8_SA(0, 0), cA, voffA); PG8_STAGE(PG8_SA(0, 1), cA + hstep, voffA);
        if (wr == 1) PG8_BAR;
        PG8_WAIT_V(2); PG8_BAR;
        PG8_STAGE(PG8_SB(1, 0), cB + kstep, voffB); PG8_STAGE(PG8_SA(1, 0), cA + kstep, voffA); PG8_STAGE(PG8_SB(1, 1), cB + hstep + kstep, voffB);
        PG8_WAIT_V(6); PG8_BAR;
    } else {
        PG8_STAGE(PG8_SB(0, 0), cB, voffB); PG8_STAGE(PG8_SA(0, 0), cA, voffA); PG8_STAGE(PG8_SB(0, 1), cB + hstep, voffB); PG8_STAGE(PG8_SA(0, 1), cA + hstep, voffA);
        if (wr == 1) PG8_BAR;
        PG8_WAIT_V(4); PG8_BAR;
        PG8_STAGE(PG8_SB(1, 0), cB + kstep, voffB); PG8_STAGE(PG8_SA(1, 0), cA + kstep, voffA); PG8_STAGE(PG8_SB(1, 1), cB + hstep + kstep, voffB);
        PG8_WAIT_V(6); PG8_BAR;
    }
    for (;;) {
        const bool has_next = S.next(ui + 1, nxt);
        const char* nA = has_next ? (const char*)g.A + (size_t)nxt.pm * tstep : cA; const char* nB = has_next ? (const char*)g.Bt + (size_t)nxt.pn * tstep : cB;
        for (int t = 0; t < nt; t += 2) {
            const bool last = (t == nt - 2);
            const char* a1 = cA + (size_t)(t + 1) * kstep;
            const char* a2 = last ? nA : cA + (size_t)(t + 2) * kstep; const char* b2 = last ? nB : cB + (size_t)(t + 2) * kstep;
            const char* a3 = a2 + kstep; const char* b3 = b2 + kstep;
            if (last && has_next) S.a_ready(nxt);
            if constexpr (SP2) {
            PG8_LDB(B0, 0, 0); PG8_LDB(B1, 0, 1); PG8_SCHED; PG8_LDA(At, 0, 0); PG8_STAGE(PG8_SA(1, 1), a1 + hstep, voffA);
            PG8_WAIT_V(8); PG8_WAIT_L(0); PG8_BAR; PG8_MMA(0, 0, At, B0); PG8_MMA(0, 1, At, B1); PG8_BAR; PG8_SCHED;
            PG8_LDA(At, 0, 1); PG8_STAGE(PG8_SB(0, 0), b2, voffB); PG8_STAGE(PG8_SB(0, 1), b2 + hstep, voffB); PG8_STAGE(PG8_SA(0, 0), a2, voffA);
            PG8_WAIT_V(8); PG8_WAIT_L(0); PG8_BAR; PG8_MMA(1, 0, At, B0); PG8_MMA(1, 1, At, B1); PG8_BAR; PG8_SCHED;
            PG8_LDB(B0, 1, 0); PG8_LDB(B1, 1, 1); PG8_SCHED; PG8_LDA(At, 1, 0); PG8_STAGE(PG8_SA(0, 1), a2 + hstep, voffA);
            PG8_WAIT_V(8); PG8_WAIT_L(0); PG8_BAR; PG8_MMA(0, 0, At, B0); PG8_MMA(0, 1, At, B1); PG8_BAR; PG8_SCHED;
            PG8_LDA(At, 1, 1); PG8_STAGE(PG8_SB(1, 0), b3, voffB); PG8_STAGE(PG8_SB(1, 1), b3 + hstep, voffB); PG8_STAGE(PG8_SA(1, 0), a3, voffA);
            PG8_WAIT_V(8); PG8_WAIT_L(0); PG8_BAR; PG8_MMA(1, 0, At, B0); PG8_MMA(1, 1, At, B1); PG8_BAR; PG8_SCHED;
            } else {
            PG8_LDB(B0, 0, 0); PG8_SCHED; PG8_LDA(At, 0, 0); PG8_STAGE(PG8_SA(1, 1), a1 + hstep, voffA);
            PG8_WAIT_L(8); PG8_BAR; PG8_WAIT_L(0); PG8_MMA(0, 0, At, B0); PG8_BAR; PG8_SCHED;
            PG8_LDB(B1, 0, 1); PG8_STAGE(PG8_SB(0, 0), b2, voffB);
            PG8_BAR; PG8_WAIT_L(0); PG8_MMA(0, 1, At, B1); PG8_BAR;
            PG8_LDA(At, 0, 1); PG8_STAGE(PG8_SA(0, 0), a2, voffA);
            PG8_BAR; PG8_WAIT_L(0); PG8_MMA(1, 0, At, B0); PG8_BAR; PG8_SCHED;
            PG8_STAGE(PG8_SB(0, 1), b2 + hstep, voffB);
            PG8_WAIT_V(6); PG8_BAR; PG8_MMA(1, 1, At, B1); PG8_BAR;
            PG8_LDB(B0, 1, 0); PG8_SCHED; PG8_LDA(At, 1, 0); PG8_STAGE(PG8_SA(0, 1), a2 + hstep, voffA);
            PG8_WAIT_L(8); PG8_BAR; PG8_WAIT_L(0); PG8_MMA(0, 0, At, B0); PG8_BAR; PG8_SCHED;
            PG8_LDB(B1, 1, 1); PG8_STAGE(PG8_SB(1, 0), b3, voffB);
            PG8_BAR; PG8_WAIT_L(0); PG8_MMA(0, 1, At, B1); PG8_BAR;
            PG8_LDA(At, 1, 1); PG8_STAGE(PG8_SA(1, 0), a3, voffA);
            PG8_BAR; PG8_WAIT_L(0); PG8_MMA(1, 0, At, B0); PG8_BAR; PG8_SCHED;
            PG8_STAGE(PG8_SB(1, 1), b3 + hstep, voffB);
            PG8_WAIT_V(6); PG8_BAR; PG8_MMA(1, 1, At, B1); PG8_BAR;
            }
        }
        if constexpr (ALIGN_EPI) { if (wr == 0) PG8_BAR; }
        E(acc, cur, ui, wr, wc, fr, fq); S.done(cur);
        if (!has_next) break;
#pragma unroll
        for (int a = 0; a < 2; ++a)
#pragma unroll
            for (int b = 0; b < 2; ++b)
#pragma unroll
                for (int m = 0; m < 4; ++m)
#pragma unroll
                    for (int n = 0; n < 2; ++n) acc[a][b][m][n] = (f32x4){0.f, 0.f, 0.f, 0.f};
        cur = nxt; cA = nA; cB = nB; ++ui;
        if constexpr (ALIGN_EPI) { if (wr == 1) PG8_BAR; }
    }
    PG8_WAIT_V(0);
    if constexpr (!ALIGN_EPI) { if (wr == 0) PG8_BAR; }
    PG8_BAR;
#undef PG8_SA
#undef PG8_SB
#undef PG8_STAGE
#undef PG8_LDA
#undef PG8_LDB
#undef PG8_MMA
#undef PG8_WAIT_V
#undef PG8_WAIT_L
#undef PG8_BAR
#undef PG8_SCHED
}
}

constexpr int BATCH = 8, SEQ = 2048, D = 1024, M = BATCH * SEQ;
constexpr int FF = 2816, DRNN = 1280, NBLK = 10, RBLK = 128, CONVW = 4;
constexpr int NHEAD = 16, HD = 64, NGRP = 3, NQKV = 9216;
constexpr float RMS_EPS = 1e-6f;
constexpr float LOG2E = 1.4426950408889634f;
constexpr int NWAVES = 8;

typedef unsigned short bf16;
typedef unsigned v4u __attribute__((ext_vector_type(4)));
typedef unsigned v2u __attribute__((ext_vector_type(2)));
typedef float f32x4 __attribute__((ext_vector_type(4)));
#define GAS __attribute__((address_space(1)))
#define LAS __attribute__((address_space(3)))
typedef GAS unsigned gu32;
#define RLX_AGENT __ATOMIC_RELAXED, __HIP_MEMORY_SCOPE_AGENT
#define LDS_WAIT() asm volatile("s_waitcnt lgkmcnt(0)" ::: "memory")

constexpr size_t MiB = 1u << 20;
constexpr size_t WS_CTL = 0, CTL_ZERO_BYTES = 1 * MiB;
constexpr size_t WS_SSQ = 1 * MiB;
constexpr size_t WS_BIAS = 2 * MiB;
constexpr size_t WS_XB = 3 * MiB;
constexpr size_t WS_WO = 35 * MiB;
constexpr size_t WS_WQKV = 37 * MiB;
constexpr size_t WS_QKV = 55 * MiB;
constexpr size_t QKV_SLAB = (size_t)M * 1024 * 2;
constexpr size_t WS_LSE = 343 * MiB;
constexpr size_t WS_END = 346 * MiB;
constexpr size_t WS_WIN0 = 55 * MiB, WS_WOUT0 = 66 * MiB, WS_WIN1 = 72 * MiB, WS_WOUT1 = 83 * MiB, WS_WIN2 = 89 * MiB, WS_WOUT2 = 100 * MiB;
constexpr size_t WS_WRIN = 106 * MiB, WS_WROUT = 111 * MiB, WS_WA = 114 * MiB, WS_WX = 114 * MiB + 512 * 1024;
constexpr size_t WS_ACT = 115 * MiB;
constexpr size_t WS_G = 203 * MiB, WS_U = 243 * MiB, WS_Y = 283 * MiB;
constexpr size_t WS_ATT = WS_QKV + 3 * QKV_SLAB;
constexpr size_t WS_WIN3 = WS_QKV + 6 * QKV_SLAB, WS_WOUT3 = WS_WIN3 + 11 * MiB;
constexpr size_t WS_ACT3 = WS_QKV;
static_assert(WS_Y + (size_t)M * DRNN * 2 <= WS_LSE && WS_ACT + (size_t)M * FF * 2 <= WS_G && WS_WX + 327680 <= WS_ACT, "ws map");
static_assert(WS_QKV + 9 * QKV_SLAB == WS_LSE && WS_LSE + (size_t)3 * M * 16 * 4 <= WS_END, "ws map");
constexpr int CW_BAR = 4096;

constexpr int RING_BYTES = 131072, LDSCTL_OFF = RING_BYTES, MISC_OFF = LDSCTL_OFF + 320;
constexpr int RSTD_OFF = RING_BYTES + 1024, RSTD_MAX_UNITS = 9, GAIN_OFF = RSTD_OFF + RSTD_MAX_UNITS * 256 * 4;
constexpr int LDS_BYTES = 147456;
static_assert(GAIN_OFF + 512 <= LDS_BYTES, "LDS map");

#define XB_TMO      128
#define XB_XCNT(j)  (256  + 64 * (j))
#define XB_XSUB(j)  (1280 + 64 * (j))
#define XB_XGEN(j)  (2304 + 64 * (j))
#define XB_TOP      3328
#define XB_TOPGEN   3392
#define XCD_BAR_WORDS 3456
#define XB_SPIN_CAP (1u << 18)
__device__ __forceinline__ unsigned xb_ld(unsigned* p)              { return __hip_atomic_load(p, __ATOMIC_RELAXED, __HIP_MEMORY_SCOPE_AGENT); }
__device__ __forceinline__ unsigned xb_add(unsigned* p, unsigned v) { return __hip_atomic_fetch_add(p, v, __ATOMIC_RELAXED, __HIP_MEMORY_SCOPE_AGENT); }
__device__ __forceinline__ unsigned xb_xcc_id() { return (unsigned)__builtin_amdgcn_s_getreg((3 << 11) | 20) & 0xFu; }
#define XB_SPIN(cond, bar) do { unsigned _sp = 0; while (cond) { __builtin_amdgcn_s_sleep(1); \
    if ((++_sp & 255u) == 0u) { if (xb_ld(&(bar)[XB_TMO])) break; if (_sp > XB_SPIN_CAP) { atomicAdd(&(bar)[XB_TMO], 1u); break; } } } } while (0)
struct XcdBarrier { unsigned* bar; unsigned x; volatile LAS unsigned* st; };
__device__ __forceinline__ XcdBarrier xcd_barrier_post(unsigned* bar, volatile LAS unsigned* st) {
    XcdBarrier b; b.bar = bar; b.x = xb_xcc_id(); b.st = st;
    if (threadIdx.x == 0) (void)xb_add(&bar[XB_XCNT(b.x)], 1u);
    return b;
}
__device__ __forceinline__ void xcd_barrier_complete(unsigned* bar, unsigned x, unsigned& nloc, unsigned& nx) {
    const unsigned G = gridDim.x * gridDim.y * gridDim.z;
    unsigned sum, cnt, mine, sp = 0u;
    for (;;) {
        sum = 0u; cnt = 0u; mine = 0u;
#pragma unroll
        for (unsigned j = 0; j < 16; ++j) { const unsigned c = xb_ld(&bar[XB_XCNT(j)]); sum += c; cnt += (c > 0u) ? 1u : 0u; mine = (j == x) ? c : mine; }
        if (sum == G) break;
        __builtin_amdgcn_s_sleep(1);
        if ((++sp & 255u) == 0u) { if (xb_ld(&bar[XB_TMO])) break; if (sp > XB_SPIN_CAP) { atomicAdd(&bar[XB_TMO], 1u); break; } }
    }
    nloc = mine > 0u ? mine : 1u; nx = cnt > 0u ? cnt : 1u;
}
__device__ __forceinline__ void xcd_barrier(const XcdBarrier& b) {
    asm volatile("s_waitcnt vmcnt(0)" ::: "memory");
    __syncthreads();
    if (threadIdx.x == 0) {
        unsigned* bar = b.bar;
        __builtin_amdgcn_s_waitcnt(0);
        unsigned nloc = b.st[0], nx = b.st[1];
        if (nloc == 0u) { xcd_barrier_complete(bar, b.x, nloc, nx); b.st[0] = nloc; b.st[1] = nx; }
        const unsigned old = xb_add(&bar[XB_XSUB(b.x)], 1u);
        const unsigned gen = old / nloc;
        if (old + 1u == (gen + 1u) * nloc) {
            __builtin_amdgcn_fence(__ATOMIC_RELEASE, "agent");
            asm volatile("s_waitcnt vmcnt(0)" ::: "memory");
            const unsigned og = xb_add(&bar[XB_TOP], 1u);
            const unsigned tg = og / nx;
            if (og + 1u == (tg + 1u) * nx) xb_add(&bar[XB_TOPGEN], 1u);
            else XB_SPIN(xb_ld(&bar[XB_TOPGEN]) == tg, bar);
            __builtin_amdgcn_fence(__ATOMIC_ACQUIRE, "agent");
            xb_add(&bar[XB_XGEN(b.x)], 1u);
            asm volatile("s_waitcnt vmcnt(0)" ::: "memory");
        } else {
            XB_SPIN(xb_ld(&bar[XB_XGEN(b.x)]) == gen, bar);
            __builtin_amdgcn_fence(__ATOMIC_ACQUIRE, "agent");
            asm volatile("s_waitcnt vmcnt(0)" ::: "memory");
        }
    }
    __syncthreads();
}

__device__ __forceinline__ unsigned f2bf(float f) { unsigned u = __builtin_bit_cast(unsigned, f); return (u + 0x7fffu + ((u >> 16) & 1u)) >> 16; }
__device__ __forceinline__ unsigned pk2(float lo, float hi) { return f2bf(lo) | (f2bf(hi) << 16); }
__device__ __forceinline__ float bf_lo(unsigned w) { return __builtin_bit_cast(float, w << 16); }
__device__ __forceinline__ float bf_hi(unsigned w) { return __builtin_bit_cast(float, w & 0xffff0000u); }
__device__ __forceinline__ float bf2f(bf16 v) { return __builtin_bit_cast(float, (unsigned)v << 16); }
__device__ __forceinline__ float wave_sum(float v) {
#pragma unroll
    for (int o = 1; o < 64; o <<= 1) v += __shfl_xor(v, o);
    return v;
}
__device__ __forceinline__ float fast_sigmoid(float x) { return __builtin_amdgcn_rcpf(1.f + __builtin_amdgcn_exp2f(-LOG2E * x)); }
__device__ __forceinline__ float row_rstd(const float* ssq, int row) {
    const f32x4* p = (const f32x4*)(ssq + (size_t)row * 16); const f32x4 a = p[0], b = p[1], c = p[2], d = p[3];
    const float s = ((a.x + a.y) + (a.z + a.w)) + ((b.x + b.y) + (b.z + b.w)) + ((c.x + c.y) + (c.z + c.w)) + ((d.x + d.y) + (d.z + d.w));
    return rsqrtf(s * (1.0f / D) + RMS_EPS);
}

typedef float f32x2 __attribute__((ext_vector_type(2)));
template <class Sched> __device__ __forceinline__ void fill_rstd(LAS unsigned char* lds, const Sched& S, const float* ssq, int tid) {
    LAS float* rt = (LAS float*)(lds + RSTD_OFF); pg8::Unit u;
    for (int i = 0; i < RSTD_MAX_UNITS && S.next(i, u); ++i)
        if ((tid >> 8) == (i & 1)) { const int r = tid & 255; rt[i * 256 + r] = row_rstd(ssq, u.pm * 256 + r); }
    __syncthreads();
}
using pg8::Unit;
__device__ __forceinline__ f32x2 silu_mul_pk(f32x2 g, f32x2 up) {
    const f32x2 t = g * (-LOG2E); f32x2 e; e.x = __builtin_amdgcn_exp2f(t.x); e.y = __builtin_amdgcn_exp2f(t.y);
    const f32x2 d = e + 1.0f; f32x2 r; r.x = __builtin_amdgcn_rcpf(d.x); r.y = __builtin_amdgcn_rcpf(d.y);
    return (g * r) * up;
}
struct EpiSwiGLU {
    static constexpr bool PERM = true;
    const LAS float* rtab; bf16* act; bool skip;
    __device__ __forceinline__ void operator()(const f32x4 (&acc)[2][2][4][2], const Unit& u, int ui, int wr, int wc, int fr, int fq) const {
        if (skip) return;
#pragma unroll
        for (int ai = 0; ai < 2; ++ai)
#pragma unroll
            for (int m = 0; m < 4; ++m) {
                const int rl = ai * 128 + wr * 64 + m * 16 + fr, row = u.pm * 256 + rl;
                const float rs = rtab[ui * 256 + rl];
                f32x2 v[4];
#pragma unroll
                for (int n = 0; n < 2; ++n)
#pragma unroll
                    for (int e = 0; e < 2; ++e) { const f32x2 g = (f32x2){acc[ai][0][m][n][2 * e], acc[ai][0][m][n][2 * e + 1]} * rs, up = (f32x2){acc[ai][1][m][n][2 * e], acc[ai][1][m][n][2 * e + 1]} * rs;
                        v[n * 2 + e] = silu_mul_pk(g, up); }
                v4u w; w.x = pg8::cvt_pk_bf16(v[0].x, v[0].y); w.y = pg8::cvt_pk_bf16(v[1].x, v[1].y); w.z = pg8::cvt_pk_bf16(v[2].x, v[2].y); w.w = pg8::cvt_pk_bf16(v[3].x, v[3].y);
                *(v4u*)(act + (size_t)row * FF + u.pn * 128 + wc * 32 + 8 * fq) = w;
            }
    }
};
struct EpiRes {
    static constexpr bool PERM = true;
    const float* xin; float* xout; bf16* xb; float* ssq; float scale;
    __device__ __forceinline__ void operator()(const f32x4 (&acc)[2][2][4][2], const Unit& u, int ui, int wr, int wc, int fr, int fq) const {
#pragma unroll
        for (int ai = 0; ai < 2; ++ai) {
            f32x4 xv[4][2][2];
#pragma unroll
            for (int m = 0; m < 4; ++m)
#pragma unroll
                for (int bj = 0; bj < 2; ++bj) { const size_t off = (size_t)(u.pm * 256 + ai * 128 + wr * 64 + m * 16 + fr) * D + u.pn * 256 + bj * 128 + wc * 32 + 8 * fq;
                    xv[m][bj][0] = *(const f32x4*)(xin + off); xv[m][bj][1] = *(const f32x4*)(xin + off + 4); }
#pragma unroll
            for (int m = 0; m < 4; ++m) {
                const int row = u.pm * 256 + ai * 128 + wr * 64 + m * 16 + fr;
                float ss = 0.f;
#pragma unroll
                for (int bj = 0; bj < 2; ++bj) {
                    const size_t off = (size_t)row * D + u.pn * 256 + bj * 128 + wc * 32 + 8 * fq;
                    const f32x4 y0 = xv[m][bj][0] + acc[ai][bj][m][0] * scale, y1 = xv[m][bj][1] + acc[ai][bj][m][1] * scale;
                    *(f32x4*)(xout + off) = y0; *(f32x4*)(xout + off + 4) = y1;
                    v4u w; w.x = pg8::cvt_pk_bf16(y0[0], y0[1]); w.y = pg8::cvt_pk_bf16(y0[2], y0[3]); w.z = pg8::cvt_pk_bf16(y1[0], y1[1]); w.w = pg8::cvt_pk_bf16(y1[2], y1[3]);
                    *(v4u*)(xb + off) = w;
                    ss += (y0[0] * y0[0] + y0[1] * y0[1]) + (y0[2] * y0[2] + y0[3] * y0[3]) + (y1[0] * y1[0] + y1[1] * y1[1]) + (y1[2] * y1[2] + y1[3] * y1[3]);
                }
                ss += __shfl_xor(ss, 16); ss += __shfl_xor(ss, 32);
                if (fq == 0) ssq[(size_t)row * 16 + u.pn * 4 + wc] = ss;
            }
            asm volatile("" ::: "memory");
        }
    }
};
struct EpiRnnIn {
    static constexpr bool PERM = true;
    const LAS float* rtab; bf16* Gb; bf16* Ub;
    __device__ __forceinline__ void operator()(const f32x4 (&acc)[2][2][4][2], const Unit& u, int ui, int wr, int wc, int fr, int fq) const {
        const bool is_gate = u.pn < 5; bf16* dstb = is_gate ? Gb : Ub; const int pc = is_gate ? u.pn : u.pn - 5;
#pragma unroll
        for (int ai = 0; ai < 2; ++ai)
#pragma unroll
            for (int m = 0; m < 4; ++m) {
                const int rl = ai * 128 + wr * 64 + m * 16 + fr, row = u.pm * 256 + rl;
                const float rs = rtab[ui * 256 + rl];
#pragma unroll
                for (int bj = 0; bj < 2; ++bj) {
                    f32x2 v[4];
#pragma unroll
                    for (int n = 0; n < 2; ++n)
#pragma unroll
                        for (int e = 0; e < 2; ++e) { f32x2 x = (f32x2){acc[ai][bj][m][n][2 * e], acc[ai][bj][m][n][2 * e + 1]} * rs;
                            if (is_gate) {
                                const f32x2 t = (x * x * 0.044715f + 1.0f) * x * (-1.5957691216057308f * LOG2E); f32x2 ex; ex.x = __builtin_amdgcn_exp2f(t.x); ex.y = __builtin_amdgcn_exp2f(t.y);
                                const f32x2 d = ex + 1.0f; f32x2 r; r.x = __builtin_amdgcn_rcpf(d.x); r.y = __builtin_amdgcn_rcpf(d.y); x = x * r; }
                            v[n * 2 + e] = x; }
                    v4u w; w.x = pg8::cvt_pk_bf16(v[0].x, v[0].y); w.y = pg8::cvt_pk_bf16(v[1].x, v[1].y); w.z = pg8::cvt_pk_bf16(v[2].x, v[2].y); w.w = pg8::cvt_pk_bf16(v[3].x, v[3].y);
                    *(v4u*)(dstb + (size_t)row * DRNN + pc * 256 + bj * 128 + wc * 32 + 8 * fq) = w;
                }
            }
    }
};
struct EpiQKV {
    static constexpr bool PERM = true;
    const LAS float* rtab; const LAS float* gtab; bf16* qkv; bool skip;
    __device__ __forceinline__ void operator()(const f32x4 (&acc)[2][2][4][2], const Unit& u, int ui, int wr, int wc, int fr, int fq) const {
        if (skip) return;
        const int hs = u.pn * 4 + wc, kind = hs / 48, gh = hs - kind * 48, g = gh >> 4, h = gh & 15, l2d = 2 * g;
        bf16* slab = qkv + (size_t)(kind * 3 + g) * ((size_t)M * 1024);
        f32x4 gv[2][2];
#pragma unroll
        for (int bj = 0; bj < 2; ++bj)
#pragma unroll
            for (int n = 0; n < 2; ++n) { gv[bj][n] = (f32x4){1.f, 1.f, 1.f, 1.f}; if (kind < 2) gv[bj][n] = *(const LAS f32x4*)(gtab + kind * 64 + 32 * bj + 8 * fq + 4 * n); }
#pragma unroll
        for (int ai = 0; ai < 2; ++ai)
#pragma unroll
            for (int m = 0; m < 4; ++m) {
                const int rl = ai * 128 + wr * 64 + m * 16 + fr, row = u.pm * 256 + rl;
                const float rs = rtab[ui * 256 + rl];
                f32x4 v[2][2]; float ss = 0.f;
#pragma unroll
                for (int bj = 0; bj < 2; ++bj)
#pragma unroll
                    for (int n = 0; n < 2; ++n) { v[bj][n] = acc[ai][bj][m][n] * rs; const f32x4 t = v[bj][n] * v[bj][n]; ss += (t[0] + t[1]) + (t[2] + t[3]); }
                float rn = 1.f;
                if (kind < 2) { ss += __shfl_xor(ss, 16); ss += __shfl_xor(ss, 32); rn = rsqrtf(ss * (1.0f / HD) + RMS_EPS); }
                const int b = row >> 11, t = row & 2047, rres = t & ((1 << l2d) - 1), l = t >> l2d, L = 2048 >> l2d;
                bf16* dst = slab + ((size_t)(b * 16 + h) * 2048 + rres * L + l) * 64 + 8 * fq;
#pragma unroll
                for (int bj = 0; bj < 2; ++bj) {
                    const f32x4 a0 = v[bj][0] * gv[bj][0] * rn, a1 = v[bj][1] * gv[bj][1] * rn;
                    v4u w; w.x = pg8::cvt_pk_bf16(a0[0], a0[1]); w.y = pg8::cvt_pk_bf16(a0[2], a0[3]); w.z = pg8::cvt_pk_bf16(a1[0], a1[1]); w.w = pg8::cvt_pk_bf16(a1[2], a1[3]);
                    *(v4u*)(dst + 32 * bj) = w;
                }
            }
    }
};

struct Args { const float* in[18]; float* out; unsigned char* ws; int ph_lo, ph_hi; };
enum { I_X = 0, I_NORMG, I_FFN_WIN, I_FFN_WOUT, I_RNN_WIN, I_CONV_W, I_CONV_B, I_WA, I_BA, I_WX, I_BX, I_LAM, I_RNN_WOUT, I_WQKV, I_QGAIN, I_KGAIN, I_WO, I_RELB };

struct Ctx { LAS unsigned char* lds; int tid, lane, wave, G, vcu; unsigned char* ws; };

typedef short v4i16_t __attribute__((ext_vector_type(4)));
__device__ __forceinline__ v4i16_t vtr16(const LAS unsigned char* p) { return __builtin_amdgcn_ds_read_tr16_b64_v4i16((LAS v4i16_t*)p); }
enum { CM_NONE = 0, CM_FFN = 1, CM_QKV = 2 };
__device__ __forceinline__ int colmap(int mode, int vr) {
    if (mode == CM_FFN) { const int pn = vr >> 8, w = vr & 255; return (w >> 7) * FF + 128 * pn + (w & 127); }
    if (mode == CM_QKV) { const int pn = vr >> 8, w = vr & 255, bj = w >> 7, wc = (w >> 5) & 3, j = w & 31; return 256 * pn + 64 * wc + 32 * bj + j; }
    return vr;
}
__device__ __forceinline__ void transpose_item(const float* W, int K, int N, const float* gvec, bf16* WT, int mode, LAS unsigned char* scr, int item, int lane) {
    const int nblk = N / 64, kb = item / nblk, nb = item - kb * nblk, k0 = 64 * kb, vr0 = 64 * nb;
    const int col4 = lane & 15, rsub = lane >> 4, nsrc = colmap(mode, vr0 + 32 * (col4 >> 3)) + (col4 & 7) * 4;
    const float* src = W + (size_t)(k0 + rsub) * N + nsrc;
    f32x4 w[16];
#pragma unroll
    for (int i = 0; i < 16; ++i) w[i] = *(const GAS f32x4*)(src + (size_t)(4 * i) * N);
    if (gvec) {
#pragma unroll
        for (int i = 0; i < 16; ++i) w[i] = w[i] * gvec[k0 + 4 * i + rsub];
    }
#pragma unroll
    for (int i = 0; i < 16; ++i) { v2u p; p.x = pg8::cvt_pk_bf16(w[i][0], w[i][1]); p.y = pg8::cvt_pk_bf16(w[i][2], w[i][3]);
        *(LAS v2u*)(scr + (col4 >> 3) * 4096 + (4 * i + rsub) * 64 + (col4 & 7) * 8) = p; }
    const int q = (lane & 15) >> 2, p4 = lane & 3, gidx = lane >> 4;
#pragma unroll
    for (int r = 0; r < 8; ++r) { const int nb16 = r >> 1, kh = r & 1, kbase = 32 * kh + 8 * gidx;
        const LAS unsigned char* a = scr + (nb16 >> 1) * 4096 + (kbase + q) * 64 + ((nb16 & 1) * 16 + 4 * p4) * 2;
        const v4i16_t lo = vtr16(a), hi = vtr16(a + 4 * 64);
        v4u o; { const v2u l2 = __builtin_bit_cast(v2u, lo), h2 = __builtin_bit_cast(v2u, hi); o.x = l2.x; o.y = l2.y; o.z = h2.x; o.w = h2.y; }
        *(GAS v4u*)(WT + (size_t)(vr0 + nb16 * 16 + (lane & 15)) * K + k0 + kbase) = o; }
}
struct MatJob { const float* W; int K, N; const float* g; bf16* WT; int mode; };
__device__ __forceinline__ MatJob mat_job(const Ctx& C, const Args& a, int idx) {
    unsigned char* ws = C.ws; const float* ng = a.in[I_NORMG]; MatJob j;
    switch (idx) {
    case 0: j = MatJob{a.in[I_FFN_WIN] + (size_t)0 * D * 2 * FF, D, 2 * FF, ng + 0 * D, (bf16*)(ws + WS_WIN0), CM_FFN}; break;
    case 1: j = MatJob{a.in[I_FFN_WOUT] + (size_t)0 * FF * D, FF, D, nullptr, (bf16*)(ws + WS_WOUT0), CM_NONE}; break;
    case 2: j = MatJob{a.in[I_RNN_WIN], D, 2 * DRNN, ng + 1 * D, (bf16*)(ws + WS_WRIN), CM_NONE}; break;
    case 3: j = MatJob{a.in[I_RNN_WOUT], DRNN, D, nullptr, (bf16*)(ws + WS_WROUT), CM_NONE}; break;
    case 4: j = MatJob{a.in[I_FFN_WIN] + (size_t)1 * D * 2 * FF, D, 2 * FF, ng + 2 * D, (bf16*)(ws + WS_WIN1), CM_FFN}; break;
    case 5: j = MatJob{a.in[I_FFN_WOUT] + (size_t)1 * FF * D, FF, D, nullptr, (bf16*)(ws + WS_WOUT1), CM_NONE}; break;
    case 6: j = MatJob{a.in[I_FFN_WIN] + (size_t)2 * D * 2 * FF, D, 2 * FF, ng + 3 * D, (bf16*)(ws + WS_WIN2), CM_FFN}; break;
    case 7: j = MatJob{a.in[I_FFN_WOUT] + (size_t)2 * FF * D, FF, D, nullptr, (bf16*)(ws + WS_WOUT2), CM_NONE}; break;
    case 8: j = MatJob{a.in[I_WQKV], D, NQKV, ng + 4 * D, (bf16*)(ws + WS_WQKV), CM_QKV}; break;
    case 9: j = MatJob{a.in[I_WO], D, D, nullptr, (bf16*)(ws + WS_WO), CM_NONE}; break;
    case 10: j = MatJob{a.in[I_FFN_WIN] + (size_t)3 * D * 2 * FF, D, 2 * FF, ng + 5 * D, (bf16*)(ws + WS_WIN3), CM_FFN}; break;
    default: j = MatJob{a.in[I_FFN_WOUT] + (size_t)3 * FF * D, FF, D, nullptr, (bf16*)(ws + WS_WOUT3), CM_NONE}; break;
    }
    return j;
}
__device__ __forceinline__ void convert_mats(const Ctx& C, const Args& a, int first, int last) {
    LAS unsigned char* scr = C.lds + C.wave * 8192;
    const int gw = C.vcu * NWAVES + C.wave, NGW = C.G * NWAVES;
    int base = 0;
    for (int mi = first; mi < last; ++mi) {
        const MatJob j = mat_job(C, a, mi); const int cnt = (j.K / 64) * (j.N / 64);
        int it = (gw - base) % NGW; if (it < 0) it += NGW;
        for (; it < cnt; it += NGW) transpose_item(j.W, j.K, j.N, j.g, j.WT, j.mode, scr, it, C.lane);
        base += cnt;
    }
}
__device__ __forceinline__ int t5_bucket(int n) {
    if (n < 16) return n;
    int b = 16;
    b += (n >= 22) + (n >= 30) + (n >= 40) + (n >= 54) + (n >= 73) + (n >= 99) + (n >= 134) + (n >= 182) + (n >= 246) + (n >= 332) + (n >= 450) + (n >= 609) + (n >= 825) + (n >= 1117) + (n >= 1513);
    return b;
}
__device__ __forceinline__ void p_prologue(const Ctx& C, const Args& a) {
    convert_mats(C, a, 0, 10);
    const int gw = C.vcu * NWAVES + C.wave, NGW = C.G * NWAVES;
    {   LAS unsigned char* scr = C.lds + C.wave * 8192;
        for (int it = gw; it < 2 * NBLK * 4; it += NGW) { const int which = it / (NBLK * 4), r = it % (NBLK * 4), blk = r >> 2, sub = r & 3;
            const float* W = (which ? a.in[I_WX] : a.in[I_WA]) + (size_t)blk * RBLK * RBLK; bf16* WT = (bf16*)(C.ws + (which ? WS_WX : WS_WA)) + (size_t)blk * RBLK * RBLK;
            transpose_item(W, RBLK, RBLK, nullptr, WT, CM_NONE, scr, sub, C.lane); } }
    const float* x = a.in[I_X]; bf16* xb = (bf16*)(C.ws + WS_XB); float* ssq = (float*)(C.ws + WS_SSQ);
    for (int m = gw; m < M; m += NGW) {
        const GAS f32x4* xr = (const GAS f32x4*)(x + (size_t)m * D) + C.lane; f32x4 v[4]; float s = 0.f;
#pragma unroll
        for (int j = 0; j < 4; ++j) { v[j] = xr[64 * j]; s += (v[j].x * v[j].x + v[j].y * v[j].y) + (v[j].z * v[j].z + v[j].w * v[j].w); }
        s = wave_sum(s);
        GAS v2u* o8 = (GAS v2u*)(xb + (size_t)m * D) + C.lane;
#pragma unroll
        for (int j = 0; j < 4; ++j) { v2u w; w.x = pk2(v[j].x, v[j].y); w.y = pk2(v[j].z, v[j].w); o8[64 * j] = w; }
        if (C.lane < 16) ssq[(size_t)m * 16 + C.lane] = (C.lane == 0) ? s : 0.f;
    }
    float* bt = (float*)(C.ws + WS_BIAS); const float* rb = a.in[I_RELB];
    for (int i = blockIdx.x * 512 + C.tid; i < 48 * 129; i += C.G * 512) { const int gh = i / 129, dist = i - gh * 129, g = gh >> 4;
        bt[gh * 132 + dist] = rb[t5_bucket(dist << (2 * g)) * 48 + gh] * LOG2E; }
}

typedef float f32x16 __attribute__((ext_vector_type(16)));
typedef short bf16x8v __attribute__((ext_vector_type(8)));
constexpr int RM_WB = 0, RM_WB_GATE = 64 * 272, RM_UF = 36864, RM_UF_ROW = 272, RM_CW = RM_UF + 256 * RM_UF_ROW, RM_CMP = RM_CW + 2560, RM_END = RM_CMP + 2 * 2 * 8 * 64 * 4;
static_assert(RM_WB + 2 * RM_WB_GATE <= RM_UF && RM_END <= RING_BYTES, "rnn-mid LDS map");
__device__ __forceinline__ bf16x8v pack8(const float (&v)[8]) {
    v4u w; w.x = pg8::cvt_pk_bf16(v[0], v[1]); w.y = pg8::cvt_pk_bf16(v[2], v[3]); w.z = pg8::cvt_pk_bf16(v[4], v[5]); w.w = pg8::cvt_pk_bf16(v[6], v[7]);
    return __builtin_bit_cast(bf16x8v, w);
}
__device__ __forceinline__ void p_rnn_mid(const Ctx& C, const Args& a) {
    const bf16* U = (const bf16*)(C.ws + WS_U); const bf16* Gb = (const bf16*)(C.ws + WS_G); bf16* Y = (bf16*)(C.ws + WS_Y);
    const bf16* WAb = (const bf16*)(C.ws + WS_WA); const bf16* WXb = (const bf16*)(C.ws + WS_WX);
    LAS unsigned char* L = C.lds;
    LAS float* CW = (LAS float*)(L + RM_CW); LAS float* CMP = (LAS float*)(L + RM_CMP);
    const int wave = C.wave;
    for (int item = blockIdx.x; item < BATCH * NBLK * 2; item += C.G) {
        const int b = item / (NBLK * 2), n = (item % (NBLK * 2)) >> 1, half = item & 1;
        int tid = C.tid; asm volatile("" : "+v"(tid));
        const int lane = tid & 63, r32 = lane & 31, hh = lane >> 5;
        __syncthreads();
#pragma unroll
        for (int p = 0; p < 4; ++p) { const int idx = p * 512 + tid, gate = idx >> 10, rem = idx & 1023, row = rem >> 4, c16 = rem & 15;
            const v4u w = *(const v4u*)((gate ? WXb : WAb) + (size_t)(n * 128 + 64 * half + row) * 128 + c16 * 8);
            *(LAS v4u*)(L + RM_WB + gate * RM_WB_GATE + row * 272 + c16 * 16) = w; }
        CW[tid] = a.in[I_CONV_W][(tid >> 7) * DRNN + n * 128 + (tid & 127)];
        if (tid < 128) CW[512 + tid] = a.in[I_CONV_B][n * 128 + tid];
        __syncthreads();
        float ba[2], bx[2], spl[2], Ht[2];
#pragma unroll
        for (int cb = 0; cb < 2; ++cb) { const int ch = n * 128 + 64 * half + 32 * cb + r32; ba[cb] = a.in[I_BA][ch]; bx[cb] = a.in[I_BX][ch];
            spl[cb] = -8.0f * LOG2E * log1pf(expf(-a.in[I_LAM][ch])); Ht[cb] = 0.f; }
        for (int tile = 0; tile < 8; ++tile) {
            const int tposw = tile * 256 + wave * 32;
            const size_t tok0 = (size_t)b * SEQ + tposw;
            bf16x8v af[8];
            v4u uu[8][4];
            {   const int tp = tposw + r32;
#pragma unroll
                for (int s = 0; s < 8; ++s)
#pragma unroll
                    for (int k = 0; k < 4; ++k) { const int back = (tp - (3 - k) >= 0) ? (3 - k) : 0;
                        uu[s][k] = *(const v4u*)(U + (tok0 + r32 - back) * DRNN + n * 128 + 16 * s + 8 * hh); }
                if (tp < 3) {
#pragma unroll
                    for (int s = 0; s < 8; ++s)
#pragma unroll
                        for (int k = 0; k < 3; ++k) if (tp - (3 - k) < 0) uu[s][k] = (v4u){0u, 0u, 0u, 0u};
                }
            }
#pragma unroll
            for (int s = 0; s < 8; ++s) {
                const int c0 = 16 * s + 8 * hh;
                float v[8];
                { const f32x4 b0 = *(const LAS f32x4*)(CW + 512 + c0), b1 = *(const LAS f32x4*)(CW + 512 + c0 + 4);
                  v[0] = b0[0]; v[1] = b0[1]; v[2] = b0[2]; v[3] = b0[3]; v[4] = b1[0]; v[5] = b1[1]; v[6] = b1[2]; v[7] = b1[3]; }
#pragma unroll
                for (int k = 0; k < 4; ++k) { const f32x4 w0 = *(const LAS f32x4*)(CW + k * 128 + c0), w1 = *(const LAS f32x4*)(CW + k * 128 + c0 + 4);
                    v[0] += w0[0] * bf_lo(uu[s][k].x); v[1] += w0[1] * bf_hi(uu[s][k].x); v[2] += w0[2] * bf_lo(uu[s][k].y); v[3] += w0[3] * bf_hi(uu[s][k].y);
                    v[4] += w1[0] * bf_lo(uu[s][k].z); v[5] += w1[1] * bf_hi(uu[s][k].z); v[6] += w1[2] * bf_lo(uu[s][k].w); v[7] += w1[3] * bf_hi(uu[s][k].w); }
                af[s] = pack8(v);
                if ((s >> 2) == half) { LAS float* d = (LAS float*)(L + RM_UF + (wave * 32 + r32) * RM_UF_ROW) + (c0 - 64 * half);
                    *(LAS f32x4*)d = (f32x4){v[0], v[1], v[2], v[3]}; *(LAS f32x4*)(d + 4) = (f32x4){v[4], v[5], v[6], v[7]}; }
            }
            f32x16 acc[2][2];
#pragma unroll
            for (int gt = 0; gt < 2; ++gt)
#pragma unroll
                for (int cb = 0; cb < 2; ++cb)
#pragma unroll
                    for (int e = 0; e < 16; ++e) acc[gt][cb][e] = 0.f;
#pragma unroll
            for (int s = 0; s < 8; ++s)
#pragma unroll
                for (int gt = 0; gt < 2; ++gt)
#pragma unroll
                    for (int cb = 0; cb < 2; ++cb) {
                        const bf16x8v bfr = *(const LAS bf16x8v*)(L + RM_WB + gt * RM_WB_GATE + (32 * cb + r32) * 272 + (16 * s + 8 * hh) * 2);
                        acc[gt][cb] = __builtin_amdgcn_mfma_f32_32x32x16_bf16(af[s], bfr, acc[gt][cb], 0, 0, 0);
                    }
            float gv[2][16];
#pragma unroll
            for (int cb = 0; cb < 2; ++cb)
#pragma unroll
                for (int e = 0; e < 16; ++e) {
                    const int tl = (e & 3) + 8 * (e >> 2) + 4 * hh;
                    const float uf = *((const LAS float*)(L + RM_UF + (wave * 32 + tl) * RM_UF_ROW) + 32 * cb + r32);
                    const float r = fast_sigmoid(acc[0][cb][e] + ba[cb]), ii = fast_sigmoid(acc[1][cb][e] + bx[cb]);
                    const float av = __builtin_amdgcn_exp2f(r * spl[cb]);
                    const float bv = __builtin_amdgcn_sqrtf(fmaxf(1.f - av * av, 0.f)) * (ii * uf);
                    acc[0][cb][e] = av; acc[1][cb][e] = bv;
                    gv[cb][e] = bf2f(Gb[(tok0 + tl) * DRNN + n * 128 + 64 * half + 32 * cb + r32]);
                }
            float A0[2][4], B0[2][4], A1[2][4], B1[2][4];
            const int par = tile & 1;
#pragma unroll
            for (int cb = 0; cb < 2; ++cb) {
                float Aw = 1.f, Bw = 0.f;
#pragma unroll
                for (int q = 0; q < 4; ++q) {
                    const float a0 = acc[0][cb][4 * q], a1 = acc[0][cb][4 * q + 1], a2 = acc[0][cb][4 * q + 2], a3 = acc[0][cb][4 * q + 3];
                    const float Ag = (a0 * a1) * (a2 * a3);
                    const float Bg = ((acc[1][cb][4 * q] * a1 + acc[1][cb][4 * q + 1]) * a2 + acc[1][cb][4 * q + 2]) * a3 + acc[1][cb][4 * q + 3];
                    const float pA = __shfl_xor(Ag, 32), pB = __shfl_xor(Bg, 32);
                    A0[cb][q] = hh ? pA : Ag; B0[cb][q] = hh ? pB : Bg; A1[cb][q] = hh ? Ag : pA; B1[cb][q] = hh ? Bg : pB;
                    Bw = Bw * A0[cb][q] + B0[cb][q]; Aw *= A0[cb][q]; Bw = Bw * A1[cb][q] + B1[cb][q]; Aw *= A1[cb][q];
                }
                if (hh == 0) { CMP[((par * 2 + 0) * 8 + wave) * 64 + 32 * cb + r32] = Aw; CMP[((par * 2 + 1) * 8 + wave) * 64 + 32 * cb + r32] = Bw; }
            }
            __syncthreads();
#pragma unroll
            for (int cb = 0; cb < 2; ++cb) {
                float h = Ht[cb], hin = 0.f;
#pragma unroll
                for (int v = 0; v < 8; ++v) { const float Av = CMP[((par * 2 + 0) * 8 + v) * 64 + 32 * cb + r32], Bv = CMP[((par * 2 + 1) * 8 + v) * 64 + 32 * cb + r32];
                    hin = (v == wave) ? h : hin; h = Av * h + Bv; }
                Ht[cb] = h;
                float hc = hin;
#pragma unroll
                for (int q = 0; q < 4; ++q) {
                    const float c0 = hc; hc = A0[cb][q] * hc + B0[cb][q]; const float c1 = hc; hc = A1[cb][q] * hc + B1[cb][q];
                    float hv = hh ? c1 : c0;
#pragma unroll
                    for (int i = 0; i < 4; ++i) { const int e = 4 * q + i; hv = acc[0][cb][e] * hv + acc[1][cb][e];
                        const int tl = (e & 3) + 8 * (e >> 2) + 4 * hh;
                        Y[(tok0 + tl) * DRNN + n * 128 + 64 * half + 32 * cb + r32] = (bf16)f2bf(hv * gv[cb][e]); }
                }
            }
        }
    }
}
constexpr int AT_EXT = 0, AT_VT = 48 * 192 * 4;
struct AttnUnit { bf16* qbase; const bf16* kres; const bf16* vres; int l0, kb_lo, eoff, g, bh, llin0; };
__device__ __forceinline__ AttnUnit attn_unit(bf16* QKV, int it, int wave) {
    AttnUnit u; const size_t SLAB = (size_t)M * 1024;
    const int g = it >> 10, rem = it & 1023, bh = rem >> 3, chunk = (rem + (it >> 8)) & 7, l2d = 2 * g, L = SEQ >> l2d;
    u.g = g; u.bh = bh; u.llin0 = chunk * 256 + wave * 32; u.l0 = u.llin0 & (L - 1); u.kb_lo = (u.l0 - 128) > 0 ? (u.l0 - 128) : 0; u.eoff = (g * 16 + (bh & 15)) * 192;
    u.qbase = QKV + (size_t)g * SLAB + ((size_t)bh * SEQ + u.llin0) * HD;
    u.kres = u.qbase + 3 * SLAB - (size_t)u.l0 * HD; u.vres = u.qbase + 6 * SLAB - (size_t)u.l0 * HD;
    return u;
}
__device__ __forceinline__ void p_attn(const Ctx& C, const bool dry) {
    bf16* QKV = (bf16*)(C.ws + WS_QKV); float* LSE = (float*)(C.ws + WS_LSE); const float* bt = (const float*)(C.ws + WS_BIAS);
    LAS float* ext = (LAS float*)(C.lds + AT_EXT);
    LAS unsigned char* vt = C.lds + AT_VT + C.wave * 8192; LAS unsigned char* kt = vt + 4096;
    const int lane = C.lane, r32 = lane & 31, hh = lane >> 5, wave = C.wave, tid = C.tid;
    const int crow8 = lane >> 3, cch = lane & 7;
    const int vtr_off = (4 * hh + ((lane & 15) >> 2)) * 64 + ((lane >> 4) & 1) * 32 + (lane & 3) * 8;
    for (int i = tid; i < 48 * 192; i += 512) { const int gh = i / 192, dist = i - gh * 192 - 32; ext[i] = (dist >= 0 && dist <= 128) ? bt[gh * 132 + dist] : -1e30f; }
    __syncthreads();
    const int total = NGRP * BATCH * NHEAD * 8;
    int it = blockIdx.x;
    if (it >= total) return;
    AttnUnit cu = attn_unit(QKV, it, wave), nu = cu;
    v4u qfn[4], kfn[4], vvn[4];
#define AT_LOADKV(U, KB) do { const bf16* kblk_ = (U).kres + (size_t)(KB) * HD; const bf16* vblk_ = (U).vres + (size_t)(KB) * HD; \
        _Pragma("unroll") for (int i_ = 0; i_ < 4; ++i_) { vvn[i_] = *(const v4u*)(vblk_ + (8 * i_ + crow8) * HD + cch * 8); kfn[i_] = *(const v4u*)(kblk_ + (8 * i_ + crow8) * HD + cch * 8); } } while (0)
#define AT_LOADQ(U) do { _Pragma("unroll") for (int i_ = 0; i_ < 4; ++i_) qfn[i_] = *(const v4u*)((U).qbase + (8 * i_ + crow8) * HD + cch * 8); } while (0)
#define AT_TILE2FRAG(RAW, FR) do { _Pragma("unroll") for (int i_ = 0; i_ < 4; ++i_) *(LAS v4u*)(kt + (8 * i_ + crow8) * 128 + ((cch ^ crow8) << 4)) = RAW[i_]; \
        _Pragma("unroll") for (int s_ = 0; s_ < 4; ++s_) FR[s_] = *(const LAS bf16x8v*)(kt + r32 * 128 + (((2 * s_ + hh) ^ (r32 & 7)) << 4)); } while (0)
    AT_LOADQ(cu); AT_LOADKV(cu, cu.l0);
    for (;;) {
        bf16x8v qf[4];
        AT_TILE2FRAG(qfn, qf);
        f32x16 o0, o1;
#pragma unroll
        for (int e = 0; e < 16; ++e) { o0[e] = 0.f; o1[e] = 0.f; }
        float mrow = -1e30f, lsum = 0.f;
        const bool has_next = (it + C.G) < total;
        for (int kb = cu.l0; kb >= cu.kb_lo; kb -= 32) {
            v4u vv[4], kraw[4]; bf16x8v kf[4];
#pragma unroll
            for (int i = 0; i < 4; ++i) { vv[i] = vvn[i]; kraw[i] = kfn[i]; }
            if (kb - 32 >= cu.kb_lo) { AT_LOADKV(cu, kb - 32); }
            else if (has_next) { nu = attn_unit(QKV, it + C.G, wave); AT_LOADQ(nu); AT_LOADKV(nu, nu.l0); }
#pragma unroll
            for (int i = 0; i < 4; ++i) *(LAS v4u*)(vt + (cch >> 2) * 2048 + (8 * i + crow8) * 64 + (cch & 3) * 16) = vv[i];
            AT_TILE2FRAG(kraw, kf);
            f32x16 p;
#pragma unroll
            for (int e = 0; e < 16; ++e) p[e] = 0.f;
#pragma unroll
            for (int s = 0; s < 4; ++s) p = __builtin_amdgcn_mfma_f32_32x32x16_bf16(kf[s], qf[s], p, 0, 0, 0);
            const int eb = cu.eoff + cu.l0 + r32 - kb - 4 * hh + 32;
            float bm = -1e30f;
#pragma unroll
            for (int e = 0; e < 16; ++e) { p[e] += ext[eb - ((e & 3) + 8 * (e >> 2))]; bm = fmaxf(bm, p[e]); }
            bm = fmaxf(bm, __shfl_xor(bm, 32));
            const float mn = fmaxf(mrow, bm), alpha = __builtin_amdgcn_exp2f(mrow - mn); mrow = mn;
            float ps = 0.f;
#pragma unroll
            for (int e = 0; e < 16; ++e) { p[e] = __builtin_amdgcn_exp2f(p[e] - mn); ps += p[e]; }
            lsum = lsum * alpha + ps;
#pragma unroll
            for (int e = 0; e < 16; ++e) { o0[e] *= alpha; o1[e] *= alpha; }
            bf16x8v pf[2];
#pragma unroll
            for (int s = 0; s < 2; ++s) { const float t8[8] = {p[8 * s], p[8 * s + 1], p[8 * s + 2], p[8 * s + 3], p[8 * s + 4], p[8 * s + 5], p[8 * s + 6], p[8 * s + 7]}; pf[s] = pack8(t8); }
#pragma unroll
            for (int s = 0; s < 2; ++s) {
                const v4i16_t a00 = vtr16(vt + 0 * 2048 + (16 * s) * 64 + vtr_off), a01 = vtr16(vt + 0 * 2048 + (16 * s + 8) * 64 + vtr_off);
                const v4i16_t a10 = vtr16(vt + 1 * 2048 + (16 * s) * 64 + vtr_off), a11 = vtr16(vt + 1 * 2048 + (16 * s + 8) * 64 + vtr_off);
                const bf16x8v va0 = (bf16x8v){a00[0], a00[1], a00[2], a00[3], a01[0], a01[1], a01[2], a01[3]};
                const bf16x8v va1 = (bf16x8v){a10[0], a10[1], a10[2], a10[3], a11[0], a11[1], a11[2], a11[3]};
                o0 = __builtin_amdgcn_mfma_f32_32x32x16_bf16(va0, pf[s], o0, 0, 0, 0);
                o1 = __builtin_amdgcn_mfma_f32_32x32x16_bf16(va1, pf[s], o1, 0, 0, 0);
            }
        }
        const float ltot = lsum + __shfl_xor(lsum, 32), inv = 1.f / ltot;
#pragma unroll
        for (int q = 0; q < 4; ++q) {
            v2u w0, w1;
            w0.x = pg8::cvt_pk_bf16(o0[4 * q] * inv, o0[4 * q + 1] * inv); w0.y = pg8::cvt_pk_bf16(o0[4 * q + 2] * inv, o0[4 * q + 3] * inv);
            w1.x = pg8::cvt_pk_bf16(o1[4 * q] * inv, o1[4 * q + 1] * inv); w1.y = pg8::cvt_pk_bf16(o1[4 * q + 2] * inv, o1[4 * q + 3] * inv);
            *(LAS v2u*)(kt + r32 * 128 + ((q ^ (r32 & 7)) << 4) + 8 * hh) = w0; *(LAS v2u*)(kt + r32 * 128 + (((4 + q) ^ (r32 & 7)) << 4) + 8 * hh) = w1;
        }
        if (!dry)
#pragma unroll
        for (int i = 0; i < 4; ++i) { const v4u w = *(const LAS v4u*)(kt + (8 * i + crow8) * 128 + ((cch ^ crow8) << 4)); *(v4u*)(cu.qbase + (8 * i + crow8) * HD + cch * 8) = w; }
        if (hh == 0) { const int l2d = 2 * cu.g, L = SEQ >> l2d, llin = cu.llin0 + r32, rres = llin >> (11 - l2d), l = llin & (L - 1), t = (l << l2d) + rres, row = (cu.bh >> 4) * SEQ + t;
            LSE[((size_t)cu.g * M + row) * 16 + (cu.bh & 15)] = mrow + log2f(ltot); }
        if (!has_next) break;
        it += C.G; cu = nu;
    }
#undef AT_LOADKV
#undef AT_LOADQ
#undef AT_TILE2FRAG
}
__device__ __forceinline__ void p_merge(const Ctx& C, const Args& a) {
    const bf16* QKV = (const bf16*)(C.ws + WS_QKV); const float* LSE = (const float*)(C.ws + WS_LSE); bf16* ATT = (bf16*)(C.ws + WS_ATT);
    for (int idx = blockIdx.x * 512 + C.tid; idx < M * 16 * 8; idx += C.G * 512) {
        const int ch = idx & 7, h = (idx >> 3) & 15, row = idx >> 7, b = row >> 11, t = row & 2047;
        float ls[3], mxl = -INFINITY;
#pragma unroll
        for (int g = 0; g < 3; ++g) { ls[g] = LSE[((size_t)g * M + row) * 16 + h]; mxl = fmaxf(mxl, ls[g]); }
        float acc[8], wsum = 0.f;
#pragma unroll
        for (int e = 0; e < 8; ++e) acc[e] = 0.f;
#pragma unroll
        for (int g = 0; g < 3; ++g) { const float w = exp2f(ls[g] - mxl); wsum += w; const int l2d = 2 * g, rres = t & ((1 << l2d) - 1), l = t >> l2d, L = SEQ >> l2d;
            const v4u v = *(const v4u*)(QKV + (size_t)g * ((size_t)M * 1024) + ((size_t)(b * 16 + h) * SEQ + rres * L + l) * HD + 8 * ch);
            acc[0] += w * bf_lo(v.x); acc[1] += w * bf_hi(v.x); acc[2] += w * bf_lo(v.y); acc[3] += w * bf_hi(v.y); acc[4] += w * bf_lo(v.z); acc[5] += w * bf_hi(v.z); acc[6] += w * bf_lo(v.w); acc[7] += w * bf_hi(v.w); }
        const float inv = 1.f / wsum; v4u o; o.x = pk2(acc[0] * inv, acc[1] * inv); o.y = pk2(acc[2] * inv, acc[3] * inv); o.z = pk2(acc[4] * inv, acc[5] * inv); o.w = pk2(acc[6] * inv, acc[7] * inv);
        *(v4u*)(ATT + (size_t)row * 1024 + h * 64 + 8 * ch) = o;
    }
    convert_mats(C, a, 10, 12);
}

enum { PH_PROLOGUE = 0, PH_FFN_IN_0, PH_FFN_OUT_0, PH_RNN_IN, PH_RNN_MID, PH_RNN_OUT, PH_FFN_IN_1, PH_FFN_OUT_1,
       PH_FFN_IN_2, PH_FFN_OUT_2, PH_QKV, PH_ATTN, PH_MERGE, PH_WO, PH_FFN_IN_3, PH_FFN_OUT_3, NPHASE };

__global__ void __launch_bounds__(NWAVES * 64, 2) fwd_kernel(Args args) {
    extern __shared__ __attribute__((aligned(16))) unsigned char lds_raw[];
    Ctx C; C.lds = (LAS unsigned char*)lds_raw; C.tid = threadIdx.x; C.lane = C.tid & 63; C.wave = __builtin_amdgcn_readfirstlane(C.tid >> 6);
    C.G = gridDim.x; { const int bx = blockIdx.x; C.vcu = (C.G % 8 == 0) ? (bx % 8) * (C.G / 8) + bx / 8 : bx; }
    C.ws = args.ws;
    volatile LAS unsigned* MISC = (volatile LAS unsigned*)(C.lds + MISC_OFF);
    for (int u = C.tid; u < (LDS_BYTES - LDSCTL_OFF) / 4; u += NWAVES * 64) ((LAS unsigned*)(C.lds + LDSCTL_OFF))[u] = 0u;
    __syncthreads();
    unsigned* ctl = (unsigned*)args.ws;
    XcdBarrier bar; bar.bar = ctl + CW_BAR; bar.x = 0; bar.st = nullptr;
    const bool multi = (args.ph_hi - args.ph_lo) > 1;
    if (multi) bar = xcd_barrier_post(ctl + CW_BAR, MISC + 8);
    unsigned char* ws = args.ws;
    float* ssq = (float*)(ws + WS_SSQ); bf16* xb = (bf16*)(ws + WS_XB);
    for (int ph = args.ph_lo; ph < args.ph_hi; ++ph) {
        for (int rep = ((DUP_MASK >> ph) & 1u) ? DUP_N : 0; rep >= 0; --rep) {
        const bool dry = rep > 0;
        { int t_ = threadIdx.x; asm volatile("" : "+v"(t_)); C.tid = t_; C.lane = t_ & 63; }
        switch (ph) {
        case PH_PROLOGUE: p_prologue(C, args); break;
        case PH_FFN_IN_0: case PH_FFN_IN_1: case PH_FFN_IN_2: case PH_FFN_IN_3: {
            const bf16* Bt = (const bf16*)(ws + (ph == PH_FFN_IN_0 ? WS_WIN0 : ph == PH_FFN_IN_1 ? WS_WIN1 : ph == PH_FFN_IN_2 ? WS_WIN2 : WS_WIN3));
            bf16* act = (bf16*)(ws + (ph == PH_FFN_IN_3 ? WS_ACT3 : WS_ACT));
            pg8::Gemm g{xb, Bt, M, 2 * FF, D}; pg8::StaticOrder S; S.init(M, 2 * FF, C.G, (int)blockIdx.x);
            fill_rstd(C.lds, S, ssq, C.tid);
            EpiSwiGLU E{(const LAS float*)(C.lds + RSTD_OFF), act, dry && DUP_SKIP_EPI};
            pg8::gemm_phase<EpiSwiGLU, pg8::StaticOrder, true, true>(C.lds, g, S, E);
        } break;
        case PH_FFN_OUT_0: case PH_FFN_OUT_1: case PH_FFN_OUT_2: case PH_FFN_OUT_3: case PH_RNN_OUT: case PH_WO: {
            const bf16* A; const bf16* Bt; int K; float scale = 0.5f; const float* xin = args.out;
            if (ph == PH_FFN_OUT_0) { A = (const bf16*)(ws + WS_ACT); Bt = (const bf16*)(ws + WS_WOUT0); K = FF; xin = args.in[I_X]; }
            else if (ph == PH_FFN_OUT_1) { A = (const bf16*)(ws + WS_ACT); Bt = (const bf16*)(ws + WS_WOUT1); K = FF; }
            else if (ph == PH_FFN_OUT_2) { A = (const bf16*)(ws + WS_ACT); Bt = (const bf16*)(ws + WS_WOUT2); K = FF; }
            else if (ph == PH_FFN_OUT_3) { A = (const bf16*)(ws + WS_ACT3); Bt = (const bf16*)(ws + WS_WOUT3); K = FF; }
            else if (ph == PH_RNN_OUT) { A = (const bf16*)(ws + WS_Y); Bt = (const bf16*)(ws + WS_WROUT); K = DRNN; scale = 1.f; }
            else { A = (const bf16*)(ws + WS_ATT); Bt = (const bf16*)(ws + WS_WO); K = D; scale = 1.f; }
            if (dry && ph != PH_FFN_OUT_0) scale = 0.f;
            pg8::Gemm g{A, Bt, M, D, K}; pg8::StaticOrder S; S.init(M, D, C.G, (int)blockIdx.x);
            EpiRes E{xin, args.out, xb, ssq, scale};
            pg8::gemm_phase<EpiRes, pg8::StaticOrder, false, true>(C.lds, g, S, E);
        } break;
        case PH_RNN_IN: {
            pg8::Gemm g{xb, (const bf16*)(ws + WS_WRIN), M, 2 * DRNN, D}; pg8::StaticOrder S; S.init(M, 2 * DRNN, C.G, (int)blockIdx.x);
            fill_rstd(C.lds, S, ssq, C.tid);
            EpiRnnIn E{(const LAS float*)(C.lds + RSTD_OFF), (bf16*)(ws + WS_G), (bf16*)(ws + WS_U)};
            pg8::gemm_phase<EpiRnnIn, pg8::StaticOrder, true, true>(C.lds, g, S, E);
        } break;
        case PH_RNN_MID: p_rnn_mid(C, args); break;
        case PH_QKV: {
            pg8::Gemm g{xb, (const bf16*)(ws + WS_WQKV), M, NQKV, D}; pg8::StaticOrder S; S.init(M, NQKV, C.G, (int)blockIdx.x);
            if (C.tid < 128) ((LAS float*)(C.lds + GAIN_OFF))[C.tid] = (C.tid < 64) ? args.in[I_QGAIN][C.tid] * (0.125f * LOG2E) : args.in[I_KGAIN][C.tid - 64];
            fill_rstd(C.lds, S, ssq, C.tid);
            EpiQKV E{(const LAS float*)(C.lds + RSTD_OFF), (const LAS float*)(C.lds + GAIN_OFF), (bf16*)(ws + WS_QKV), dry && DUP_SKIP_EPI};
            pg8::gemm_phase<EpiQKV, pg8::StaticOrder, true, true>(C.lds, g, S, E);
        } break;
        case PH_ATTN: p_attn(C, dry); break;
        case PH_MERGE: p_merge(C, args); break;
        default: break;
        }
        if (dry || ph + 1 < args.ph_hi) xcd_barrier(bar);
        }
    }
}

extern "C" void kernel_launch(void* const* d_in, const int* in_sizes, int n_in, void* d_out, int out_size, void* d_ws, size_t ws_size, hipStream_t stream) {
    static int grid = 0;
    if (grid == 0) {
        if (n_in != 18 || in_sizes[0] != M * D || out_size != M * D || ws_size < WS_END) { fprintf(stderr, "kernel_launch: unexpected shapes (n_in %d, in0 %d, out %d, ws %zu)\n", n_in, n_in > 0 ? in_sizes[0] : -1, out_size, ws_size); grid = -1; return; }
        int dev = 0, cus = 0, per_cu = 0;
        if (hipGetDevice(&dev) != hipSuccess || hipDeviceGetAttribute(&cus, hipDeviceAttributeMultiprocessorCount, dev) != hipSuccess) { fprintf(stderr, "kernel_launch: device query failed\n"); grid = -1; return; }
        if (hipFuncSetAttribute((const void*)fwd_kernel, hipFuncAttributeMaxDynamicSharedMemorySize, LDS_BYTES) != hipSuccess) { fprintf(stderr, "kernel_launch: hipFuncSetAttribute failed\n"); grid = -1; return; }
        if (hipOccupancyMaxActiveBlocksPerMultiprocessor(&per_cu, (const void*)fwd_kernel, NWAVES * 64, LDS_BYTES) != hipSuccess || per_cu < 1) { fprintf(stderr, "kernel_launch: occupancy query says %d blocks per CU\n", per_cu); (void)hipGetLastError(); grid = -1; return; }
        grid = cus;
    }
    if (grid < 0) return;
    if (hipMemsetAsync(d_ws, 0, CTL_ZERO_BYTES, stream) != hipSuccess) { fprintf(stderr, "kernel_launch: memset failed\n"); return; }
    Args a{};
    for (int i = 0; i < 18; ++i) a.in[i] = (const float*)d_in[i];
    a.out = (float*)d_out; a.ws = (unsigned char*)d_ws;
#if SINGLE_LAUNCH
    a.ph_lo = 0; a.ph_hi = NPHASE;
    hipLaunchKernelGGL(fwd_kernel, dim3(grid), dim3(NWAVES * 64), LDS_BYTES, stream, a);
#else
    for (int ph = 0; ph < NPHASE; ++ph) { a.ph_lo = ph; a.ph_hi = ph + 1; hipLaunchKernelGGL(fwd_kernel, dim3(grid), dim3(NWAVES * 64), LDS_BYTES, stream, a); }
#endif
}
```

```cpp
#include <hip/hip_runtime.h>
#include <cstdio>
#include <cstdint>

#ifndef SINGLE_LAUNCH
#define SINGLE_LAUNCH 1
#define DUP_MASK 0u
#define DUP_N 1
#define DUP_SKIP_EPI 0
#endif

namespace pg8 {
#define PG8_LAS __attribute__((address_space(3)))
typedef unsigned short bf16_t;
typedef short bf16x8 __attribute__((ext_vector_type(8)));
typedef float f32x4 __attribute__((ext_vector_type(4)));
typedef unsigned u32x4 __attribute__((ext_vector_type(4)));
constexpr int BM = 256, BK = 64, HALF = 128, HTB = HALF * BK * 2, STAGE_BYTES = 8 * HTB, NXCD = 8, WGM = 8;

__host__ __device__ __forceinline__ int lds_byte(int r, int c) { const int st = (r >> 4) * 2 + (c >> 5), rr = r & 15, cc = c & 31, ob = rr * 64 + cc * 2; return st * 1024 + (ob ^ (((ob >> 9) & 1) << 5)); }
__host__ __device__ __forceinline__ void stage_rc(int b, int& R, int& C) { const int st = b / 1024, sb = b % 1024, swz = sb ^ (((sb >> 9) & 1) << 5); R = (st >> 1) * 16 + swz / 64; C = (st & 1) * 32 + (swz % 64) / 2; }
__host__ __device__ __forceinline__ int perm32(int rho) { const int n = rho >> 4, i = rho & 15; return 8 * (i >> 2) + 4 * n + (i & 3); }

struct Unit { int pm, pn; };
struct Gemm { const bf16_t* A; const bf16_t* Bt; int M, N, K; };

struct StaticOrder {
    int nM, nN, nwg, G, c;
    __host__ __device__ void init(int M, int N, int G_, int c_) { nM = M / BM; nN = N / BM; nwg = nM * nN; G = G_; c = c_; }
    __host__ __device__ bool next(int i, Unit& u) const {
        const long L = (long)i * G + c; if (L >= nwg) return false;
        int wgid = (int)L; { const int q = nwg / NXCD, r = nwg % NXCD, xcd = wgid % NXCD, off = wgid / NXCD; wgid = (xcd < r ? xcd * (q + 1) : r * (q + 1) + (xcd - r) * q) + off; }
        const int nig = WGM * nN, gid = wgid / nig, fm = gid * WGM, gsz = (nM - fm) < WGM ? (nM - fm) : WGM;
        u.pm = fm + ((wgid % nig) % gsz); u.pn = (wgid % nig) / gsz; return true;
    }
    __device__ __forceinline__ void a_ready(const Unit&) const {}
    __device__ __forceinline__ void done(const Unit&) const {}
};

__device__ __forceinline__ unsigned cvt_pk_bf16(float lo, float hi) { unsigned r; asm volatile("v_cvt_pk_bf16_f32 %0, %1, %2" : "=v"(r) : "v"(lo), "v"(hi)); return r; }

template <class Epi, class Sched, bool ALIGN_EPI = false, bool SP2 = false>
__device__ __forceinline__ void gemm_phase(PG8_LAS unsigned char* lds, const Gemm g, const Sched& S, const Epi& E) {
    int tid_ = threadIdx.x; asm volatile("" : "+v"(tid_));
    const int tid = tid_, wid = __builtin_amdgcn_readfirstlane(tid >> 6), lane = tid & 63, wr = wid >> 2, wc = wid & 3, fr = lane & 15, fq = lane >> 4;
    const int K = g.K, nt = K / BK;
    unsigned voffA[2], voffB[2];
#pragma unroll
    for (int i = 0; i < 2; ++i) { int R, C; stage_rc(tid * 16 + i * 8192, R, C); const int Rb = Epi::PERM ? ((R & ~31) + perm32(R & 31)) : R;
        voffA[i] = (unsigned)(R * K + C) * 2u; voffB[i] = (unsigned)(Rb * K + C) * 2u; }
    const size_t kstep = (size_t)(BK * 2);
    const size_t hstep = (size_t)HALF * K * 2;
    const size_t tstep = 2 * hstep;
    const unsigned ldsw = (unsigned)wid * 1024u;
    const int aoff = lds_byte(wr * 64 + fr, fq * 8), boff = lds_byte(wc * 32 + fr, fq * 8);
#define PG8_SA(b, h) (((b) * 2 + (h)) * HTB)
#define PG8_SB(b, h) ((4 + (b) * 2 + (h)) * HTB)
#define PG8_STAGE(bufoff, gbase, voff) do { _Pragma("unroll") for (int _i = 0; _i < 2; ++_i) \
        __builtin_amdgcn_global_load_lds((const unsigned*)((const char*)(gbase) + (voff)[_i]), (PG8_LAS unsigned*)(lds + (bufoff) + ldsw + _i * 8192), 16, 0, 0); } while (0)
#define PG8_LDA(dst, b, h) do { _Pragma("unroll") for (int m = 0; m < 4; ++m) _Pragma("unroll") for (int k = 0; k < 2; ++k) dst[m][k] = *(const PG8_LAS bf16x8*)(lds + PG8_SA(b, h) + aoff + m * 2048 + k * 1024); } while (0)
#define PG8_LDB(dst, b, h) do { _Pragma("unroll") for (int n = 0; n < 2; ++n) _Pragma("unroll") for (int k = 0; k < 2; ++k) dst[n][k] = *(const PG8_LAS bf16x8*)(lds + PG8_SB(b, h) + boff + n * 2048 + k * 1024); } while (0)
#define PG8_MMA(ai, bj, At, Bt) do { __builtin_amdgcn_s_setprio(1); _Pragma("unroll") for (int m = 0; m < 4; ++m) _Pragma("unroll") for (int n = 0; n < 2; ++n) _Pragma("unroll") for (int k = 0; k < 2; ++k) \
        acc[ai][bj][m][n] = __builtin_amdgcn_mfma_f32_16x16x32_bf16(Bt[n][k], At[m][k], acc[ai][bj][m][n], 0, 0, 0); __builtin_amdgcn_s_setprio(0); } while (0)
#define PG8_WAIT_V(n) asm volatile("s_waitcnt vmcnt(" #n ")" ::: "memory")
#define PG8_WAIT_L(n) asm volatile("s_waitcnt lgkmcnt(" #n ")" ::: "memory")
#define PG8_BAR __builtin_amdgcn_s_barrier()
#define PG8_SCHED __builtin_amdgcn_sched_barrier(0)
    Unit cur, nxt; int ui = 0;
    if (!S.next(0, cur)) return;
    f32x4 acc[2][2][4][2];
#pragma unroll
    for (int a = 0; a < 2; ++a)
#pragma unroll
        for (int b = 0; b < 2; ++b)
#pragma unroll
            for (int m = 0; m < 4; ++m)
#pragma unroll
                for (int n = 0; n < 2; ++n) acc[a][b][m][n] = (f32x4){0.f, 0.f, 0.f, 0.f};
    bf16x8 At[4][2], B0[2][2], B1[2][2];
    const char* cA = (const char*)g.A + (size_t)cur.pm * tstep; const char* cB = (const char*)g.Bt + (size_t)cur.pn * tstep;
    S.a_ready(cur);
    if constexpr (SP2) {
        PG8_STAGE(PG8_SB(0, 0), cB, voffB); PG8_STAGE(PG8_SB(0, 1), cB + hstep, voffB); PG8_STAGE(PG8_SA(0, 0), cA, voffA); PG8_STAGE(PG8_SA(0, 1), cA + hstep, voffA);
        if (wr == 1) PG8_BAR;
        PG8_WAIT_V(2); PG8_BAR;
        PG8_STAGE(PG8_SB(1, 0), cB + kstep, voffB); PG8_STAGE(PG8_SA(1, 0), cA + kstep, voffA); PG8_STAGE(PG8_SB(1, 1), cB + hstep + kstep, voffB);
        PG8_WAIT_V(6); PG8_BAR;
    } else {
        PG8_STAGE(PG8_SB(0, 0), cB, voffB); PG8_STAGE(PG8_SA(0, 0), cA, voffA); PG8_STAGE(PG8_SB(0, 1), cB + hstep, voffB); PG8_STAGE(PG8_SA(0, 1), cA + hstep, voffA);
        if (wr == 1) PG8_BAR;
        PG8_WAIT_V(4); PG8_BAR;
        PG8_STAGE(PG8_SB(1, 0), cB + kstep, voffB); PG8_STAGE(PG8_SA(1, 0), cA + kstep, voffA); PG8_STAGE(PG8_SB(1, 1), cB + hstep + kstep, voffB);
        PG8_WAIT_V(6); PG8_BAR;
    }
    for (;;) {
        const bool has_next = S.next(ui + 1, nxt);
        const char* nA = has_next ? (const char*)g.A + (size_t)nxt.pm * tstep : cA; const char* nB = has_next ? (const char*)g.Bt + (size_t)nxt.pn * tstep : cB;
        for (int t = 0; t < nt; t += 2) {
            const bool last = (t == nt - 2);
            const char* a1 = cA + (size_t)(t + 1) * kstep;
            const char* a2 = last ? nA : cA + (size_t)(t + 2) * kstep; const char* b2 = last ? nB : cB + (size_t)(t + 2) * kstep;
            const char* a3 = a2 + kstep; const char* b3 = b2 + kstep;
            if (last && has_next) S.a_ready(nxt);
            if constexpr (SP2) {
            PG8_LDB(B0, 0, 0); PG8_LDB(B1, 0, 1); PG8_SCHED; PG8_LDA(At, 0, 0); PG8_STAGE(PG8_SA(1, 1), a1 + hstep, voffA);
            PG8_WAIT_V(8); PG8_WAIT_L(0); PG8_BAR; PG8_MMA(0, 0, At, B0); PG8_MMA(0, 1, At, B1); PG8_BAR; PG8_SCHED;
            PG8_LDA(At, 0, 1); PG8_STAGE(PG8_SB(0, 0), b2, voffB); PG8_STAGE(PG8_SB(0, 1), b2 + hstep, voffB); PG8_STAGE(PG8_SA(0, 0), a2, voffA);
            PG8_WAIT_V(8); PG8_WAIT_L(0); PG8_BAR; PG8_MMA(1, 0, At, B0); PG8_MMA(1, 1, At, B1); PG8_BAR; PG8_SCHED;
            PG8_LDB(B0, 1, 0); PG8_LDB(B1, 1, 1); PG8_SCHED; PG8_LDA(At, 1, 0); PG8_STAGE(PG8_SA(0, 1), a2 + hstep, voffA);
            PG8_WAIT_V(8); PG8_WAIT_L(0); PG8_BAR; PG8_MMA(0, 0, At, B0); PG8_MMA(0, 1, At, B1); PG8_BAR; PG8_SCHED;
            PG8_LDA(At, 1, 1); PG8_STAGE(PG8_SB(1, 0), b3, voffB); PG8_STAGE(PG8_SB(1, 1), b3 + hstep, voffB); PG8_STAGE(PG8_SA(1, 0), a3, voffA);
            PG8_WAIT_V(8); PG8_WAIT_L(0); PG8_BAR; PG8_MMA(1, 0, At, B0); PG8_MMA(1, 1, At, B1); PG8_BAR; PG8_SCHED;
            } else {
            PG8_LDB(B0, 0, 0); PG8_SCHED; PG8_LDA(At, 0, 0); PG8_STAGE(PG8_SA(1, 1), a1 + hstep, voffA);
            PG8_WAIT_L(8); PG8_BAR; PG8_WAIT_L(0); PG8_MMA(0, 0, At, B0); PG8_BAR; PG8_SCHED;
            PG8_LDB(B1, 0, 1); PG8_STAGE(PG8_SB(0, 0), b2, voffB);
            PG8_BAR; PG8_WAIT_L(0); PG8_MMA(0, 1, At, B1); PG8_BAR;
            PG8_LDA(At, 0, 1); PG8_STAGE(PG8_SA(0, 0), a2, voffA);
            PG8_BAR; PG8_WAIT_L(0); PG8_MMA(1, 0, At, B0); PG8_BAR; PG8_SCHED;
            PG8_STAGE(PG8_SB(0, 1), b2 + hstep, voffB);
            PG8_WAIT_V(6); PG8_BAR; PG8_MMA(1, 1, At, B1); PG8_BAR;
            PG8_LDB(B0, 1, 0); PG8_SCHED; PG8_LDA(At, 1, 0); PG8_STAGE(PG8_SA(0, 1), a2 + hstep, voffA);
            PG8_WAIT_L(8); PG8_BAR; PG8_WAIT_L(0); PG8_MMA(0, 0, At, B0); PG8_BAR; PG8_SCHED;
            PG8_LDB(B1, 1, 1); PG8_STAGE(PG8_SB(1, 0), b3, voffB);
            PG8_BAR; PG8_WAIT_L(0); PG8_MMA(0, 1, At, B1); PG8_BAR;
            PG8_LDA(At, 1, 1); PG8_STAGE(PG8_SA(1, 0), a3, voffA);
            PG8_BAR; PG8_WAIT_L(0); PG8_MMA(1, 0, At, B0); PG8_BAR; PG8_SCHED;
            PG8_STAGE(PG8_SB(1, 1), b3 + hstep, voffB);
            PG8_WAIT_V(6); PG8_BAR; PG8_MMA(1, 1, At, B1); PG8_BAR;
            }
        }
        if constexpr (ALIGN_EPI) { if (wr == 0) PG8_BAR; }
        E(acc, cur, ui, wr, wc, fr, fq); S.done(cur);
        if (!has_next) break;
#pragma unroll
        for (int a = 0; a < 2; ++a)
#pragma unroll
            for (int b = 0; b < 2; ++b)
#pragma unroll
                for (int m = 0; m < 4; ++m)
#pragma unroll
                    for (int n = 0; n < 2; ++n) acc[a][b][m][n] = (f32x4){0.f, 0.f, 0.f, 0.f};
        cur = nxt; cA = nA; cB = nB; ++ui;
        if constexpr (ALIGN_EPI) { if (wr == 1) PG8_BAR; }
    }
    PG8_WAIT_V(0);
    if constexpr (!ALIGN_EPI) { if (wr == 0) PG8_BAR; }
    PG8_BAR;
#undef PG8_SA
#undef PG8_SB
#undef PG8_STAGE
#undef PG8_LDA
#undef PG8_LDB
#undef PG8_MMA
#undef PG8_WAIT_V
#undef PG8_WAIT_L
#undef PG8_BAR
#undef PG8_SCHED
}
}

constexpr int BATCH = 8, SEQ = 2048, D = 1024, M = BATCH * SEQ;
constexpr int FF = 2816, DRNN = 1280, NBLK = 10, RBLK = 128, CONVW = 4;
constexpr int NHEAD = 16, HD = 64, NGRP = 3, NQKV = 9216;
constexpr float RMS_EPS = 1e-6f;
constexpr float LOG2E = 1.4426950408889634f;
constexpr int NWAVES = 8;

typedef unsigned short bf16;
typedef unsigned v4u __attribute__((ext_vector_type(4)));
typedef unsigned v2u __attribute__((ext_vector_type(2)));
typedef float f32x4 __attribute__((ext_vector_type(4)));
#define GAS __attribute__((address_space(1)))
#define LAS __attribute__((address_space(3)))
typedef GAS unsigned gu32;
#define RLX_AGENT __ATOMIC_RELAXED, __HIP_MEMORY_SCOPE_AGENT
#define LDS_WAIT() asm volatile("s_waitcnt lgkmcnt(0)" ::: "memory")

constexpr size_t MiB = 1u << 20;
constexpr size_t WS_CTL = 0, CTL_ZERO_BYTES = 1 * MiB;
constexpr size_t WS_SSQ = 1 * MiB;
constexpr size_t WS_BIAS = 2 * MiB;
constexpr size_t WS_XB = 3 * MiB;
constexpr size_t WS_WO = 35 * MiB;
constexpr size_t WS_WQKV = 37 * MiB;
constexpr size_t WS_QKV = 55 * MiB;
constexpr size_t QKV_SLAB = (size_t)M * 1024 * 2;
constexpr size_t WS_LSE = 343 * MiB;
constexpr size_t WS_END = 346 * MiB;
constexpr size_t WS_WIN0 = 55 * MiB, WS_WOUT0 = 66 * MiB, WS_WIN1 = 72 * MiB, WS_WOUT1 = 83 * MiB, WS_WIN2 = 89 * MiB, WS_WOUT2 = 100 * MiB;
constexpr size_t WS_WRIN = 106 * MiB, WS_WROUT = 111 * MiB, WS_WA = 114 * MiB, WS_WX = 114 * MiB + 512 * 1024;
constexpr size_t WS_ACT = 115 * MiB;
constexpr size_t WS_G = 203 * MiB, WS_U = 243 * MiB, WS_Y = 283 * MiB;
constexpr size_t WS_ATT = WS_QKV + 3 * QKV_SLAB;
constexpr size_t WS_WIN3 = WS_QKV + 6 * QKV_SLAB, WS_WOUT3 = WS_WIN3 + 11 * MiB;
constexpr size_t WS_ACT3 = WS_QKV;
static_assert(WS_Y + (size_t)M * DRNN * 2 <= WS_LSE && WS_ACT + (size_t)M * FF * 2 <= WS_G && WS_WX + 327680 <= WS_ACT, "ws map");
static_assert(WS_QKV + 9 * QKV_SLAB == WS_LSE && WS_LSE + (size_t)3 * M * 16 * 4 <= WS_END, "ws map");
constexpr int CW_BAR = 4096;

constexpr int RING_BYTES = 131072, LDSCTL_OFF = RING_BYTES, MISC_OFF = LDSCTL_OFF + 320;
constexpr int RSTD_OFF = RING_BYTES + 1024, RSTD_MAX_UNITS = 9, GAIN_OFF = RSTD_OFF + RSTD_MAX_UNITS * 256 * 4;
constexpr int LDS_BYTES = 147456;
static_assert(GAIN_OFF + 512 <= LDS_BYTES, "LDS map");

#define XB_TMO      128
#define XB_XCNT(j)  (256  + 64 * (j))
#define XB_XSUB(j)  (1280 + 64 * (j))
#define XB_XGEN(j)  (2304 + 64 * (j))
#define XB_TOP      3328
#define XB_TOPGEN   3392
#define XCD_BAR_WORDS 3456
#define XB_SPIN_CAP (1u << 18)
__device__ __forceinline__ unsigned xb_ld(unsigned* p)              { return __hip_atomic_load(p, __ATOMIC_RELAXED, __HIP_MEMORY_SCOPE_AGENT); }
__device__ __forceinline__ unsigned xb_add(unsigned* p, unsigned v) { return __hip_atomic_fetch_add(p, v, __ATOMIC_RELAXED, __HIP_MEMORY_SCOPE_AGENT); }
__device__ __forceinline__ unsigned xb_xcc_id() { return (unsigned)__builtin_amdgcn_s_getreg((3 << 11) | 20) & 0xFu; }
#define XB_SPIN(cond, bar) do { unsigned _sp = 0; while (cond) { __builtin_amdgcn_s_sleep(1); \
    if ((++_sp & 255u) == 0u) { if (xb_ld(&(bar)[XB_TMO])) break; if (_sp > XB_SPIN_CAP) { atomicAdd(&(bar)[XB_TMO], 1u); break; } } } } while (0)
struct XcdBarrier { unsigned* bar; unsigned x; volatile LAS unsigned* st; };
__device__ __forceinline__ XcdBarrier xcd_barrier_post(unsigned* bar, volatile LAS unsigned* st) {
    XcdBarrier b; b.bar = bar; b.x = xb_xcc_id(); b.st = st;
    if (threadIdx.x == 0) (void)xb_add(&bar[XB_XCNT(b.x)], 1u);
    return b;
}
__device__ __forceinline__ void xcd_barrier_complete(unsigned* bar, unsigned x, unsigned& nloc, unsigned& nx) {
    const unsigned G = gridDim.x * gridDim.y * gridDim.z;
    unsigned sum, cnt, mine, sp = 0u;
    for (;;) {
        sum = 0u; cnt = 0u; mine = 0u;
#pragma unroll
        for (unsigned j = 0; j < 16; ++j) { const unsigned c = xb_ld(&bar[XB_XCNT(j)]); sum += c; cnt += (c > 0u) ? 1u : 0u; mine = (j == x) ? c : mine; }
        if (sum == G) break;
        __builtin_amdgcn_s_sleep(1);
        if ((++sp & 255u) == 0u) { if (xb_ld(&bar[XB_TMO])) break; if (sp > XB_SPIN_CAP) { atomicAdd(&bar[XB_TMO], 1u); break; } }
    }
    nloc = mine > 0u ? mine : 1u; nx = cnt > 0u ? cnt : 1u;
}
__device__ __forceinline__ void xcd_barrier(const XcdBarrier& b) {
    asm volatile("s_waitcnt vmcnt(0)" ::: "memory");
    __syncthreads();
    if (threadIdx.x == 0) {
        unsigned* bar = b.bar;
        __builtin_amdgcn_s_waitcnt(0);
        unsigned nloc = b.st[0], nx = b.st[1];
        if (nloc == 0u) { xcd_barrier_complete(bar, b.x, nloc, nx); b.st[0] = nloc; b.st[1] = nx; }
        const unsigned old = xb_add(&bar[XB_XSUB(b.x)], 1u);
        const unsigned gen = old / nloc;
        if (old + 1u == (gen + 1u) * nloc) {
            __builtin_amdgcn_fence(__ATOMIC_RELEASE, "agent");
            asm volatile("s_waitcnt vmcnt(0)" ::: "memory");
            const unsigned og = xb_add(&bar[XB_TOP], 1u);
            const unsigned tg = og / nx;
            if (og + 1u == (tg + 1u) * nx) xb_add(&bar[XB_TOPGEN], 1u);
            else XB_SPIN(xb_ld(&bar[XB_TOPGEN]) == tg, bar);
            __builtin_amdgcn_fence(__ATOMIC_ACQUIRE, "agent");
            xb_add(&bar[XB_XGEN(b.x)], 1u);
            asm volatile("s_waitcnt vmcnt(0)" ::: "memory");
        } else {
            XB_SPIN(xb_ld(&bar[XB_XGEN(b.x)]) == gen, bar);
            __builtin_amdgcn_fence(__ATOMIC_ACQUIRE, "agent");
            asm volatile("s_waitcnt vmcnt(0)" ::: "memory");
        }
    }
    __syncthreads();
}

__device__ __forceinline__ unsigned f2bf(float f) { unsigned u = __builtin_bit_cast(unsigned, f); return (u + 0x7fffu + ((u >> 16) & 1u)) >> 16; }
__device__ __forceinline__ unsigned pk2(float lo, float hi) { return f2bf(lo) | (f2bf(hi) << 16); }
__device__ __forceinline__ float bf_lo(unsigned w) { return __builtin_bit_cast(float, w << 16); }
__device__ __forceinline__ float bf_hi(unsigned w) { return __builtin_bit_cast(float, w & 0xffff0000u); }
__device__ __forceinline__ float bf2f(bf16 v) { return __builtin_bit_cast(float, (unsigned)v << 16); }
__device__ __forceinline__ float wave_sum(float v) {
#pragma unroll
    for (int o = 1; o < 64; o <<= 1) v += __shfl_xor(v, o);
    return v;
}
__device__ __forceinline__ float fast_sigmoid(float x) { return __builtin_amdgcn_rcpf(1.f + __builtin_amdgcn_exp2f(-LOG2E * x)); }
__device__ __forceinline__ float row_rstd(const float* ssq, int row) {
    const f32x4* p = (const f32x4*)(ssq + (size_t)row * 16); const f32x4 a = p[0], b = p[1], c = p[2], d = p[3];
    const float s = ((a.x + a.y) + (a.z + a.w)) + ((b.x + b.y) + (b.z + b.w)) + ((c.x + c.y) + (c.z + c.w)) + ((d.x + d.y) + (d.z + d.w));
    return rsqrtf(s * (1.0f / D) + RMS_EPS);
}

typedef float f32x2 __attribute__((ext_vector_type(2)));
template <class Sched> __device__ __forceinline__ void fill_rstd(LAS unsigned char* lds, const Sched& S, const float* ssq, int tid) {
    LAS float* rt = (LAS float*)(lds + RSTD_OFF); pg8::Unit u;
    for (int i = 0; i < RSTD_MAX_UNITS && S.next(i, u); ++i)
        if ((tid >> 8) == (i & 1)) { const int r = tid & 255; rt[i * 256 + r] = row_rstd(ssq, u.pm * 256 + r); }
    __syncthreads();
}
using pg8::Unit;
__device__ __forceinline__ f32x2 silu_mul_pk(f32x2 g, f32x2 up) {
    const f32x2 t = g * (-LOG2E); f32x2 e; e.x = __builtin_amdgcn_exp2f(t.x); e.y = __builtin_amdgcn_exp2f(t.y);
    const f32x2 d = e + 1.0f; f32x2 r; r.x = __builtin_amdgcn_rcpf(d.x); r.y = __builtin_amdgcn_rcpf(d.y);
    return (g * r) * up;
}
struct EpiSwiGLU {
    static constexpr bool PERM = true;
    const LAS float* rtab; bf16* act; bool skip;
    __device__ __forceinline__ void operator()(const f32x4 (&acc)[2][2][4][2], const Unit& u, int ui, int wr, int wc, int fr, int fq) const {
        if (skip) return;
#pragma unroll
        for (int ai = 0; ai < 2; ++ai)
#pragma unroll
            for (int m = 0; m < 4; ++m) {
                const int rl = ai * 128 + wr * 64 + m * 16 + fr, row = u.pm * 256 + rl;
                const float rs = rtab[ui * 256 + rl];
                f32x2 v[4];
#pragma unroll
                for (int n = 0; n < 2; ++n)
#pragma unroll
                    for (int e = 0; e < 2; ++e) { const f32x2 g = (f32x2){acc[ai][0][m][n][2 * e], acc[ai][0][m][n][2 * e + 1]} * rs, up = (f32x2){acc[ai][1][m][n][2 * e], acc[ai][1][m][n][2 * e + 1]} * rs;
                        v[n * 2 + e] = silu_mul_pk(g, up); }
                v4u w; w.x = pg8::cvt_pk_bf16(v[0].x, v[0].y); w.y = pg8::cvt_pk_bf16(v[1].x, v[1].y); w.z = pg8::cvt_pk_bf16(v[2].x, v[2].y); w.w = pg8::cvt_pk_bf16(v[3].x, v[3].y);
                *(v4u*)(act + (size_t)row * FF + u.pn * 128 + wc * 32 + 8 * fq) = w;
            }
    }
};
struct EpiRes {
    static constexpr bool PERM = true;
    const float* xin; float* xout; bf16* xb; float* ssq; float scale;
    __device__ __forceinline__ void operator()(const f32x4 (&acc)[2][2][4][2], const Unit& u, int ui, int wr, int wc, int fr, int fq) const {
#pragma unroll
        for (int ai = 0; ai < 2; ++ai) {
            f32x4 xv[4][2][2];
#pragma unroll
            for (int m = 0; m < 4; ++m)
#pragma unroll
                for (int bj = 0; bj < 2; ++bj) { const size_t off = (size_t)(u.pm * 256 + ai * 128 + wr * 64 + m * 16 + fr) * D + u.pn * 256 + bj * 128 + wc * 32 + 8 * fq;
                    xv[m][bj][0] = *(const f32x4*)(xin + off); xv[m][bj][1] = *(const f32x4*)(xin + off + 4); }
#pragma unroll
            for (int m = 0; m < 4; ++m) {
                const int row = u.pm * 256 + ai * 128 + wr * 64 + m * 16 + fr;
                float ss = 0.f;
#pragma unroll
                for (int bj = 0; bj < 2; ++bj) {
                    const size_t off = (size_t)row * D + u.pn * 256 + bj * 128 + wc * 32 + 8 * fq;
                    const f32x4 y0 = xv[m][bj][0] + acc[ai][bj][m][0] * scale, y1 = xv[m][bj][1] + acc[ai][bj][m][1] * scale;
                    *(f32x4*)(xout + off) = y0; *(f32x4*)(xout + off + 4) = y1;
                    v4u w; w.x = pg8::cvt_pk_bf16(y0[0], y0[1]); w.y = pg8::cvt_pk_bf16(y0[2], y0[3]); w.z = pg8::cvt_pk_bf16(y1[0], y1[1]); w.w = pg8::cvt_pk_bf16(y1[2], y1[3]);
                    *(v4u*)(xb + off) = w;
                    ss += (y0[0] * y0[0] + y0[1] * y0[1]) + (y0[2] * y0[2] + y0[3] * y0[3]) + (y1[0] * y1[0] + y1[1] * y1[1]) + (y1[2] * y1[2] + y1[3] * y1[3]);
                }
                ss += __shfl_xor(ss, 16); ss += __shfl_xor(ss, 32);
                if (fq == 0) ssq[(size_t)row * 16 + u.pn * 4 + wc] = ss;
            }
            asm volatile("" ::: "memory");
        }
    }
};
struct EpiRnnIn {
    static constexpr bool PERM = true;
    const LAS float* rtab; bf16* Gb; bf16* Ub;
    __device__ __forceinline__ void operator()(const f32x4 (&acc)[2][2][4][2], const Unit& u, int ui, int wr, int wc, int fr, int fq) const {
        const bool is_gate = u.pn < 5; bf16* dstb = is_gate ? Gb : Ub; const int pc = is_gate ? u.pn : u.pn - 5;
#pragma unroll
        for (int ai = 0; ai < 2; ++ai)
#pragma unroll
            for (int m = 0; m < 4; ++m) {
                const int rl = ai * 128 + wr * 64 + m * 16 + fr, row = u.pm * 256 + rl;
                const float rs = rtab[ui * 256 + rl];
#pragma unroll
                for (int bj = 0; bj < 2; ++bj) {
                    f32x2 v[4];
#pragma unroll
                    for (int n = 0; n < 2; ++n)
#pragma unroll
                        for (int e = 0; e < 2; ++e) { f32x2 x = (f32x2){acc[ai][bj][m][n][2 * e], acc[ai][bj][m][n][2 * e + 1]} * rs;
                            if (is_gate) {
                                const f32x2 t = (x * x * 0.044715f + 1.0f) * x * (-1.5957691216057308f * LOG2E); f32x2 ex; ex.x = __builtin_amdgcn_exp2f(t.x); ex.y = __builtin_amdgcn_exp2f(t.y);
                                const f32x2 d = ex + 1.0f; f32x2 r; r.x = __builtin_amdgcn_rcpf(d.x); r.y = __builtin_amdgcn_rcpf(d.y); x = x * r; }
                            v[n * 2 + e] = x; }
                    v4u w; w.x = pg8::cvt_pk_bf16(v[0].x, v[0].y); w.y = pg8::cvt_pk_bf16(v[1].x, v[1].y); w.z = pg8::cvt_pk_bf16(v[2].x, v[2].y); w.w = pg8::cvt_pk_bf16(v[3].x, v[3].y);
                    *(v4u*)(dstb + (size_t)row * DRNN + pc * 256 + bj * 128 + wc * 32 + 8 * fq) = w;
                }
            }
    }
};
struct EpiQKV {
    static constexpr bool PERM = true;
    const LAS float* rtab; const LAS float* gtab; bf16* qkv; bool skip;
    __device__ __forceinline__ void operator()(const f32x4 (&acc)[2][2][4][2], const Unit& u, int ui, int wr, int wc, int fr, int fq) const {
        if (skip) return;
        const int hs = u.pn * 4 + wc, kind = hs / 48, gh = hs - kind * 48, g = gh >> 4, h = gh & 15, l2d = 2 * g;
        bf16* slab = qkv + (size_t)(kind * 3 + g) * ((size_t)M * 1024);
        f32x4 gv[2][2];
#pragma unroll
        for (int bj = 0; bj < 2; ++bj)
#pragma unroll
            for (int n = 0; n < 2; ++n) { gv[bj][n] = (f32x4){1.f, 1.f, 1.f, 1.f}; if (kind < 2) gv[bj][n] = *(const LAS f32x4*)(gtab + kind * 64 + 32 * bj + 8 * fq + 4 * n); }
#pragma unroll
        for (int ai = 0; ai < 2; ++ai)
#pragma unroll
            for (int m = 0; m < 4; ++m) {
                const int rl = ai * 128 + wr * 64 + m * 16 + fr, row = u.pm * 256 + rl;
                const float rs = rtab[ui * 256 + rl];
                f32x4 v[2][2]; float ss = 0.f;
#pragma unroll
                for (int bj = 0; bj < 2; ++bj)
#pragma unroll
                    for (int n = 0; n < 2; ++n) { v[bj][n] = acc[ai][bj][m][n] * rs; const f32x4 t = v[bj][n] * v[bj][n]; ss += (t[0] + t[1]) + (t[2] + t[3]); }
                float rn = 1.f;
                if (kind < 2) { ss += __shfl_xor(ss, 16); ss += __shfl_xor(ss, 32); rn = rsqrtf(ss * (1.0f / HD) + RMS_EPS); }
                const int b = row >> 11, t = row & 2047, rres = t & ((1 << l2d) - 1), l = t >> l2d, L = 2048 >> l2d;
                bf16* dst = slab + ((size_t)(b * 16 + h) * 2048 + rres * L + l) * 64 + 8 * fq;
#pragma unroll
                for (int bj = 0; bj < 2; ++bj) {
                    const f32x4 a0 = v[bj][0] * gv[bj][0] * rn, a1 = v[bj][1] * gv[bj][1] * rn;
                    v4u w; w.x = pg8::cvt_pk_bf16(a0[0], a0[1]); w.y = pg8::cvt_pk_bf16(a0[2], a0[3]); w.z = pg8::cvt_pk_bf16(a1[0], a1[1]); w.w = pg8::cvt_pk_bf16(a1[2], a1[3]);
                    *(v4u*)(dst + 32 * bj) = w;
                }
            }
    }
};

struct Args { const float* in[18]; float* out; unsigned char* ws; int ph_lo, ph_hi; };
enum { I_X = 0, I_NORMG, I_FFN_WIN, I_FFN_WOUT, I_RNN_WIN, I_CONV_W, I_CONV_B, I_WA, I_BA, I_WX, I_BX, I_LAM, I_RNN_WOUT, I_WQKV, I_QGAIN, I_KGAIN, I_WO, I_RELB };

struct Ctx { LAS unsigned char* lds; int tid, lane, wave, G, vcu; unsigned char* ws; };

typedef short v4i16_t __attribute__((ext_vector_type(4)));
__device__ __forceinline__ v4i16_t vtr16(const LAS unsigned char* p) { return __builtin_amdgcn_ds_read_tr16_b64_v4i16((LAS v4i16_t*)p); }
enum { CM_NONE = 0, CM_FFN = 1, CM_QKV = 2 };
__device__ __forceinline__ int colmap(int mode, int vr) {
    if (mode == CM_FFN) { const int pn = vr >> 8, w = vr & 255; return (w >> 7) * FF + 128 * pn + (w & 127); }
    if (mode == CM_QKV) { const int pn = vr >> 8, w = vr & 255, bj = w >> 7, wc = (w >> 5) & 3, j = w & 31; return 256 * pn + 64 * wc + 32 * bj + j; }
    return vr;
}
__device__ __forceinline__ void transpose_item(const float* W, int K, int N, const float* gvec, bf16* WT, int mode, LAS unsigned char* scr, int item, int lane) {
    const int nblk = N / 64, kb = item / nblk, nb = item - kb * nblk, k0 = 64 * kb, vr0 = 64 * nb;
    const int col4 = lane & 15, rsub = lane >> 4, nsrc = colmap(mode, vr0 + 32 * (col4 >> 3)) + (col4 & 7) * 4;
    const float* src = W + (size_t)(k0 + rsub) * N + nsrc;
    f32x4 w[16];
#pragma unroll
    for (int i = 0; i < 16; ++i) w[i] = *(const GAS f32x4*)(src + (size_t)(4 * i) * N);
    if (gvec) {
#pragma unroll
        for (int i = 0; i < 16; ++i) w[i] = w[i] * gvec[k0 + 4 * i + rsub];
    }
#pragma unroll
    for (int i = 0; i < 16; ++i) { v2u p; p.x = pg8::cvt_pk_bf16(w[i][0], w[i][1]); p.y = pg8::cvt_pk_bf16(w[i][2], w[i][3]);
        *(LAS v2u*)(scr + (col4 >> 3) * 4096 + (4 * i + rsub) * 64 + (col4 & 7) * 8) = p; }
    const int q = (lane & 15) >> 2, p4 = lane & 3, gidx = lane >> 4;
#pragma unroll
    for (int r = 0; r < 8; ++r) { const int nb16 = r >> 1, kh = r & 1, kbase = 32 * kh + 8 * gidx;
        const LAS unsigned char* a = scr + (nb16 >> 1) * 4096 + (kbase + q) * 64 + ((nb16 & 1) * 16 + 4 * p4) * 2;
        const v4i16_t lo = vtr16(a), hi = vtr16(a + 4 * 64);
        v4u o; { const v2u l2 = __builtin_bit_cast(v2u, lo), h2 = __builtin_bit_cast(v2u, hi); o.x = l2.x; o.y = l2.y; o.z = h2.x; o.w = h2.y; }
        *(GAS v4u*)(WT + (size_t)(vr0 + nb16 * 16 + (lane & 15)) * K + k0 + kbase) = o; }
}
struct MatJob { const float* W; int K, N; const float* g; bf16* WT; int mode; };
__device__ __forceinline__ MatJob mat_job(const Ctx& C, const Args& a, int idx) {
    unsigned char* ws = C.ws; const float* ng = a.in[I_NORMG]; MatJob j;
    switch (idx) {
    case 0: j = MatJob{a.in[I_FFN_WIN] + (size_t)0 * D * 2 * FF, D, 2 * FF, ng + 0 * D, (bf16*)(ws + WS_WIN0), CM_FFN}; break;
    case 1: j = MatJob{a.in[I_FFN_WOUT] + (size_t)0 * FF * D, FF, D, nullptr, (bf16*)(ws + WS_WOUT0), CM_NONE}; break;
    case 2: j = MatJob{a.in[I_RNN_WIN], D, 2 * DRNN, ng + 1 * D, (bf16*)(ws + WS_WRIN), CM_NONE}; break;
    case 3: j = MatJob{a.in[I_RNN_WOUT], DRNN, D, nullptr, (bf16*)(ws + WS_WROUT), CM_NONE}; break;
    case 4: j = MatJob{a.in[I_FFN_WIN] + (size_t)1 * D * 2 * FF, D, 2 * FF, ng + 2 * D, (bf16*)(ws + WS_WIN1), CM_FFN}; break;
    case 5: j = MatJob{a.in[I_FFN_WOUT] + (size_t)1 * FF * D, FF, D, nullptr, (bf16*)(ws + WS_WOUT1), CM_NONE}; break;
    case 6: j = MatJob{a.in[I_FFN_WIN] + (size_t)2 * D * 2 * FF, D, 2 * FF, ng + 3 * D, (bf16*)(ws + WS_WIN2), CM_FFN}; break;
    case 7: j = MatJob{a.in[I_FFN_WOUT] + (size_t)2 * FF * D, FF, D, nullptr, (bf16*)(ws + WS_WOUT2), CM_NONE}; break;
    case 8: j = MatJob{a.in[I_WQKV], D, NQKV, ng + 4 * D, (bf16*)(ws + WS_WQKV), CM_QKV}; break;
    case 9: j = MatJob{a.in[I_WO], D, D, nullptr, (bf16*)(ws + WS_WO), CM_NONE}; break;
    case 10: j = MatJob{a.in[I_FFN_WIN] + (size_t)3 * D * 2 * FF, D, 2 * FF, ng + 5 * D, (bf16*)(ws + WS_WIN3), CM_FFN}; break;
    default: j = MatJob{a.in[I_FFN_WOUT] + (size_t)3 * FF * D, FF, D, nullptr, (bf16*)(ws + WS_WOUT3), CM_NONE}; break;
    }
    return j;
}
__device__ __forceinline__ void convert_mats(const Ctx& C, const Args& a, int first, int last, int gw, int NGW) {
    LAS unsigned char* scr = C.lds + C.wave * 8192;
    int base = 0;
    for (int mi = first; mi < last; ++mi) {
        const MatJob j = mat_job(C, a, mi); const int cnt = (j.K / 64) * (j.N / 64);
        int it = (gw - base) % NGW; if (it < 0) it += NGW;
        for (; it < cnt; it += NGW) transpose_item(j.W, j.K, j.N, j.g, j.WT, j.mode, scr, it, C.lane);
        base += cnt;
    }
}
__device__ __forceinline__ int t5_bucket(int n) {
    if (n < 16) return n;
    int b = 16;
    b += (n >= 22) + (n >= 30) + (n >= 40) + (n >= 54) + (n >= 73) + (n >= 99) + (n >= 134) + (n >= 182) + (n >= 246) + (n >= 332) + (n >= 450) + (n >= 609) + (n >= 825) + (n >= 1117) + (n >= 1513);
    return b;
}
__device__ __forceinline__ void p_prologue(const Ctx& C, const Args& a) {
    const int gw = C.vcu * NWAVES + C.wave, NGW = C.G * NWAVES;
    convert_mats(C, a, 0, 3, gw, NGW);
    {   LAS unsigned char* scr = C.lds + C.wave * 8192;
        for (int it = gw; it < 2 * NBLK * 4; it += NGW) { const int which = it / (NBLK * 4), r = it % (NBLK * 4), blk = r >> 2, sub = r & 3;
            const float* W = (which ? a.in[I_WX] : a.in[I_WA]) + (size_t)blk * RBLK * RBLK; bf16* WT = (bf16*)(C.ws + (which ? WS_WX : WS_WA)) + (size_t)blk * RBLK * RBLK;
            transpose_item(W, RBLK, RBLK, nullptr, WT, CM_NONE, scr, sub, C.lane); } }
    const float* x = a.in[I_X]; bf16* xb = (bf16*)(C.ws + WS_XB); float* ssq = (float*)(C.ws + WS_SSQ);
    for (int m = gw; m < M; m += NGW) {
        const GAS f32x4* xr = (const GAS f32x4*)(x + (size_t)m * D) + C.lane; f32x4 v[4]; float s = 0.f;
#pragma unroll
        for (int j = 0; j < 4; ++j) { v[j] = xr[64 * j]; s += (v[j].x * v[j].x + v[j].y * v[j].y) + (v[j].z * v[j].z + v[j].w * v[j].w); }
        s = wave_sum(s);
        GAS v2u* o8 = (GAS v2u*)(xb + (size_t)m * D) + C.lane;
#pragma unroll
        for (int j = 0; j < 4; ++j) { v2u w; w.x = pk2(v[j].x, v[j].y); w.y = pk2(v[j].z, v[j].w); o8[64 * j] = w; }
        if (C.lane < 16) ssq[(size_t)m * 16 + C.lane] = (C.lane == 0) ? s : 0.f;
    }
    float* bt = (float*)(C.ws + WS_BIAS); const float* rb = a.in[I_RELB];
    for (int i = blockIdx.x * 512 + C.tid; i < 48 * 129; i += C.G * 512) { const int gh = i / 129, dist = i - gh * 129, g = gh >> 4;
        bt[gh * 132 + dist] = rb[t5_bucket(dist << (2 * g)) * 48 + gh] * LOG2E; }
}

typedef float f32x16 __attribute__((ext_vector_type(16)));
typedef short bf16x8v __attribute__((ext_vector_type(8)));
constexpr int RM_WB = 0, RM_WB_GATE = 64 * 272, RM_CW = 36864, RM_CMP = RM_CW + 2560, RM_TILE = 49152, RM_TILE_BYTES = 36 * 256, RM_END = RM_TILE + 8 * RM_TILE_BYTES;
static_assert(RM_WB + 2 * RM_WB_GATE <= RM_CW && RM_CMP + 2 * 2 * 8 * 64 * 4 <= RM_TILE && RM_END <= RING_BYTES, "rnn-mid LDS map");
__device__ __forceinline__ bf16x8v pack8(const float (&v)[8]) {
    v4u w; w.x = pg8::cvt_pk_bf16(v[0], v[1]); w.y = pg8::cvt_pk_bf16(v[2], v[3]); w.z = pg8::cvt_pk_bf16(v[4], v[5]); w.w = pg8::cvt_pk_bf16(v[6], v[7]);
    return __builtin_bit_cast(bf16x8v, w);
}
__device__ __forceinline__ void p_rnn_mid(const Ctx& C, const Args& a) {
    const bf16* U = (const bf16*)(C.ws + WS_U); const bf16* Gb = (const bf16*)(C.ws + WS_G); bf16* Y = (bf16*)(C.ws + WS_Y);
    const bf16* WAb = (const bf16*)(C.ws + WS_WA); const bf16* WXb = (const bf16*)(C.ws + WS_WX);
    LAS unsigned char* L = C.lds;
    LAS float* CW = (LAS float*)(L + RM_CW); LAS float* CMP = (LAS float*)(L + RM_CMP);
    const int wave = C.wave;
    LAS unsigned char* wt = L + RM_TILE + wave * RM_TILE_BYTES;
    for (int item = blockIdx.x; item < BATCH * NBLK * 2; item += C.G) {
        const int b = item / (NBLK * 2), n = (item % (NBLK * 2)) >> 1, half = item & 1;
        int tid = C.tid; asm volatile("" : "+v"(tid));
        const int lane = tid & 63, r32 = lane & 31, hh = lane >> 5;
        __syncthreads();
#pragma unroll
        for (int p = 0; p < 4; ++p) { const int idx = p * 512 + tid, gate = idx >> 10, rem = idx & 1023, row = rem >> 4, c16 = rem & 15;
            const v4u w = *(const v4u*)((gate ? WXb : WAb) + (size_t)(n * 128 + 64 * half + row) * 128 + c16 * 8);
            *(LAS v4u*)(L + RM_WB + gate * RM_WB_GATE + row * 272 + c16 * 16) = w; }
        CW[tid] = a.in[I_CONV_W][(tid >> 7) * DRNN + n * 128 + (tid & 127)];
        if (tid < 128) CW[512 + tid] = a.in[I_CONV_B][n * 128 + tid];
        __syncthreads();
        float ba[2], bx[2], spl[2], Ht[2];
#pragma unroll
        for (int cb = 0; cb < 2; ++cb) { const int ch = n * 128 + 64 * half + 32 * cb + r32; ba[cb] = a.in[I_BA][ch]; bx[cb] = a.in[I_BX][ch];
            spl[cb] = -8.0f * LOG2E * log1pf(expf(-a.in[I_LAM][ch])); Ht[cb] = 0.f; }
        bf16x8v idf[2];
#pragma unroll
        for (int sp = 0; sp < 2; ++sp)
#pragma unroll
            for (int j = 0; j < 8; ++j) idf[sp][j] = (16 * sp + 8 * hh + j == r32) ? (short)0x3F80 : (short)0;
        const int urow = lane >> 4, uch = lane & 15, grow = lane >> 3, gch = lane & 7;
        v4u uraw[9], graw[4];
#define RM_LOADU(TILE) do { const int tp_ = (TILE) * 256 + wave * 32; const int ub_ = (b * SEQ + tp_ - 3 + urow) * DRNN + n * 128 + uch * 8;        \
        _Pragma("unroll") for (int i_ = 0; i_ < 9; ++i_) uraw[i_] = *(const v4u*)(U + (ptrdiff_t)(ub_ + i_ * 4 * DRNN)); \
        if (tp_ == 0 && urow < 3) uraw[0] = (v4u){0u, 0u, 0u, 0u};         } while (0)
#define RM_LOADG(TILE) do { const int gb_ = (b * SEQ + (TILE) * 256 + wave * 32 + grow) * DRNN + n * 128 + 64 * half + gch * 8; \
        _Pragma("unroll") for (int i_ = 0; i_ < 4; ++i_) graw[i_] = *(const v4u*)(Gb + (unsigned)(gb_ + i_ * 8 * DRNN)); } while (0)
        for (int tile = 0; tile < 8; ++tile) {
            const int tposw = tile * 256 + wave * 32;
            const size_t tok0 = (size_t)b * SEQ + tposw;
            LAS float* CWt = CW; LAS unsigned char* WBt = L + RM_WB; asm volatile("" : "+v"(CWt), "+v"(WBt));
            RM_LOADU(tile); RM_LOADG(tile);
#pragma unroll
            for (int i = 0; i < 9; ++i) { const int rl = 4 * i + urow; *(LAS v4u*)(wt + rl * 256 + ((uch ^ (rl & 15)) << 4)) = uraw[i]; }
            bf16x8v af[8];
#pragma unroll
            for (int s = 0; s < 8; ++s) {
                const int c0 = 16 * s + 8 * hh;
                float v[8];
                { const f32x4 b0 = *(const LAS f32x4*)(CWt + 512 + c0), b1 = *(const LAS f32x4*)(CWt + 512 + c0 + 4);
                  v[0] = b0[0]; v[1] = b0[1]; v[2] = b0[2]; v[3] = b0[3]; v[4] = b1[0]; v[5] = b1[1]; v[6] = b1[2]; v[7] = b1[3]; }
#pragma unroll
                for (int k = 0; k < 4; ++k) { const f32x4 w0 = *(const LAS f32x4*)(CWt + k * 128 + c0), w1 = *(const LAS f32x4*)(CWt + k * 128 + c0 + 4);
                    const v4u uu = *(const LAS v4u*)(wt + (r32 + k) * 256 + (((2 * s + hh) ^ ((r32 + k) & 15)) << 4));
                    v[0] += w0[0] * bf_lo(uu.x); v[1] += w0[1] * bf_hi(uu.x); v[2] += w0[2] * bf_lo(uu.y); v[3] += w0[3] * bf_hi(uu.y);
                    v[4] += w1[0] * bf_lo(uu.z); v[5] += w1[1] * bf_hi(uu.z); v[6] += w1[2] * bf_lo(uu.w); v[7] += w1[3] * bf_hi(uu.w); }
                af[s] = pack8(v);
                __builtin_amdgcn_sched_barrier(0);
            }
#pragma unroll
            for (int i = 0; i < 4; ++i) *(LAS v4u*)(wt + (8 * i + grow) * 128 + gch * 16) = graw[i];
            f32x16 acc[2][2], ufa[2];
#pragma unroll
            for (int cb = 0; cb < 2; ++cb)
#pragma unroll
                for (int e = 0; e < 16; ++e) { acc[0][cb][e] = 0.f; acc[1][cb][e] = 0.f; ufa[cb][e] = 0.f; }
#pragma unroll
            for (int s = 0; s < 8; ++s)
#pragma unroll
                for (int gt = 0; gt < 2; ++gt)
#pragma unroll
                    for (int cb = 0; cb < 2; ++cb) {
                        const bf16x8v bfr = *(const LAS bf16x8v*)(WBt + gt * RM_WB_GATE + (32 * cb + r32) * 272 + (16 * s + 8 * hh) * 2);
                        acc[gt][cb] = __builtin_amdgcn_mfma_f32_32x32x16_bf16(af[s], bfr, acc[gt][cb], 0, 0, 0);
                        if (gt == 1 && cb == 1 && (s & 1)) __builtin_amdgcn_sched_barrier(0);
                    }
#pragma unroll
            for (int cb = 0; cb < 2; ++cb)
#pragma unroll
                for (int sp = 0; sp < 2; ++sp) { const bf16x8v asel = half ? af[4 + 2 * cb + sp] : af[2 * cb + sp];
                    ufa[cb] = __builtin_amdgcn_mfma_f32_32x32x16_bf16(asel, idf[sp], ufa[cb], 0, 0, 0); }
#pragma unroll
            for (int cb = 0; cb < 2; ++cb)
#pragma unroll
                for (int e = 0; e < 16; ++e) {
                    const float uf = ufa[cb][e];
                    const float r = fast_sigmoid(acc[0][cb][e] + ba[cb]), ii = fast_sigmoid(acc[1][cb][e] + bx[cb]);
                    const float av = __builtin_amdgcn_exp2f(r * spl[cb]);
                    const float bv = __builtin_amdgcn_sqrtf(fmaxf(1.f - av * av, 0.f)) * (ii * uf);
                    acc[0][cb][e] = av; acc[1][cb][e] = bv;
                }
            float A0[2][4], B0[2][4], A1[2][4], B1[2][4];
            const int par = tile & 1;
#pragma unroll
            for (int cb = 0; cb < 2; ++cb) {
                float Aw = 1.f, Bw = 0.f;
#pragma unroll
                for (int q = 0; q < 4; ++q) {
                    const float a0 = acc[0][cb][4 * q], a1 = acc[0][cb][4 * q + 1], a2 = acc[0][cb][4 * q + 2], a3 = acc[0][cb][4 * q + 3];
                    const float Ag = (a0 * a1) * (a2 * a3);
                    const float Bg = ((acc[1][cb][4 * q] * a1 + acc[1][cb][4 * q + 1]) * a2 + acc[1][cb][4 * q + 2]) * a3 + acc[1][cb][4 * q + 3];
                    const float pA = __shfl_xor(Ag, 32), pB = __shfl_xor(Bg, 32);
                    A0[cb][q] = hh ? pA : Ag; B0[cb][q] = hh ? pB : Bg; A1[cb][q] = hh ? Ag : pA; B1[cb][q] = hh ? Bg : pB;
                    Bw = Bw * A0[cb][q] + B0[cb][q]; Aw *= A0[cb][q]; Bw = Bw * A1[cb][q] + B1[cb][q]; Aw *= A1[cb][q];
                }
                if (hh == 0) { CMP[((par * 2 + 0) * 8 + wave) * 64 + 32 * cb + r32] = Aw; CMP[((par * 2 + 1) * 8 + wave) * 64 + 32 * cb + r32] = Bw; }
            }
            __syncthreads();
#pragma unroll
            for (int cb = 0; cb < 2; ++cb) {
                float h = Ht[cb], hin = 0.f;
#pragma unroll
                for (int v = 0; v < 8; ++v) { const float Av = CMP[((par * 2 + 0) * 8 + v) * 64 + 32 * cb + r32], Bv = CMP[((par * 2 + 1) * 8 + v) * 64 + 32 * cb + r32];
                    hin = (v == wave) ? h : hin; h = Av * h + Bv; }
                Ht[cb] = h;
                float hc = hin;
#pragma unroll
                for (int q = 0; q < 4; ++q) {
                    const float c0 = hc; hc = A0[cb][q] * hc + B0[cb][q]; const float c1 = hc; hc = A1[cb][q] * hc + B1[cb][q];
                    float hv = hh ? c1 : c0;
#pragma unroll
                    for (int i = 0; i < 4; ++i) { const int e = 4 * q + i; hv = acc[0][cb][e] * hv + acc[1][cb][e];
                        const int tl = (e & 3) + 8 * (e >> 2) + 4 * hh;
                        LAS bf16* gp = (LAS bf16*)(wt + tl * 128 + (32 * cb + r32) * 2);
                        *gp = (bf16)f2bf(hv * bf2f(*gp)); }
                }
            }
#pragma unroll
            for (int i = 0; i < 4; ++i) { const v4u w = *(const LAS v4u*)(wt + (8 * i + grow) * 128 + gch * 16);
                *(v4u*)(Y + (unsigned)(((int)tok0 + 8 * i + grow) * DRNN + n * 128 + 64 * half + gch * 8)) = w; }
        }
#undef RM_LOADU
#undef RM_LOADG
    }
    const int nitems = BATCH * NBLK * 2;
    if (C.G > nitems) { if ((int)blockIdx.x >= nitems) convert_mats(C, a, 3, 10, ((int)blockIdx.x - nitems) * NWAVES + wave, (C.G - nitems) * NWAVES); }
    else { __syncthreads(); convert_mats(C, a, 3, 10, (int)blockIdx.x * NWAVES + wave, C.G * NWAVES); }
}
constexpr int AT_EXT = 0, AT_VT = 48 * 192 * 4;
struct AttnUnit { bf16* qbase; const bf16* kres; const bf16* vres; int l0, kb_lo, eoff, g, bh, llin0; };
__device__ __forceinline__ AttnUnit attn_unit(bf16* QKV, int it, int wave) {
    AttnUnit u; const size_t SLAB = (size_t)M * 1024;
    const int g = it >> 10, rem = it & 1023, bh = rem >> 3, chunk = (rem + (it >> 8)) & 7, l2d = 2 * g, L = SEQ >> l2d;
    u.g = g; u.bh = bh; u.llin0 = chunk * 256 + wave * 32; u.l0 = u.llin0 & (L - 1); u.kb_lo = (u.l0 - 128) > 0 ? (u.l0 - 128) : 0; u.eoff = (g * 16 + (bh & 15)) * 192;
    u.qbase = QKV + (size_t)g * SLAB + ((size_t)bh * SEQ + u.llin0) * HD;
    u.kres = u.qbase + 3 * SLAB - (size_t)u.l0 * HD; u.vres = u.qbase + 6 * SLAB - (size_t)u.l0 * HD;
    return u;
}
__device__ __forceinline__ void p_attn(const Ctx& C, const bool dry) {
    bf16* QKV = (bf16*)(C.ws + WS_QKV); float* LSE = (float*)(C.ws + WS_LSE); const float* bt = (const float*)(C.ws + WS_BIAS);
    LAS float* ext = (LAS float*)(C.lds + AT_EXT);
    LAS unsigned char* vt = C.lds + AT_VT + C.wave * 8192; LAS unsigned char* kt = vt + 4096;
    const int lane = C.lane, r32 = lane & 31, hh = lane >> 5, wave = C.wave, tid = C.tid;
    const int crow8 = lane >> 3, cch = lane & 7;
    const int vtr_off = (4 * hh + ((lane & 15) >> 2)) * 64 + ((lane >> 4) & 1) * 32 + (lane & 3) * 8;
    for (int i = tid; i < 48 * 192; i += 512) { const int gh = i / 192, dist = i - gh * 192 - 32; ext[i] = (dist >= 0 && dist <= 128) ? bt[gh * 132 + dist] : -1e30f; }
    __syncthreads();
    const int total = NGRP * BATCH * NHEAD * 8;
    int it = blockIdx.x;
    if (it >= total) return;
    AttnUnit cu = attn_unit(QKV, it, wave), nu = cu;
    v4u qfn[4], kfn[4], vvn[4];
#define AT_LOADKV(U, KB) do { const bf16* kblk_ = (U).kres + (size_t)(KB) * HD; const bf16* vblk_ = (U).vres + (size_t)(KB) * HD; \
        _Pragma("unroll") for (int i_ = 0; i_ < 4; ++i_) { vvn[i_] = *(const v4u*)(vblk_ + (8 * i_ + crow8) * HD + cch * 8); kfn[i_] = *(const v4u*)(kblk_ + (8 * i_ + crow8) * HD + cch * 8); } } while (0)
#define AT_LOADQ(U) do { _Pragma("unroll") for (int i_ = 0; i_ < 4; ++i_) qfn[i_] = *(const v4u*)((U).qbase + (8 * i_ + crow8) * HD + cch * 8); } while (0)
#define AT_TILE2FRAG(RAW, FR) do { _Pragma("unroll") for (int i_ = 0; i_ < 4; ++i_) *(LAS v4u*)(kt + (8 * i_ + crow8) * 128 + ((cch ^ crow8) << 4)) = RAW[i_]; \
        _Pragma("unroll") for (int s_ = 0; s_ < 4; ++s_) FR[s_] = *(const LAS bf16x8v*)(kt + r32 * 128 + (((2 * s_ + hh) ^ (r32 & 7)) << 4)); } while (0)
    AT_LOADQ(cu); AT_LOADKV(cu, cu.l0);
    for (;;) {
        bf16x8v qf[4];
        AT_TILE2FRAG(qfn, qf);
        f32x16 o0, o1;
#pragma unroll
        for (int e = 0; e < 16; ++e) { o0[e] = 0.f; o1[e] = 0.f; }
        float mrow = -1e30f, lsum = 0.f;
        const bool has_next = (it + C.G) < total;
        for (int kb = cu.l0; kb >= cu.kb_lo; kb -= 32) {
            v4u vv[4], kraw[4]; bf16x8v kf[4];
#pragma unroll
            for (int i = 0; i < 4; ++i) { vv[i] = vvn[i]; kraw[i] = kfn[i]; }
            if (kb - 32 >= cu.kb_lo) { AT_LOADKV(cu, kb - 32); }
            else if (has_next) { nu = attn_unit(QKV, it + C.G, wave); AT_LOADQ(nu); AT_LOADKV(nu, nu.l0); }
#pragma unroll
            for (int i = 0; i < 4; ++i) *(LAS v4u*)(vt + (cch >> 2) * 2048 + (8 * i + crow8) * 64 + (cch & 3) * 16) = vv[i];
            AT_TILE2FRAG(kraw, kf);
            f32x16 p;
#pragma unroll
            for (int e = 0; e < 16; ++e) p[e] = 0.f;
#pragma unroll
            for (int s = 0; s < 4; ++s) p = __builtin_amdgcn_mfma_f32_32x32x16_bf16(kf[s], qf[s], p, 0, 0, 0);
            const int eb = cu.eoff + cu.l0 + r32 - kb - 4 * hh + 32;
            float bm = -1e30f;
#pragma unroll
            for (int e = 0; e < 16; ++e) { p[e] += ext[eb - ((e & 3) + 8 * (e >> 2))]; bm = fmaxf(bm, p[e]); }
            bm = fmaxf(bm, __shfl_xor(bm, 32));
            const float mn = fmaxf(mrow, bm), alpha = __builtin_amdgcn_exp2f(mrow - mn); mrow = mn;
            float ps = 0.f;
#pragma unroll
            for (int e = 0; e < 16; ++e) { p[e] = __builtin_amdgcn_exp2f(p[e] - mn); ps += p[e]; }
            lsum = lsum * alpha + ps;
#pragma unroll
            for (int e = 0; e < 16; ++e) { o0[e] *= alpha; o1[e] *= alpha; }
            bf16x8v pf[2];
#pragma unroll
            for (int s = 0; s < 2; ++s) { const float t8[8] = {p[8 * s], p[8 * s + 1], p[8 * s + 2], p[8 * s + 3], p[8 * s + 4], p[8 * s + 5], p[8 * s + 6], p[8 * s + 7]}; pf[s] = pack8(t8); }
#pragma unroll
            for (int s = 0; s < 2; ++s) {
                const v4i16_t a00 = vtr16(vt + 0 * 2048 + (16 * s) * 64 + vtr_off), a01 = vtr16(vt + 0 * 2048 + (16 * s + 8) * 64 + vtr_off);
                const v4i16_t a10 = vtr16(vt + 1 * 2048 + (16 * s) * 64 + vtr_off), a11 = vtr16(vt + 1 * 2048 + (16 * s + 8) * 64 + vtr_off);
                const bf16x8v va0 = (bf16x8v){a00[0], a00[1], a00[2], a00[3], a01[0], a01[1], a01[2], a01[3]};
                const bf16x8v va1 = (bf16x8v){a10[0], a10[1], a10[2], a10[3], a11[0], a11[1], a11[2], a11[3]};
                o0 = __builtin_amdgcn_mfma_f32_32x32x16_bf16(va0, pf[s], o0, 0, 0, 0);
                o1 = __builtin_amdgcn_mfma_f32_32x32x16_bf16(va1, pf[s], o1, 0, 0, 0);
            }
        }
        const float ltot = lsum + __shfl_xor(lsum, 32), inv = 1.f / ltot;
#pragma unroll
        for (int q = 0; q < 4; ++q) {
            v2u w0, w1;
            w0.x = pg8::cvt_pk_bf16(o0[4 * q] * inv, o0[4 * q + 1] * inv); w0.y = pg8::cvt_pk_bf16(o0[4 * q + 2] * inv, o0[4 * q + 3] * inv);
            w1.x = pg8::cvt_pk_bf16(o1[4 * q] * inv, o1[4 * q + 1] * inv); w1.y = pg8::cvt_pk_bf16(o1[4 * q + 2] * inv, o1[4 * q + 3] * inv);
            *(LAS v2u*)(kt + r32 * 128 + ((q ^ (r32 & 7)) << 4) + 8 * hh) = w0; *(LAS v2u*)(kt + r32 * 128 + (((4 + q) ^ (r32 & 7)) << 4) + 8 * hh) = w1;
        }
        if (!dry)
#pragma unroll
        for (int i = 0; i < 4; ++i) { const v4u w = *(const LAS v4u*)(kt + (8 * i + crow8) * 128 + ((cch ^ crow8) << 4)); *(v4u*)(cu.qbase + (8 * i + crow8) * HD + cch * 8) = w; }
        if (hh == 0) { const int l2d = 2 * cu.g, L = SEQ >> l2d, llin = cu.llin0 + r32, rres = llin >> (11 - l2d), l = llin & (L - 1), t = (l << l2d) + rres, row = (cu.bh >> 4) * SEQ + t;
            LSE[((size_t)cu.g * M + row) * 16 + (cu.bh & 15)] = mrow + log2f(ltot); }
        if (!has_next) break;
        it += C.G; cu = nu;
    }
#undef AT_LOADKV
#undef AT_LOADQ
#undef AT_TILE2FRAG
}
__device__ __forceinline__ void p_merge(const Ctx& C, const Args& a) {
    const bf16* QKV = (const bf16*)(C.ws + WS_QKV); const float* LSE = (const float*)(C.ws + WS_LSE); bf16* ATT = (bf16*)(C.ws + WS_ATT);
    for (int idx = blockIdx.x * 512 + C.tid; idx < M * 16 * 8; idx += C.G * 512) {
        const int ch = idx & 7, h = (idx >> 3) & 15, row = idx >> 7, b = row >> 11, t = row & 2047;
        float ls[3], mxl = -INFINITY;
#pragma unroll
        for (int g = 0; g < 3; ++g) { ls[g] = LSE[((size_t)g * M + row) * 16 + h]; mxl = fmaxf(mxl, ls[g]); }
        float acc[8], wsum = 0.f;
#pragma unroll
        for (int e = 0; e < 8; ++e) acc[e] = 0.f;
#pragma unroll
        for (int g = 0; g < 3; ++g) { const float w = exp2f(ls[g] - mxl); wsum += w; const int l2d = 2 * g, rres = t & ((1 << l2d) - 1), l = t >> l2d, L = SEQ >> l2d;
            const v4u v = *(const v4u*)(QKV + (size_t)g * ((size_t)M * 1024) + ((size_t)(b * 16 + h) * SEQ + rres * L + l) * HD + 8 * ch);
            acc[0] += w * bf_lo(v.x); acc[1] += w * bf_hi(v.x); acc[2] += w * bf_lo(v.y); acc[3] += w * bf_hi(v.y); acc[4] += w * bf_lo(v.z); acc[5] += w * bf_hi(v.z); acc[6] += w * bf_lo(v.w); acc[7] += w * bf_hi(v.w); }
        const float inv = 1.f / wsum; v4u o; o.x = pk2(acc[0] * inv, acc[1] * inv); o.y = pk2(acc[2] * inv, acc[3] * inv); o.z = pk2(acc[4] * inv, acc[5] * inv); o.w = pk2(acc[6] * inv, acc[7] * inv);
        *(v4u*)(ATT + (size_t)row * 1024 + h * 64 + 8 * ch) = o;
    }
    convert_mats(C, a, 10, 12, C.vcu * NWAVES + C.wave, C.G * NWAVES);
}

enum { PH_PROLOGUE = 0, PH_FFN_IN_0, PH_FFN_OUT_0, PH_RNN_IN, PH_RNN_MID, PH_RNN_OUT, PH_FFN_IN_1, PH_FFN_OUT_1,
       PH_FFN_IN_2, PH_FFN_OUT_2, PH_QKV, PH_ATTN, PH_MERGE, PH_WO, PH_FFN_IN_3, PH_FFN_OUT_3, NPHASE };

__global__ void __launch_bounds__(NWAVES * 64, 2) fwd_kernel(Args args) {
    extern __shared__ __attribute__((aligned(16))) unsigned char lds_raw[];
    Ctx C; C.lds = (LAS unsigned char*)lds_raw; C.tid = threadIdx.x; C.lane = C.tid & 63; C.wave = __builtin_amdgcn_readfirstlane(C.tid >> 6);
    C.G = gridDim.x; { const int bx = blockIdx.x; C.vcu = (C.G % 8 == 0) ? (bx % 8) * (C.G / 8) + bx / 8 : bx; }
    C.ws = args.ws;
    volatile LAS unsigned* MISC = (volatile LAS unsigned*)(C.lds + MISC_OFF);
    for (int u = C.tid; u < (LDS_BYTES - LDSCTL_OFF) / 4; u += NWAVES * 64) ((LAS unsigned*)(C.lds + LDSCTL_OFF))[u] = 0u;
    __syncthreads();
    unsigned* ctl = (unsigned*)args.ws;
    XcdBarrier bar; bar.bar = ctl + CW_BAR; bar.x = 0; bar.st = nullptr;
    const bool multi = (args.ph_hi - args.ph_lo) > 1;
    if (multi) bar = xcd_barrier_post(ctl + CW_BAR, MISC + 8);
    for (int ph = args.ph_lo; ph < args.ph_hi; ++ph) {
        for (int rep = ((DUP_MASK >> ph) & 1u) ? DUP_N : 0; rep >= 0; --rep) {
        const bool dry = rep > 0;
        { int t_ = threadIdx.x; asm volatile("" : "+v"(t_)); C.tid = t_; C.lane = t_ & 63; }
        unsigned char* ws = args.ws; asm volatile("" : "+s"(ws));
        C.ws = ws; float* ssq = (float*)(ws + WS_SSQ); bf16* xb = (bf16*)(ws + WS_XB);
        switch (ph) {
        case PH_PROLOGUE: p_prologue(C, args); break;
        case PH_FFN_IN_0: case PH_FFN_IN_1: case PH_FFN_IN_2: case PH_FFN_IN_3: {
            const bf16* Bt = (const bf16*)(ws + (ph == PH_FFN_IN_0 ? WS_WIN0 : ph == PH_FFN_IN_1 ? WS_WIN1 : ph == PH_FFN_IN_2 ? WS_WIN2 : WS_WIN3));
            bf16* act = (bf16*)(ws + (ph == PH_FFN_IN_3 ? WS_ACT3 : WS_ACT));
            pg8::Gemm g{xb, Bt, M, 2 * FF, D}; pg8::StaticOrder S; S.init(M, 2 * FF, C.G, (int)blockIdx.x);
            fill_rstd(C.lds, S, ssq, C.tid);
            EpiSwiGLU E{(const LAS float*)(C.lds + RSTD_OFF), act, dry && DUP_SKIP_EPI};
            pg8::gemm_phase<EpiSwiGLU, pg8::StaticOrder, true, true>(C.lds, g, S, E);
        } break;
        case PH_FFN_OUT_0: case PH_FFN_OUT_1: case PH_FFN_OUT_2: case PH_FFN_OUT_3: case PH_RNN_OUT: case PH_WO: {
            const bf16* A; const bf16* Bt; int K; float scale = 0.5f; const float* xin = args.out;
            if (ph == PH_FFN_OUT_0) { A = (const bf16*)(ws + WS_ACT); Bt = (const bf16*)(ws + WS_WOUT0); K = FF; xin = args.in[I_X]; }
            else if (ph == PH_FFN_OUT_1) { A = (const bf16*)(ws + WS_ACT); Bt = (const bf16*)(ws + WS_WOUT1); K = FF; }
            else if (ph == PH_FFN_OUT_2) { A = (const bf16*)(ws + WS_ACT); Bt = (const bf16*)(ws + WS_WOUT2); K = FF; }
            else if (ph == PH_FFN_OUT_3) { A = (const bf16*)(ws + WS_ACT3); Bt = (const bf16*)(ws + WS_WOUT3); K = FF; }
            else if (ph == PH_RNN_OUT) { A = (const bf16*)(ws + WS_Y); Bt = (const bf16*)(ws + WS_WROUT); K = DRNN; scale = 1.f; }
            else { A = (const bf16*)(ws + WS_ATT); Bt = (const bf16*)(ws + WS_WO); K = D; scale = 1.f; }
            if (dry && ph != PH_FFN_OUT_0) scale = 0.f;
            pg8::Gemm g{A, Bt, M, D, K}; pg8::StaticOrder S; S.init(M, D, C.G, (int)blockIdx.x);
            EpiRes E{xin, args.out, xb, ssq, scale};
            pg8::gemm_phase<EpiRes, pg8::StaticOrder, false, true>(C.lds, g, S, E);
        } break;
        case PH_RNN_IN: {
            pg8::Gemm g{xb, (const bf16*)(ws + WS_WRIN), M, 2 * DRNN, D}; pg8::StaticOrder S; S.init(M, 2 * DRNN, C.G, (int)blockIdx.x);
            fill_rstd(C.lds, S, ssq, C.tid);
            EpiRnnIn E{(const LAS float*)(C.lds + RSTD_OFF), (bf16*)(ws + WS_G), (bf16*)(ws + WS_U)};
            pg8::gemm_phase<EpiRnnIn, pg8::StaticOrder, true, true>(C.lds, g, S, E);
        } break;
        case PH_RNN_MID: p_rnn_mid(C, args); break;
        case PH_QKV: {
            pg8::Gemm g{xb, (const bf16*)(ws + WS_WQKV), M, NQKV, D}; pg8::StaticOrder S; S.init(M, NQKV, C.G, (int)blockIdx.x);
            if (C.tid < 128) ((LAS float*)(C.lds + GAIN_OFF))[C.tid] = (C.tid < 64) ? args.in[I_QGAIN][C.tid] * (0.125f * LOG2E) : args.in[I_KGAIN][C.tid - 64];
            fill_rstd(C.lds, S, ssq, C.tid);
            EpiQKV E{(const LAS float*)(C.lds + RSTD_OFF), (const LAS float*)(C.lds + GAIN_OFF), (bf16*)(ws + WS_QKV), dry && DUP_SKIP_EPI};
            pg8::gemm_phase<EpiQKV, pg8::StaticOrder, true, true>(C.lds, g, S, E);
        } break;
        case PH_ATTN: p_attn(C, dry); break;
        case PH_MERGE: p_merge(C, args); break;
        default: break;
        }
        if (dry || ph + 1 < args.ph_hi) xcd_barrier(bar);
        }
    }
}

extern "C" void kernel_launch(void* const* d_in, const int* in_sizes, int n_in, void* d_out, int out_size, void* d_ws, size_t ws_size, hipStream_t stream) {
    static int grid = 0;
    if (grid == 0) {
        if (n_in != 18 || in_sizes[0] != M * D || out_size != M * D || ws_size < WS_END) { fprintf(stderr, "kernel_launch: unexpected shapes (n_in %d, in0 %d, out %d, ws %zu)\n", n_in, n_in > 0 ? in_sizes[0] : -1, out_size, ws_size); grid = -1; return; }
        int dev = 0, cus = 0, per_cu = 0;
        if (hipGetDevice(&dev) != hipSuccess || hipDeviceGetAttribute(&cus, hipDeviceAttributeMultiprocessorCount, dev) != hipSuccess) { fprintf(stderr, "kernel_launch: device query failed\n"); grid = -1; return; }
        if (hipFuncSetAttribute((const void*)fwd_kernel, hipFuncAttributeMaxDynamicSharedMemorySize, LDS_BYTES) != hipSuccess) { fprintf(stderr, "kernel_launch: hipFuncSetAttribute failed\n"); grid = -1; return; }
        if (hipOccupancyMaxActiveBlocksPerMultiprocessor(&per_cu, (const void*)fwd_kernel, NWAVES * 64, LDS_BYTES) != hipSuccess || per_cu < 1) { fprintf(stderr, "kernel_launch: occupancy query says %d blocks per CU\n", per_cu); (void)hipGetLastError(); grid = -1; return; }
        grid = cus;
    }
    if (grid < 0) return;
    if (hipMemsetAsync(d_ws, 0, CTL_ZERO_BYTES, stream) != hipSuccess) { fprintf(stderr, "kernel_launch: memset failed\n"); return; }
    Args a{};
    for (int i = 0; i < 18; ++i) a.in[i] = (const float*)d_in[i];
    a.out = (float*)d_out; a.ws = (unsigned char*)d_ws;
#if SINGLE_LAUNCH
    a.ph_lo = 0; a.ph_hi = NPHASE;
    hipLaunchKernelGGL(fwd_kernel, dim3(grid), dim3(NWAVES * 64), LDS_BYTES, stream, a);
#else
    for (int ph = 0; ph < NPHASE; ++ph) { a.ph_lo = ph; a.ph_hi = ph + 1; hipLaunchKernelGGL(fwd_kernel, dim3(grid), dim3(NWAVES * 64), LDS_BYTES, stream, a); }
#endif
}
```

```cpp
#include <hip/hip_runtime.h>
#include <cstdio>
#include <cstdint>

#ifndef SINGLE_LAUNCH
#define SINGLE_LAUNCH 1
#define DUP_MASK 0u
#define DUP_N 1
#define DUP_EXTRA_BARRIERS 0
#define DUP_SKIP_EPI 0
#endif

namespace pg8 {
#define PG8_LAS __attribute__((address_space(3)))
typedef unsigned short bf16_t;
typedef short bf16x8 __attribute__((ext_vector_type(8)));
typedef float f32x4 __attribute__((ext_vector_type(4)));
typedef unsigned u32x4 __attribute__((ext_vector_type(4)));
constexpr int BM = 256, BK = 64, HALF = 128, HTB = HALF * BK * 2, STAGE_BYTES = 8 * HTB, NXCD = 8, WGM = 8;

__host__ __device__ __forceinline__ int lds_byte(int r, int c) { const int st = (r >> 4) * 2 + (c >> 5), rr = r & 15, cc = c & 31, ob = rr * 64 + cc * 2; return st * 1024 + (ob ^ (((ob >> 9) & 1) << 5)); }
__host__ __device__ __forceinline__ void stage_rc(int b, int& R, int& C) { const int st = b / 1024, sb = b % 1024, swz = sb ^ (((sb >> 9) & 1) << 5); R = (st >> 1) * 16 + swz / 64; C = (st & 1) * 32 + (swz % 64) / 2; }
__host__ __device__ __forceinline__ int perm32(int rho) { const int n = rho >> 4, i = rho & 15; return 8 * (i >> 2) + 4 * n + (i & 3); }

struct Unit { int pm, pn; };
struct Gemm { const bf16_t* A; const bf16_t* Bt; int M, N, K; };

struct StaticOrder {
    int nM, nN, nwg, G, c;
    __host__ __device__ void init(int M, int N, int G_, int c_) { nM = M / BM; nN = N / BM; nwg = nM * nN; G = G_; c = c_; }
    __host__ __device__ bool next(int i, Unit& u) const {
        const long L = (long)i * G + c; if (L >= nwg) return false;
        int wgid = (int)L; { const int q = nwg / NXCD, r = nwg % NXCD, xcd = wgid % NXCD, off = wgid / NXCD; wgid = (xcd < r ? xcd * (q + 1) : r * (q + 1) + (xcd - r) * q) + off; }
        const int nig = WGM * nN, gid = wgid / nig, fm = gid * WGM, gsz = (nM - fm) < WGM ? (nM - fm) : WGM;
        u.pm = fm + ((wgid % nig) % gsz); u.pn = (wgid % nig) / gsz; return true;
    }
    __device__ __forceinline__ void a_ready(const Unit&) const {}
    __device__ __forceinline__ void done(const Unit&) const {}
};

__device__ __forceinline__ unsigned cvt_pk_bf16(float lo, float hi) { unsigned r; asm volatile("v_cvt_pk_bf16_f32 %0, %1, %2" : "=v"(r) : "v"(lo), "v"(hi)); return r; }

template <class Epi, class Sched, bool ALIGN_EPI = false, bool SP2 = false>
__device__ __forceinline__ void gemm_phase(PG8_LAS unsigned char* lds, const Gemm g, const Sched& S, const Epi& E) {
    int tid_ = threadIdx.x; asm volatile("" : "+v"(tid_));
    const int tid = tid_, wid = __builtin_amdgcn_readfirstlane(tid >> 6), lane = tid & 63, wr = wid >> 2, wc = wid & 3, fr = lane & 15, fq = lane >> 4;
    const int K = g.K, nt = K / BK;
    unsigned voffA[2], voffB[2];
#pragma unroll
    for (int i = 0; i < 2; ++i) { int R, C; stage_rc(tid * 16 + i * 8192, R, C); const int Rb = Epi::PERM ? ((R & ~31) + perm32(R & 31)) : R;
        voffA[i] = (unsigned)(R * K + C) * 2u; voffB[i] = (unsigned)(Rb * K + C) * 2u; }
    const size_t kstep = (size_t)(BK * 2);
    const size_t hstep = (size_t)HALF * K * 2;
    const size_t tstep = 2 * hstep;
    const unsigned ldsw = (unsigned)wid * 1024u;
    const int aoff = lds_byte(wr * 64 + fr, fq * 8), boff = lds_byte(wc * 32 + fr, fq * 8);
#define PG8_SA(b, h) (((b) * 2 + (h)) * HTB)
#define PG8_SB(b, h) ((4 + (b) * 2 + (h)) * HTB)
#define PG8_STAGE(bufoff, gbase, voff) do { _Pragma("unroll") for (int _i = 0; _i < 2; ++_i) \
        __builtin_amdgcn_global_load_lds((const unsigned*)((const char*)(gbase) + (voff)[_i]), (PG8_LAS unsigned*)(lds + (bufoff) + ldsw + _i * 8192), 16, 0, 0); } while (0)
#define PG8_LDA(dst, b, h) do { _Pragma("unroll") for (int m = 0; m < 4; ++m) _Pragma("unroll") for (int k = 0; k < 2; ++k) dst[m][k] = *(const PG8_LAS bf16x8*)(lds + PG8_SA(b, h) + aoff + m * 2048 + k * 1024); } while (0)
#define PG8_LDB(dst, b, h) do { _Pragma("unroll") for (int n = 0; n < 2; ++n) _Pragma("unroll") for (int k = 0; k < 2; ++k) dst[n][k] = *(const PG8_LAS bf16x8*)(lds + PG8_SB(b, h) + boff + n * 2048 + k * 1024); } while (0)
#define PG8_MMA(ai, bj, At, Bt) do { __builtin_amdgcn_s_setprio(1); _Pragma("unroll") for (int m = 0; m < 4; ++m) _Pragma("unroll") for (int n = 0; n < 2; ++n) _Pragma("unroll") for (int k = 0; k < 2; ++k) \
        acc[ai][bj][m][n] = __builtin_amdgcn_mfma_f32_16x16x32_bf16(Bt[n][k], At[m][k], acc[ai][bj][m][n], 0, 0, 0); __builtin_amdgcn_s_setprio(0); } while (0)
#define PG8_WAIT_V(n) asm volatile("s_waitcnt vmcnt(" #n ")" ::: "memory")
#define PG8_WAIT_L(n) asm volatile("s_waitcnt lgkmcnt(" #n ")" ::: "memory")
#define PG8_BAR __builtin_amdgcn_s_barrier()
#define PG8_SCHED __builtin_amdgcn_sched_barrier(0)
    Unit cur, nxt; int ui = 0;
    if (!S.next(0, cur)) return;
    f32x4 acc[2][2][4][2];
#pragma unroll
    for (int a = 0; a < 2; ++a)
#pragma unroll
        for (int b = 0; b < 2; ++b)
#pragma unroll
            for (int m = 0; m < 4; ++m)
#pragma unroll
                for (int n = 0; n < 2; ++n) acc[a][b][m][n] = (f32x4){0.f, 0.f, 0.f, 0.f};
    bf16x8 At[4][2], B0[2][2], B1[2][2];
    const char* cA = (const char*)g.A + (size_t)cur.pm * tstep; const char* cB = (const char*)g.Bt + (size_t)cur.pn * tstep;
    S.a_ready(cur);
    if constexpr (SP2) {
        PG8_STAGE(PG8_SB(0, 0), cB, voffB); PG8_STAGE(PG8_SB(0, 1), cB + hstep, voffB); PG8_STAGE(PG8_SA(0, 0), cA, voffA); PG8_STAGE(PG8_SA(0, 1), cA + hstep, voffA);
        if (wr == 1) PG8_BAR;
        PG8_WAIT_V(2); PG8_BAR;
        PG8_STAGE(PG8_SB(1, 0), cB + kstep, voffB); PG8_STAGE(PG8_SA(1, 0), cA + kstep, voffA); PG8_STAGE(PG8_SB(1, 1), cB + hstep + kstep, voffB);
        PG8_WAIT_V(6); PG8_BAR;
    } else {
        PG8_STAGE(PG8_SB(0, 0), cB, voffB); PG8_STAGE(PG8_SA(0, 0), cA, voffA); PG8_STAGE(PG8_SB(0, 1), cB + hstep, voffB); PG8_STAGE(PG8_SA(0, 1), cA + hstep, voffA);
        if (wr == 1) PG8_BAR;
        PG8_WAIT_V(4); PG8_BAR;
        PG8_STAGE(PG8_SB(1, 0), cB + kstep, voffB); PG8_STAGE(PG8_SA(1, 0), cA + kstep, voffA); PG8_STAGE(PG8_SB(1, 1), cB + hstep + kstep, voffB);
        PG8_WAIT_V(6); PG8_BAR;
    }
    for (;;) {
        const bool has_next = S.next(ui + 1, nxt);
        const char* nA = has_next ? (const char*)g.A + (size_t)nxt.pm * tstep : cA; const char* nB = has_next ? (const char*)g.Bt + (size_t)nxt.pn * tstep : cB;
        for (int t = 0; t < nt; t += 2) {
            const bool last = (t == nt - 2);
            const char* a1 = cA + (size_t)(t + 1) * kstep;
            const char* a2 = last ? nA : cA + (size_t)(t + 2) * kstep; const char* b2 = last ? nB : cB + (size_t)(t + 2) * kstep;
            const char* a3 = a2 + kstep; const char* b3 = b2 + kstep;
            if (last && has_next) S.a_ready(nxt);
            if constexpr (SP2) {
            PG8_LDB(B0, 0, 0); PG8_LDB(B1, 0, 1); PG8_SCHED; PG8_LDA(At, 0, 0); PG8_STAGE(PG8_SA(1, 1), a1 + hstep, voffA);
            PG8_WAIT_V(8); PG8_WAIT_L(0); PG8_BAR; PG8_MMA(0, 0, At, B0); PG8_MMA(0, 1, At, B1); PG8_BAR; PG8_SCHED;
            PG8_LDA(At, 0, 1); PG8_STAGE(PG8_SB(0, 0), b2, voffB); PG8_STAGE(PG8_SB(0, 1), b2 + hstep, voffB); PG8_STAGE(PG8_SA(0, 0), a2, voffA);
            PG8_WAIT_V(8); PG8_WAIT_L(0); PG8_BAR; PG8_MMA(1, 0, At, B0); PG8_MMA(1, 1, At, B1); PG8_BAR; PG8_SCHED;
            PG8_LDB(B0, 1, 0); PG8_LDB(B1, 1, 1); PG8_SCHED; PG8_LDA(At, 1, 0); PG8_STAGE(PG8_SA(0, 1), a2 + hstep, voffA);
            PG8_WAIT_V(8); PG8_WAIT_L(0); PG8_BAR; PG8_MMA(0, 0, At, B0); PG8_MMA(0, 1, At, B1); PG8_BAR; PG8_SCHED;
            PG8_LDA(At, 1, 1); PG8_STAGE(PG8_SB(1, 0), b3, voffB); PG8_STAGE(PG8_SB(1, 1), b3 + hstep, voffB); PG8_STAGE(PG8_SA(1, 0), a3, voffA);
            PG8_WAIT_V(8); PG8_WAIT_L(0); PG8_BAR; PG8_MMA(1, 0, At, B0); PG8_MMA(1, 1, At, B1); PG8_BAR; PG8_SCHED;
            } else {
            PG8_LDB(B0, 0, 0); PG8_SCHED; PG8_LDA(At, 0, 0); PG8_STAGE(PG8_SA(1, 1), a1 + hstep, voffA);
            PG8_WAIT_L(8); PG8_BAR; PG8_WAIT_L(0); PG8_MMA(0, 0, At, B0); PG8_BAR; PG8_SCHED;
            PG8_LDB(B1, 0, 1); PG8_STAGE(PG8_SB(0, 0), b2, voffB);
            PG8_BAR; PG8_WAIT_L(0); PG8_MMA(0, 1, At, B1); PG8_BAR;
            PG8_LDA(At, 0, 1); PG8_STAGE(PG8_SA(0, 0), a2, voffA);
            PG8_BAR; PG8_WAIT_L(0); PG8_MMA(1, 0, At, B0); PG8_BAR; PG8_SCHED;
            PG8_STAGE(PG8_SB(0, 1), b2 + hstep, voffB);
            PG8_WAIT_V(6); PG8_BAR; PG8_MMA(1, 1, At, B1); PG8_BAR;
            PG8_LDB(B0, 1, 0); PG8_SCHED; PG8_LDA(At, 1, 0); PG8_STAGE(PG8_SA(0, 1), a2 + hstep, voffA);
            PG8_WAIT_L(8); PG8_BAR; PG8_WAIT_L(0); PG8_MMA(0, 0, At, B0); PG8_BAR; PG8_SCHED;
            PG8_LDB(B1, 1, 1); PG8_STAGE(PG8_SB(1, 0), b3, voffB);
            PG8_BAR; PG8_WAIT_L(0); PG8_MMA(0, 1, At, B1); PG8_BAR;
            PG8_LDA(At, 1, 1); PG8_STAGE(PG8_SA(1, 0), a3, voffA);
            PG8_BAR; PG8_WAIT_L(0); PG8_MMA(1, 0, At, B0); PG8_BAR; PG8_SCHED;
            PG8_STAGE(PG8_SB(1, 1), b3 + hstep, voffB);
            PG8_WAIT_V(6); PG8_BAR; PG8_MMA(1, 1, At, B1); PG8_BAR;
            }
        }
        if constexpr (ALIGN_EPI) { if (wr == 0) PG8_BAR; }
        E(acc, cur, ui, wr, wc, fr, fq); S.done(cur);
        if (!has_next) break;
#pragma unroll
        for (int a = 0; a < 2; ++a)
#pragma unroll
            for (int b = 0; b < 2; ++b)
#pragma unroll
                for (int m = 0; m < 4; ++m)
#pragma unroll
                    for (int n = 0; n < 2; ++n) acc[a][b][m][n] = (f32x4){0.f, 0.f, 0.f, 0.f};
        cur = nxt; cA = nA; cB = nB; ++ui;
        if constexpr (ALIGN_EPI) { if (wr == 1) PG8_BAR; }
    }
    PG8_WAIT_V(0);
    if constexpr (!ALIGN_EPI) { if (wr == 0) PG8_BAR; }
    PG8_BAR;
#undef PG8_SA
#undef PG8_SB
#undef PG8_STAGE
#undef PG8_LDA
#undef PG8_LDB
#undef PG8_MMA
#undef PG8_WAIT_V
#undef PG8_WAIT_L
#undef PG8_BAR
#undef PG8_SCHED
}
}

constexpr int BATCH = 8, SEQ = 2048, D = 1024, M = BATCH * SEQ;
constexpr int FF = 2816, DRNN = 1280, NBLK = 10, RBLK = 128, CONVW = 4;
constexpr int NHEAD = 16, HD = 64, NGRP = 3, NQKV = 9216;
constexpr float RMS_EPS = 1e-6f;
constexpr float LOG2E = 1.4426950408889634f;
constexpr int NWAVES = 8;

typedef unsigned short bf16;
typedef unsigned v4u __attribute__((ext_vector_type(4)));
typedef unsigned v2u __attribute__((ext_vector_type(2)));
typedef float f32x4 __attribute__((ext_vector_type(4)));
#define GAS __attribute__((address_space(1)))
#define LAS __attribute__((address_space(3)))
typedef GAS unsigned gu32;
#define RLX_AGENT __ATOMIC_RELAXED, __HIP_MEMORY_SCOPE_AGENT
#define LDS_WAIT() asm volatile("s_waitcnt lgkmcnt(0)" ::: "memory")

constexpr size_t MiB = 1u << 20;
constexpr size_t WS_CTL = 0, CTL_ZERO_BYTES = 1 * MiB;
constexpr size_t WS_SSQ = 1 * MiB;
constexpr size_t WS_BIAS = 2 * MiB;
constexpr size_t WS_XB = 3 * MiB;
constexpr size_t WS_WO = 35 * MiB;
constexpr size_t WS_WQKV = 37 * MiB;
constexpr size_t WS_QKV = 55 * MiB;
constexpr size_t QKV_SLAB = (size_t)M * 1024 * 2;
constexpr size_t WS_LSE = 343 * MiB;
constexpr size_t WS_END = 346 * MiB;
constexpr size_t WS_WIN0 = 55 * MiB, WS_WOUT0 = 66 * MiB, WS_WIN1 = 72 * MiB, WS_WOUT1 = 83 * MiB, WS_WIN2 = 89 * MiB, WS_WOUT2 = 100 * MiB;
constexpr size_t WS_WRIN = 106 * MiB, WS_WROUT = 111 * MiB, WS_WA = 114 * MiB, WS_WX = 114 * MiB + 512 * 1024;
constexpr size_t WS_ACT = 115 * MiB;
constexpr size_t WS_G = 203 * MiB, WS_U = 243 * MiB, WS_Y = 283 * MiB;
constexpr size_t WS_ATT = WS_QKV + 3 * QKV_SLAB;
constexpr size_t WS_WIN3 = WS_QKV + 6 * QKV_SLAB, WS_WOUT3 = WS_WIN3 + 11 * MiB;
constexpr size_t WS_ACT3 = WS_QKV;
static_assert(WS_Y + (size_t)M * DRNN * 2 <= WS_LSE && WS_ACT + (size_t)M * FF * 2 <= WS_G && WS_WX + 327680 <= WS_ACT, "ws map");
static_assert(WS_QKV + 9 * QKV_SLAB == WS_LSE && WS_LSE + (size_t)3 * M * 16 * 4 <= WS_END, "ws map");
constexpr int CW_BAR = 4096;

constexpr int RING_BYTES = 131072, LDSCTL_OFF = RING_BYTES, MISC_OFF = LDSCTL_OFF + 320;
constexpr int RSTD_OFF = RING_BYTES + 1024, RSTD_MAX_UNITS = 9, GAIN_OFF = RSTD_OFF + RSTD_MAX_UNITS * 256 * 4;
constexpr int LDS_BYTES = 147456;
static_assert(GAIN_OFF + 512 <= LDS_BYTES, "LDS map");

#define XB_TMO      128
#define XB_XCNT(j)  (256  + 64 * (j))
#define XB_XSUB(j)  (1280 + 64 * (j))
#define XB_XGEN(j)  (2304 + 64 * (j))
#define XB_TOP      3328
#define XB_TOPGEN   3392
#define XCD_BAR_WORDS 3456
#define XB_SPIN_CAP (1u << 18)
__device__ __forceinline__ unsigned xb_ld(unsigned* p)              { return __hip_atomic_load(p, __ATOMIC_RELAXED, __HIP_MEMORY_SCOPE_AGENT); }
__device__ __forceinline__ unsigned xb_add(unsigned* p, unsigned v) { return __hip_atomic_fetch_add(p, v, __ATOMIC_RELAXED, __HIP_MEMORY_SCOPE_AGENT); }
__device__ __forceinline__ unsigned xb_xcc_id() { return (unsigned)__builtin_amdgcn_s_getreg((3 << 11) | 20) & 0xFu; }
#define XB_SPIN(cond, bar) do { unsigned _sp = 0; while (cond) { __builtin_amdgcn_s_sleep(1); \
    if ((++_sp & 255u) == 0u) { if (xb_ld(&(bar)[XB_TMO])) break; if (_sp > XB_SPIN_CAP) { atomicAdd(&(bar)[XB_TMO], 1u); break; } } } } while (0)
struct XcdBarrier { unsigned* bar; unsigned x; volatile LAS unsigned* st; };
__device__ __forceinline__ XcdBarrier xcd_barrier_post(unsigned* bar, volatile LAS unsigned* st) {
    XcdBarrier b; b.bar = bar; b.x = xb_xcc_id(); b.st = st;
    if (threadIdx.x == 0) (void)xb_add(&bar[XB_XCNT(b.x)], 1u);
    return b;
}
__device__ __forceinline__ void xcd_barrier_complete(unsigned* bar, unsigned x, unsigned& nloc, unsigned& nx) {
    const unsigned G = gridDim.x * gridDim.y * gridDim.z;
    unsigned sum, cnt, mine, sp = 0u;
    for (;;) {
        sum = 0u; cnt = 0u; mine = 0u;
#pragma unroll
        for (unsigned j = 0; j < 16; ++j) { const unsigned c = xb_ld(&bar[XB_XCNT(j)]); sum += c; cnt += (c > 0u) ? 1u : 0u; mine = (j == x) ? c : mine; }
        if (sum == G) break;
        __builtin_amdgcn_s_sleep(1);
        if ((++sp & 255u) == 0u) { if (xb_ld(&bar[XB_TMO])) break; if (sp > XB_SPIN_CAP) { atomicAdd(&bar[XB_TMO], 1u); break; } }
    }
    nloc = mine > 0u ? mine : 1u; nx = cnt > 0u ? cnt : 1u;
}
__device__ __forceinline__ void xcd_barrier(const XcdBarrier& b) {
    asm volatile("s_waitcnt vmcnt(0)" ::: "memory");
    __syncthreads();
    if (threadIdx.x == 0) {
        unsigned* bar = b.bar;
        __builtin_amdgcn_s_waitcnt(0);
        unsigned nloc = b.st[0], nx = b.st[1];
        if (nloc == 0u) { xcd_barrier_complete(bar, b.x, nloc, nx); b.st[0] = nloc; b.st[1] = nx; }
        const unsigned old = xb_add(&bar[XB_XSUB(b.x)], 1u);
        const unsigned gen = old / nloc;
        if (old + 1u == (gen + 1u) * nloc) {
            __builtin_amdgcn_fence(__ATOMIC_RELEASE, "agent");
            asm volatile("s_waitcnt vmcnt(0)" ::: "memory");
            const unsigned og = xb_add(&bar[XB_TOP], 1u);
            const unsigned tg = og / nx;
            if (og + 1u == (tg + 1u) * nx) xb_add(&bar[XB_TOPGEN], 1u);
            else XB_SPIN(xb_ld(&bar[XB_TOPGEN]) == tg, bar);
            __builtin_amdgcn_fence(__ATOMIC_ACQUIRE, "agent");
            xb_add(&bar[XB_XGEN(b.x)], 1u);
            asm volatile("s_waitcnt vmcnt(0)" ::: "memory");
        } else {
            XB_SPIN(xb_ld(&bar[XB_XGEN(b.x)]) == gen, bar);
            __builtin_amdgcn_fence(__ATOMIC_ACQUIRE, "agent");
            asm volatile("s_waitcnt vmcnt(0)" ::: "memory");
        }
    }
    __syncthreads();
}

__device__ __forceinline__ unsigned f2bf(float f) { unsigned u = __builtin_bit_cast(unsigned, f); return (u + 0x7fffu + ((u >> 16) & 1u)) >> 16; }
__device__ __forceinline__ unsigned pk2(float lo, float hi) { return f2bf(lo) | (f2bf(hi) << 16); }
__device__ __forceinline__ float bf_lo(unsigned w) { return __builtin_bit_cast(float, w << 16); }
__device__ __forceinline__ float bf_hi(unsigned w) { return __builtin_bit_cast(float, w & 0xffff0000u); }
__device__ __forceinline__ float bf2f(bf16 v) { return __builtin_bit_cast(float, (unsigned)v << 16); }
__device__ __forceinline__ float wave_sum(float v) {
#pragma unroll
    for (int o = 1; o < 64; o <<= 1) v += __shfl_xor(v, o);
    return v;
}
__device__ __forceinline__ float fast_sigmoid(float x) { return __builtin_amdgcn_rcpf(1.f + __builtin_amdgcn_exp2f(-LOG2E * x)); }
__device__ __forceinline__ float row_rstd(const float* ssq, int row) {
    const f32x4* p = (const f32x4*)(ssq + (size_t)row * 16); const f32x4 a = p[0], b = p[1], c = p[2], d = p[3];
    const float s = ((a.x + a.y) + (a.z + a.w)) + ((b.x + b.y) + (b.z + b.w)) + ((c.x + c.y) + (c.z + c.w)) + ((d.x + d.y) + (d.z + d.w));
    return rsqrtf(s * (1.0f / D) + RMS_EPS);
}

typedef float f32x2 __attribute__((ext_vector_type(2)));
template <class Sched> __device__ __forceinline__ void fill_rstd(LAS unsigned char* lds, const Sched& S, const float* ssq, int tid) {
    LAS float* rt = (LAS float*)(lds + RSTD_OFF); pg8::Unit u;
    for (int i = 0; i < RSTD_MAX_UNITS && S.next(i, u); ++i)
        if ((tid >> 8) == (i & 1)) { const int r = tid & 255; rt[i * 256 + r] = row_rstd(ssq, u.pm * 256 + r); }
    __syncthreads();
}
using pg8::Unit;
__device__ __forceinline__ f32x2 silu_mul_pk(f32x2 g, f32x2 up) {
    const f32x2 t = g * (-LOG2E); f32x2 e; e.x = __builtin_amdgcn_exp2f(t.x); e.y = __builtin_amdgcn_exp2f(t.y);
    const f32x2 d = e + 1.0f; f32x2 r; r.x = __builtin_amdgcn_rcpf(d.x); r.y = __builtin_amdgcn_rcpf(d.y);
    return (g * r) * up;
}
struct EpiSwiGLU {
    static constexpr bool PERM = true;
    const LAS float* rtab; bf16* act; bool skip;
    __device__ __forceinline__ void operator()(const f32x4 (&acc)[2][2][4][2], const Unit& u, int ui, int wr, int wc, int fr, int fq) const {
        if (skip) return;
#pragma unroll
        for (int ai = 0; ai < 2; ++ai)
#pragma unroll
            for (int m = 0; m < 4; ++m) {
                const int rl = ai * 128 + wr * 64 + m * 16 + fr, row = u.pm * 256 + rl;
                const float rs = rtab[ui * 256 + rl];
                f32x2 v[4];
#pragma unroll
                for (int n = 0; n < 2; ++n)
#pragma unroll
                    for (int e = 0; e < 2; ++e) { const f32x2 g = (f32x2){acc[ai][0][m][n][2 * e], acc[ai][0][m][n][2 * e + 1]} * rs, up = (f32x2){acc[ai][1][m][n][2 * e], acc[ai][1][m][n][2 * e + 1]} * rs;
                        v[n * 2 + e] = silu_mul_pk(g, up); }
                v4u w; w.x = pg8::cvt_pk_bf16(v[0].x, v[0].y); w.y = pg8::cvt_pk_bf16(v[1].x, v[1].y); w.z = pg8::cvt_pk_bf16(v[2].x, v[2].y); w.w = pg8::cvt_pk_bf16(v[3].x, v[3].y);
                *(v4u*)(act + (size_t)row * FF + u.pn * 128 + wc * 32 + 8 * fq) = w;
            }
    }
};
struct EpiRes {
    static constexpr bool PERM = true;
    const float* xin; float* xout; bf16* xb; float* ssq; float scale; bool skip;
    __device__ __forceinline__ void operator()(const f32x4 (&acc)[2][2][4][2], const Unit& u, int ui, int wr, int wc, int fr, int fq) const {
        if (skip) return;
#pragma unroll
        for (int ai = 0; ai < 2; ++ai) {
            f32x4 xv[4][2][2];
#pragma unroll
            for (int m = 0; m < 4; ++m)
#pragma unroll
                for (int bj = 0; bj < 2; ++bj) { const size_t off = (size_t)(u.pm * 256 + ai * 128 + wr * 64 + m * 16 + fr) * D + u.pn * 256 + bj * 128 + wc * 32 + 8 * fq;
                    xv[m][bj][0] = *(const f32x4*)(xin + off); xv[m][bj][1] = *(const f32x4*)(xin + off + 4); }
#pragma unroll
            for (int m = 0; m < 4; ++m) {
                const int row = u.pm * 256 + ai * 128 + wr * 64 + m * 16 + fr;
                float ss = 0.f;
#pragma unroll
                for (int bj = 0; bj < 2; ++bj) {
                    const size_t off = (size_t)row * D + u.pn * 256 + bj * 128 + wc * 32 + 8 * fq;
                    const f32x4 y0 = xv[m][bj][0] + acc[ai][bj][m][0] * scale, y1 = xv[m][bj][1] + acc[ai][bj][m][1] * scale;
                    *(f32x4*)(xout + off) = y0; *(f32x4*)(xout + off + 4) = y1;
                    v4u w; w.x = pg8::cvt_pk_bf16(y0[0], y0[1]); w.y = pg8::cvt_pk_bf16(y0[2], y0[3]); w.z = pg8::cvt_pk_bf16(y1[0], y1[1]); w.w = pg8::cvt_pk_bf16(y1[2], y1[3]);
                    *(v4u*)(xb + off) = w;
                    ss += (y0[0] * y0[0] + y0[1] * y0[1]) + (y0[2] * y0[2] + y0[3] * y0[3]) + (y1[0] * y1[0] + y1[1] * y1[1]) + (y1[2] * y1[2] + y1[3] * y1[3]);
                }
                ss += __shfl_xor(ss, 16); ss += __shfl_xor(ss, 32);
                if (fq == 0) ssq[(size_t)row * 16 + u.pn * 4 + wc] = ss;
            }
            asm volatile("" ::: "memory");
        }
    }
};
struct EpiRnnIn {
    static constexpr bool PERM = true;
    const LAS float* rtab; bf16* Gb; bf16* Ub;
    template <bool GATE> __device__ __forceinline__ void run(const f32x4 (&acc)[2][2][4][2], const Unit& u, int ui, int wr, int wc, int fr, int fq, bf16* dstb, int pc) const {
#pragma unroll
        for (int ai = 0; ai < 2; ++ai)
#pragma unroll
            for (int m = 0; m < 4; ++m) {
                const int rl = ai * 128 + wr * 64 + m * 16 + fr, row = u.pm * 256 + rl;
                const float rs = rtab[ui * 256 + rl];
#pragma unroll
                for (int bj = 0; bj < 2; ++bj) {
                    f32x2 v[4];
#pragma unroll
                    for (int n = 0; n < 2; ++n)
#pragma unroll
                        for (int e = 0; e < 2; ++e) { f32x2 x = (f32x2){acc[ai][bj][m][n][2 * e], acc[ai][bj][m][n][2 * e + 1]} * rs;
                            if (GATE) {
                                const f32x2 t = (x * x * 0.044715f + 1.0f) * x * (-1.5957691216057308f * LOG2E); f32x2 ex; ex.x = __builtin_amdgcn_exp2f(t.x); ex.y = __builtin_amdgcn_exp2f(t.y);
                                const f32x2 d = ex + 1.0f; f32x2 r; r.x = __builtin_amdgcn_rcpf(d.x); r.y = __builtin_amdgcn_rcpf(d.y); x = x * r; }
                            v[n * 2 + e] = x; }
                    v4u w; w.x = pg8::cvt_pk_bf16(v[0].x, v[0].y); w.y = pg8::cvt_pk_bf16(v[1].x, v[1].y); w.z = pg8::cvt_pk_bf16(v[2].x, v[2].y); w.w = pg8::cvt_pk_bf16(v[3].x, v[3].y);
                    *(v4u*)(dstb + (size_t)row * DRNN + pc * 256 + bj * 128 + wc * 32 + 8 * fq) = w;
                }
            }
    }
    __device__ __forceinline__ void operator()(const f32x4 (&acc)[2][2][4][2], const Unit& u, int ui, int wr, int wc, int fr, int fq) const {
        if (u.pn < 5) run<true>(acc, u, ui, wr, wc, fr, fq, Gb, u.pn); else run<false>(acc, u, ui, wr, wc, fr, fq, Ub, u.pn - 5);
    }
};
struct EpiQKV {
    static constexpr bool PERM = true;
    const LAS float* rtab; const LAS float* gtab; bf16* qkv; bool skip;
    __device__ __forceinline__ void operator()(const f32x4 (&acc)[2][2][4][2], const Unit& u, int ui, int wr, int wc, int fr, int fq) const {
        if (skip) return;
        const int hs = u.pn * 4 + wc, kind = hs / 48, gh = hs - kind * 48, g = gh >> 4, h = gh & 15, l2d = 2 * g;
        bf16* slab = qkv + (size_t)(kind * 3 + g) * ((size_t)M * 1024);
        f32x4 gv[2][2];
#pragma unroll
        for (int bj = 0; bj < 2; ++bj)
#pragma unroll
            for (int n = 0; n < 2; ++n) { gv[bj][n] = (f32x4){1.f, 1.f, 1.f, 1.f}; if (kind < 2) gv[bj][n] = *(const LAS f32x4*)(gtab + kind * 64 + 32 * bj + 8 * fq + 4 * n); }
#pragma unroll
        for (int ai = 0; ai < 2; ++ai)
#pragma unroll
            for (int m = 0; m < 4; ++m) {
                const int rl = ai * 128 + wr * 64 + m * 16 + fr, row = u.pm * 256 + rl;
                const float rs = rtab[ui * 256 + rl];
                f32x4 v[2][2]; float ss = 0.f;
#pragma unroll
                for (int bj = 0; bj < 2; ++bj)
#pragma unroll
                    for (int n = 0; n < 2; ++n) { v[bj][n] = acc[ai][bj][m][n] * rs; const f32x4 t = v[bj][n] * v[bj][n]; ss += (t[0] + t[1]) + (t[2] + t[3]); }
                float rn = 1.f;
                if (kind < 2) { ss += __shfl_xor(ss, 16); ss += __shfl_xor(ss, 32); rn = rsqrtf(ss * (1.0f / HD) + RMS_EPS); }
                const int b = row >> 11, t = row & 2047, rres = t & ((1 << l2d) - 1), l = t >> l2d, L = 2048 >> l2d;
                bf16* dst = slab + ((size_t)(b * 16 + h) * 2048 + rres * L + l) * 64 + 8 * fq;
#pragma unroll
                for (int bj = 0; bj < 2; ++bj) {
                    const f32x4 a0 = v[bj][0] * gv[bj][0] * rn, a1 = v[bj][1] * gv[bj][1] * rn;
                    v4u w; w.x = pg8::cvt_pk_bf16(a0[0], a0[1]); w.y = pg8::cvt_pk_bf16(a0[2], a0[3]); w.z = pg8::cvt_pk_bf16(a1[0], a1[1]); w.w = pg8::cvt_pk_bf16(a1[2], a1[3]);
                    *(v4u*)(dst + 32 * bj) = w;
                }
            }
    }
};

struct Args { const float* in[18]; float* out; unsigned char* ws; int ph_lo, ph_hi; };
enum { I_X = 0, I_NORMG, I_FFN_WIN, I_FFN_WOUT, I_RNN_WIN, I_CONV_W, I_CONV_B, I_WA, I_BA, I_WX, I_BX, I_LAM, I_RNN_WOUT, I_WQKV, I_QGAIN, I_KGAIN, I_WO, I_RELB };

struct Ctx { LAS unsigned char* lds; int tid, lane, wave, G, vcu; unsigned char* ws; };

typedef short v4i16_t __attribute__((ext_vector_type(4)));
__device__ __forceinline__ v4i16_t vtr16(const LAS unsigned char* p) { return __builtin_amdgcn_ds_read_tr16_b64_v4i16((LAS v4i16_t*)p); }
enum { CM_NONE = 0, CM_FFN = 1, CM_QKV = 2 };
__device__ __forceinline__ int colmap(int mode, int vr) {
    if (mode == CM_FFN) { const int pn = vr >> 8, w = vr & 255; return (w >> 7) * FF + 128 * pn + (w & 127); }
    if (mode == CM_QKV) { const int pn = vr >> 8, w = vr & 255, bj = w >> 7, wc = (w >> 5) & 3, j = w & 31; return 256 * pn + 64 * wc + 32 * bj + j; }
    return vr;
}
__device__ __forceinline__ void transpose_item(const float* W, int K, int N, const float* gvec, bf16* WT, int mode, LAS unsigned char* scr, int item, int lane) {
    const int nblk = N / 64, kb = item / nblk, nb = item - kb * nblk, k0 = 64 * kb, vr0 = 64 * nb;
    const int col4 = lane & 15, rsub = lane >> 4, nsrc = colmap(mode, vr0 + 32 * (col4 >> 3)) + (col4 & 7) * 4;
    const float* src = W + (size_t)(k0 + rsub) * N + nsrc;
    f32x4 w[16];
#pragma unroll
    for (int i = 0; i < 16; ++i) w[i] = *(const GAS f32x4*)(src + (size_t)(4 * i) * N);
    if (gvec) {
#pragma unroll
        for (int i = 0; i < 16; ++i) w[i] = w[i] * gvec[k0 + 4 * i + rsub];
    }
#pragma unroll
    for (int i = 0; i < 16; ++i) { v2u p; p.x = pg8::cvt_pk_bf16(w[i][0], w[i][1]); p.y = pg8::cvt_pk_bf16(w[i][2], w[i][3]);
        *(LAS v2u*)(scr + (col4 >> 3) * 4096 + (4 * i + rsub) * 64 + (col4 & 7) * 8) = p; }
    const int q = (lane & 15) >> 2, p4 = lane & 3, gidx = lane >> 4;
#pragma unroll
    for (int r = 0; r < 8; ++r) { const int nb16 = r >> 1, kh = r & 1, kbase = 32 * kh + 8 * gidx;
        const LAS unsigned char* a = scr + (nb16 >> 1) * 4096 + (kbase + q) * 64 + ((nb16 & 1) * 16 + 4 * p4) * 2;
        const v4i16_t lo = vtr16(a), hi = vtr16(a + 4 * 64);
        v4u o; { const v2u l2 = __builtin_bit_cast(v2u, lo), h2 = __builtin_bit_cast(v2u, hi); o.x = l2.x; o.y = l2.y; o.z = h2.x; o.w = h2.y; }
        *(GAS v4u*)(WT + (size_t)(vr0 + nb16 * 16 + (lane & 15)) * K + k0 + kbase) = o; }
}
struct MatJob { const float* W; int K, N; const float* g; bf16* WT; int mode; };
__device__ __forceinline__ MatJob mat_job(const Ctx& C, const Args& a, int idx) {
    unsigned char* ws = C.ws; const float* ng = a.in[I_NORMG]; MatJob j;
    switch (idx) {
    case 0: j = MatJob{a.in[I_FFN_WIN] + (size_t)0 * D * 2 * FF, D, 2 * FF, ng + 0 * D, (bf16*)(ws + WS_WIN0), CM_FFN}; break;
    case 1: j = MatJob{a.in[I_FFN_WOUT] + (size_t)0 * FF * D, FF, D, nullptr, (bf16*)(ws + WS_WOUT0), CM_NONE}; break;
    case 2: j = MatJob{a.in[I_RNN_WIN], D, 2 * DRNN, ng + 1 * D, (bf16*)(ws + WS_WRIN), CM_NONE}; break;
    case 3: j = MatJob{a.in[I_RNN_WOUT], DRNN, D, nullptr, (bf16*)(ws + WS_WROUT), CM_NONE}; break;
    case 4: j = MatJob{a.in[I_FFN_WIN] + (size_t)1 * D * 2 * FF, D, 2 * FF, ng + 2 * D, (bf16*)(ws + WS_WIN1), CM_FFN}; break;
    case 5: j = MatJob{a.in[I_FFN_WOUT] + (size_t)1 * FF * D, FF, D, nullptr, (bf16*)(ws + WS_WOUT1), CM_NONE}; break;
    case 6: j = MatJob{a.in[I_FFN_WIN] + (size_t)2 * D * 2 * FF, D, 2 * FF, ng + 3 * D, (bf16*)(ws + WS_WIN2), CM_FFN}; break;
    case 7: j = MatJob{a.in[I_FFN_WOUT] + (size_t)2 * FF * D, FF, D, nullptr, (bf16*)(ws + WS_WOUT2), CM_NONE}; break;
    case 8: j = MatJob{a.in[I_WQKV], D, NQKV, ng + 4 * D, (bf16*)(ws + WS_WQKV), CM_QKV}; break;
    case 9: j = MatJob{a.in[I_WO], D, D, nullptr, (bf16*)(ws + WS_WO), CM_NONE}; break;
    case 10: j = MatJob{a.in[I_FFN_WIN] + (size_t)3 * D * 2 * FF, D, 2 * FF, ng + 5 * D, (bf16*)(ws + WS_WIN3), CM_FFN}; break;
    default: j = MatJob{a.in[I_FFN_WOUT] + (size_t)3 * FF * D, FF, D, nullptr, (bf16*)(ws + WS_WOUT3), CM_NONE}; break;
    }
    return j;
}
__device__ __forceinline__ void convert_mats(const Ctx& C, const Args& a, int first, int last, int gw, int NGW) {
    LAS unsigned char* scr = C.lds + C.wave * 8192;
    int base = 0;
    for (int mi = first; mi < last; ++mi) {
        const MatJob j = mat_job(C, a, mi); const int cnt = (j.K / 64) * (j.N / 64);
        int it = (gw - base) % NGW; if (it < 0) it += NGW;
        for (; it < cnt; it += NGW) transpose_item(j.W, j.K, j.N, j.g, j.WT, j.mode, scr, it, C.lane);
        base += cnt;
    }
}
__device__ __forceinline__ int t5_bucket(int n) {
    if (n < 16) return n;
    int b = 16;
    b += (n >= 22) + (n >= 30) + (n >= 40) + (n >= 54) + (n >= 73) + (n >= 99) + (n >= 134) + (n >= 182) + (n >= 246) + (n >= 332) + (n >= 450) + (n >= 609) + (n >= 825) + (n >= 1117) + (n >= 1513);
    return b;
}
__device__ __forceinline__ void p_prologue(const Ctx& C, const Args& a) {
    const int gw = C.vcu * NWAVES + C.wave, NGW = C.G * NWAVES;
    convert_mats(C, a, 0, 3, gw, NGW);
    {   LAS unsigned char* scr = C.lds + C.wave * 8192;
        for (int it = gw; it < 2 * NBLK * 4; it += NGW) { const int which = it / (NBLK * 4), r = it % (NBLK * 4), blk = r >> 2, sub = r & 3;
            const float* W = (which ? a.in[I_WX] : a.in[I_WA]) + (size_t)blk * RBLK * RBLK; bf16* WT = (bf16*)(C.ws + (which ? WS_WX : WS_WA)) + (size_t)blk * RBLK * RBLK;
            transpose_item(W, RBLK, RBLK, nullptr, WT, CM_NONE, scr, sub, C.lane); } }
    const float* x = a.in[I_X]; bf16* xb = (bf16*)(C.ws + WS_XB); float* ssq = (float*)(C.ws + WS_SSQ);
    for (int m = gw; m < M; m += NGW) {
        const GAS f32x4* xr = (const GAS f32x4*)(x + (size_t)m * D) + C.lane; f32x4 v[4]; float s = 0.f;
#pragma unroll
        for (int j = 0; j < 4; ++j) { v[j] = xr[64 * j]; s += (v[j].x * v[j].x + v[j].y * v[j].y) + (v[j].z * v[j].z + v[j].w * v[j].w); }
        s = wave_sum(s);
        GAS v2u* o8 = (GAS v2u*)(xb + (size_t)m * D) + C.lane;
#pragma unroll
        for (int j = 0; j < 4; ++j) { v2u w; w.x = pk2(v[j].x, v[j].y); w.y = pk2(v[j].z, v[j].w); o8[64 * j] = w; }
        if (C.lane < 16) ssq[(size_t)m * 16 + C.lane] = (C.lane == 0) ? s : 0.f;
    }
    float* bt = (float*)(C.ws + WS_BIAS); const float* rb = a.in[I_RELB];
    for (int i = blockIdx.x * 512 + C.tid; i < 48 * 129; i += C.G * 512) { const int gh = i / 129, dist = i - gh * 129, g = gh >> 4;
        bt[gh * 132 + dist] = rb[t5_bucket(dist << (2 * g)) * 48 + gh] * LOG2E; }
}

typedef float f32x16 __attribute__((ext_vector_type(16)));
typedef short bf16x8v __attribute__((ext_vector_type(8)));
constexpr int RM_WB = 0, RM_WB_GATE = 64 * 272, RM_CW = 36864, RM_CMP = RM_CW + 2560, RM_TILE = 49152, RM_TILE_BYTES = 36 * 256, RM_END = RM_TILE + 8 * RM_TILE_BYTES;
static_assert(RM_WB + 2 * RM_WB_GATE <= RM_CW && RM_CMP + 2 * 2 * 8 * 64 * 4 <= RM_TILE && RM_END <= RING_BYTES, "rnn-mid LDS map");
__device__ __forceinline__ bf16x8v pack8(const float (&v)[8]) {
    v4u w; w.x = pg8::cvt_pk_bf16(v[0], v[1]); w.y = pg8::cvt_pk_bf16(v[2], v[3]); w.z = pg8::cvt_pk_bf16(v[4], v[5]); w.w = pg8::cvt_pk_bf16(v[6], v[7]);
    return __builtin_bit_cast(bf16x8v, w);
}
__device__ __forceinline__ void p_rnn_mid(const Ctx& C, const Args& a) {
    const bf16* U = (const bf16*)(C.ws + WS_U); const bf16* Gb = (const bf16*)(C.ws + WS_G); bf16* Y = (bf16*)(C.ws + WS_Y);
    const bf16* WAb = (const bf16*)(C.ws + WS_WA); const bf16* WXb = (const bf16*)(C.ws + WS_WX);
    LAS unsigned char* L = C.lds;
    LAS float* CW = (LAS float*)(L + RM_CW); LAS float* CMP = (LAS float*)(L + RM_CMP);
    const int wave = C.wave;
    LAS unsigned char* wt = L + RM_TILE + wave * RM_TILE_BYTES;
    for (int item = blockIdx.x; item < BATCH * NBLK * 2; item += C.G) {
        const int b = item / (NBLK * 2), n = (item % (NBLK * 2)) >> 1, half = item & 1;
        int tid = C.tid; asm volatile("" : "+v"(tid));
        const int lane = tid & 63, r32 = lane & 31, hh = lane >> 5;
        __syncthreads();
#pragma unroll
        for (int p = 0; p < 4; ++p) { const int idx = p * 512 + tid, gate = idx >> 10, rem = idx & 1023, row = rem >> 4, c16 = rem & 15;
            const v4u w = *(const v4u*)((gate ? WXb : WAb) + (size_t)(n * 128 + 64 * half + row) * 128 + c16 * 8);
            *(LAS v4u*)(L + RM_WB + gate * RM_WB_GATE + row * 272 + c16 * 16) = w; }
        CW[tid] = a.in[I_CONV_W][(tid >> 7) * DRNN + n * 128 + (tid & 127)];
        if (tid < 128) CW[512 + tid] = a.in[I_CONV_B][n * 128 + tid];
        __syncthreads();
        float ba[2], bx[2], spl[2], Ht[2];
#pragma unroll
        for (int cb = 0; cb < 2; ++cb) { const int ch = n * 128 + 64 * half + 32 * cb + r32; ba[cb] = a.in[I_BA][ch]; bx[cb] = a.in[I_BX][ch];
            spl[cb] = -8.0f * LOG2E * log1pf(expf(-a.in[I_LAM][ch])); Ht[cb] = 0.f; }
        bf16x8v idf[2];
#pragma unroll
        for (int sp = 0; sp < 2; ++sp)
#pragma unroll
            for (int j = 0; j < 8; ++j) idf[sp][j] = (16 * sp + 8 * hh + j == r32) ? (short)0x3F80 : (short)0;
        const int urow = lane >> 4, uch = lane & 15, grow = lane >> 3, gch = lane & 7;
        v4u uraw[9], graw[4];
#define RM_LOADU(TILE) do { const int tp_ = (TILE) * 256 + wave * 32; const int ub_ = (b * SEQ + tp_ - 3 + urow) * DRNN + n * 128 + uch * 8;        \
        _Pragma("unroll") for (int i_ = 0; i_ < 9; ++i_) uraw[i_] = *(const v4u*)(U + (ptrdiff_t)(ub_ + i_ * 4 * DRNN)); \
        if (tp_ == 0 && urow < 3) uraw[0] = (v4u){0u, 0u, 0u, 0u};         } while (0)
#define RM_LOADG(TILE) do { const int gb_ = (b * SEQ + (TILE) * 256 + wave * 32 + grow) * DRNN + n * 128 + 64 * half + gch * 8; \
        _Pragma("unroll") for (int i_ = 0; i_ < 4; ++i_) graw[i_] = *(const v4u*)(Gb + (unsigned)(gb_ + i_ * 8 * DRNN)); } while (0)
        for (int tile = 0; tile < 8; ++tile) {
            const int tposw = tile * 256 + wave * 32;
            const size_t tok0 = (size_t)b * SEQ + tposw;
            LAS float* CWt = CW; LAS unsigned char* WBt = L + RM_WB; asm volatile("" : "+v"(CWt), "+v"(WBt));
            RM_LOADU(tile); RM_LOADG(tile);
#pragma unroll
            for (int i = 0; i < 9; ++i) { const int rl = 4 * i + urow; *(LAS v4u*)(wt + rl * 256 + ((uch ^ (rl & 15)) << 4)) = uraw[i]; }
            bf16x8v af[8];
#pragma unroll
            for (int s = 0; s < 8; ++s) {
                const int c0 = 16 * s + 8 * hh;
                float v[8];
                { const f32x4 b0 = *(const LAS f32x4*)(CWt + 512 + c0), b1 = *(const LAS f32x4*)(CWt + 512 + c0 + 4);
                  v[0] = b0[0]; v[1] = b0[1]; v[2] = b0[2]; v[3] = b0[3]; v[4] = b1[0]; v[5] = b1[1]; v[6] = b1[2]; v[7] = b1[3]; }
#pragma unroll
                for (int k = 0; k < 4; ++k) { const f32x4 w0 = *(const LAS f32x4*)(CWt + k * 128 + c0), w1 = *(const LAS f32x4*)(CWt + k * 128 + c0 + 4);
                    const v4u uu = *(const LAS v4u*)(wt + (r32 + k) * 256 + (((2 * s + hh) ^ ((r32 + k) & 15)) << 4));
                    v[0] += w0[0] * bf_lo(uu.x); v[1] += w0[1] * bf_hi(uu.x); v[2] += w0[2] * bf_lo(uu.y); v[3] += w0[3] * bf_hi(uu.y);
                    v[4] += w1[0] * bf_lo(uu.z); v[5] += w1[1] * bf_hi(uu.z); v[6] += w1[2] * bf_lo(uu.w); v[7] += w1[3] * bf_hi(uu.w); }
                af[s] = pack8(v);
                __builtin_amdgcn_sched_barrier(0);
            }
#pragma unroll
            for (int i = 0; i < 4; ++i) *(LAS v4u*)(wt + (8 * i + grow) * 128 + gch * 16) = graw[i];
            f32x16 acc[2][2], ufa[2];
#pragma unroll
            for (int cb = 0; cb < 2; ++cb)
#pragma unroll
                for (int e = 0; e < 16; ++e) { acc[0][cb][e] = 0.f; acc[1][cb][e] = 0.f; ufa[cb][e] = 0.f; }
#pragma unroll
            for (int s = 0; s < 8; ++s)
#pragma unroll
                for (int gt = 0; gt < 2; ++gt)
#pragma unroll
                    for (int cb = 0; cb < 2; ++cb) {
                        const bf16x8v bfr = *(const LAS bf16x8v*)(WBt + gt * RM_WB_GATE + (32 * cb + r32) * 272 + (16 * s + 8 * hh) * 2);
                        acc[gt][cb] = __builtin_amdgcn_mfma_f32_32x32x16_bf16(af[s], bfr, acc[gt][cb], 0, 0, 0);
                        if (gt == 1 && cb == 1 && (s & 1)) __builtin_amdgcn_sched_barrier(0);
                    }
#pragma unroll
            for (int cb = 0; cb < 2; ++cb)
#pragma unroll
                for (int sp = 0; sp < 2; ++sp) { const bf16x8v asel = half ? af[4 + 2 * cb + sp] : af[2 * cb + sp];
                    ufa[cb] = __builtin_amdgcn_mfma_f32_32x32x16_bf16(asel, idf[sp], ufa[cb], 0, 0, 0); }
#pragma unroll
            for (int cb = 0; cb < 2; ++cb)
#pragma unroll
                for (int e = 0; e < 16; ++e) {
                    const float uf = ufa[cb][e];
                    const float r = fast_sigmoid(acc[0][cb][e] + ba[cb]), ii = fast_sigmoid(acc[1][cb][e] + bx[cb]);
                    const float av = __builtin_amdgcn_exp2f(r * spl[cb]);
                    const float bv = __builtin_amdgcn_sqrtf(fmaxf(1.f - av * av, 0.f)) * (ii * uf);
                    acc[0][cb][e] = av; acc[1][cb][e] = bv;
                }
            float A0[2][4], B0[2][4], A1[2][4], B1[2][4];
            const int par = tile & 1;
#pragma unroll
            for (int cb = 0; cb < 2; ++cb) {
                float Aw = 1.f, Bw = 0.f;
#pragma unroll
                for (int q = 0; q < 4; ++q) {
                    const float a0 = acc[0][cb][4 * q], a1 = acc[0][cb][4 * q + 1], a2 = acc[0][cb][4 * q + 2], a3 = acc[0][cb][4 * q + 3];
                    const float Ag = (a0 * a1) * (a2 * a3);
                    const float Bg = ((acc[1][cb][4 * q] * a1 + acc[1][cb][4 * q + 1]) * a2 + acc[1][cb][4 * q + 2]) * a3 + acc[1][cb][4 * q + 3];
                    const float pA = __shfl_xor(Ag, 32), pB = __shfl_xor(Bg, 32);
                    A0[cb][q] = hh ? pA : Ag; B0[cb][q] = hh ? pB : Bg; A1[cb][q] = hh ? Ag : pA; B1[cb][q] = hh ? Bg : pB;
                    Bw = Bw * A0[cb][q] + B0[cb][q]; Aw *= A0[cb][q]; Bw = Bw * A1[cb][q] + B1[cb][q]; Aw *= A1[cb][q];
                }
                if (hh == 0) { CMP[((par * 2 + 0) * 8 + wave) * 64 + 32 * cb + r32] = Aw; CMP[((par * 2 + 1) * 8 + wave) * 64 + 32 * cb + r32] = Bw; }
            }
            __syncthreads();
#pragma unroll
            for (int cb = 0; cb < 2; ++cb) {
                float h = Ht[cb], hin = 0.f;
#pragma unroll
                for (int v = 0; v < 8; ++v) { const float Av = CMP[((par * 2 + 0) * 8 + v) * 64 + 32 * cb + r32], Bv = CMP[((par * 2 + 1) * 8 + v) * 64 + 32 * cb + r32];
                    hin = (v == wave) ? h : hin; h = Av * h + Bv; }
                Ht[cb] = h;
                float hc = hin;
#pragma unroll
                for (int q = 0; q < 4; ++q) {
                    const float c0 = hc; hc = A0[cb][q] * hc + B0[cb][q]; const float c1 = hc; hc = A1[cb][q] * hc + B1[cb][q];
                    float hv = hh ? c1 : c0;
#pragma unroll
                    for (int i = 0; i < 4; ++i) { const int e = 4 * q + i; hv = acc[0][cb][e] * hv + acc[1][cb][e];
                        const int tl = (e & 3) + 8 * (e >> 2) + 4 * hh;
                        LAS bf16* gp = (LAS bf16*)(wt + tl * 128 + (32 * cb + r32) * 2);
                        *gp = (bf16)f2bf(hv * bf2f(*gp)); }
                }
            }
#pragma unroll
            for (int i = 0; i < 4; ++i) { const v4u w = *(const LAS v4u*)(wt + (8 * i + grow) * 128 + gch * 16);
                *(v4u*)(Y + (unsigned)(((int)tok0 + 8 * i + grow) * DRNN + n * 128 + 64 * half + gch * 8)) = w; }
        }
#undef RM_LOADU
#undef RM_LOADG
    }
    const int nitems = BATCH * NBLK * 2;
    if (C.G > nitems) { if ((int)blockIdx.x >= nitems) convert_mats(C, a, 3, 10, ((int)blockIdx.x - nitems) * NWAVES + wave, (C.G - nitems) * NWAVES); }
    else { __syncthreads(); convert_mats(C, a, 3, 10, (int)blockIdx.x * NWAVES + wave, C.G * NWAVES); }
}
constexpr int AT_EXT = 0, AT_VT = 48 * 192 * 4;
struct AttnUnit { bf16* qbase; const bf16* kres; const bf16* vres; int l0, kb_lo, eoff, g, bh, llin0; };
__device__ __forceinline__ AttnUnit attn_unit(bf16* QKV, int it, int wave) {
    AttnUnit u; const size_t SLAB = (size_t)M * 1024;
    const int g = it >> 10, rem = it & 1023, bh = rem >> 3, chunk = (rem + (it >> 8)) & 7, l2d = 2 * g, L = SEQ >> l2d;
    u.g = g; u.bh = bh; u.llin0 = chunk * 256 + wave * 32; u.l0 = u.llin0 & (L - 1); u.kb_lo = (u.l0 - 128) > 0 ? (u.l0 - 128) : 0; u.eoff = (g * 16 + (bh & 15)) * 192;
    u.qbase = QKV + (size_t)g * SLAB + ((size_t)bh * SEQ + u.llin0) * HD;
    u.kres = u.qbase + 3 * SLAB - (size_t)u.l0 * HD; u.vres = u.qbase + 6 * SLAB - (size_t)u.l0 * HD;
    return u;
}
__device__ __forceinline__ void p_attn(const Ctx& C, const bool dry) {
    bf16* QKV = (bf16*)(C.ws + WS_QKV); float* LSE = (float*)(C.ws + WS_LSE); const float* bt = (const float*)(C.ws + WS_BIAS);
    LAS float* ext = (LAS float*)(C.lds + AT_EXT);
    LAS unsigned char* vt = C.lds + AT_VT + C.wave * 8192; LAS unsigned char* kt = vt + 4096;
    const int lane = C.lane, r32 = lane & 31, hh = lane >> 5, wave = C.wave, tid = C.tid;
    const int crow8 = lane >> 3, cch = lane & 7;
    const int vtr_off = (4 * hh + ((lane & 15) >> 2)) * 64 + ((lane >> 4) & 1) * 32 + (lane & 3) * 8;
    for (int i = tid; i < 48 * 192; i += 512) { const int gh = i / 192, dist = i - gh * 192 - 32; ext[i] = (dist >= 0 && dist <= 128) ? bt[gh * 132 + dist] : -1e30f; }
    __syncthreads();
    const int total = NGRP * BATCH * NHEAD * 8;
    int it = blockIdx.x;
    if (it >= total) return;
    AttnUnit cu = attn_unit(QKV, it, wave), nu = cu;
    v4u qfn[4], kfn[4], vvn[4];
#define AT_LOADKV(U, KB) do { const bf16* kblk_ = (U).kres + (size_t)(KB) * HD; const bf16* vblk_ = (U).vres + (size_t)(KB) * HD; \
        _Pragma("unroll") for (int i_ = 0; i_ < 4; ++i_) { vvn[i_] = *(const v4u*)(vblk_ + (8 * i_ + crow8) * HD + cch * 8); kfn[i_] = *(const v4u*)(kblk_ + (8 * i_ + crow8) * HD + cch * 8); } } while (0)
#define AT_LOADQ(U) do { _Pragma("unroll") for (int i_ = 0; i_ < 4; ++i_) qfn[i_] = *(const v4u*)((U).qbase + (8 * i_ + crow8) * HD + cch * 8); } while (0)
#define AT_TILE2FRAG(RAW, FR) do { _Pragma("unroll") for (int i_ = 0; i_ < 4; ++i_) *(LAS v4u*)(kt + (8 * i_ + crow8) * 128 + ((cch ^ crow8) << 4)) = RAW[i_]; \
        _Pragma("unroll") for (int s_ = 0; s_ < 4; ++s_) FR[s_] = *(const LAS bf16x8v*)(kt + r32 * 128 + (((2 * s_ + hh) ^ (r32 & 7)) << 4)); } while (0)
    AT_LOADQ(cu); AT_LOADKV(cu, cu.l0);
    for (;;) {
        bf16x8v qf[4];
        AT_TILE2FRAG(qfn, qf);
        f32x16 o0, o1;
#pragma unroll
        for (int e = 0; e < 16; ++e) { o0[e] = 0.f; o1[e] = 0.f; }
        float mrow = -1e30f, lsum = 0.f;
        const bool has_next = (it + C.G) < total;
        for (int kb = cu.l0; kb >= cu.kb_lo; kb -= 32) {
            v4u vv[4], kraw[4]; bf16x8v kf[4];
#pragma unroll
            for (int i = 0; i < 4; ++i) { vv[i] = vvn[i]; kraw[i] = kfn[i]; }
            if (kb - 32 >= cu.kb_lo) { AT_LOADKV(cu, kb - 32); }
            else if (has_next) { nu = attn_unit(QKV, it + C.G, wave); AT_LOADQ(nu); AT_LOADKV(nu, nu.l0); }
#pragma unroll
            for (int i = 0; i < 4; ++i) *(LAS v4u*)(vt + (cch >> 2) * 2048 + (8 * i + crow8) * 64 + (cch & 3) * 16) = vv[i];
            AT_TILE2FRAG(kraw, kf);
            f32x16 p;
#pragma unroll
            for (int e = 0; e < 16; ++e) p[e] = 0.f;
#pragma unroll
            for (int s = 0; s < 4; ++s) p = __builtin_amdgcn_mfma_f32_32x32x16_bf16(kf[s], qf[s], p, 0, 0, 0);
            const int eb = cu.eoff + cu.l0 + r32 - kb - 4 * hh + 32;
            float bm = -1e30f;
#pragma unroll
            for (int e = 0; e < 16; ++e) { p[e] += ext[eb - ((e & 3) + 8 * (e >> 2))]; bm = fmaxf(bm, p[e]); }
            bm = fmaxf(bm, __shfl_xor(bm, 32));
            const float mn = fmaxf(mrow, bm), alpha = __builtin_amdgcn_exp2f(mrow - mn); mrow = mn;
            float ps = 0.f;
#pragma unroll
            for (int e = 0; e < 16; ++e) { p[e] = __builtin_amdgcn_exp2f(p[e] - mn); ps += p[e]; }
            lsum = lsum * alpha + ps;
#pragma unroll
            for (int e = 0; e < 16; ++e) { o0[e] *= alpha; o1[e] *= alpha; }
            bf16x8v pf[2];
#pragma unroll
            for (int s = 0; s < 2; ++s) { const float t8[8] = {p[8 * s], p[8 * s + 1], p[8 * s + 2], p[8 * s + 3], p[8 * s + 4], p[8 * s + 5], p[8 * s + 6], p[8 * s + 7]}; pf[s] = pack8(t8); }
#pragma unroll
            for (int s = 0; s < 2; ++s) {
                const v4i16_t a00 = vtr16(vt + 0 * 2048 + (16 * s) * 64 + vtr_off), a01 = vtr16(vt + 0 * 2048 + (16 * s + 8) * 64 + vtr_off);
                const v4i16_t a10 = vtr16(vt + 1 * 2048 + (16 * s) * 64 + vtr_off), a11 = vtr16(vt + 1 * 2048 + (16 * s + 8) * 64 + vtr_off);
                const bf16x8v va0 = (bf16x8v){a00[0], a00[1], a00[2], a00[3], a01[0], a01[1], a01[2], a01[3]};
                const bf16x8v va1 = (bf16x8v){a10[0], a10[1], a10[2], a10[3], a11[0], a11[1], a11[2], a11[3]};
                o0 = __builtin_amdgcn_mfma_f32_32x32x16_bf16(va0, pf[s], o0, 0, 0, 0);
                o1 = __builtin_amdgcn_mfma_f32_32x32x16_bf16(va1, pf[s], o1, 0, 0, 0);
            }
        }
        const float ltot = lsum + __shfl_xor(lsum, 32), inv = 1.f / ltot;
#pragma unroll
        for (int q = 0; q < 4; ++q) {
            v2u w0, w1;
            w0.x = pg8::cvt_pk_bf16(o0[4 * q] * inv, o0[4 * q + 1] * inv); w0.y = pg8::cvt_pk_bf16(o0[4 * q + 2] * inv, o0[4 * q + 3] * inv);
            w1.x = pg8::cvt_pk_bf16(o1[4 * q] * inv, o1[4 * q + 1] * inv); w1.y = pg8::cvt_pk_bf16(o1[4 * q + 2] * inv, o1[4 * q + 3] * inv);
            *(LAS v2u*)(kt + r32 * 128 + ((q ^ (r32 & 7)) << 4) + 8 * hh) = w0; *(LAS v2u*)(kt + r32 * 128 + (((4 + q) ^ (r32 & 7)) << 4) + 8 * hh) = w1;
        }
        if (!dry)
#pragma unroll
        for (int i = 0; i < 4; ++i) { const v4u w = *(const LAS v4u*)(kt + (8 * i + crow8) * 128 + ((cch ^ crow8) << 4)); *(v4u*)(cu.qbase + (8 * i + crow8) * HD + cch * 8) = w; }
        if (hh == 0) { const int l2d = 2 * cu.g, L = SEQ >> l2d, llin = cu.llin0 + r32, rres = llin >> (11 - l2d), l = llin & (L - 1), t = (l << l2d) + rres, row = (cu.bh >> 4) * SEQ + t;
            LSE[((size_t)cu.g * M + row) * 16 + (cu.bh & 15)] = mrow + log2f(ltot); }
        if (!has_next) break;
        it += C.G; cu = nu;
    }
#undef AT_LOADKV
#undef AT_LOADQ
#undef AT_TILE2FRAG
}
__device__ __forceinline__ void p_merge(const Ctx& C, const Args& a) {
    const bf16* QKV = (const bf16*)(C.ws + WS_QKV); const float* LSE = (const float*)(C.ws + WS_LSE); bf16* ATT = (bf16*)(C.ws + WS_ATT);
    for (int idx = blockIdx.x * 512 + C.tid; idx < M * 16 * 8; idx += C.G * 512) {
        const int ch = idx & 7, h = (idx >> 3) & 15, row = idx >> 7, b = row >> 11, t = row & 2047;
        float ls[3], mxl = -INFINITY;
#pragma unroll
        for (int g = 0; g < 3; ++g) { ls[g] = LSE[((size_t)g * M + row) * 16 + h]; mxl = fmaxf(mxl, ls[g]); }
        float acc[8], wsum = 0.f;
#pragma unroll
        for (int e = 0; e < 8; ++e) acc[e] = 0.f;
#pragma unroll
        for (int g = 0; g < 3; ++g) { const float w = exp2f(ls[g] - mxl); wsum += w; const int l2d = 2 * g, rres = t & ((1 << l2d) - 1), l = t >> l2d, L = SEQ >> l2d;
            const v4u v = *(const v4u*)(QKV + (size_t)g * ((size_t)M * 1024) + ((size_t)(b * 16 + h) * SEQ + rres * L + l) * HD + 8 * ch);
            acc[0] += w * bf_lo(v.x); acc[1] += w * bf_hi(v.x); acc[2] += w * bf_lo(v.y); acc[3] += w * bf_hi(v.y); acc[4] += w * bf_lo(v.z); acc[5] += w * bf_hi(v.z); acc[6] += w * bf_lo(v.w); acc[7] += w * bf_hi(v.w); }
        const float inv = 1.f / wsum; v4u o; o.x = pk2(acc[0] * inv, acc[1] * inv); o.y = pk2(acc[2] * inv, acc[3] * inv); o.z = pk2(acc[4] * inv, acc[5] * inv); o.w = pk2(acc[6] * inv, acc[7] * inv);
        *(v4u*)(ATT + (size_t)row * 1024 + h * 64 + 8 * ch) = o;
    }
    convert_mats(C, a, 10, 12, C.vcu * NWAVES + C.wave, C.G * NWAVES);
}

enum { PH_PROLOGUE = 0, PH_FFN_IN_0, PH_FFN_OUT_0, PH_RNN_IN, PH_RNN_MID, PH_RNN_OUT, PH_FFN_IN_1, PH_FFN_OUT_1,
       PH_FFN_IN_2, PH_FFN_OUT_2, PH_QKV, PH_ATTN, PH_MERGE, PH_WO, PH_FFN_IN_3, PH_FFN_OUT_3, NPHASE };

__global__ void __launch_bounds__(NWAVES * 64, 2) fwd_kernel(Args args) {
    extern __shared__ __attribute__((aligned(16))) unsigned char lds_raw[];
    Ctx C; C.lds = (LAS unsigned char*)lds_raw; C.tid = threadIdx.x; C.lane = C.tid & 63; C.wave = __builtin_amdgcn_readfirstlane(C.tid >> 6);
    C.G = gridDim.x; { const int bx = blockIdx.x; C.vcu = (C.G % 8 == 0) ? (bx % 8) * (C.G / 8) + bx / 8 : bx; }
    C.ws = args.ws;
    volatile LAS unsigned* MISC = (volatile LAS unsigned*)(C.lds + MISC_OFF);
    for (int u = C.tid; u < (LDS_BYTES - LDSCTL_OFF) / 4; u += NWAVES * 64) ((LAS unsigned*)(C.lds + LDSCTL_OFF))[u] = 0u;
    __syncthreads();
    unsigned* ctl = (unsigned*)args.ws;
    XcdBarrier bar; bar.bar = ctl + CW_BAR; bar.x = 0; bar.st = nullptr;
    const bool multi = (args.ph_hi - args.ph_lo) > 1;
    if (multi) bar = xcd_barrier_post(ctl + CW_BAR, MISC + 8);
    for (int ph = args.ph_lo; ph < args.ph_hi; ++ph) {
        for (int rep = ((DUP_MASK >> ph) & 1u) ? DUP_N : 0; rep >= 0; --rep) {
        const bool dry = rep > 0;
        { int t_ = threadIdx.x; asm volatile("" : "+v"(t_)); C.tid = t_; C.lane = t_ & 63; }
        unsigned char* ws = args.ws;
        C.ws = ws; float* ssq = (float*)(ws + WS_SSQ); bf16* xb = (bf16*)(ws + WS_XB);
        switch (ph) {
        case PH_PROLOGUE: p_prologue(C, args); break;
        case PH_FFN_IN_0: case PH_FFN_IN_1: case PH_FFN_IN_2: case PH_FFN_IN_3: {
            const bf16* Bt = (const bf16*)(ws + (ph == PH_FFN_IN_0 ? WS_WIN0 : ph == PH_FFN_IN_1 ? WS_WIN1 : ph == PH_FFN_IN_2 ? WS_WIN2 : WS_WIN3));
            bf16* act = (bf16*)(ws + (ph == PH_FFN_IN_3 ? WS_ACT3 : WS_ACT));
            pg8::Gemm g{xb, Bt, M, 2 * FF, D}; pg8::StaticOrder S; S.init(M, 2 * FF, C.G, (int)blockIdx.x);
            fill_rstd(C.lds, S, ssq, C.tid);
            EpiSwiGLU E{(const LAS float*)(C.lds + RSTD_OFF), act, dry && DUP_SKIP_EPI};
            pg8::gemm_phase<EpiSwiGLU, pg8::StaticOrder, true, true>(C.lds, g, S, E);
        } break;
        case PH_FFN_OUT_0: case PH_FFN_OUT_1: case PH_FFN_OUT_2: case PH_FFN_OUT_3: case PH_RNN_OUT: case PH_WO: {
            const bf16* A; const bf16* Bt; int K; float scale = 0.5f; const float* xin = args.out;
            if (ph == PH_FFN_OUT_0) { A = (const bf16*)(ws + WS_ACT); Bt = (const bf16*)(ws + WS_WOUT0); K = FF; xin = args.in[I_X]; }
            else if (ph == PH_FFN_OUT_1) { A = (const bf16*)(ws + WS_ACT); Bt = (const bf16*)(ws + WS_WOUT1); K = FF; }
            else if (ph == PH_FFN_OUT_2) { A = (const bf16*)(ws + WS_ACT); Bt = (const bf16*)(ws + WS_WOUT2); K = FF; }
            else if (ph == PH_FFN_OUT_3) { A = (const bf16*)(ws + WS_ACT3); Bt = (const bf16*)(ws + WS_WOUT3); K = FF; }
            else if (ph == PH_RNN_OUT) { A = (const bf16*)(ws + WS_Y); Bt = (const bf16*)(ws + WS_WROUT); K = DRNN; scale = 1.f; }
            else { A = (const bf16*)(ws + WS_ATT); Bt = (const bf16*)(ws + WS_WO); K = D; scale = 1.f; }
            if (dry && ph != PH_FFN_OUT_0) scale = 0.f;
            pg8::Gemm g{A, Bt, M, D, K}; pg8::StaticOrder S; S.init(M, D, C.G, (int)blockIdx.x);
            EpiRes E{xin, args.out, xb, ssq, scale, dry && DUP_SKIP_EPI};
            pg8::gemm_phase<EpiRes, pg8::StaticOrder, false, true>(C.lds, g, S, E);
        } break;
        case PH_RNN_IN: {
            pg8::Gemm g{xb, (const bf16*)(ws + WS_WRIN), M, 2 * DRNN, D}; pg8::StaticOrder S; S.init(M, 2 * DRNN, C.G, (int)blockIdx.x);
            fill_rstd(C.lds, S, ssq, C.tid);
            EpiRnnIn E{(const LAS float*)(C.lds + RSTD_OFF), (bf16*)(ws + WS_G), (bf16*)(ws + WS_U)};
            pg8::gemm_phase<EpiRnnIn, pg8::StaticOrder, true, true>(C.lds, g, S, E);
        } break;
        case PH_RNN_MID: p_rnn_mid(C, args); break;
        case PH_QKV: {
            pg8::Gemm g{xb, (const bf16*)(ws + WS_WQKV), M, NQKV, D}; pg8::StaticOrder S; S.init(M, NQKV, C.G, (int)blockIdx.x);
            if (C.tid < 128) ((LAS float*)(C.lds + GAIN_OFF))[C.tid] = (C.tid < 64) ? args.in[I_QGAIN][C.tid] * (0.125f * LOG2E) : args.in[I_KGAIN][C.tid - 64];
            fill_rstd(C.lds, S, ssq, C.tid);
            EpiQKV E{(const LAS float*)(C.lds + RSTD_OFF), (const LAS float*)(C.lds + GAIN_OFF), (bf16*)(ws + WS_QKV), dry && DUP_SKIP_EPI};
            pg8::gemm_phase<EpiQKV, pg8::StaticOrder, true, true>(C.lds, g, S, E);
        } break;
        case PH_ATTN: p_attn(C, dry); break;
        case PH_MERGE: p_merge(C, args); break;
        default: break;
        }
        if (dry || ph + 1 < args.ph_hi) xcd_barrier(bar);
        if (ph == 0 && !dry) for (int eb = 0; eb < DUP_EXTRA_BARRIERS; ++eb) xcd_barrier(bar);
        }
    }
}

extern "C" void kernel_launch(void* const* d_in, const int* in_sizes, int n_in, void* d_out, int out_size, void* d_ws, size_t ws_size, hipStream_t stream) {
    static int grid = 0;
    if (grid == 0) {
        if (n_in != 18 || in_sizes[0] != M * D || out_size != M * D || ws_size < WS_END) { fprintf(stderr, "kernel_launch: unexpected shapes (n_in %d, in0 %d, out %d, ws %zu)\n", n_in, n_in > 0 ? in_sizes[0] : -1, out_size, ws_size); grid = -1; return; }
        int dev = 0, cus = 0, per_cu = 0;
        if (hipGetDevice(&dev) != hipSuccess || hipDeviceGetAttribute(&cus, hipDeviceAttributeMultiprocessorCount, dev) != hipSuccess) { fprintf(stderr, "kernel_launch: device query failed\n"); grid = -1; return; }
        if (hipFuncSetAttribute((const void*)fwd_kernel, hipFuncAttributeMaxDynamicSharedMemorySize, LDS_BYTES) != hipSuccess) { fprintf(stderr, "kernel_launch: hipFuncSetAttribute failed\n"); grid = -1; return; }
        if (hipOccupancyMaxActiveBlocksPerMultiprocessor(&per_cu, (const void*)fwd_kernel, NWAVES * 64, LDS_BYTES) != hipSuccess || per_cu < 1) { fprintf(stderr, "kernel_launch: occupancy query says %d blocks per CU\n", per_cu); (void)hipGetLastError(); grid = -1; return; }
        grid = cus;
    }
    if (grid < 0) return;
    if (hipMemsetAsync(d_ws, 0, CTL_ZERO_BYTES, stream) != hipSuccess) { fprintf(stderr, "kernel_launch: memset failed\n"); return; }
    Args a{};
    for (int i = 0; i < 18; ++i) a.in[i] = (const float*)d_in[i];
    a.out = (float*)d_out; a.ws = (unsigned char*)d_ws;
#if SINGLE_LAUNCH
    a.ph_lo = 0; a.ph_hi = NPHASE;
    hipLaunchKernelGGL(fwd_kernel, dim3(grid), dim3(NWAVES * 64), LDS_BYTES, stream, a);
#else
    for (int ph = 0; ph < NPHASE; ++ph) { a.ph_lo = ph; a.ph_hi = ph + 1; hipLaunchKernelGGL(fwd_kernel, dim3(grid), dim3(NWAVES * 64), LDS_BYTES, stream, a); }
#endif
}
```

```cpp
#include <hip/hip_runtime.h>
#include <cstdio>
#include <cstdint>

#ifndef SINGLE_LAUNCH
#define SINGLE_LAUNCH 1
#define DUP_MASK 0u
#define DUP_N 1
#define DUP_EXTRA_BARRIERS 0
#define DUP_SKIP_EPI 0
#endif

namespace pg8 {
#define PG8_LAS __attribute__((address_space(3)))
typedef unsigned short bf16_t;
typedef short bf16x8 __attribute__((ext_vector_type(8)));
typedef float f32x4 __attribute__((ext_vector_type(4)));
typedef unsigned u32x4 __attribute__((ext_vector_type(4)));
constexpr int BM = 256, BK = 64, HALF = 128, HTB = HALF * BK * 2, STAGE_BYTES = 8 * HTB, NXCD = 8, WGM = 8;

__host__ __device__ __forceinline__ int lds_byte(int r, int c) { const int st = (r >> 4) * 2 + (c >> 5), rr = r & 15, cc = c & 31, ob = rr * 64 + cc * 2; return st * 1024 + (ob ^ (((ob >> 9) & 1) << 5)); }
__host__ __device__ __forceinline__ void stage_rc(int b, int& R, int& C) { const int st = b / 1024, sb = b % 1024, swz = sb ^ (((sb >> 9) & 1) << 5); R = (st >> 1) * 16 + swz / 64; C = (st & 1) * 32 + (swz % 64) / 2; }
__host__ __device__ __forceinline__ int perm32(int rho) { const int n = rho >> 4, i = rho & 15; return 8 * (i >> 2) + 4 * n + (i & 3); }

struct Unit { int pm, pn; };
struct Gemm { const bf16_t* A; const bf16_t* Bt; int M, N, K; };

struct StaticOrder {
    int nM, nN, nwg, G, c;
    __host__ __device__ void init(int M, int N, int G_, int c_) { nM = M / BM; nN = N / BM; nwg = nM * nN; G = G_; c = c_; }
    __host__ __device__ bool next(int i, Unit& u) const {
        const long L = (long)i * G + c; if (L >= nwg) return false;
        int wgid = (int)L; { const int q = nwg / NXCD, r = nwg % NXCD, xcd = wgid % NXCD, off = wgid / NXCD; wgid = (xcd < r ? xcd * (q + 1) : r * (q + 1) + (xcd - r) * q) + off; }
        const int nig = WGM * nN, gid = wgid / nig, fm = gid * WGM, gsz = (nM - fm) < WGM ? (nM - fm) : WGM;
        u.pm = fm + ((wgid % nig) % gsz); u.pn = (wgid % nig) / gsz; return true;
    }
    __device__ __forceinline__ void a_ready(const Unit&) const {}
    __device__ __forceinline__ void done(const Unit&) const {}
};

__device__ __forceinline__ unsigned cvt_pk_bf16(float lo, float hi) { unsigned r; asm volatile("v_cvt_pk_bf16_f32 %0, %1, %2" : "=v"(r) : "v"(lo), "v"(hi)); return r; }

template <class Epi, class Sched, bool ALIGN_EPI = false, bool SP2 = false>
__device__ __forceinline__ void gemm_phase(PG8_LAS unsigned char* lds, const Gemm g, const Sched& S, const Epi& E) {
    int tid_ = threadIdx.x; asm volatile("" : "+v"(tid_));
    const int tid = tid_, wid = __builtin_amdgcn_readfirstlane(tid >> 6), lane = tid & 63, wr = wid >> 2, wc = wid & 3, fr = lane & 15, fq = lane >> 4;
    const int K = g.K, nt = K / BK;
    unsigned voffA[2], voffB[2];
#pragma unroll
    for (int i = 0; i < 2; ++i) { int R, C; stage_rc(tid * 16 + i * 8192, R, C); const int Rb = Epi::PERM ? ((R & ~31) + perm32(R & 31)) : R;
        voffA[i] = (unsigned)(R * K + C) * 2u; voffB[i] = (unsigned)(Rb * K + C) * 2u; }
    const size_t kstep = (size_t)(BK * 2);
    const size_t hstep = (size_t)HALF * K * 2;
    const size_t tstep = 2 * hstep;
    const unsigned ldsw = (unsigned)wid * 1024u;
    const int aoff = lds_byte(wr * 64 + fr, fq * 8), boff = lds_byte(wc * 32 + fr, fq * 8);
#define PG8_SA(b, h) (((b) * 2 + (h)) * HTB)
#define PG8_SB(b, h) ((4 + (b) * 2 + (h)) * HTB)
#define PG8_STAGE(bufoff, gbase, voff) do { _Pragma("unroll") for (int _i = 0; _i < 2; ++_i) \
        __builtin_amdgcn_global_load_lds((const unsigned*)((const char*)(gbase) + (voff)[_i]), (PG8_LAS unsigned*)(lds + (bufoff) + ldsw + _i * 8192), 16, 0, 0); } while (0)
#define PG8_LDA(dst, b, h) do { _Pragma("unroll") for (int m = 0; m < 4; ++m) _Pragma("unroll") for (int k = 0; k < 2; ++k) dst[m][k] = *(const PG8_LAS bf16x8*)(lds + PG8_SA(b, h) + aoff + m * 2048 + k * 1024); } while (0)
#define PG8_LDB(dst, b, h) do { _Pragma("unroll") for (int n = 0; n < 2; ++n) _Pragma("unroll") for (int k = 0; k < 2; ++k) dst[n][k] = *(const PG8_LAS bf16x8*)(lds + PG8_SB(b, h) + boff + n * 2048 + k * 1024); } while (0)
#define PG8_MMA(ai, bj, At, Bt) do { __builtin_amdgcn_s_setprio(1); _Pragma("unroll") for (int m = 0; m < 4; ++m) _Pragma("unroll") for (int n = 0; n < 2; ++n) _Pragma("unroll") for (int k = 0; k < 2; ++k) \
        acc[ai][bj][m][n] = __builtin_amdgcn_mfma_f32_16x16x32_bf16(Bt[n][k], At[m][k], acc[ai][bj][m][n], 0, 0, 0); __builtin_amdgcn_s_setprio(0); } while (0)
#define PG8_WAIT_V(n) asm volatile("s_waitcnt vmcnt(" #n ")" ::: "memory")
#define PG8_WAIT_L(n) asm volatile("s_waitcnt lgkmcnt(" #n ")" ::: "memory")
#define PG8_BAR __builtin_amdgcn_s_barrier()
#define PG8_SCHED __builtin_amdgcn_sched_barrier(0)
    Unit cur, nxt; int ui = 0;
    if (!S.next(0, cur)) return;
    f32x4 acc[2][2][4][2];
#pragma unroll
    for (int a = 0; a < 2; ++a)
#pragma unroll
        for (int b = 0; b < 2; ++b)
#pragma unroll
            for (int m = 0; m < 4; ++m)
#pragma unroll
                for (int n = 0; n < 2; ++n) acc[a][b][m][n] = (f32x4){0.f, 0.f, 0.f, 0.f};
    bf16x8 At[4][2], B0[2][2], B1[2][2];
    const char* cA = (const char*)g.A + (size_t)cur.pm * tstep; const char* cB = (const char*)g.Bt + (size_t)cur.pn * tstep;
    S.a_ready(cur);
    if constexpr (SP2) {
        PG8_STAGE(PG8_SB(0, 0), cB, voffB); PG8_STAGE(PG8_SB(0, 1), cB + hstep, voffB); PG8_STAGE(PG8_SA(0, 0), cA, voffA); PG8_STAGE(PG8_SA(0, 1), cA + hstep, voffA);
        if (wr == 1) PG8_BAR;
        PG8_WAIT_V(2); PG8_BAR;
        PG8_STAGE(PG8_SB(1, 0), cB + kstep, voffB); PG8_STAGE(PG8_SA(1, 0), cA + kstep, voffA); PG8_STAGE(PG8_SB(1, 1), cB + hstep + kstep, voffB);
        PG8_WAIT_V(6); PG8_BAR;
    } else {
        PG8_STAGE(PG8_SB(0, 0), cB, voffB); PG8_STAGE(PG8_SA(0, 0), cA, voffA); PG8_STAGE(PG8_SB(0, 1), cB + hstep, voffB); PG8_STAGE(PG8_SA(0, 1), cA + hstep, voffA);
        if (wr == 1) PG8_BAR;
        PG8_WAIT_V(4); PG8_BAR;
        PG8_STAGE(PG8_SB(1, 0), cB + kstep, voffB); PG8_STAGE(PG8_SA(1, 0), cA + kstep, voffA); PG8_STAGE(PG8_SB(1, 1), cB + hstep + kstep, voffB);
        PG8_WAIT_V(6); PG8_BAR;
    }
    for (;;) {
        const bool has_next = S.next(ui + 1, nxt);
        const char* nA = has_next ? (const char*)g.A + (size_t)nxt.pm * tstep : cA; const char* nB = has_next ? (const char*)g.Bt + (size_t)nxt.pn * tstep : cB;
        for (int t = 0; t < nt; t += 2) {
            const bool last = (t == nt - 2);
            const char* a1 = cA + (size_t)(t + 1) * kstep;
            const char* a2 = last ? nA : cA + (size_t)(t + 2) * kstep; const char* b2 = last ? nB : cB + (size_t)(t + 2) * kstep;
            const char* a3 = a2 + kstep; const char* b3 = b2 + kstep;
            if (last && has_next) S.a_ready(nxt);
            if constexpr (SP2) {
            PG8_LDB(B0, 0, 0); PG8_LDB(B1, 0, 1); PG8_SCHED; PG8_LDA(At, 0, 0); PG8_STAGE(PG8_SA(1, 1), a1 + hstep, voffA);
            PG8_WAIT_V(8); PG8_WAIT_L(0); PG8_BAR; PG8_MMA(0, 0, At, B0); PG8_MMA(0, 1, At, B1); PG8_BAR; PG8_SCHED;
            PG8_LDA(At, 0, 1); PG8_STAGE(PG8_SB(0, 0), b2, voffB); PG8_STAGE(PG8_SB(0, 1), b2 + hstep, voffB); PG8_STAGE(PG8_SA(0, 0), a2, voffA);
            PG8_WAIT_V(8); PG8_WAIT_L(0); PG8_BAR; PG8_MMA(1, 0, At, B0); PG8_MMA(1, 1, At, B1); PG8_BAR; PG8_SCHED;
            PG8_LDB(B0, 1, 0); PG8_LDB(B1, 1, 1); PG8_SCHED; PG8_LDA(At, 1, 0); PG8_STAGE(PG8_SA(0, 1), a2 + hstep, voffA);
            PG8_WAIT_V(8); PG8_WAIT_L(0); PG8_BAR; PG8_MMA(0, 0, At, B0); PG8_MMA(0, 1, At, B1); PG8_BAR; PG8_SCHED;
            PG8_LDA(At, 1, 1); PG8_STAGE(PG8_SB(1, 0), b3, voffB); PG8_STAGE(PG8_SB(1, 1), b3 + hstep, voffB); PG8_STAGE(PG8_SA(1, 0), a3, voffA);
            PG8_WAIT_V(8); PG8_WAIT_L(0); PG8_BAR; PG8_MMA(1, 0, At, B0); PG8_MMA(1, 1, At, B1); PG8_BAR; PG8_SCHED;
            } else {
            PG8_LDB(B0, 0, 0); PG8_SCHED; PG8_LDA(At, 0, 0); PG8_STAGE(PG8_SA(1, 1), a1 + hstep, voffA);
            PG8_WAIT_L(8); PG8_BAR; PG8_WAIT_L(0); PG8_MMA(0, 0, At, B0); PG8_BAR; PG8_SCHED;
            PG8_LDB(B1, 0, 1); PG8_STAGE(PG8_SB(0, 0), b2, voffB);
            PG8_BAR; PG8_WAIT_L(0); PG8_MMA(0, 1, At, B1); PG8_BAR;
            PG8_LDA(At, 0, 1); PG8_STAGE(PG8_SA(0, 0), a2, voffA);
            PG8_BAR; PG8_WAIT_L(0); PG8_MMA(1, 0, At, B0); PG8_BAR; PG8_SCHED;
            PG8_STAGE(PG8_SB(0, 1), b2 + hstep, voffB);
            PG8_WAIT_V(6); PG8_BAR; PG8_MMA(1, 1, At, B1); PG8_BAR;
            PG8_LDB(B0, 1, 0); PG8_SCHED; PG8_LDA(At, 1, 0); PG8_STAGE(PG8_SA(0, 1), a2 + hstep, voffA);
            PG8_WAIT_L(8); PG8_BAR; PG8_WAIT_L(0); PG8_MMA(0, 0, At, B0); PG8_BAR; PG8_SCHED;
            PG8_LDB(B1, 1, 1); PG8_STAGE(PG8_SB(1, 0), b3, voffB);
            PG8_BAR; PG8_WAIT_L(0); PG8_MMA(0, 1, At, B1); PG8_BAR;
            PG8_LDA(At, 1, 1); PG8_STAGE(PG8_SA(1, 0), a3, voffA);
            PG8_BAR; PG8_WAIT_L(0); PG8_MMA(1, 0, At, B0); PG8_BAR; PG8_SCHED;
            PG8_STAGE(PG8_SB(1, 1), b3 + hstep, voffB);
            PG8_WAIT_V(6); PG8_BAR; PG8_MMA(1, 1, At, B1); PG8_BAR;
            }
        }
        if constexpr (ALIGN_EPI) { if (wr == 0) PG8_BAR; }
        E(acc, cur, ui, wr, wc, fr, fq); S.done(cur);
        if (!has_next) break;
#pragma unroll
        for (int a = 0; a < 2; ++a)
#pragma unroll
            for (int b = 0; b < 2; ++b)
#pragma unroll
                for (int m = 0; m < 4; ++m)
#pragma unroll
                    for (int n = 0; n < 2; ++n) acc[a][b][m][n] = (f32x4){0.f, 0.f, 0.f, 0.f};
        cur = nxt; cA = nA; cB = nB; ++ui;
        if constexpr (ALIGN_EPI) { if (wr == 1) PG8_BAR; }
    }
    PG8_WAIT_V(0);
    if constexpr (!ALIGN_EPI) { if (wr == 0) PG8_BAR; }
    PG8_BAR;
#undef PG8_SA
#undef PG8_SB
#undef PG8_STAGE
#undef PG8_LDA
#undef PG8_LDB
#undef PG8_MMA
#undef PG8_WAIT_V
#undef PG8_WAIT_L
#undef PG8_BAR
#undef PG8_SCHED
}
}

constexpr int BATCH = 8, SEQ = 2048, D = 1024, M = BATCH * SEQ;
constexpr int FF = 2816, DRNN = 1280, NBLK = 10, RBLK = 128, CONVW = 4;
constexpr int NHEAD = 16, HD = 64, NGRP = 3, NQKV = 9216;
constexpr float RMS_EPS = 1e-6f;
constexpr float LOG2E = 1.4426950408889634f;
constexpr int NWAVES = 8;

typedef unsigned short bf16;
typedef unsigned v4u __attribute__((ext_vector_type(4)));
typedef unsigned v2u __attribute__((ext_vector_type(2)));
typedef float f32x4 __attribute__((ext_vector_type(4)));
#define GAS __attribute__((address_space(1)))
#define LAS __attribute__((address_space(3)))
typedef GAS unsigned gu32;
#define RLX_AGENT __ATOMIC_RELAXED, __HIP_MEMORY_SCOPE_AGENT
#define LDS_WAIT() asm volatile("s_waitcnt lgkmcnt(0)" ::: "memory")

constexpr size_t MiB = 1u << 20;
constexpr size_t WS_CTL = 0, CTL_ZERO_BYTES = 1 * MiB;
constexpr size_t WS_SSQ = 1 * MiB;
constexpr size_t WS_BIAS = 2 * MiB;
constexpr size_t WS_XB = 3 * MiB;
constexpr size_t WS_WO = 35 * MiB;
constexpr size_t WS_WQKV = 37 * MiB;
constexpr size_t WS_QKV = 55 * MiB;
constexpr size_t QKV_SLAB = (size_t)M * 1024 * 2;
constexpr size_t WS_LSE = 343 * MiB;
constexpr size_t WS_END = 346 * MiB;
constexpr size_t WS_WIN0 = 55 * MiB, WS_WOUT0 = 66 * MiB, WS_WIN1 = 72 * MiB, WS_WOUT1 = 83 * MiB, WS_WIN2 = 89 * MiB, WS_WOUT2 = 100 * MiB;
constexpr size_t WS_WRIN = 106 * MiB, WS_WROUT = 111 * MiB, WS_WA = 114 * MiB, WS_WX = 114 * MiB + 512 * 1024;
constexpr size_t WS_ACT = 115 * MiB;
constexpr size_t WS_G = 203 * MiB, WS_U = 243 * MiB, WS_Y = 283 * MiB;
constexpr size_t WS_ATT = WS_QKV + 3 * QKV_SLAB;
constexpr size_t WS_WIN3 = WS_QKV + 6 * QKV_SLAB, WS_WOUT3 = WS_WIN3 + 11 * MiB;
constexpr size_t WS_ACT3 = WS_QKV;
static_assert(WS_Y + (size_t)M * DRNN * 2 <= WS_LSE && WS_ACT + (size_t)M * FF * 2 <= WS_G && WS_WX + 327680 <= WS_ACT, "ws map");
static_assert(WS_QKV + 9 * QKV_SLAB == WS_LSE && WS_LSE + (size_t)3 * M * 16 * 4 <= WS_END, "ws map");
constexpr int CW_BAR = 4096;

constexpr int RING_BYTES = 131072, LDSCTL_OFF = RING_BYTES, MISC_OFF = LDSCTL_OFF + 320;
constexpr int RSTD_OFF = RING_BYTES + 1024, RSTD_MAX_UNITS = 9, GAIN_OFF = RSTD_OFF + RSTD_MAX_UNITS * 256 * 4;
constexpr int LDS_BYTES = 147456;
static_assert(GAIN_OFF + 512 <= LDS_BYTES, "LDS map");

#define XB_TMO      128
#define XB_XCNT(j)  (256  + 64 * (j))
#define XB_XSUB(j)  (1280 + 64 * (j))
#define XB_XGEN(j)  (2304 + 64 * (j))
#define XB_TOP      3328
#define XB_TOPGEN   3392
#define XCD_BAR_WORDS 3456
#define XB_SPIN_CAP (1u << 18)
__device__ __forceinline__ unsigned xb_ld(unsigned* p)              { return __hip_atomic_load(p, __ATOMIC_RELAXED, __HIP_MEMORY_SCOPE_AGENT); }
__device__ __forceinline__ unsigned xb_add(unsigned* p, unsigned v) { return __hip_atomic_fetch_add(p, v, __ATOMIC_RELAXED, __HIP_MEMORY_SCOPE_AGENT); }
__device__ __forceinline__ unsigned xb_xcc_id() { return (unsigned)__builtin_amdgcn_s_getreg((3 << 11) | 20) & 0xFu; }
#define XB_SPIN(cond, bar) do { unsigned _sp = 0; while (cond) { __builtin_amdgcn_s_sleep(1); \
    if ((++_sp & 255u) == 0u) { if (xb_ld(&(bar)[XB_TMO])) break; if (_sp > XB_SPIN_CAP) { atomicAdd(&(bar)[XB_TMO], 1u); break; } } } } while (0)
struct XcdBarrier { unsigned* bar; unsigned x; volatile LAS unsigned* st; };
__device__ __forceinline__ XcdBarrier xcd_barrier_post(unsigned* bar, volatile LAS unsigned* st) {
    XcdBarrier b; b.bar = bar; b.x = xb_xcc_id(); b.st = st;
    if (threadIdx.x == 0) (void)xb_add(&bar[XB_XCNT(b.x)], 1u);
    return b;
}
__device__ __forceinline__ void xcd_barrier_complete(unsigned* bar, unsigned x, unsigned& nloc, unsigned& nx) {
    const unsigned G = gridDim.x * gridDim.y * gridDim.z;
    unsigned sum, cnt, mine, sp = 0u;
    for (;;) {
        sum = 0u; cnt = 0u; mine = 0u;
#pragma unroll
        for (unsigned j = 0; j < 16; ++j) { const unsigned c = xb_ld(&bar[XB_XCNT(j)]); sum += c; cnt += (c > 0u) ? 1u : 0u; mine = (j == x) ? c : mine; }
        if (sum == G) break;
        __builtin_amdgcn_s_sleep(1);
        if ((++sp & 255u) == 0u) { if (xb_ld(&bar[XB_TMO])) break; if (sp > XB_SPIN_CAP) { atomicAdd(&bar[XB_TMO], 1u); break; } }
    }
    nloc = mine > 0u ? mine : 1u; nx = cnt > 0u ? cnt : 1u;
}
__device__ __forceinline__ void xcd_barrier(const XcdBarrier& b) {
    asm volatile("s_waitcnt vmcnt(0)" ::: "memory");
    __syncthreads();
    if (threadIdx.x == 0) {
        unsigned* bar = b.bar;
        __builtin_amdgcn_s_waitcnt(0);
        unsigned nloc = b.st[0], nx = b.st[1];
        if (nloc == 0u) { xcd_barrier_complete(bar, b.x, nloc, nx); b.st[0] = nloc; b.st[1] = nx; }
        const unsigned old = xb_add(&bar[XB_XSUB(b.x)], 1u);
        const unsigned gen = old / nloc;
        if (old + 1u == (gen + 1u) * nloc) {
            __builtin_amdgcn_fence(__ATOMIC_RELEASE, "agent");
            asm volatile("s_waitcnt vmcnt(0)" ::: "memory");
            const unsigned og = xb_add(&bar[XB_TOP], 1u);
            const unsigned tg = og / nx;
            if (og + 1u == (tg + 1u) * nx) xb_add(&bar[XB_TOPGEN], 1u);
            else XB_SPIN(xb_ld(&bar[XB_TOPGEN]) == tg, bar);
            __builtin_amdgcn_fence(__ATOMIC_ACQUIRE, "agent");
            xb_add(&bar[XB_XGEN(b.x)], 1u);
            asm volatile("s_waitcnt vmcnt(0)" ::: "memory");
        } else {
            XB_SPIN(xb_ld(&bar[XB_XGEN(b.x)]) == gen, bar);
            __builtin_amdgcn_fence(__ATOMIC_ACQUIRE, "agent");
            asm volatile("s_waitcnt vmcnt(0)" ::: "memory");
        }
    }
    __syncthreads();
}

__device__ __forceinline__ unsigned f2bf(float f) { unsigned u = __builtin_bit_cast(unsigned, f); return (u + 0x7fffu + ((u >> 16) & 1u)) >> 16; }
__device__ __forceinline__ unsigned pk2(float lo, float hi) { return f2bf(lo) | (f2bf(hi) << 16); }
__device__ __forceinline__ float bf_lo(unsigned w) { return __builtin_bit_cast(float, w << 16); }
__device__ __forceinline__ float bf_hi(unsigned w) { return __builtin_bit_cast(float, w & 0xffff0000u); }
__device__ __forceinline__ float bf2f(bf16 v) { return __builtin_bit_cast(float, (unsigned)v << 16); }
__device__ __forceinline__ float wave_sum(float v) {
#pragma unroll
    for (int o = 1; o < 64; o <<= 1) v += __shfl_xor(v, o);
    return v;
}
__device__ __forceinline__ float fast_sigmoid(float x) { return __builtin_amdgcn_rcpf(1.f + __builtin_amdgcn_exp2f(-LOG2E * x)); }
__device__ __forceinline__ float row_rstd(const float* ssq, int row) {
    const f32x4* p = (const f32x4*)(ssq + (size_t)row * 16); const f32x4 a = p[0], b = p[1], c = p[2], d = p[3];
    const float s = ((a.x + a.y) + (a.z + a.w)) + ((b.x + b.y) + (b.z + b.w)) + ((c.x + c.y) + (c.z + c.w)) + ((d.x + d.y) + (d.z + d.w));
    return rsqrtf(s * (1.0f / D) + RMS_EPS);
}

typedef float f32x2 __attribute__((ext_vector_type(2)));
template <class Sched> __device__ __forceinline__ void fill_rstd(LAS unsigned char* lds, const Sched& S, const float* ssq, int tid) {
    LAS float* rt = (LAS float*)(lds + RSTD_OFF); pg8::Unit u;
    for (int i = 0; i < RSTD_MAX_UNITS && S.next(i, u); ++i)
        if ((tid >> 8) == (i & 1)) { const int r = tid & 255; rt[i * 256 + r] = row_rstd(ssq, u.pm * 256 + r); }
    __syncthreads();
}
using pg8::Unit;
__device__ __forceinline__ f32x2 silu_mul_pk(f32x2 g, f32x2 up) {
    const f32x2 t = g * (-LOG2E); f32x2 e; e.x = __builtin_amdgcn_exp2f(t.x); e.y = __builtin_amdgcn_exp2f(t.y);
    const f32x2 d = e + 1.0f; f32x2 r; r.x = __builtin_amdgcn_rcpf(d.x); r.y = __builtin_amdgcn_rcpf(d.y);
    return (g * r) * up;
}
struct EpiSwiGLU {
    static constexpr bool PERM = true;
    const LAS float* rtab; bf16* act; int skip;
    __device__ __forceinline__ void operator()(const f32x4 (&acc)[2][2][4][2], const Unit& u, int ui, int wr, int wc, int fr, int fq) const {
        if (skip == 1) return;
#pragma unroll
        for (int ai = 0; ai < 2; ++ai)
#pragma unroll
            for (int m = 0; m < 4; ++m) {
                const int rl = ai * 128 + wr * 64 + m * 16 + fr, row = u.pm * 256 + rl;
                const float rs = rtab[ui * 256 + rl];
                f32x2 v[4];
#pragma unroll
                for (int n = 0; n < 2; ++n)
#pragma unroll
                    for (int e = 0; e < 2; ++e) { const f32x2 g = (f32x2){acc[ai][0][m][n][2 * e], acc[ai][0][m][n][2 * e + 1]} * rs, up = (f32x2){acc[ai][1][m][n][2 * e], acc[ai][1][m][n][2 * e + 1]} * rs;
                        v[n * 2 + e] = silu_mul_pk(g, up); }
                v4u w; w.x = pg8::cvt_pk_bf16(v[0].x, v[0].y); w.y = pg8::cvt_pk_bf16(v[1].x, v[1].y); w.z = pg8::cvt_pk_bf16(v[2].x, v[2].y); w.w = pg8::cvt_pk_bf16(v[3].x, v[3].y);
                if (skip != 2 || w.x == 0x7fc17fc1u) *(v4u*)(act + (size_t)row * FF + u.pn * 128 + wc * 32 + 8 * fq) = w;
            }
    }
};
#ifndef RESID_BF16
#define RESID_BF16 1
#endif
struct EpiRes {
    static constexpr bool PERM = true;
    const float* xin; float* xout; bf16* xb; float* ssq; float scale; bool skip;
    __device__ __forceinline__ void operator()(const f32x4 (&acc)[2][2][4][2], const Unit& u, int ui, int wr, int wc, int fr, int fq) const {
        if (skip) return;
        if (xin) run<true>(acc, u, wr, wc, fr, fq); else run<false>(acc, u, wr, wc, fr, fq);
    }
    template <bool F32IN> __device__ __forceinline__ void run(const f32x4 (&acc)[2][2][4][2], const Unit& u, int wr, int wc, int fr, int fq) const {
#pragma unroll
        for (int ai = 0; ai < 2; ++ai) {
            f32x4 xv[4][2][2];
#pragma unroll
            for (int m = 0; m < 4; ++m)
#pragma unroll
                for (int bj = 0; bj < 2; ++bj) { const size_t off = (size_t)(u.pm * 256 + ai * 128 + wr * 64 + m * 16 + fr) * D + u.pn * 256 + bj * 128 + wc * 32 + 8 * fq;
                    if (F32IN) { xv[m][bj][0] = *(const f32x4*)(xin + off); xv[m][bj][1] = *(const f32x4*)(xin + off + 4); }
                    else { const v4u w = *(const v4u*)(xb + off); xv[m][bj][0] = (f32x4){bf_lo(w.x), bf_hi(w.x), bf_lo(w.y), bf_hi(w.y)}; xv[m][bj][1] = (f32x4){bf_lo(w.z), bf_hi(w.z), bf_lo(w.w), bf_hi(w.w)}; } }
#pragma unroll
            for (int m = 0; m < 4; ++m) {
                const int row = u.pm * 256 + ai * 128 + wr * 64 + m * 16 + fr;
                float ss = 0.f;
#pragma unroll
                for (int bj = 0; bj < 2; ++bj) {
                    const size_t off = (size_t)row * D + u.pn * 256 + bj * 128 + wc * 32 + 8 * fq;
                    const f32x4 y0 = xv[m][bj][0] + acc[ai][bj][m][0] * scale, y1 = xv[m][bj][1] + acc[ai][bj][m][1] * scale;
                    if (xout) { *(f32x4*)(xout + off) = y0; *(f32x4*)(xout + off + 4) = y1; }
                    v4u w; w.x = pg8::cvt_pk_bf16(y0[0], y0[1]); w.y = pg8::cvt_pk_bf16(y0[2], y0[3]); w.z = pg8::cvt_pk_bf16(y1[0], y1[1]); w.w = pg8::cvt_pk_bf16(y1[2], y1[3]);
                    *(v4u*)(xb + off) = w;
                    ss += (y0[0] * y0[0] + y0[1] * y0[1]) + (y0[2] * y0[2] + y0[3] * y0[3]) + (y1[0] * y1[0] + y1[1] * y1[1]) + (y1[2] * y1[2] + y1[3] * y1[3]);
                }
                ss += __shfl_xor(ss, 16); ss += __shfl_xor(ss, 32);
                if (fq == 0) ssq[(size_t)row * 16 + u.pn * 4 + wc] = ss;
            }
            asm volatile("" ::: "memory");
        }
    }
};
struct EpiRnnIn {
    static constexpr bool PERM = true;
    const LAS float* rtab; bf16* Gb; bf16* Ub;
    template <bool GATE> __device__ __forceinline__ void run(const f32x4 (&acc)[2][2][4][2], const Unit& u, int ui, int wr, int wc, int fr, int fq, bf16* dstb, int pc) const {
#pragma unroll
        for (int ai = 0; ai < 2; ++ai)
#pragma unroll
            for (int m = 0; m < 4; ++m) {
                const int rl = ai * 128 + wr * 64 + m * 16 + fr, row = u.pm * 256 + rl;
                const float rs = rtab[ui * 256 + rl];
#pragma unroll
                for (int bj = 0; bj < 2; ++bj) {
                    f32x2 v[4];
#pragma unroll
                    for (int n = 0; n < 2; ++n)
#pragma unroll
                        for (int e = 0; e < 2; ++e) { f32x2 x = (f32x2){acc[ai][bj][m][n][2 * e], acc[ai][bj][m][n][2 * e + 1]} * rs;
                            if (GATE) {
                                const f32x2 t = (x * x * 0.044715f + 1.0f) * x * (-1.5957691216057308f * LOG2E); f32x2 ex; ex.x = __builtin_amdgcn_exp2f(t.x); ex.y = __builtin_amdgcn_exp2f(t.y);
                                const f32x2 d = ex + 1.0f; f32x2 r; r.x = __builtin_amdgcn_rcpf(d.x); r.y = __builtin_amdgcn_rcpf(d.y); x = x * r; }
                            v[n * 2 + e] = x; }
                    v4u w; w.x = pg8::cvt_pk_bf16(v[0].x, v[0].y); w.y = pg8::cvt_pk_bf16(v[1].x, v[1].y); w.z = pg8::cvt_pk_bf16(v[2].x, v[2].y); w.w = pg8::cvt_pk_bf16(v[3].x, v[3].y);
                    *(v4u*)(dstb + (size_t)row * DRNN + pc * 256 + bj * 128 + wc * 32 + 8 * fq) = w;
                }
            }
    }
    __device__ __forceinline__ void operator()(const f32x4 (&acc)[2][2][4][2], const Unit& u, int ui, int wr, int wc, int fr, int fq) const {
        if (u.pn < 5) run<true>(acc, u, ui, wr, wc, fr, fq, Gb, u.pn); else run<false>(acc, u, ui, wr, wc, fr, fq, Ub, u.pn - 5);
    }
};
struct EpiQKV {
    static constexpr bool PERM = true;
    const LAS float* rtab; const LAS float* gtab; bf16* qkv; bool skip;
    __device__ __forceinline__ void operator()(const f32x4 (&acc)[2][2][4][2], const Unit& u, int ui, int wr, int wc, int fr, int fq) const {
        if (skip) return;
        const int hs = u.pn * 4 + wc, kind = hs / 48, gh = hs - kind * 48, g = gh >> 4, h = gh & 15, l2d = 2 * g;
        bf16* slab = qkv + (size_t)(kind * 3 + g) * ((size_t)M * 1024);
        f32x4 gv[2][2];
#pragma unroll
        for (int bj = 0; bj < 2; ++bj)
#pragma unroll
            for (int n = 0; n < 2; ++n) { gv[bj][n] = (f32x4){1.f, 1.f, 1.f, 1.f}; if (kind < 2) gv[bj][n] = *(const LAS f32x4*)(gtab + kind * 64 + 32 * bj + 8 * fq + 4 * n); }
#pragma unroll
        for (int ai = 0; ai < 2; ++ai)
#pragma unroll
            for (int m = 0; m < 4; ++m) {
                const int rl = ai * 128 + wr * 64 + m * 16 + fr, row = u.pm * 256 + rl;
                const float rs = rtab[ui * 256 + rl];
                f32x4 v[2][2]; float ss = 0.f;
#pragma unroll
                for (int bj = 0; bj < 2; ++bj)
#pragma unroll
                    for (int n = 0; n < 2; ++n) { v[bj][n] = acc[ai][bj][m][n] * rs; const f32x4 t = v[bj][n] * v[bj][n]; ss += (t[0] + t[1]) + (t[2] + t[3]); }
                float rn = 1.f;
                if (kind < 2) { ss += __shfl_xor(ss, 16); ss += __shfl_xor(ss, 32); rn = rsqrtf(ss * (1.0f / HD) + RMS_EPS); }
                const int b = row >> 11, t = row & 2047, rres = t & ((1 << l2d) - 1), l = t >> l2d, L = 2048 >> l2d;
                bf16* dst = slab + ((size_t)(b * 16 + h) * 2048 + rres * L + l) * 64 + 8 * fq;
#pragma unroll
                for (int bj = 0; bj < 2; ++bj) {
                    const f32x4 a0 = v[bj][0] * gv[bj][0] * rn, a1 = v[bj][1] * gv[bj][1] * rn;
                    v4u w; w.x = pg8::cvt_pk_bf16(a0[0], a0[1]); w.y = pg8::cvt_pk_bf16(a0[2], a0[3]); w.z = pg8::cvt_pk_bf16(a1[0], a1[1]); w.w = pg8::cvt_pk_bf16(a1[2], a1[3]);
                    *(v4u*)(dst + 32 * bj) = w;
                }
            }
    }
};

struct Args { const float* in[18]; float* out; unsigned char* ws; int ph_lo, ph_hi; };
enum { I_X = 0, I_NORMG, I_FFN_WIN, I_FFN_WOUT, I_RNN_WIN, I_CONV_W, I_CONV_B, I_WA, I_BA, I_WX, I_BX, I_LAM, I_RNN_WOUT, I_WQKV, I_QGAIN, I_KGAIN, I_WO, I_RELB };

struct Ctx { LAS unsigned char* lds; int tid, lane, wave, G, vcu; unsigned char* ws; };

typedef short v4i16_t __attribute__((ext_vector_type(4)));
__device__ __forceinline__ v4i16_t vtr16(const LAS unsigned char* p) { return __builtin_amdgcn_ds_read_tr16_b64_v4i16((LAS v4i16_t*)p); }
enum { CM_NONE = 0, CM_FFN = 1, CM_QKV = 2 };
__device__ __forceinline__ int colmap(int mode, int vr) {
    if (mode == CM_FFN) { const int pn = vr >> 8, w = vr & 255; return (w >> 7) * FF + 128 * pn + (w & 127); }
    if (mode == CM_QKV) { const int pn = vr >> 8, w = vr & 255, bj = w >> 7, wc = (w >> 5) & 3, j = w & 31; return 256 * pn + 64 * wc + 32 * bj + j; }
    return vr;
}
__device__ __forceinline__ void transpose_item(const float* W, int K, int N, const float* gvec, bf16* WT, int mode, LAS unsigned char* scr, int item, int lane) {
    const int nblk = N / 64, kb = item / nblk, nb = item - kb * nblk, k0 = 64 * kb, vr0 = 64 * nb;
    const int col4 = lane & 15, rsub = lane >> 4, nsrc = colmap(mode, vr0 + 32 * (col4 >> 3)) + (col4 & 7) * 4;
    const float* src = W + (size_t)(k0 + rsub) * N + nsrc;
    f32x4 w[16];
#pragma unroll
    for (int i = 0; i < 16; ++i) w[i] = *(const GAS f32x4*)(src + (size_t)(4 * i) * N);
    if (gvec) {
#pragma unroll
        for (int i = 0; i < 16; ++i) w[i] = w[i] * gvec[k0 + 4 * i + rsub];
    }
#pragma unroll
    for (int i = 0; i < 16; ++i) { v2u p; p.x = pg8::cvt_pk_bf16(w[i][0], w[i][1]); p.y = pg8::cvt_pk_bf16(w[i][2], w[i][3]);
        *(LAS v2u*)(scr + (col4 >> 3) * 4096 + (4 * i + rsub) * 64 + (col4 & 7) * 8) = p; }
    const int q = (lane & 15) >> 2, p4 = lane & 3, gidx = lane >> 4;
#pragma unroll
    for (int r = 0; r < 8; ++r) { const int nb16 = r >> 1, kh = r & 1, kbase = 32 * kh + 8 * gidx;
        const LAS unsigned char* a = scr + (nb16 >> 1) * 4096 + (kbase + q) * 64 + ((nb16 & 1) * 16 + 4 * p4) * 2;
        const v4i16_t lo = vtr16(a), hi = vtr16(a + 4 * 64);
        v4u o; { const v2u l2 = __builtin_bit_cast(v2u, lo), h2 = __builtin_bit_cast(v2u, hi); o.x = l2.x; o.y = l2.y; o.z = h2.x; o.w = h2.y; }
        *(GAS v4u*)(WT + (size_t)(vr0 + nb16 * 16 + (lane & 15)) * K + k0 + kbase) = o; }
}
struct MatJob { const float* W; int K, N; const float* g; bf16* WT; int mode; };
__device__ __forceinline__ MatJob mat_job(const Ctx& C, const Args& a, int idx) {
    unsigned char* ws = C.ws; const float* ng = a.in[I_NORMG]; MatJob j;
    switch (idx) {
    case 0: j = MatJob{a.in[I_FFN_WIN] + (size_t)0 * D * 2 * FF, D, 2 * FF, ng + 0 * D, (bf16*)(ws + WS_WIN0), CM_FFN}; break;
    case 1: j = MatJob{a.in[I_FFN_WOUT] + (size_t)0 * FF * D, FF, D, nullptr, (bf16*)(ws + WS_WOUT0), CM_NONE}; break;
    case 2: j = MatJob{a.in[I_RNN_WIN], D, 2 * DRNN, ng + 1 * D, (bf16*)(ws + WS_WRIN), CM_NONE}; break;
    case 3: j = MatJob{a.in[I_RNN_WOUT], DRNN, D, nullptr, (bf16*)(ws + WS_WROUT), CM_NONE}; break;
    case 4: j = MatJob{a.in[I_FFN_WIN] + (size_t)1 * D * 2 * FF, D, 2 * FF, ng + 2 * D, (bf16*)(ws + WS_WIN1), CM_FFN}; break;
    case 5: j = MatJob{a.in[I_FFN_WOUT] + (size_t)1 * FF * D, FF, D, nullptr, (bf16*)(ws + WS_WOUT1), CM_NONE}; break;
    case 6: j = MatJob{a.in[I_FFN_WIN] + (size_t)2 * D * 2 * FF, D, 2 * FF, ng + 3 * D, (bf16*)(ws + WS_WIN2), CM_FFN}; break;
    case 7: j = MatJob{a.in[I_FFN_WOUT] + (size_t)2 * FF * D, FF, D, nullptr, (bf16*)(ws + WS_WOUT2), CM_NONE}; break;
    case 8: j = MatJob{a.in[I_WQKV], D, NQKV, ng + 4 * D, (bf16*)(ws + WS_WQKV), CM_QKV}; break;
    case 9: j = MatJob{a.in[I_WO], D, D, nullptr, (bf16*)(ws + WS_WO), CM_NONE}; break;
    case 10: j = MatJob{a.in[I_FFN_WIN] + (size_t)3 * D * 2 * FF, D, 2 * FF, ng + 5 * D, (bf16*)(ws + WS_WIN3), CM_FFN}; break;
    default: j = MatJob{a.in[I_FFN_WOUT] + (size_t)3 * FF * D, FF, D, nullptr, (bf16*)(ws + WS_WOUT3), CM_NONE}; break;
    }
    return j;
}
__device__ __forceinline__ void convert_mats(const Ctx& C, const Args& a, int first, int last, int gw, int NGW) {
    LAS unsigned char* scr = C.lds + C.wave * 8192;
    int base = 0;
    for (int mi = first; mi < last; ++mi) {
        const MatJob j = mat_job(C, a, mi); const int cnt = (j.K / 64) * (j.N / 64);
        int it = (gw - base) % NGW; if (it < 0) it += NGW;
        for (; it < cnt; it += NGW) transpose_item(j.W, j.K, j.N, j.g, j.WT, j.mode, scr, it, C.lane);
        base += cnt;
    }
}
__device__ __forceinline__ int t5_bucket(int n) {
    if (n < 16) return n;
    int b = 16;
    b += (n >= 22) + (n >= 30) + (n >= 40) + (n >= 54) + (n >= 73) + (n >= 99) + (n >= 134) + (n >= 182) + (n >= 246) + (n >= 332) + (n >= 450) + (n >= 609) + (n >= 825) + (n >= 1117) + (n >= 1513);
    return b;
}
__device__ __forceinline__ void p_prologue(const Ctx& C, const Args& a) {
    const int gw = C.vcu * NWAVES + C.wave, NGW = C.G * NWAVES;
    convert_mats(C, a, 0, 3, gw, NGW);
    {   LAS unsigned char* scr = C.lds + C.wave * 8192;
        for (int it = gw; it < 2 * NBLK * 4; it += NGW) { const int which = it / (NBLK * 4), r = it % (NBLK * 4), blk = r >> 2, sub = r & 3;
            const float* W = (which ? a.in[I_WX] : a.in[I_WA]) + (size_t)blk * RBLK * RBLK; bf16* WT = (bf16*)(C.ws + (which ? WS_WX : WS_WA)) + (size_t)blk * RBLK * RBLK;
            transpose_item(W, RBLK, RBLK, nullptr, WT, CM_NONE, scr, sub, C.lane); } }
    const float* x = a.in[I_X]; bf16* xb = (bf16*)(C.ws + WS_XB); float* ssq = (float*)(C.ws + WS_SSQ);
    for (int m = gw; m < M; m += NGW) {
        const GAS f32x4* xr = (const GAS f32x4*)(x + (size_t)m * D) + C.lane; f32x4 v[4]; float s = 0.f;
#pragma unroll
        for (int j = 0; j < 4; ++j) { v[j] = xr[64 * j]; s += (v[j].x * v[j].x + v[j].y * v[j].y) + (v[j].z * v[j].z + v[j].w * v[j].w); }
        s = wave_sum(s);
        GAS v2u* o8 = (GAS v2u*)(xb + (size_t)m * D) + C.lane;
#pragma unroll
        for (int j = 0; j < 4; ++j) { v2u w; w.x = pk2(v[j].x, v[j].y); w.y = pk2(v[j].z, v[j].w); o8[64 * j] = w; }
        if (C.lane < 16) ssq[(size_t)m * 16 + C.lane] = (C.lane == 0) ? s : 0.f;
    }
    float* bt = (float*)(C.ws + WS_BIAS); const float* rb = a.in[I_RELB];
    for (int i = blockIdx.x * 512 + C.tid; i < 48 * 129; i += C.G * 512) { const int gh = i / 129, dist = i - gh * 129, g = gh >> 4;
        bt[gh * 132 + dist] = rb[t5_bucket(dist << (2 * g)) * 48 + gh] * LOG2E; }
}

typedef float f32x16 __attribute__((ext_vector_type(16)));
typedef short bf16x8v __attribute__((ext_vector_type(8)));
constexpr int RM_WB = 0, RM_WB_GATE = 64 * 272, RM_CW = 36864, RM_CMP = RM_CW + 2560, RM_TILE = 49152, RM_TILE_BYTES = 36 * 256, RM_END = RM_TILE + 8 * RM_TILE_BYTES;
static_assert(RM_WB + 2 * RM_WB_GATE <= RM_CW && RM_CMP + 2 * 2 * 8 * 64 * 4 <= RM_TILE && RM_END <= RING_BYTES, "rnn-mid LDS map");
__device__ __forceinline__ bf16x8v pack8(const float (&v)[8]) {
    v4u w; w.x = pg8::cvt_pk_bf16(v[0], v[1]); w.y = pg8::cvt_pk_bf16(v[2], v[3]); w.z = pg8::cvt_pk_bf16(v[4], v[5]); w.w = pg8::cvt_pk_bf16(v[6], v[7]);
    return __builtin_bit_cast(bf16x8v, w);
}
__device__ __forceinline__ void p_rnn_mid(const Ctx& C, const Args& a) {
    const bf16* U = (const bf16*)(C.ws + WS_U); const bf16* Gb = (const bf16*)(C.ws + WS_G); bf16* Y = (bf16*)(C.ws + WS_Y);
    const bf16* WAb = (const bf16*)(C.ws + WS_WA); const bf16* WXb = (const bf16*)(C.ws + WS_WX);
    LAS unsigned char* L = C.lds;
    LAS float* CW = (LAS float*)(L + RM_CW); LAS float* CMP = (LAS float*)(L + RM_CMP);
    const int wave = C.wave;
    LAS unsigned char* wt = L + RM_TILE + wave * RM_TILE_BYTES;
    for (int item = blockIdx.x; item < BATCH * NBLK * 2; item += C.G) {
        const int b = item / (NBLK * 2), n = (item % (NBLK * 2)) >> 1, half = item & 1;
        int tid = C.tid; asm volatile("" : "+v"(tid));
        const int lane = tid & 63, r32 = lane & 31, hh = lane >> 5;
        __syncthreads();
#pragma unroll
        for (int p = 0; p < 4; ++p) { const int idx = p * 512 + tid, gate = idx >> 10, rem = idx & 1023, row = rem >> 4, c16 = rem & 15;
            const v4u w = *(const v4u*)((gate ? WXb : WAb) + (size_t)(n * 128 + 64 * half + row) * 128 + c16 * 8);
            *(LAS v4u*)(L + RM_WB + gate * RM_WB_GATE + row * 272 + c16 * 16) = w; }
        CW[tid] = a.in[I_CONV_W][(tid >> 7) * DRNN + n * 128 + (tid & 127)];
        if (tid < 128) CW[512 + tid] = a.in[I_CONV_B][n * 128 + tid];
        __syncthreads();
        float ba[2], bx[2], spl[2], Ht[2];
#pragma unroll
        for (int cb = 0; cb < 2; ++cb) { const int ch = n * 128 + 64 * half + 32 * cb + r32; ba[cb] = a.in[I_BA][ch]; bx[cb] = a.in[I_BX][ch];
            spl[cb] = -8.0f * LOG2E * log1pf(expf(-a.in[I_LAM][ch])); Ht[cb] = 0.f; }
        bf16x8v idf[2];
#pragma unroll
        for (int sp = 0; sp < 2; ++sp)
#pragma unroll
            for (int j = 0; j < 8; ++j) idf[sp][j] = (16 * sp + 8 * hh + j == r32) ? (short)0x3F80 : (short)0;
        const int urow = lane >> 4, uch = lane & 15, grow = lane >> 3, gch = lane & 7;
        v4u uraw[9], graw[4];
#define RM_LOADU(TILE) do { const int tp_ = (TILE) * 256 + wave * 32; const int ub_ = (b * SEQ + tp_ - 3 + urow) * DRNN + n * 128 + uch * 8;        \
        _Pragma("unroll") for (int i_ = 0; i_ < 9; ++i_) uraw[i_] = *(const v4u*)(U + (ptrdiff_t)(ub_ + i_ * 4 * DRNN)); \
        if (tp_ == 0 && urow < 3) uraw[0] = (v4u){0u, 0u, 0u, 0u};         } while (0)
#define RM_LOADG(TILE) do { const int gb_ = (b * SEQ + (TILE) * 256 + wave * 32 + grow) * DRNN + n * 128 + 64 * half + gch * 8; \
        _Pragma("unroll") for (int i_ = 0; i_ < 4; ++i_) graw[i_] = *(const v4u*)(Gb + (unsigned)(gb_ + i_ * 8 * DRNN)); } while (0)
        for (int tile = 0; tile < 8; ++tile) {
            const int tposw = tile * 256 + wave * 32;
            const size_t tok0 = (size_t)b * SEQ + tposw;
            LAS float* CWt = CW; LAS unsigned char* WBt = L + RM_WB; asm volatile("" : "+v"(CWt), "+v"(WBt));
            RM_LOADU(tile); RM_LOADG(tile);
#pragma unroll
            for (int i = 0; i < 9; ++i) { const int rl = 4 * i + urow; *(LAS v4u*)(wt + rl * 256 + ((uch ^ (rl & 15)) << 4)) = uraw[i]; }
            bf16x8v af[8];
#pragma unroll
            for (int s = 0; s < 8; ++s) {
                const int c0 = 16 * s + 8 * hh;
                float v[8];
                { const f32x4 b0 = *(const LAS f32x4*)(CWt + 512 + c0), b1 = *(const LAS f32x4*)(CWt + 512 + c0 + 4);
                  v[0] = b0[0]; v[1] = b0[1]; v[2] = b0[2]; v[3] = b0[3]; v[4] = b1[0]; v[5] = b1[1]; v[6] = b1[2]; v[7] = b1[3]; }
#pragma unroll
                for (int k = 0; k < 4; ++k) { const f32x4 w0 = *(const LAS f32x4*)(CWt + k * 128 + c0), w1 = *(const LAS f32x4*)(CWt + k * 128 + c0 + 4);
                    const v4u uu = *(const LAS v4u*)(wt + (r32 + k) * 256 + (((2 * s + hh) ^ ((r32 + k) & 15)) << 4));
                    v[0] += w0[0] * bf_lo(uu.x); v[1] += w0[1] * bf_hi(uu.x); v[2] += w0[2] * bf_lo(uu.y); v[3] += w0[3] * bf_hi(uu.y);
                    v[4] += w1[0] * bf_lo(uu.z); v[5] += w1[1] * bf_hi(uu.z); v[6] += w1[2] * bf_lo(uu.w); v[7] += w1[3] * bf_hi(uu.w); }
                af[s] = pack8(v);
                __builtin_amdgcn_sched_barrier(0);
            }
#pragma unroll
            for (int i = 0; i < 4; ++i) *(LAS v4u*)(wt + (8 * i + grow) * 128 + gch * 16) = graw[i];
            f32x16 acc[2][2], ufa[2];
#pragma unroll
            for (int cb = 0; cb < 2; ++cb)
#pragma unroll
                for (int e = 0; e < 16; ++e) { acc[0][cb][e] = 0.f; acc[1][cb][e] = 0.f; ufa[cb][e] = 0.f; }
#pragma unroll
            for (int s = 0; s < 8; ++s)
#pragma unroll
                for (int gt = 0; gt < 2; ++gt)
#pragma unroll
                    for (int cb = 0; cb < 2; ++cb) {
                        const bf16x8v bfr = *(const LAS bf16x8v*)(WBt + gt * RM_WB_GATE + (32 * cb + r32) * 272 + (16 * s + 8 * hh) * 2);
                        acc[gt][cb] = __builtin_amdgcn_mfma_f32_32x32x16_bf16(af[s], bfr, acc[gt][cb], 0, 0, 0);
                        if (gt == 1 && cb == 1 && (s & 1)) __builtin_amdgcn_sched_barrier(0);
                    }
#pragma unroll
            for (int cb = 0; cb < 2; ++cb)
#pragma unroll
                for (int sp = 0; sp < 2; ++sp) { const bf16x8v asel = half ? af[4 + 2 * cb + sp] : af[2 * cb + sp];
                    ufa[cb] = __builtin_amdgcn_mfma_f32_32x32x16_bf16(asel, idf[sp], ufa[cb], 0, 0, 0); }
#pragma unroll
            for (int cb = 0; cb < 2; ++cb)
#pragma unroll
                for (int e = 0; e < 16; ++e) {
                    const float uf = ufa[cb][e];
                    const float r = fast_sigmoid(acc[0][cb][e] + ba[cb]), ii = fast_sigmoid(acc[1][cb][e] + bx[cb]);
                    const float av = __builtin_amdgcn_exp2f(r * spl[cb]);
                    const float bv = __builtin_amdgcn_sqrtf(fmaxf(1.f - av * av, 0.f)) * (ii * uf);
                    acc[0][cb][e] = av; acc[1][cb][e] = bv;
                }
            float A0[2][4], B0[2][4], A1[2][4], B1[2][4];
            const int par = tile & 1;
#pragma unroll
            for (int cb = 0; cb < 2; ++cb) {
                float Aw = 1.f, Bw = 0.f;
#pragma unroll
                for (int q = 0; q < 4; ++q) {
                    const float a0 = acc[0][cb][4 * q], a1 = acc[0][cb][4 * q + 1], a2 = acc[0][cb][4 * q + 2], a3 = acc[0][cb][4 * q + 3];
                    const float Ag = (a0 * a1) * (a2 * a3);
                    const float Bg = ((acc[1][cb][4 * q] * a1 + acc[1][cb][4 * q + 1]) * a2 + acc[1][cb][4 * q + 2]) * a3 + acc[1][cb][4 * q + 3];
                    const float pA = __shfl_xor(Ag, 32), pB = __shfl_xor(Bg, 32);
                    A0[cb][q] = hh ? pA : Ag; B0[cb][q] = hh ? pB : Bg; A1[cb][q] = hh ? Ag : pA; B1[cb][q] = hh ? Bg : pB;
                    Bw = Bw * A0[cb][q] + B0[cb][q]; Aw *= A0[cb][q]; Bw = Bw * A1[cb][q] + B1[cb][q]; Aw *= A1[cb][q];
                }
                if (hh == 0) { CMP[((par * 2 + 0) * 8 + wave) * 64 + 32 * cb + r32] = Aw; CMP[((par * 2 + 1) * 8 + wave) * 64 + 32 * cb + r32] = Bw; }
            }
            __syncthreads();
#pragma unroll
            for (int cb = 0; cb < 2; ++cb) {
                float h = Ht[cb], hin = 0.f;
#pragma unroll
                for (int v = 0; v < 8; ++v) { const float Av = CMP[((par * 2 + 0) * 8 + v) * 64 + 32 * cb + r32], Bv = CMP[((par * 2 + 1) * 8 + v) * 64 + 32 * cb + r32];
                    hin = (v == wave) ? h : hin; h = Av * h + Bv; }
                Ht[cb] = h;
                float hc = hin;
#pragma unroll
                for (int q = 0; q < 4; ++q) {
                    const float c0 = hc; hc = A0[cb][q] * hc + B0[cb][q]; const float c1 = hc; hc = A1[cb][q] * hc + B1[cb][q];
                    float hv = hh ? c1 : c0;
#pragma unroll
                    for (int i = 0; i < 4; ++i) { const int e = 4 * q + i; hv = acc[0][cb][e] * hv + acc[1][cb][e];
                        const int tl = (e & 3) + 8 * (e >> 2) + 4 * hh;
                        LAS bf16* gp = (LAS bf16*)(wt + tl * 128 + (32 * cb + r32) * 2);
                        *gp = (bf16)f2bf(hv * bf2f(*gp)); }
                }
            }
#pragma unroll
            for (int i = 0; i < 4; ++i) { const v4u w = *(const LAS v4u*)(wt + (8 * i + grow) * 128 + gch * 16);
                *(v4u*)(Y + (unsigned)(((int)tok0 + 8 * i + grow) * DRNN + n * 128 + 64 * half + gch * 8)) = w; }
        }
#undef RM_LOADU
#undef RM_LOADG
    }
    const int nitems = BATCH * NBLK * 2;
    if (C.G > nitems) { if ((int)blockIdx.x >= nitems) convert_mats(C, a, 3, 10, ((int)blockIdx.x - nitems) * NWAVES + wave, (C.G - nitems) * NWAVES); }
    else { __syncthreads(); convert_mats(C, a, 3, 10, (int)blockIdx.x * NWAVES + wave, C.G * NWAVES); }
}
constexpr int AT_EXT = 0, AT_VT = 48 * 192 * 4;
struct AttnUnit { bf16* qbase; const bf16* kres; const bf16* vres; int l0, kb_lo, eoff, g, bh, llin0; };
__device__ __forceinline__ AttnUnit attn_unit(bf16* QKV, int it, int wave) {
    AttnUnit u; const size_t SLAB = (size_t)M * 1024;
    const int g = it >> 10, rem = it & 1023, bh = rem >> 3, chunk = (rem + (it >> 8)) & 7, l2d = 2 * g, L = SEQ >> l2d;
    u.g = g; u.bh = bh; u.llin0 = chunk * 256 + wave * 32; u.l0 = u.llin0 & (L - 1); u.kb_lo = (u.l0 - 128) > 0 ? (u.l0 - 128) : 0; u.eoff = (g * 16 + (bh & 15)) * 192;
    u.qbase = QKV + (size_t)g * SLAB + ((size_t)bh * SEQ + u.llin0) * HD;
    u.kres = u.qbase + 3 * SLAB - (size_t)u.l0 * HD; u.vres = u.qbase + 6 * SLAB - (size_t)u.l0 * HD;
    return u;
}
__device__ __forceinline__ void p_attn(const Ctx& C, const bool dry) {
    bf16* QKV = (bf16*)(C.ws + WS_QKV); float* LSE = (float*)(C.ws + WS_LSE); const float* bt = (const float*)(C.ws + WS_BIAS);
    LAS float* ext = (LAS float*)(C.lds + AT_EXT);
    LAS unsigned char* vt = C.lds + AT_VT + C.wave * 8192; LAS unsigned char* kt = vt + 4096;
    const int lane = C.lane, r32 = lane & 31, hh = lane >> 5, wave = C.wave, tid = C.tid;
    const int crow8 = lane >> 3, cch = lane & 7;
    const int vtr_off = (4 * hh + ((lane & 15) >> 2)) * 64 + ((lane >> 4) & 1) * 32 + (lane & 3) * 8;
    for (int i = tid; i < 48 * 192; i += 512) { const int gh = i / 192, dist = i - gh * 192 - 32; ext[i] = (dist >= 0 && dist <= 128) ? bt[gh * 132 + dist] : -1e30f; }
    __syncthreads();
    const int total = NGRP * BATCH * NHEAD * 8;
    int it = blockIdx.x;
    if (it >= total) return;
    AttnUnit cu = attn_unit(QKV, it, wave), nu = cu;
    v4u qfn[4], kfn[4], vvn[4];
#define AT_LOADKV(U, KB) do { const bf16* kblk_ = (U).kres + (size_t)(KB) * HD; const bf16* vblk_ = (U).vres + (size_t)(KB) * HD; \
        _Pragma("unroll") for (int i_ = 0; i_ < 4; ++i_) { vvn[i_] = *(const v4u*)(vblk_ + (8 * i_ + crow8) * HD + cch * 8); kfn[i_] = *(const v4u*)(kblk_ + (8 * i_ + crow8) * HD + cch * 8); } } while (0)
#define AT_LOADQ(U) do { _Pragma("unroll") for (int i_ = 0; i_ < 4; ++i_) qfn[i_] = *(const v4u*)((U).qbase + (8 * i_ + crow8) * HD + cch * 8); } while (0)
#define AT_TILE2FRAG(RAW, FR) do { _Pragma("unroll") for (int i_ = 0; i_ < 4; ++i_) *(LAS v4u*)(kt + (8 * i_ + crow8) * 128 + ((cch ^ crow8) << 4)) = RAW[i_]; \
        _Pragma("unroll") for (int s_ = 0; s_ < 4; ++s_) FR[s_] = *(const LAS bf16x8v*)(kt + r32 * 128 + (((2 * s_ + hh) ^ (r32 & 7)) << 4)); } while (0)
    AT_LOADQ(cu); AT_LOADKV(cu, cu.l0);
    for (;;) {
        bf16x8v qf[4];
        AT_TILE2FRAG(qfn, qf);
        f32x16 o0, o1;
#pragma unroll
        for (int e = 0; e < 16; ++e) { o0[e] = 0.f; o1[e] = 0.f; }
        float mrow = -1e30f, lsum = 0.f;
        const bool has_next = (it + C.G) < total;
        for (int kb = cu.l0; kb >= cu.kb_lo; kb -= 32) {
            v4u vv[4], kraw[4]; bf16x8v kf[4];
#pragma unroll
            for (int i = 0; i < 4; ++i) { vv[i] = vvn[i]; kraw[i] = kfn[i]; }
            if (kb - 32 >= cu.kb_lo) { AT_LOADKV(cu, kb - 32); }
            else if (has_next) { nu = attn_unit(QKV, it + C.G, wave); AT_LOADQ(nu); AT_LOADKV(nu, nu.l0); }
#pragma unroll
            for (int i = 0; i < 4; ++i) *(LAS v4u*)(vt + (cch >> 2) * 2048 + (8 * i + crow8) * 64 + (cch & 3) * 16) = vv[i];
            AT_TILE2FRAG(kraw, kf);
            f32x16 p;
#pragma unroll
            for (int e = 0; e < 16; ++e) p[e] = 0.f;
#pragma unroll
            for (int s = 0; s < 4; ++s) p = __builtin_amdgcn_mfma_f32_32x32x16_bf16(kf[s], qf[s], p, 0, 0, 0);
            const int eb = cu.eoff + cu.l0 + r32 - kb - 4 * hh + 32;
            float bm = -1e30f;
#pragma unroll
            for (int e = 0; e < 16; ++e) { p[e] += ext[eb - ((e & 3) + 8 * (e >> 2))]; bm = fmaxf(bm, p[e]); }
            bm = fmaxf(bm, __shfl_xor(bm, 32));
            const float mn = fmaxf(mrow, bm), alpha = __builtin_amdgcn_exp2f(mrow - mn); mrow = mn;
            float ps = 0.f;
#pragma unroll
            for (int e = 0; e < 16; ++e) { p[e] = __builtin_amdgcn_exp2f(p[e] - mn); ps += p[e]; }
            lsum = lsum * alpha + ps;
#pragma unroll
            for (int e = 0; e < 16; ++e) { o0[e] *= alpha; o1[e] *= alpha; }
            bf16x8v pf[2];
#pragma unroll
            for (int s = 0; s < 2; ++s) { const float t8[8] = {p[8 * s], p[8 * s + 1], p[8 * s + 2], p[8 * s + 3], p[8 * s + 4], p[8 * s + 5], p[8 * s + 6], p[8 * s + 7]}; pf[s] = pack8(t8); }
#pragma unroll
            for (int s = 0; s < 2; ++s) {
                const v4i16_t a00 = vtr16(vt + 0 * 2048 + (16 * s) * 64 + vtr_off), a01 = vtr16(vt + 0 * 2048 + (16 * s + 8) * 64 + vtr_off);
                const v4i16_t a10 = vtr16(vt + 1 * 2048 + (16 * s) * 64 + vtr_off), a11 = vtr16(vt + 1 * 2048 + (16 * s + 8) * 64 + vtr_off);
                const bf16x8v va0 = (bf16x8v){a00[0], a00[1], a00[2], a00[3], a01[0], a01[1], a01[2], a01[3]};
                const bf16x8v va1 = (bf16x8v){a10[0], a10[1], a10[2], a10[3], a11[0], a11[1], a11[2], a11[3]};
                o0 = __builtin_amdgcn_mfma_f32_32x32x16_bf16(va0, pf[s], o0, 0, 0, 0);
                o1 = __builtin_amdgcn_mfma_f32_32x32x16_bf16(va1, pf[s], o1, 0, 0, 0);
            }
        }
        const float ltot = lsum + __shfl_xor(lsum, 32), inv = 1.f / ltot;
#pragma unroll
        for (int q = 0; q < 4; ++q) {
            v2u w0, w1;
            w0.x = pg8::cvt_pk_bf16(o0[4 * q] * inv, o0[4 * q + 1] * inv); w0.y = pg8::cvt_pk_bf16(o0[4 * q + 2] * inv, o0[4 * q + 3] * inv);
            w1.x = pg8::cvt_pk_bf16(o1[4 * q] * inv, o1[4 * q + 1] * inv); w1.y = pg8::cvt_pk_bf16(o1[4 * q + 2] * inv, o1[4 * q + 3] * inv);
            *(LAS v2u*)(kt + r32 * 128 + ((q ^ (r32 & 7)) << 4) + 8 * hh) = w0; *(LAS v2u*)(kt + r32 * 128 + (((4 + q) ^ (r32 & 7)) << 4) + 8 * hh) = w1;
        }
        if (!dry)
#pragma unroll
        for (int i = 0; i < 4; ++i) { const v4u w = *(const LAS v4u*)(kt + (8 * i + crow8) * 128 + ((cch ^ crow8) << 4)); *(v4u*)(cu.qbase + (8 * i + crow8) * HD + cch * 8) = w; }
        if (hh == 0) { const int l2d = 2 * cu.g, L = SEQ >> l2d, llin = cu.llin0 + r32, rres = llin >> (11 - l2d), l = llin & (L - 1), t = (l << l2d) + rres, row = (cu.bh >> 4) * SEQ + t;
            LSE[((size_t)cu.g * M + row) * 16 + (cu.bh & 15)] = mrow + log2f(ltot); }
        if (!has_next) break;
        it += C.G; cu = nu;
    }
#undef AT_LOADKV
#undef AT_LOADQ
#undef AT_TILE2FRAG
}
__device__ __forceinline__ void p_merge(const Ctx& C, const Args& a) {
    const bf16* QKV = (const bf16*)(C.ws + WS_QKV); const float* LSE = (const float*)(C.ws + WS_LSE); bf16* ATT = (bf16*)(C.ws + WS_ATT);
    for (int idx = blockIdx.x * 512 + C.tid; idx < M * 16 * 8; idx += C.G * 512) {
        const int ch = idx & 7, h = (idx >> 3) & 15, row = idx >> 7, b = row >> 11, t = row & 2047;
        float ls[3], mxl = -INFINITY;
#pragma unroll
        for (int g = 0; g < 3; ++g) { ls[g] = LSE[((size_t)g * M + row) * 16 + h]; mxl = fmaxf(mxl, ls[g]); }
        float acc[8], wsum = 0.f;
#pragma unroll
        for (int e = 0; e < 8; ++e) acc[e] = 0.f;
#pragma unroll
        for (int g = 0; g < 3; ++g) { const float w = exp2f(ls[g] - mxl); wsum += w; const int l2d = 2 * g, rres = t & ((1 << l2d) - 1), l = t >> l2d, L = SEQ >> l2d;
            const v4u v = *(const v4u*)(QKV + (size_t)g * ((size_t)M * 1024) + ((size_t)(b * 16 + h) * SEQ + rres * L + l) * HD + 8 * ch);
            acc[0] += w * bf_lo(v.x); acc[1] += w * bf_hi(v.x); acc[2] += w * bf_lo(v.y); acc[3] += w * bf_hi(v.y); acc[4] += w * bf_lo(v.z); acc[5] += w * bf_hi(v.z); acc[6] += w * bf_lo(v.w); acc[7] += w * bf_hi(v.w); }
        const float inv = 1.f / wsum; v4u o; o.x = pk2(acc[0] * inv, acc[1] * inv); o.y = pk2(acc[2] * inv, acc[3] * inv); o.z = pk2(acc[4] * inv, acc[5] * inv); o.w = pk2(acc[6] * inv, acc[7] * inv);
        *(v4u*)(ATT + (size_t)row * 1024 + h * 64 + 8 * ch) = o;
    }
    convert_mats(C, a, 10, 12, C.vcu * NWAVES + C.wave, C.G * NWAVES);
}

enum { PH_PROLOGUE = 0, PH_FFN_IN_0, PH_FFN_OUT_0, PH_RNN_IN, PH_RNN_MID, PH_RNN_OUT, PH_FFN_IN_1, PH_FFN_OUT_1,
       PH_FFN_IN_2, PH_FFN_OUT_2, PH_QKV, PH_ATTN, PH_MERGE, PH_WO, PH_FFN_IN_3, PH_FFN_OUT_3, NPHASE };

__global__ void __launch_bounds__(NWAVES * 64, 2) fwd_kernel(Args args) {
    extern __shared__ __attribute__((aligned(16))) unsigned char lds_raw[];
    Ctx C; C.lds = (LAS unsigned char*)lds_raw; C.tid = threadIdx.x; C.lane = C.tid & 63; C.wave = __builtin_amdgcn_readfirstlane(C.tid >> 6);
    C.G = gridDim.x; { const int bx = blockIdx.x; C.vcu = (C.G % 8 == 0) ? (bx % 8) * (C.G / 8) + bx / 8 : bx; }
    C.ws = args.ws;
    volatile LAS unsigned* MISC = (volatile LAS unsigned*)(C.lds + MISC_OFF);
    for (int u = C.tid; u < (LDS_BYTES - LDSCTL_OFF) / 4; u += NWAVES * 64) ((LAS unsigned*)(C.lds + LDSCTL_OFF))[u] = 0u;
    __syncthreads();
    unsigned* ctl = (unsigned*)args.ws;
    XcdBarrier bar; bar.bar = ctl + CW_BAR; bar.x = 0; bar.st = nullptr;
    const bool multi = (args.ph_hi - args.ph_lo) > 1;
    if (multi) bar = xcd_barrier_post(ctl + CW_BAR, MISC + 8);
    for (int ph = args.ph_lo; ph < args.ph_hi; ++ph) {
        for (int rep = ((DUP_MASK >> ph) & 1u) ? DUP_N : 0; rep >= 0; --rep) {
        const bool dry = rep > 0;
        { int t_ = threadIdx.x; asm volatile("" : "+v"(t_)); C.tid = t_; C.lane = t_ & 63; }
        unsigned char* ws = args.ws;
        C.ws = ws; float* ssq = (float*)(ws + WS_SSQ); bf16* xb = (bf16*)(ws + WS_XB);
        switch (ph) {
        case PH_PROLOGUE: p_prologue(C, args); break;
        case PH_FFN_IN_0: case PH_FFN_IN_1: case PH_FFN_IN_2: case PH_FFN_IN_3: {
            const bf16* Bt = (const bf16*)(ws + (ph == PH_FFN_IN_0 ? WS_WIN0 : ph == PH_FFN_IN_1 ? WS_WIN1 : ph == PH_FFN_IN_2 ? WS_WIN2 : WS_WIN3));
            bf16* act = (bf16*)(ws + (ph == PH_FFN_IN_3 ? WS_ACT3 : WS_ACT));
            pg8::Gemm g{xb, Bt, M, 2 * FF, D}; pg8::StaticOrder S; S.init(M, 2 * FF, C.G, (int)blockIdx.x);
            fill_rstd(C.lds, S, ssq, C.tid);
            EpiSwiGLU E{(const LAS float*)(C.lds + RSTD_OFF), act, dry ? DUP_SKIP_EPI : 0};
            pg8::gemm_phase<EpiSwiGLU, pg8::StaticOrder, true, true>(C.lds, g, S, E);
        } break;
        case PH_FFN_OUT_0: case PH_FFN_OUT_1: case PH_FFN_OUT_2: case PH_FFN_OUT_3: case PH_RNN_OUT: case PH_WO: {
            const bf16* A; const bf16* Bt; int K; float scale = 0.5f; const float* xin = args.out;
            if (ph == PH_FFN_OUT_0) { A = (const bf16*)(ws + WS_ACT); Bt = (const bf16*)(ws + WS_WOUT0); K = FF; xin = args.in[I_X]; }
            else if (ph == PH_FFN_OUT_1) { A = (const bf16*)(ws + WS_ACT); Bt = (const bf16*)(ws + WS_WOUT1); K = FF; }
            else if (ph == PH_FFN_OUT_2) { A = (const bf16*)(ws + WS_ACT); Bt = (const bf16*)(ws + WS_WOUT2); K = FF; }
            else if (ph == PH_FFN_OUT_3) { A = (const bf16*)(ws + WS_ACT3); Bt = (const bf16*)(ws + WS_WOUT3); K = FF; }
            else if (ph == PH_RNN_OUT) { A = (const bf16*)(ws + WS_Y); Bt = (const bf16*)(ws + WS_WROUT); K = DRNN; scale = 1.f; }
            else { A = (const bf16*)(ws + WS_ATT); Bt = (const bf16*)(ws + WS_WO); K = D; scale = 1.f; }
            if (dry && ph != PH_FFN_OUT_0) scale = 0.f;
            float* xo = args.out;
#if RESID_BF16
            if (ph != PH_FFN_OUT_0) xin = nullptr;
            if (ph != PH_FFN_OUT_3 || dry) xo = nullptr;
#endif
            pg8::Gemm g{A, Bt, M, D, K}; pg8::StaticOrder S; S.init(M, D, C.G, (int)blockIdx.x);
            EpiRes E{xin, xo, xb, ssq, scale, dry && DUP_SKIP_EPI};
            pg8::gemm_phase<EpiRes, pg8::StaticOrder, false, true>(C.lds, g, S, E);
        } break;
        case PH_RNN_IN: {
            pg8::Gemm g{xb, (const bf16*)(ws + WS_WRIN), M, 2 * DRNN, D}; pg8::StaticOrder S; S.init(M, 2 * DRNN, C.G, (int)blockIdx.x);
            fill_rstd(C.lds, S, ssq, C.tid);
            EpiRnnIn E{(const LAS float*)(C.lds + RSTD_OFF), (bf16*)(ws + WS_G), (bf16*)(ws + WS_U)};
            pg8::gemm_phase<EpiRnnIn, pg8::StaticOrder, true, true>(C.lds, g, S, E);
        } break;
        case PH_RNN_MID: p_rnn_mid(C, args); break;
        case PH_QKV: {
            pg8::Gemm g{xb, (const bf16*)(ws + WS_WQKV), M, NQKV, D}; pg8::StaticOrder S; S.init(M, NQKV, C.G, (int)blockIdx.x);
            if (C.tid < 128) ((LAS float*)(C.lds + GAIN_OFF))[C.tid] = (C.tid < 64) ? args.in[I_QGAIN][C.tid] * (0.125f * LOG2E) : args.in[I_KGAIN][C.tid - 64];
            fill_rstd(C.lds, S, ssq, C.tid);
            EpiQKV E{(const LAS float*)(C.lds + RSTD_OFF), (const LAS float*)(C.lds + GAIN_OFF), (bf16*)(ws + WS_QKV), dry && DUP_SKIP_EPI};
            pg8::gemm_phase<EpiQKV, pg8::StaticOrder, true, true>(C.lds, g, S, E);
        } break;
        case PH_ATTN: p_attn(C, dry); break;
        case PH_MERGE: p_merge(C, args); break;
        default: break;
        }
        if (dry || ph + 1 < args.ph_hi) xcd_barrier(bar);
        if (ph == 0 && !dry) for (int eb = 0; eb < DUP_EXTRA_BARRIERS; ++eb) xcd_barrier(bar);
        }
    }
}

extern "C" void kernel_launch(void* const* d_in, const int* in_sizes, int n_in, void* d_out, int out_size, void* d_ws, size_t ws_size, hipStream_t stream) {
    static int grid = 0;
    if (grid == 0) {
        if (n_in != 18 || in_sizes[0] != M * D || out_size != M * D || ws_size < WS_END) { fprintf(stderr, "kernel_launch: unexpected shapes (n_in %d, in0 %d, out %d, ws %zu)\n", n_in, n_in > 0 ? in_sizes[0] : -1, out_size, ws_size); grid = -1; return; }
        int dev = 0, cus = 0, per_cu = 0;
        if (hipGetDevice(&dev) != hipSuccess || hipDeviceGetAttribute(&cus, hipDeviceAttributeMultiprocessorCount, dev) != hipSuccess) { fprintf(stderr, "kernel_launch: device query failed\n"); grid = -1; return; }
        if (hipFuncSetAttribute((const void*)fwd_kernel, hipFuncAttributeMaxDynamicSharedMemorySize, LDS_BYTES) != hipSuccess) { fprintf(stderr, "kernel_launch: hipFuncSetAttribute failed\n"); grid = -1; return; }
        if (hipOccupancyMaxActiveBlocksPerMultiprocessor(&per_cu, (const void*)fwd_kernel, NWAVES * 64, LDS_BYTES) != hipSuccess || per_cu < 1) { fprintf(stderr, "kernel_launch: occupancy query says %d blocks per CU\n", per_cu); (void)hipGetLastError(); grid = -1; return; }
        grid = cus;
    }
    if (grid < 0) return;
    if (hipMemsetAsync(d_ws, 0, CTL_ZERO_BYTES, stream) != hipSuccess) { fprintf(stderr, "kernel_launch: memset failed\n"); return; }
    Args a{};
    for (int i = 0; i < 18; ++i) a.in[i] = (const float*)d_in[i];
    a.out = (float*)d_out; a.ws = (unsigned char*)d_ws;
#if SINGLE_LAUNCH
    a.ph_lo = 0; a.ph_hi = NPHASE;
    hipLaunchKernelGGL(fwd_kernel, dim3(grid), dim3(NWAVES * 64), LDS_BYTES, stream, a);
#else
    for (int ph = 0; ph < NPHASE; ++ph) { a.ph_lo = ph; a.ph_hi = ph + 1; hipLaunchKernelGGL(fwd_kernel, dim3(grid), dim3(NWAVES * 64), LDS_BYTES, stream, a); }
#endif
}
```

```cpp
#include <hip/hip_runtime.h>
#include <cstdio>
#include <cstdint>

#ifndef SINGLE_LAUNCH
#define SINGLE_LAUNCH 1
#define DUP_MASK 0u
#define DUP_N 1
#define DUP_EXTRA_BARRIERS 0
#define DUP_SKIP_EPI 0
#endif

namespace pg8 {
#define PG8_LAS __attribute__((address_space(3)))
typedef unsigned short bf16_t;
typedef short bf16x8 __attribute__((ext_vector_type(8)));
typedef float f32x4 __attribute__((ext_vector_type(4)));
typedef unsigned u32x4 __attribute__((ext_vector_type(4)));
constexpr int BM = 256, BK = 64, HALF = 128, HTB = HALF * BK * 2, STAGE_BYTES = 8 * HTB, NXCD = 8, WGM = 8;

__host__ __device__ __forceinline__ int lds_byte(int r, int c) { return (r >> 3) * 1024 + (r & 7) * 128 + ((((c >> 3) ^ (r & 7)) & 7) << 4) + (c & 7) * 2; }
__host__ __device__ __forceinline__ void stage_rc(int b, int& R, int& C) { const int sidx = b / 1024, w = b % 1024, rowin = w / 128, pch = (w % 128) / 16; R = sidx * 8 + rowin; C = ((pch ^ rowin) & 7) * 8; }
__host__ __device__ __forceinline__ int perm32(int rho) { const int n = rho >> 4, i = rho & 15; return 8 * (i >> 2) + 4 * n + (i & 3); }

struct Unit { int pm, pn; };
struct Gemm { const bf16_t* A; const bf16_t* Bt; int M, N, K; };

struct StaticOrder {
    int nM, nN, nwg, G, c;
    __host__ __device__ void init(int M, int N, int G_, int c_) { nM = M / BM; nN = N / BM; nwg = nM * nN; G = G_; c = c_; }
    __host__ __device__ bool next(int i, Unit& u) const {
        const long L = (long)i * G + c; if (L >= nwg) return false;
        int wgid = (int)L; { const int q = nwg / NXCD, r = nwg % NXCD, xcd = wgid % NXCD, off = wgid / NXCD; wgid = (xcd < r ? xcd * (q + 1) : r * (q + 1) + (xcd - r) * q) + off; }
        const int nig = WGM * nN, gid = wgid / nig, fm = gid * WGM, gsz = (nM - fm) < WGM ? (nM - fm) : WGM;
        u.pm = fm + ((wgid % nig) % gsz); u.pn = (wgid % nig) / gsz; return true;
    }
    __device__ __forceinline__ void a_ready(const Unit&) const {}
    __device__ __forceinline__ void done(const Unit&) const {}
};

__device__ __forceinline__ unsigned cvt_pk_bf16(float lo, float hi) { unsigned r; asm volatile("v_cvt_pk_bf16_f32 %0, %1, %2" : "=v"(r) : "v"(lo), "v"(hi)); return r; }

template <class Epi, class Sched, bool ALIGN_EPI = false, bool SP2 = false>
__device__ __forceinline__ void gemm_phase(PG8_LAS unsigned char* lds, const Gemm g, const Sched& S, const Epi& E) {
    int tid_ = threadIdx.x; asm volatile("" : "+v"(tid_));
    const int tid = tid_, wid = __builtin_amdgcn_readfirstlane(tid >> 6), lane = tid & 63, wr = wid >> 2, wc = wid & 3, fr = lane & 15, fq = lane >> 4;
    const int K = g.K, nt = K / BK;
    unsigned voffA[2], voffB[2];
#pragma unroll
    for (int i = 0; i < 2; ++i) { int R, C; stage_rc(tid * 16 + i * 8192, R, C); const int Rb = Epi::PERM ? ((R & ~31) + perm32(R & 31)) : R;
        voffA[i] = (unsigned)(R * K + C) * 2u; voffB[i] = (unsigned)(Rb * K + C) * 2u; }
    const size_t kstep = (size_t)(BK * 2);
    const size_t hstep = (size_t)HALF * K * 2;
    const size_t tstep = 2 * hstep;
    const unsigned ldsw = (unsigned)wid * 1024u;
    const int aoff = lds_byte(wr * 64 + fr, fq * 8), boff = lds_byte(wc * 32 + fr, fq * 8);
#define PG8_SA(b, h) (((b) * 2 + (h)) * HTB)
#define PG8_SB(b, h) ((4 + (b) * 2 + (h)) * HTB)
#define PG8_STAGE(bufoff, gbase, voff) do { _Pragma("unroll") for (int _i = 0; _i < 2; ++_i) \
        __builtin_amdgcn_global_load_lds((const unsigned*)((const char*)(gbase) + (voff)[_i]), (PG8_LAS unsigned*)(lds + (bufoff) + ldsw + _i * 8192), 16, 0, 0); } while (0)
#define PG8_LDA(dst, b, h) do { _Pragma("unroll") for (int m = 0; m < 4; ++m) _Pragma("unroll") for (int k = 0; k < 2; ++k) dst[m][k] = *(const PG8_LAS bf16x8*)(lds + PG8_SA(b, h) + (aoff ^ (k * 64)) + m * 2048); } while (0)
#define PG8_LDB(dst, b, h) do { _Pragma("unroll") for (int n = 0; n < 2; ++n) _Pragma("unroll") for (int k = 0; k < 2; ++k) dst[n][k] = *(const PG8_LAS bf16x8*)(lds + PG8_SB(b, h) + (boff ^ (k * 64)) + n * 2048); } while (0)
#define PG8_MMA(ai, bj, At, Bt) do { __builtin_amdgcn_s_setprio(1); _Pragma("unroll") for (int m = 0; m < 4; ++m) _Pragma("unroll") for (int n = 0; n < 2; ++n) _Pragma("unroll") for (int k = 0; k < 2; ++k) \
        acc[ai][bj][m][n] = __builtin_amdgcn_mfma_f32_16x16x32_bf16(Bt[n][k], At[m][k], acc[ai][bj][m][n], 0, 0, 0); __builtin_amdgcn_s_setprio(0); } while (0)
#define PG8_WAIT_V(n) asm volatile("s_waitcnt vmcnt(" #n ")" ::: "memory")
#define PG8_WAIT_L(n) asm volatile("s_waitcnt lgkmcnt(" #n ")" ::: "memory")
#define PG8_BAR __builtin_amdgcn_s_barrier()
#define PG8_SCHED __builtin_amdgcn_sched_barrier(0)
    Unit cur, nxt; int ui = 0;
    if (!S.next(0, cur)) return;
    f32x4 acc[2][2][4][2];
#pragma unroll
    for (int a = 0; a < 2; ++a)
#pragma unroll
        for (int b = 0; b < 2; ++b)
#pragma unroll
            for (int m = 0; m < 4; ++m)
#pragma unroll
                for (int n = 0; n < 2; ++n) acc[a][b][m][n] = (f32x4){0.f, 0.f, 0.f, 0.f};
    bf16x8 At[4][2], B0[2][2], B1[2][2];
    const char* cA = (const char*)g.A + (size_t)cur.pm * tstep; const char* cB = (const char*)g.Bt + (size_t)cur.pn * tstep;
    S.a_ready(cur);
    if constexpr (SP2) {
        PG8_STAGE(PG8_SB(0, 0), cB, voffB); PG8_STAGE(PG8_SB(0, 1), cB + hstep, voffB); PG8_STAGE(PG8_SA(0, 0), cA, voffA); PG8_STAGE(PG8_SA(0, 1), cA + hstep, voffA);
        if (wr == 1) PG8_BAR;
        PG8_WAIT_V(2); PG8_BAR;
        PG8_STAGE(PG8_SB(1, 0), cB + kstep, voffB); PG8_STAGE(PG8_SA(1, 0), cA + kstep, voffA); PG8_STAGE(PG8_SB(1, 1), cB + hstep + kstep, voffB);
        PG8_WAIT_V(6); PG8_BAR;
    } else {
        PG8_STAGE(PG8_SB(0, 0), cB, voffB); PG8_STAGE(PG8_SA(0, 0), cA, voffA); PG8_STAGE(PG8_SB(0, 1), cB + hstep, voffB); PG8_STAGE(PG8_SA(0, 1), cA + hstep, voffA);
        if (wr == 1) PG8_BAR;
        PG8_WAIT_V(4); PG8_BAR;
        PG8_STAGE(PG8_SB(1, 0), cB + kstep, voffB); PG8_STAGE(PG8_SA(1, 0), cA + kstep, voffA); PG8_STAGE(PG8_SB(1, 1), cB + hstep + kstep, voffB);
        PG8_WAIT_V(6); PG8_BAR;
    }
    for (;;) {
        const bool has_next = S.next(ui + 1, nxt);
        const char* nA = has_next ? (const char*)g.A + (size_t)nxt.pm * tstep : cA; const char* nB = has_next ? (const char*)g.Bt + (size_t)nxt.pn * tstep : cB;
        for (int t = 0; t < nt; t += 2) {
            const bool last = (t == nt - 2);
            const char* a1 = cA + (size_t)(t + 1) * kstep;
            const char* a2 = last ? nA : cA + (size_t)(t + 2) * kstep; const char* b2 = last ? nB : cB + (size_t)(t + 2) * kstep;
            const char* a3 = a2 + kstep; const char* b3 = b2 + kstep;
            if (last && has_next) S.a_ready(nxt);
            if constexpr (SP2) {
            PG8_LDB(B0, 0, 0); PG8_LDB(B1, 0, 1); PG8_SCHED; PG8_LDA(At, 0, 0); PG8_STAGE(PG8_SA(1, 1), a1 + hstep, voffA);
            PG8_WAIT_V(8); PG8_WAIT_L(0); PG8_BAR; PG8_MMA(0, 0, At, B0); PG8_MMA(0, 1, At, B1); PG8_BAR; PG8_SCHED;
            PG8_LDA(At, 0, 1); PG8_STAGE(PG8_SB(0, 0), b2, voffB); PG8_STAGE(PG8_SB(0, 1), b2 + hstep, voffB); PG8_STAGE(PG8_SA(0, 0), a2, voffA);
            PG8_WAIT_V(8); PG8_WAIT_L(0); PG8_BAR; PG8_MMA(1, 0, At, B0); PG8_MMA(1, 1, At, B1); PG8_BAR; PG8_SCHED;
            PG8_LDB(B0, 1, 0); PG8_LDB(B1, 1, 1); PG8_SCHED; PG8_LDA(At, 1, 0); PG8_STAGE(PG8_SA(0, 1), a2 + hstep, voffA);
            PG8_WAIT_V(8); PG8_WAIT_L(0); PG8_BAR; PG8_MMA(0, 0, At, B0); PG8_MMA(0, 1, At, B1); PG8_BAR; PG8_SCHED;
            PG8_LDA(At, 1, 1); PG8_STAGE(PG8_SB(1, 0), b3, voffB); PG8_STAGE(PG8_SB(1, 1), b3 + hstep, voffB); PG8_STAGE(PG8_SA(1, 0), a3, voffA);
            PG8_WAIT_V(8); PG8_WAIT_L(0); PG8_BAR; PG8_MMA(1, 0, At, B0); PG8_MMA(1, 1, At, B1); PG8_BAR; PG8_SCHED;
            } else {
            PG8_LDB(B0, 0, 0); PG8_SCHED; PG8_LDA(At, 0, 0); PG8_STAGE(PG8_SA(1, 1), a1 + hstep, voffA);
            PG8_WAIT_L(8); PG8_BAR; PG8_WAIT_L(0); PG8_MMA(0, 0, At, B0); PG8_BAR; PG8_SCHED;
            PG8_LDB(B1, 0, 1); PG8_STAGE(PG8_SB(0, 0), b2, voffB);
            PG8_BAR; PG8_WAIT_L(0); PG8_MMA(0, 1, At, B1); PG8_BAR;
            PG8_LDA(At, 0, 1); PG8_STAGE(PG8_SA(0, 0), a2, voffA);
            PG8_BAR; PG8_WAIT_L(0); PG8_MMA(1, 0, At, B0); PG8_BAR; PG8_SCHED;
            PG8_STAGE(PG8_SB(0, 1), b2 + hstep, voffB);
            PG8_WAIT_V(6); PG8_BAR; PG8_MMA(1, 1, At, B1); PG8_BAR;
            PG8_LDB(B0, 1, 0); PG8_SCHED; PG8_LDA(At, 1, 0); PG8_STAGE(PG8_SA(0, 1), a2 + hstep, voffA);
            PG8_WAIT_L(8); PG8_BAR; PG8_WAIT_L(0); PG8_MMA(0, 0, At, B0); PG8_BAR; PG8_SCHED;
            PG8_LDB(B1, 1, 1); PG8_STAGE(PG8_SB(1, 0), b3, voffB);
            PG8_BAR; PG8_WAIT_L(0); PG8_MMA(0, 1, At, B1); PG8_BAR;
            PG8_LDA(At, 1, 1); PG8_STAGE(PG8_SA(1, 0), a3, voffA);
            PG8_BAR; PG8_WAIT_L(0); PG8_MMA(1, 0, At, B0); PG8_BAR; PG8_SCHED;
            PG8_STAGE(PG8_SB(1, 1), b3 + hstep, voffB);
            PG8_WAIT_V(6); PG8_BAR; PG8_MMA(1, 1, At, B1); PG8_BAR;
            }
        }
        if constexpr (ALIGN_EPI) { if (wr == 0) PG8_BAR; }
        E(acc, cur, ui, wr, wc, fr, fq); S.done(cur);
        if (!has_next) break;
#pragma unroll
        for (int a = 0; a < 2; ++a)
#pragma unroll
            for (int b = 0; b < 2; ++b)
#pragma unroll
                for (int m = 0; m < 4; ++m)
#pragma unroll
                    for (int n = 0; n < 2; ++n) acc[a][b][m][n] = (f32x4){0.f, 0.f, 0.f, 0.f};
        cur = nxt; cA = nA; cB = nB; ++ui;
        if constexpr (ALIGN_EPI) { if (wr == 1) PG8_BAR; }
    }
    PG8_WAIT_V(0);
    if constexpr (!ALIGN_EPI) { if (wr == 0) PG8_BAR; }
    PG8_BAR;
#undef PG8_SA
#undef PG8_SB
#undef PG8_STAGE
#undef PG8_LDA
#undef PG8_LDB
#undef PG8_MMA
#undef PG8_WAIT_V
#undef PG8_WAIT_L
#undef PG8_BAR
#undef PG8_SCHED
}
}

constexpr int BATCH = 8, SEQ = 2048, D = 1024, M = BATCH * SEQ;
constexpr int FF = 2816, DRNN = 1280, NBLK = 10, RBLK = 128, CONVW = 4;
constexpr int NHEAD = 16, HD = 64, NGRP = 3, NQKV = 9216;
constexpr float RMS_EPS = 1e-6f;
constexpr float LOG2E = 1.4426950408889634f;
constexpr int NWAVES = 8;

typedef unsigned short bf16;
typedef unsigned v4u __attribute__((ext_vector_type(4)));
typedef unsigned v2u __attribute__((ext_vector_type(2)));
typedef float f32x4 __attribute__((ext_vector_type(4)));
#define GAS __attribute__((address_space(1)))
#define LAS __attribute__((address_space(3)))
typedef GAS unsigned gu32;
#define RLX_AGENT __ATOMIC_RELAXED, __HIP_MEMORY_SCOPE_AGENT
#define LDS_WAIT() asm volatile("s_waitcnt lgkmcnt(0)" ::: "memory")

constexpr size_t MiB = 1u << 20;
constexpr size_t WS_CTL = 0, CTL_ZERO_BYTES = 1 * MiB;
constexpr size_t WS_SSQ = 1 * MiB;
constexpr size_t WS_BIAS = 2 * MiB;
constexpr size_t WS_XB = 3 * MiB;
constexpr size_t WS_WO = 35 * MiB;
constexpr size_t WS_WQKV = 37 * MiB;
constexpr size_t WS_QKV = 55 * MiB;
constexpr size_t QKV_SLAB = (size_t)M * 1024 * 2;
constexpr size_t WS_LSE = 343 * MiB;
constexpr size_t WS_END = 346 * MiB;
constexpr size_t WS_WIN0 = 55 * MiB, WS_WOUT0 = 66 * MiB, WS_WIN1 = 72 * MiB, WS_WOUT1 = 83 * MiB, WS_WIN2 = 89 * MiB, WS_WOUT2 = 100 * MiB;
constexpr size_t WS_WRIN = 106 * MiB, WS_WROUT = 111 * MiB, WS_WA = 114 * MiB, WS_WX = 114 * MiB + 512 * 1024;
constexpr size_t WS_ACT = 115 * MiB;
constexpr size_t WS_G = 203 * MiB, WS_U = 243 * MiB, WS_Y = 283 * MiB;
constexpr size_t WS_ATT = WS_QKV + 3 * QKV_SLAB;
constexpr size_t WS_WIN3 = WS_QKV + 6 * QKV_SLAB, WS_WOUT3 = WS_WIN3 + 11 * MiB;
constexpr size_t WS_ACT3 = WS_QKV;
static_assert(WS_Y + (size_t)M * DRNN * 2 <= WS_LSE && WS_ACT + (size_t)M * FF * 2 <= WS_G && WS_WX + 327680 <= WS_ACT, "ws map");
static_assert(WS_QKV + 9 * QKV_SLAB == WS_LSE && WS_LSE + (size_t)3 * M * 16 * 4 <= WS_END, "ws map");
constexpr int CW_BAR = 4096;

constexpr int RING_BYTES = 131072, LDSCTL_OFF = RING_BYTES, MISC_OFF = LDSCTL_OFF + 320;
constexpr int RSTD_OFF = RING_BYTES + 1024, RSTD_MAX_UNITS = 9, GAIN_OFF = RSTD_OFF + RSTD_MAX_UNITS * 256 * 4;
constexpr int LDS_BYTES = 147456;
static_assert(GAIN_OFF + 512 <= LDS_BYTES, "LDS map");

#define XB_TMO      128
#define XB_XCNT(j)  (256  + 64 * (j))
#define XB_XSUB(j)  (1280 + 64 * (j))
#define XB_XGEN(j)  (2304 + 64 * (j))
#define XB_TOP      3328
#define XB_TOPGEN   3392
#define XCD_BAR_WORDS 3456
#define XB_SPIN_CAP (1u << 18)
__device__ __forceinline__ unsigned xb_ld(unsigned* p)              { return __hip_atomic_load(p, __ATOMIC_RELAXED, __HIP_MEMORY_SCOPE_AGENT); }
__device__ __forceinline__ unsigned xb_add(unsigned* p, unsigned v) { return __hip_atomic_fetch_add(p, v, __ATOMIC_RELAXED, __HIP_MEMORY_SCOPE_AGENT); }
__device__ __forceinline__ unsigned xb_xcc_id() { return (unsigned)__builtin_amdgcn_s_getreg((3 << 11) | 20) & 0xFu; }
#define XB_SPIN(cond, bar) do { unsigned _sp = 0; while (cond) { __builtin_amdgcn_s_sleep(1); \
    if ((++_sp & 255u) == 0u) { if (xb_ld(&(bar)[XB_TMO])) break; if (_sp > XB_SPIN_CAP) { atomicAdd(&(bar)[XB_TMO], 1u); break; } } } } while (0)
struct XcdBarrier { unsigned* bar; unsigned x; volatile LAS unsigned* st; };
__device__ __forceinline__ XcdBarrier xcd_barrier_post(unsigned* bar, volatile LAS unsigned* st) {
    XcdBarrier b; b.bar = bar; b.x = xb_xcc_id(); b.st = st;
    if (threadIdx.x == 0) (void)xb_add(&bar[XB_XCNT(b.x)], 1u);
    return b;
}
__device__ __forceinline__ void xcd_barrier_complete(unsigned* bar, unsigned x, unsigned& nloc, unsigned& nx) {
    const unsigned G = gridDim.x * gridDim.y * gridDim.z;
    unsigned sum, cnt, mine, sp = 0u;
    for (;;) {
        sum = 0u; cnt = 0u; mine = 0u;
#pragma unroll
        for (unsigned j = 0; j < 16; ++j) { const unsigned c = xb_ld(&bar[XB_XCNT(j)]); sum += c; cnt += (c > 0u) ? 1u : 0u; mine = (j == x) ? c : mine; }
        if (sum == G) break;
        __builtin_amdgcn_s_sleep(1);
        if ((++sp & 255u) == 0u) { if (xb_ld(&bar[XB_TMO])) break; if (sp > XB_SPIN_CAP) { atomicAdd(&bar[XB_TMO], 1u); break; } }
    }
    nloc = mine > 0u ? mine : 1u; nx = cnt > 0u ? cnt : 1u;
}
__device__ __forceinline__ void xcd_barrier(const XcdBarrier& b) {
    asm volatile("s_waitcnt vmcnt(0)" ::: "memory");
    __syncthreads();
    if (threadIdx.x == 0) {
        unsigned* bar = b.bar;
        __builtin_amdgcn_s_waitcnt(0);
        unsigned nloc = b.st[0], nx = b.st[1];
        if (nloc == 0u) { xcd_barrier_complete(bar, b.x, nloc, nx); b.st[0] = nloc; b.st[1] = nx; }
        const unsigned old = xb_add(&bar[XB_XSUB(b.x)], 1u);
        const unsigned gen = old / nloc;
        if (old + 1u == (gen + 1u) * nloc) {
            __builtin_amdgcn_fence(__ATOMIC_RELEASE, "agent");
            asm volatile("s_waitcnt vmcnt(0)" ::: "memory");
            const unsigned og = xb_add(&bar[XB_TOP], 1u);
            const unsigned tg = og / nx;
            if (og + 1u == (tg + 1u) * nx) xb_add(&bar[XB_TOPGEN], 1u);
            else XB_SPIN(xb_ld(&bar[XB_TOPGEN]) == tg, bar);
            __builtin_amdgcn_fence(__ATOMIC_ACQUIRE, "agent");
            xb_add(&bar[XB_XGEN(b.x)], 1u);
            asm volatile("s_waitcnt vmcnt(0)" ::: "memory");
        } else {
            XB_SPIN(xb_ld(&bar[XB_XGEN(b.x)]) == gen, bar);
            __builtin_amdgcn_fence(__ATOMIC_ACQUIRE, "agent");
            asm volatile("s_waitcnt vmcnt(0)" ::: "memory");
        }
    }
    __syncthreads();
}

__device__ __forceinline__ unsigned f2bf(float f) { unsigned u = __builtin_bit_cast(unsigned, f); return (u + 0x7fffu + ((u >> 16) & 1u)) >> 16; }
__device__ __forceinline__ unsigned pk2(float lo, float hi) { return f2bf(lo) | (f2bf(hi) << 16); }
__device__ __forceinline__ float bf_lo(unsigned w) { return __builtin_bit_cast(float, w << 16); }
__device__ __forceinline__ float bf_hi(unsigned w) { return __builtin_bit_cast(float, w & 0xffff0000u); }
__device__ __forceinline__ float bf2f(bf16 v) { return __builtin_bit_cast(float, (unsigned)v << 16); }
__device__ __forceinline__ float wave_sum(float v) {
#pragma unroll
    for (int o = 1; o < 64; o <<= 1) v += __shfl_xor(v, o);
    return v;
}
__device__ __forceinline__ float fast_sigmoid(float x) { return __builtin_amdgcn_rcpf(1.f + __builtin_amdgcn_exp2f(-LOG2E * x)); }
__device__ __forceinline__ float row_rstd(const float* ssq, int row) {
    const f32x4* p = (const f32x4*)(ssq + (size_t)row * 16); const f32x4 a = p[0], b = p[1], c = p[2], d = p[3];
    const float s = ((a.x + a.y) + (a.z + a.w)) + ((b.x + b.y) + (b.z + b.w)) + ((c.x + c.y) + (c.z + c.w)) + ((d.x + d.y) + (d.z + d.w));
    return rsqrtf(s * (1.0f / D) + RMS_EPS);
}

typedef float f32x2 __attribute__((ext_vector_type(2)));
template <class Sched> __device__ __forceinline__ void fill_rstd(LAS unsigned char* lds, const Sched& S, const float* ssq, int tid) {
    LAS float* rt = (LAS float*)(lds + RSTD_OFF); pg8::Unit u;
    for (int i = 0; i < RSTD_MAX_UNITS && S.next(i, u); ++i)
        if ((tid >> 8) == (i & 1)) { const int r = tid & 255; rt[i * 256 + r] = row_rstd(ssq, u.pm * 256 + r); }
    __syncthreads();
}
using pg8::Unit;
__device__ __forceinline__ f32x2 silu_mul_pk(f32x2 g, f32x2 up) {
    const f32x2 t = g * (-LOG2E); f32x2 e; e.x = __builtin_amdgcn_exp2f(t.x); e.y = __builtin_amdgcn_exp2f(t.y);
    const f32x2 d = e + 1.0f; f32x2 r; r.x = __builtin_amdgcn_rcpf(d.x); r.y = __builtin_amdgcn_rcpf(d.y);
    return (g * r) * up;
}
struct EpiSwiGLU {
    static constexpr bool PERM = true;
    const LAS float* rtab; bf16* act; int skip;
    __device__ __forceinline__ void operator()(const f32x4 (&acc)[2][2][4][2], const Unit& u, int ui, int wr, int wc, int fr, int fq) const {
        if (skip == 1) return;
#pragma unroll
        for (int ai = 0; ai < 2; ++ai)
#pragma unroll
            for (int m = 0; m < 4; ++m) {
                const int rl = ai * 128 + wr * 64 + m * 16 + fr, row = u.pm * 256 + rl;
                const float rs = rtab[ui * 256 + rl];
                f32x2 v[4];
#pragma unroll
                for (int n = 0; n < 2; ++n)
#pragma unroll
                    for (int e = 0; e < 2; ++e) { const f32x2 g = (f32x2){acc[ai][0][m][n][2 * e], acc[ai][0][m][n][2 * e + 1]} * rs, up = (f32x2){acc[ai][1][m][n][2 * e], acc[ai][1][m][n][2 * e + 1]} * rs;
                        v[n * 2 + e] = silu_mul_pk(g, up); }
                v4u w; w.x = pg8::cvt_pk_bf16(v[0].x, v[0].y); w.y = pg8::cvt_pk_bf16(v[1].x, v[1].y); w.z = pg8::cvt_pk_bf16(v[2].x, v[2].y); w.w = pg8::cvt_pk_bf16(v[3].x, v[3].y);
                if (skip != 2 || w.x == 0x7fc17fc1u) *(v4u*)(act + (size_t)row * FF + u.pn * 128 + wc * 32 + 8 * fq) = w;
            }
    }
};
#ifndef RESID_BF16
#define RESID_BF16 1
#endif
struct EpiRes {
    static constexpr bool PERM = true;
    const float* xin; float* xout; bf16* xb; float* ssq; float scale; bool skip;
    __device__ __forceinline__ void operator()(const f32x4 (&acc)[2][2][4][2], const Unit& u, int ui, int wr, int wc, int fr, int fq) const {
        if (skip) return;
        if (xin) run<true>(acc, u, wr, wc, fr, fq); else run<false>(acc, u, wr, wc, fr, fq);
    }
    template <bool F32IN> __device__ __forceinline__ void run(const f32x4 (&acc)[2][2][4][2], const Unit& u, int wr, int wc, int fr, int fq) const {
#pragma unroll
        for (int ai = 0; ai < 2; ++ai) {
            f32x4 xv[4][2][2];
#pragma unroll
            for (int m = 0; m < 4; ++m)
#pragma unroll
                for (int bj = 0; bj < 2; ++bj) { const size_t off = (size_t)(u.pm * 256 + ai * 128 + wr * 64 + m * 16 + fr) * D + u.pn * 256 + bj * 128 + wc * 32 + 8 * fq;
                    if (F32IN) { xv[m][bj][0] = *(const f32x4*)(xin + off); xv[m][bj][1] = *(const f32x4*)(xin + off + 4); }
                    else { const v4u w = *(const v4u*)(xb + off); xv[m][bj][0] = (f32x4){bf_lo(w.x), bf_hi(w.x), bf_lo(w.y), bf_hi(w.y)}; xv[m][bj][1] = (f32x4){bf_lo(w.z), bf_hi(w.z), bf_lo(w.w), bf_hi(w.w)}; } }
#pragma unroll
            for (int m = 0; m < 4; ++m) {
                const int row = u.pm * 256 + ai * 128 + wr * 64 + m * 16 + fr;
                float ss = 0.f;
#pragma unroll
                for (int bj = 0; bj < 2; ++bj) {
                    const size_t off = (size_t)row * D + u.pn * 256 + bj * 128 + wc * 32 + 8 * fq;
                    const f32x4 y0 = xv[m][bj][0] + acc[ai][bj][m][0] * scale, y1 = xv[m][bj][1] + acc[ai][bj][m][1] * scale;
                    if (xout) { *(f32x4*)(xout + off) = y0; *(f32x4*)(xout + off + 4) = y1; }
                    v4u w; w.x = pg8::cvt_pk_bf16(y0[0], y0[1]); w.y = pg8::cvt_pk_bf16(y0[2], y0[3]); w.z = pg8::cvt_pk_bf16(y1[0], y1[1]); w.w = pg8::cvt_pk_bf16(y1[2], y1[3]);
                    *(v4u*)(xb + off) = w;
                    ss += (y0[0] * y0[0] + y0[1] * y0[1]) + (y0[2] * y0[2] + y0[3] * y0[3]) + (y1[0] * y1[0] + y1[1] * y1[1]) + (y1[2] * y1[2] + y1[3] * y1[3]);
                }
                ss += __shfl_xor(ss, 16); ss += __shfl_xor(ss, 32);
                if (fq == 0) ssq[(size_t)row * 16 + u.pn * 4 + wc] = ss;
            }
            asm volatile("" ::: "memory");
        }
    }
};
struct EpiRnnIn {
    static constexpr bool PERM = true;
    const LAS float* rtab; bf16* Gb; bf16* Ub;
    template <bool GATE> __device__ __forceinline__ void run(const f32x4 (&acc)[2][2][4][2], const Unit& u, int ui, int wr, int wc, int fr, int fq, bf16* dstb, int pc) const {
#pragma unroll
        for (int ai = 0; ai < 2; ++ai)
#pragma unroll
            for (int m = 0; m < 4; ++m) {
                const int rl = ai * 128 + wr * 64 + m * 16 + fr, row = u.pm * 256 + rl;
                const float rs = rtab[ui * 256 + rl];
#pragma unroll
                for (int bj = 0; bj < 2; ++bj) {
                    f32x2 v[4];
#pragma unroll
                    for (int n = 0; n < 2; ++n)
#pragma unroll
                        for (int e = 0; e < 2; ++e) { f32x2 x = (f32x2){acc[ai][bj][m][n][2 * e], acc[ai][bj][m][n][2 * e + 1]} * rs;
                            if (GATE) {
                                const f32x2 t = (x * x * 0.044715f + 1.0f) * x * (-1.5957691216057308f * LOG2E); f32x2 ex; ex.x = __builtin_amdgcn_exp2f(t.x); ex.y = __builtin_amdgcn_exp2f(t.y);
                                const f32x2 d = ex + 1.0f; f32x2 r; r.x = __builtin_amdgcn_rcpf(d.x); r.y = __builtin_amdgcn_rcpf(d.y); x = x * r; }
                            v[n * 2 + e] = x; }
                    v4u w; w.x = pg8::cvt_pk_bf16(v[0].x, v[0].y); w.y = pg8::cvt_pk_bf16(v[1].x, v[1].y); w.z = pg8::cvt_pk_bf16(v[2].x, v[2].y); w.w = pg8::cvt_pk_bf16(v[3].x, v[3].y);
                    *(v4u*)(dstb + (size_t)row * DRNN + pc * 256 + bj * 128 + wc * 32 + 8 * fq) = w;
                }
            }
    }
    __device__ __forceinline__ void operator()(const f32x4 (&acc)[2][2][4][2], const Unit& u, int ui, int wr, int wc, int fr, int fq) const {
        if (u.pn < 5) run<true>(acc, u, ui, wr, wc, fr, fq, Gb, u.pn); else run<false>(acc, u, ui, wr, wc, fr, fq, Ub, u.pn - 5);
    }
};
struct EpiQKV {
    static constexpr bool PERM = true;
    const LAS float* rtab; const LAS float* gtab; bf16* qkv; bool skip;
    __device__ __forceinline__ void operator()(const f32x4 (&acc)[2][2][4][2], const Unit& u, int ui, int wr, int wc, int fr, int fq) const {
        if (skip) return;
        const int hs = u.pn * 4 + wc, kind = hs / 48, gh = hs - kind * 48, g = gh >> 4, h = gh & 15, l2d = 2 * g;
        bf16* slab = qkv + (size_t)(kind * 3 + g) * ((size_t)M * 1024);
        f32x4 gv[2][2];
#pragma unroll
        for (int bj = 0; bj < 2; ++bj)
#pragma unroll
            for (int n = 0; n < 2; ++n) { gv[bj][n] = (f32x4){1.f, 1.f, 1.f, 1.f}; if (kind < 2) gv[bj][n] = *(const LAS f32x4*)(gtab + kind * 64 + 32 * bj + 8 * fq + 4 * n); }
#pragma unroll
        for (int ai = 0; ai < 2; ++ai)
#pragma unroll
            for (int m = 0; m < 4; ++m) {
                const int rl = ai * 128 + wr * 64 + m * 16 + fr, row = u.pm * 256 + rl;
                const float rs = rtab[ui * 256 + rl];
                f32x4 v[2][2]; float ss = 0.f;
#pragma unroll
                for (int bj = 0; bj < 2; ++bj)
#pragma unroll
                    for (int n = 0; n < 2; ++n) { v[bj][n] = acc[ai][bj][m][n] * rs; const f32x4 t = v[bj][n] * v[bj][n]; ss += (t[0] + t[1]) + (t[2] + t[3]); }
                float rn = 1.f;
                if (kind < 2) { ss += __shfl_xor(ss, 16); ss += __shfl_xor(ss, 32); rn = rsqrtf(ss * (1.0f / HD) + RMS_EPS); }
                const int b = row >> 11, t = row & 2047, rres = t & ((1 << l2d) - 1), l = t >> l2d, L = 2048 >> l2d;
                bf16* dst = slab + ((size_t)(b * 16 + h) * 2048 + rres * L + l) * 64 + 8 * fq;
#pragma unroll
                for (int bj = 0; bj < 2; ++bj) {
                    const f32x4 a0 = v[bj][0] * gv[bj][0] * rn, a1 = v[bj][1] * gv[bj][1] * rn;
                    v4u w; w.x = pg8::cvt_pk_bf16(a0[0], a0[1]); w.y = pg8::cvt_pk_bf16(a0[2], a0[3]); w.z = pg8::cvt_pk_bf16(a1[0], a1[1]); w.w = pg8::cvt_pk_bf16(a1[2], a1[3]);
                    *(v4u*)(dst + 32 * bj) = w;
                }
            }
    }
};

struct Args { const float* in[18]; float* out; unsigned char* ws; int ph_lo, ph_hi; };
enum { I_X = 0, I_NORMG, I_FFN_WIN, I_FFN_WOUT, I_RNN_WIN, I_CONV_W, I_CONV_B, I_WA, I_BA, I_WX, I_BX, I_LAM, I_RNN_WOUT, I_WQKV, I_QGAIN, I_KGAIN, I_WO, I_RELB };

struct Ctx { LAS unsigned char* lds; int tid, lane, wave, G, vcu; unsigned char* ws; };

typedef short v4i16_t __attribute__((ext_vector_type(4)));
__device__ __forceinline__ v4i16_t vtr16(const LAS unsigned char* p) { return __builtin_amdgcn_ds_read_tr16_b64_v4i16((LAS v4i16_t*)p); }
enum { CM_NONE = 0, CM_FFN = 1, CM_QKV = 2 };
__device__ __forceinline__ int colmap(int mode, int vr) {
    if (mode == CM_FFN) { const int pn = vr >> 8, w = vr & 255; return (w >> 7) * FF + 128 * pn + (w & 127); }
    if (mode == CM_QKV) { const int pn = vr >> 8, w = vr & 255, bj = w >> 7, wc = (w >> 5) & 3, j = w & 31; return 256 * pn + 64 * wc + 32 * bj + j; }
    return vr;
}
__device__ __forceinline__ void transpose_item(const float* W, int K, int N, const float* gvec, bf16* WT, int mode, LAS unsigned char* scr, int item, int lane) {
    const int nblk = N / 64, kb = item / nblk, nb = item - kb * nblk, k0 = 64 * kb, vr0 = 64 * nb;
    const int col4 = lane & 15, rsub = lane >> 4, nsrc = colmap(mode, vr0 + 32 * (col4 >> 3)) + (col4 & 7) * 4;
    const float* src = W + (size_t)(k0 + rsub) * N + nsrc;
    f32x4 w[16];
#pragma unroll
    for (int i = 0; i < 16; ++i) w[i] = *(const GAS f32x4*)(src + (size_t)(4 * i) * N);
    if (gvec) {
#pragma unroll
        for (int i = 0; i < 16; ++i) w[i] = w[i] * gvec[k0 + 4 * i + rsub];
    }
#pragma unroll
    for (int i = 0; i < 16; ++i) { v2u p; p.x = pg8::cvt_pk_bf16(w[i][0], w[i][1]); p.y = pg8::cvt_pk_bf16(w[i][2], w[i][3]);
        *(LAS v2u*)(scr + (col4 >> 3) * 4096 + (4 * i + rsub) * 64 + (col4 & 7) * 8) = p; }
    const int q = (lane & 15) >> 2, p4 = lane & 3, gidx = lane >> 4;
#pragma unroll
    for (int r = 0; r < 8; ++r) { const int nb16 = r >> 1, kh = r & 1, kbase = 32 * kh + 8 * gidx;
        const LAS unsigned char* a = scr + (nb16 >> 1) * 4096 + (kbase + q) * 64 + ((nb16 & 1) * 16 + 4 * p4) * 2;
        const v4i16_t lo = vtr16(a), hi = vtr16(a + 4 * 64);
        v4u o; { const v2u l2 = __builtin_bit_cast(v2u, lo), h2 = __builtin_bit_cast(v2u, hi); o.x = l2.x; o.y = l2.y; o.z = h2.x; o.w = h2.y; }
        *(GAS v4u*)(WT + (size_t)(vr0 + nb16 * 16 + (lane & 15)) * K + k0 + kbase) = o; }
}
struct MatJob { const float* W; int K, N; const float* g; bf16* WT; int mode; };
__device__ __forceinline__ MatJob mat_job(const Ctx& C, const Args& a, int idx) {
    unsigned char* ws = C.ws; const float* ng = a.in[I_NORMG]; MatJob j;
    switch (idx) {
    case 0: j = MatJob{a.in[I_FFN_WIN] + (size_t)0 * D * 2 * FF, D, 2 * FF, ng + 0 * D, (bf16*)(ws + WS_WIN0), CM_FFN}; break;
    case 1: j = MatJob{a.in[I_FFN_WOUT] + (size_t)0 * FF * D, FF, D, nullptr, (bf16*)(ws + WS_WOUT0), CM_NONE}; break;
    case 2: j = MatJob{a.in[I_RNN_WIN], D, 2 * DRNN, ng + 1 * D, (bf16*)(ws + WS_WRIN), CM_NONE}; break;
    case 3: j = MatJob{a.in[I_RNN_WOUT], DRNN, D, nullptr, (bf16*)(ws + WS_WROUT), CM_NONE}; break;
    case 4: j = MatJob{a.in[I_FFN_WIN] + (size_t)1 * D * 2 * FF, D, 2 * FF, ng + 2 * D, (bf16*)(ws + WS_WIN1), CM_FFN}; break;
    case 5: j = MatJob{a.in[I_FFN_WOUT] + (size_t)1 * FF * D, FF, D, nullptr, (bf16*)(ws + WS_WOUT1), CM_NONE}; break;
    case 6: j = MatJob{a.in[I_FFN_WIN] + (size_t)2 * D * 2 * FF, D, 2 * FF, ng + 3 * D, (bf16*)(ws + WS_WIN2), CM_FFN}; break;
    case 7: j = MatJob{a.in[I_FFN_WOUT] + (size_t)2 * FF * D, FF, D, nullptr, (bf16*)(ws + WS_WOUT2), CM_NONE}; break;
    case 8: j = MatJob{a.in[I_WQKV], D, NQKV, ng + 4 * D, (bf16*)(ws + WS_WQKV), CM_QKV}; break;
    case 9: j = MatJob{a.in[I_WO], D, D, nullptr, (bf16*)(ws + WS_WO), CM_NONE}; break;
    case 10: j = MatJob{a.in[I_FFN_WIN] + (size_t)3 * D * 2 * FF, D, 2 * FF, ng + 5 * D, (bf16*)(ws + WS_WIN3), CM_FFN}; break;
    default: j = MatJob{a.in[I_FFN_WOUT] + (size_t)3 * FF * D, FF, D, nullptr, (bf16*)(ws + WS_WOUT3), CM_NONE}; break;
    }
    return j;
}
__device__ __forceinline__ void convert_mats(const Ctx& C, const Args& a, int first, int last, int gw, int NGW) {
    LAS unsigned char* scr = C.lds + C.wave * 8192;
    int base = 0;
    for (int mi = first; mi < last; ++mi) {
        const MatJob j = mat_job(C, a, mi); const int cnt = (j.K / 64) * (j.N / 64);
        int it = (gw - base) % NGW; if (it < 0) it += NGW;
        for (; it < cnt; it += NGW) transpose_item(j.W, j.K, j.N, j.g, j.WT, j.mode, scr, it, C.lane);
        base += cnt;
    }
}
__device__ __forceinline__ int t5_bucket(int n) {
    if (n < 16) return n;
    int b = 16;
    b += (n >= 22) + (n >= 30) + (n >= 40) + (n >= 54) + (n >= 73) + (n >= 99) + (n >= 134) + (n >= 182) + (n >= 246) + (n >= 332) + (n >= 450) + (n >= 609) + (n >= 825) + (n >= 1117) + (n >= 1513);
    return b;
}
__device__ __forceinline__ void p_prologue(const Ctx& C, const Args& a) {
    const int gw = C.vcu * NWAVES + C.wave, NGW = C.G * NWAVES;
    convert_mats(C, a, 0, 3, gw, NGW);
    {   LAS unsigned char* scr = C.lds + C.wave * 8192;
        for (int it = gw; it < 2 * NBLK * 4; it += NGW) { const int which = it / (NBLK * 4), r = it % (NBLK * 4), blk = r >> 2, sub = r & 3;
            const float* W = (which ? a.in[I_WX] : a.in[I_WA]) + (size_t)blk * RBLK * RBLK; bf16* WT = (bf16*)(C.ws + (which ? WS_WX : WS_WA)) + (size_t)blk * RBLK * RBLK;
            transpose_item(W, RBLK, RBLK, nullptr, WT, CM_NONE, scr, sub, C.lane); } }
    const float* x = a.in[I_X]; bf16* xb = (bf16*)(C.ws + WS_XB); float* ssq = (float*)(C.ws + WS_SSQ);
    for (int m = gw; m < M; m += NGW) {
        const GAS f32x4* xr = (const GAS f32x4*)(x + (size_t)m * D) + C.lane; f32x4 v[4]; float s = 0.f;
#pragma unroll
        for (int j = 0; j < 4; ++j) { v[j] = xr[64 * j]; s += (v[j].x * v[j].x + v[j].y * v[j].y) + (v[j].z * v[j].z + v[j].w * v[j].w); }
        s = wave_sum(s);
        GAS v2u* o8 = (GAS v2u*)(xb + (size_t)m * D) + C.lane;
#pragma unroll
        for (int j = 0; j < 4; ++j) { v2u w; w.x = pk2(v[j].x, v[j].y); w.y = pk2(v[j].z, v[j].w); o8[64 * j] = w; }
        if (C.lane < 16) ssq[(size_t)m * 16 + C.lane] = (C.lane == 0) ? s : 0.f;
    }
    float* bt = (float*)(C.ws + WS_BIAS); const float* rb = a.in[I_RELB];
    for (int i = blockIdx.x * 512 + C.tid; i < 48 * 129; i += C.G * 512) { const int gh = i / 129, dist = i - gh * 129, g = gh >> 4;
        bt[gh * 132 + dist] = rb[t5_bucket(dist << (2 * g)) * 48 + gh] * LOG2E; }
}

typedef float f32x16 __attribute__((ext_vector_type(16)));
typedef short bf16x8v __attribute__((ext_vector_type(8)));
constexpr int RM_WB = 0, RM_WB_GATE = 64 * 272, RM_CW = 36864, RM_CMP = RM_CW + 2560, RM_TILE = 49152, RM_TILE_BYTES = 36 * 256, RM_END = RM_TILE + 8 * RM_TILE_BYTES;
static_assert(RM_WB + 2 * RM_WB_GATE <= RM_CW && RM_CMP + 2 * 2 * 8 * 64 * 4 <= RM_TILE && RM_END <= RING_BYTES, "rnn-mid LDS map");
__device__ __forceinline__ bf16x8v pack8(const float (&v)[8]) {
    v4u w; w.x = pg8::cvt_pk_bf16(v[0], v[1]); w.y = pg8::cvt_pk_bf16(v[2], v[3]); w.z = pg8::cvt_pk_bf16(v[4], v[5]); w.w = pg8::cvt_pk_bf16(v[6], v[7]);
    return __builtin_bit_cast(bf16x8v, w);
}
__device__ __forceinline__ void p_rnn_mid(const Ctx& C, const Args& a) {
    const bf16* U = (const bf16*)(C.ws + WS_U); const bf16* Gb = (const bf16*)(C.ws + WS_G); bf16* Y = (bf16*)(C.ws + WS_Y);
    const bf16* WAb = (const bf16*)(C.ws + WS_WA); const bf16* WXb = (const bf16*)(C.ws + WS_WX);
    LAS unsigned char* L = C.lds;
    LAS float* CW = (LAS float*)(L + RM_CW); LAS float* CMP = (LAS float*)(L + RM_CMP);
    const int wave = C.wave;
    LAS unsigned char* wt = L + RM_TILE + wave * RM_TILE_BYTES;
    for (int item = blockIdx.x; item < BATCH * NBLK * 2; item += C.G) {
        const int b = item / (NBLK * 2), n = (item % (NBLK * 2)) >> 1, half = item & 1;
        int tid = C.tid; asm volatile("" : "+v"(tid));
        const int lane = tid & 63, r32 = lane & 31, hh = lane >> 5;
        __syncthreads();
#pragma unroll
        for (int p = 0; p < 4; ++p) { const int idx = p * 512 + tid, gate = idx >> 10, rem = idx & 1023, row = rem >> 4, c16 = rem & 15;
            const v4u w = *(const v4u*)((gate ? WXb : WAb) + (size_t)(n * 128 + 64 * half + row) * 128 + c16 * 8);
            *(LAS v4u*)(L + RM_WB + gate * RM_WB_GATE + row * 272 + c16 * 16) = w; }
        CW[tid] = a.in[I_CONV_W][(tid >> 7) * DRNN + n * 128 + (tid & 127)];
        if (tid < 128) CW[512 + tid] = a.in[I_CONV_B][n * 128 + tid];
        __syncthreads();
        float ba[2], bx[2], spl[2], Ht[2];
#pragma unroll
        for (int cb = 0; cb < 2; ++cb) { const int ch = n * 128 + 64 * half + 32 * cb + r32; ba[cb] = a.in[I_BA][ch]; bx[cb] = a.in[I_BX][ch];
            spl[cb] = -8.0f * LOG2E * log1pf(expf(-a.in[I_LAM][ch])); Ht[cb] = 0.f; }
        bf16x8v idf[2];
#pragma unroll
        for (int sp = 0; sp < 2; ++sp)
#pragma unroll
            for (int j = 0; j < 8; ++j) idf[sp][j] = (16 * sp + 8 * hh + j == r32) ? (short)0x3F80 : (short)0;
        const int urow = lane >> 4, uch = lane & 15, grow = lane >> 3, gch = lane & 7;
        v4u uraw[9], graw[4];
#define RM_LOADU(TILE) do { const int tp_ = (TILE) * 256 + wave * 32; const int ub_ = (b * SEQ + tp_ - 3 + urow) * DRNN + n * 128 + uch * 8;        \
        _Pragma("unroll") for (int i_ = 0; i_ < 9; ++i_) uraw[i_] = *(const v4u*)(U + (ptrdiff_t)(ub_ + i_ * 4 * DRNN)); \
        if (tp_ == 0 && urow < 3) uraw[0] = (v4u){0u, 0u, 0u, 0u};         } while (0)
#define RM_LOADG(TILE) do { const int gb_ = (b * SEQ + (TILE) * 256 + wave * 32 + grow) * DRNN + n * 128 + 64 * half + gch * 8; \
        _Pragma("unroll") for (int i_ = 0; i_ < 4; ++i_) graw[i_] = *(const v4u*)(Gb + (unsigned)(gb_ + i_ * 8 * DRNN)); } while (0)
        for (int tile = 0; tile < 8; ++tile) {
            const int tposw = tile * 256 + wave * 32;
            const size_t tok0 = (size_t)b * SEQ + tposw;
            LAS float* CWt = CW; LAS unsigned char* WBt = L + RM_WB; asm volatile("" : "+v"(CWt), "+v"(WBt));
            RM_LOADU(tile); RM_LOADG(tile);
#pragma unroll
            for (int i = 0; i < 9; ++i) { const int rl = 4 * i + urow; *(LAS v4u*)(wt + rl * 256 + ((uch ^ (rl & 15)) << 4)) = uraw[i]; }
            {
                const int tg = lane >> 4, cc = lane & 15;
                f32x2 wv[4][4], bv2[4];
#pragma unroll
                for (int k = 0; k < 4; ++k) { const f32x4 w0 = *(const LAS f32x4*)(CWt + k * 128 + 8 * cc), w1 = *(const LAS f32x4*)(CWt + k * 128 + 8 * cc + 4);
                    wv[k][0] = (f32x2){w0[0], w0[1]}; wv[k][1] = (f32x2){w0[2], w0[3]}; wv[k][2] = (f32x2){w1[0], w1[1]}; wv[k][3] = (f32x2){w1[2], w1[3]}; }
                { const f32x4 b0 = *(const LAS f32x4*)(CWt + 512 + 8 * cc), b1 = *(const LAS f32x4*)(CWt + 512 + 8 * cc + 4);
                  bv2[0] = (f32x2){b0[0], b0[1]}; bv2[1] = (f32x2){b0[2], b0[3]}; bv2[2] = (f32x2){b1[0], b1[1]}; bv2[3] = (f32x2){b1[2], b1[3]}; }
                v4u ur[11];
#pragma unroll
                for (int j = 0; j < 11; ++j) { const int rl = 8 * tg + j; ur[j] = *(const LAS v4u*)(wt + rl * 256 + ((cc ^ (rl & 15)) << 4)); }
                f32x2 o[8][4];
#pragma unroll
                for (int i = 0; i < 8; ++i)
#pragma unroll
                    for (int e = 0; e < 4; ++e) o[i][e] = bv2[e];
#pragma unroll
                for (int j = 0; j < 11; ++j) {
                    const f32x2 u0 = (f32x2){bf_lo(ur[j].x), bf_hi(ur[j].x)}, u1 = (f32x2){bf_lo(ur[j].y), bf_hi(ur[j].y)}, u2 = (f32x2){bf_lo(ur[j].z), bf_hi(ur[j].z)}, u3 = (f32x2){bf_lo(ur[j].w), bf_hi(ur[j].w)};
#pragma unroll
                    for (int k = 0; k < 4; ++k) { const int i = j - k; if (i >= 0 && i < 8) {
                        o[i][0] += wv[k][0] * u0; o[i][1] += wv[k][1] * u1; o[i][2] += wv[k][2] * u2; o[i][3] += wv[k][3] * u3; } }
                }
#pragma unroll
                for (int i = 0; i < 8; ++i) { const int rl = 8 * tg + i;
                    v4u w; w.x = pg8::cvt_pk_bf16(o[i][0].x, o[i][0].y); w.y = pg8::cvt_pk_bf16(o[i][1].x, o[i][1].y); w.z = pg8::cvt_pk_bf16(o[i][2].x, o[i][2].y); w.w = pg8::cvt_pk_bf16(o[i][3].x, o[i][3].y);
                    *(LAS v4u*)(wt + rl * 256 + ((cc ^ (rl & 15)) << 4)) = w; }
            }
            bf16x8v af[8];
#pragma unroll
            for (int s = 0; s < 8; ++s) af[s] = *(const LAS bf16x8v*)(wt + r32 * 256 + (((2 * s + hh) ^ (r32 & 15)) << 4));
#pragma unroll
            for (int i = 0; i < 4; ++i) *(LAS v4u*)(wt + (8 * i + grow) * 128 + gch * 16) = graw[i];
            f32x16 acc[2][2], ufa[2];
#pragma unroll
            for (int cb = 0; cb < 2; ++cb)
#pragma unroll
                for (int e = 0; e < 16; ++e) { acc[0][cb][e] = 0.f; acc[1][cb][e] = 0.f; ufa[cb][e] = 0.f; }
            bf16x8v bq[2][4];
#define RM_LDB(S, DST) do { _Pragma("unroll") for (int g_ = 0; g_ < 2; ++g_) _Pragma("unroll") for (int c_ = 0; c_ < 2; ++c_) \
                DST[g_ * 2 + c_] = *(const LAS bf16x8v*)(WBt + g_ * RM_WB_GATE + (32 * c_ + r32) * 272 + (16 * (S) + 8 * hh) * 2); } while (0)
            RM_LDB(0, bq[0]);
#pragma unroll
            for (int s = 0; s < 8; ++s) {
                if (s < 7) RM_LDB(s + 1, bq[(s + 1) & 1]);
#pragma unroll
                for (int gt = 0; gt < 2; ++gt)
#pragma unroll
                    for (int cb = 0; cb < 2; ++cb) acc[gt][cb] = __builtin_amdgcn_mfma_f32_32x32x16_bf16(af[s], bq[s & 1][gt * 2 + cb], acc[gt][cb], 0, 0, 0);
            }
#undef RM_LDB
#pragma unroll
            for (int cb = 0; cb < 2; ++cb)
#pragma unroll
                for (int sp = 0; sp < 2; ++sp) { const bf16x8v asel = half ? af[4 + 2 * cb + sp] : af[2 * cb + sp];
                    ufa[cb] = __builtin_amdgcn_mfma_f32_32x32x16_bf16(asel, idf[sp], ufa[cb], 0, 0, 0); }
#pragma unroll
            for (int cb = 0; cb < 2; ++cb)
#pragma unroll
                for (int e = 0; e < 16; ++e) {
                    const float uf = ufa[cb][e];
                    const float r = fast_sigmoid(acc[0][cb][e] + ba[cb]), ii = fast_sigmoid(acc[1][cb][e] + bx[cb]);
                    const float av = __builtin_amdgcn_exp2f(r * spl[cb]);
                    const float bv = __builtin_amdgcn_sqrtf(fmaxf(1.f - av * av, 0.f)) * (ii * uf);
                    acc[0][cb][e] = av; acc[1][cb][e] = bv;
                }
            float A0[2][4], B0[2][4], A1[2][4], B1[2][4];
            const int par = tile & 1;
#pragma unroll
            for (int cb = 0; cb < 2; ++cb) {
                float Aw = 1.f, Bw = 0.f;
#pragma unroll
                for (int q = 0; q < 4; ++q) {
                    const float a0 = acc[0][cb][4 * q], a1 = acc[0][cb][4 * q + 1], a2 = acc[0][cb][4 * q + 2], a3 = acc[0][cb][4 * q + 3];
                    const float Ag = (a0 * a1) * (a2 * a3);
                    const float Bg = ((acc[1][cb][4 * q] * a1 + acc[1][cb][4 * q + 1]) * a2 + acc[1][cb][4 * q + 2]) * a3 + acc[1][cb][4 * q + 3];
                    const float pA = __shfl_xor(Ag, 32), pB = __shfl_xor(Bg, 32);
                    A0[cb][q] = hh ? pA : Ag; B0[cb][q] = hh ? pB : Bg; A1[cb][q] = hh ? Ag : pA; B1[cb][q] = hh ? Bg : pB;
                    Bw = Bw * A0[cb][q] + B0[cb][q]; Aw *= A0[cb][q]; Bw = Bw * A1[cb][q] + B1[cb][q]; Aw *= A1[cb][q];
                }
                if (hh == 0) { CMP[((par * 2 + 0) * 8 + wave) * 64 + 32 * cb + r32] = Aw; CMP[((par * 2 + 1) * 8 + wave) * 64 + 32 * cb + r32] = Bw; }
            }
            __syncthreads();
#pragma unroll
            for (int cb = 0; cb < 2; ++cb) {
                float h = Ht[cb], hin = 0.f;
#pragma unroll
                for (int v = 0; v < 8; ++v) { const float Av = CMP[((par * 2 + 0) * 8 + v) * 64 + 32 * cb + r32], Bv = CMP[((par * 2 + 1) * 8 + v) * 64 + 32 * cb + r32];
                    hin = (v == wave) ? h : hin; h = Av * h + Bv; }
                Ht[cb] = h;
                float hc = hin;
#pragma unroll
                for (int q = 0; q < 4; ++q) {
                    const float c0 = hc; hc = A0[cb][q] * hc + B0[cb][q]; const float c1 = hc; hc = A1[cb][q] * hc + B1[cb][q];
                    float hv = hh ? c1 : c0;
#pragma unroll
                    for (int i = 0; i < 4; ++i) { const int e = 4 * q + i; hv = acc[0][cb][e] * hv + acc[1][cb][e];
                        const int tl = (e & 3) + 8 * (e >> 2) + 4 * hh;
                        LAS bf16* gp = (LAS bf16*)(wt + tl * 128 + (32 * cb + r32) * 2);
                        *gp = (bf16)f2bf(hv * bf2f(*gp)); }
                }
            }
#pragma unroll
            for (int i = 0; i < 4; ++i) { const v4u w = *(const LAS v4u*)(wt + (8 * i + grow) * 128 + gch * 16);
                *(v4u*)(Y + (unsigned)(((int)tok0 + 8 * i + grow) * DRNN + n * 128 + 64 * half + gch * 8)) = w; }
        }
#undef RM_LOADU
#undef RM_LOADG
    }
    const int nitems = BATCH * NBLK * 2;
    if (C.G > nitems) { if ((int)blockIdx.x >= nitems) convert_mats(C, a, 3, 10, ((int)blockIdx.x - nitems) * NWAVES + wave, (C.G - nitems) * NWAVES); }
    else { __syncthreads(); convert_mats(C, a, 3, 10, (int)blockIdx.x * NWAVES + wave, C.G * NWAVES); }
}
constexpr int AT_EXT = 0, AT_VT = 48 * 192 * 4;
struct AttnUnit { bf16* qbase; const bf16* kres; const bf16* vres; int l0, kb_lo, eoff, g, bh, llin0; };
__device__ __forceinline__ AttnUnit attn_unit(bf16* QKV, int it, int wave) {
    AttnUnit u; const size_t SLAB = (size_t)M * 1024;
    const int g = it >> 10, rem = it & 1023, bh = rem >> 3, chunk = (rem + (it >> 8)) & 7, l2d = 2 * g, L = SEQ >> l2d;
    u.g = g; u.bh = bh; u.llin0 = chunk * 256 + wave * 32; u.l0 = u.llin0 & (L - 1); u.kb_lo = (u.l0 - 128) > 0 ? (u.l0 - 128) : 0; u.eoff = (g * 16 + (bh & 15)) * 192;
    u.qbase = QKV + (size_t)g * SLAB + ((size_t)bh * SEQ + u.llin0) * HD;
    u.kres = u.qbase + 3 * SLAB - (size_t)u.l0 * HD; u.vres = u.qbase + 6 * SLAB - (size_t)u.l0 * HD;
    return u;
}
__device__ __forceinline__ void p_attn(const Ctx& C, const bool dry) {
    bf16* QKV = (bf16*)(C.ws + WS_QKV); float* LSE = (float*)(C.ws + WS_LSE); const float* bt = (const float*)(C.ws + WS_BIAS);
    LAS float* ext = (LAS float*)(C.lds + AT_EXT);
    LAS unsigned char* vt = C.lds + AT_VT + C.wave * 8192; LAS unsigned char* kt = vt + 4096;
    const int lane = C.lane, r32 = lane & 31, hh = lane >> 5, wave = C.wave, tid = C.tid;
    const int crow8 = lane >> 3, cch = lane & 7;
    const int vtr_off = (4 * hh + ((lane & 15) >> 2)) * 64 + ((lane >> 4) & 1) * 32 + (lane & 3) * 8;
    for (int i = tid; i < 48 * 192; i += 512) { const int gh = i / 192, dist = i - gh * 192 - 32; ext[i] = (dist >= 0 && dist <= 128) ? bt[gh * 132 + dist] : -1e30f; }
    __syncthreads();
    const int total = NGRP * BATCH * NHEAD * 8;
    int it = blockIdx.x;
    if (it >= total) return;
    AttnUnit cu = attn_unit(QKV, it, wave), nu = cu;
    v4u qfn[4], kfn[4], vvn[4];
#define AT_LOADKV(U, KB) do { const bf16* kblk_ = (U).kres + (size_t)(KB) * HD; const bf16* vblk_ = (U).vres + (size_t)(KB) * HD; \
        _Pragma("unroll") for (int i_ = 0; i_ < 4; ++i_) { vvn[i_] = *(const v4u*)(vblk_ + (8 * i_ + crow8) * HD + cch * 8); kfn[i_] = *(const v4u*)(kblk_ + (8 * i_ + crow8) * HD + cch * 8); } } while (0)
#define AT_LOADQ(U) do { _Pragma("unroll") for (int i_ = 0; i_ < 4; ++i_) qfn[i_] = *(const v4u*)((U).qbase + (8 * i_ + crow8) * HD + cch * 8); } while (0)
#define AT_TILE2FRAG(RAW, FR) do { _Pragma("unroll") for (int i_ = 0; i_ < 4; ++i_) *(LAS v4u*)(kt + (8 * i_ + crow8) * 128 + ((cch ^ crow8) << 4)) = RAW[i_]; \
        _Pragma("unroll") for (int s_ = 0; s_ < 4; ++s_) FR[s_] = *(const LAS bf16x8v*)(kt + r32 * 128 + (((2 * s_ + hh) ^ (r32 & 7)) << 4)); } while (0)
    AT_LOADQ(cu); AT_LOADKV(cu, cu.l0);
    for (;;) {
        bf16x8v qf[4];
        AT_TILE2FRAG(qfn, qf);
        f32x16 o0, o1;
#pragma unroll
        for (int e = 0; e < 16; ++e) { o0[e] = 0.f; o1[e] = 0.f; }
        float mrow = -1e30f, lsum = 0.f;
        const bool has_next = (it + C.G) < total;
        for (int kb = cu.l0; kb >= cu.kb_lo; kb -= 32) {
            v4u vv[4], kraw[4]; bf16x8v kf[4];
#pragma unroll
            for (int i = 0; i < 4; ++i) { vv[i] = vvn[i]; kraw[i] = kfn[i]; }
            if (kb - 32 >= cu.kb_lo) { AT_LOADKV(cu, kb - 32); }
            else if (has_next) { nu = attn_unit(QKV, it + C.G, wave); AT_LOADQ(nu); AT_LOADKV(nu, nu.l0); }
#pragma unroll
            for (int i = 0; i < 4; ++i) *(LAS v4u*)(vt + (cch >> 2) * 2048 + (8 * i + crow8) * 64 + (cch & 3) * 16) = vv[i];
            AT_TILE2FRAG(kraw, kf);
            f32x16 p;
#pragma unroll
            for (int e = 0; e < 16; ++e) p[e] = 0.f;
#pragma unroll
            for (int s = 0; s < 4; ++s) p = __builtin_amdgcn_mfma_f32_32x32x16_bf16(kf[s], qf[s], p, 0, 0, 0);
            const int eb = cu.eoff + cu.l0 + r32 - kb - 4 * hh + 32;
            float bm = -1e30f;
#pragma unroll
            for (int e = 0; e < 16; ++e) { p[e] += ext[eb - ((e & 3) + 8 * (e >> 2))]; bm = fmaxf(bm, p[e]); }
            bm = fmaxf(bm, __shfl_xor(bm, 32));
            const float mn = fmaxf(mrow, bm), alpha = __builtin_amdgcn_exp2f(mrow - mn); mrow = mn;
            float ps = 0.f;
#pragma unroll
            for (int e = 0; e < 16; ++e) { p[e] = __builtin_amdgcn_exp2f(p[e] - mn); ps += p[e]; }
            lsum = lsum * alpha + ps;
#pragma unroll
            for (int e = 0; e < 16; ++e) { o0[e] *= alpha; o1[e] *= alpha; }
            bf16x8v pf[2];
#pragma unroll
            for (int s = 0; s < 2; ++s) { const float t8[8] = {p[8 * s], p[8 * s + 1], p[8 * s + 2], p[8 * s + 3], p[8 * s + 4], p[8 * s + 5], p[8 * s + 6], p[8 * s + 7]}; pf[s] = pack8(t8); }
#pragma unroll
            for (int s = 0; s < 2; ++s) {
                const v4i16_t a00 = vtr16(vt + 0 * 2048 + (16 * s) * 64 + vtr_off), a01 = vtr16(vt + 0 * 2048 + (16 * s + 8) * 64 + vtr_off);
                const v4i16_t a10 = vtr16(vt + 1 * 2048 + (16 * s) * 64 + vtr_off), a11 = vtr16(vt + 1 * 2048 + (16 * s + 8) * 64 + vtr_off);
                const bf16x8v va0 = (bf16x8v){a00[0], a00[1], a00[2], a00[3], a01[0], a01[1], a01[2], a01[3]};
                const bf16x8v va1 = (bf16x8v){a10[0], a10[1], a10[2], a10[3], a11[0], a11[1], a11[2], a11[3]};
                o0 = __builtin_amdgcn_mfma_f32_32x32x16_bf16(va0, pf[s], o0, 0, 0, 0);
                o1 = __builtin_amdgcn_mfma_f32_32x32x16_bf16(va1, pf[s], o1, 0, 0, 0);
            }
        }
        const float ltot = lsum + __shfl_xor(lsum, 32), inv = 1.f / ltot;
#pragma unroll
        for (int q = 0; q < 4; ++q) {
            v2u w0, w1;
            w0.x = pg8::cvt_pk_bf16(o0[4 * q] * inv, o0[4 * q + 1] * inv); w0.y = pg8::cvt_pk_bf16(o0[4 * q + 2] * inv, o0[4 * q + 3] * inv);
            w1.x = pg8::cvt_pk_bf16(o1[4 * q] * inv, o1[4 * q + 1] * inv); w1.y = pg8::cvt_pk_bf16(o1[4 * q + 2] * inv, o1[4 * q + 3] * inv);
            *(LAS v2u*)(kt + r32 * 128 + ((q ^ (r32 & 7)) << 4) + 8 * hh) = w0; *(LAS v2u*)(kt + r32 * 128 + (((4 + q) ^ (r32 & 7)) << 4) + 8 * hh) = w1;
        }
        if (!dry)
#pragma unroll
        for (int i = 0; i < 4; ++i) { const v4u w = *(const LAS v4u*)(kt + (8 * i + crow8) * 128 + ((cch ^ crow8) << 4)); *(v4u*)(cu.qbase + (8 * i + crow8) * HD + cch * 8) = w; }
        if (hh == 0) { const int l2d = 2 * cu.g, L = SEQ >> l2d, llin = cu.llin0 + r32, rres = llin >> (11 - l2d), l = llin & (L - 1), t = (l << l2d) + rres, row = (cu.bh >> 4) * SEQ + t;
            LSE[((size_t)cu.g * M + row) * 16 + (cu.bh & 15)] = mrow + log2f(ltot); }
        if (!has_next) break;
        it += C.G; cu = nu;
    }
#undef AT_LOADKV
#undef AT_LOADQ
#undef AT_TILE2FRAG
}
__device__ __forceinline__ void p_merge(const Ctx& C, const Args& a) {
    const bf16* QKV = (const bf16*)(C.ws + WS_QKV); const float* LSE = (const float*)(C.ws + WS_LSE); bf16* ATT = (bf16*)(C.ws + WS_ATT);
    for (int idx = blockIdx.x * 512 + C.tid; idx < M * 16 * 8; idx += C.G * 512) {
        const int ch = idx & 7, h = (idx >> 3) & 15, row = idx >> 7, b = row >> 11, t = row & 2047;
        float ls[3], mxl = -INFINITY;
#pragma unroll
        for (int g = 0; g < 3; ++g) { ls[g] = LSE[((size_t)g * M + row) * 16 + h]; mxl = fmaxf(mxl, ls[g]); }
        float acc[8], wsum = 0.f;
#pragma unroll
        for (int e = 0; e < 8; ++e) acc[e] = 0.f;
#pragma unroll
        for (int g = 0; g < 3; ++g) { const float w = exp2f(ls[g] - mxl); wsum += w; const int l2d = 2 * g, rres = t & ((1 << l2d) - 1), l = t >> l2d, L = SEQ >> l2d;
            const v4u v = *(const v4u*)(QKV + (size_t)g * ((size_t)M * 1024) + ((size_t)(b * 16 + h) * SEQ + rres * L + l) * HD + 8 * ch);
            acc[0] += w * bf_lo(v.x); acc[1] += w * bf_hi(v.x); acc[2] += w * bf_lo(v.y); acc[3] += w * bf_hi(v.y); acc[4] += w * bf_lo(v.z); acc[5] += w * bf_hi(v.z); acc[6] += w * bf_lo(v.w); acc[7] += w * bf_hi(v.w); }
        const float inv = 1.f / wsum; v4u o; o.x = pk2(acc[0] * inv, acc[1] * inv); o.y = pk2(acc[2] * inv, acc[3] * inv); o.z = pk2(acc[4] * inv, acc[5] * inv); o.w = pk2(acc[6] * inv, acc[7] * inv);
        *(v4u*)(ATT + (size_t)row * 1024 + h * 64 + 8 * ch) = o;
    }
    convert_mats(C, a, 10, 12, C.vcu * NWAVES + C.wave, C.G * NWAVES);
}

enum { PH_PROLOGUE = 0, PH_FFN_IN_0, PH_FFN_OUT_0, PH_RNN_IN, PH_RNN_MID, PH_RNN_OUT, PH_FFN_IN_1, PH_FFN_OUT_1,
       PH_FFN_IN_2, PH_FFN_OUT_2, PH_QKV, PH_ATTN, PH_MERGE, PH_WO, PH_FFN_IN_3, PH_FFN_OUT_3, NPHASE };

__global__ void __launch_bounds__(NWAVES * 64, 2) fwd_kernel(Args args) {
    extern __shared__ __attribute__((aligned(16))) unsigned char lds_raw[];
    Ctx C; C.lds = (LAS unsigned char*)lds_raw; C.tid = threadIdx.x; C.lane = C.tid & 63; C.wave = __builtin_amdgcn_readfirstlane(C.tid >> 6);
    C.G = gridDim.x; { const int bx = blockIdx.x; C.vcu = (C.G % 8 == 0) ? (bx % 8) * (C.G / 8) + bx / 8 : bx; }
    C.ws = args.ws;
    volatile LAS unsigned* MISC = (volatile LAS unsigned*)(C.lds + MISC_OFF);
    for (int u = C.tid; u < (LDS_BYTES - LDSCTL_OFF) / 4; u += NWAVES * 64) ((LAS unsigned*)(C.lds + LDSCTL_OFF))[u] = 0u;
    __syncthreads();
    unsigned* ctl = (unsigned*)args.ws;
    XcdBarrier bar; bar.bar = ctl + CW_BAR; bar.x = 0; bar.st = nullptr;
    const bool multi = (args.ph_hi - args.ph_lo) > 1;
    if (multi) bar = xcd_barrier_post(ctl + CW_BAR, MISC + 8);
    for (int ph = args.ph_lo; ph < args.ph_hi; ++ph) {
        for (int rep = ((DUP_MASK >> ph) & 1u) ? DUP_N : 0; rep >= 0; --rep) {
        const bool dry = rep > 0;
        { int t_ = threadIdx.x; asm volatile("" : "+v"(t_)); C.tid = t_; C.lane = t_ & 63; }
        unsigned char* ws = args.ws;
        C.ws = ws; float* ssq = (float*)(ws + WS_SSQ); bf16* xb = (bf16*)(ws + WS_XB);
        switch (ph) {
        case PH_PROLOGUE: p_prologue(C, args); break;
        case PH_FFN_IN_0: case PH_FFN_IN_1: case PH_FFN_IN_2: case PH_FFN_IN_3: {
            const bf16* Bt = (const bf16*)(ws + (ph == PH_FFN_IN_0 ? WS_WIN0 : ph == PH_FFN_IN_1 ? WS_WIN1 : ph == PH_FFN_IN_2 ? WS_WIN2 : WS_WIN3));
            bf16* act = (bf16*)(ws + (ph == PH_FFN_IN_3 ? WS_ACT3 : WS_ACT));
            pg8::Gemm g{xb, Bt, M, 2 * FF, D}; pg8::StaticOrder S; S.init(M, 2 * FF, C.G, (int)blockIdx.x);
            fill_rstd(C.lds, S, ssq, C.tid);
            EpiSwiGLU E{(const LAS float*)(C.lds + RSTD_OFF), act, dry ? DUP_SKIP_EPI : 0};
            pg8::gemm_phase<EpiSwiGLU, pg8::StaticOrder, true, true>(C.lds, g, S, E);
        } break;
        case PH_FFN_OUT_0: case PH_FFN_OUT_1: case PH_FFN_OUT_2: case PH_FFN_OUT_3: case PH_RNN_OUT: case PH_WO: {
            const bf16* A; const bf16* Bt; int K; float scale = 0.5f; const float* xin = args.out;
            if (ph == PH_FFN_OUT_0) { A = (const bf16*)(ws + WS_ACT); Bt = (const bf16*)(ws + WS_WOUT0); K = FF; xin = args.in[I_X]; }
            else if (ph == PH_FFN_OUT_1) { A = (const bf16*)(ws + WS_ACT); Bt = (const bf16*)(ws + WS_WOUT1); K = FF; }
            else if (ph == PH_FFN_OUT_2) { A = (const bf16*)(ws + WS_ACT); Bt = (const bf16*)(ws + WS_WOUT2); K = FF; }
            else if (ph == PH_FFN_OUT_3) { A = (const bf16*)(ws + WS_ACT3); Bt = (const bf16*)(ws + WS_WOUT3); K = FF; }
            else if (ph == PH_RNN_OUT) { A = (const bf16*)(ws + WS_Y); Bt = (const bf16*)(ws + WS_WROUT); K = DRNN; scale = 1.f; }
            else { A = (const bf16*)(ws + WS_ATT); Bt = (const bf16*)(ws + WS_WO); K = D; scale = 1.f; }
            if (dry && ph != PH_FFN_OUT_0) scale = 0.f;
            float* xo = args.out;
#if RESID_BF16
            if (ph != PH_FFN_OUT_0) xin = nullptr;
            if (ph != PH_FFN_OUT_3 || dry) xo = nullptr;
#endif
            pg8::Gemm g{A, Bt, M, D, K}; pg8::StaticOrder S; S.init(M, D, C.G, (int)blockIdx.x);
            EpiRes E{xin, xo, xb, ssq, scale, dry && DUP_SKIP_EPI};
            pg8::gemm_phase<EpiRes, pg8::StaticOrder, false, true>(C.lds, g, S, E);
        } break;
        case PH_RNN_IN: {
            pg8::Gemm g{xb, (const bf16*)(ws + WS_WRIN), M, 2 * DRNN, D}; pg8::StaticOrder S; S.init(M, 2 * DRNN, C.G, (int)blockIdx.x);
            fill_rstd(C.lds, S, ssq, C.tid);
            EpiRnnIn E{(const LAS float*)(C.lds + RSTD_OFF), (bf16*)(ws + WS_G), (bf16*)(ws + WS_U)};
            pg8::gemm_phase<EpiRnnIn, pg8::StaticOrder, true, true>(C.lds, g, S, E);
        } break;
        case PH_RNN_MID: p_rnn_mid(C, args); break;
        case PH_QKV: {
            pg8::Gemm g{xb, (const bf16*)(ws + WS_WQKV), M, NQKV, D}; pg8::StaticOrder S; S.init(M, NQKV, C.G, (int)blockIdx.x);
            if (C.tid < 128) ((LAS float*)(C.lds + GAIN_OFF))[C.tid] = (C.tid < 64) ? args.in[I_QGAIN][C.tid] * (0.125f * LOG2E) : args.in[I_KGAIN][C.tid - 64];
            fill_rstd(C.lds, S, ssq, C.tid);
            EpiQKV E{(const LAS float*)(C.lds + RSTD_OFF), (const LAS float*)(C.lds + GAIN_OFF), (bf16*)(ws + WS_QKV), dry && DUP_SKIP_EPI};
            pg8::gemm_phase<EpiQKV, pg8::StaticOrder, true, true>(C.lds, g, S, E);
        } break;
        case PH_ATTN: p_attn(C, dry); break;
        case PH_MERGE: p_merge(C, args); break;
        default: break;
        }
        if (dry || ph + 1 < args.ph_hi) xcd_barrier(bar);
        if (ph == 0 && !dry) for (int eb = 0; eb < DUP_EXTRA_BARRIERS; ++eb) xcd_barrier(bar);
        }
    }
}

extern "C" void kernel_launch(void* const* d_in, const int* in_sizes, int n_in, void* d_out, int out_size, void* d_ws, size_t ws_size, hipStream_t stream) {
    static int grid = 0;
    if (grid == 0) {
        if (n_in != 18 || in_sizes[0] != M * D || out_size != M * D || ws_size < WS_END) { fprintf(stderr, "kernel_launch: unexpected shapes (n_in %d, in0 %d, out %d, ws %zu)\n", n_in, n_in > 0 ? in_sizes[0] : -1, out_size, ws_size); grid = -1; return; }
        int dev = 0, cus = 0, per_cu = 0;
        if (hipGetDevice(&dev) != hipSuccess || hipDeviceGetAttribute(&cus, hipDeviceAttributeMultiprocessorCount, dev) != hipSuccess) { fprintf(stderr, "kernel_launch: device query failed\n"); grid = -1; return; }
        if (hipFuncSetAttribute((const void*)fwd_kernel, hipFuncAttributeMaxDynamicSharedMemorySize, LDS_BYTES) != hipSuccess) { fprintf(stderr, "kernel_launch: hipFuncSetAttribute failed\n"); grid = -1; return; }
        if (hipOccupancyMaxActiveBlocksPerMultiprocessor(&per_cu, (const void*)fwd_kernel, NWAVES * 64, LDS_BYTES) != hipSuccess || per_cu < 1) { fprintf(stderr, "kernel_launch: occupancy query says %d blocks per CU\n", per_cu); (void)hipGetLastError(); grid = -1; return; }
        grid = cus;
    }
    if (grid < 0) return;
    if (hipMemsetAsync(d_ws, 0, CTL_ZERO_BYTES, stream) != hipSuccess) { fprintf(stderr, "kernel_launch: memset failed\n"); return; }
    Args a{};
    for (int i = 0; i < 18; ++i) a.in[i] = (const float*)d_in[i];
    a.out = (float*)d_out; a.ws = (unsigned char*)d_ws;
#if SINGLE_LAUNCH
    a.ph_lo = 0; a.ph_hi = NPHASE;
    hipLaunchKernelGGL(fwd_kernel, dim3(grid), dim3(NWAVES * 64), LDS_BYTES, stream, a);
#else
    for (int ph = 0; ph < NPHASE; ++ph) { a.ph_lo = ph; a.ph_hi = ph + 1; hipLaunchKernelGGL(fwd_kernel, dim3(grid), dim3(NWAVES * 64), LDS_BYTES, stream, a); }
#endif
}
```

```cpp
#include <hip/hip_runtime.h>
#include <cstdio>
#include <cstdint>

#ifndef SINGLE_LAUNCH
#define SINGLE_LAUNCH 1
#define DUP_MASK 0u
#define DUP_N 1
#define DUP_EXTRA_BARRIERS 0
#define DUP_SKIP_EPI 0
#endif

namespace pg8 {
#define PG8_LAS __attribute__((address_space(3)))
typedef unsigned short bf16_t;
typedef short bf16x8 __attribute__((ext_vector_type(8)));
typedef float f32x4 __attribute__((ext_vector_type(4)));
typedef unsigned u32x4 __attribute__((ext_vector_type(4)));
constexpr int BM = 256, BK = 64, HALF = 128, HTB = HALF * BK * 2, STAGE_BYTES = 8 * HTB, NXCD = 8, WGM = 8;

__host__ __device__ __forceinline__ int lds_byte(int r, int c) { return (r >> 3) * 1024 + (r & 7) * 128 + ((((c >> 3) ^ (r & 7)) & 7) << 4) + (c & 7) * 2; }
__host__ __device__ __forceinline__ void stage_rc(int b, int& R, int& C) { const int sidx = b / 1024, w = b % 1024, rowin = w / 128, pch = (w % 128) / 16; R = sidx * 8 + rowin; C = ((pch ^ rowin) & 7) * 8; }
__host__ __device__ __forceinline__ int perm32(int rho) { const int n = rho >> 4, i = rho & 15; return 8 * (i >> 2) + 4 * n + (i & 3); }

struct Unit { int pm, pn; };
struct Gemm { const bf16_t* A; const bf16_t* Bt; int M, N, K; };

struct StaticOrder {
    int nM, nN, nwg, G, c;
    __host__ __device__ void init(int M, int N, int G_, int c_) { nM = M / BM; nN = N / BM; nwg = nM * nN; G = G_; c = c_; }
    __host__ __device__ bool next(int i, Unit& u) const {
        const long L = (long)i * G + c; if (L >= nwg) return false;
        int wgid = (int)L; { const int q = nwg / NXCD, r = nwg % NXCD, xcd = wgid % NXCD, off = wgid / NXCD; wgid = (xcd < r ? xcd * (q + 1) : r * (q + 1) + (xcd - r) * q) + off; }
        const int nig = WGM * nN, gid = wgid / nig, fm = gid * WGM, gsz = (nM - fm) < WGM ? (nM - fm) : WGM;
        u.pm = fm + ((wgid % nig) % gsz); u.pn = (wgid % nig) / gsz; return true;
    }
    __device__ __forceinline__ void a_ready(const Unit&) const {}
    __device__ __forceinline__ void done(const Unit&) const {}
};

__device__ __forceinline__ unsigned cvt_pk_bf16(float lo, float hi) { unsigned r; asm volatile("v_cvt_pk_bf16_f32 %0, %1, %2" : "=v"(r) : "v"(lo), "v"(hi)); return r; }

template <class Epi, class Sched, bool ALIGN_EPI = false, bool SP2 = false>
__device__ __forceinline__ void gemm_phase(PG8_LAS unsigned char* lds, const Gemm g, const Sched& S, const Epi& E) {
    int tid_ = threadIdx.x; asm volatile("" : "+v"(tid_));
    const int tid = tid_, wid = __builtin_amdgcn_readfirstlane(tid >> 6), lane = tid & 63, wr = wid >> 2, wc = wid & 3, fr = lane & 15, fq = lane >> 4;
    const int K = g.K, nt = K / BK;
    unsigned voffA[2], voffB[2];
#pragma unroll
    for (int i = 0; i < 2; ++i) { int R, C; stage_rc(tid * 16 + i * 8192, R, C); const int Rb = Epi::PERM ? ((R & ~31) + perm32(R & 31)) : R;
        voffA[i] = (unsigned)(R * K + C) * 2u; voffB[i] = (unsigned)(Rb * K + C) * 2u; }
    const size_t kstep = (size_t)(BK * 2);
    const size_t hstep = (size_t)HALF * K * 2;
    const size_t tstep = 2 * hstep;
    const unsigned ldsw = (unsigned)wid * 1024u;
    const int aoff = lds_byte(wr * 64 + fr, fq * 8), boff = lds_byte(wc * 32 + fr, fq * 8);
#define PG8_SA(b, h) (((b) * 2 + (h)) * HTB)
#define PG8_SB(b, h) ((4 + (b) * 2 + (h)) * HTB)
#define PG8_STAGE(bufoff, gbase, voff) do { _Pragma("unroll") for (int _i = 0; _i < 2; ++_i) \
        __builtin_amdgcn_global_load_lds((const unsigned*)((const char*)(gbase) + (voff)[_i]), (PG8_LAS unsigned*)(lds + (bufoff) + ldsw + _i * 8192), 16, 0, 0); } while (0)
#define PG8_LDA(dst, b, h) do { _Pragma("unroll") for (int m = 0; m < 4; ++m) _Pragma("unroll") for (int k = 0; k < 2; ++k) dst[m][k] = *(const PG8_LAS bf16x8*)(lds + PG8_SA(b, h) + (aoff ^ (k * 64)) + m * 2048); } while (0)
#define PG8_LDB(dst, b, h) do { _Pragma("unroll") for (int n = 0; n < 2; ++n) _Pragma("unroll") for (int k = 0; k < 2; ++k) dst[n][k] = *(const PG8_LAS bf16x8*)(lds + PG8_SB(b, h) + (boff ^ (k * 64)) + n * 2048); } while (0)
#define PG8_MMA(ai, bj, At, Bt) do { __builtin_amdgcn_s_setprio(1); _Pragma("unroll") for (int m = 0; m < 4; ++m) _Pragma("unroll") for (int n = 0; n < 2; ++n) _Pragma("unroll") for (int k = 0; k < 2; ++k) \
        acc[ai][bj][m][n] = __builtin_amdgcn_mfma_f32_16x16x32_bf16(Bt[n][k], At[m][k], acc[ai][bj][m][n], 0, 0, 0); __builtin_amdgcn_s_setprio(0); } while (0)
#define PG8_WAIT_V(n) asm volatile("s_waitcnt vmcnt(" #n ")" ::: "memory")
#define PG8_WAIT_L(n) asm volatile("s_waitcnt lgkmcnt(" #n ")" ::: "memory")
#define PG8_BAR __builtin_amdgcn_s_barrier()
#define PG8_SCHED __builtin_amdgcn_sched_barrier(0)
    Unit cur, nxt; int ui = 0;
    if (!S.next(0, cur)) return;
    f32x4 acc[2][2][4][2];
#pragma unroll
    for (int a = 0; a < 2; ++a)
#pragma unroll
        for (int b = 0; b < 2; ++b)
#pragma unroll
            for (int m = 0; m < 4; ++m)
#pragma unroll
                for (int n = 0; n < 2; ++n) acc[a][b][m][n] = (f32x4){0.f, 0.f, 0.f, 0.f};
    bf16x8 At[4][2], B0[2][2], B1[2][2];
    const char* cA = (const char*)g.A + (size_t)cur.pm * tstep; const char* cB = (const char*)g.Bt + (size_t)cur.pn * tstep;
    S.a_ready(cur);
    if constexpr (SP2) {
        PG8_STAGE(PG8_SB(0, 0), cB, voffB); PG8_STAGE(PG8_SB(0, 1), cB + hstep, voffB); PG8_STAGE(PG8_SA(0, 0), cA, voffA); PG8_STAGE(PG8_SA(0, 1), cA + hstep, voffA);
        if (wr == 1) PG8_BAR;
        PG8_WAIT_V(2); PG8_BAR;
        PG8_STAGE(PG8_SB(1, 0), cB + kstep, voffB); PG8_STAGE(PG8_SA(1, 0), cA + kstep, voffA); PG8_STAGE(PG8_SB(1, 1), cB + hstep + kstep, voffB);
        PG8_WAIT_V(6); PG8_BAR;
    } else {
        PG8_STAGE(PG8_SB(0, 0), cB, voffB); PG8_STAGE(PG8_SA(0, 0), cA, voffA); PG8_STAGE(PG8_SB(0, 1), cB + hstep, voffB); PG8_STAGE(PG8_SA(0, 1), cA + hstep, voffA);
        if (wr == 1) PG8_BAR;
        PG8_WAIT_V(4); PG8_BAR;
        PG8_STAGE(PG8_SB(1, 0), cB + kstep, voffB); PG8_STAGE(PG8_SA(1, 0), cA + kstep, voffA); PG8_STAGE(PG8_SB(1, 1), cB + hstep + kstep, voffB);
        PG8_WAIT_V(6); PG8_BAR;
    }
    for (;;) {
        const bool has_next = S.next(ui + 1, nxt);
        const char* nA = has_next ? (const char*)g.A + (size_t)nxt.pm * tstep : cA; const char* nB = has_next ? (const char*)g.Bt + (size_t)nxt.pn * tstep : cB;
        for (int t = 0; t < nt; t += 2) {
            const bool last = (t == nt - 2);
            const char* a1 = cA + (size_t)(t + 1) * kstep;
            const char* a2 = last ? nA : cA + (size_t)(t + 2) * kstep; const char* b2 = last ? nB : cB + (size_t)(t + 2) * kstep;
            const char* a3 = a2 + kstep; const char* b3 = b2 + kstep;
            if (last && has_next) S.a_ready(nxt);
            if constexpr (SP2) {
            PG8_LDB(B0, 0, 0); PG8_LDB(B1, 0, 1); PG8_SCHED; PG8_LDA(At, 0, 0); PG8_STAGE(PG8_SA(1, 1), a1 + hstep, voffA);
            PG8_WAIT_V(8); PG8_WAIT_L(0); PG8_BAR; PG8_MMA(0, 0, At, B0); PG8_MMA(0, 1, At, B1); PG8_BAR; PG8_SCHED;
            PG8_LDA(At, 0, 1); PG8_STAGE(PG8_SB(0, 0), b2, voffB); PG8_STAGE(PG8_SB(0, 1), b2 + hstep, voffB); PG8_STAGE(PG8_SA(0, 0), a2, voffA);
            PG8_WAIT_V(8); PG8_WAIT_L(0); PG8_BAR; PG8_MMA(1, 0, At, B0); PG8_MMA(1, 1, At, B1); PG8_BAR; PG8_SCHED;
            PG8_LDB(B0, 1, 0); PG8_LDB(B1, 1, 1); PG8_SCHED; PG8_LDA(At, 1, 0); PG8_STAGE(PG8_SA(0, 1), a2 + hstep, voffA);
            PG8_WAIT_V(8); PG8_WAIT_L(0); PG8_BAR; PG8_MMA(0, 0, At, B0); PG8_MMA(0, 1, At, B1); PG8_BAR; PG8_SCHED;
            PG8_LDA(At, 1, 1); PG8_STAGE(PG8_SB(1, 0), b3, voffB); PG8_STAGE(PG8_SB(1, 1), b3 + hstep, voffB); PG8_STAGE(PG8_SA(1, 0), a3, voffA);
            PG8_WAIT_V(8); PG8_WAIT_L(0); PG8_BAR; PG8_MMA(1, 0, At, B0); PG8_MMA(1, 1, At, B1); PG8_BAR; PG8_SCHED;
            } else {
            PG8_LDB(B0, 0, 0); PG8_SCHED; PG8_LDA(At, 0, 0); PG8_STAGE(PG8_SA(1, 1), a1 + hstep, voffA);
            PG8_WAIT_L(8); PG8_BAR; PG8_WAIT_L(0); PG8_MMA(0, 0, At, B0); PG8_BAR; PG8_SCHED;
            PG8_LDB(B1, 0, 1); PG8_STAGE(PG8_SB(0, 0), b2, voffB);
            PG8_BAR; PG8_WAIT_L(0); PG8_MMA(0, 1, At, B1); PG8_BAR;
            PG8_LDA(At, 0, 1); PG8_STAGE(PG8_SA(0, 0), a2, voffA);
            PG8_BAR; PG8_WAIT_L(0); PG8_MMA(1, 0, At, B0); PG8_BAR; PG8_SCHED;
            PG8_STAGE(PG8_SB(0, 1), b2 + hstep, voffB);
            PG8_WAIT_V(6); PG8_BAR; PG8_MMA(1, 1, At, B1); PG8_BAR;
            PG8_LDB(B0, 1, 0); PG8_SCHED; PG8_LDA(At, 1, 0); PG8_STAGE(PG8_SA(0, 1), a2 + hstep, voffA);
            PG8_WAIT_L(8); PG8_BAR; PG8_WAIT_L(0); PG8_MMA(0, 0, At, B0); PG8_BAR; PG8_SCHED;
            PG8_LDB(B1, 1, 1); PG8_STAGE(PG8_SB(1, 0), b3, voffB);
            PG8_BAR; PG8_WAIT_L(0); PG8_MMA(0, 1, At, B1); PG8_BAR;
            PG8_LDA(At, 1, 1); PG8_STAGE(PG8_SA(1, 0), a3, voffA);
            PG8_BAR; PG8_WAIT_L(0); PG8_MMA(1, 0, At, B0); PG8_BAR; PG8_SCHED;
            PG8_STAGE(PG8_SB(1, 1), b3 + hstep, voffB);
            PG8_WAIT_V(6); PG8_BAR; PG8_MMA(1, 1, At, B1); PG8_BAR;
            }
        }
        if constexpr (ALIGN_EPI) { if (wr == 0) PG8_BAR; }
        E(acc, cur, ui, wr, wc, fr, fq); S.done(cur);
        if (!has_next) break;
#pragma unroll
        for (int a = 0; a < 2; ++a)
#pragma unroll
            for (int b = 0; b < 2; ++b)
#pragma unroll
                for (int m = 0; m < 4; ++m)
#pragma unroll
                    for (int n = 0; n < 2; ++n) acc[a][b][m][n] = (f32x4){0.f, 0.f, 0.f, 0.f};
        cur = nxt; cA = nA; cB = nB; ++ui;
        if constexpr (ALIGN_EPI) { if (wr == 1) PG8_BAR; }
    }
    PG8_WAIT_V(0);
    if constexpr (!ALIGN_EPI) { if (wr == 0) PG8_BAR; }
    PG8_BAR;
#undef PG8_SA
#undef PG8_SB
#undef PG8_STAGE
#undef PG8_LDA
#undef PG8_LDB
#undef PG8_MMA
#undef PG8_WAIT_V
#undef PG8_WAIT_L
#undef PG8_BAR
#undef PG8_SCHED
}
}

constexpr int BATCH = 8, SEQ = 2048, D = 1024, M = BATCH * SEQ;
constexpr int FF = 2816, DRNN = 1280, NBLK = 10, RBLK = 128, CONVW = 4;
constexpr int NHEAD = 16, HD = 64, NGRP = 3, NQKV = 9216;
constexpr float RMS_EPS = 1e-6f;
constexpr float LOG2E = 1.4426950408889634f;
constexpr int NWAVES = 8;

typedef unsigned short bf16;
typedef unsigned v4u __attribute__((ext_vector_type(4)));
typedef unsigned v2u __attribute__((ext_vector_type(2)));
typedef float f32x4 __attribute__((ext_vector_type(4)));
#define GAS __attribute__((address_space(1)))
#define LAS __attribute__((address_space(3)))
typedef GAS unsigned gu32;
#define RLX_AGENT __ATOMIC_RELAXED, __HIP_MEMORY_SCOPE_AGENT
#define LDS_WAIT() asm volatile("s_waitcnt lgkmcnt(0)" ::: "memory")

#ifndef RESID_BF16
#define RESID_BF16 1
#endif
constexpr size_t MiB = 1u << 20;
constexpr size_t WS_CTL = 0, CTL_ZERO_BYTES = 1 * MiB;
constexpr size_t WS_SSQ = 1 * MiB;
constexpr size_t WS_BIAS = 2 * MiB;
constexpr size_t WS_XB = 3 * MiB;
constexpr size_t WS_WO = 35 * MiB;
constexpr size_t WS_WQKV = 37 * MiB;
constexpr size_t WS_QKV = 55 * MiB;
constexpr size_t QKV_SLAB = (size_t)M * 1024 * 2;
constexpr size_t WS_LSE = 343 * MiB;
constexpr size_t WS_END = 352 * MiB;
constexpr size_t WS_WIN0 = 55 * MiB, WS_WOUT0 = 66 * MiB, WS_WIN1 = 72 * MiB, WS_WOUT1 = 83 * MiB, WS_WIN2 = 89 * MiB, WS_WOUT2 = 100 * MiB;
constexpr size_t WS_WRIN = 106 * MiB, WS_WROUT = 111 * MiB, WS_WA = 114 * MiB, WS_WX = 114 * MiB + 512 * 1024;
constexpr size_t WS_ACT = 115 * MiB;
constexpr size_t WS_G = 203 * MiB, WS_U = 243 * MiB, WS_Y = 283 * MiB;
constexpr size_t WS_ATT = WS_QKV + 3 * QKV_SLAB;
constexpr size_t WS_WOUT3 = 346 * MiB;
constexpr size_t WS_ACT3 = WS_QKV;
static_assert(WS_Y + (size_t)M * DRNN * 2 <= WS_LSE && WS_ACT + (size_t)M * FF * 2 <= WS_G && WS_WX + 327680 <= WS_ACT, "ws map");
static_assert(WS_QKV + 9 * QKV_SLAB == WS_LSE && WS_LSE + (size_t)3 * M * 16 * 4 <= WS_WOUT3 && WS_WOUT3 + (size_t)D * FF * 2 <= WS_END && RESID_BF16 == 1, "ws map");
constexpr int CW_BAR = 4096;

constexpr int RING_BYTES = 131072, LDSCTL_OFF = RING_BYTES, MISC_OFF = LDSCTL_OFF + 320;
constexpr int RSTD_OFF = RING_BYTES + 1024, RSTD_MAX_UNITS = 9, GAIN_OFF = RSTD_OFF + RSTD_MAX_UNITS * 256 * 4;
constexpr int LDS_BYTES = 147456;
static_assert(GAIN_OFF + 512 <= LDS_BYTES, "LDS map");

#define XB_TMO      128
#define XB_XCNT(j)  (256  + 64 * (j))
#define XB_XSUB(j)  (1280 + 64 * (j))
#define XB_XGEN(j)  (2304 + 64 * (j))
#define XB_TOP      3328
#define XB_TOPGEN   3392
#define XCD_BAR_WORDS 3456
#define XB_SPIN_CAP (1u << 18)
__device__ __forceinline__ unsigned xb_ld(unsigned* p)              { return __hip_atomic_load(p, __ATOMIC_RELAXED, __HIP_MEMORY_SCOPE_AGENT); }
__device__ __forceinline__ unsigned xb_add(unsigned* p, unsigned v) { return __hip_atomic_fetch_add(p, v, __ATOMIC_RELAXED, __HIP_MEMORY_SCOPE_AGENT); }
__device__ __forceinline__ unsigned xb_xcc_id() { return (unsigned)__builtin_amdgcn_s_getreg((3 << 11) | 20) & 0xFu; }
#define XB_SPIN(cond, bar) do { unsigned _sp = 0; while (cond) { __builtin_amdgcn_s_sleep(1); \
    if ((++_sp & 255u) == 0u) { if (xb_ld(&(bar)[XB_TMO])) break; if (_sp > XB_SPIN_CAP) { atomicAdd(&(bar)[XB_TMO], 1u); break; } } } } while (0)
struct XcdBarrier { unsigned* bar; unsigned x; volatile LAS unsigned* st; };
__device__ __forceinline__ XcdBarrier xcd_barrier_post(unsigned* bar, volatile LAS unsigned* st) {
    XcdBarrier b; b.bar = bar; b.x = xb_xcc_id(); b.st = st;
    if (threadIdx.x == 0) (void)xb_add(&bar[XB_XCNT(b.x)], 1u);
    return b;
}
__device__ __forceinline__ void xcd_barrier_complete(unsigned* bar, unsigned x, unsigned& nloc, unsigned& nx) {
    const unsigned G = gridDim.x * gridDim.y * gridDim.z;
    unsigned sum, cnt, mine, sp = 0u;
    for (;;) {
        sum = 0u; cnt = 0u; mine = 0u;
#pragma unroll
        for (unsigned j = 0; j < 16; ++j) { const unsigned c = xb_ld(&bar[XB_XCNT(j)]); sum += c; cnt += (c > 0u) ? 1u : 0u; mine = (j == x) ? c : mine; }
        if (sum == G) break;
        __builtin_amdgcn_s_sleep(1);
        if ((++sp & 255u) == 0u) { if (xb_ld(&bar[XB_TMO])) break; if (sp > XB_SPIN_CAP) { atomicAdd(&bar[XB_TMO], 1u); break; } }
    }
    nloc = mine > 0u ? mine : 1u; nx = cnt > 0u ? cnt : 1u;
}
__device__ __forceinline__ void xcd_barrier(const XcdBarrier& b) {
    asm volatile("s_waitcnt vmcnt(0)" ::: "memory");
    __syncthreads();
    if (threadIdx.x == 0) {
        unsigned* bar = b.bar;
        __builtin_amdgcn_s_waitcnt(0);
        unsigned nloc = b.st[0], nx = b.st[1];
        if (nloc == 0u) { xcd_barrier_complete(bar, b.x, nloc, nx); b.st[0] = nloc; b.st[1] = nx; }
        const unsigned old = xb_add(&bar[XB_XSUB(b.x)], 1u);
        const unsigned gen = old / nloc;
        if (old + 1u == (gen + 1u) * nloc) {
            __builtin_amdgcn_fence(__ATOMIC_RELEASE, "agent");
            asm volatile("s_waitcnt vmcnt(0)" ::: "memory");
            const unsigned og = xb_add(&bar[XB_TOP], 1u);
            const unsigned tg = og / nx;
            if (og + 1u == (tg + 1u) * nx) xb_add(&bar[XB_TOPGEN], 1u);
            else XB_SPIN(xb_ld(&bar[XB_TOPGEN]) == tg, bar);
            __builtin_amdgcn_fence(__ATOMIC_ACQUIRE, "agent");
            xb_add(&bar[XB_XGEN(b.x)], 1u);
            asm volatile("s_waitcnt vmcnt(0)" ::: "memory");
        } else {
            XB_SPIN(xb_ld(&bar[XB_XGEN(b.x)]) == gen, bar);
            __builtin_amdgcn_fence(__ATOMIC_ACQUIRE, "agent");
            asm volatile("s_waitcnt vmcnt(0)" ::: "memory");
        }
    }
    __syncthreads();
}

__device__ __forceinline__ unsigned f2bf(float f) { unsigned u = __builtin_bit_cast(unsigned, f); return (u + 0x7fffu + ((u >> 16) & 1u)) >> 16; }
__device__ __forceinline__ unsigned pk2(float lo, float hi) { return f2bf(lo) | (f2bf(hi) << 16); }
__device__ __forceinline__ float bf_lo(unsigned w) { return __builtin_bit_cast(float, w << 16); }
__device__ __forceinline__ float bf_hi(unsigned w) { return __builtin_bit_cast(float, w & 0xffff0000u); }
__device__ __forceinline__ float bf2f(bf16 v) { return __builtin_bit_cast(float, (unsigned)v << 16); }
__device__ __forceinline__ float wave_sum(float v) {
#pragma unroll
    for (int o = 1; o < 64; o <<= 1) v += __shfl_xor(v, o);
    return v;
}
__device__ __forceinline__ float fast_sigmoid(float x) { return __builtin_amdgcn_rcpf(1.f + __builtin_amdgcn_exp2f(-LOG2E * x)); }
__device__ __forceinline__ float row_rstd(const float* ssq, int row) {
    const f32x4* p = (const f32x4*)(ssq + (size_t)row * 16); const f32x4 a = p[0], b = p[1], c = p[2], d = p[3];
    const float s = ((a.x + a.y) + (a.z + a.w)) + ((b.x + b.y) + (b.z + b.w)) + ((c.x + c.y) + (c.z + c.w)) + ((d.x + d.y) + (d.z + d.w));
    return rsqrtf(s * (1.0f / D) + RMS_EPS);
}

typedef float f32x2 __attribute__((ext_vector_type(2)));
template <class Sched> __device__ __forceinline__ void fill_rstd(LAS unsigned char* lds, const Sched& S, const float* ssq, int tid) {
    LAS float* rt = (LAS float*)(lds + RSTD_OFF); pg8::Unit u;
    for (int i = 0; i < RSTD_MAX_UNITS && S.next(i, u); ++i)
        if ((tid >> 8) == (i & 1)) { const int r = tid & 255; rt[i * 256 + r] = row_rstd(ssq, u.pm * 256 + r); }
    __syncthreads();
}
using pg8::Unit;
__device__ __forceinline__ f32x2 silu_mul_pk(f32x2 g, f32x2 up) {
    const f32x2 t = g * (-LOG2E); f32x2 e; e.x = __builtin_amdgcn_exp2f(t.x); e.y = __builtin_amdgcn_exp2f(t.y);
    const f32x2 d = e + 1.0f; f32x2 r; r.x = __builtin_amdgcn_rcpf(d.x); r.y = __builtin_amdgcn_rcpf(d.y);
    return (g * r) * up;
}
struct EpiSwiGLU {
    static constexpr bool PERM = true;
    const LAS float* rtab; bf16* act; int skip;
    __device__ __forceinline__ void operator()(const f32x4 (&acc)[2][2][4][2], const Unit& u, int ui, int wr, int wc, int fr, int fq) const {
        if (skip == 1) return;
#pragma unroll
        for (int ai = 0; ai < 2; ++ai)
#pragma unroll
            for (int m = 0; m < 4; ++m) {
                const int rl = ai * 128 + wr * 64 + m * 16 + fr, row = u.pm * 256 + rl;
                const float rs = rtab[ui * 256 + rl];
                f32x2 v[4];
#pragma unroll
                for (int n = 0; n < 2; ++n)
#pragma unroll
                    for (int e = 0; e < 2; ++e) { const f32x2 g = (f32x2){acc[ai][0][m][n][2 * e], acc[ai][0][m][n][2 * e + 1]} * rs, up = (f32x2){acc[ai][1][m][n][2 * e], acc[ai][1][m][n][2 * e + 1]} * rs;
                        v[n * 2 + e] = silu_mul_pk(g, up); }
                v4u w; w.x = pg8::cvt_pk_bf16(v[0].x, v[0].y); w.y = pg8::cvt_pk_bf16(v[1].x, v[1].y); w.z = pg8::cvt_pk_bf16(v[2].x, v[2].y); w.w = pg8::cvt_pk_bf16(v[3].x, v[3].y);
                if (skip != 2 || w.x == 0x7fc17fc1u) *(v4u*)(act + (size_t)row * FF + u.pn * 128 + wc * 32 + 8 * fq) = w;
            }
    }
};
#ifndef RESID_BF16
#define RESID_BF16 1
#endif
struct EpiRes {
    static constexpr bool PERM = true;
    const float* xin; float* xout; bf16* xb; float* ssq; float scale; bool skip;
    __device__ __forceinline__ void operator()(const f32x4 (&acc)[2][2][4][2], const Unit& u, int ui, int wr, int wc, int fr, int fq) const {
        if (skip) return;
        if (xin) run<true>(acc, u, wr, wc, fr, fq); else run<false>(acc, u, wr, wc, fr, fq);
    }
    template <bool F32IN> __device__ __forceinline__ void run(const f32x4 (&acc)[2][2][4][2], const Unit& u, int wr, int wc, int fr, int fq) const {
#pragma unroll
        for (int ai = 0; ai < 2; ++ai) {
            f32x4 xv[4][2][2];
#pragma unroll
            for (int m = 0; m < 4; ++m)
#pragma unroll
                for (int bj = 0; bj < 2; ++bj) { const size_t off = (size_t)(u.pm * 256 + ai * 128 + wr * 64 + m * 16 + fr) * D + u.pn * 256 + bj * 128 + wc * 32 + 8 * fq;
                    if (F32IN) { xv[m][bj][0] = *(const f32x4*)(xin + off); xv[m][bj][1] = *(const f32x4*)(xin + off + 4); }
                    else { const v4u w = *(const v4u*)(xb + off); xv[m][bj][0] = (f32x4){bf_lo(w.x), bf_hi(w.x), bf_lo(w.y), bf_hi(w.y)}; xv[m][bj][1] = (f32x4){bf_lo(w.z), bf_hi(w.z), bf_lo(w.w), bf_hi(w.w)}; } }
#pragma unroll
            for (int m = 0; m < 4; ++m) {
                const int row = u.pm * 256 + ai * 128 + wr * 64 + m * 16 + fr;
                float ss = 0.f;
#pragma unroll
                for (int bj = 0; bj < 2; ++bj) {
                    const size_t off = (size_t)row * D + u.pn * 256 + bj * 128 + wc * 32 + 8 * fq;
                    const f32x4 y0 = xv[m][bj][0] + acc[ai][bj][m][0] * scale, y1 = xv[m][bj][1] + acc[ai][bj][m][1] * scale;
                    if (xout) { *(f32x4*)(xout + off) = y0; *(f32x4*)(xout + off + 4) = y1; }
                    v4u w; w.x = pg8::cvt_pk_bf16(y0[0], y0[1]); w.y = pg8::cvt_pk_bf16(y0[2], y0[3]); w.z = pg8::cvt_pk_bf16(y1[0], y1[1]); w.w = pg8::cvt_pk_bf16(y1[2], y1[3]);
                    *(v4u*)(xb + off) = w;
                    ss += (y0[0] * y0[0] + y0[1] * y0[1]) + (y0[2] * y0[2] + y0[3] * y0[3]) + (y1[0] * y1[0] + y1[1] * y1[1]) + (y1[2] * y1[2] + y1[3] * y1[3]);
                }
                ss += __shfl_xor(ss, 16); ss += __shfl_xor(ss, 32);
                if (fq == 0) ssq[(size_t)row * 16 + u.pn * 4 + wc] = ss;
            }
            asm volatile("" ::: "memory");
        }
    }
};
struct EpiRnnIn {
    static constexpr bool PERM = true;
    const LAS float* rtab; bf16* Gb; bf16* Ub;
    template <bool GATE> __device__ __forceinline__ void run(const f32x4 (&acc)[2][2][4][2], const Unit& u, int ui, int wr, int wc, int fr, int fq, bf16* dstb, int pc) const {
#pragma unroll
        for (int ai = 0; ai < 2; ++ai)
#pragma unroll
            for (int m = 0; m < 4; ++m) {
                const int rl = ai * 128 + wr * 64 + m * 16 + fr, row = u.pm * 256 + rl;
                const float rs = rtab[ui * 256 + rl];
#pragma unroll
                for (int bj = 0; bj < 2; ++bj) {
                    f32x2 v[4];
#pragma unroll
                    for (int n = 0; n < 2; ++n)
#pragma unroll
                        for (int e = 0; e < 2; ++e) { f32x2 x = (f32x2){acc[ai][bj][m][n][2 * e], acc[ai][bj][m][n][2 * e + 1]} * rs;
                            if (GATE) {
                                const f32x2 t = (x * x * 0.044715f + 1.0f) * x * (-1.5957691216057308f * LOG2E); f32x2 ex; ex.x = __builtin_amdgcn_exp2f(t.x); ex.y = __builtin_amdgcn_exp2f(t.y);
                                const f32x2 d = ex + 1.0f; f32x2 r; r.x = __builtin_amdgcn_rcpf(d.x); r.y = __builtin_amdgcn_rcpf(d.y); x = x * r; }
                            v[n * 2 + e] = x; }
                    v4u w; w.x = pg8::cvt_pk_bf16(v[0].x, v[0].y); w.y = pg8::cvt_pk_bf16(v[1].x, v[1].y); w.z = pg8::cvt_pk_bf16(v[2].x, v[2].y); w.w = pg8::cvt_pk_bf16(v[3].x, v[3].y);
                    *(v4u*)(dstb + (size_t)row * DRNN + pc * 256 + bj * 128 + wc * 32 + 8 * fq) = w;
                }
            }
    }
    __device__ __forceinline__ void operator()(const f32x4 (&acc)[2][2][4][2], const Unit& u, int ui, int wr, int wc, int fr, int fq) const {
        if (u.pn < 5) run<true>(acc, u, ui, wr, wc, fr, fq, Gb, u.pn); else run<false>(acc, u, ui, wr, wc, fr, fq, Ub, u.pn - 5);
    }
};
struct EpiQKV {
    static constexpr bool PERM = true;
    const LAS float* rtab; const LAS float* gtab; bf16* qkv; bool skip;
    __device__ __forceinline__ void operator()(const f32x4 (&acc)[2][2][4][2], const Unit& u, int ui, int wr, int wc, int fr, int fq) const {
        if (skip) return;
        const int hs = u.pn * 4 + wc, kind = hs / 48, gh = hs - kind * 48, g = gh >> 4, h = gh & 15, l2d = 2 * g;
        bf16* slab = qkv + (size_t)(kind * 3 + g) * ((size_t)M * 1024);
        f32x4 gv[2][2];
#pragma unroll
        for (int bj = 0; bj < 2; ++bj)
#pragma unroll
            for (int n = 0; n < 2; ++n) { gv[bj][n] = (f32x4){1.f, 1.f, 1.f, 1.f}; if (kind < 2) gv[bj][n] = *(const LAS f32x4*)(gtab + kind * 64 + 32 * bj + 8 * fq + 4 * n); }
#pragma unroll
        for (int ai = 0; ai < 2; ++ai)
#pragma unroll
            for (int m = 0; m < 4; ++m) {
                const int rl = ai * 128 + wr * 64 + m * 16 + fr, row = u.pm * 256 + rl;
                const float rs = rtab[ui * 256 + rl];
                f32x4 v[2][2]; float ss = 0.f;
#pragma unroll
                for (int bj = 0; bj < 2; ++bj)
#pragma unroll
                    for (int n = 0; n < 2; ++n) { v[bj][n] = acc[ai][bj][m][n] * rs; const f32x4 t = v[bj][n] * v[bj][n]; ss += (t[0] + t[1]) + (t[2] + t[3]); }
                float rn = 1.f;
                if (kind < 2) { ss += __shfl_xor(ss, 16); ss += __shfl_xor(ss, 32); rn = rsqrtf(ss * (1.0f / HD) + RMS_EPS); }
                const int b = row >> 11, t = row & 2047, rres = t & ((1 << l2d) - 1), l = t >> l2d, L = 2048 >> l2d;
                bf16* dst = slab + ((size_t)(b * 16 + h) * 2048 + rres * L + l) * 64 + 8 * fq;
#pragma unroll
                for (int bj = 0; bj < 2; ++bj) {
                    const f32x4 a0 = v[bj][0] * gv[bj][0] * rn, a1 = v[bj][1] * gv[bj][1] * rn;
                    v4u w; w.x = pg8::cvt_pk_bf16(a0[0], a0[1]); w.y = pg8::cvt_pk_bf16(a0[2], a0[3]); w.z = pg8::cvt_pk_bf16(a1[0], a1[1]); w.w = pg8::cvt_pk_bf16(a1[2], a1[3]);
                    *(v4u*)(dst + 32 * bj) = w;
                }
            }
    }
};

struct Args { const float* in[18]; float* out; unsigned char* ws; int ph_lo, ph_hi; };
enum { I_X = 0, I_NORMG, I_FFN_WIN, I_FFN_WOUT, I_RNN_WIN, I_CONV_W, I_CONV_B, I_WA, I_BA, I_WX, I_BX, I_LAM, I_RNN_WOUT, I_WQKV, I_QGAIN, I_KGAIN, I_WO, I_RELB };

struct Ctx { LAS unsigned char* lds; int tid, lane, wave, G, vcu; unsigned char* ws; };

typedef short v4i16_t __attribute__((ext_vector_type(4)));
__device__ __forceinline__ v4i16_t vtr16(const LAS unsigned char* p) { return __builtin_amdgcn_ds_read_tr16_b64_v4i16((LAS v4i16_t*)p); }
enum { CM_NONE = 0, CM_FFN = 1, CM_QKV = 2 };
__device__ __forceinline__ int colmap(int mode, int vr) {
    if (mode == CM_FFN) { const int pn = vr >> 8, w = vr & 255; return (w >> 7) * FF + 128 * pn + (w & 127); }
    if (mode == CM_QKV) { const int pn = vr >> 8, w = vr & 255, bj = w >> 7, wc = (w >> 5) & 3, j = w & 31; return 256 * pn + 64 * wc + 32 * bj + j; }
    return vr;
}
__device__ __forceinline__ void transpose_item(const float* W, int K, int N, const float* gvec, bf16* WT, int mode, LAS unsigned char* scr, int item, int lane) {
    const int nblk = N / 64, kb = item / nblk, nb = item - kb * nblk, k0 = 64 * kb, vr0 = 64 * nb;
    const int col4 = lane & 15, rsub = lane >> 4, nsrc = colmap(mode, vr0 + 32 * (col4 >> 3)) + (col4 & 7) * 4;
    const float* src = W + (size_t)(k0 + rsub) * N + nsrc;
    f32x4 w[16];
#pragma unroll
    for (int i = 0; i < 16; ++i) w[i] = *(const GAS f32x4*)(src + (size_t)(4 * i) * N);
    if (gvec) {
#pragma unroll
        for (int i = 0; i < 16; ++i) w[i] = w[i] * gvec[k0 + 4 * i + rsub];
    }
#pragma unroll
    for (int i = 0; i < 16; ++i) { v2u p; p.x = pg8::cvt_pk_bf16(w[i][0], w[i][1]); p.y = pg8::cvt_pk_bf16(w[i][2], w[i][3]);
        *(LAS v2u*)(scr + (col4 >> 3) * 4096 + (4 * i + rsub) * 64 + (col4 & 7) * 8) = p; }
    const int q = (lane & 15) >> 2, p4 = lane & 3, gidx = lane >> 4;
#pragma unroll
    for (int r = 0; r < 8; ++r) { const int nb16 = r >> 1, kh = r & 1, kbase = 32 * kh + 8 * gidx;
        const LAS unsigned char* a = scr + (nb16 >> 1) * 4096 + (kbase + q) * 64 + ((nb16 & 1) * 16 + 4 * p4) * 2;
        const v4i16_t lo = vtr16(a), hi = vtr16(a + 4 * 64);
        v4u o; { const v2u l2 = __builtin_bit_cast(v2u, lo), h2 = __builtin_bit_cast(v2u, hi); o.x = l2.x; o.y = l2.y; o.z = h2.x; o.w = h2.y; }
        *(GAS v4u*)(WT + (size_t)(vr0 + nb16 * 16 + (lane & 15)) * K + k0 + kbase) = o; }
}
struct MatJob { const float* W; int K, N; const float* g; bf16* WT; int mode; };
__device__ __forceinline__ MatJob mat_job(const Ctx& C, const Args& a, int idx) {
    unsigned char* ws = C.ws; const float* ng = a.in[I_NORMG]; MatJob j;
    switch (idx) {
    case 0: j = MatJob{a.in[I_FFN_WIN] + (size_t)0 * D * 2 * FF, D, 2 * FF, ng + 0 * D, (bf16*)(ws + WS_WIN0), CM_FFN}; break;
    case 1: j = MatJob{a.in[I_FFN_WOUT] + (size_t)0 * FF * D, FF, D, nullptr, (bf16*)(ws + WS_WOUT0), CM_NONE}; break;
    case 2: j = MatJob{a.in[I_RNN_WIN], D, 2 * DRNN, ng + 1 * D, (bf16*)(ws + WS_WRIN), CM_NONE}; break;
    case 3: j = MatJob{a.in[I_RNN_WOUT], DRNN, D, nullptr, (bf16*)(ws + WS_WROUT), CM_NONE}; break;
    case 4: j = MatJob{a.in[I_FFN_WIN] + (size_t)1 * D * 2 * FF, D, 2 * FF, ng + 2 * D, (bf16*)(ws + WS_WIN1), CM_FFN}; break;
    case 5: j = MatJob{a.in[I_FFN_WOUT] + (size_t)1 * FF * D, FF, D, nullptr, (bf16*)(ws + WS_WOUT1), CM_NONE}; break;
    case 6: j = MatJob{a.in[I_WQKV], D, NQKV, ng + 4 * D, (bf16*)(ws + WS_WQKV), CM_QKV}; break;
    case 7: j = MatJob{a.in[I_WO], D, D, nullptr, (bf16*)(ws + WS_WO), CM_NONE}; break;
    case 8: j = MatJob{a.in[I_FFN_WIN] + (size_t)2 * D * 2 * FF, D, 2 * FF, ng + 3 * D, (bf16*)(ws + WS_WIN2), CM_FFN}; break;
    case 9: j = MatJob{a.in[I_FFN_WOUT] + (size_t)2 * FF * D, FF, D, nullptr, (bf16*)(ws + WS_WOUT2), CM_NONE}; break;
    case 10: j = MatJob{a.in[I_FFN_WIN] + (size_t)3 * D * 2 * FF, D, 2 * FF, ng + 5 * D, (bf16*)a.out, CM_FFN}; break;
    default: j = MatJob{a.in[I_FFN_WOUT] + (size_t)3 * FF * D, FF, D, nullptr, (bf16*)(ws + WS_WOUT3), CM_NONE}; break;
    }
    return j;
}
__device__ __forceinline__ void convert_mats(const Ctx& C, const Args& a, int first, int last, int gw, int NGW) {
    LAS unsigned char* scr = C.lds + C.wave * 8192;
    int base = 0;
    for (int mi = first; mi < last; ++mi) {
        const MatJob j = mat_job(C, a, mi); const int cnt = (j.K / 64) * (j.N / 64);
        int it = (gw - base) % NGW; if (it < 0) it += NGW;
        for (; it < cnt; it += NGW) transpose_item(j.W, j.K, j.N, j.g, j.WT, j.mode, scr, it, C.lane);
        base += cnt;
    }
}
__device__ __forceinline__ void spare_convert(const Ctx& C, const Args& a, int first, int last, int nwg) {
    const int R = (nwg + C.G - 1) / C.G, first_spare = nwg - (R - 1) * C.G, nspare = C.G - first_spare, c = (int)blockIdx.x;
    if (nspare > 0) { if (c >= first_spare) convert_mats(C, a, first, last, (c - first_spare) * NWAVES + C.wave, nspare * NWAVES); }
    else convert_mats(C, a, first, last, c * NWAVES + C.wave, C.G * NWAVES);
    __syncthreads();
}
__device__ __forceinline__ int t5_bucket(int n) {
    if (n < 16) return n;
    int b = 16;
    b += (n >= 22) + (n >= 30) + (n >= 40) + (n >= 54) + (n >= 73) + (n >= 99) + (n >= 134) + (n >= 182) + (n >= 246) + (n >= 332) + (n >= 450) + (n >= 609) + (n >= 825) + (n >= 1117) + (n >= 1513);
    return b;
}
__device__ __forceinline__ void p_prologue(const Ctx& C, const Args& a) {
    const int gw = C.vcu * NWAVES + C.wave, NGW = C.G * NWAVES;
    convert_mats(C, a, 0, 1, gw, NGW);
    {   LAS unsigned char* scr = C.lds + C.wave * 8192;
        for (int it = gw; it < 2 * NBLK * 4; it += NGW) { const int which = it / (NBLK * 4), r = it % (NBLK * 4), blk = r >> 2, sub = r & 3;
            const float* W = (which ? a.in[I_WX] : a.in[I_WA]) + (size_t)blk * RBLK * RBLK; bf16* WT = (bf16*)(C.ws + (which ? WS_WX : WS_WA)) + (size_t)blk * RBLK * RBLK;
            transpose_item(W, RBLK, RBLK, nullptr, WT, CM_NONE, scr, sub, C.lane); } }
    const float* x = a.in[I_X]; bf16* xb = (bf16*)(C.ws + WS_XB); float* ssq = (float*)(C.ws + WS_SSQ);
    for (int m = gw; m < M; m += NGW) {
        const GAS f32x4* xr = (const GAS f32x4*)(x + (size_t)m * D) + C.lane; f32x4 v[4]; float s = 0.f;
#pragma unroll
        for (int j = 0; j < 4; ++j) { v[j] = xr[64 * j]; s += (v[j].x * v[j].x + v[j].y * v[j].y) + (v[j].z * v[j].z + v[j].w * v[j].w); }
        s = wave_sum(s);
        GAS v2u* o8 = (GAS v2u*)(xb + (size_t)m * D) + C.lane;
#pragma unroll
        for (int j = 0; j < 4; ++j) { v2u w; w.x = pk2(v[j].x, v[j].y); w.y = pk2(v[j].z, v[j].w); o8[64 * j] = w; }
        if (C.lane < 16) ssq[(size_t)m * 16 + C.lane] = (C.lane == 0) ? s : 0.f;
    }
    float* bt = (float*)(C.ws + WS_BIAS); const float* rb = a.in[I_RELB];
    for (int i = blockIdx.x * 512 + C.tid; i < 48 * 129; i += C.G * 512) { const int gh = i / 129, dist = i - gh * 129, g = gh >> 4;
        bt[gh * 132 + dist] = rb[t5_bucket(dist << (2 * g)) * 48 + gh] * LOG2E; }
}

typedef float f32x16 __attribute__((ext_vector_type(16)));
typedef short bf16x8v __attribute__((ext_vector_type(8)));
constexpr int RM_WB = 0, RM_WB_GATE = 64 * 272, RM_CW = 36864, RM_CMP = RM_CW + 2560, RM_TILE = 49152, RM_TILE_BYTES = 36 * 256, RM_END = RM_TILE + 8 * RM_TILE_BYTES;
static_assert(RM_WB + 2 * RM_WB_GATE <= RM_CW && RM_CMP + 2 * 2 * 8 * 64 * 4 <= RM_TILE && RM_END <= RING_BYTES, "rnn-mid LDS map");
__device__ __forceinline__ bf16x8v pack8(const float (&v)[8]) {
    v4u w; w.x = pg8::cvt_pk_bf16(v[0], v[1]); w.y = pg8::cvt_pk_bf16(v[2], v[3]); w.z = pg8::cvt_pk_bf16(v[4], v[5]); w.w = pg8::cvt_pk_bf16(v[6], v[7]);
    return __builtin_bit_cast(bf16x8v, w);
}
__device__ __forceinline__ void p_rnn_mid(const Ctx& C, const Args& a) {
    const bf16* U = (const bf16*)(C.ws + WS_U); const bf16* Gb = (const bf16*)(C.ws + WS_G); bf16* Y = (bf16*)(C.ws + WS_Y);
    const bf16* WAb = (const bf16*)(C.ws + WS_WA); const bf16* WXb = (const bf16*)(C.ws + WS_WX);
    LAS unsigned char* L = C.lds;
    LAS float* CW = (LAS float*)(L + RM_CW); LAS float* CMP = (LAS float*)(L + RM_CMP);
    const int wave = C.wave;
    LAS unsigned char* wt = L + RM_TILE + wave * RM_TILE_BYTES;
    for (int item = blockIdx.x; item < BATCH * NBLK * 2; item += C.G) {
        const int b = item / (NBLK * 2), n = (item % (NBLK * 2)) >> 1, half = item & 1;
        int tid = C.tid; asm volatile("" : "+v"(tid));
        const int lane = tid & 63, r32 = lane & 31, hh = lane >> 5;
        __syncthreads();
#pragma unroll
        for (int p = 0; p < 4; ++p) { const int idx = p * 512 + tid, gate = idx >> 10, rem = idx & 1023, row = rem >> 4, c16 = rem & 15;
            const v4u w = *(const v4u*)((gate ? WXb : WAb) + (size_t)(n * 128 + 64 * half + row) * 128 + c16 * 8);
            *(LAS v4u*)(L + RM_WB + gate * RM_WB_GATE + row * 272 + c16 * 16) = w; }
        CW[tid] = a.in[I_CONV_W][(tid >> 7) * DRNN + n * 128 + (tid & 127)];
        if (tid < 128) CW[512 + tid] = a.in[I_CONV_B][n * 128 + tid];
        __syncthreads();
        float ba[2], bx[2], spl[2], Ht[2];
#pragma unroll
        for (int cb = 0; cb < 2; ++cb) { const int ch = n * 128 + 64 * half + 32 * cb + r32; ba[cb] = a.in[I_BA][ch]; bx[cb] = a.in[I_BX][ch];
            spl[cb] = -8.0f * LOG2E * log1pf(expf(-a.in[I_LAM][ch])); Ht[cb] = 0.f; }
        bf16x8v idf[2];
#pragma unroll
        for (int sp = 0; sp < 2; ++sp)
#pragma unroll
            for (int j = 0; j < 8; ++j) idf[sp][j] = (16 * sp + 8 * hh + j == r32) ? (short)0x3F80 : (short)0;
        const int urow = lane >> 4, uch = lane & 15, grow = lane >> 3, gch = lane & 7;
        v4u uraw[9], graw[4];
#define RM_LOADU(TILE) do { const int tp_ = (TILE) * 256 + wave * 32; const int ub_ = (b * SEQ + tp_ - 3 + urow) * DRNN + n * 128 + uch * 8;        \
        _Pragma("unroll") for (int i_ = 0; i_ < 9; ++i_) uraw[i_] = *(const v4u*)(U + (ptrdiff_t)(ub_ + i_ * 4 * DRNN)); \
        if (tp_ == 0 && urow < 3) uraw[0] = (v4u){0u, 0u, 0u, 0u};         } while (0)
#define RM_LOADG(TILE) do { const int gb_ = (b * SEQ + (TILE) * 256 + wave * 32 + grow) * DRNN + n * 128 + 64 * half + gch * 8; \
        _Pragma("unroll") for (int i_ = 0; i_ < 4; ++i_) graw[i_] = *(const v4u*)(Gb + (unsigned)(gb_ + i_ * 8 * DRNN)); } while (0)
        for (int tile = 0; tile < 8; ++tile) {
            const int tposw = tile * 256 + wave * 32;
            const size_t tok0 = (size_t)b * SEQ + tposw;
            LAS float* CWt = CW; LAS unsigned char* WBt = L + RM_WB; asm volatile("" : "+v"(CWt), "+v"(WBt));
            RM_LOADU(tile); RM_LOADG(tile);
#pragma unroll
            for (int i = 0; i < 9; ++i) { const int rl = 4 * i + urow; *(LAS v4u*)(wt + rl * 256 + ((uch ^ (rl & 15)) << 4)) = uraw[i]; }
            {
                const int tg = lane >> 4, cc = lane & 15;
                f32x2 wv[4][4], bv2[4];
#pragma unroll
                for (int k = 0; k < 4; ++k) { const f32x4 w0 = *(const LAS f32x4*)(CWt + k * 128 + 8 * cc), w1 = *(const LAS f32x4*)(CWt + k * 128 + 8 * cc + 4);
                    wv[k][0] = (f32x2){w0[0], w0[1]}; wv[k][1] = (f32x2){w0[2], w0[3]}; wv[k][2] = (f32x2){w1[0], w1[1]}; wv[k][3] = (f32x2){w1[2], w1[3]}; }
                { const f32x4 b0 = *(const LAS f32x4*)(CWt + 512 + 8 * cc), b1 = *(const LAS f32x4*)(CWt + 512 + 8 * cc + 4);
                  bv2[0] = (f32x2){b0[0], b0[1]}; bv2[1] = (f32x2){b0[2], b0[3]}; bv2[2] = (f32x2){b1[0], b1[1]}; bv2[3] = (f32x2){b1[2], b1[3]}; }
                v4u ur[11];
#pragma unroll
                for (int j = 0; j < 11; ++j) { const int rl = 8 * tg + j; ur[j] = *(const LAS v4u*)(wt + rl * 256 + ((cc ^ (rl & 15)) << 4)); }
                f32x2 o[8][4];
#pragma unroll
                for (int i = 0; i < 8; ++i)
#pragma unroll
                    for (int e = 0; e < 4; ++e) o[i][e] = bv2[e];
#pragma unroll
                for (int j = 0; j < 11; ++j) {
                    const f32x2 u0 = (f32x2){bf_lo(ur[j].x), bf_hi(ur[j].x)}, u1 = (f32x2){bf_lo(ur[j].y), bf_hi(ur[j].y)}, u2 = (f32x2){bf_lo(ur[j].z), bf_hi(ur[j].z)}, u3 = (f32x2){bf_lo(ur[j].w), bf_hi(ur[j].w)};
#pragma unroll
                    for (int k = 0; k < 4; ++k) { const int i = j - k; if (i >= 0 && i < 8) {
                        o[i][0] += wv[k][0] * u0; o[i][1] += wv[k][1] * u1; o[i][2] += wv[k][2] * u2; o[i][3] += wv[k][3] * u3; } }
                }
#pragma unroll
                for (int i = 0; i < 8; ++i) { const int rl = 8 * tg + i;
                    v4u w; w.x = pg8::cvt_pk_bf16(o[i][0].x, o[i][0].y); w.y = pg8::cvt_pk_bf16(o[i][1].x, o[i][1].y); w.z = pg8::cvt_pk_bf16(o[i][2].x, o[i][2].y); w.w = pg8::cvt_pk_bf16(o[i][3].x, o[i][3].y);
                    *(LAS v4u*)(wt + rl * 256 + ((cc ^ (rl & 15)) << 4)) = w; }
            }
            bf16x8v af[8];
#pragma unroll
            for (int s = 0; s < 8; ++s) af[s] = *(const LAS bf16x8v*)(wt + r32 * 256 + (((2 * s + hh) ^ (r32 & 15)) << 4));
#pragma unroll
            for (int i = 0; i < 4; ++i) *(LAS v4u*)(wt + (8 * i + grow) * 128 + gch * 16) = graw[i];
            f32x16 acc[2][2], ufa[2];
#pragma unroll
            for (int cb = 0; cb < 2; ++cb)
#pragma unroll
                for (int e = 0; e < 16; ++e) { acc[0][cb][e] = 0.f; acc[1][cb][e] = 0.f; ufa[cb][e] = 0.f; }
            bf16x8v bq[2][4];
#define RM_LDB(S, DST) do { _Pragma("unroll") for (int g_ = 0; g_ < 2; ++g_) _Pragma("unroll") for (int c_ = 0; c_ < 2; ++c_) \
                DST[g_ * 2 + c_] = *(const LAS bf16x8v*)(WBt + g_ * RM_WB_GATE + (32 * c_ + r32) * 272 + (16 * (S) + 8 * hh) * 2); } while (0)
            RM_LDB(0, bq[0]);
#pragma unroll
            for (int s = 0; s < 8; ++s) {
                if (s < 7) RM_LDB(s + 1, bq[(s + 1) & 1]);
#pragma unroll
                for (int gt = 0; gt < 2; ++gt)
#pragma unroll
                    for (int cb = 0; cb < 2; ++cb) acc[gt][cb] = __builtin_amdgcn_mfma_f32_32x32x16_bf16(af[s], bq[s & 1][gt * 2 + cb], acc[gt][cb], 0, 0, 0);
            }
#undef RM_LDB
#pragma unroll
            for (int cb = 0; cb < 2; ++cb)
#pragma unroll
                for (int sp = 0; sp < 2; ++sp) { const bf16x8v asel = half ? af[4 + 2 * cb + sp] : af[2 * cb + sp];
                    ufa[cb] = __builtin_amdgcn_mfma_f32_32x32x16_bf16(asel, idf[sp], ufa[cb], 0, 0, 0); }
#pragma unroll
            for (int cb = 0; cb < 2; ++cb)
#pragma unroll
                for (int e = 0; e < 16; ++e) {
                    const float uf = ufa[cb][e];
                    const float r = fast_sigmoid(acc[0][cb][e] + ba[cb]), ii = fast_sigmoid(acc[1][cb][e] + bx[cb]);
                    const float av = __builtin_amdgcn_exp2f(r * spl[cb]);
                    const float bv = __builtin_amdgcn_sqrtf(fmaxf(1.f - av * av, 0.f)) * (ii * uf);
                    acc[0][cb][e] = av; acc[1][cb][e] = bv;
                }
            float A0[2][4], B0[2][4], A1[2][4], B1[2][4];
            const int par = tile & 1;
#pragma unroll
            for (int cb = 0; cb < 2; ++cb) {
                float Aw = 1.f, Bw = 0.f;
#pragma unroll
                for (int q = 0; q < 4; ++q) {
                    const float a0 = acc[0][cb][4 * q], a1 = acc[0][cb][4 * q + 1], a2 = acc[0][cb][4 * q + 2], a3 = acc[0][cb][4 * q + 3];
                    const float Ag = (a0 * a1) * (a2 * a3);
                    const float Bg = ((acc[1][cb][4 * q] * a1 + acc[1][cb][4 * q + 1]) * a2 + acc[1][cb][4 * q + 2]) * a3 + acc[1][cb][4 * q + 3];
                    const float pA = __shfl_xor(Ag, 32), pB = __shfl_xor(Bg, 32);
                    A0[cb][q] = hh ? pA : Ag; B0[cb][q] = hh ? pB : Bg; A1[cb][q] = hh ? Ag : pA; B1[cb][q] = hh ? Bg : pB;
                    Bw = Bw * A0[cb][q] + B0[cb][q]; Aw *= A0[cb][q]; Bw = Bw * A1[cb][q] + B1[cb][q]; Aw *= A1[cb][q];
                }
                if (hh == 0) { CMP[((par * 2 + 0) * 8 + wave) * 64 + 32 * cb + r32] = Aw; CMP[((par * 2 + 1) * 8 + wave) * 64 + 32 * cb + r32] = Bw; }
            }
            __syncthreads();
#pragma unroll
            for (int cb = 0; cb < 2; ++cb) {
                float h = Ht[cb], hin = 0.f;
#pragma unroll
                for (int v = 0; v < 8; ++v) { const float Av = CMP[((par * 2 + 0) * 8 + v) * 64 + 32 * cb + r32], Bv = CMP[((par * 2 + 1) * 8 + v) * 64 + 32 * cb + r32];
                    hin = (v == wave) ? h : hin; h = Av * h + Bv; }
                Ht[cb] = h;
                float hc = hin;
#pragma unroll
                for (int q = 0; q < 4; ++q) {
                    const float c0 = hc; hc = A0[cb][q] * hc + B0[cb][q]; const float c1 = hc; hc = A1[cb][q] * hc + B1[cb][q];
                    float hv = hh ? c1 : c0;
#pragma unroll
                    for (int i = 0; i < 4; ++i) { const int e = 4 * q + i; hv = acc[0][cb][e] * hv + acc[1][cb][e];
                        const int tl = (e & 3) + 8 * (e >> 2) + 4 * hh;
                        LAS bf16* gp = (LAS bf16*)(wt + tl * 128 + (32 * cb + r32) * 2);
                        *gp = (bf16)f2bf(hv * bf2f(*gp)); }
                }
            }
#pragma unroll
            for (int i = 0; i < 4; ++i) { const v4u w = *(const LAS v4u*)(wt + (8 * i + grow) * 128 + gch * 16);
                *(v4u*)(Y + (unsigned)(((int)tok0 + 8 * i + grow) * DRNN + n * 128 + 64 * half + gch * 8)) = w; }
        }
#undef RM_LOADU
#undef RM_LOADG
    }
    const int nitems = BATCH * NBLK * 2;
    if (C.G > nitems) { if ((int)blockIdx.x >= nitems) convert_mats(C, a, 4, 8, ((int)blockIdx.x - nitems) * NWAVES + wave, (C.G - nitems) * NWAVES); }
    else { __syncthreads(); convert_mats(C, a, 4, 8, (int)blockIdx.x * NWAVES + wave, C.G * NWAVES); }
}
constexpr int AT_EXT = 0, AT_VT = 48 * 192 * 4;
struct AttnUnit { bf16* qbase; const bf16* kres; const bf16* vres; int l0, kb_lo, eoff, g, bh, llin0; };
__device__ __forceinline__ AttnUnit attn_unit(bf16* QKV, int it, int wave) {
    AttnUnit u; const size_t SLAB = (size_t)M * 1024;
    const int g = it >> 10, rem = it & 1023, bh = rem >> 3, chunk = (rem + (it >> 8)) & 7, l2d = 2 * g, L = SEQ >> l2d;
    u.g = g; u.bh = bh; u.llin0 = chunk * 256 + wave * 32; u.l0 = u.llin0 & (L - 1); u.kb_lo = (u.l0 - 128) > 0 ? (u.l0 - 128) : 0; u.eoff = (g * 16 + (bh & 15)) * 192;
    u.qbase = QKV + (size_t)g * SLAB + ((size_t)bh * SEQ + u.llin0) * HD;
    u.kres = u.qbase + 3 * SLAB - (size_t)u.l0 * HD; u.vres = u.qbase + 6 * SLAB - (size_t)u.l0 * HD;
    return u;
}
__device__ __forceinline__ void p_attn(const Ctx& C, const bool dry) {
    bf16* QKV = (bf16*)(C.ws + WS_QKV); float* LSE = (float*)(C.ws + WS_LSE); const float* bt = (const float*)(C.ws + WS_BIAS);
    LAS float* ext = (LAS float*)(C.lds + AT_EXT);
    LAS unsigned char* vt = C.lds + AT_VT + C.wave * 8192; LAS unsigned char* kt = vt + 4096;
    const int lane = C.lane, r32 = lane & 31, hh = lane >> 5, wave = C.wave, tid = C.tid;
    const int crow8 = lane >> 3, cch = lane & 7;
    const int vtr_off = (4 * hh + ((lane & 15) >> 2)) * 64 + ((lane >> 4) & 1) * 32 + (lane & 3) * 8;
    for (int i = tid; i < 48 * 192; i += 512) { const int gh = i / 192, dist = i - gh * 192 - 32; ext[i] = (dist >= 0 && dist <= 128) ? bt[gh * 132 + dist] : -1e30f; }
    __syncthreads();
    const int total = NGRP * BATCH * NHEAD * 8;
    int it = blockIdx.x;
    if (it >= total) return;
    AttnUnit cu = attn_unit(QKV, it, wave), nu = cu;
    v4u qfn[4], kfn[4], vvn[4];
#define AT_LOADKV(U, KB) do { const bf16* kblk_ = (U).kres + (size_t)(KB) * HD; const bf16* vblk_ = (U).vres + (size_t)(KB) * HD; \
        _Pragma("unroll") for (int i_ = 0; i_ < 4; ++i_) { vvn[i_] = *(const v4u*)(vblk_ + (8 * i_ + crow8) * HD + cch * 8); kfn[i_] = *(const v4u*)(kblk_ + (8 * i_ + crow8) * HD + cch * 8); } } while (0)
#define AT_LOADQ(U) do { _Pragma("unroll") for (int i_ = 0; i_ < 4; ++i_) qfn[i_] = *(const v4u*)((U).qbase + (8 * i_ + crow8) * HD + cch * 8); } while (0)
#define AT_TILE2FRAG(RAW, FR) do { _Pragma("unroll") for (int i_ = 0; i_ < 4; ++i_) *(LAS v4u*)(kt + (8 * i_ + crow8) * 128 + ((cch ^ crow8) << 4)) = RAW[i_]; \
        _Pragma("unroll") for (int s_ = 0; s_ < 4; ++s_) FR[s_] = *(const LAS bf16x8v*)(kt + r32 * 128 + (((2 * s_ + hh) ^ (r32 & 7)) << 4)); } while (0)
    AT_LOADQ(cu); AT_LOADKV(cu, cu.l0);
    for (;;) {
        bf16x8v qf[4];
        AT_TILE2FRAG(qfn, qf);
        f32x16 o0, o1;
#pragma unroll
        for (int e = 0; e < 16; ++e) { o0[e] = 0.f; o1[e] = 0.f; }
        float mrow = -1e30f, lsum = 0.f;
        const bool has_next = (it + C.G) < total;
        for (int kb = cu.l0; kb >= cu.kb_lo; kb -= 32) {
            v4u vv[4], kraw[4]; bf16x8v kf[4];
#pragma unroll
            for (int i = 0; i < 4; ++i) { vv[i] = vvn[i]; kraw[i] = kfn[i]; }
            if (kb - 32 >= cu.kb_lo) { AT_LOADKV(cu, kb - 32); }
            else if (has_next) { nu = attn_unit(QKV, it + C.G, wave); AT_LOADQ(nu); AT_LOADKV(nu, nu.l0); }
#pragma unroll
            for (int i = 0; i < 4; ++i) *(LAS v4u*)(vt + (cch >> 2) * 2048 + (8 * i + crow8) * 64 + (cch & 3) * 16) = vv[i];
            AT_TILE2FRAG(kraw, kf);
            f32x16 p;
#pragma unroll
            for (int e = 0; e < 16; ++e) p[e] = 0.f;
#pragma unroll
            for (int s = 0; s < 4; ++s) p = __builtin_amdgcn_mfma_f32_32x32x16_bf16(kf[s], qf[s], p, 0, 0, 0);
            const int eb = cu.eoff + cu.l0 + r32 - kb - 4 * hh + 32;
            float bm = -1e30f;
#pragma unroll
            for (int e = 0; e < 16; ++e) { p[e] += ext[eb - ((e & 3) + 8 * (e >> 2))]; bm = fmaxf(bm, p[e]); }
            bm = fmaxf(bm, __shfl_xor(bm, 32));
            const float mn = fmaxf(mrow, bm), alpha = __builtin_amdgcn_exp2f(mrow - mn); mrow = mn;
            float ps = 0.f;
#pragma unroll
            for (int e = 0; e < 16; ++e) { p[e] = __builtin_amdgcn_exp2f(p[e] - mn); ps += p[e]; }
            lsum = lsum * alpha + ps;
#pragma unroll
            for (int e = 0; e < 16; ++e) { o0[e] *= alpha; o1[e] *= alpha; }
            bf16x8v pf[2];
#pragma unroll
            for (int s = 0; s < 2; ++s) { const float t8[8] = {p[8 * s], p[8 * s + 1], p[8 * s + 2], p[8 * s + 3], p[8 * s + 4], p[8 * s + 5], p[8 * s + 6], p[8 * s + 7]}; pf[s] = pack8(t8); }
#pragma unroll
            for (int s = 0; s < 2; ++s) {
                const v4i16_t a00 = vtr16(vt + 0 * 2048 + (16 * s) * 64 + vtr_off), a01 = vtr16(vt + 0 * 2048 + (16 * s + 8) * 64 + vtr_off);
                const v4i16_t a10 = vtr16(vt + 1 * 2048 + (16 * s) * 64 + vtr_off), a11 = vtr16(vt + 1 * 2048 + (16 * s + 8) * 64 + vtr_off);
                const bf16x8v va0 = (bf16x8v){a00[0], a00[1], a00[2], a00[3], a01[0], a01[1], a01[2], a01[3]};
                const bf16x8v va1 = (bf16x8v){a10[0], a10[1], a10[2], a10[3], a11[0], a11[1], a11[2], a11[3]};
                o0 = __builtin_amdgcn_mfma_f32_32x32x16_bf16(va0, pf[s], o0, 0, 0, 0);
                o1 = __builtin_amdgcn_mfma_f32_32x32x16_bf16(va1, pf[s], o1, 0, 0, 0);
            }
        }
        const float ltot = lsum + __shfl_xor(lsum, 32), inv = 1.f / ltot;
#pragma unroll
        for (int q = 0; q < 4; ++q) {
            v2u w0, w1;
            w0.x = pg8::cvt_pk_bf16(o0[4 * q] * inv, o0[4 * q + 1] * inv); w0.y = pg8::cvt_pk_bf16(o0[4 * q + 2] * inv, o0[4 * q + 3] * inv);
            w1.x = pg8::cvt_pk_bf16(o1[4 * q] * inv, o1[4 * q + 1] * inv); w1.y = pg8::cvt_pk_bf16(o1[4 * q + 2] * inv, o1[4 * q + 3] * inv);
            *(LAS v2u*)(kt + r32 * 128 + ((q ^ (r32 & 7)) << 4) + 8 * hh) = w0; *(LAS v2u*)(kt + r32 * 128 + (((4 + q) ^ (r32 & 7)) << 4) + 8 * hh) = w1;
        }
        if (!dry)
#pragma unroll
        for (int i = 0; i < 4; ++i) { const v4u w = *(const LAS v4u*)(kt + (8 * i + crow8) * 128 + ((cch ^ crow8) << 4)); *(v4u*)(cu.qbase + (8 * i + crow8) * HD + cch * 8) = w; }
        if (hh == 0) { const int l2d = 2 * cu.g, L = SEQ >> l2d, llin = cu.llin0 + r32, rres = llin >> (11 - l2d), l = llin & (L - 1), t = (l << l2d) + rres, row = (cu.bh >> 4) * SEQ + t;
            LSE[((size_t)cu.g * M + row) * 16 + (cu.bh & 15)] = mrow + log2f(ltot); }
        if (!has_next) break;
        it += C.G; cu = nu;
    }
#undef AT_LOADKV
#undef AT_LOADQ
#undef AT_TILE2FRAG
}
__device__ __forceinline__ void p_merge(const Ctx& C, const Args& a) {
    const bf16* QKV = (const bf16*)(C.ws + WS_QKV); const float* LSE = (const float*)(C.ws + WS_LSE); bf16* ATT = (bf16*)(C.ws + WS_ATT);
    for (int idx = blockIdx.x * 512 + C.tid; idx < M * 16 * 8; idx += C.G * 512) {
        const int ch = idx & 7, h = (idx >> 3) & 15, row = idx >> 7, b = row >> 11, t = row & 2047;
        float ls[3], mxl = -INFINITY;
#pragma unroll
        for (int g = 0; g < 3; ++g) { ls[g] = LSE[((size_t)g * M + row) * 16 + h]; mxl = fmaxf(mxl, ls[g]); }
        float acc[8], wsum = 0.f;
#pragma unroll
        for (int e = 0; e < 8; ++e) acc[e] = 0.f;
#pragma unroll
        for (int g = 0; g < 3; ++g) { const float w = exp2f(ls[g] - mxl); wsum += w; const int l2d = 2 * g, rres = t & ((1 << l2d) - 1), l = t >> l2d, L = SEQ >> l2d;
            const v4u v = *(const v4u*)(QKV + (size_t)g * ((size_t)M * 1024) + ((size_t)(b * 16 + h) * SEQ + rres * L + l) * HD + 8 * ch);
            acc[0] += w * bf_lo(v.x); acc[1] += w * bf_hi(v.x); acc[2] += w * bf_lo(v.y); acc[3] += w * bf_hi(v.y); acc[4] += w * bf_lo(v.z); acc[5] += w * bf_hi(v.z); acc[6] += w * bf_lo(v.w); acc[7] += w * bf_hi(v.w); }
        const float inv = 1.f / wsum; v4u o; o.x = pk2(acc[0] * inv, acc[1] * inv); o.y = pk2(acc[2] * inv, acc[3] * inv); o.z = pk2(acc[4] * inv, acc[5] * inv); o.w = pk2(acc[6] * inv, acc[7] * inv);
        *(v4u*)(ATT + (size_t)row * 1024 + h * 64 + 8 * ch) = o;
    }
}

enum { PH_PROLOGUE = 0, PH_FFN_IN_0, PH_FFN_OUT_0, PH_RNN_IN, PH_RNN_MID, PH_RNN_OUT, PH_FFN_IN_1, PH_FFN_OUT_1,
       PH_FFN_IN_2, PH_FFN_OUT_2, PH_QKV, PH_ATTN, PH_MERGE, PH_WO, PH_FFN_IN_3, PH_FFN_OUT_3, NPHASE };

__global__ void __launch_bounds__(NWAVES * 64, 2) fwd_kernel(Args args) {
    extern __shared__ __attribute__((aligned(16))) unsigned char lds_raw[];
    Ctx C; C.lds = (LAS unsigned char*)lds_raw; C.tid = threadIdx.x; C.lane = C.tid & 63; C.wave = __builtin_amdgcn_readfirstlane(C.tid >> 6);
    C.G = gridDim.x; { const int bx = blockIdx.x; C.vcu = (C.G % 8 == 0) ? (bx % 8) * (C.G / 8) + bx / 8 : bx; }
    C.ws = args.ws;
    volatile LAS unsigned* MISC = (volatile LAS unsigned*)(C.lds + MISC_OFF);
    for (int u = C.tid; u < (LDS_BYTES - LDSCTL_OFF) / 4; u += NWAVES * 64) ((LAS unsigned*)(C.lds + LDSCTL_OFF))[u] = 0u;
    __syncthreads();
    unsigned* ctl = (unsigned*)args.ws;
    XcdBarrier bar; bar.bar = ctl + CW_BAR; bar.x = 0; bar.st = nullptr;
    const bool multi = (args.ph_hi - args.ph_lo) > 1;
    if (multi) bar = xcd_barrier_post(ctl + CW_BAR, MISC + 8);
    for (int ph = args.ph_lo; ph < args.ph_hi; ++ph) {
        for (int rep = ((DUP_MASK >> ph) & 1u) ? DUP_N : 0; rep >= 0; --rep) {
        const bool dry = rep > 0;
        { int t_ = threadIdx.x; asm volatile("" : "+v"(t_)); C.tid = t_; C.lane = t_ & 63; }
        unsigned char* ws = args.ws;
        C.ws = ws; float* ssq = (float*)(ws + WS_SSQ); bf16* xb = (bf16*)(ws + WS_XB);
        switch (ph) {
        case PH_PROLOGUE: p_prologue(C, args); break;
        case PH_FFN_IN_0: case PH_FFN_IN_1: case PH_FFN_IN_2: case PH_FFN_IN_3: {
            if (!dry && ph != PH_FFN_IN_3) { const int f = (ph == PH_FFN_IN_0) ? 1 : (ph == PH_FFN_IN_1) ? 8 : 10, l = (ph == PH_FFN_IN_0) ? 4 : (ph == PH_FFN_IN_1) ? 10 : 12; spare_convert(C, args, f, l, (M / 256) * (2 * FF / 256)); }
            const bf16* Bt = (ph == PH_FFN_IN_3) ? (const bf16*)args.out : (const bf16*)(ws + (ph == PH_FFN_IN_0 ? WS_WIN0 : ph == PH_FFN_IN_1 ? WS_WIN1 : WS_WIN2));
            bf16* act = (bf16*)(ws + (ph == PH_FFN_IN_3 ? WS_ACT3 : WS_ACT));
            pg8::Gemm g{xb, Bt, M, 2 * FF, D}; pg8::StaticOrder S; S.init(M, 2 * FF, C.G, (int)blockIdx.x);
            fill_rstd(C.lds, S, ssq, C.tid);
            EpiSwiGLU E{(const LAS float*)(C.lds + RSTD_OFF), act, dry ? DUP_SKIP_EPI : 0};
            pg8::gemm_phase<EpiSwiGLU, pg8::StaticOrder, true, true>(C.lds, g, S, E);
        } break;
        case PH_FFN_OUT_0: case PH_FFN_OUT_1: case PH_FFN_OUT_2: case PH_FFN_OUT_3: case PH_RNN_OUT: case PH_WO: {
            const bf16* A; const bf16* Bt; int K; float scale = 0.5f; const float* xin = args.out;
            if (ph == PH_FFN_OUT_0) { A = (const bf16*)(ws + WS_ACT); Bt = (const bf16*)(ws + WS_WOUT0); K = FF; xin = args.in[I_X]; }
            else if (ph == PH_FFN_OUT_1) { A = (const bf16*)(ws + WS_ACT); Bt = (const bf16*)(ws + WS_WOUT1); K = FF; }
            else if (ph == PH_FFN_OUT_2) { A = (const bf16*)(ws + WS_ACT); Bt = (const bf16*)(ws + WS_WOUT2); K = FF; }
            else if (ph == PH_FFN_OUT_3) { A = (const bf16*)(ws + WS_ACT3); Bt = (const bf16*)(ws + WS_WOUT3); K = FF; }
            else if (ph == PH_RNN_OUT) { A = (const bf16*)(ws + WS_Y); Bt = (const bf16*)(ws + WS_WROUT); K = DRNN; scale = 1.f; }
            else { A = (const bf16*)(ws + WS_ATT); Bt = (const bf16*)(ws + WS_WO); K = D; scale = 1.f; }
            if (dry && ph != PH_FFN_OUT_0) scale = 0.f;
            float* xo = args.out;
#if RESID_BF16
            if (ph != PH_FFN_OUT_0) xin = nullptr;
            if (ph != PH_FFN_OUT_3 || dry) xo = nullptr;
#endif
            pg8::Gemm g{A, Bt, M, D, K}; pg8::StaticOrder S; S.init(M, D, C.G, (int)blockIdx.x);
            EpiRes E{xin, xo, xb, ssq, scale, dry && DUP_SKIP_EPI};
            pg8::gemm_phase<EpiRes, pg8::StaticOrder, false, true>(C.lds, g, S, E);
        } break;
        case PH_RNN_IN: {
            pg8::Gemm g{xb, (const bf16*)(ws + WS_WRIN), M, 2 * DRNN, D}; pg8::StaticOrder S; S.init(M, 2 * DRNN, C.G, (int)blockIdx.x);
            fill_rstd(C.lds, S, ssq, C.tid);
            EpiRnnIn E{(const LAS float*)(C.lds + RSTD_OFF), (bf16*)(ws + WS_G), (bf16*)(ws + WS_U)};
            pg8::gemm_phase<EpiRnnIn, pg8::StaticOrder, true, true>(C.lds, g, S, E);
        } break;
        case PH_RNN_MID: p_rnn_mid(C, args); break;
        case PH_QKV: {
            pg8::Gemm g{xb, (const bf16*)(ws + WS_WQKV), M, NQKV, D}; pg8::StaticOrder S; S.init(M, NQKV, C.G, (int)blockIdx.x);
            if (C.tid < 128) ((LAS float*)(C.lds + GAIN_OFF))[C.tid] = (C.tid < 64) ? args.in[I_QGAIN][C.tid] * (0.125f * LOG2E) : args.in[I_KGAIN][C.tid - 64];
            fill_rstd(C.lds, S, ssq, C.tid);
            EpiQKV E{(const LAS float*)(C.lds + RSTD_OFF), (const LAS float*)(C.lds + GAIN_OFF), (bf16*)(ws + WS_QKV), dry && DUP_SKIP_EPI};
            pg8::gemm_phase<EpiQKV, pg8::StaticOrder, true, true>(C.lds, g, S, E);
        } break;
        case PH_ATTN: p_attn(C, dry); break;
        case PH_MERGE: p_merge(C, args); break;
        default: break;
        }
        if (dry || ph + 1 < args.ph_hi) xcd_barrier(bar);
        if (ph == 0 && !dry) for (int eb = 0; eb < DUP_EXTRA_BARRIERS; ++eb) xcd_barrier(bar);
        }
    }
}

extern "C" void kernel_launch(void* const* d_in, const int* in_sizes, int n_in, void* d_out, int out_size, void* d_ws, size_t ws_size, hipStream_t stream) {
    static int grid = 0;
    if (grid == 0) {
        if (n_in != 18 || in_sizes[0] != M * D || out_size != M * D || ws_size < WS_END) { fprintf(stderr, "kernel_launch: unexpected shapes (n_in %d, in0 %d, out %d, ws %zu)\n", n_in, n_in > 0 ? in_sizes[0] : -1, out_size, ws_size); grid = -1; return; }
        int dev = 0, cus = 0, per_cu = 0;
        if (hipGetDevice(&dev) != hipSuccess || hipDeviceGetAttribute(&cus, hipDeviceAttributeMultiprocessorCount, dev) != hipSuccess) { fprintf(stderr, "kernel_launch: device query failed\n"); grid = -1; return; }
        if (hipFuncSetAttribute((const void*)fwd_kernel, hipFuncAttributeMaxDynamicSharedMemorySize, LDS_BYTES) != hipSuccess) { fprintf(stderr, "kernel_launch: hipFuncSetAttribute failed\n"); grid = -1; return; }
        if (hipOccupancyMaxActiveBlocksPerMultiprocessor(&per_cu, (const void*)fwd_kernel, NWAVES * 64, LDS_BYTES) != hipSuccess || per_cu < 1) { fprintf(stderr, "kernel_launch: occupancy query says %d blocks per CU\n", per_cu); (void)hipGetLastError(); grid = -1; return; }
        grid = cus;
    }
    if (grid < 0) return;
    if (hipMemsetAsync(d_ws, 0, CTL_ZERO_BYTES, stream) != hipSuccess) { fprintf(stderr, "kernel_launch: memset failed\n"); return; }
    Args a{};
    for (int i = 0; i < 18; ++i) a.in[i] = (const float*)d_in[i];
    a.out = (float*)d_out; a.ws = (unsigned char*)d_ws;
#if SINGLE_LAUNCH
    a.ph_lo = 0; a.ph_hi = NPHASE;
    hipLaunchKernelGGL(fwd_kernel, dim3(grid), dim3(NWAVES * 64), LDS_BYTES, stream, a);
#else
    for (int ph = 0; ph < NPHASE; ++ph) { a.ph_lo = ph; a.ph_hi = ph + 1; hipLaunchKernelGGL(fwd_kernel, dim3(grid), dim3(NWAVES * 64), LDS_BYTES, stream, a); }
#endif
}
```

```cpp
#include <hip/hip_runtime.h>
#include <cstdio>
#include <cstdint>

#ifndef SINGLE_LAUNCH
#define SINGLE_LAUNCH 1
#define DUP_MASK 0u
#define DUP_N 1
#define DUP_EXTRA_BARRIERS 0
#define DUP_SKIP_EPI 0
#endif

namespace pg8 {
#define PG8_LAS __attribute__((address_space(3)))
typedef unsigned short bf16_t;
typedef short bf16x8 __attribute__((ext_vector_type(8)));
typedef float f32x4 __attribute__((ext_vector_type(4)));
typedef unsigned u32x4 __attribute__((ext_vector_type(4)));
constexpr int BM = 256, BK = 64, HALF = 128, HTB = HALF * BK * 2, STAGE_BYTES = 8 * HTB, NXCD = 8, WGM = 8;

__host__ __device__ __forceinline__ int lds_byte(int r, int c) { return (r >> 3) * 1024 + (r & 7) * 128 + ((((c >> 3) ^ (r & 7)) & 7) << 4) + (c & 7) * 2; }
__host__ __device__ __forceinline__ void stage_rc(int b, int& R, int& C) { const int sidx = b / 1024, w = b % 1024, rowin = w / 128, pch = (w % 128) / 16; R = sidx * 8 + rowin; C = ((pch ^ rowin) & 7) * 8; }
__host__ __device__ __forceinline__ int perm32(int rho) { const int n = rho >> 4, i = rho & 15; return 8 * (i >> 2) + 4 * n + (i & 3); }

struct Unit { int pm, pn; };
struct Gemm { const bf16_t* A; const bf16_t* Bt; int M, N, K; };

struct StaticOrder {
    int nM, nN, nwg, G, c;
    __host__ __device__ void init(int M, int N, int G_, int c_) { nM = M / BM; nN = N / BM; nwg = nM * nN; G = G_; c = c_; }
    __host__ __device__ bool next(int i, Unit& u) const {
        const long L = (long)i * G + c; if (L >= nwg) return false;
        int wgid = (int)L; { const int q = nwg / NXCD, r = nwg % NXCD, xcd = wgid % NXCD, off = wgid / NXCD; wgid = (xcd < r ? xcd * (q + 1) : r * (q + 1) + (xcd - r) * q) + off; }
        const int nig = WGM * nN, gid = wgid / nig, fm = gid * WGM, gsz = (nM - fm) < WGM ? (nM - fm) : WGM;
        u.pm = fm + ((wgid % nig) % gsz); u.pn = (wgid % nig) / gsz; return true;
    }
    __device__ __forceinline__ void a_ready(const Unit&) const {}
    __device__ __forceinline__ void done(const Unit&) const {}
};

__device__ __forceinline__ unsigned cvt_pk_bf16(float lo, float hi) { unsigned r; asm volatile("v_cvt_pk_bf16_f32 %0, %1, %2" : "=v"(r) : "v"(lo), "v"(hi)); return r; }

template <class Epi, class Sched, bool ALIGN_EPI = false, bool SP2 = false>
__device__ __forceinline__ void gemm_phase(PG8_LAS unsigned char* lds, const Gemm g, const Sched& S, const Epi& E) {
    int tid_ = threadIdx.x; asm volatile("" : "+v"(tid_));
    const int tid = tid_, wid = __builtin_amdgcn_readfirstlane(tid >> 6), lane = tid & 63, wr = wid >> 2, wc = wid & 3, fr = lane & 15, fq = lane >> 4;
    const int K = g.K, nt = K / BK;
    unsigned voffA[2], voffB[2];
#pragma unroll
    for (int i = 0; i < 2; ++i) { int R, C; stage_rc(tid * 16 + i * 8192, R, C); const int Rb = Epi::PERM ? ((R & ~31) + perm32(R & 31)) : R;
        voffA[i] = (unsigned)(R * K + C) * 2u; voffB[i] = (unsigned)(Rb * K + C) * 2u; }
    const size_t kstep = (size_t)(BK * 2);
    const size_t hstep = (size_t)HALF * K * 2;
    const size_t tstep = 2 * hstep;
    const unsigned ldsw = (unsigned)wid * 1024u;
    const int aoff = lds_byte(wr * 64 + fr, fq * 8), boff = lds_byte(wc * 32 + fr, fq * 8);
#define PG8_SA(b, h) (((b) * 2 + (h)) * HTB)
#define PG8_SB(b, h) ((4 + (b) * 2 + (h)) * HTB)
#define PG8_STAGE(bufoff, gbase, voff) do { _Pragma("unroll") for (int _i = 0; _i < 2; ++_i) \
        __builtin_amdgcn_global_load_lds((const unsigned*)((const char*)(gbase) + (voff)[_i]), (PG8_LAS unsigned*)(lds + (bufoff) + ldsw + _i * 8192), 16, 0, 0); } while (0)
#define PG8_LDA(dst, b, h) do { _Pragma("unroll") for (int m = 0; m < 4; ++m) _Pragma("unroll") for (int k = 0; k < 2; ++k) dst[m][k] = *(const PG8_LAS bf16x8*)(lds + PG8_SA(b, h) + (aoff ^ (k * 64)) + m * 2048); } while (0)
#define PG8_LDB(dst, b, h) do { _Pragma("unroll") for (int n = 0; n < 2; ++n) _Pragma("unroll") for (int k = 0; k < 2; ++k) dst[n][k] = *(const PG8_LAS bf16x8*)(lds + PG8_SB(b, h) + (boff ^ (k * 64)) + n * 2048); } while (0)
#define PG8_MMA(ai, bj, At, Bt) do { __builtin_amdgcn_s_setprio(1); _Pragma("unroll") for (int m = 0; m < 4; ++m) _Pragma("unroll") for (int n = 0; n < 2; ++n) _Pragma("unroll") for (int k = 0; k < 2; ++k) \
        acc[ai][bj][m][n] = __builtin_amdgcn_mfma_f32_16x16x32_bf16(Bt[n][k], At[m][k], acc[ai][bj][m][n], 0, 0, 0); __builtin_amdgcn_s_setprio(0); } while (0)
#define PG8_WAIT_V(n) asm volatile("s_waitcnt vmcnt(" #n ")" ::: "memory")
#define PG8_WAIT_L(n) asm volatile("s_waitcnt lgkmcnt(" #n ")" ::: "memory")
#define PG8_BAR __builtin_amdgcn_s_barrier()
#define PG8_SCHED __builtin_amdgcn_sched_barrier(0)
    Unit cur, nxt; int ui = 0;
    if (!S.next(0, cur)) return;
    f32x4 acc[2][2][4][2];
#pragma unroll
    for (int a = 0; a < 2; ++a)
#pragma unroll
        for (int b = 0; b < 2; ++b)
#pragma unroll
            for (int m = 0; m < 4; ++m)
#pragma unroll
                for (int n = 0; n < 2; ++n) acc[a][b][m][n] = (f32x4){0.f, 0.f, 0.f, 0.f};
    bf16x8 At[4][2], B0[2][2], B1[2][2];
    const char* cA = (const char*)g.A + (size_t)cur.pm * tstep; const char* cB = (const char*)g.Bt + (size_t)cur.pn * tstep;
    S.a_ready(cur);
    if constexpr (SP2) {
        PG8_STAGE(PG8_SB(0, 0), cB, voffB); PG8_STAGE(PG8_SB(0, 1), cB + hstep, voffB); PG8_STAGE(PG8_SA(0, 0), cA, voffA); PG8_STAGE(PG8_SA(0, 1), cA + hstep, voffA);
        if (wr == 1) PG8_BAR;
        PG8_WAIT_V(2); PG8_BAR;
        PG8_STAGE(PG8_SB(1, 0), cB + kstep, voffB); PG8_STAGE(PG8_SA(1, 0), cA + kstep, voffA); PG8_STAGE(PG8_SB(1, 1), cB + hstep + kstep, voffB);
        PG8_WAIT_V(6); PG8_BAR;
    } else {
        PG8_STAGE(PG8_SB(0, 0), cB, voffB); PG8_STAGE(PG8_SA(0, 0), cA, voffA); PG8_STAGE(PG8_SB(0, 1), cB + hstep, voffB); PG8_STAGE(PG8_SA(0, 1), cA + hstep, voffA);
        if (wr == 1) PG8_BAR;
        PG8_WAIT_V(4); PG8_BAR;
        PG8_STAGE(PG8_SB(1, 0), cB + kstep, voffB); PG8_STAGE(PG8_SA(1, 0), cA + kstep, voffA); PG8_STAGE(PG8_SB(1, 1), cB + hstep + kstep, voffB);
        PG8_WAIT_V(6); PG8_BAR;
    }
    for (;;) {
        const bool has_next = S.next(ui + 1, nxt);
        const char* nA = has_next ? (const char*)g.A + (size_t)nxt.pm * tstep : cA; const char* nB = has_next ? (const char*)g.Bt + (size_t)nxt.pn * tstep : cB;
        for (int t = 0; t < nt; t += 2) {
            const bool last = (t == nt - 2);
            const char* a1 = cA + (size_t)(t + 1) * kstep;
            const char* a2 = last ? nA : cA + (size_t)(t + 2) * kstep; const char* b2 = last ? nB : cB + (size_t)(t + 2) * kstep;
            const char* a3 = a2 + kstep; const char* b3 = b2 + kstep;
            if (last && has_next) S.a_ready(nxt);
            if constexpr (SP2) {
            PG8_LDB(B0, 0, 0); PG8_LDB(B1, 0, 1); PG8_SCHED; PG8_LDA(At, 0, 0); PG8_STAGE(PG8_SA(1, 1), a1 + hstep, voffA);
            PG8_WAIT_V(8); PG8_WAIT_L(0); PG8_BAR; PG8_MMA(0, 0, At, B0); PG8_MMA(0, 1, At, B1); PG8_BAR; PG8_SCHED;
            PG8_LDA(At, 0, 1); PG8_STAGE(PG8_SB(0, 0), b2, voffB); PG8_STAGE(PG8_SB(0, 1), b2 + hstep, voffB); PG8_STAGE(PG8_SA(0, 0), a2, voffA);
            PG8_WAIT_V(8); PG8_WAIT_L(0); PG8_BAR; PG8_MMA(1, 0, At, B0); PG8_MMA(1, 1, At, B1); PG8_BAR; PG8_SCHED;
            PG8_LDB(B0, 1, 0); PG8_LDB(B1, 1, 1); PG8_SCHED; PG8_LDA(At, 1, 0); PG8_STAGE(PG8_SA(0, 1), a2 + hstep, voffA);
            PG8_WAIT_V(8); PG8_WAIT_L(0); PG8_BAR; PG8_MMA(0, 0, At, B0); PG8_MMA(0, 1, At, B1); PG8_BAR; PG8_SCHED;
            PG8_LDA(At, 1, 1); PG8_STAGE(PG8_SB(1, 0), b3, voffB); PG8_STAGE(PG8_SB(1, 1), b3 + hstep, voffB); PG8_STAGE(PG8_SA(1, 0), a3, voffA);
            PG8_WAIT_V(8); PG8_WAIT_L(0); PG8_BAR; PG8_MMA(1, 0, At, B0); PG8_MMA(1, 1, At, B1); PG8_BAR; PG8_SCHED;
            } else {
            PG8_LDB(B0, 0, 0); PG8_SCHED; PG8_LDA(At, 0, 0); PG8_STAGE(PG8_SA(1, 1), a1 + hstep, voffA);
            PG8_WAIT_L(8); PG8_BAR; PG8_WAIT_L(0); PG8_MMA(0, 0, At, B0); PG8_BAR; PG8_SCHED;
            PG8_LDB(B1, 0, 1); PG8_STAGE(PG8_SB(0, 0), b2, voffB);
            PG8_BAR; PG8_WAIT_L(0); PG8_MMA(0, 1, At, B1); PG8_BAR;
            PG8_LDA(At, 0, 1); PG8_STAGE(PG8_SA(0, 0), a2, voffA);
            PG8_BAR; PG8_WAIT_L(0); PG8_MMA(1, 0, At, B0); PG8_BAR; PG8_SCHED;
            PG8_STAGE(PG8_SB(0, 1), b2 + hstep, voffB);
            PG8_WAIT_V(6); PG8_BAR; PG8_MMA(1, 1, At, B1); PG8_BAR;
            PG8_LDB(B0, 1, 0); PG8_SCHED; PG8_LDA(At, 1, 0); PG8_STAGE(PG8_SA(0, 1), a2 + hstep, voffA);
            PG8_WAIT_L(8); PG8_BAR; PG8_WAIT_L(0); PG8_MMA(0, 0, At, B0); PG8_BAR; PG8_SCHED;
            PG8_LDB(B1, 1, 1); PG8_STAGE(PG8_SB(1, 0), b3, voffB);
            PG8_BAR; PG8_WAIT_L(0); PG8_MMA(0, 1, At, B1); PG8_BAR;
            PG8_LDA(At, 1, 1); PG8_STAGE(PG8_SA(1, 0), a3, voffA);
            PG8_BAR; PG8_WAIT_L(0); PG8_MMA(1, 0, At, B0); PG8_BAR; PG8_SCHED;
            PG8_STAGE(PG8_SB(1, 1), b3 + hstep, voffB);
            PG8_WAIT_V(6); PG8_BAR; PG8_MMA(1, 1, At, B1); PG8_BAR;
            }
        }
        if constexpr (ALIGN_EPI) { if (wr == 0) PG8_BAR; }
        E(acc, cur, ui, wr, wc, fr, fq); S.done(cur);
        if (!has_next) break;
#pragma unroll
        for (int a = 0; a < 2; ++a)
#pragma unroll
            for (int b = 0; b < 2; ++b)
#pragma unroll
                for (int m = 0; m < 4; ++m)
#pragma unroll
                    for (int n = 0; n < 2; ++n) acc[a][b][m][n] = (f32x4){0.f, 0.f, 0.f, 0.f};
        cur = nxt; cA = nA; cB = nB; ++ui;
        if constexpr (ALIGN_EPI) { if (wr == 1) PG8_BAR; }
    }
    PG8_WAIT_V(0);
    if constexpr (!ALIGN_EPI) { if (wr == 0) PG8_BAR; }
    PG8_BAR;
#undef PG8_SA
#undef PG8_SB
#undef PG8_STAGE
#undef PG8_LDA
#undef PG8_LDB
#undef PG8_MMA
#undef PG8_WAIT_V
#undef PG8_WAIT_L
#undef PG8_BAR
#undef PG8_SCHED
}
}

constexpr int BATCH = 8, SEQ = 2048, D = 1024, M = BATCH * SEQ;
constexpr int FF = 2816, DRNN = 1280, NBLK = 10, RBLK = 128, CONVW = 4;
constexpr int NHEAD = 16, HD = 64, NGRP = 3, NQKV = 9216;
constexpr float RMS_EPS = 1e-6f;
constexpr float LOG2E = 1.4426950408889634f;
constexpr int NWAVES = 8;

typedef unsigned short bf16;
typedef unsigned v4u __attribute__((ext_vector_type(4)));
typedef unsigned v2u __attribute__((ext_vector_type(2)));
typedef float f32x4 __attribute__((ext_vector_type(4)));
#define GAS __attribute__((address_space(1)))
#define LAS __attribute__((address_space(3)))
typedef GAS unsigned gu32;
#define RLX_AGENT __ATOMIC_RELAXED, __HIP_MEMORY_SCOPE_AGENT
#define LDS_WAIT() asm volatile("s_waitcnt lgkmcnt(0)" ::: "memory")

#ifndef RESID_BF16
#define RESID_BF16 1
#endif
constexpr size_t MiB = 1u << 20;
constexpr size_t WS_CTL = 0, CTL_ZERO_BYTES = 1 * MiB;
constexpr size_t WS_SSQ = 1 * MiB;
constexpr size_t WS_BIAS = 2 * MiB;
constexpr size_t WS_XB = 3 * MiB;
constexpr size_t WS_WO = 35 * MiB;
constexpr size_t WS_WQKV = 37 * MiB;
constexpr size_t WS_QKV = 55 * MiB;
constexpr size_t QKV_SLAB = (size_t)M * 1024 * 2;
constexpr size_t WS_LSE = 343 * MiB;
constexpr size_t WS_END = 352 * MiB;
constexpr size_t WS_WIN0 = 55 * MiB, WS_WOUT0 = 66 * MiB, WS_WIN1 = 72 * MiB, WS_WOUT1 = 83 * MiB, WS_WIN2 = 89 * MiB, WS_WOUT2 = 100 * MiB;
constexpr size_t WS_WRIN = 106 * MiB, WS_WROUT = 111 * MiB, WS_WA = 114 * MiB, WS_WX = 114 * MiB + 512 * 1024;
constexpr size_t WS_ACT = 115 * MiB;
constexpr size_t WS_G = 203 * MiB, WS_U = 243 * MiB, WS_Y = 283 * MiB;
constexpr size_t WS_ATT = WS_QKV + 3 * QKV_SLAB;
constexpr size_t WS_WOUT3 = 346 * MiB;
constexpr size_t WS_ACT3 = WS_QKV;
static_assert(WS_Y + (size_t)M * DRNN * 2 <= WS_LSE && WS_ACT + (size_t)M * FF * 2 <= WS_G && WS_WX + 327680 <= WS_ACT, "ws map");
static_assert(WS_QKV + 9 * QKV_SLAB == WS_LSE && WS_LSE + (size_t)3 * M * 16 * 4 <= WS_WOUT3 && WS_WOUT3 + (size_t)D * FF * 2 <= WS_END && RESID_BF16 == 1, "ws map");
constexpr int CW_BAR = 4096;

constexpr int RING_BYTES = 131072, LDSCTL_OFF = RING_BYTES, MISC_OFF = LDSCTL_OFF + 320;
constexpr int RSTD_OFF = RING_BYTES + 1024, RSTD_MAX_UNITS = 9, GAIN_OFF = RSTD_OFF + RSTD_MAX_UNITS * 256 * 4;
constexpr int LDS_BYTES = 147456;
static_assert(GAIN_OFF + 512 <= LDS_BYTES, "LDS map");

#define XB_TMO      128
#define XB_XCNT(j)  (256  + 64 * (j))
#define XB_XSUB(j)  (1280 + 64 * (j))
#define XB_XGEN(j)  (2304 + 64 * (j))
#define XB_TOP      3328
#define XB_TOPGEN   3392
#define XCD_BAR_WORDS 3456
#define XB_SPIN_CAP (1u << 18)
__device__ __forceinline__ unsigned xb_ld(unsigned* p)              { return __hip_atomic_load(p, __ATOMIC_RELAXED, __HIP_MEMORY_SCOPE_AGENT); }
__device__ __forceinline__ unsigned xb_add(unsigned* p, unsigned v) { return __hip_atomic_fetch_add(p, v, __ATOMIC_RELAXED, __HIP_MEMORY_SCOPE_AGENT); }
__device__ __forceinline__ unsigned xb_xcc_id() { return (unsigned)__builtin_amdgcn_s_getreg((3 << 11) | 20) & 0xFu; }
#define XB_SPIN(cond, bar) do { unsigned _sp = 0; while (cond) { __builtin_amdgcn_s_sleep(1); \
    if ((++_sp & 255u) == 0u) { if (xb_ld(&(bar)[XB_TMO])) break; if (_sp > XB_SPIN_CAP) { atomicAdd(&(bar)[XB_TMO], 1u); break; } } } } while (0)
struct XcdBarrier { unsigned* bar; unsigned x; volatile LAS unsigned* st; };
__device__ __forceinline__ XcdBarrier xcd_barrier_post(unsigned* bar, volatile LAS unsigned* st) {
    XcdBarrier b; b.bar = bar; b.x = xb_xcc_id(); b.st = st;
    if (threadIdx.x == 0) (void)xb_add(&bar[XB_XCNT(b.x)], 1u);
    return b;
}
__device__ __forceinline__ void xcd_barrier_complete(unsigned* bar, unsigned x, unsigned& nloc, unsigned& nx) {
    const unsigned G = gridDim.x * gridDim.y * gridDim.z;
    unsigned sum, cnt, mine, sp = 0u;
    for (;;) {
        sum = 0u; cnt = 0u; mine = 0u;
#pragma unroll
        for (unsigned j = 0; j < 16; ++j) { const unsigned c = xb_ld(&bar[XB_XCNT(j)]); sum += c; cnt += (c > 0u) ? 1u : 0u; mine = (j == x) ? c : mine; }
        if (sum == G) break;
        __builtin_amdgcn_s_sleep(1);
        if ((++sp & 255u) == 0u) { if (xb_ld(&bar[XB_TMO])) break; if (sp > XB_SPIN_CAP) { atomicAdd(&bar[XB_TMO], 1u); break; } }
    }
    nloc = mine > 0u ? mine : 1u; nx = cnt > 0u ? cnt : 1u;
}
__device__ __forceinline__ void xcd_barrier(const XcdBarrier& b) {
    asm volatile("s_waitcnt vmcnt(0)" ::: "memory");
    __syncthreads();
    if (threadIdx.x == 0) {
        unsigned* bar = b.bar;
        __builtin_amdgcn_s_waitcnt(0);
        unsigned nloc = b.st[0], nx = b.st[1];
        if (nloc == 0u) { xcd_barrier_complete(bar, b.x, nloc, nx); b.st[0] = nloc; b.st[1] = nx; }
        const unsigned old = xb_add(&bar[XB_XSUB(b.x)], 1u);
        const unsigned gen = old / nloc;
        if (old + 1u == (gen + 1u) * nloc) {
            __builtin_amdgcn_fence(__ATOMIC_RELEASE, "agent");
            asm volatile("s_waitcnt vmcnt(0)" ::: "memory");
            const unsigned og = xb_add(&bar[XB_TOP], 1u);
            const unsigned tg = og / nx;
            if (og + 1u == (tg + 1u) * nx) xb_add(&bar[XB_TOPGEN], 1u);
            else XB_SPIN(xb_ld(&bar[XB_TOPGEN]) == tg, bar);
            __builtin_amdgcn_fence(__ATOMIC_ACQUIRE, "agent");
            xb_add(&bar[XB_XGEN(b.x)], 1u);
            asm volatile("s_waitcnt vmcnt(0)" ::: "memory");
        } else {
            XB_SPIN(xb_ld(&bar[XB_XGEN(b.x)]) == gen, bar);
            __builtin_amdgcn_fence(__ATOMIC_ACQUIRE, "agent");
            asm volatile("s_waitcnt vmcnt(0)" ::: "memory");
        }
    }
    __syncthreads();
}

__device__ __forceinline__ unsigned f2bf(float f) { unsigned u = __builtin_bit_cast(unsigned, f); return (u + 0x7fffu + ((u >> 16) & 1u)) >> 16; }
__device__ __forceinline__ unsigned pk2(float lo, float hi) { return f2bf(lo) | (f2bf(hi) << 16); }
__device__ __forceinline__ float bf_lo(unsigned w) { return __builtin_bit_cast(float, w << 16); }
__device__ __forceinline__ float bf_hi(unsigned w) { return __builtin_bit_cast(float, w & 0xffff0000u); }
__device__ __forceinline__ float bf2f(bf16 v) { return __builtin_bit_cast(float, (unsigned)v << 16); }
__device__ __forceinline__ float wave_sum(float v) {
#pragma unroll
    for (int o = 1; o < 64; o <<= 1) v += __shfl_xor(v, o);
    return v;
}
__device__ __forceinline__ float fast_sigmoid(float x) { return __builtin_amdgcn_rcpf(1.f + __builtin_amdgcn_exp2f(-LOG2E * x)); }
__device__ __forceinline__ float row_rstd(const float* ssq, int row) {
    const f32x4* p = (const f32x4*)(ssq + (size_t)row * 16); const f32x4 a = p[0], b = p[1], c = p[2], d = p[3];
    const float s = ((a.x + a.y) + (a.z + a.w)) + ((b.x + b.y) + (b.z + b.w)) + ((c.x + c.y) + (c.z + c.w)) + ((d.x + d.y) + (d.z + d.w));
    return rsqrtf(s * (1.0f / D) + RMS_EPS);
}

typedef float f32x2 __attribute__((ext_vector_type(2)));
template <class Sched> __device__ __forceinline__ void fill_rstd(LAS unsigned char* lds, const Sched& S, const float* ssq, int tid) {
    LAS float* rt = (LAS float*)(lds + RSTD_OFF); pg8::Unit u;
    for (int i = 0; i < RSTD_MAX_UNITS && S.next(i, u); ++i)
        if ((tid >> 8) == (i & 1)) { const int r = tid & 255; rt[i * 256 + r] = row_rstd(ssq, u.pm * 256 + r); }
    __syncthreads();
}
using pg8::Unit;
__device__ __forceinline__ f32x2 silu_mul_pk(f32x2 g, f32x2 up) {
    const f32x2 t = g * (-LOG2E); f32x2 e; e.x = __builtin_amdgcn_exp2f(t.x); e.y = __builtin_amdgcn_exp2f(t.y);
    const f32x2 d = e + 1.0f; f32x2 r; r.x = __builtin_amdgcn_rcpf(d.x); r.y = __builtin_amdgcn_rcpf(d.y);
    return (g * r) * up;
}
struct EpiSwiGLU {
    static constexpr bool PERM = true;
    const LAS float* rtab; bf16* act; int skip;
    __device__ __forceinline__ void operator()(const f32x4 (&acc)[2][2][4][2], const Unit& u, int ui, int wr, int wc, int fr, int fq) const {
        if (skip == 1) return;
#pragma unroll
        for (int ai = 0; ai < 2; ++ai)
#pragma unroll
            for (int m = 0; m < 4; ++m) {
                const int rl = ai * 128 + wr * 64 + m * 16 + fr, row = u.pm * 256 + rl;
                const float rs = rtab[ui * 256 + rl];
                f32x2 v[4];
#pragma unroll
                for (int n = 0; n < 2; ++n)
#pragma unroll
                    for (int e = 0; e < 2; ++e) { const f32x2 g = (f32x2){acc[ai][0][m][n][2 * e], acc[ai][0][m][n][2 * e + 1]} * rs, up = (f32x2){acc[ai][1][m][n][2 * e], acc[ai][1][m][n][2 * e + 1]} * rs;
                        v[n * 2 + e] = silu_mul_pk(g, up); }
                v4u w; w.x = pg8::cvt_pk_bf16(v[0].x, v[0].y); w.y = pg8::cvt_pk_bf16(v[1].x, v[1].y); w.z = pg8::cvt_pk_bf16(v[2].x, v[2].y); w.w = pg8::cvt_pk_bf16(v[3].x, v[3].y);
                if (skip != 2 || w.x == 0x7fc17fc1u) *(v4u*)(act + (size_t)row * FF + u.pn * 128 + wc * 32 + 8 * fq) = w;
            }
    }
};
#ifndef RESID_BF16
#define RESID_BF16 1
#endif
struct EpiRes {
    static constexpr bool PERM = true;
    const float* xin; float* xout; bf16* xb; float* ssq; float scale; bool skip;
    __device__ __forceinline__ void operator()(const f32x4 (&acc)[2][2][4][2], const Unit& u, int ui, int wr, int wc, int fr, int fq) const {
        if (skip) return;
        if (xin) run<true>(acc, u, wr, wc, fr, fq); else run<false>(acc, u, wr, wc, fr, fq);
    }
    template <bool F32IN> __device__ __forceinline__ void run(const f32x4 (&acc)[2][2][4][2], const Unit& u, int wr, int wc, int fr, int fq) const {
#pragma unroll
        for (int ai = 0; ai < 2; ++ai) {
            f32x4 xv[4][2][2];
#pragma unroll
            for (int m = 0; m < 4; ++m)
#pragma unroll
                for (int bj = 0; bj < 2; ++bj) { const size_t off = (size_t)(u.pm * 256 + ai * 128 + wr * 64 + m * 16 + fr) * D + u.pn * 256 + bj * 128 + wc * 32 + 8 * fq;
                    if (F32IN) { xv[m][bj][0] = *(const f32x4*)(xin + off); xv[m][bj][1] = *(const f32x4*)(xin + off + 4); }
                    else { const v4u w = *(const v4u*)(xb + off); xv[m][bj][0] = (f32x4){bf_lo(w.x), bf_hi(w.x), bf_lo(w.y), bf_hi(w.y)}; xv[m][bj][1] = (f32x4){bf_lo(w.z), bf_hi(w.z), bf_lo(w.w), bf_hi(w.w)}; } }
#pragma unroll
            for (int m = 0; m < 4; ++m) {
                const int row = u.pm * 256 + ai * 128 + wr * 64 + m * 16 + fr;
                float ss = 0.f;
#pragma unroll
                for (int bj = 0; bj < 2; ++bj) {
                    const size_t off = (size_t)row * D + u.pn * 256 + bj * 128 + wc * 32 + 8 * fq;
                    const f32x4 y0 = xv[m][bj][0] + acc[ai][bj][m][0] * scale, y1 = xv[m][bj][1] + acc[ai][bj][m][1] * scale;
                    if (xout) { *(f32x4*)(xout + off) = y0; *(f32x4*)(xout + off + 4) = y1; }
                    v4u w; w.x = pg8::cvt_pk_bf16(y0[0], y0[1]); w.y = pg8::cvt_pk_bf16(y0[2], y0[3]); w.z = pg8::cvt_pk_bf16(y1[0], y1[1]); w.w = pg8::cvt_pk_bf16(y1[2], y1[3]);
                    *(v4u*)(xb + off) = w;
                    ss += (y0[0] * y0[0] + y0[1] * y0[1]) + (y0[2] * y0[2] + y0[3] * y0[3]) + (y1[0] * y1[0] + y1[1] * y1[1]) + (y1[2] * y1[2] + y1[3] * y1[3]);
                }
                ss += __shfl_xor(ss, 16); ss += __shfl_xor(ss, 32);
                if (fq == 0) ssq[(size_t)row * 16 + u.pn * 4 + wc] = ss;
            }
            asm volatile("" ::: "memory");
        }
    }
};
struct EpiRnnIn {
    static constexpr bool PERM = true;
    const LAS float* rtab; bf16* Gb; bf16* Ub;
    template <bool GATE> __device__ __forceinline__ void run(const f32x4 (&acc)[2][2][4][2], const Unit& u, int ui, int wr, int wc, int fr, int fq, bf16* dstb, int pc) const {
#pragma unroll
        for (int ai = 0; ai < 2; ++ai)
#pragma unroll
            for (int m = 0; m < 4; ++m) {
                const int rl = ai * 128 + wr * 64 + m * 16 + fr, row = u.pm * 256 + rl;
                const float rs = rtab[ui * 256 + rl];
#pragma unroll
                for (int bj = 0; bj < 2; ++bj) {
                    f32x2 v[4];
#pragma unroll
                    for (int n = 0; n < 2; ++n)
#pragma unroll
                        for (int e = 0; e < 2; ++e) { f32x2 x = (f32x2){acc[ai][bj][m][n][2 * e], acc[ai][bj][m][n][2 * e + 1]} * rs;
                            if (GATE) {
                                const f32x2 t = (x * x * 0.044715f + 1.0f) * x * (-1.5957691216057308f * LOG2E); f32x2 ex; ex.x = __builtin_amdgcn_exp2f(t.x); ex.y = __builtin_amdgcn_exp2f(t.y);
                                const f32x2 d = ex + 1.0f; f32x2 r; r.x = __builtin_amdgcn_rcpf(d.x); r.y = __builtin_amdgcn_rcpf(d.y); x = x * r; }
                            v[n * 2 + e] = x; }
                    v4u w; w.x = pg8::cvt_pk_bf16(v[0].x, v[0].y); w.y = pg8::cvt_pk_bf16(v[1].x, v[1].y); w.z = pg8::cvt_pk_bf16(v[2].x, v[2].y); w.w = pg8::cvt_pk_bf16(v[3].x, v[3].y);
                    *(v4u*)(dstb + (size_t)row * DRNN + pc * 256 + bj * 128 + wc * 32 + 8 * fq) = w;
                }
            }
    }
    __device__ __forceinline__ void operator()(const f32x4 (&acc)[2][2][4][2], const Unit& u, int ui, int wr, int wc, int fr, int fq) const {
        if (u.pn < 5) run<true>(acc, u, ui, wr, wc, fr, fq, Gb, u.pn); else run<false>(acc, u, ui, wr, wc, fr, fq, Ub, u.pn - 5);
    }
};
struct EpiQKV {
    static constexpr bool PERM = true;
    const LAS float* rtab; const LAS float* gtab; bf16* qkv; bool skip;
    __device__ __forceinline__ void operator()(const f32x4 (&acc)[2][2][4][2], const Unit& u, int ui, int wr, int wc, int fr, int fq) const {
        if (skip) return;
        const int hs = u.pn * 4 + wc, kind = hs / 48, gh = hs - kind * 48, g = gh >> 4, h = gh & 15, l2d = 2 * g;
        bf16* slab = qkv + (size_t)(kind * 3 + g) * ((size_t)M * 1024);
        f32x4 gv[2][2];
#pragma unroll
        for (int bj = 0; bj < 2; ++bj)
#pragma unroll
            for (int n = 0; n < 2; ++n) { gv[bj][n] = (f32x4){1.f, 1.f, 1.f, 1.f}; if (kind < 2) gv[bj][n] = *(const LAS f32x4*)(gtab + kind * 64 + 32 * bj + 8 * fq + 4 * n); }
#pragma unroll
        for (int ai = 0; ai < 2; ++ai)
#pragma unroll
            for (int m = 0; m < 4; ++m) {
                const int rl = ai * 128 + wr * 64 + m * 16 + fr, row = u.pm * 256 + rl;
                const float rs = rtab[ui * 256 + rl];
                f32x4 v[2][2]; float ss = 0.f;
#pragma unroll
                for (int bj = 0; bj < 2; ++bj)
#pragma unroll
                    for (int n = 0; n < 2; ++n) { v[bj][n] = acc[ai][bj][m][n] * rs; const f32x4 t = v[bj][n] * v[bj][n]; ss += (t[0] + t[1]) + (t[2] + t[3]); }
                float rn = 1.f;
                if (kind < 2) { ss += __shfl_xor(ss, 16); ss += __shfl_xor(ss, 32); rn = rsqrtf(ss * (1.0f / HD) + RMS_EPS); }
                const int b = row >> 11, t = row & 2047, rres = t & ((1 << l2d) - 1), l = t >> l2d, L = 2048 >> l2d;
                bf16* dst = slab + ((size_t)(b * 16 + h) * 2048 + rres * L + l) * 64 + 8 * fq;
#pragma unroll
                for (int bj = 0; bj < 2; ++bj) {
                    const f32x4 a0 = v[bj][0] * gv[bj][0] * rn, a1 = v[bj][1] * gv[bj][1] * rn;
                    v4u w; w.x = pg8::cvt_pk_bf16(a0[0], a0[1]); w.y = pg8::cvt_pk_bf16(a0[2], a0[3]); w.z = pg8::cvt_pk_bf16(a1[0], a1[1]); w.w = pg8::cvt_pk_bf16(a1[2], a1[3]);
                    *(v4u*)(dst + 32 * bj) = w;
                }
            }
    }
};

struct Args { const float* in[18]; float* out; unsigned char* ws; int ph_lo, ph_hi; };
enum { I_X = 0, I_NORMG, I_FFN_WIN, I_FFN_WOUT, I_RNN_WIN, I_CONV_W, I_CONV_B, I_WA, I_BA, I_WX, I_BX, I_LAM, I_RNN_WOUT, I_WQKV, I_QGAIN, I_KGAIN, I_WO, I_RELB };

struct Ctx { LAS unsigned char* lds; int tid, lane, wave, G, vcu; unsigned char* ws; };

typedef short v4i16_t __attribute__((ext_vector_type(4)));
__device__ __forceinline__ v4i16_t vtr16(const LAS unsigned char* p) { return __builtin_amdgcn_ds_read_tr16_b64_v4i16((LAS v4i16_t*)p); }
enum { CM_NONE = 0, CM_FFN = 1, CM_QKV = 2 };
__device__ __forceinline__ int colmap(int mode, int vr) {
    if (mode == CM_FFN) { const int pn = vr >> 8, w = vr & 255; return (w >> 7) * FF + 128 * pn + (w & 127); }
    if (mode == CM_QKV) { const int pn = vr >> 8, w = vr & 255, bj = w >> 7, wc = (w >> 5) & 3, j = w & 31; return 256 * pn + 64 * wc + 32 * bj + j; }
    return vr;
}
__device__ __forceinline__ void transpose_item(const float* W, int K, int N, const float* gvec, bf16* WT, int mode, LAS unsigned char* scr, int item, int lane) {
    const int nblk = N / 64, kb = item / nblk, nb = item - kb * nblk, k0 = 64 * kb, vr0 = 64 * nb;
    const int col4 = lane & 15, rsub = lane >> 4, nsrc = colmap(mode, vr0 + 32 * (col4 >> 3)) + (col4 & 7) * 4;
    const float* src = W + (size_t)(k0 + rsub) * N + nsrc;
    f32x4 w[16];
#pragma unroll
    for (int i = 0; i < 16; ++i) w[i] = __builtin_nontemporal_load((const GAS f32x4*)(src + (size_t)(4 * i) * N));
    if (gvec) {
#pragma unroll
        for (int i = 0; i < 16; ++i) w[i] = w[i] * gvec[k0 + 4 * i + rsub];
    }
#pragma unroll
    for (int i = 0; i < 16; ++i) { v2u p; p.x = pg8::cvt_pk_bf16(w[i][0], w[i][1]); p.y = pg8::cvt_pk_bf16(w[i][2], w[i][3]);
        *(LAS v2u*)(scr + (col4 >> 3) * 4096 + (4 * i + rsub) * 64 + (col4 & 7) * 8) = p; }
    const int q = (lane & 15) >> 2, p4 = lane & 3, gidx = lane >> 4;
#pragma unroll
    for (int r = 0; r < 8; ++r) { const int nb16 = r >> 1, kh = r & 1, kbase = 32 * kh + 8 * gidx;
        const LAS unsigned char* a = scr + (nb16 >> 1) * 4096 + (kbase + q) * 64 + ((nb16 & 1) * 16 + 4 * p4) * 2;
        const v4i16_t lo = vtr16(a), hi = vtr16(a + 4 * 64);
        v4u o; { const v2u l2 = __builtin_bit_cast(v2u, lo), h2 = __builtin_bit_cast(v2u, hi); o.x = l2.x; o.y = l2.y; o.z = h2.x; o.w = h2.y; }
        *(GAS v4u*)(WT + (size_t)(vr0 + nb16 * 16 + (lane & 15)) * K + k0 + kbase) = o; }
}
struct MatJob { const float* W; int K, N; const float* g; bf16* WT; int mode; };
__device__ __forceinline__ MatJob mat_job(const Ctx& C, const Args& a, int idx) {
    unsigned char* ws = C.ws; const float* ng = a.in[I_NORMG]; MatJob j;
    switch (idx) {
    case 0: j = MatJob{a.in[I_FFN_WIN] + (size_t)0 * D * 2 * FF, D, 2 * FF, ng + 0 * D, (bf16*)(ws + WS_WIN0), CM_FFN}; break;
    case 1: j = MatJob{a.in[I_FFN_WOUT] + (size_t)0 * FF * D, FF, D, nullptr, (bf16*)(ws + WS_WOUT0), CM_NONE}; break;
    case 2: j = MatJob{a.in[I_RNN_WIN], D, 2 * DRNN, ng + 1 * D, (bf16*)(ws + WS_WRIN), CM_NONE}; break;
    case 3: j = MatJob{a.in[I_RNN_WOUT], DRNN, D, nullptr, (bf16*)(ws + WS_WROUT), CM_NONE}; break;
    case 4: j = MatJob{a.in[I_FFN_WIN] + (size_t)1 * D * 2 * FF, D, 2 * FF, ng + 2 * D, (bf16*)(ws + WS_WIN1), CM_FFN}; break;
    case 5: j = MatJob{a.in[I_FFN_WOUT] + (size_t)1 * FF * D, FF, D, nullptr, (bf16*)(ws + WS_WOUT1), CM_NONE}; break;
    case 6: j = MatJob{a.in[I_WQKV], D, NQKV, ng + 4 * D, (bf16*)(ws + WS_WQKV), CM_QKV}; break;
    case 7: j = MatJob{a.in[I_WO], D, D, nullptr, (bf16*)(ws + WS_WO), CM_NONE}; break;
    case 8: j = MatJob{a.in[I_FFN_WIN] + (size_t)2 * D * 2 * FF, D, 2 * FF, ng + 3 * D, (bf16*)(ws + WS_WIN2), CM_FFN}; break;
    case 9: j = MatJob{a.in[I_FFN_WOUT] + (size_t)2 * FF * D, FF, D, nullptr, (bf16*)(ws + WS_WOUT2), CM_NONE}; break;
    case 10: j = MatJob{a.in[I_FFN_WIN] + (size_t)3 * D * 2 * FF, D, 2 * FF, ng + 5 * D, (bf16*)a.out, CM_FFN}; break;
    default: j = MatJob{a.in[I_FFN_WOUT] + (size_t)3 * FF * D, FF, D, nullptr, (bf16*)(ws + WS_WOUT3), CM_NONE}; break;
    }
    return j;
}
__device__ __forceinline__ void convert_mats(const Ctx& C, const Args& a, int first, int last, int gw, int NGW) {
    LAS unsigned char* scr = C.lds + C.wave * 8192;
    int base = 0;
    for (int mi = first; mi < last; ++mi) {
        const MatJob j = mat_job(C, a, mi); const int cnt = (j.K / 64) * (j.N / 64);
        int it = (gw - base) % NGW; if (it < 0) it += NGW;
        for (; it < cnt; it += NGW) transpose_item(j.W, j.K, j.N, j.g, j.WT, j.mode, scr, it, C.lane);
        base += cnt;
    }
}
__device__ __forceinline__ void spare_convert(const Ctx& C, const Args& a, int first, int last, int nwg) {
    const int R = (nwg + C.G - 1) / C.G, first_spare = nwg - (R - 1) * C.G, nspare = C.G - first_spare, c = (int)blockIdx.x;
    if (nspare > 0) { if (c >= first_spare) convert_mats(C, a, first, last, (c - first_spare) * NWAVES + C.wave, nspare * NWAVES); }
    else convert_mats(C, a, first, last, c * NWAVES + C.wave, C.G * NWAVES);
    __syncthreads();
}
__device__ __forceinline__ int t5_bucket(int n) {
    if (n < 16) return n;
    int b = 16;
    b += (n >= 22) + (n >= 30) + (n >= 40) + (n >= 54) + (n >= 73) + (n >= 99) + (n >= 134) + (n >= 182) + (n >= 246) + (n >= 332) + (n >= 450) + (n >= 609) + (n >= 825) + (n >= 1117) + (n >= 1513);
    return b;
}
__device__ __forceinline__ void p_prologue(const Ctx& C, const Args& a) {
    const int gw = C.vcu * NWAVES + C.wave, NGW = C.G * NWAVES;
    convert_mats(C, a, 0, 1, gw, NGW);
    {   LAS unsigned char* scr = C.lds + C.wave * 8192;
        for (int it = gw; it < 2 * NBLK * 4; it += NGW) { const int which = it / (NBLK * 4), r = it % (NBLK * 4), blk = r >> 2, sub = r & 3;
            const float* W = (which ? a.in[I_WX] : a.in[I_WA]) + (size_t)blk * RBLK * RBLK; bf16* WT = (bf16*)(C.ws + (which ? WS_WX : WS_WA)) + (size_t)blk * RBLK * RBLK;
            transpose_item(W, RBLK, RBLK, nullptr, WT, CM_NONE, scr, sub, C.lane); } }
    const float* x = a.in[I_X]; bf16* xb = (bf16*)(C.ws + WS_XB); float* ssq = (float*)(C.ws + WS_SSQ);
    for (int m = gw; m < M; m += NGW) {
        const GAS f32x4* xr = (const GAS f32x4*)(x + (size_t)m * D) + C.lane; f32x4 v[4]; float s = 0.f;
#pragma unroll
        for (int j = 0; j < 4; ++j) { v[j] = __builtin_nontemporal_load(xr + 64 * j); s += (v[j].x * v[j].x + v[j].y * v[j].y) + (v[j].z * v[j].z + v[j].w * v[j].w); }
        s = wave_sum(s);
        GAS v2u* o8 = (GAS v2u*)(xb + (size_t)m * D) + C.lane;
#pragma unroll
        for (int j = 0; j < 4; ++j) { v2u w; w.x = pk2(v[j].x, v[j].y); w.y = pk2(v[j].z, v[j].w); o8[64 * j] = w; }
        if (C.lane < 16) ssq[(size_t)m * 16 + C.lane] = (C.lane == 0) ? s : 0.f;
    }
    float* bt = (float*)(C.ws + WS_BIAS); const float* rb = a.in[I_RELB];
    for (int i = blockIdx.x * 512 + C.tid; i < 48 * 129; i += C.G * 512) { const int gh = i / 129, dist = i - gh * 129, g = gh >> 4;
        bt[gh * 132 + dist] = rb[t5_bucket(dist << (2 * g)) * 48 + gh] * LOG2E; }
}

typedef float f32x16 __attribute__((ext_vector_type(16)));
typedef short bf16x8v __attribute__((ext_vector_type(8)));
constexpr int RM_WB = 0, RM_WB_GATE = 64 * 272, RM_CW = 36864, RM_CMP = RM_CW + 2560, RM_TILE = 49152, RM_TILE_BYTES = 36 * 256, RM_END = RM_TILE + 8 * RM_TILE_BYTES;
static_assert(RM_WB + 2 * RM_WB_GATE <= RM_CW && RM_CMP + 2 * 2 * 8 * 64 * 4 <= RM_TILE && RM_END <= RING_BYTES, "rnn-mid LDS map");
__device__ __forceinline__ bf16x8v pack8(const float (&v)[8]) {
    v4u w; w.x = pg8::cvt_pk_bf16(v[0], v[1]); w.y = pg8::cvt_pk_bf16(v[2], v[3]); w.z = pg8::cvt_pk_bf16(v[4], v[5]); w.w = pg8::cvt_pk_bf16(v[6], v[7]);
    return __builtin_bit_cast(bf16x8v, w);
}
__device__ __forceinline__ void p_rnn_mid(const Ctx& C, const Args& a) {
    const bf16* U = (const bf16*)(C.ws + WS_U); const bf16* Gb = (const bf16*)(C.ws + WS_G); bf16* Y = (bf16*)(C.ws + WS_Y);
    const bf16* WAb = (const bf16*)(C.ws + WS_WA); const bf16* WXb = (const bf16*)(C.ws + WS_WX);
    LAS unsigned char* L = C.lds;
    LAS float* CW = (LAS float*)(L + RM_CW); LAS float* CMP = (LAS float*)(L + RM_CMP);
    const int wave = C.wave;
    LAS unsigned char* wt = L + RM_TILE + wave * RM_TILE_BYTES;
    for (int item = blockIdx.x; item < BATCH * NBLK * 2; item += C.G) {
        const int b = item / (NBLK * 2), n = (item % (NBLK * 2)) >> 1, half = item & 1;
        int tid = C.tid; asm volatile("" : "+v"(tid));
        const int lane = tid & 63, r32 = lane & 31, hh = lane >> 5;
        __syncthreads();
#pragma unroll
        for (int p = 0; p < 4; ++p) { const int idx = p * 512 + tid, gate = idx >> 10, rem = idx & 1023, row = rem >> 4, c16 = rem & 15;
            const v4u w = *(const v4u*)((gate ? WXb : WAb) + (size_t)(n * 128 + 64 * half + row) * 128 + c16 * 8);
            *(LAS v4u*)(L + RM_WB + gate * RM_WB_GATE + row * 272 + c16 * 16) = w; }
        CW[tid] = a.in[I_CONV_W][(tid >> 7) * DRNN + n * 128 + (tid & 127)];
        if (tid < 128) CW[512 + tid] = a.in[I_CONV_B][n * 128 + tid];
        __syncthreads();
        float ba[2], bx[2], spl[2], Ht[2];
#pragma unroll
        for (int cb = 0; cb < 2; ++cb) { const int ch = n * 128 + 64 * half + 32 * cb + r32; ba[cb] = a.in[I_BA][ch]; bx[cb] = a.in[I_BX][ch];
            spl[cb] = -8.0f * LOG2E * log1pf(expf(-a.in[I_LAM][ch])); Ht[cb] = 0.f; }
        bf16x8v idf[2];
#pragma unroll
        for (int sp = 0; sp < 2; ++sp)
#pragma unroll
            for (int j = 0; j < 8; ++j) idf[sp][j] = (16 * sp + 8 * hh + j == r32) ? (short)0x3F80 : (short)0;
        const int urow = lane >> 4, uch = lane & 15, grow = lane >> 3, gch = lane & 7;
        v4u uraw[9], graw[4];
#define RM_LOADU(TILE) do { const int tp_ = (TILE) * 256 + wave * 32; const int ub_ = (b * SEQ + tp_ - 3 + urow) * DRNN + n * 128 + uch * 8;        \
        _Pragma("unroll") for (int i_ = 0; i_ < 9; ++i_) uraw[i_] = *(const v4u*)(U + (ptrdiff_t)(ub_ + i_ * 4 * DRNN)); \
        if (tp_ == 0 && urow < 3) uraw[0] = (v4u){0u, 0u, 0u, 0u};         } while (0)
#define RM_LOADG(TILE) do { const int gb_ = (b * SEQ + (TILE) * 256 + wave * 32 + grow) * DRNN + n * 128 + 64 * half + gch * 8; \
        _Pragma("unroll") for (int i_ = 0; i_ < 4; ++i_) graw[i_] = *(const v4u*)(Gb + (unsigned)(gb_ + i_ * 8 * DRNN)); } while (0)
        for (int tile = 0; tile < 8; ++tile) {
            const int tposw = tile * 256 + wave * 32;
            const size_t tok0 = (size_t)b * SEQ + tposw;
            LAS float* CWt = CW; LAS unsigned char* WBt = L + RM_WB; asm volatile("" : "+v"(CWt), "+v"(WBt));
            RM_LOADU(tile); RM_LOADG(tile);
#pragma unroll
            for (int i = 0; i < 9; ++i) { const int rl = 4 * i + urow; *(LAS v4u*)(wt + rl * 256 + ((uch ^ (rl & 15)) << 4)) = uraw[i]; }
            {
                const int tg = lane >> 4, cc = lane & 15;
                f32x2 wv[4][4], bv2[4];
#pragma unroll
                for (int k = 0; k < 4; ++k) { const f32x4 w0 = *(const LAS f32x4*)(CWt + k * 128 + 8 * cc), w1 = *(const LAS f32x4*)(CWt + k * 128 + 8 * cc + 4);
                    wv[k][0] = (f32x2){w0[0], w0[1]}; wv[k][1] = (f32x2){w0[2], w0[3]}; wv[k][2] = (f32x2){w1[0], w1[1]}; wv[k][3] = (f32x2){w1[2], w1[3]}; }
                { const f32x4 b0 = *(const LAS f32x4*)(CWt + 512 + 8 * cc), b1 = *(const LAS f32x4*)(CWt + 512 + 8 * cc + 4);
                  bv2[0] = (f32x2){b0[0], b0[1]}; bv2[1] = (f32x2){b0[2], b0[3]}; bv2[2] = (f32x2){b1[0], b1[1]}; bv2[3] = (f32x2){b1[2], b1[3]}; }
                v4u ur[11];
#pragma unroll
                for (int j = 0; j < 11; ++j) { const int rl = 8 * tg + j; ur[j] = *(const LAS v4u*)(wt + rl * 256 + ((cc ^ (rl & 15)) << 4)); }
                f32x2 o[8][4];
#pragma unroll
                for (int i = 0; i < 8; ++i)
#pragma unroll
                    for (int e = 0; e < 4; ++e) o[i][e] = bv2[e];
#pragma unroll
                for (int j = 0; j < 11; ++j) {
                    const f32x2 u0 = (f32x2){bf_lo(ur[j].x), bf_hi(ur[j].x)}, u1 = (f32x2){bf_lo(ur[j].y), bf_hi(ur[j].y)}, u2 = (f32x2){bf_lo(ur[j].z), bf_hi(ur[j].z)}, u3 = (f32x2){bf_lo(ur[j].w), bf_hi(ur[j].w)};
#pragma unroll
                    for (int k = 0; k < 4; ++k) { const int i = j - k; if (i >= 0 && i < 8) {
                        o[i][0] += wv[k][0] * u0; o[i][1] += wv[k][1] * u1; o[i][2] += wv[k][2] * u2; o[i][3] += wv[k][3] * u3; } }
                }
#pragma unroll
                for (int i = 0; i < 8; ++i) { const int rl = 8 * tg + i;
                    v4u w; w.x = pg8::cvt_pk_bf16(o[i][0].x, o[i][0].y); w.y = pg8::cvt_pk_bf16(o[i][1].x, o[i][1].y); w.z = pg8::cvt_pk_bf16(o[i][2].x, o[i][2].y); w.w = pg8::cvt_pk_bf16(o[i][3].x, o[i][3].y);
                    *(LAS v4u*)(wt + rl * 256 + ((cc ^ (rl & 15)) << 4)) = w; }
            }
            bf16x8v af[8];
#pragma unroll
            for (int s = 0; s < 8; ++s) af[s] = *(const LAS bf16x8v*)(wt + r32 * 256 + (((2 * s + hh) ^ (r32 & 15)) << 4));
#pragma unroll
            for (int i = 0; i < 4; ++i) *(LAS v4u*)(wt + (8 * i + grow) * 128 + gch * 16) = graw[i];
            f32x16 acc[2][2], ufa[2];
#pragma unroll
            for (int cb = 0; cb < 2; ++cb)
#pragma unroll
                for (int e = 0; e < 16; ++e) { acc[0][cb][e] = 0.f; acc[1][cb][e] = 0.f; ufa[cb][e] = 0.f; }
            bf16x8v bq[2][4];
#define RM_LDB(S, DST) do { _Pragma("unroll") for (int g_ = 0; g_ < 2; ++g_) _Pragma("unroll") for (int c_ = 0; c_ < 2; ++c_) \
                DST[g_ * 2 + c_] = *(const LAS bf16x8v*)(WBt + g_ * RM_WB_GATE + (32 * c_ + r32) * 272 + (16 * (S) + 8 * hh) * 2); } while (0)
            RM_LDB(0, bq[0]);
#pragma unroll
            for (int s = 0; s < 8; ++s) {
                if (s < 7) RM_LDB(s + 1, bq[(s + 1) & 1]);
#pragma unroll
                for (int gt = 0; gt < 2; ++gt)
#pragma unroll
                    for (int cb = 0; cb < 2; ++cb) acc[gt][cb] = __builtin_amdgcn_mfma_f32_32x32x16_bf16(af[s], bq[s & 1][gt * 2 + cb], acc[gt][cb], 0, 0, 0);
            }
#undef RM_LDB
#pragma unroll
            for (int cb = 0; cb < 2; ++cb)
#pragma unroll
                for (int sp = 0; sp < 2; ++sp) { const bf16x8v asel = half ? af[4 + 2 * cb + sp] : af[2 * cb + sp];
                    ufa[cb] = __builtin_amdgcn_mfma_f32_32x32x16_bf16(asel, idf[sp], ufa[cb], 0, 0, 0); }
#pragma unroll
            for (int cb = 0; cb < 2; ++cb)
#pragma unroll
                for (int e = 0; e < 16; ++e) {
                    const float uf = ufa[cb][e];
                    const float r = fast_sigmoid(acc[0][cb][e] + ba[cb]), ii = fast_sigmoid(acc[1][cb][e] + bx[cb]);
                    const float av = __builtin_amdgcn_exp2f(r * spl[cb]);
                    const float bv = __builtin_amdgcn_sqrtf(fmaxf(1.f - av * av, 0.f)) * (ii * uf);
                    acc[0][cb][e] = av; acc[1][cb][e] = bv;
                }
            float A0[2][4], B0[2][4], A1[2][4], B1[2][4];
            const int par = tile & 1;
#pragma unroll
            for (int cb = 0; cb < 2; ++cb) {
                float Aw = 1.f, Bw = 0.f;
#pragma unroll
                for (int q = 0; q < 4; ++q) {
                    const float a0 = acc[0][cb][4 * q], a1 = acc[0][cb][4 * q + 1], a2 = acc[0][cb][4 * q + 2], a3 = acc[0][cb][4 * q + 3];
                    const float Ag = (a0 * a1) * (a2 * a3);
                    const float Bg = ((acc[1][cb][4 * q] * a1 + acc[1][cb][4 * q + 1]) * a2 + acc[1][cb][4 * q + 2]) * a3 + acc[1][cb][4 * q + 3];
                    const float pA = __shfl_xor(Ag, 32), pB = __shfl_xor(Bg, 32);
                    A0[cb][q] = hh ? pA : Ag; B0[cb][q] = hh ? pB : Bg; A1[cb][q] = hh ? Ag : pA; B1[cb][q] = hh ? Bg : pB;
                    Bw = Bw * A0[cb][q] + B0[cb][q]; Aw *= A0[cb][q]; Bw = Bw * A1[cb][q] + B1[cb][q]; Aw *= A1[cb][q];
                }
                if (hh == 0) { CMP[((par * 2 + 0) * 8 + wave) * 64 + 32 * cb + r32] = Aw; CMP[((par * 2 + 1) * 8 + wave) * 64 + 32 * cb + r32] = Bw; }
            }
            __syncthreads();
#pragma unroll
            for (int cb = 0; cb < 2; ++cb) {
                float h = Ht[cb], hin = 0.f;
#pragma unroll
                for (int v = 0; v < 8; ++v) { const float Av = CMP[((par * 2 + 0) * 8 + v) * 64 + 32 * cb + r32], Bv = CMP[((par * 2 + 1) * 8 + v) * 64 + 32 * cb + r32];
                    hin = (v == wave) ? h : hin; h = Av * h + Bv; }
                Ht[cb] = h;
                float hc = hin;
#pragma unroll
                for (int q = 0; q < 4; ++q) {
                    const float c0 = hc; hc = A0[cb][q] * hc + B0[cb][q]; const float c1 = hc; hc = A1[cb][q] * hc + B1[cb][q];
                    float hv = hh ? c1 : c0;
#pragma unroll
                    for (int i = 0; i < 4; ++i) { const int e = 4 * q + i; hv = acc[0][cb][e] * hv + acc[1][cb][e];
                        const int tl = (e & 3) + 8 * (e >> 2) + 4 * hh;
                        LAS bf16* gp = (LAS bf16*)(wt + tl * 128 + (32 * cb + r32) * 2);
                        *gp = (bf16)f2bf(hv * bf2f(*gp)); }
                }
            }
#pragma unroll
            for (int i = 0; i < 4; ++i) { const v4u w = *(const LAS v4u*)(wt + (8 * i + grow) * 128 + gch * 16);
                *(v4u*)(Y + (unsigned)(((int)tok0 + 8 * i + grow) * DRNN + n * 128 + 64 * half + gch * 8)) = w; }
        }
#undef RM_LOADU
#undef RM_LOADG
    }
    const int nitems = BATCH * NBLK * 2;
    if (C.G > nitems) { if ((int)blockIdx.x >= nitems) convert_mats(C, a, 4, 8, ((int)blockIdx.x - nitems) * NWAVES + wave, (C.G - nitems) * NWAVES); }
    else { __syncthreads(); convert_mats(C, a, 4, 8, (int)blockIdx.x * NWAVES + wave, C.G * NWAVES); }
}
constexpr int AT_EXT = 0, AT_VT = 48 * 192 * 4;
struct AttnUnit { bf16* qbase; const bf16* kres; const bf16* vres; int l0, kb_lo, eoff, g, bh, llin0; };
__device__ __forceinline__ AttnUnit attn_unit(bf16* QKV, int it, int wave) {
    AttnUnit u; const size_t SLAB = (size_t)M * 1024;
    const int g = it >> 10, rem = it & 1023, bh = rem >> 3, chunk = (rem + (it >> 8)) & 7, l2d = 2 * g, L = SEQ >> l2d;
    u.g = g; u.bh = bh; u.llin0 = chunk * 256 + wave * 32; u.l0 = u.llin0 & (L - 1); u.kb_lo = (u.l0 - 128) > 0 ? (u.l0 - 128) : 0; u.eoff = (g * 16 + (bh & 15)) * 192;
    u.qbase = QKV + (size_t)g * SLAB + ((size_t)bh * SEQ + u.llin0) * HD;
    u.kres = u.qbase + 3 * SLAB - (size_t)u.l0 * HD; u.vres = u.qbase + 6 * SLAB - (size_t)u.l0 * HD;
    return u;
}
__device__ __forceinline__ void p_attn(const Ctx& C, const bool dry) {
    bf16* QKV = (bf16*)(C.ws + WS_QKV); float* LSE = (float*)(C.ws + WS_LSE); const float* bt = (const float*)(C.ws + WS_BIAS);
    LAS float* ext = (LAS float*)(C.lds + AT_EXT);
    LAS unsigned char* vt = C.lds + AT_VT + C.wave * 8192; LAS unsigned char* kt = vt + 4096;
    const int lane = C.lane, r32 = lane & 31, hh = lane >> 5, wave = C.wave, tid = C.tid;
    const int crow8 = lane >> 3, cch = lane & 7;
    const int vtr_off = (4 * hh + ((lane & 15) >> 2)) * 64 + ((lane >> 4) & 1) * 32 + (lane & 3) * 8;
    for (int i = tid; i < 48 * 192; i += 512) { const int gh = i / 192, dist = i - gh * 192 - 32; ext[i] = (dist >= 0 && dist <= 128) ? bt[gh * 132 + dist] : -1e30f; }
    __syncthreads();
    const int total = NGRP * BATCH * NHEAD * 8;
    int it = blockIdx.x;
    if (it >= total) return;
    AttnUnit cu = attn_unit(QKV, it, wave), nu = cu;
    v4u qfn[4], kfn[4], vvn[4];
#define AT_LOADKV(U, KB) do { const bf16* kblk_ = (U).kres + (size_t)(KB) * HD; const bf16* vblk_ = (U).vres + (size_t)(KB) * HD; \
        _Pragma("unroll") for (int i_ = 0; i_ < 4; ++i_) { vvn[i_] = *(const v4u*)(vblk_ + (8 * i_ + crow8) * HD + cch * 8); kfn[i_] = *(const v4u*)(kblk_ + (8 * i_ + crow8) * HD + cch * 8); } } while (0)
#define AT_LOADQ(U) do { _Pragma("unroll") for (int i_ = 0; i_ < 4; ++i_) qfn[i_] = *(const v4u*)((U).qbase + (8 * i_ + crow8) * HD + cch * 8); } while (0)
#define AT_TILE2FRAG(RAW, FR) do { _Pragma("unroll") for (int i_ = 0; i_ < 4; ++i_) *(LAS v4u*)(kt + (8 * i_ + crow8) * 128 + ((cch ^ crow8) << 4)) = RAW[i_]; \
        _Pragma("unroll") for (int s_ = 0; s_ < 4; ++s_) FR[s_] = *(const LAS bf16x8v*)(kt + r32 * 128 + (((2 * s_ + hh) ^ (r32 & 7)) << 4)); } while (0)
    AT_LOADQ(cu); AT_LOADKV(cu, cu.l0);
    for (;;) {
        bf16x8v qf[4];
        AT_TILE2FRAG(qfn, qf);
        f32x16 o0, o1;
#pragma unroll
        for (int e = 0; e < 16; ++e) { o0[e] = 0.f; o1[e] = 0.f; }
        float mrow = -1e30f, lsum = 0.f;
        const bool has_next = (it + C.G) < total;
        for (int kb = cu.l0; kb >= cu.kb_lo; kb -= 32) {
            v4u vv[4], kraw[4]; bf16x8v kf[4];
#pragma unroll
            for (int i = 0; i < 4; ++i) { vv[i] = vvn[i]; kraw[i] = kfn[i]; }
            if (kb - 32 >= cu.kb_lo) { AT_LOADKV(cu, kb - 32); }
            else if (has_next) { nu = attn_unit(QKV, it + C.G, wave); AT_LOADQ(nu); AT_LOADKV(nu, nu.l0); }
#pragma unroll
            for (int i = 0; i < 4; ++i) *(LAS v4u*)(vt + (cch >> 2) * 2048 + (8 * i + crow8) * 64 + (cch & 3) * 16) = vv[i];
            AT_TILE2FRAG(kraw, kf);
            f32x16 p;
#pragma unroll
            for (int e = 0; e < 16; ++e) p[e] = 0.f;
#pragma unroll
            for (int s = 0; s < 4; ++s) p = __builtin_amdgcn_mfma_f32_32x32x16_bf16(kf[s], qf[s], p, 0, 0, 0);
            const int eb = cu.eoff + cu.l0 + r32 - kb - 4 * hh + 32;
            float bm = -1e30f;
#pragma unroll
            for (int e = 0; e < 16; ++e) { p[e] += ext[eb - ((e & 3) + 8 * (e >> 2))]; bm = fmaxf(bm, p[e]); }
            bm = fmaxf(bm, __shfl_xor(bm, 32));
            const float mn = fmaxf(mrow, bm), alpha = __builtin_amdgcn_exp2f(mrow - mn); mrow = mn;
            float ps = 0.f;
#pragma unroll
            for (int e = 0; e < 16; ++e) { p[e] = __builtin_amdgcn_exp2f(p[e] - mn); ps += p[e]; }
            lsum = lsum * alpha + ps;
#pragma unroll
            for (int e = 0; e < 16; ++e) { o0[e] *= alpha; o1[e] *= alpha; }
            bf16x8v pf[2];
#pragma unroll
            for (int s = 0; s < 2; ++s) { const float t8[8] = {p[8 * s], p[8 * s + 1], p[8 * s + 2], p[8 * s + 3], p[8 * s + 4], p[8 * s + 5], p[8 * s + 6], p[8 * s + 7]}; pf[s] = pack8(t8); }
#pragma unroll
            for (int s = 0; s < 2; ++s) {
                const v4i16_t a00 = vtr16(vt + 0 * 2048 + (16 * s) * 64 + vtr_off), a01 = vtr16(vt + 0 * 2048 + (16 * s + 8) * 64 + vtr_off);
                const v4i16_t a10 = vtr16(vt + 1 * 2048 + (16 * s) * 64 + vtr_off), a11 = vtr16(vt + 1 * 2048 + (16 * s + 8) * 64 + vtr_off);
                const bf16x8v va0 = (bf16x8v){a00[0], a00[1], a00[2], a00[3], a01[0], a01[1], a01[2], a01[3]};
                const bf16x8v va1 = (bf16x8v){a10[0], a10[1], a10[2], a10[3], a11[0], a11[1], a11[2], a11[3]};
                o0 = __builtin_amdgcn_mfma_f32_32x32x16_bf16(va0, pf[s], o0, 0, 0, 0);
                o1 = __builtin_amdgcn_mfma_f32_32x32x16_bf16(va1, pf[s], o1, 0, 0, 0);
            }
        }
        const float ltot = lsum + __shfl_xor(lsum, 32), inv = 1.f / ltot;
#pragma unroll
        for (int q = 0; q < 4; ++q) {
            v2u w0, w1;
            w0.x = pg8::cvt_pk_bf16(o0[4 * q] * inv, o0[4 * q + 1] * inv); w0.y = pg8::cvt_pk_bf16(o0[4 * q + 2] * inv, o0[4 * q + 3] * inv);
            w1.x = pg8::cvt_pk_bf16(o1[4 * q] * inv, o1[4 * q + 1] * inv); w1.y = pg8::cvt_pk_bf16(o1[4 * q + 2] * inv, o1[4 * q + 3] * inv);
            *(LAS v2u*)(kt + r32 * 128 + ((q ^ (r32 & 7)) << 4) + 8 * hh) = w0; *(LAS v2u*)(kt + r32 * 128 + (((4 + q) ^ (r32 & 7)) << 4) + 8 * hh) = w1;
        }
        if (!dry)
#pragma unroll
        for (int i = 0; i < 4; ++i) { const v4u w = *(const LAS v4u*)(kt + (8 * i + crow8) * 128 + ((cch ^ crow8) << 4)); *(v4u*)(cu.qbase + (8 * i + crow8) * HD + cch * 8) = w; }
        if (hh == 0) { const int l2d = 2 * cu.g, L = SEQ >> l2d, llin = cu.llin0 + r32, rres = llin >> (11 - l2d), l = llin & (L - 1), t = (l << l2d) + rres, row = (cu.bh >> 4) * SEQ + t;
            LSE[((size_t)cu.g * M + row) * 16 + (cu.bh & 15)] = mrow + log2f(ltot); }
        if (!has_next) break;
        it += C.G; cu = nu;
    }
#undef AT_LOADKV
#undef AT_LOADQ
#undef AT_TILE2FRAG
}
__device__ __forceinline__ void p_merge(const Ctx& C, const Args& a) {
    const bf16* QKV = (const bf16*)(C.ws + WS_QKV); const float* LSE = (const float*)(C.ws + WS_LSE); bf16* ATT = (bf16*)(C.ws + WS_ATT);
    for (int idx = blockIdx.x * 512 + C.tid; idx < M * 16 * 8; idx += C.G * 512) {
        const int ch = idx & 7, h = (idx >> 3) & 15, row = idx >> 7, b = row >> 11, t = row & 2047;
        float ls[3], mxl = -INFINITY;
#pragma unroll
        for (int g = 0; g < 3; ++g) { ls[g] = LSE[((size_t)g * M + row) * 16 + h]; mxl = fmaxf(mxl, ls[g]); }
        float acc[8], wsum = 0.f;
#pragma unroll
        for (int e = 0; e < 8; ++e) acc[e] = 0.f;
#pragma unroll
        for (int g = 0; g < 3; ++g) { const float w = exp2f(ls[g] - mxl); wsum += w; const int l2d = 2 * g, rres = t & ((1 << l2d) - 1), l = t >> l2d, L = SEQ >> l2d;
            const v4u v = *(const v4u*)(QKV + (size_t)g * ((size_t)M * 1024) + ((size_t)(b * 16 + h) * SEQ + rres * L + l) * HD + 8 * ch);
            acc[0] += w * bf_lo(v.x); acc[1] += w * bf_hi(v.x); acc[2] += w * bf_lo(v.y); acc[3] += w * bf_hi(v.y); acc[4] += w * bf_lo(v.z); acc[5] += w * bf_hi(v.z); acc[6] += w * bf_lo(v.w); acc[7] += w * bf_hi(v.w); }
        const float inv = 1.f / wsum; v4u o; o.x = pk2(acc[0] * inv, acc[1] * inv); o.y = pk2(acc[2] * inv, acc[3] * inv); o.z = pk2(acc[4] * inv, acc[5] * inv); o.w = pk2(acc[6] * inv, acc[7] * inv);
        *(v4u*)(ATT + (size_t)row * 1024 + h * 64 + 8 * ch) = o;
    }
}

enum { PH_PROLOGUE = 0, PH_FFN_IN_0, PH_FFN_OUT_0, PH_RNN_IN, PH_RNN_MID, PH_RNN_OUT, PH_FFN_IN_1, PH_FFN_OUT_1,
       PH_FFN_IN_2, PH_FFN_OUT_2, PH_QKV, PH_ATTN, PH_MERGE, PH_WO, PH_FFN_IN_3, PH_FFN_OUT_3, NPHASE };

__global__ void __launch_bounds__(NWAVES * 64, 2) fwd_kernel(Args args) {
    extern __shared__ __attribute__((aligned(16))) unsigned char lds_raw[];
    Ctx C; C.lds = (LAS unsigned char*)lds_raw; C.tid = threadIdx.x; C.lane = C.tid & 63; C.wave = __builtin_amdgcn_readfirstlane(C.tid >> 6);
    C.G = gridDim.x; { const int bx = blockIdx.x; C.vcu = (C.G % 8 == 0) ? (bx % 8) * (C.G / 8) + bx / 8 : bx; }
    C.ws = args.ws;
    volatile LAS unsigned* MISC = (volatile LAS unsigned*)(C.lds + MISC_OFF);
    for (int u = C.tid; u < (LDS_BYTES - LDSCTL_OFF) / 4; u += NWAVES * 64) ((LAS unsigned*)(C.lds + LDSCTL_OFF))[u] = 0u;
    __syncthreads();
    unsigned* ctl = (unsigned*)args.ws;
    XcdBarrier bar; bar.bar = ctl + CW_BAR; bar.x = 0; bar.st = nullptr;
    const bool multi = (args.ph_hi - args.ph_lo) > 1;
    if (multi) bar = xcd_barrier_post(ctl + CW_BAR, MISC + 8);
    for (int ph = args.ph_lo; ph < args.ph_hi; ++ph) {
        for (int rep = ((DUP_MASK >> ph) & 1u) ? DUP_N : 0; rep >= 0; --rep) {
        const bool dry = rep > 0;
        { int t_ = threadIdx.x; asm volatile("" : "+v"(t_)); C.tid = t_; C.lane = t_ & 63; }
        unsigned char* ws = args.ws;
        C.ws = ws; float* ssq = (float*)(ws + WS_SSQ); bf16* xb = (bf16*)(ws + WS_XB);
        switch (ph) {
        case PH_PROLOGUE: p_prologue(C, args); break;
        case PH_FFN_IN_0: case PH_FFN_IN_1: case PH_FFN_IN_2: case PH_FFN_IN_3: {
            if (!dry && ph != PH_FFN_IN_3) { const int f = (ph == PH_FFN_IN_0) ? 1 : (ph == PH_FFN_IN_1) ? 8 : 10, l = (ph == PH_FFN_IN_0) ? 4 : (ph == PH_FFN_IN_1) ? 10 : 12; spare_convert(C, args, f, l, (M / 256) * (2 * FF / 256)); }
            const bf16* Bt = (ph == PH_FFN_IN_3) ? (const bf16*)args.out : (const bf16*)(ws + (ph == PH_FFN_IN_0 ? WS_WIN0 : ph == PH_FFN_IN_1 ? WS_WIN1 : WS_WIN2));
            bf16* act = (bf16*)(ws + (ph == PH_FFN_IN_3 ? WS_ACT3 : WS_ACT));
            pg8::Gemm g{xb, Bt, M, 2 * FF, D}; pg8::StaticOrder S; S.init(M, 2 * FF, C.G, (int)blockIdx.x);
            fill_rstd(C.lds, S, ssq, C.tid);
            EpiSwiGLU E{(const LAS float*)(C.lds + RSTD_OFF), act, dry ? DUP_SKIP_EPI : 0};
            pg8::gemm_phase<EpiSwiGLU, pg8::StaticOrder, true, true>(C.lds, g, S, E);
        } break;
        case PH_FFN_OUT_0: case PH_FFN_OUT_1: case PH_FFN_OUT_2: case PH_FFN_OUT_3: case PH_RNN_OUT: case PH_WO: {
            const bf16* A; const bf16* Bt; int K; float scale = 0.5f; const float* xin = args.out;
            if (ph == PH_FFN_OUT_0) { A = (const bf16*)(ws + WS_ACT); Bt = (const bf16*)(ws + WS_WOUT0); K = FF; xin = args.in[I_X]; }
            else if (ph == PH_FFN_OUT_1) { A = (const bf16*)(ws + WS_ACT); Bt = (const bf16*)(ws + WS_WOUT1); K = FF; }
            else if (ph == PH_FFN_OUT_2) { A = (const bf16*)(ws + WS_ACT); Bt = (const bf16*)(ws + WS_WOUT2); K = FF; }
            else if (ph == PH_FFN_OUT_3) { A = (const bf16*)(ws + WS_ACT3); Bt = (const bf16*)(ws + WS_WOUT3); K = FF; }
            else if (ph == PH_RNN_OUT) { A = (const bf16*)(ws + WS_Y); Bt = (const bf16*)(ws + WS_WROUT); K = DRNN; scale = 1.f; }
            else { A = (const bf16*)(ws + WS_ATT); Bt = (const bf16*)(ws + WS_WO); K = D; scale = 1.f; }
            if (dry && ph != PH_FFN_OUT_0) scale = 0.f;
            float* xo = args.out;
#if RESID_BF16
            if (ph != PH_FFN_OUT_0) xin = nullptr;
            if (ph != PH_FFN_OUT_3 || dry) xo = nullptr;
#endif
            pg8::Gemm g{A, Bt, M, D, K}; pg8::StaticOrder S; S.init(M, D, C.G, (int)blockIdx.x);
            EpiRes E{xin, xo, xb, ssq, scale, dry && DUP_SKIP_EPI};
            pg8::gemm_phase<EpiRes, pg8::StaticOrder, false, true>(C.lds, g, S, E);
        } break;
        case PH_RNN_IN: {
            pg8::Gemm g{xb, (const bf16*)(ws + WS_WRIN), M, 2 * DRNN, D}; pg8::StaticOrder S; S.init(M, 2 * DRNN, C.G, (int)blockIdx.x);
            fill_rstd(C.lds, S, ssq, C.tid);
            EpiRnnIn E{(const LAS float*)(C.lds + RSTD_OFF), (bf16*)(ws + WS_G), (bf16*)(ws + WS_U)};
            pg8::gemm_phase<EpiRnnIn, pg8::StaticOrder, true, true>(C.lds, g, S, E);
        } break;
        case PH_RNN_MID: p_rnn_mid(C, args); break;
        case PH_QKV: {
            pg8::Gemm g{xb, (const bf16*)(ws + WS_WQKV), M, NQKV, D}; pg8::StaticOrder S; S.init(M, NQKV, C.G, (int)blockIdx.x);
            if (C.tid < 128) ((LAS float*)(C.lds + GAIN_OFF))[C.tid] = (C.tid < 64) ? args.in[I_QGAIN][C.tid] * (0.125f * LOG2E) : args.in[I_KGAIN][C.tid - 64];
            fill_rstd(C.lds, S, ssq, C.tid);
            EpiQKV E{(const LAS float*)(C.lds + RSTD_OFF), (const LAS float*)(C.lds + GAIN_OFF), (bf16*)(ws + WS_QKV), dry && DUP_SKIP_EPI};
            pg8::gemm_phase<EpiQKV, pg8::StaticOrder, true, true>(C.lds, g, S, E);
        } break;
        case PH_ATTN: p_attn(C, dry); break;
        case PH_MERGE: p_merge(C, args); break;
        default: break;
        }
        if (dry || ph + 1 < args.ph_hi) xcd_barrier(bar);
        if (ph == 0 && !dry) for (int eb = 0; eb < DUP_EXTRA_BARRIERS; ++eb) xcd_barrier(bar);
        }
    }
}

extern "C" void kernel_launch(void* const* d_in, const int* in_sizes, int n_in, void* d_out, int out_size, void* d_ws, size_t ws_size, hipStream_t stream) {
    static int grid = 0;
    if (grid == 0) {
        if (n_in != 18 || in_sizes[0] != M * D || out_size != M * D || ws_size < WS_END) { fprintf(stderr, "kernel_launch: unexpected shapes (n_in %d, in0 %d, out %d, ws %zu)\n", n_in, n_in > 0 ? in_sizes[0] : -1, out_size, ws_size); grid = -1; return; }
        int dev = 0, cus = 0, per_cu = 0;
        if (hipGetDevice(&dev) != hipSuccess || hipDeviceGetAttribute(&cus, hipDeviceAttributeMultiprocessorCount, dev) != hipSuccess) { fprintf(stderr, "kernel_launch: device query failed\n"); grid = -1; return; }
        if (hipFuncSetAttribute((const void*)fwd_kernel, hipFuncAttributeMaxDynamicSharedMemorySize, LDS_BYTES) != hipSuccess) { fprintf(stderr, "kernel_launch: hipFuncSetAttribute failed\n"); grid = -1; return; }
        if (hipOccupancyMaxActiveBlocksPerMultiprocessor(&per_cu, (const void*)fwd_kernel, NWAVES * 64, LDS_BYTES) != hipSuccess || per_cu < 1) { fprintf(stderr, "kernel_launch: occupancy query says %d blocks per CU\n", per_cu); (void)hipGetLastError(); grid = -1; return; }
        grid = cus;
    }
    if (grid < 0) return;
    if (hipMemsetAsync(d_ws, 0, CTL_ZERO_BYTES, stream) != hipSuccess) { fprintf(stderr, "kernel_launch: memset failed\n"); return; }
    Args a{};
    for (int i = 0; i < 18; ++i) a.in[i] = (const float*)d_in[i];
    a.out = (float*)d_out; a.ws = (unsigned char*)d_ws;
#if SINGLE_LAUNCH
    a.ph_lo = 0; a.ph_hi = NPHASE;
    hipLaunchKernelGGL(fwd_kernel, dim3(grid), dim3(NWAVES * 64), LDS_BYTES, stream, a);
#else
    for (int ph = 0; ph < NPHASE; ++ph) { a.ph_lo = ph; a.ph_hi = ph + 1; hipLaunchKernelGGL(fwd_kernel, dim3(grid), dim3(NWAVES * 64), LDS_BYTES, stream, a); }
#endif
}
```

```cpp
#include <hip/hip_runtime.h>
#include <cstdio>
#include <cstdint>

#ifndef SINGLE_LAUNCH
#define SINGLE_LAUNCH 1
#define DUP_MASK 0u
#define DUP_N 1
#define DUP_EXTRA_BARRIERS 0
#define DUP_SKIP_EPI 0
#endif

namespace pg8 {
#define PG8_LAS __attribute__((address_space(3)))
typedef unsigned short bf16_t;
typedef short bf16x8 __attribute__((ext_vector_type(8)));
typedef float f32x4 __attribute__((ext_vector_type(4)));
typedef unsigned u32x4 __attribute__((ext_vector_type(4)));
constexpr int BM = 256, BK = 64, HALF = 128, HTB = HALF * BK * 2, STAGE_BYTES = 8 * HTB, NXCD = 8, WGM = 8;

__host__ __device__ __forceinline__ int lds_byte(int r, int c) { return (r >> 3) * 1024 + (r & 7) * 128 + ((((c >> 3) ^ (r & 7)) & 7) << 4) + (c & 7) * 2; }
__host__ __device__ __forceinline__ void stage_rc(int b, int& R, int& C) { const int sidx = b / 1024, w = b % 1024, rowin = w / 128, pch = (w % 128) / 16; R = sidx * 8 + rowin; C = ((pch ^ rowin) & 7) * 8; }
__host__ __device__ __forceinline__ int perm32(int rho) { const int n = rho >> 4, i = rho & 15; return 8 * (i >> 2) + 4 * n + (i & 3); }

struct Unit { int pm, pn; };
struct Gemm { const bf16_t* A; const bf16_t* Bt; int M, N, K; };

struct StaticOrder {
    int nM, nN, nwg, G, c;
    __host__ __device__ void init(int M, int N, int G_, int c_) { nM = M / BM; nN = N / BM; nwg = nM * nN; G = G_; c = c_; }
    __host__ __device__ bool next(int i, Unit& u) const {
        const long L = (long)i * G + c; if (L >= nwg) return false;
        int wgid = (int)L; { const int q = nwg / NXCD, r = nwg % NXCD, xcd = wgid % NXCD, off = wgid / NXCD; wgid = (xcd < r ? xcd * (q + 1) : r * (q + 1) + (xcd - r) * q) + off; }
        const int nig = WGM * nN, gid = wgid / nig, fm = gid * WGM, gsz = (nM - fm) < WGM ? (nM - fm) : WGM;
        u.pm = fm + ((wgid % nig) % gsz); u.pn = (wgid % nig) / gsz; return true;
    }
    __device__ __forceinline__ void a_ready(const Unit&) const {}
    __device__ __forceinline__ void done(const Unit&) const {}
};

__device__ __forceinline__ unsigned cvt_pk_bf16(float lo, float hi) { unsigned r; asm volatile("v_cvt_pk_bf16_f32 %0, %1, %2" : "=v"(r) : "v"(lo), "v"(hi)); return r; }

template <class Epi, class Sched, bool ALIGN_EPI = false, bool SP2 = false>
__device__ __forceinline__ void gemm_phase(PG8_LAS unsigned char* lds, const Gemm g, const Sched& S, const Epi& E) {
    int tid_ = threadIdx.x; asm volatile("" : "+v"(tid_));
    const int tid = tid_, wid = __builtin_amdgcn_readfirstlane(tid >> 6), lane = tid & 63, wr = wid >> 2, wc = wid & 3, fr = lane & 15, fq = lane >> 4;
    const int K = g.K, nt = K / BK;
    unsigned voffA, voffB;
    { int R, C; stage_rc(tid * 16, R, C); const int Rb = Epi::PERM ? ((R & ~31) + perm32(R & 31)) : R; voffA = (unsigned)(R * K + C) * 2u; voffB = (unsigned)(Rb * K + C) * 2u; }
    const size_t pstep = (size_t)64 * K * 2;
    const size_t kstep = (size_t)(BK * 2);
    const size_t hstep = (size_t)HALF * K * 2;
    const size_t tstep = 2 * hstep;
    const unsigned ldsw = (unsigned)wid * 1024u;
    const int aoff = lds_byte(wr * 64 + fr, fq * 8), boff = lds_byte(wc * 32 + fr, fq * 8);
#define PG8_SA(b, h) (((b) * 2 + (h)) * HTB)
#define PG8_SB(b, h) ((4 + (b) * 2 + (h)) * HTB)
#define PG8_STAGE(bufoff, gbase, voff) do { _Pragma("unroll") for (int _i = 0; _i < 2; ++_i) \
        __builtin_amdgcn_global_load_lds((const unsigned*)((const char*)(gbase) + _i * pstep + (voff)), (PG8_LAS unsigned*)(lds + (bufoff) + ldsw + _i * 8192), 16, 0, 0); } while (0)
#define PG8_LDA(dst, b, h) do { _Pragma("unroll") for (int m = 0; m < 4; ++m) _Pragma("unroll") for (int k = 0; k < 2; ++k) dst[m][k] = *(const PG8_LAS bf16x8*)(lds + PG8_SA(b, h) + (aoff ^ (k * 64)) + m * 2048); } while (0)
#define PG8_LDB(dst, b, h) do { _Pragma("unroll") for (int n = 0; n < 2; ++n) _Pragma("unroll") for (int k = 0; k < 2; ++k) dst[n][k] = *(const PG8_LAS bf16x8*)(lds + PG8_SB(b, h) + (boff ^ (k * 64)) + n * 2048); } while (0)
#define PG8_MMA(ai, bj, At, Bt) do { __builtin_amdgcn_s_setprio(1); _Pragma("unroll") for (int m = 0; m < 4; ++m) _Pragma("unroll") for (int n = 0; n < 2; ++n) _Pragma("unroll") for (int k = 0; k < 2; ++k) \
        acc[ai][bj][m][n] = __builtin_amdgcn_mfma_f32_16x16x32_bf16(Bt[n][k], At[m][k], acc[ai][bj][m][n], 0, 0, 0); __builtin_amdgcn_s_setprio(0); } while (0)
#define PG8_WAIT_V(n) asm volatile("s_waitcnt vmcnt(" #n ")" ::: "memory")
#define PG8_WAIT_L(n) asm volatile("s_waitcnt lgkmcnt(" #n ")" ::: "memory")
#define PG8_BAR __builtin_amdgcn_s_barrier()
#define PG8_SCHED __builtin_amdgcn_sched_barrier(0)
    Unit cur, nxt; int ui = 0;
    if (!S.next(0, cur)) return;
    f32x4 acc[2][2][4][2];
#pragma unroll
    for (int a = 0; a < 2; ++a)
#pragma unroll
        for (int b = 0; b < 2; ++b)
#pragma unroll
            for (int m = 0; m < 4; ++m)
#pragma unroll
                for (int n = 0; n < 2; ++n) acc[a][b][m][n] = (f32x4){0.f, 0.f, 0.f, 0.f};
    bf16x8 At[4][2], B0[2][2], B1[2][2];
    const char* cA = (const char*)g.A + (size_t)cur.pm * tstep; const char* cB = (const char*)g.Bt + (size_t)cur.pn * tstep;
    S.a_ready(cur);
    if constexpr (SP2) {
        PG8_STAGE(PG8_SB(0, 0), cB, voffB); PG8_STAGE(PG8_SB(0, 1), cB + hstep, voffB); PG8_STAGE(PG8_SA(0, 0), cA, voffA); PG8_STAGE(PG8_SA(0, 1), cA + hstep, voffA);
        if (wr == 1) PG8_BAR;
        PG8_WAIT_V(2); PG8_BAR;
        PG8_STAGE(PG8_SB(1, 0), cB + kstep, voffB); PG8_STAGE(PG8_SA(1, 0), cA + kstep, voffA); PG8_STAGE(PG8_SB(1, 1), cB + hstep + kstep, voffB);
        PG8_WAIT_V(6); PG8_BAR;
    } else {
        PG8_STAGE(PG8_SB(0, 0), cB, voffB); PG8_STAGE(PG8_SA(0, 0), cA, voffA); PG8_STAGE(PG8_SB(0, 1), cB + hstep, voffB); PG8_STAGE(PG8_SA(0, 1), cA + hstep, voffA);
        if (wr == 1) PG8_BAR;
        PG8_WAIT_V(4); PG8_BAR;
        PG8_STAGE(PG8_SB(1, 0), cB + kstep, voffB); PG8_STAGE(PG8_SA(1, 0), cA + kstep, voffA); PG8_STAGE(PG8_SB(1, 1), cB + hstep + kstep, voffB);
        PG8_WAIT_V(6); PG8_BAR;
    }
    for (;;) {
        const bool has_next = S.next(ui + 1, nxt);
        const char* nA = has_next ? (const char*)g.A + (size_t)nxt.pm * tstep : cA; const char* nB = has_next ? (const char*)g.Bt + (size_t)nxt.pn * tstep : cB;
        for (int t = 0; t < nt; t += 2) {
            const bool last = (t == nt - 2);
            const char* a1 = cA + (size_t)(t + 1) * kstep;
            const char* a2 = last ? nA : cA + (size_t)(t + 2) * kstep; const char* b2 = last ? nB : cB + (size_t)(t + 2) * kstep;
            const char* a3 = a2 + kstep; const char* b3 = b2 + kstep;
            if (last && has_next) S.a_ready(nxt);
            if constexpr (SP2) {
            PG8_LDB(B0, 0, 0); PG8_LDB(B1, 0, 1); PG8_SCHED; PG8_LDA(At, 0, 0); PG8_STAGE(PG8_SA(1, 1), a1 + hstep, voffA);
            PG8_WAIT_V(8); PG8_WAIT_L(0); PG8_BAR; PG8_MMA(0, 0, At, B0); PG8_MMA(0, 1, At, B1); PG8_BAR; PG8_SCHED;
            PG8_LDA(At, 0, 1); PG8_STAGE(PG8_SB(0, 0), b2, voffB); PG8_STAGE(PG8_SB(0, 1), b2 + hstep, voffB); PG8_STAGE(PG8_SA(0, 0), a2, voffA);
            PG8_WAIT_V(8); PG8_WAIT_L(0); PG8_BAR; PG8_MMA(1, 0, At, B0); PG8_MMA(1, 1, At, B1); PG8_BAR; PG8_SCHED;
            PG8_LDB(B0, 1, 0); PG8_LDB(B1, 1, 1); PG8_SCHED; PG8_LDA(At, 1, 0); PG8_STAGE(PG8_SA(0, 1), a2 + hstep, voffA);
            PG8_WAIT_V(8); PG8_WAIT_L(0); PG8_BAR; PG8_MMA(0, 0, At, B0); PG8_MMA(0, 1, At, B1); PG8_BAR; PG8_SCHED;
            PG8_LDA(At, 1, 1); PG8_STAGE(PG8_SB(1, 0), b3, voffB); PG8_STAGE(PG8_SB(1, 1), b3 + hstep, voffB); PG8_STAGE(PG8_SA(1, 0), a3, voffA);
            PG8_WAIT_V(8); PG8_WAIT_L(0); PG8_BAR; PG8_MMA(1, 0, At, B0); PG8_MMA(1, 1, At, B1); PG8_BAR; PG8_SCHED;
            } else {
            PG8_LDB(B0, 0, 0); PG8_SCHED; PG8_LDA(At, 0, 0); PG8_STAGE(PG8_SA(1, 1), a1 + hstep, voffA);
            PG8_WAIT_L(8); PG8_BAR; PG8_WAIT_L(0); PG8_MMA(0, 0, At, B0); PG8_BAR; PG8_SCHED;
            PG8_LDB(B1, 0, 1); PG8_STAGE(PG8_SB(0, 0), b2, voffB);
            PG8_BAR; PG8_WAIT_L(0); PG8_MMA(0, 1, At, B1); PG8_BAR;
            PG8_LDA(At, 0, 1); PG8_STAGE(PG8_SA(0, 0), a2, voffA);
            PG8_BAR; PG8_WAIT_L(0); PG8_MMA(1, 0, At, B0); PG8_BAR; PG8_SCHED;
            PG8_STAGE(PG8_SB(0, 1), b2 + hstep, voffB);
            PG8_WAIT_V(6); PG8_BAR; PG8_MMA(1, 1, At, B1); PG8_BAR;
            PG8_LDB(B0, 1, 0); PG8_SCHED; PG8_LDA(At, 1, 0); PG8_STAGE(PG8_SA(0, 1), a2 + hstep, voffA);
            PG8_WAIT_L(8); PG8_BAR; PG8_WAIT_L(0); PG8_MMA(0, 0, At, B0); PG8_BAR; PG8_SCHED;
            PG8_LDB(B1, 1, 1); PG8_STAGE(PG8_SB(1, 0), b3, voffB);
            PG8_BAR; PG8_WAIT_L(0); PG8_MMA(0, 1, At, B1); PG8_BAR;
            PG8_LDA(At, 1, 1); PG8_STAGE(PG8_SA(1, 0), a3, voffA);
            PG8_BAR; PG8_WAIT_L(0); PG8_MMA(1, 0, At, B0); PG8_BAR; PG8_SCHED;
            PG8_STAGE(PG8_SB(1, 1), b3 + hstep, voffB);
            PG8_WAIT_V(6); PG8_BAR; PG8_MMA(1, 1, At, B1); PG8_BAR;
            }
        }
        if constexpr (ALIGN_EPI) { if (wr == 0) PG8_BAR; }
        E(acc, cur, ui, wr, wc, fr, fq); S.done(cur);
        if (!has_next) break;
#pragma unroll
        for (int a = 0; a < 2; ++a)
#pragma unroll
            for (int b = 0; b < 2; ++b)
#pragma unroll
                for (int m = 0; m < 4; ++m)
#pragma unroll
                    for (int n = 0; n < 2; ++n) acc[a][b][m][n] = (f32x4){0.f, 0.f, 0.f, 0.f};
        cur = nxt; cA = nA; cB = nB; ++ui;
        if constexpr (ALIGN_EPI) { if (wr == 1) PG8_BAR; }
    }
    PG8_WAIT_V(0);
    if constexpr (!ALIGN_EPI) { if (wr == 0) PG8_BAR; }
    PG8_BAR;
#undef PG8_SA
#undef PG8_SB
#undef PG8_STAGE
#undef PG8_LDA
#undef PG8_LDB
#undef PG8_MMA
#undef PG8_WAIT_V
#undef PG8_WAIT_L
#undef PG8_BAR
#undef PG8_SCHED
}
}

constexpr int BATCH = 8, SEQ = 2048, D = 1024, M = BATCH * SEQ;
constexpr int FF = 2816, DRNN = 1280, NBLK = 10, RBLK = 128, CONVW = 4;
constexpr int NHEAD = 16, HD = 64, NGRP = 3, NQKV = 9216;
constexpr float RMS_EPS = 1e-6f;
constexpr float LOG2E = 1.4426950408889634f;
constexpr int NWAVES = 8;

typedef unsigned short bf16;
typedef unsigned v4u __attribute__((ext_vector_type(4)));
typedef unsigned v2u __attribute__((ext_vector_type(2)));
typedef float f32x4 __attribute__((ext_vector_type(4)));
#define GAS __attribute__((address_space(1)))
#define LAS __attribute__((address_space(3)))
typedef GAS unsigned gu32;
#define RLX_AGENT __ATOMIC_RELAXED, __HIP_MEMORY_SCOPE_AGENT
#define LDS_WAIT() asm volatile("s_waitcnt lgkmcnt(0)" ::: "memory")

#ifndef RESID_BF16
#define RESID_BF16 1
#endif
constexpr size_t MiB = 1u << 20;
constexpr size_t WS_CTL = 0, CTL_ZERO_BYTES = 1 * MiB;
constexpr size_t WS_SSQ = 1 * MiB;
constexpr size_t WS_BIAS = 2 * MiB;
constexpr size_t WS_XB = 3 * MiB;
constexpr size_t WS_WO = 35 * MiB;
constexpr size_t WS_WQKV = 37 * MiB;
constexpr size_t WS_QKV = 55 * MiB;
constexpr size_t QKV_SLAB = (size_t)M * 1024 * 2;
constexpr size_t WS_LSE = 343 * MiB;
constexpr size_t WS_END = 352 * MiB;
constexpr size_t WS_WIN0 = 55 * MiB, WS_WOUT0 = 66 * MiB, WS_WIN1 = 72 * MiB, WS_WOUT1 = 83 * MiB, WS_WIN2 = 89 * MiB, WS_WOUT2 = 100 * MiB;
constexpr size_t WS_WRIN = 106 * MiB, WS_WROUT = 111 * MiB, WS_WA = 114 * MiB, WS_WX = 114 * MiB + 512 * 1024;
constexpr size_t WS_ACT = 115 * MiB;
constexpr size_t WS_G = 203 * MiB, WS_U = 243 * MiB, WS_Y = 283 * MiB;
constexpr size_t WS_ATT = WS_QKV + 3 * QKV_SLAB;
constexpr size_t WS_WOUT3 = 346 * MiB;
constexpr size_t WS_ACT3 = WS_QKV;
static_assert(WS_Y + (size_t)M * DRNN * 2 <= WS_LSE && WS_ACT + (size_t)M * FF * 2 <= WS_G && WS_WX + 327680 <= WS_ACT, "ws map");
static_assert(WS_QKV + 9 * QKV_SLAB == WS_LSE && WS_LSE + (size_t)3 * M * 16 * 4 <= WS_WOUT3 && WS_WOUT3 + (size_t)D * FF * 2 <= WS_END && RESID_BF16 == 1, "ws map");
constexpr int CW_BAR = 4096;

constexpr int RING_BYTES = 131072, LDSCTL_OFF = RING_BYTES, MISC_OFF = LDSCTL_OFF + 320;
constexpr int RSTD_OFF = RING_BYTES + 1024, RSTD_MAX_UNITS = 9, GAIN_OFF = RSTD_OFF + RSTD_MAX_UNITS * 256 * 4;
constexpr int LDS_BYTES = 147456;
static_assert(GAIN_OFF + 512 <= LDS_BYTES, "LDS map");

#define XB_TMO      128
#define XB_XCNT(j)  (256  + 64 * (j))
#define XB_XSUB(j)  (1280 + 64 * (j))
#define XB_XGEN(j)  (2304 + 64 * (j))
#define XB_TOP      3328
#define XB_TOPGEN   3392
#define XCD_BAR_WORDS 3456
#define XB_SPIN_CAP (1u << 18)
__device__ __forceinline__ unsigned xb_ld(unsigned* p)              { return __hip_atomic_load(p, __ATOMIC_RELAXED, __HIP_MEMORY_SCOPE_AGENT); }
__device__ __forceinline__ unsigned xb_add(unsigned* p, unsigned v) { return __hip_atomic_fetch_add(p, v, __ATOMIC_RELAXED, __HIP_MEMORY_SCOPE_AGENT); }
__device__ __forceinline__ unsigned xb_xcc_id() { return (unsigned)__builtin_amdgcn_s_getreg((3 << 11) | 20) & 0xFu; }
#define XB_SPIN(cond, bar) do { unsigned _sp = 0; while (cond) { __builtin_amdgcn_s_sleep(1); \
    if ((++_sp & 255u) == 0u) { if (xb_ld(&(bar)[XB_TMO])) break; if (_sp > XB_SPIN_CAP) { atomicAdd(&(bar)[XB_TMO], 1u); break; } } } } while (0)
struct XcdBarrier { unsigned* bar; unsigned x; volatile LAS unsigned* st; };
__device__ __forceinline__ XcdBarrier xcd_barrier_post(unsigned* bar, volatile LAS unsigned* st) {
    XcdBarrier b; b.bar = bar; b.x = xb_xcc_id(); b.st = st;
    if (threadIdx.x == 0) (void)xb_add(&bar[XB_XCNT(b.x)], 1u);
    return b;
}
__device__ __forceinline__ void xcd_barrier_complete(unsigned* bar, unsigned x, unsigned& nloc, unsigned& nx) {
    const unsigned G = gridDim.x * gridDim.y * gridDim.z;
    unsigned sum, cnt, mine, sp = 0u;
    for (;;) {
        sum = 0u; cnt = 0u; mine = 0u;
#pragma unroll
        for (unsigned j = 0; j < 16; ++j) { const unsigned c = xb_ld(&bar[XB_XCNT(j)]); sum += c; cnt += (c > 0u) ? 1u : 0u; mine = (j == x) ? c : mine; }
        if (sum == G) break;
        __builtin_amdgcn_s_sleep(1);
        if ((++sp & 255u) == 0u) { if (xb_ld(&bar[XB_TMO])) break; if (sp > XB_SPIN_CAP) { atomicAdd(&bar[XB_TMO], 1u); break; } }
    }
    nloc = mine > 0u ? mine : 1u; nx = cnt > 0u ? cnt : 1u;
}
__device__ __forceinline__ void xcd_barrier(const XcdBarrier& b) {
    asm volatile("s_waitcnt vmcnt(0)" ::: "memory");
    __syncthreads();
    if (threadIdx.x == 0) {
        unsigned* bar = b.bar;
        __builtin_amdgcn_s_waitcnt(0);
        unsigned nloc = b.st[0], nx = b.st[1];
        if (nloc == 0u) { xcd_barrier_complete(bar, b.x, nloc, nx); b.st[0] = nloc; b.st[1] = nx; }
        const unsigned old = xb_add(&bar[XB_XSUB(b.x)], 1u);
        const unsigned gen = old / nloc;
        if (old + 1u == (gen + 1u) * nloc) {
            __builtin_amdgcn_fence(__ATOMIC_RELEASE, "agent");
            asm volatile("s_waitcnt vmcnt(0)" ::: "memory");
            const unsigned og = xb_add(&bar[XB_TOP], 1u);
            const unsigned tg = og / nx;
            if (og + 1u == (tg + 1u) * nx) xb_add(&bar[XB_TOPGEN], 1u);
            else XB_SPIN(xb_ld(&bar[XB_TOPGEN]) == tg, bar);
            __builtin_amdgcn_fence(__ATOMIC_ACQUIRE, "agent");
            xb_add(&bar[XB_XGEN(b.x)], 1u);
            asm volatile("s_waitcnt vmcnt(0)" ::: "memory");
        } else {
            XB_SPIN(xb_ld(&bar[XB_XGEN(b.x)]) == gen, bar);
            __builtin_amdgcn_fence(__ATOMIC_ACQUIRE, "agent");
            asm volatile("s_waitcnt vmcnt(0)" ::: "memory");
        }
    }
    __syncthreads();
}

__device__ __forceinline__ unsigned f2bf(float f) { unsigned u = __builtin_bit_cast(unsigned, f); return (u + 0x7fffu + ((u >> 16) & 1u)) >> 16; }
__device__ __forceinline__ unsigned pk2(float lo, float hi) { return f2bf(lo) | (f2bf(hi) << 16); }
__device__ __forceinline__ float bf_lo(unsigned w) { return __builtin_bit_cast(float, w << 16); }
__device__ __forceinline__ float bf_hi(unsigned w) { return __builtin_bit_cast(float, w & 0xffff0000u); }
__device__ __forceinline__ float bf2f(bf16 v) { return __builtin_bit_cast(float, (unsigned)v << 16); }
__device__ __forceinline__ float wave_sum(float v) {
#pragma unroll
    for (int o = 1; o < 64; o <<= 1) v += __shfl_xor(v, o);
    return v;
}
__device__ __forceinline__ float fast_sigmoid(float x) { return __builtin_amdgcn_rcpf(1.f + __builtin_amdgcn_exp2f(-LOG2E * x)); }
__device__ __forceinline__ float row_rstd(const float* ssq, int row) {
    const f32x4* p = (const f32x4*)(ssq + (size_t)row * 16); const f32x4 a = p[0], b = p[1], c = p[2], d = p[3];
    const float s = ((a.x + a.y) + (a.z + a.w)) + ((b.x + b.y) + (b.z + b.w)) + ((c.x + c.y) + (c.z + c.w)) + ((d.x + d.y) + (d.z + d.w));
    return rsqrtf(s * (1.0f / D) + RMS_EPS);
}

typedef float f32x2 __attribute__((ext_vector_type(2)));
template <class Sched> __device__ __forceinline__ void fill_rstd(LAS unsigned char* lds, const Sched& S, const float* ssq, int tid) {
    LAS float* rt = (LAS float*)(lds + RSTD_OFF); pg8::Unit u;
    for (int i = 0; i < RSTD_MAX_UNITS && S.next(i, u); ++i)
        if ((tid >> 8) == (i & 1)) { const int r = tid & 255; rt[i * 256 + r] = row_rstd(ssq, u.pm * 256 + r); }
    __syncthreads();
}
using pg8::Unit;
__device__ __forceinline__ f32x2 silu_mul_pk(f32x2 g, f32x2 up) {
    const f32x2 t = g * (-LOG2E); f32x2 e; e.x = __builtin_amdgcn_exp2f(t.x); e.y = __builtin_amdgcn_exp2f(t.y);
    const f32x2 d = e + 1.0f; f32x2 r; r.x = __builtin_amdgcn_rcpf(d.x); r.y = __builtin_amdgcn_rcpf(d.y);
    return (g * r) * up;
}
struct EpiSwiGLU {
    static constexpr bool PERM = true;
    const LAS float* rtab; bf16* act; int skip;
    __device__ __forceinline__ void operator()(const f32x4 (&acc)[2][2][4][2], const Unit& u, int ui, int wr, int wc, int fr, int fq) const {
        if (skip == 1) return;
#pragma unroll
        for (int ai = 0; ai < 2; ++ai)
#pragma unroll
            for (int m = 0; m < 4; ++m) {
                const int rl = ai * 128 + wr * 64 + m * 16 + fr, row = u.pm * 256 + rl;
                const float rs = rtab[ui * 256 + rl];
                f32x2 v[4];
#pragma unroll
                for (int n = 0; n < 2; ++n)
#pragma unroll
                    for (int e = 0; e < 2; ++e) { const f32x2 g = (f32x2){acc[ai][0][m][n][2 * e], acc[ai][0][m][n][2 * e + 1]} * rs, up = (f32x2){acc[ai][1][m][n][2 * e], acc[ai][1][m][n][2 * e + 1]} * rs;
                        v[n * 2 + e] = silu_mul_pk(g, up); }
                v4u w; w.x = pg8::cvt_pk_bf16(v[0].x, v[0].y); w.y = pg8::cvt_pk_bf16(v[1].x, v[1].y); w.z = pg8::cvt_pk_bf16(v[2].x, v[2].y); w.w = pg8::cvt_pk_bf16(v[3].x, v[3].y);
                if (skip != 2 || w.x == 0x7fc17fc1u) *(v4u*)(act + (size_t)row * FF + u.pn * 128 + wc * 32 + 8 * fq) = w;
            }
    }
};
#ifndef RESID_BF16
#define RESID_BF16 1
#endif
struct EpiRes {
    static constexpr bool PERM = true;
    const float* xin; float* xout; bf16* xb; float* ssq; float scale; bool skip;
    __device__ __forceinline__ void operator()(const f32x4 (&acc)[2][2][4][2], const Unit& u, int ui, int wr, int wc, int fr, int fq) const {
        if (skip) return;
        if (xin) run<true>(acc, u, wr, wc, fr, fq); else run<false>(acc, u, wr, wc, fr, fq);
    }
    template <bool F32IN> __device__ __forceinline__ void run(const f32x4 (&acc)[2][2][4][2], const Unit& u, int wr, int wc, int fr, int fq) const {
#pragma unroll
        for (int ai = 0; ai < 2; ++ai) {
            f32x4 xv[4][2][2];
#pragma unroll
            for (int m = 0; m < 4; ++m)
#pragma unroll
                for (int bj = 0; bj < 2; ++bj) { const size_t off = (size_t)(u.pm * 256 + ai * 128 + wr * 64 + m * 16 + fr) * D + u.pn * 256 + bj * 128 + wc * 32 + 8 * fq;
                    if (F32IN) { xv[m][bj][0] = *(const f32x4*)(xin + off); xv[m][bj][1] = *(const f32x4*)(xin + off + 4); }
                    else { const v4u w = *(const v4u*)(xb + off); xv[m][bj][0] = (f32x4){bf_lo(w.x), bf_hi(w.x), bf_lo(w.y), bf_hi(w.y)}; xv[m][bj][1] = (f32x4){bf_lo(w.z), bf_hi(w.z), bf_lo(w.w), bf_hi(w.w)}; } }
#pragma unroll
            for (int m = 0; m < 4; ++m) {
                const int row = u.pm * 256 + ai * 128 + wr * 64 + m * 16 + fr;
                float ss = 0.f;
#pragma unroll
                for (int bj = 0; bj < 2; ++bj) {
                    const size_t off = (size_t)row * D + u.pn * 256 + bj * 128 + wc * 32 + 8 * fq;
                    const f32x4 y0 = xv[m][bj][0] + acc[ai][bj][m][0] * scale, y1 = xv[m][bj][1] + acc[ai][bj][m][1] * scale;
                    if (xout) { *(f32x4*)(xout + off) = y0; *(f32x4*)(xout + off + 4) = y1; }
                    v4u w; w.x = pg8::cvt_pk_bf16(y0[0], y0[1]); w.y = pg8::cvt_pk_bf16(y0[2], y0[3]); w.z = pg8::cvt_pk_bf16(y1[0], y1[1]); w.w = pg8::cvt_pk_bf16(y1[2], y1[3]);
                    *(v4u*)(xb + off) = w;
                    ss += (y0[0] * y0[0] + y0[1] * y0[1]) + (y0[2] * y0[2] + y0[3] * y0[3]) + (y1[0] * y1[0] + y1[1] * y1[1]) + (y1[2] * y1[2] + y1[3] * y1[3]);
                }
                ss += __shfl_xor(ss, 16); ss += __shfl_xor(ss, 32);
                if (fq == 0) ssq[(size_t)row * 16 + u.pn * 4 + wc] = ss;
            }
            asm volatile("" ::: "memory");
        }
    }
};
struct EpiRnnIn {
    static constexpr bool PERM = true;
    const LAS float* rtab; bf16* Gb; bf16* Ub;
    template <bool GATE> __device__ __forceinline__ void run(const f32x4 (&acc)[2][2][4][2], const Unit& u, int ui, int wr, int wc, int fr, int fq, bf16* dstb, int pc) const {
#pragma unroll
        for (int ai = 0; ai < 2; ++ai)
#pragma unroll
            for (int m = 0; m < 4; ++m) {
                const int rl = ai * 128 + wr * 64 + m * 16 + fr, row = u.pm * 256 + rl;
                const float rs = rtab[ui * 256 + rl];
#pragma unroll
                for (int bj = 0; bj < 2; ++bj) {
                    f32x2 v[4];
#pragma unroll
                    for (int n = 0; n < 2; ++n)
#pragma unroll
                        for (int e = 0; e < 2; ++e) { f32x2 x = (f32x2){acc[ai][bj][m][n][2 * e], acc[ai][bj][m][n][2 * e + 1]} * rs;
                            if (GATE) {
                                const f32x2 t = (x * x * 0.044715f + 1.0f) * x * (-1.5957691216057308f * LOG2E); f32x2 ex; ex.x = __builtin_amdgcn_exp2f(t.x); ex.y = __builtin_amdgcn_exp2f(t.y);
                                const f32x2 d = ex + 1.0f; f32x2 r; r.x = __builtin_amdgcn_rcpf(d.x); r.y = __builtin_amdgcn_rcpf(d.y); x = x * r; }
                            v[n * 2 + e] = x; }
                    v4u w; w.x = pg8::cvt_pk_bf16(v[0].x, v[0].y); w.y = pg8::cvt_pk_bf16(v[1].x, v[1].y); w.z = pg8::cvt_pk_bf16(v[2].x, v[2].y); w.w = pg8::cvt_pk_bf16(v[3].x, v[3].y);
                    *(v4u*)(dstb + (size_t)row * DRNN + pc * 256 + bj * 128 + wc * 32 + 8 * fq) = w;
                }
            }
    }
    __device__ __forceinline__ void operator()(const f32x4 (&acc)[2][2][4][2], const Unit& u, int ui, int wr, int wc, int fr, int fq) const {
        if (u.pn < 5) run<true>(acc, u, ui, wr, wc, fr, fq, Gb, u.pn); else run<false>(acc, u, ui, wr, wc, fr, fq, Ub, u.pn - 5);
    }
};
struct EpiQKV {
    static constexpr bool PERM = true;
    const LAS float* rtab; const LAS float* gtab; bf16* qkv; bool skip;
    __device__ __forceinline__ void operator()(const f32x4 (&acc)[2][2][4][2], const Unit& u, int ui, int wr, int wc, int fr, int fq) const {
        if (skip) return;
        const int hs = u.pn * 4 + wc, kind = hs / 48, gh = hs - kind * 48, g = gh >> 4, h = gh & 15, l2d = 2 * g;
        bf16* slab = qkv + (size_t)(kind * 3 + g) * ((size_t)M * 1024);
        f32x4 gv[2][2];
#pragma unroll
        for (int bj = 0; bj < 2; ++bj)
#pragma unroll
            for (int n = 0; n < 2; ++n) { gv[bj][n] = (f32x4){1.f, 1.f, 1.f, 1.f}; if (kind < 2) gv[bj][n] = *(const LAS f32x4*)(gtab + kind * 64 + 32 * bj + 8 * fq + 4 * n); }
#pragma unroll
        for (int ai = 0; ai < 2; ++ai)
#pragma unroll
            for (int m = 0; m < 4; ++m) {
                const int rl = ai * 128 + wr * 64 + m * 16 + fr, row = u.pm * 256 + rl;
                const float rs = rtab[ui * 256 + rl];
                f32x4 v[2][2]; float ss = 0.f;
#pragma unroll
                for (int bj = 0; bj < 2; ++bj)
#pragma unroll
                    for (int n = 0; n < 2; ++n) { v[bj][n] = acc[ai][bj][m][n] * rs; const f32x4 t = v[bj][n] * v[bj][n]; ss += (t[0] + t[1]) + (t[2] + t[3]); }
                float rn = 1.f;
                if (kind < 2) { ss += __shfl_xor(ss, 16); ss += __shfl_xor(ss, 32); rn = rsqrtf(ss * (1.0f / HD) + RMS_EPS); }
                const int b = row >> 11, t = row & 2047, rres = t & ((1 << l2d) - 1), l = t >> l2d, L = 2048 >> l2d;
                bf16* dst = slab + ((size_t)(b * 16 + h) * 2048 + rres * L + l) * 64 + 8 * fq;
#pragma unroll
                for (int bj = 0; bj < 2; ++bj) {
                    const f32x4 a0 = v[bj][0] * gv[bj][0] * rn, a1 = v[bj][1] * gv[bj][1] * rn;
                    v4u w; w.x = pg8::cvt_pk_bf16(a0[0], a0[1]); w.y = pg8::cvt_pk_bf16(a0[2], a0[3]); w.z = pg8::cvt_pk_bf16(a1[0], a1[1]); w.w = pg8::cvt_pk_bf16(a1[2], a1[3]);
                    *(v4u*)(dst + 32 * bj) = w;
                }
            }
    }
};

struct Args { const float* in[18]; float* out; unsigned char* ws; int ph_lo, ph_hi; };
enum { I_X = 0, I_NORMG, I_FFN_WIN, I_FFN_WOUT, I_RNN_WIN, I_CONV_W, I_CONV_B, I_WA, I_BA, I_WX, I_BX, I_LAM, I_RNN_WOUT, I_WQKV, I_QGAIN, I_KGAIN, I_WO, I_RELB };

struct Ctx { LAS unsigned char* lds; int tid, lane, wave, G, vcu; unsigned char* ws; };

typedef short v4i16_t __attribute__((ext_vector_type(4)));
__device__ __forceinline__ v4i16_t vtr16(const LAS unsigned char* p) { return __builtin_amdgcn_ds_read_tr16_b64_v4i16((LAS v4i16_t*)p); }
enum { CM_NONE = 0, CM_FFN = 1, CM_QKV = 2 };
__device__ __forceinline__ int colmap(int mode, int vr) {
    if (mode == CM_FFN) { const int pn = vr >> 8, w = vr & 255; return (w >> 7) * FF + 128 * pn + (w & 127); }
    if (mode == CM_QKV) { const int pn = vr >> 8, w = vr & 255, bj = w >> 7, wc = (w >> 5) & 3, j = w & 31; return 256 * pn + 64 * wc + 32 * bj + j; }
    return vr;
}
__device__ __forceinline__ void transpose_item(const float* W, int K, int N, const float* gvec, bf16* WT, int mode, LAS unsigned char* scr, int item, int lane) {
    const int nblk = N / 64, kb = item / nblk, nb = item - kb * nblk, k0 = 64 * kb, vr0 = 64 * nb;
    const int col4 = lane & 15, rsub = lane >> 4, nsrc = colmap(mode, vr0 + 32 * (col4 >> 3)) + (col4 & 7) * 4;
    const float* src = W + (size_t)(k0 + rsub) * N + nsrc;
    f32x4 w[16];
#pragma unroll
    for (int i = 0; i < 16; ++i) w[i] = __builtin_nontemporal_load((const GAS f32x4*)(src + (size_t)(4 * i) * N));
    if (gvec) {
#pragma unroll
        for (int i = 0; i < 16; ++i) w[i] = w[i] * gvec[k0 + 4 * i + rsub];
    }
#pragma unroll
    for (int i = 0; i < 16; ++i) { v2u p; p.x = pg8::cvt_pk_bf16(w[i][0], w[i][1]); p.y = pg8::cvt_pk_bf16(w[i][2], w[i][3]);
        *(LAS v2u*)(scr + (col4 >> 3) * 4096 + (4 * i + rsub) * 64 + (col4 & 7) * 8) = p; }
    const int q = (lane & 15) >> 2, p4 = lane & 3, gidx = lane >> 4;
#pragma unroll
    for (int r = 0; r < 8; ++r) { const int nb16 = r >> 1, kh = r & 1, kbase = 32 * kh + 8 * gidx;
        const LAS unsigned char* a = scr + (nb16 >> 1) * 4096 + (kbase + q) * 64 + ((nb16 & 1) * 16 + 4 * p4) * 2;
        const v4i16_t lo = vtr16(a), hi = vtr16(a + 4 * 64);
        v4u o; { const v2u l2 = __builtin_bit_cast(v2u, lo), h2 = __builtin_bit_cast(v2u, hi); o.x = l2.x; o.y = l2.y; o.z = h2.x; o.w = h2.y; }
        *(GAS v4u*)(WT + (size_t)(vr0 + nb16 * 16 + (lane & 15)) * K + k0 + kbase) = o; }
}
struct MatJob { const float* W; int K, N; const float* g; bf16* WT; int mode; };
__device__ __forceinline__ MatJob mat_job(const Ctx& C, const Args& a, int idx) {
    unsigned char* ws = C.ws; const float* ng = a.in[I_NORMG]; MatJob j;
    switch (idx) {
    case 0: j = MatJob{a.in[I_FFN_WIN] + (size_t)0 * D * 2 * FF, D, 2 * FF, ng + 0 * D, (bf16*)(ws + WS_WIN0), CM_FFN}; break;
    case 1: j = MatJob{a.in[I_FFN_WOUT] + (size_t)0 * FF * D, FF, D, nullptr, (bf16*)(ws + WS_WOUT0), CM_NONE}; break;
    case 2: j = MatJob{a.in[I_RNN_WIN], D, 2 * DRNN, ng + 1 * D, (bf16*)(ws + WS_WRIN), CM_NONE}; break;
    case 3: j = MatJob{a.in[I_RNN_WOUT], DRNN, D, nullptr, (bf16*)(ws + WS_WROUT), CM_NONE}; break;
    case 4: j = MatJob{a.in[I_FFN_WIN] + (size_t)1 * D * 2 * FF, D, 2 * FF, ng + 2 * D, (bf16*)(ws + WS_WIN1), CM_FFN}; break;
    case 5: j = MatJob{a.in[I_FFN_WOUT] + (size_t)1 * FF * D, FF, D, nullptr, (bf16*)(ws + WS_WOUT1), CM_NONE}; break;
    case 6: j = MatJob{a.in[I_WQKV], D, NQKV, ng + 4 * D, (bf16*)(ws + WS_WQKV), CM_QKV}; break;
    case 7: j = MatJob{a.in[I_WO], D, D, nullptr, (bf16*)(ws + WS_WO), CM_NONE}; break;
    case 8: j = MatJob{a.in[I_FFN_WIN] + (size_t)2 * D * 2 * FF, D, 2 * FF, ng + 3 * D, (bf16*)(ws + WS_WIN2), CM_FFN}; break;
    case 9: j = MatJob{a.in[I_FFN_WOUT] + (size_t)2 * FF * D, FF, D, nullptr, (bf16*)(ws + WS_WOUT2), CM_NONE}; break;
    case 10: j = MatJob{a.in[I_FFN_WIN] + (size_t)3 * D * 2 * FF, D, 2 * FF, ng + 5 * D, (bf16*)a.out, CM_FFN}; break;
    default: j = MatJob{a.in[I_FFN_WOUT] + (size_t)3 * FF * D, FF, D, nullptr, (bf16*)(ws + WS_WOUT3), CM_NONE}; break;
    }
    return j;
}
__device__ __forceinline__ void convert_mats(const Ctx& C, const Args& a, int first, int last, int gw, int NGW) {
    LAS unsigned char* scr = C.lds + C.wave * 8192;
    int base = 0;
    for (int mi = first; mi < last; ++mi) {
        const MatJob j = mat_job(C, a, mi); const int cnt = (j.K / 64) * (j.N / 64);
        int it = (gw - base) % NGW; if (it < 0) it += NGW;
        for (; it < cnt; it += NGW) transpose_item(j.W, j.K, j.N, j.g, j.WT, j.mode, scr, it, C.lane);
        base += cnt;
    }
}
__device__ __forceinline__ void spare_convert(const Ctx& C, const Args& a, int first, int last, int nwg) {
    const int R = (nwg + C.G - 1) / C.G, first_spare = nwg - (R - 1) * C.G, nspare = C.G - first_spare, c = (int)blockIdx.x;
    if (nspare > 0) { if (c >= first_spare) convert_mats(C, a, first, last, (c - first_spare) * NWAVES + C.wave, nspare * NWAVES); }
    else convert_mats(C, a, first, last, c * NWAVES + C.wave, C.G * NWAVES);
    __syncthreads();
}
__device__ __forceinline__ int t5_bucket(int n) {
    if (n < 16) return n;
    int b = 16;
    b += (n >= 22) + (n >= 30) + (n >= 40) + (n >= 54) + (n >= 73) + (n >= 99) + (n >= 134) + (n >= 182) + (n >= 246) + (n >= 332) + (n >= 450) + (n >= 609) + (n >= 825) + (n >= 1117) + (n >= 1513);
    return b;
}
__device__ __forceinline__ void p_prologue(const Ctx& C, const Args& a) {
    const int gw = C.vcu * NWAVES + C.wave, NGW = C.G * NWAVES;
    convert_mats(C, a, 0, 1, gw, NGW);
    {   LAS unsigned char* scr = C.lds + C.wave * 8192;
        for (int it = gw; it < 2 * NBLK * 4; it += NGW) { const int which = it / (NBLK * 4), r = it % (NBLK * 4), blk = r >> 2, sub = r & 3;
            const float* W = (which ? a.in[I_WX] : a.in[I_WA]) + (size_t)blk * RBLK * RBLK; bf16* WT = (bf16*)(C.ws + (which ? WS_WX : WS_WA)) + (size_t)blk * RBLK * RBLK;
            transpose_item(W, RBLK, RBLK, nullptr, WT, CM_NONE, scr, sub, C.lane); } }
    const float* x = a.in[I_X]; bf16* xb = (bf16*)(C.ws + WS_XB); float* ssq = (float*)(C.ws + WS_SSQ);
    for (int m = gw; m < M; m += NGW) {
        const GAS f32x4* xr = (const GAS f32x4*)(x + (size_t)m * D) + C.lane; f32x4 v[4]; float s = 0.f;
#pragma unroll
        for (int j = 0; j < 4; ++j) { v[j] = __builtin_nontemporal_load(xr + 64 * j); s += (v[j].x * v[j].x + v[j].y * v[j].y) + (v[j].z * v[j].z + v[j].w * v[j].w); }
        s = wave_sum(s);
        GAS v2u* o8 = (GAS v2u*)(xb + (size_t)m * D) + C.lane;
#pragma unroll
        for (int j = 0; j < 4; ++j) { v2u w; w.x = pk2(v[j].x, v[j].y); w.y = pk2(v[j].z, v[j].w); o8[64 * j] = w; }
        if (C.lane < 16) ssq[(size_t)m * 16 + C.lane] = (C.lane == 0) ? s : 0.f;
    }
    float* bt = (float*)(C.ws + WS_BIAS); const float* rb = a.in[I_RELB];
    for (int i = blockIdx.x * 512 + C.tid; i < 48 * 129; i += C.G * 512) { const int gh = i / 129, dist = i - gh * 129, g = gh >> 4;
        bt[gh * 132 + dist] = rb[t5_bucket(dist << (2 * g)) * 48 + gh] * LOG2E; }
}

typedef float f32x16 __attribute__((ext_vector_type(16)));
typedef short bf16x8v __attribute__((ext_vector_type(8)));
constexpr int RM_WB = 0, RM_WB_GATE = 64 * 272, RM_CW = 36864, RM_CMP = RM_CW + 2560, RM_TILE = 49152, RM_TILE_BYTES = 36 * 256, RM_END = RM_TILE + 8 * RM_TILE_BYTES;
static_assert(RM_WB + 2 * RM_WB_GATE <= RM_CW && RM_CMP + 2 * 2 * 8 * 64 * 4 <= RM_TILE && RM_END <= RING_BYTES, "rnn-mid LDS map");
__device__ __forceinline__ bf16x8v pack8(const float (&v)[8]) {
    v4u w; w.x = pg8::cvt_pk_bf16(v[0], v[1]); w.y = pg8::cvt_pk_bf16(v[2], v[3]); w.z = pg8::cvt_pk_bf16(v[4], v[5]); w.w = pg8::cvt_pk_bf16(v[6], v[7]);
    return __builtin_bit_cast(bf16x8v, w);
}
__device__ __forceinline__ void p_rnn_mid(const Ctx& C, const Args& a) {
    const bf16* U = (const bf16*)(C.ws + WS_U); const bf16* Gb = (const bf16*)(C.ws + WS_G); bf16* Y = (bf16*)(C.ws + WS_Y);
    const bf16* WAb = (const bf16*)(C.ws + WS_WA); const bf16* WXb = (const bf16*)(C.ws + WS_WX);
    LAS unsigned char* L = C.lds;
    LAS float* CW = (LAS float*)(L + RM_CW); LAS float* CMP = (LAS float*)(L + RM_CMP);
    const int wave = C.wave;
    LAS unsigned char* wt = L + RM_TILE + wave * RM_TILE_BYTES;
    for (int item = blockIdx.x; item < BATCH * NBLK * 2; item += C.G) {
        const int b = item / (NBLK * 2), n = (item % (NBLK * 2)) >> 1, half = item & 1;
        int tid = C.tid; asm volatile("" : "+v"(tid));
        const int lane = tid & 63, r32 = lane & 31, hh = lane >> 5;
        __syncthreads();
#pragma unroll
        for (int p = 0; p < 4; ++p) { const int idx = p * 512 + tid, gate = idx >> 10, rem = idx & 1023, row = rem >> 4, c16 = rem & 15;
            const v4u w = *(const v4u*)((gate ? WXb : WAb) + (size_t)(n * 128 + 64 * half + row) * 128 + c16 * 8);
            *(LAS v4u*)(L + RM_WB + gate * RM_WB_GATE + row * 272 + c16 * 16) = w; }
        CW[tid] = a.in[I_CONV_W][(tid >> 7) * DRNN + n * 128 + (tid & 127)];
        if (tid < 128) CW[512 + tid] = a.in[I_CONV_B][n * 128 + tid];
        __syncthreads();
        float ba[2], bx[2], spl[2], Ht[2];
#pragma unroll
        for (int cb = 0; cb < 2; ++cb) { const int ch = n * 128 + 64 * half + 32 * cb + r32; ba[cb] = a.in[I_BA][ch]; bx[cb] = a.in[I_BX][ch];
            spl[cb] = -8.0f * LOG2E * log1pf(expf(-a.in[I_LAM][ch])); Ht[cb] = 0.f; }
        bf16x8v idf[2];
#pragma unroll
        for (int sp = 0; sp < 2; ++sp)
#pragma unroll
            for (int j = 0; j < 8; ++j) idf[sp][j] = (16 * sp + 8 * hh + j == r32) ? (short)0x3F80 : (short)0;
        const int urow = lane >> 4, uch = lane & 15, grow = lane >> 3, gch = lane & 7;
        v4u uraw[9], graw[4];
#define RM_LOADU(TILE) do { const int tp_ = (TILE) * 256 + wave * 32; const int ub_ = (b * SEQ + tp_ - 3 + urow) * DRNN + n * 128 + uch * 8;        \
        _Pragma("unroll") for (int i_ = 0; i_ < 9; ++i_) uraw[i_] = *(const v4u*)(U + (ptrdiff_t)(ub_ + i_ * 4 * DRNN)); \
        if (tp_ == 0 && urow < 3) uraw[0] = (v4u){0u, 0u, 0u, 0u};         } while (0)
#define RM_LOADG(TILE) do { const int gb_ = (b * SEQ + (TILE) * 256 + wave * 32 + grow) * DRNN + n * 128 + 64 * half + gch * 8; \
        _Pragma("unroll") for (int i_ = 0; i_ < 4; ++i_) graw[i_] = *(const v4u*)(Gb + (unsigned)(gb_ + i_ * 8 * DRNN)); } while (0)
        for (int tile = 0; tile < 8; ++tile) {
            const int tposw = tile * 256 + wave * 32;
            const size_t tok0 = (size_t)b * SEQ + tposw;
            LAS float* CWt = CW; LAS unsigned char* WBt = L + RM_WB; asm volatile("" : "+v"(CWt), "+v"(WBt));
            RM_LOADU(tile); RM_LOADG(tile);
#pragma unroll
            for (int i = 0; i < 9; ++i) { const int rl = 4 * i + urow; *(LAS v4u*)(wt + rl * 256 + ((uch ^ (rl & 15)) << 4)) = uraw[i]; }
            {
                const int tg = lane >> 4, cc = lane & 15;
                f32x2 wv[4][4], bv2[4];
#pragma unroll
                for (int k = 0; k < 4; ++k) { const f32x4 w0 = *(const LAS f32x4*)(CWt + k * 128 + 8 * cc), w1 = *(const LAS f32x4*)(CWt + k * 128 + 8 * cc + 4);
                    wv[k][0] = (f32x2){w0[0], w0[1]}; wv[k][1] = (f32x2){w0[2], w0[3]}; wv[k][2] = (f32x2){w1[0], w1[1]}; wv[k][3] = (f32x2){w1[2], w1[3]}; }
                { const f32x4 b0 = *(const LAS f32x4*)(CWt + 512 + 8 * cc), b1 = *(const LAS f32x4*)(CWt + 512 + 8 * cc + 4);
                  bv2[0] = (f32x2){b0[0], b0[1]}; bv2[1] = (f32x2){b0[2], b0[3]}; bv2[2] = (f32x2){b1[0], b1[1]}; bv2[3] = (f32x2){b1[2], b1[3]}; }
                v4u ur[11];
#pragma unroll
                for (int j = 0; j < 11; ++j) { const int rl = 8 * tg + j; ur[j] = *(const LAS v4u*)(wt + rl * 256 + ((cc ^ (rl & 15)) << 4)); }
                f32x2 o[8][4];
#pragma unroll
                for (int i = 0; i < 8; ++i)
#pragma unroll
                    for (int e = 0; e < 4; ++e) o[i][e] = bv2[e];
#pragma unroll
                for (int j = 0; j < 11; ++j) {
                    const f32x2 u0 = (f32x2){bf_lo(ur[j].x), bf_hi(ur[j].x)}, u1 = (f32x2){bf_lo(ur[j].y), bf_hi(ur[j].y)}, u2 = (f32x2){bf_lo(ur[j].z), bf_hi(ur[j].z)}, u3 = (f32x2){bf_lo(ur[j].w), bf_hi(ur[j].w)};
#pragma unroll
                    for (int k = 0; k < 4; ++k) { const int i = j - k; if (i >= 0 && i < 8) {
                        o[i][0] += wv[k][0] * u0; o[i][1] += wv[k][1] * u1; o[i][2] += wv[k][2] * u2; o[i][3] += wv[k][3] * u3; } }
                }
#pragma unroll
                for (int i = 0; i < 8; ++i) { const int rl = 8 * tg + i;
                    v4u w; w.x = pg8::cvt_pk_bf16(o[i][0].x, o[i][0].y); w.y = pg8::cvt_pk_bf16(o[i][1].x, o[i][1].y); w.z = pg8::cvt_pk_bf16(o[i][2].x, o[i][2].y); w.w = pg8::cvt_pk_bf16(o[i][3].x, o[i][3].y);
                    *(LAS v4u*)(wt + rl * 256 + ((cc ^ (rl & 15)) << 4)) = w; }
            }
            bf16x8v af[8];
#pragma unroll
            for (int s = 0; s < 8; ++s) af[s] = *(const LAS bf16x8v*)(wt + r32 * 256 + (((2 * s + hh) ^ (r32 & 15)) << 4));
#pragma unroll
            for (int i = 0; i < 4; ++i) *(LAS v4u*)(wt + (8 * i + grow) * 128 + gch * 16) = graw[i];
            f32x16 acc[2][2], ufa[2];
#pragma unroll
            for (int cb = 0; cb < 2; ++cb)
#pragma unroll
                for (int e = 0; e < 16; ++e) { acc[0][cb][e] = 0.f; acc[1][cb][e] = 0.f; ufa[cb][e] = 0.f; }
            bf16x8v bq[2][4];
#define RM_LDB(S, DST) do { _Pragma("unroll") for (int g_ = 0; g_ < 2; ++g_) _Pragma("unroll") for (int c_ = 0; c_ < 2; ++c_) \
                DST[g_ * 2 + c_] = *(const LAS bf16x8v*)(WBt + g_ * RM_WB_GATE + (32 * c_ + r32) * 272 + (16 * (S) + 8 * hh) * 2); } while (0)
            RM_LDB(0, bq[0]);
#pragma unroll
            for (int s = 0; s < 8; ++s) {
                if (s < 7) RM_LDB(s + 1, bq[(s + 1) & 1]);
#pragma unroll
                for (int gt = 0; gt < 2; ++gt)
#pragma unroll
                    for (int cb = 0; cb < 2; ++cb) acc[gt][cb] = __builtin_amdgcn_mfma_f32_32x32x16_bf16(af[s], bq[s & 1][gt * 2 + cb], acc[gt][cb], 0, 0, 0);
            }
#undef RM_LDB
#pragma unroll
            for (int cb = 0; cb < 2; ++cb)
#pragma unroll
                for (int sp = 0; sp < 2; ++sp) { const bf16x8v asel = half ? af[4 + 2 * cb + sp] : af[2 * cb + sp];
                    ufa[cb] = __builtin_amdgcn_mfma_f32_32x32x16_bf16(asel, idf[sp], ufa[cb], 0, 0, 0); }
#pragma unroll
            for (int cb = 0; cb < 2; ++cb)
#pragma unroll
                for (int e = 0; e < 16; ++e) {
                    const float uf = ufa[cb][e];
                    const float r = fast_sigmoid(acc[0][cb][e] + ba[cb]), ii = fast_sigmoid(acc[1][cb][e] + bx[cb]);
                    const float av = __builtin_amdgcn_exp2f(r * spl[cb]);
                    const float bv = __builtin_amdgcn_sqrtf(fmaxf(1.f - av * av, 0.f)) * (ii * uf);
                    acc[0][cb][e] = av; acc[1][cb][e] = bv;
                }
            float A0[2][4], B0[2][4], A1[2][4], B1[2][4];
            const int par = tile & 1;
#pragma unroll
            for (int cb = 0; cb < 2; ++cb) {
                float Aw = 1.f, Bw = 0.f;
#pragma unroll
                for (int q = 0; q < 4; ++q) {
                    const float a0 = acc[0][cb][4 * q], a1 = acc[0][cb][4 * q + 1], a2 = acc[0][cb][4 * q + 2], a3 = acc[0][cb][4 * q + 3];
                    const float Ag = (a0 * a1) * (a2 * a3);
                    const float Bg = ((acc[1][cb][4 * q] * a1 + acc[1][cb][4 * q + 1]) * a2 + acc[1][cb][4 * q + 2]) * a3 + acc[1][cb][4 * q + 3];
                    const float pA = __shfl_xor(Ag, 32), pB = __shfl_xor(Bg, 32);
                    A0[cb][q] = hh ? pA : Ag; B0[cb][q] = hh ? pB : Bg; A1[cb][q] = hh ? Ag : pA; B1[cb][q] = hh ? Bg : pB;
                    Bw = Bw * A0[cb][q] + B0[cb][q]; Aw *= A0[cb][q]; Bw = Bw * A1[cb][q] + B1[cb][q]; Aw *= A1[cb][q];
                }
                if (hh == 0) { CMP[((par * 2 + 0) * 8 + wave) * 64 + 32 * cb + r32] = Aw; CMP[((par * 2 + 1) * 8 + wave) * 64 + 32 * cb + r32] = Bw; }
            }
            __syncthreads();
#pragma unroll
            for (int cb = 0; cb < 2; ++cb) {
                float h = Ht[cb], hin = 0.f;
#pragma unroll
                for (int v = 0; v < 8; ++v) { const float Av = CMP[((par * 2 + 0) * 8 + v) * 64 + 32 * cb + r32], Bv = CMP[((par * 2 + 1) * 8 + v) * 64 + 32 * cb + r32];
                    hin = (v == wave) ? h : hin; h = Av * h + Bv; }
                Ht[cb] = h;
                float hc = hin;
#pragma unroll
                for (int q = 0; q < 4; ++q) {
                    const float c0 = hc; hc = A0[cb][q] * hc + B0[cb][q]; const float c1 = hc; hc = A1[cb][q] * hc + B1[cb][q];
                    float hv = hh ? c1 : c0;
#pragma unroll
                    for (int i = 0; i < 4; ++i) { const int e = 4 * q + i; hv = acc[0][cb][e] * hv + acc[1][cb][e];
                        const int tl = (e & 3) + 8 * (e >> 2) + 4 * hh;
                        LAS bf16* gp = (LAS bf16*)(wt + tl * 128 + (32 * cb + r32) * 2);
                        *gp = (bf16)f2bf(hv * bf2f(*gp)); }
                }
            }
#pragma unroll
            for (int i = 0; i < 4; ++i) { const v4u w = *(const LAS v4u*)(wt + (8 * i + grow) * 128 + gch * 16);
                *(v4u*)(Y + (unsigned)(((int)tok0 + 8 * i + grow) * DRNN + n * 128 + 64 * half + gch * 8)) = w; }
        }
#undef RM_LOADU
#undef RM_LOADG
    }
    const int nitems = BATCH * NBLK * 2;
    if (C.G > nitems) { if ((int)blockIdx.x >= nitems) convert_mats(C, a, 4, 8, ((int)blockIdx.x - nitems) * NWAVES + wave, (C.G - nitems) * NWAVES); }
    else { __syncthreads(); convert_mats(C, a, 4, 8, (int)blockIdx.x * NWAVES + wave, C.G * NWAVES); }
}
constexpr int AT_EXT = 0, AT_VT = 48 * 192 * 4;
struct AttnUnit { bf16* qbase; const bf16* kres; const bf16* vres; int l0, kb_lo, eoff, g, bh, llin0; };
__device__ __forceinline__ AttnUnit attn_unit(bf16* QKV, int it, int wave) {
    AttnUnit u; const size_t SLAB = (size_t)M * 1024;
    const int g = it >> 9, rem = it & 511, bh = rem >> 2, c4 = (rem + (it >> 8)) & 3, l2d = 2 * g, L = SEQ >> l2d;
    u.g = g; u.bh = bh; u.llin0 = c4 * 512 + wave * 64; u.l0 = u.llin0 & (L - 1); u.kb_lo = (u.l0 - 128) > 0 ? (u.l0 - 128) : 0; u.eoff = (g * 16 + (bh & 15)) * 192;
    u.qbase = QKV + (size_t)g * SLAB + ((size_t)bh * SEQ + u.llin0) * HD;
    u.kres = u.qbase + 3 * SLAB - (size_t)u.l0 * HD; u.vres = u.qbase + 6 * SLAB - (size_t)u.l0 * HD;
    return u;
}
typedef __bf16 bf16x2n __attribute__((ext_vector_type(2)));
__device__ __forceinline__ unsigned cvtpk_n(float lo, float hi) { const f32x2 v = {lo, hi}; return __builtin_bit_cast(unsigned, __builtin_convertvector(v, bf16x2n)); }
#define AT_QBLOCK(QF, O0, O1, MROW, LSUM, EB) do { \
        f32x16 p_; _Pragma("unroll") for (int e = 0; e < 16; ++e) p_[e] = 0.f; \
        _Pragma("unroll") for (int s_ = 0; s_ < 4; ++s_) p_ = __builtin_amdgcn_mfma_f32_32x32x16_bf16(kf[s_], QF[s_], p_, 0, 0, 0); \
        float bm_ = -1e30f; \
        _Pragma("unroll") for (int e = 0; e < 16; ++e) { p_[e] += ext[(EB) - ((e & 3) + 8 * (e >> 2))]; bm_ = fmaxf(bm_, p_[e]); } \
        bm_ = fmaxf(bm_, __shfl_xor(bm_, 32)); \
        const float mn_ = fmaxf(MROW, bm_), alpha_ = __builtin_amdgcn_exp2f(MROW - mn_); MROW = mn_; \
        float ps_ = 0.f; \
        _Pragma("unroll") for (int e = 0; e < 16; ++e) { p_[e] = __builtin_amdgcn_exp2f(p_[e] - mn_); ps_ += p_[e]; } \
        LSUM = LSUM * alpha_ + ps_; \
        _Pragma("unroll") for (int e = 0; e < 16; ++e) { O0[e] *= alpha_; O1[e] *= alpha_; } \
        _Pragma("unroll") for (int s_ = 0; s_ < 2; ++s_) { \
            v4u w_; w_.x = cvtpk_n(p_[8 * s_], p_[8 * s_ + 1]); w_.y = cvtpk_n(p_[8 * s_ + 2], p_[8 * s_ + 3]); w_.z = cvtpk_n(p_[8 * s_ + 4], p_[8 * s_ + 5]); w_.w = cvtpk_n(p_[8 * s_ + 6], p_[8 * s_ + 7]); \
            const bf16x8v pf_ = __builtin_bit_cast(bf16x8v, w_); \
            const v4i16_t a00_ = vtr16(vt + (16 * s_) * 64 + vtr_off), a01_ = vtr16(vt + (16 * s_ + 8) * 64 + vtr_off), a10_ = vtr16(vt + 2048 + (16 * s_) * 64 + vtr_off), a11_ = vtr16(vt + 2048 + (16 * s_ + 8) * 64 + vtr_off); \
            O0 = __builtin_amdgcn_mfma_f32_32x32x16_bf16((bf16x8v){a00_[0], a00_[1], a00_[2], a00_[3], a01_[0], a01_[1], a01_[2], a01_[3]}, pf_, O0, 0, 0, 0); \
            O1 = __builtin_amdgcn_mfma_f32_32x32x16_bf16((bf16x8v){a10_[0], a10_[1], a10_[2], a10_[3], a11_[0], a11_[1], a11_[2], a11_[3]}, pf_, O1, 0, 0, 0); } \
    } while (0)
#define AT_FINISH(O0, O1, MROW, LSUM, QROW0) do { \
        const float ltot_ = LSUM + __shfl_xor(LSUM, 32), inv_ = 1.f / ltot_; \
        _Pragma("unroll") for (int q = 0; q < 4; ++q) { v2u w0_, w1_; \
            w0_.x = cvtpk_n(O0[4 * q] * inv_, O0[4 * q + 1] * inv_); w0_.y = cvtpk_n(O0[4 * q + 2] * inv_, O0[4 * q + 3] * inv_); \
            w1_.x = cvtpk_n(O1[4 * q] * inv_, O1[4 * q + 1] * inv_); w1_.y = cvtpk_n(O1[4 * q + 2] * inv_, O1[4 * q + 3] * inv_); \
            *(LAS v2u*)(kt + r32 * 128 + ((q ^ (r32 & 7)) << 4) + 8 * hh) = w0_; *(LAS v2u*)(kt + r32 * 128 + (((4 + q) ^ (r32 & 7)) << 4) + 8 * hh) = w1_; } \
        if (!dry) { _Pragma("unroll") for (int i = 0; i < 4; ++i) { const v4u w_ = *(const LAS v4u*)(kt + (8 * i + crow8) * 128 + ((cch ^ crow8) << 4)); *(v4u*)(cu.qbase + ((QROW0) + 8 * i + crow8) * HD + cch * 8) = w_; } } \
        if (hh == 0) { const int l2d_ = 2 * cu.g, L_ = SEQ >> l2d_, llin_ = cu.llin0 + (QROW0) + r32, rres_ = llin_ >> (11 - l2d_), l_ = llin_ & (L_ - 1), t_ = (l_ << l2d_) + rres_, row_ = (cu.bh >> 4) * SEQ + t_; \
            LSE[((size_t)cu.g * M + row_) * 16 + (cu.bh & 15)] = MROW + log2f(ltot_); } \
    } while (0)
__device__ __forceinline__ void p_attn(const Ctx& C, const bool dry) {
    bf16* QKV = (bf16*)(C.ws + WS_QKV); float* LSE = (float*)(C.ws + WS_LSE); const float* bt = (const float*)(C.ws + WS_BIAS);
    LAS float* ext = (LAS float*)(C.lds + AT_EXT);
    LAS unsigned char* vt = C.lds + AT_VT + C.wave * 8192; LAS unsigned char* kt = vt + 4096;
    const int lane = C.lane, r32 = lane & 31, hh = lane >> 5, wave = C.wave, tid = C.tid;
    const int crow8 = lane >> 3, cch = lane & 7;
    const int vtr_off = (4 * hh + ((lane & 15) >> 2)) * 64 + ((lane >> 4) & 1) * 32 + (lane & 3) * 8;
    for (int i = tid; i < 48 * 192; i += 512) { const int gh = i / 192, dist = i - gh * 192 - 32; ext[i] = (dist >= 0 && dist <= 128) ? bt[gh * 132 + dist] : -1e30f; }
    __syncthreads();
    const int total = NGRP * BATCH * NHEAD * 4;
    int it = blockIdx.x;
    if (it >= total) return;
    AttnUnit cu = attn_unit(QKV, it, wave), nu = cu;
    v4u kfn[4], vvn[4];
#define AT_LOADKV(U, KB) do { const bf16* kblk_ = (U).kres + (size_t)(KB) * HD; const bf16* vblk_ = (U).vres + (size_t)(KB) * HD; \
        _Pragma("unroll") for (int i_ = 0; i_ < 4; ++i_) { vvn[i_] = *(const v4u*)(vblk_ + (8 * i_ + crow8) * HD + cch * 8); kfn[i_] = *(const v4u*)(kblk_ + (8 * i_ + crow8) * HD + cch * 8); } } while (0)
#define AT_LOADQ(U) do { _Pragma("unroll") for (int i_ = 0; i_ < 8; ++i_) qfn[i_] = *(const v4u*)((U).qbase + (8 * i_ + crow8) * HD + cch * 8); } while (0)
#define AT_TILE2FRAG(RAW, OFS, FR) do { _Pragma("unroll") for (int i_ = 0; i_ < 4; ++i_) *(LAS v4u*)(kt + (8 * i_ + crow8) * 128 + ((cch ^ crow8) << 4)) = RAW[(OFS) + i_]; \
        _Pragma("unroll") for (int s_ = 0; s_ < 4; ++s_) FR[s_] = *(const LAS bf16x8v*)(kt + r32 * 128 + (((2 * s_ + hh) ^ (r32 & 7)) << 4)); } while (0)
    AT_LOADKV(cu, cu.l0 + 32);
    for (;;) {
        bf16x8v qfA[4], qfB[4];
        { v4u qfn[8]; AT_LOADQ(cu); AT_TILE2FRAG(qfn, 0, qfA); AT_TILE2FRAG(qfn, 4, qfB); }
        f32x16 oA0, oA1, oB0, oB1;
#pragma unroll
        for (int e = 0; e < 16; ++e) { oA0[e] = 0.f; oA1[e] = 0.f; oB0[e] = 0.f; oB1[e] = 0.f; }
        float mA = -1e30f, lA = 0.f, mB = -1e30f, lB = 0.f;
        const bool has_next = (it + C.G) < total;
#define AT_STEP(KB, USEA, USEB) do { const int kb_ = (KB); \
            v4u vv[4], kraw[4]; bf16x8v kf[4]; \
            _Pragma("unroll") for (int i = 0; i < 4; ++i) { vv[i] = vvn[i]; kraw[i] = kfn[i]; } \
              \
            if (kb_ - 32 >= cu.kb_lo) { AT_LOADKV(cu, kb_ - 32); } \
            else if (has_next) { nu = attn_unit(QKV, it + C.G, wave); AT_LOADKV(nu, nu.l0 + 32); } \
            _Pragma("unroll") for (int i = 0; i < 4; ++i) *(LAS v4u*)(vt + (cch >> 2) * 2048 + (8 * i + crow8) * 64 + (cch & 3) * 16) = vv[i]; \
            AT_TILE2FRAG(kraw, 0, kf); \
            const int ebA = cu.eoff + cu.l0 + r32 - kb_ - 4 * hh + 32;            \
            if (USEB) { AT_QBLOCK(qfB, oB0, oB1, mB, lB, ebA + 32); } \
            if (USEA) { AT_QBLOCK(qfA, oA0, oA1, mA, lA, ebA); } \
        } while (0)
        AT_STEP(cu.l0 + 32, false, true);
        { const int kb_both_lo = (cu.l0 - 96) > cu.kb_lo ? (cu.l0 - 96) : cu.kb_lo;
          for (int kb = cu.l0; kb >= kb_both_lo; kb -= 32) AT_STEP(kb, true, true); }
        if (cu.l0 >= 128) AT_STEP(cu.l0 - 128, true, false);
#undef AT_STEP
        AT_FINISH(oA0, oA1, mA, lA, 0);
        AT_FINISH(oB0, oB1, mB, lB, 32);
        if (!has_next) break;
        it += C.G; cu = nu;
    }
#undef AT_LOADKV
#undef AT_LOADQ
#undef AT_TILE2FRAG
}
#undef AT_QBLOCK
#undef AT_FINISH
__device__ __forceinline__ void p_merge(const Ctx& C, const Args& a) {
    const bf16* QKV = (const bf16*)(C.ws + WS_QKV); const float* LSE = (const float*)(C.ws + WS_LSE); bf16* ATT = (bf16*)(C.ws + WS_ATT);
    for (int idx = blockIdx.x * 512 + C.tid; idx < M * 16 * 8; idx += C.G * 512) {
        const int ch = idx & 7, h = (idx >> 3) & 15, row = idx >> 7, b = row >> 11, t = row & 2047;
        float ls[3], mxl = -INFINITY;
#pragma unroll
        for (int g = 0; g < 3; ++g) { ls[g] = LSE[((size_t)g * M + row) * 16 + h]; mxl = fmaxf(mxl, ls[g]); }
        float acc[8], wsum = 0.f;
#pragma unroll
        for (int e = 0; e < 8; ++e) acc[e] = 0.f;
#pragma unroll
        for (int g = 0; g < 3; ++g) { const float w = exp2f(ls[g] - mxl); wsum += w; const int l2d = 2 * g, rres = t & ((1 << l2d) - 1), l = t >> l2d, L = SEQ >> l2d;
            const v4u v = *(const v4u*)(QKV + (size_t)g * ((size_t)M * 1024) + ((size_t)(b * 16 + h) * SEQ + rres * L + l) * HD + 8 * ch);
            acc[0] += w * bf_lo(v.x); acc[1] += w * bf_hi(v.x); acc[2] += w * bf_lo(v.y); acc[3] += w * bf_hi(v.y); acc[4] += w * bf_lo(v.z); acc[5] += w * bf_hi(v.z); acc[6] += w * bf_lo(v.w); acc[7] += w * bf_hi(v.w); }
        const float inv = 1.f / wsum; v4u o; o.x = pk2(acc[0] * inv, acc[1] * inv); o.y = pk2(acc[2] * inv, acc[3] * inv); o.z = pk2(acc[4] * inv, acc[5] * inv); o.w = pk2(acc[6] * inv, acc[7] * inv);
        *(v4u*)(ATT + (size_t)row * 1024 + h * 64 + 8 * ch) = o;
    }
}

enum { PH_PROLOGUE = 0, PH_FFN_IN_0, PH_FFN_OUT_0, PH_RNN_IN, PH_RNN_MID, PH_RNN_OUT, PH_FFN_IN_1, PH_FFN_OUT_1,
       PH_FFN_IN_2, PH_FFN_OUT_2, PH_QKV, PH_ATTN, PH_MERGE, PH_WO, PH_FFN_IN_3, PH_FFN_OUT_3, NPHASE };

__global__ void __launch_bounds__(NWAVES * 64, 2) fwd_kernel(Args args) {
    extern __shared__ __attribute__((aligned(16))) unsigned char lds_raw[];
    Ctx C; C.lds = (LAS unsigned char*)lds_raw; C.tid = threadIdx.x; C.lane = C.tid & 63; C.wave = __builtin_amdgcn_readfirstlane(C.tid >> 6);
    C.G = gridDim.x; { const int bx = blockIdx.x; C.vcu = (C.G % 8 == 0) ? (bx % 8) * (C.G / 8) + bx / 8 : bx; }
    C.ws = args.ws;
    volatile LAS unsigned* MISC = (volatile LAS unsigned*)(C.lds + MISC_OFF);
    for (int u = C.tid; u < (LDS_BYTES - LDSCTL_OFF) / 4; u += NWAVES * 64) ((LAS unsigned*)(C.lds + LDSCTL_OFF))[u] = 0u;
    __syncthreads();
    unsigned* ctl = (unsigned*)args.ws;
    XcdBarrier bar; bar.bar = ctl + CW_BAR; bar.x = 0; bar.st = nullptr;
    const bool multi = (args.ph_hi - args.ph_lo) > 1;
    if (multi) bar = xcd_barrier_post(ctl + CW_BAR, MISC + 8);
    for (int ph = args.ph_lo; ph < args.ph_hi; ++ph) {
        for (int rep = ((DUP_MASK >> ph) & 1u) ? DUP_N : 0; rep >= 0; --rep) {
        const bool dry = rep > 0;
        { int t_ = threadIdx.x; asm volatile("" : "+v"(t_)); C.tid = t_; C.lane = t_ & 63; }
        unsigned char* ws = args.ws;
        C.ws = ws; float* ssq = (float*)(ws + WS_SSQ); bf16* xb = (bf16*)(ws + WS_XB);
        switch (ph) {
        case PH_PROLOGUE: p_prologue(C, args); break;
        case PH_FFN_IN_0: case PH_FFN_IN_1: case PH_FFN_IN_2: case PH_FFN_IN_3: {
            if (!dry && ph != PH_FFN_IN_3) { const int f = (ph == PH_FFN_IN_0) ? 1 : (ph == PH_FFN_IN_1) ? 8 : 10, l = (ph == PH_FFN_IN_0) ? 4 : (ph == PH_FFN_IN_1) ? 10 : 12; spare_convert(C, args, f, l, (M / 256) * (2 * FF / 256)); }
            const bf16* Bt = (ph == PH_FFN_IN_3) ? (const bf16*)args.out : (const bf16*)(ws + (ph == PH_FFN_IN_0 ? WS_WIN0 : ph == PH_FFN_IN_1 ? WS_WIN1 : WS_WIN2));
            bf16* act = (bf16*)(ws + (ph == PH_FFN_IN_3 ? WS_ACT3 : WS_ACT));
            pg8::Gemm g{xb, Bt, M, 2 * FF, D}; pg8::StaticOrder S; S.init(M, 2 * FF, C.G, (int)blockIdx.x);
            fill_rstd(C.lds, S, ssq, C.tid);
            EpiSwiGLU E{(const LAS float*)(C.lds + RSTD_OFF), act, dry ? DUP_SKIP_EPI : 0};
            pg8::gemm_phase<EpiSwiGLU, pg8::StaticOrder, true, true>(C.lds, g, S, E);
        } break;
        case PH_FFN_OUT_0: case PH_FFN_OUT_1: case PH_FFN_OUT_2: case PH_FFN_OUT_3: case PH_RNN_OUT: case PH_WO: {
            const bf16* A; const bf16* Bt; int K; float scale = 0.5f; const float* xin = args.out;
            if (ph == PH_FFN_OUT_0) { A = (const bf16*)(ws + WS_ACT); Bt = (const bf16*)(ws + WS_WOUT0); K = FF; xin = args.in[I_X]; }
            else if (ph == PH_FFN_OUT_1) { A = (const bf16*)(ws + WS_ACT); Bt = (const bf16*)(ws + WS_WOUT1); K = FF; }
            else if (ph == PH_FFN_OUT_2) { A = (const bf16*)(ws + WS_ACT); Bt = (const bf16*)(ws + WS_WOUT2); K = FF; }
            else if (ph == PH_FFN_OUT_3) { A = (const bf16*)(ws + WS_ACT3); Bt = (const bf16*)(ws + WS_WOUT3); K = FF; }
            else if (ph == PH_RNN_OUT) { A = (const bf16*)(ws + WS_Y); Bt = (const bf16*)(ws + WS_WROUT); K = DRNN; scale = 1.f; }
            else { A = (const bf16*)(ws + WS_ATT); Bt = (const bf16*)(ws + WS_WO); K = D; scale = 1.f; }
            if (dry && ph != PH_FFN_OUT_0) scale = 0.f;
            float* xo = args.out;
#if RESID_BF16
            if (ph != PH_FFN_OUT_0) xin = nullptr;
            if (ph != PH_FFN_OUT_3 || dry) xo = nullptr;
#endif
            pg8::Gemm g{A, Bt, M, D, K}; pg8::StaticOrder S; S.init(M, D, C.G, (int)blockIdx.x);
            EpiRes E{xin, xo, xb, ssq, scale, dry && DUP_SKIP_EPI};
            pg8::gemm_phase<EpiRes, pg8::StaticOrder, false, true>(C.lds, g, S, E);
        } break;
        case PH_RNN_IN: {
            pg8::Gemm g{xb, (const bf16*)(ws + WS_WRIN), M, 2 * DRNN, D}; pg8::StaticOrder S; S.init(M, 2 * DRNN, C.G, (int)blockIdx.x);
            fill_rstd(C.lds, S, ssq, C.tid);
            EpiRnnIn E{(const LAS float*)(C.lds + RSTD_OFF), (bf16*)(ws + WS_G), (bf16*)(ws + WS_U)};
            pg8::gemm_phase<EpiRnnIn, pg8::StaticOrder, true, true>(C.lds, g, S, E);
        } break;
        case PH_RNN_MID: p_rnn_mid(C, args); break;
        case PH_QKV: {
            pg8::Gemm g{xb, (const bf16*)(ws + WS_WQKV), M, NQKV, D}; pg8::StaticOrder S; S.init(M, NQKV, C.G, (int)blockIdx.x);
            if (C.tid < 128) ((LAS float*)(C.lds + GAIN_OFF))[C.tid] = (C.tid < 64) ? args.in[I_QGAIN][C.tid] * (0.125f * LOG2E) : args.in[I_KGAIN][C.tid - 64];
            fill_rstd(C.lds, S, ssq, C.tid);
            EpiQKV E{(const LAS float*)(C.lds + RSTD_OFF), (const LAS float*)(C.lds + GAIN_OFF), (bf16*)(ws + WS_QKV), dry && DUP_SKIP_EPI};
            pg8::gemm_phase<EpiQKV, pg8::StaticOrder, true, true>(C.lds, g, S, E);
        } break;
        case PH_ATTN: p_attn(C, dry); break;
        case PH_MERGE: p_merge(C, args); break;
        default: break;
        }
        if (dry || ph + 1 < args.ph_hi) xcd_barrier(bar);
        if (ph == 0 && !dry) for (int eb = 0; eb < DUP_EXTRA_BARRIERS; ++eb) xcd_barrier(bar);
        }
    }
}

extern "C" void kernel_launch(void* const* d_in, const int* in_sizes, int n_in, void* d_out, int out_size, void* d_ws, size_t ws_size, hipStream_t stream) {
    static int grid = 0;
    if (grid == 0) {
        if (n_in != 18 || in_sizes[0] != M * D || out_size != M * D || ws_size < WS_END) { fprintf(stderr, "kernel_launch: unexpected shapes (n_in %d, in0 %d, out %d, ws %zu)\n", n_in, n_in > 0 ? in_sizes[0] : -1, out_size, ws_size); grid = -1; return; }
        int dev = 0, cus = 0, per_cu = 0;
        if (hipGetDevice(&dev) != hipSuccess || hipDeviceGetAttribute(&cus, hipDeviceAttributeMultiprocessorCount, dev) != hipSuccess) { fprintf(stderr, "kernel_launch: device query failed\n"); grid = -1; return; }
        if (hipFuncSetAttribute((const void*)fwd_kernel, hipFuncAttributeMaxDynamicSharedMemorySize, LDS_BYTES) != hipSuccess) { fprintf(stderr, "kernel_launch: hipFuncSetAttribute failed\n"); grid = -1; return; }
        if (hipOccupancyMaxActiveBlocksPerMultiprocessor(&per_cu, (const void*)fwd_kernel, NWAVES * 64, LDS_BYTES) != hipSuccess || per_cu < 1) { fprintf(stderr, "kernel_launch: occupancy query says %d blocks per CU\n", per_cu); (void)hipGetLastError(); grid = -1; return; }
        grid = cus;
    }
    if (grid < 0) return;
    if (hipMemsetAsync(d_ws, 0, CTL_ZERO_BYTES, stream) != hipSuccess) { fprintf(stderr, "kernel_launch: memset failed\n"); return; }
    Args a{};
    for (int i = 0; i < 18; ++i) a.in[i] = (const float*)d_in[i];
    a.out = (float*)d_out; a.ws = (unsigned char*)d_ws;
#if SINGLE_LAUNCH
    a.ph_lo = 0; a.ph_hi = NPHASE;
    hipLaunchKernelGGL(fwd_kernel, dim3(grid), dim3(NWAVES * 64), LDS_BYTES, stream, a);
#else
    for (int ph = 0; ph < NPHASE; ++ph) { a.ph_lo = ph; a.ph_hi = ph + 1; hipLaunchKernelGGL(fwd_kernel, dim3(grid), dim3(NWAVES * 64), LDS_BYTES, stream, a); }
#endif
}
```

```cpp
#include <hip/hip_runtime.h>
#include <cstdio>
#include <cstdint>

#ifndef SINGLE_LAUNCH
#define SINGLE_LAUNCH 1
#define DUP_MASK 0u
#define DUP_N 1
#define DUP_EXTRA_BARRIERS 0
#define DUP_SKIP_EPI 0
#endif

namespace pg8 {
#define PG8_LAS __attribute__((address_space(3)))
typedef unsigned short bf16_t;
typedef short bf16x8 __attribute__((ext_vector_type(8)));
typedef float f32x4 __attribute__((ext_vector_type(4)));
typedef unsigned u32x4 __attribute__((ext_vector_type(4)));
constexpr int BM = 256, BK = 64, HALF = 128, HTB = HALF * BK * 2, STAGE_BYTES = 8 * HTB, NXCD = 8, WGM = 8;

__host__ __device__ __forceinline__ int lds_byte(int r, int c) { return (r >> 3) * 1024 + (r & 7) * 128 + ((((c >> 3) ^ (r & 7)) & 7) << 4) + (c & 7) * 2; }
__host__ __device__ __forceinline__ void stage_rc(int b, int& R, int& C) { const int sidx = b / 1024, w = b % 1024, rowin = w / 128, pch = (w % 128) / 16; R = sidx * 8 + rowin; C = ((pch ^ rowin) & 7) * 8; }
__host__ __device__ __forceinline__ int perm32(int rho) { const int n = rho >> 4, i = rho & 15; return 8 * (i >> 2) + 4 * n + (i & 3); }

struct Unit { int pm, pn; };
struct Gemm { const bf16_t* A; const bf16_t* Bt; int M, N, K; };

struct StaticOrder {
    int nM, nN, nwg, G, c;
    __host__ __device__ void init(int M, int N, int G_, int c_) { nM = M / BM; nN = N / BM; nwg = nM * nN; G = G_; c = c_; }
    __host__ __device__ bool next(int i, Unit& u) const {
        const long L = (long)i * G + c; if (L >= nwg) return false;
        int wgid = (int)L; { const int q = nwg / NXCD, r = nwg % NXCD, xcd = wgid % NXCD, off = wgid / NXCD; wgid = (xcd < r ? xcd * (q + 1) : r * (q + 1) + (xcd - r) * q) + off; }
        const int nig = WGM * nN, gid = wgid / nig, fm = gid * WGM, gsz = (nM - fm) < WGM ? (nM - fm) : WGM;
        u.pm = fm + ((wgid % nig) % gsz); u.pn = (wgid % nig) / gsz; return true;
    }
    __device__ __forceinline__ void a_ready(const Unit&) const {}
    __device__ __forceinline__ void done(const Unit&) const {}
};

__device__ __forceinline__ unsigned cvt_pk_bf16(float lo, float hi) { unsigned r; asm volatile("v_cvt_pk_bf16_f32 %0, %1, %2" : "=v"(r) : "v"(lo), "v"(hi)); return r; }

template <class Epi, class Sched, bool ALIGN_EPI = false, bool SP2 = false>
__device__ __forceinline__ void gemm_phase(PG8_LAS unsigned char* lds, const Gemm g, const Sched& S, const Epi& E) {
    int tid_ = threadIdx.x; asm volatile("" : "+v"(tid_));
    const int tid = tid_, wid = __builtin_amdgcn_readfirstlane(tid >> 6), lane = tid & 63, wr = wid >> 2, wc = wid & 3, fr = lane & 15, fq = lane >> 4;
    const int K = g.K, nt = K / BK;
    unsigned voffA, voffB;
    { int R, C; stage_rc(tid * 16, R, C); const int Rb = Epi::PERM ? ((R & ~31) + perm32(R & 31)) : R; voffA = (unsigned)(R * K + C) * 2u; voffB = (unsigned)(Rb * K + C) * 2u; }
    const size_t pstep = (size_t)64 * K * 2;
    const size_t kstep = (size_t)(BK * 2);
    const size_t hstep = (size_t)HALF * K * 2;
    const size_t tstep = 2 * hstep;
    const unsigned ldsw = (unsigned)wid * 1024u;
    const int aoff = lds_byte(wr * 64 + fr, fq * 8), boff = lds_byte(wc * 32 + fr, fq * 8);
#define PG8_SA(b, h) (((b) * 2 + (h)) * HTB)
#define PG8_SB(b, h) ((4 + (b) * 2 + (h)) * HTB)
#define PG8_STAGE(bufoff, gbase, voff) do { _Pragma("unroll") for (int _i = 0; _i < 2; ++_i) \
        __builtin_amdgcn_global_load_lds((const unsigned*)((const char*)(gbase) + _i * pstep + (voff)), (PG8_LAS unsigned*)(lds + (bufoff) + ldsw + _i * 8192), 16, 0, 0); } while (0)
#define PG8_LDA(dst, b, h) do { _Pragma("unroll") for (int m = 0; m < 4; ++m) _Pragma("unroll") for (int k = 0; k < 2; ++k) dst[m][k] = *(const PG8_LAS bf16x8*)(lds + PG8_SA(b, h) + (aoff ^ (k * 64)) + m * 2048); } while (0)
#define PG8_LDB(dst, b, h) do { _Pragma("unroll") for (int n = 0; n < 2; ++n) _Pragma("unroll") for (int k = 0; k < 2; ++k) dst[n][k] = *(const PG8_LAS bf16x8*)(lds + PG8_SB(b, h) + (boff ^ (k * 64)) + n * 2048); } while (0)
#define PG8_MMA(ai, bj, At, Bt) do { __builtin_amdgcn_s_setprio(1); _Pragma("unroll") for (int m = 0; m < 4; ++m) _Pragma("unroll") for (int n = 0; n < 2; ++n) _Pragma("unroll") for (int k = 0; k < 2; ++k) \
        acc[ai][bj][m][n] = __builtin_amdgcn_mfma_f32_16x16x32_bf16(Bt[n][k], At[m][k], acc[ai][bj][m][n], 0, 0, 0); __builtin_amdgcn_s_setprio(0); } while (0)
#define PG8_WAIT_V(n) asm volatile("s_waitcnt vmcnt(" #n ")" ::: "memory")
#define PG8_WAIT_L(n) asm volatile("s_waitcnt lgkmcnt(" #n ")" ::: "memory")
#define PG8_BAR __builtin_amdgcn_s_barrier()
#define PG8_SCHED __builtin_amdgcn_sched_barrier(0)
    Unit cur, nxt; int ui = 0;
    if (!S.next(0, cur)) return;
    f32x4 acc[2][2][4][2];
#pragma unroll
    for (int a = 0; a < 2; ++a)
#pragma unroll
        for (int b = 0; b < 2; ++b)
#pragma unroll
            for (int m = 0; m < 4; ++m)
#pragma unroll
                for (int n = 0; n < 2; ++n) acc[a][b][m][n] = (f32x4){0.f, 0.f, 0.f, 0.f};
    bf16x8 At[4][2], B0[2][2], B1[2][2];
    const char* cA = (const char*)g.A + (size_t)cur.pm * tstep; const char* cB = (const char*)g.Bt + (size_t)cur.pn * tstep;
    S.a_ready(cur);
    if constexpr (SP2) {
        PG8_STAGE(PG8_SB(0, 0), cB, voffB); PG8_STAGE(PG8_SB(0, 1), cB + hstep, voffB); PG8_STAGE(PG8_SA(0, 0), cA, voffA); PG8_STAGE(PG8_SA(0, 1), cA + hstep, voffA);
        if (wr == 1) PG8_BAR;
        PG8_WAIT_V(2); PG8_BAR;
        PG8_STAGE(PG8_SB(1, 0), cB + kstep, voffB); PG8_STAGE(PG8_SA(1, 0), cA + kstep, voffA); PG8_STAGE(PG8_SB(1, 1), cB + hstep + kstep, voffB);
        PG8_WAIT_V(6); PG8_BAR;
    } else {
        PG8_STAGE(PG8_SB(0, 0), cB, voffB); PG8_STAGE(PG8_SA(0, 0), cA, voffA); PG8_STAGE(PG8_SB(0, 1), cB + hstep, voffB); PG8_STAGE(PG8_SA(0, 1), cA + hstep, voffA);
        if (wr == 1) PG8_BAR;
        PG8_WAIT_V(4); PG8_BAR;
        PG8_STAGE(PG8_SB(1, 0), cB + kstep, voffB); PG8_STAGE(PG8_SA(1, 0), cA + kstep, voffA); PG8_STAGE(PG8_SB(1, 1), cB + hstep + kstep, voffB);
        PG8_WAIT_V(6); PG8_BAR;
    }
    for (;;) {
        const bool has_next = S.next(ui + 1, nxt);
        const char* nA = has_next ? (const char*)g.A + (size_t)nxt.pm * tstep : cA; const char* nB = has_next ? (const char*)g.Bt + (size_t)nxt.pn * tstep : cB;
        for (int t = 0; t < nt; t += 2) {
            const bool last = (t == nt - 2);
            const char* a1 = cA + (size_t)(t + 1) * kstep;
            const char* a2 = last ? nA : cA + (size_t)(t + 2) * kstep; const char* b2 = last ? nB : cB + (size_t)(t + 2) * kstep;
            const char* a3 = a2 + kstep; const char* b3 = b2 + kstep;
            if (last && has_next) S.a_ready(nxt);
            if constexpr (SP2) {
            PG8_LDB(B0, 0, 0); PG8_LDB(B1, 0, 1); PG8_SCHED; PG8_LDA(At, 0, 0); PG8_STAGE(PG8_SA(1, 1), a1 + hstep, voffA);
            PG8_WAIT_V(8); PG8_WAIT_L(0); PG8_BAR; PG8_MMA(0, 0, At, B0); PG8_MMA(0, 1, At, B1); PG8_BAR; PG8_SCHED;
            PG8_LDA(At, 0, 1); PG8_STAGE(PG8_SB(0, 0), b2, voffB); PG8_STAGE(PG8_SB(0, 1), b2 + hstep, voffB); PG8_STAGE(PG8_SA(0, 0), a2, voffA);
            PG8_WAIT_V(8); PG8_WAIT_L(0); PG8_BAR; PG8_MMA(1, 0, At, B0); PG8_MMA(1, 1, At, B1); PG8_BAR; PG8_SCHED;
            PG8_LDB(B0, 1, 0); PG8_LDB(B1, 1, 1); PG8_SCHED; PG8_LDA(At, 1, 0); PG8_STAGE(PG8_SA(0, 1), a2 + hstep, voffA);
            PG8_WAIT_V(8); PG8_WAIT_L(0); PG8_BAR; PG8_MMA(0, 0, At, B0); PG8_MMA(0, 1, At, B1); PG8_BAR; PG8_SCHED;
            PG8_LDA(At, 1, 1); PG8_STAGE(PG8_SB(1, 0), b3, voffB); PG8_STAGE(PG8_SB(1, 1), b3 + hstep, voffB); PG8_STAGE(PG8_SA(1, 0), a3, voffA);
            PG8_WAIT_V(8); PG8_WAIT_L(0); PG8_BAR; PG8_MMA(1, 0, At, B0); PG8_MMA(1, 1, At, B1); PG8_BAR; PG8_SCHED;
            } else {
            PG8_LDB(B0, 0, 0); PG8_SCHED; PG8_LDA(At, 0, 0); PG8_STAGE(PG8_SA(1, 1), a1 + hstep, voffA);
            PG8_WAIT_L(8); PG8_BAR; PG8_WAIT_L(0); PG8_MMA(0, 0, At, B0); PG8_BAR; PG8_SCHED;
            PG8_LDB(B1, 0, 1); PG8_STAGE(PG8_SB(0, 0), b2, voffB);
            PG8_BAR; PG8_WAIT_L(0); PG8_MMA(0, 1, At, B1); PG8_BAR;
            PG8_LDA(At, 0, 1); PG8_STAGE(PG8_SA(0, 0), a2, voffA);
            PG8_BAR; PG8_WAIT_L(0); PG8_MMA(1, 0, At, B0); PG8_BAR; PG8_SCHED;
            PG8_STAGE(PG8_SB(0, 1), b2 + hstep, voffB);
            PG8_WAIT_V(6); PG8_BAR; PG8_MMA(1, 1, At, B1); PG8_BAR;
            PG8_LDB(B0, 1, 0); PG8_SCHED; PG8_LDA(At, 1, 0); PG8_STAGE(PG8_SA(0, 1), a2 + hstep, voffA);
            PG8_WAIT_L(8); PG8_BAR; PG8_WAIT_L(0); PG8_MMA(0, 0, At, B0); PG8_BAR; PG8_SCHED;
            PG8_LDB(B1, 1, 1); PG8_STAGE(PG8_SB(1, 0), b3, voffB);
            PG8_BAR; PG8_WAIT_L(0); PG8_MMA(0, 1, At, B1); PG8_BAR;
            PG8_LDA(At, 1, 1); PG8_STAGE(PG8_SA(1, 0), a3, voffA);
            PG8_BAR; PG8_WAIT_L(0); PG8_MMA(1, 0, At, B0); PG8_BAR; PG8_SCHED;
            PG8_STAGE(PG8_SB(1, 1), b3 + hstep, voffB);
            PG8_WAIT_V(6); PG8_BAR; PG8_MMA(1, 1, At, B1); PG8_BAR;
            }
        }
        if constexpr (ALIGN_EPI) { if (wr == 0) PG8_BAR; }
        E(acc, cur, ui, wr, wc, fr, fq); S.done(cur);
        if (!has_next) break;
#pragma unroll
        for (int a = 0; a < 2; ++a)
#pragma unroll
            for (int b = 0; b < 2; ++b)
#pragma unroll
                for (int m = 0; m < 4; ++m)
#pragma unroll
                    for (int n = 0; n < 2; ++n) acc[a][b][m][n] = (f32x4){0.f, 0.f, 0.f, 0.f};
        cur = nxt; cA = nA; cB = nB; ++ui;
        if constexpr (ALIGN_EPI) { if (wr == 1) PG8_BAR; }
    }
    PG8_WAIT_V(0);
    if constexpr (!ALIGN_EPI) { if (wr == 0) PG8_BAR; }
    PG8_BAR;
#undef PG8_SA
#undef PG8_SB
#undef PG8_STAGE
#undef PG8_LDA
#undef PG8_LDB
#undef PG8_MMA
#undef PG8_WAIT_V
#undef PG8_WAIT_L
#undef PG8_BAR
#undef PG8_SCHED
}
}

constexpr int BATCH = 8, SEQ = 2048, D = 1024, M = BATCH * SEQ;
constexpr int FF = 2816, DRNN = 1280, NBLK = 10, RBLK = 128, CONVW = 4;
constexpr int NHEAD = 16, HD = 64, NGRP = 3, NQKV = 9216;
constexpr float RMS_EPS = 1e-6f;
constexpr float LOG2E = 1.4426950408889634f;
constexpr int NWAVES = 8;

typedef unsigned short bf16;
typedef unsigned v4u __attribute__((ext_vector_type(4)));
typedef unsigned v2u __attribute__((ext_vector_type(2)));
typedef float f32x4 __attribute__((ext_vector_type(4)));
#define GAS __attribute__((address_space(1)))
#define LAS __attribute__((address_space(3)))
typedef GAS unsigned gu32;
#define RLX_AGENT __ATOMIC_RELAXED, __HIP_MEMORY_SCOPE_AGENT
#define LDS_WAIT() asm volatile("s_waitcnt lgkmcnt(0)" ::: "memory")

#ifndef RESID_BF16
#define RESID_BF16 1
#endif
constexpr size_t MiB = 1u << 20;
constexpr size_t WS_CTL = 0, CTL_ZERO_BYTES = 1 * MiB;
constexpr size_t WS_SSQ = 1 * MiB;
constexpr size_t WS_BIAS = 2 * MiB;
constexpr size_t WS_XB = 3 * MiB;
constexpr size_t WS_WO = 35 * MiB;
constexpr size_t WS_WQKV = 37 * MiB;
constexpr size_t WS_QKV = 55 * MiB;
constexpr size_t QKV_SLAB = (size_t)M * 1024 * 2;
constexpr size_t WS_LSE = 343 * MiB;
constexpr size_t WS_END = 352 * MiB;
constexpr size_t WS_WIN0 = 55 * MiB, WS_WOUT0 = 66 * MiB, WS_WIN1 = 72 * MiB, WS_WOUT1 = 83 * MiB, WS_WIN2 = 89 * MiB, WS_WOUT2 = 100 * MiB;
constexpr size_t WS_WRIN = 106 * MiB, WS_WROUT = 111 * MiB, WS_WA = 114 * MiB, WS_WX = 114 * MiB + 512 * 1024;
constexpr size_t WS_ACT = 115 * MiB;
constexpr size_t WS_G = 203 * MiB, WS_U = 243 * MiB, WS_Y = 283 * MiB;
constexpr size_t WS_ATT = WS_QKV + 3 * QKV_SLAB;
constexpr size_t WS_WOUT3 = 346 * MiB;
constexpr size_t WS_ACT3 = WS_QKV;
static_assert(WS_Y + (size_t)M * DRNN * 2 <= WS_LSE && WS_ACT + (size_t)M * FF * 2 <= WS_G && WS_WX + 327680 <= WS_ACT, "ws map");
static_assert(WS_QKV + 9 * QKV_SLAB == WS_LSE && WS_LSE + (size_t)3 * M * 16 * 4 <= WS_WOUT3 && WS_WOUT3 + (size_t)D * FF * 2 <= WS_END && RESID_BF16 == 1, "ws map");
constexpr int CW_BAR = 4096;

constexpr int RING_BYTES = 131072, LDSCTL_OFF = RING_BYTES, MISC_OFF = LDSCTL_OFF + 320;
constexpr int RSTD_OFF = RING_BYTES + 1024, RSTD_MAX_UNITS = 9, GAIN_OFF = RSTD_OFF + RSTD_MAX_UNITS * 256 * 4;
constexpr int LDS_BYTES = 147456;
static_assert(GAIN_OFF + 512 <= LDS_BYTES, "LDS map");

#define XB_TMO      128
#define XB_XCNT(j)  (256  + 64 * (j))
#define XB_XSUB(j)  (1280 + 64 * (j))
#define XB_XGEN(j)  (2304 + 64 * (j))
#define XB_TOP      3328
#define XB_TOPGEN   3392
#define XCD_BAR_WORDS 3456
#define XB_SPIN_CAP (1u << 18)
__device__ __forceinline__ unsigned xb_ld(unsigned* p)              { return __hip_atomic_load(p, __ATOMIC_RELAXED, __HIP_MEMORY_SCOPE_AGENT); }
__device__ __forceinline__ unsigned xb_add(unsigned* p, unsigned v) { return __hip_atomic_fetch_add(p, v, __ATOMIC_RELAXED, __HIP_MEMORY_SCOPE_AGENT); }
__device__ __forceinline__ unsigned xb_xcc_id() { return (unsigned)__builtin_amdgcn_s_getreg((3 << 11) | 20) & 0xFu; }
#define XB_SPIN(cond, bar) do { unsigned _sp = 0; while (cond) { __builtin_amdgcn_s_sleep(1); \
    if ((++_sp & 255u) == 0u) { if (xb_ld(&(bar)[XB_TMO])) break; if (_sp > XB_SPIN_CAP) { atomicAdd(&(bar)[XB_TMO], 1u); break; } } } } while (0)
struct XcdBarrier { unsigned* bar; unsigned x; volatile LAS unsigned* st; };
__device__ __forceinline__ XcdBarrier xcd_barrier_post(unsigned* bar, volatile LAS unsigned* st) {
    XcdBarrier b; b.bar = bar; b.x = xb_xcc_id(); b.st = st;
    if (threadIdx.x == 0) (void)xb_add(&bar[XB_XCNT(b.x)], 1u);
    return b;
}
__device__ __forceinline__ void xcd_barrier_complete(unsigned* bar, unsigned x, unsigned& nloc, unsigned& nx) {
    const unsigned G = gridDim.x * gridDim.y * gridDim.z;
    unsigned sum, cnt, mine, sp = 0u;
    for (;;) {
        sum = 0u; cnt = 0u; mine = 0u;
#pragma unroll
        for (unsigned j = 0; j < 16; ++j) { const unsigned c = xb_ld(&bar[XB_XCNT(j)]); sum += c; cnt += (c > 0u) ? 1u : 0u; mine = (j == x) ? c : mine; }
        if (sum == G) break;
        __builtin_amdgcn_s_sleep(1);
        if ((++sp & 255u) == 0u) { if (xb_ld(&bar[XB_TMO])) break; if (sp > XB_SPIN_CAP) { atomicAdd(&bar[XB_TMO], 1u); break; } }
    }
    nloc = mine > 0u ? mine : 1u; nx = cnt > 0u ? cnt : 1u;
}
__device__ __forceinline__ void xcd_barrier(const XcdBarrier& b) {
    asm volatile("s_waitcnt vmcnt(0)" ::: "memory");
    __syncthreads();
    if (threadIdx.x == 0) {
        unsigned* bar = b.bar;
        __builtin_amdgcn_s_waitcnt(0);
        unsigned nloc = b.st[0], nx = b.st[1];
        if (nloc == 0u) { xcd_barrier_complete(bar, b.x, nloc, nx); b.st[0] = nloc; b.st[1] = nx; }
        const unsigned old = xb_add(&bar[XB_XSUB(b.x)], 1u);
        const unsigned gen = old / nloc;
        if (old + 1u == (gen + 1u) * nloc) {
            __builtin_amdgcn_fence(__ATOMIC_RELEASE, "agent");
            asm volatile("s_waitcnt vmcnt(0)" ::: "memory");
            const unsigned og = xb_add(&bar[XB_TOP], 1u);
            const unsigned tg = og / nx;
            if (og + 1u == (tg + 1u) * nx) xb_add(&bar[XB_TOPGEN], 1u);
            else XB_SPIN(xb_ld(&bar[XB_TOPGEN]) == tg, bar);
            __builtin_amdgcn_fence(__ATOMIC_ACQUIRE, "agent");
            xb_add(&bar[XB_XGEN(b.x)], 1u);
            asm volatile("s_waitcnt vmcnt(0)" ::: "memory");
        } else {
            XB_SPIN(xb_ld(&bar[XB_XGEN(b.x)]) == gen, bar);
            __builtin_amdgcn_fence(__ATOMIC_ACQUIRE, "agent");
            asm volatile("s_waitcnt vmcnt(0)" ::: "memory");
        }
    }
    __syncthreads();
}

__device__ __forceinline__ unsigned f2bf(float f) { unsigned u = __builtin_bit_cast(unsigned, f); return (u + 0x7fffu + ((u >> 16) & 1u)) >> 16; }
__device__ __forceinline__ unsigned pk2(float lo, float hi) { return f2bf(lo) | (f2bf(hi) << 16); }
__device__ __forceinline__ float bf_lo(unsigned w) { return __builtin_bit_cast(float, w << 16); }
__device__ __forceinline__ float bf_hi(unsigned w) { return __builtin_bit_cast(float, w & 0xffff0000u); }
__device__ __forceinline__ float bf2f(bf16 v) { return __builtin_bit_cast(float, (unsigned)v << 16); }
__device__ __forceinline__ float wave_sum(float v) {
#pragma unroll
    for (int o = 1; o < 64; o <<= 1) v += __shfl_xor(v, o);
    return v;
}
__device__ __forceinline__ float fast_sigmoid(float x) { return __builtin_amdgcn_rcpf(1.f + __builtin_amdgcn_exp2f(-LOG2E * x)); }
__device__ __forceinline__ float row_rstd(const float* ssq, int row) {
    const f32x4* p = (const f32x4*)(ssq + (size_t)row * 16); const f32x4 a = p[0], b = p[1], c = p[2], d = p[3];
    const float s = ((a.x + a.y) + (a.z + a.w)) + ((b.x + b.y) + (b.z + b.w)) + ((c.x + c.y) + (c.z + c.w)) + ((d.x + d.y) + (d.z + d.w));
    return rsqrtf(s * (1.0f / D) + RMS_EPS);
}

typedef float f32x2 __attribute__((ext_vector_type(2)));
template <class Sched> __device__ __forceinline__ void fill_rstd(LAS unsigned char* lds, const Sched& S, const float* ssq, int tid) {
    LAS float* rt = (LAS float*)(lds + RSTD_OFF); pg8::Unit u;
    for (int i = 0; i < RSTD_MAX_UNITS && S.next(i, u); ++i)
        if ((tid >> 8) == (i & 1)) { const int r = tid & 255; rt[i * 256 + r] = row_rstd(ssq, u.pm * 256 + r); }
    __syncthreads();
}
using pg8::Unit;
__device__ __forceinline__ f32x2 silu_mul_pk(f32x2 g, f32x2 up) {
    const f32x2 t = g * (-LOG2E); f32x2 e; e.x = __builtin_amdgcn_exp2f(t.x); e.y = __builtin_amdgcn_exp2f(t.y);
    const f32x2 d = e + 1.0f; f32x2 r; r.x = __builtin_amdgcn_rcpf(d.x); r.y = __builtin_amdgcn_rcpf(d.y);
    return (g * r) * up;
}
struct EpiSwiGLU {
    static constexpr bool PERM = true;
    const LAS float* rtab; bf16* act; int skip;
    __device__ __forceinline__ void operator()(const f32x4 (&acc)[2][2][4][2], const Unit& u, int ui, int wr, int wc, int fr, int fq) const {
        if (skip == 1) return;
#pragma unroll
        for (int ai = 0; ai < 2; ++ai)
#pragma unroll
            for (int m = 0; m < 4; ++m) {
                const int rl = ai * 128 + wr * 64 + m * 16 + fr, row = u.pm * 256 + rl;
                const float rs = rtab[ui * 256 + rl];
                f32x2 v[4];
#pragma unroll
                for (int n = 0; n < 2; ++n)
#pragma unroll
                    for (int e = 0; e < 2; ++e) { const f32x2 g = (f32x2){acc[ai][0][m][n][2 * e], acc[ai][0][m][n][2 * e + 1]} * rs, up = (f32x2){acc[ai][1][m][n][2 * e], acc[ai][1][m][n][2 * e + 1]} * rs;
                        v[n * 2 + e] = silu_mul_pk(g, up); }
                v4u w; w.x = pg8::cvt_pk_bf16(v[0].x, v[0].y); w.y = pg8::cvt_pk_bf16(v[1].x, v[1].y); w.z = pg8::cvt_pk_bf16(v[2].x, v[2].y); w.w = pg8::cvt_pk_bf16(v[3].x, v[3].y);
                if (skip != 2 || w.x == 0x7fc17fc1u) *(v4u*)(act + (size_t)row * FF + u.pn * 128 + wc * 32 + 8 * fq) = w;
            }
    }
};
#ifndef RESID_BF16
#define RESID_BF16 1
#endif
struct EpiRes {
    static constexpr bool PERM = true;
    const float* xin; float* xout; bf16* xb; float* ssq; float scale; bool skip;
    __device__ __forceinline__ void operator()(const f32x4 (&acc)[2][2][4][2], const Unit& u, int ui, int wr, int wc, int fr, int fq) const {
        if (skip) return;
        if (xin) run<true>(acc, u, wr, wc, fr, fq); else run<false>(acc, u, wr, wc, fr, fq);
    }
    template <bool F32IN> __device__ __forceinline__ void run(const f32x4 (&acc)[2][2][4][2], const Unit& u, int wr, int wc, int fr, int fq) const {
#pragma unroll
        for (int ai = 0; ai < 2; ++ai) {
            f32x4 xv[4][2][2];
#pragma unroll
            for (int m = 0; m < 4; ++m)
#pragma unroll
                for (int bj = 0; bj < 2; ++bj) { const size_t off = (size_t)(u.pm * 256 + ai * 128 + wr * 64 + m * 16 + fr) * D + u.pn * 256 + bj * 128 + wc * 32 + 8 * fq;
                    if (F32IN) { xv[m][bj][0] = *(const f32x4*)(xin + off); xv[m][bj][1] = *(const f32x4*)(xin + off + 4); }
                    else { const v4u w = *(const v4u*)(xb + off); xv[m][bj][0] = (f32x4){bf_lo(w.x), bf_hi(w.x), bf_lo(w.y), bf_hi(w.y)}; xv[m][bj][1] = (f32x4){bf_lo(w.z), bf_hi(w.z), bf_lo(w.w), bf_hi(w.w)}; } }
#pragma unroll
            for (int m = 0; m < 4; ++m) {
                const int row = u.pm * 256 + ai * 128 + wr * 64 + m * 16 + fr;
                float ss = 0.f;
#pragma unroll
                for (int bj = 0; bj < 2; ++bj) {
                    const size_t off = (size_t)row * D + u.pn * 256 + bj * 128 + wc * 32 + 8 * fq;
                    const f32x4 y0 = xv[m][bj][0] + acc[ai][bj][m][0] * scale, y1 = xv[m][bj][1] + acc[ai][bj][m][1] * scale;
                    if (xout) { *(f32x4*)(xout + off) = y0; *(f32x4*)(xout + off + 4) = y1; }
                    v4u w; w.x = pg8::cvt_pk_bf16(y0[0], y0[1]); w.y = pg8::cvt_pk_bf16(y0[2], y0[3]); w.z = pg8::cvt_pk_bf16(y1[0], y1[1]); w.w = pg8::cvt_pk_bf16(y1[2], y1[3]);
                    *(v4u*)(xb + off) = w;
                    ss += (y0[0] * y0[0] + y0[1] * y0[1]) + (y0[2] * y0[2] + y0[3] * y0[3]) + (y1[0] * y1[0] + y1[1] * y1[1]) + (y1[2] * y1[2] + y1[3] * y1[3]);
                }
                ss += __shfl_xor(ss, 16); ss += __shfl_xor(ss, 32);
                if (fq == 0) ssq[(size_t)row * 16 + u.pn * 4 + wc] = ss;
            }
            asm volatile("" ::: "memory");
        }
    }
};
struct EpiRnnIn {
    static constexpr bool PERM = true;
    const LAS float* rtab; bf16* Gb; bf16* Ub;
    template <bool GATE> __device__ __forceinline__ void run(const f32x4 (&acc)[2][2][4][2], const Unit& u, int ui, int wr, int wc, int fr, int fq, bf16* dstb, int pc) const {
#pragma unroll
        for (int ai = 0; ai < 2; ++ai)
#pragma unroll
            for (int m = 0; m < 4; ++m) {
                const int rl = ai * 128 + wr * 64 + m * 16 + fr, row = u.pm * 256 + rl;
                const float rs = rtab[ui * 256 + rl];
#pragma unroll
                for (int bj = 0; bj < 2; ++bj) {
                    f32x2 v[4];
#pragma unroll
                    for (int n = 0; n < 2; ++n)
#pragma unroll
                        for (int e = 0; e < 2; ++e) { f32x2 x = (f32x2){acc[ai][bj][m][n][2 * e], acc[ai][bj][m][n][2 * e + 1]} * rs;
                            if (GATE) {
                                const f32x2 t = (x * x * 0.044715f + 1.0f) * x * (-1.5957691216057308f * LOG2E); f32x2 ex; ex.x = __builtin_amdgcn_exp2f(t.x); ex.y = __builtin_amdgcn_exp2f(t.y);
                                const f32x2 d = ex + 1.0f; f32x2 r; r.x = __builtin_amdgcn_rcpf(d.x); r.y = __builtin_amdgcn_rcpf(d.y); x = x * r; }
                            v[n * 2 + e] = x; }
                    v4u w; w.x = pg8::cvt_pk_bf16(v[0].x, v[0].y); w.y = pg8::cvt_pk_bf16(v[1].x, v[1].y); w.z = pg8::cvt_pk_bf16(v[2].x, v[2].y); w.w = pg8::cvt_pk_bf16(v[3].x, v[3].y);
                    *(v4u*)(dstb + (size_t)row * DRNN + pc * 256 + bj * 128 + wc * 32 + 8 * fq) = w;
                }
            }
    }
    __device__ __forceinline__ void operator()(const f32x4 (&acc)[2][2][4][2], const Unit& u, int ui, int wr, int wc, int fr, int fq) const {
        if (u.pn < 5) run<true>(acc, u, ui, wr, wc, fr, fq, Gb, u.pn); else run<false>(acc, u, ui, wr, wc, fr, fq, Ub, u.pn - 5);
    }
};
struct EpiQKV {
    static constexpr bool PERM = true;
    const LAS float* rtab; const LAS float* gtab; bf16* qkv; bool skip;
    __device__ __forceinline__ void operator()(const f32x4 (&acc)[2][2][4][2], const Unit& u, int ui, int wr, int wc, int fr, int fq) const {
        if (skip) return;
        const int hs = u.pn * 4 + wc, kind = hs / 48, gh = hs - kind * 48, g = gh >> 4, h = gh & 15, l2d = 2 * g;
        bf16* slab = qkv + (size_t)(kind * 3 + g) * ((size_t)M * 1024);
        f32x4 gv[2][2];
#pragma unroll
        for (int bj = 0; bj < 2; ++bj)
#pragma unroll
            for (int n = 0; n < 2; ++n) { gv[bj][n] = (f32x4){1.f, 1.f, 1.f, 1.f}; if (kind < 2) gv[bj][n] = *(const LAS f32x4*)(gtab + kind * 64 + 32 * bj + 8 * fq + 4 * n); }
#pragma unroll
        for (int ai = 0; ai < 2; ++ai)
#pragma unroll
            for (int m = 0; m < 4; ++m) {
                const int rl = ai * 128 + wr * 64 + m * 16 + fr, row = u.pm * 256 + rl;
                const float rs = rtab[ui * 256 + rl];
                f32x4 v[2][2]; float ss = 0.f;
#pragma unroll
                for (int bj = 0; bj < 2; ++bj)
#pragma unroll
                    for (int n = 0; n < 2; ++n) { v[bj][n] = acc[ai][bj][m][n] * rs; const f32x4 t = v[bj][n] * v[bj][n]; ss += (t[0] + t[1]) + (t[2] + t[3]); }
                float rn = 1.f;
                if (kind < 2) { ss += __shfl_xor(ss, 16); ss += __shfl_xor(ss, 32); rn = rsqrtf(ss * (1.0f / HD) + RMS_EPS); }
                const int b = row >> 11, t = row & 2047, rres = t & ((1 << l2d) - 1), l = t >> l2d, L = 2048 >> l2d;
                bf16* dst = slab + ((size_t)(b * 16 + h) * 2048 + rres * L + l) * 64 + 8 * fq;
#pragma unroll
                for (int bj = 0; bj < 2; ++bj) {
                    const f32x4 a0 = v[bj][0] * gv[bj][0] * rn, a1 = v[bj][1] * gv[bj][1] * rn;
                    v4u w; w.x = pg8::cvt_pk_bf16(a0[0], a0[1]); w.y = pg8::cvt_pk_bf16(a0[2], a0[3]); w.z = pg8::cvt_pk_bf16(a1[0], a1[1]); w.w = pg8::cvt_pk_bf16(a1[2], a1[3]);
                    *(v4u*)(dst + 32 * bj) = w;
                }
            }
    }
};

struct Args { const float* in[18]; float* out; unsigned char* ws; int ph_lo, ph_hi; };
enum { I_X = 0, I_NORMG, I_FFN_WIN, I_FFN_WOUT, I_RNN_WIN, I_CONV_W, I_CONV_B, I_WA, I_BA, I_WX, I_BX, I_LAM, I_RNN_WOUT, I_WQKV, I_QGAIN, I_KGAIN, I_WO, I_RELB };

struct Ctx { LAS unsigned char* lds; int tid, lane, wave, G, vcu; unsigned char* ws; };

typedef short v4i16_t __attribute__((ext_vector_type(4)));
__device__ __forceinline__ v4i16_t vtr16(const LAS unsigned char* p) { return __builtin_amdgcn_ds_read_tr16_b64_v4i16((LAS v4i16_t*)p); }
enum { CM_NONE = 0, CM_FFN = 1, CM_QKV = 2 };
__device__ __forceinline__ int colmap(int mode, int vr) {
    if (mode == CM_FFN) { const int pn = vr >> 8, w = vr & 255; return (w >> 7) * FF + 128 * pn + (w & 127); }
    if (mode == CM_QKV) { const int pn = vr >> 8, w = vr & 255, bj = w >> 7, wc = (w >> 5) & 3, j = w & 31; return 256 * pn + 64 * wc + 32 * bj + j; }
    return vr;
}
__device__ __forceinline__ void transpose_item(const float* W, int K, int N, const float* gvec, bf16* WT, int mode, LAS unsigned char* scr, int item, int lane) {
    const int nblk = N / 64, kb = item / nblk, nb = item - kb * nblk, k0 = 64 * kb, vr0 = 64 * nb;
    const int col4 = lane & 15, rsub = lane >> 4, nsrc = colmap(mode, vr0 + 32 * (col4 >> 3)) + (col4 & 7) * 4;
    const float* src = W + (size_t)(k0 + rsub) * N + nsrc;
    f32x4 w[16];
#pragma unroll
    for (int i = 0; i < 16; ++i) w[i] = __builtin_nontemporal_load((const GAS f32x4*)(src + (size_t)(4 * i) * N));
    if (gvec) {
#pragma unroll
        for (int i = 0; i < 16; ++i) w[i] = w[i] * gvec[k0 + 4 * i + rsub];
    }
#pragma unroll
    for (int i = 0; i < 16; ++i) { v2u p; p.x = pg8::cvt_pk_bf16(w[i][0], w[i][1]); p.y = pg8::cvt_pk_bf16(w[i][2], w[i][3]);
        *(LAS v2u*)(scr + (col4 >> 3) * 4096 + (4 * i + rsub) * 64 + (col4 & 7) * 8) = p; }
    const int q = (lane & 15) >> 2, p4 = lane & 3, gidx = lane >> 4;
#pragma unroll
    for (int r = 0; r < 8; ++r) { const int nb16 = r >> 1, kh = r & 1, kbase = 32 * kh + 8 * gidx;
        const LAS unsigned char* a = scr + (nb16 >> 1) * 4096 + (kbase + q) * 64 + ((nb16 & 1) * 16 + 4 * p4) * 2;
        const v4i16_t lo = vtr16(a), hi = vtr16(a + 4 * 64);
        v4u o; { const v2u l2 = __builtin_bit_cast(v2u, lo), h2 = __builtin_bit_cast(v2u, hi); o.x = l2.x; o.y = l2.y; o.z = h2.x; o.w = h2.y; }
        *(GAS v4u*)(WT + (size_t)(vr0 + nb16 * 16 + (lane & 15)) * K + k0 + kbase) = o; }
}
struct MatJob { const float* W; int K, N; const float* g; bf16* WT; int mode; };
__device__ __forceinline__ MatJob mat_job(const Ctx& C, const Args& a, int idx) {
    unsigned char* ws = C.ws; const float* ng = a.in[I_NORMG]; MatJob j;
    switch (idx) {
    case 0: j = MatJob{a.in[I_FFN_WIN] + (size_t)0 * D * 2 * FF, D, 2 * FF, ng + 0 * D, (bf16*)(ws + WS_WIN0), CM_FFN}; break;
    case 1: j = MatJob{a.in[I_FFN_WOUT] + (size_t)0 * FF * D, FF, D, nullptr, (bf16*)(ws + WS_WOUT0), CM_NONE}; break;
    case 2: j = MatJob{a.in[I_RNN_WIN], D, 2 * DRNN, ng + 1 * D, (bf16*)(ws + WS_WRIN), CM_NONE}; break;
    case 3: j = MatJob{a.in[I_RNN_WOUT], DRNN, D, nullptr, (bf16*)(ws + WS_WROUT), CM_NONE}; break;
    case 4: j = MatJob{a.in[I_FFN_WIN] + (size_t)1 * D * 2 * FF, D, 2 * FF, ng + 2 * D, (bf16*)(ws + WS_WIN1), CM_FFN}; break;
    case 5: j = MatJob{a.in[I_FFN_WOUT] + (size_t)1 * FF * D, FF, D, nullptr, (bf16*)(ws + WS_WOUT1), CM_NONE}; break;
    case 6: j = MatJob{a.in[I_WO], D, D, nullptr, (bf16*)(ws + WS_WO), CM_NONE}; break;
    case 7: j = MatJob{a.in[I_WQKV], D, NQKV, ng + 4 * D, (bf16*)(ws + WS_WQKV), CM_QKV}; break;
    case 8: j = MatJob{a.in[I_FFN_WIN] + (size_t)2 * D * 2 * FF, D, 2 * FF, ng + 3 * D, (bf16*)(ws + WS_WIN2), CM_FFN}; break;
    case 9: j = MatJob{a.in[I_FFN_WOUT] + (size_t)2 * FF * D, FF, D, nullptr, (bf16*)(ws + WS_WOUT2), CM_NONE}; break;
    case 10: j = MatJob{a.in[I_FFN_WIN] + (size_t)3 * D * 2 * FF, D, 2 * FF, ng + 5 * D, (bf16*)a.out, CM_FFN}; break;
    default: j = MatJob{a.in[I_FFN_WOUT] + (size_t)3 * FF * D, FF, D, nullptr, (bf16*)(ws + WS_WOUT3), CM_NONE}; break;
    }
    return j;
}
__device__ __forceinline__ void convert_mats(const Ctx& C, const Args& a, int first, int last, int gw, int NGW) {
    LAS unsigned char* scr = C.lds + C.wave * 8192;
    int base = 0;
    for (int mi = first; mi < last; ++mi) {
        const MatJob j = mat_job(C, a, mi); const int cnt = (j.K / 64) * (j.N / 64);
        int it = (gw - base) % NGW; if (it < 0) it += NGW;
        for (; it < cnt; it += NGW) transpose_item(j.W, j.K, j.N, j.g, j.WT, j.mode, scr, it, C.lane);
        base += cnt;
    }
}
__device__ __forceinline__ void spare_convert(const Ctx& C, const Args& a, int first, int last, int nwg) {
    const int R = (nwg + C.G - 1) / C.G, first_spare = nwg - (R - 1) * C.G, nspare = C.G - first_spare, c = (int)blockIdx.x;
    if (nspare > 0) { if (c >= first_spare) convert_mats(C, a, first, last, (c - first_spare) * NWAVES + C.wave, nspare * NWAVES); }
    else convert_mats(C, a, first, last, c * NWAVES + C.wave, C.G * NWAVES);
    __syncthreads();
}
__device__ __forceinline__ int t5_bucket(int n) {
    if (n < 16) return n;
    int b = 16;
    b += (n >= 22) + (n >= 30) + (n >= 40) + (n >= 54) + (n >= 73) + (n >= 99) + (n >= 134) + (n >= 182) + (n >= 246) + (n >= 332) + (n >= 450) + (n >= 609) + (n >= 825) + (n >= 1117) + (n >= 1513);
    return b;
}
__device__ __forceinline__ void p_prologue(const Ctx& C, const Args& a) {
    const int gw = C.vcu * NWAVES + C.wave, NGW = C.G * NWAVES;
    convert_mats(C, a, 0, 1, gw, NGW);
    {   LAS unsigned char* scr = C.lds + C.wave * 8192;
        for (int it = gw; it < 2 * NBLK * 4; it += NGW) { const int which = it / (NBLK * 4), r = it % (NBLK * 4), blk = r >> 2, sub = r & 3;
            const float* W = (which ? a.in[I_WX] : a.in[I_WA]) + (size_t)blk * RBLK * RBLK; bf16* WT = (bf16*)(C.ws + (which ? WS_WX : WS_WA)) + (size_t)blk * RBLK * RBLK;
            transpose_item(W, RBLK, RBLK, nullptr, WT, CM_NONE, scr, sub, C.lane); } }
    const float* x = a.in[I_X]; bf16* xb = (bf16*)(C.ws + WS_XB); float* ssq = (float*)(C.ws + WS_SSQ);
    for (int m = gw; m < M; m += NGW) {
        const GAS f32x4* xr = (const GAS f32x4*)(x + (size_t)m * D) + C.lane; f32x4 v[4]; float s = 0.f;
#pragma unroll
        for (int j = 0; j < 4; ++j) { v[j] = __builtin_nontemporal_load(xr + 64 * j); s += (v[j].x * v[j].x + v[j].y * v[j].y) + (v[j].z * v[j].z + v[j].w * v[j].w); }
        s = wave_sum(s);
        GAS v2u* o8 = (GAS v2u*)(xb + (size_t)m * D) + C.lane;
#pragma unroll
        for (int j = 0; j < 4; ++j) { v2u w; w.x = pk2(v[j].x, v[j].y); w.y = pk2(v[j].z, v[j].w); o8[64 * j] = w; }
        if (C.lane < 16) ssq[(size_t)m * 16 + C.lane] = (C.lane == 0) ? s : 0.f;
    }
    float* bt = (float*)(C.ws + WS_BIAS); const float* rb = a.in[I_RELB];
    for (int i = blockIdx.x * 512 + C.tid; i < 48 * 129; i += C.G * 512) { const int gh = i / 129, dist = i - gh * 129, g = gh >> 4;
        bt[gh * 132 + dist] = rb[t5_bucket(dist << (2 * g)) * 48 + gh] * LOG2E; }
}

typedef float f32x16 __attribute__((ext_vector_type(16)));
typedef short bf16x8v __attribute__((ext_vector_type(8)));
constexpr int RM_WB = 0, RM_WB_GATE = 64 * 272, RM_CW = 36864, RM_CMP = RM_CW + 2560, RM_TILE = 49152, RM_TILE_BYTES = 36 * 256, RM_END = RM_TILE + 8 * RM_TILE_BYTES;
static_assert(RM_WB + 2 * RM_WB_GATE <= RM_CW && RM_CMP + 2 * 2 * 8 * 64 * 4 <= RM_TILE && RM_END <= RING_BYTES, "rnn-mid LDS map");
__device__ __forceinline__ bf16x8v pack8(const float (&v)[8]) {
    v4u w; w.x = pg8::cvt_pk_bf16(v[0], v[1]); w.y = pg8::cvt_pk_bf16(v[2], v[3]); w.z = pg8::cvt_pk_bf16(v[4], v[5]); w.w = pg8::cvt_pk_bf16(v[6], v[7]);
    return __builtin_bit_cast(bf16x8v, w);
}
__device__ __forceinline__ void p_rnn_mid(const Ctx& C, const Args& a) {
    const bf16* U = (const bf16*)(C.ws + WS_U); const bf16* Gb = (const bf16*)(C.ws + WS_G); bf16* Y = (bf16*)(C.ws + WS_Y);
    const bf16* WAb = (const bf16*)(C.ws + WS_WA); const bf16* WXb = (const bf16*)(C.ws + WS_WX);
    LAS unsigned char* L = C.lds;
    LAS float* CW = (LAS float*)(L + RM_CW); LAS float* CMP = (LAS float*)(L + RM_CMP);
    const int wave = C.wave;
    LAS unsigned char* wt = L + RM_TILE + wave * RM_TILE_BYTES;
    for (int item = blockIdx.x; item < BATCH * NBLK * 2; item += C.G) {
        const int b = item / (NBLK * 2), n = (item % (NBLK * 2)) >> 1, half = item & 1;
        int tid = C.tid; asm volatile("" : "+v"(tid));
        const int lane = tid & 63, r32 = lane & 31, hh = lane >> 5;
        __syncthreads();
#pragma unroll
        for (int p = 0; p < 4; ++p) { const int idx = p * 512 + tid, gate = idx >> 10, rem = idx & 1023, row = rem >> 4, c16 = rem & 15;
            const v4u w = *(const v4u*)((gate ? WXb : WAb) + (size_t)(n * 128 + 64 * half + row) * 128 + c16 * 8);
            *(LAS v4u*)(L + RM_WB + gate * RM_WB_GATE + row * 272 + c16 * 16) = w; }
        CW[tid] = a.in[I_CONV_W][(tid >> 7) * DRNN + n * 128 + (tid & 127)];
        if (tid < 128) CW[512 + tid] = a.in[I_CONV_B][n * 128 + tid];
        __syncthreads();
        float ba[2], bx[2], spl[2], Ht[2];
#pragma unroll
        for (int cb = 0; cb < 2; ++cb) { const int ch = n * 128 + 64 * half + 32 * cb + r32; ba[cb] = a.in[I_BA][ch]; bx[cb] = a.in[I_BX][ch];
            spl[cb] = -8.0f * LOG2E * log1pf(expf(-a.in[I_LAM][ch])); Ht[cb] = 0.f; }
        bf16x8v idf[2];
#pragma unroll
        for (int sp = 0; sp < 2; ++sp)
#pragma unroll
            for (int j = 0; j < 8; ++j) idf[sp][j] = (16 * sp + 8 * hh + j == r32) ? (short)0x3F80 : (short)0;
        const int urow = lane >> 4, uch = lane & 15, grow = lane >> 3, gch = lane & 7;
        v4u uraw[9], graw[4];
#define RM_LOADU(TILE) do { const int tp_ = (TILE) * 256 + wave * 32; const int ub_ = (b * SEQ + tp_ - 3 + urow) * DRNN + n * 128 + uch * 8;        \
        _Pragma("unroll") for (int i_ = 0; i_ < 9; ++i_) uraw[i_] = *(const v4u*)(U + (ptrdiff_t)(ub_ + i_ * 4 * DRNN)); \
        if (tp_ == 0 && urow < 3) uraw[0] = (v4u){0u, 0u, 0u, 0u};         } while (0)
#define RM_LOADG(TILE) do { const int gb_ = (b * SEQ + (TILE) * 256 + wave * 32 + grow) * DRNN + n * 128 + 64 * half + gch * 8; \
        _Pragma("unroll") for (int i_ = 0; i_ < 4; ++i_) graw[i_] = *(const v4u*)(Gb + (unsigned)(gb_ + i_ * 8 * DRNN)); } while (0)
        RM_LOADU(0);
        for (int tile = 0; tile < 8; ++tile) {
            const int tposw = tile * 256 + wave * 32;
            const size_t tok0 = (size_t)b * SEQ + tposw;
            LAS float* CWt = CW; LAS unsigned char* WBt = L + RM_WB; asm volatile("" : "+v"(CWt), "+v"(WBt));
            RM_LOADG(tile);
#pragma unroll
            for (int i = 0; i < 9; ++i) { const int rl = 4 * i + urow; *(LAS v4u*)(wt + rl * 256 + ((uch ^ (rl & 15)) << 4)) = uraw[i]; }
            {
                const int tg = lane >> 4, cc = lane & 15;
                f32x2 wv[4][4], bv2[4];
#pragma unroll
                for (int k = 0; k < 4; ++k) { const f32x4 w0 = *(const LAS f32x4*)(CWt + k * 128 + 8 * cc), w1 = *(const LAS f32x4*)(CWt + k * 128 + 8 * cc + 4);
                    wv[k][0] = (f32x2){w0[0], w0[1]}; wv[k][1] = (f32x2){w0[2], w0[3]}; wv[k][2] = (f32x2){w1[0], w1[1]}; wv[k][3] = (f32x2){w1[2], w1[3]}; }
                { const f32x4 b0 = *(const LAS f32x4*)(CWt + 512 + 8 * cc), b1 = *(const LAS f32x4*)(CWt + 512 + 8 * cc + 4);
                  bv2[0] = (f32x2){b0[0], b0[1]}; bv2[1] = (f32x2){b0[2], b0[3]}; bv2[2] = (f32x2){b1[0], b1[1]}; bv2[3] = (f32x2){b1[2], b1[3]}; }
                v4u ur[11];
#pragma unroll
                for (int j = 0; j < 11; ++j) { const int rl = 8 * tg + j; ur[j] = *(const LAS v4u*)(wt + rl * 256 + ((cc ^ (rl & 15)) << 4)); }
                f32x2 o[8][4];
#pragma unroll
                for (int i = 0; i < 8; ++i)
#pragma unroll
                    for (int e = 0; e < 4; ++e) o[i][e] = bv2[e];
#pragma unroll
                for (int j = 0; j < 11; ++j) {
                    const f32x2 u0 = (f32x2){bf_lo(ur[j].x), bf_hi(ur[j].x)}, u1 = (f32x2){bf_lo(ur[j].y), bf_hi(ur[j].y)}, u2 = (f32x2){bf_lo(ur[j].z), bf_hi(ur[j].z)}, u3 = (f32x2){bf_lo(ur[j].w), bf_hi(ur[j].w)};
#pragma unroll
                    for (int k = 0; k < 4; ++k) { const int i = j - k; if (i >= 0 && i < 8) {
                        o[i][0] += wv[k][0] * u0; o[i][1] += wv[k][1] * u1; o[i][2] += wv[k][2] * u2; o[i][3] += wv[k][3] * u3; } }
                }
#pragma unroll
                for (int i = 0; i < 8; ++i) { const int rl = 8 * tg + i;
                    v4u w; w.x = pg8::cvt_pk_bf16(o[i][0].x, o[i][0].y); w.y = pg8::cvt_pk_bf16(o[i][1].x, o[i][1].y); w.z = pg8::cvt_pk_bf16(o[i][2].x, o[i][2].y); w.w = pg8::cvt_pk_bf16(o[i][3].x, o[i][3].y);
                    *(LAS v4u*)(wt + rl * 256 + ((cc ^ (rl & 15)) << 4)) = w; }
            }
            bf16x8v af[8];
#pragma unroll
            for (int s = 0; s < 8; ++s) af[s] = *(const LAS bf16x8v*)(wt + r32 * 256 + (((2 * s + hh) ^ (r32 & 15)) << 4));
#pragma unroll
            for (int i = 0; i < 4; ++i) *(LAS v4u*)(wt + (8 * i + grow) * 128 + gch * 16) = graw[i];
            f32x16 acc[2][2], ufa[2];
#pragma unroll
            for (int cb = 0; cb < 2; ++cb)
#pragma unroll
                for (int e = 0; e < 16; ++e) { acc[0][cb][e] = 0.f; acc[1][cb][e] = 0.f; ufa[cb][e] = 0.f; }
            bf16x8v bq[2][4];
#define RM_LDB(S, DST) do { _Pragma("unroll") for (int g_ = 0; g_ < 2; ++g_) _Pragma("unroll") for (int c_ = 0; c_ < 2; ++c_) \
                DST[g_ * 2 + c_] = *(const LAS bf16x8v*)(WBt + g_ * RM_WB_GATE + (32 * c_ + r32) * 272 + (16 * (S) + 8 * hh) * 2); } while (0)
            RM_LDB(0, bq[0]);
#pragma unroll
            for (int s = 0; s < 8; ++s) {
                if (s < 7) RM_LDB(s + 1, bq[(s + 1) & 1]);
#pragma unroll
                for (int gt = 0; gt < 2; ++gt)
#pragma unroll
                    for (int cb = 0; cb < 2; ++cb) acc[gt][cb] = __builtin_amdgcn_mfma_f32_32x32x16_bf16(af[s], bq[s & 1][gt * 2 + cb], acc[gt][cb], 0, 0, 0);
            }
#undef RM_LDB
#pragma unroll
            for (int cb = 0; cb < 2; ++cb)
#pragma unroll
                for (int sp = 0; sp < 2; ++sp) { const bf16x8v asel = half ? af[4 + 2 * cb + sp] : af[2 * cb + sp];
                    ufa[cb] = __builtin_amdgcn_mfma_f32_32x32x16_bf16(asel, idf[sp], ufa[cb], 0, 0, 0); }
#pragma unroll
            for (int cb = 0; cb < 2; ++cb)
#pragma unroll
                for (int e = 0; e < 16; ++e) {
                    const float uf = ufa[cb][e];
                    const float r = fast_sigmoid(acc[0][cb][e] + ba[cb]), ii = fast_sigmoid(acc[1][cb][e] + bx[cb]);
                    const float av = __builtin_amdgcn_exp2f(r * spl[cb]);
                    const float bv = __builtin_amdgcn_sqrtf(fmaxf(1.f - av * av, 0.f)) * (ii * uf);
                    acc[0][cb][e] = av; acc[1][cb][e] = bv;
                }
            float A0[2][4], B0[2][4], A1[2][4], B1[2][4];
            const int par = tile & 1;
#pragma unroll
            for (int cb = 0; cb < 2; ++cb) {
                float Aw = 1.f, Bw = 0.f;
#pragma unroll
                for (int q = 0; q < 4; ++q) {
                    const float a0 = acc[0][cb][4 * q], a1 = acc[0][cb][4 * q + 1], a2 = acc[0][cb][4 * q + 2], a3 = acc[0][cb][4 * q + 3];
                    const float Ag = (a0 * a1) * (a2 * a3);
                    const float Bg = ((acc[1][cb][4 * q] * a1 + acc[1][cb][4 * q + 1]) * a2 + acc[1][cb][4 * q + 2]) * a3 + acc[1][cb][4 * q + 3];
                    const float pA = __shfl_xor(Ag, 32), pB = __shfl_xor(Bg, 32);
                    A0[cb][q] = hh ? pA : Ag; B0[cb][q] = hh ? pB : Bg; A1[cb][q] = hh ? Ag : pA; B1[cb][q] = hh ? Bg : pB;
                    Bw = Bw * A0[cb][q] + B0[cb][q]; Aw *= A0[cb][q]; Bw = Bw * A1[cb][q] + B1[cb][q]; Aw *= A1[cb][q];
                }
                if (hh == 0) { CMP[((par * 2 + 0) * 8 + wave) * 64 + 32 * cb + r32] = Aw; CMP[((par * 2 + 1) * 8 + wave) * 64 + 32 * cb + r32] = Bw; }
            }
            __syncthreads();
            if (tile < 7) RM_LOADU(tile + 1);
#pragma unroll
            for (int cb = 0; cb < 2; ++cb) {
                float h = Ht[cb], hin = 0.f;
#pragma unroll
                for (int v = 0; v < 8; ++v) { const float Av = CMP[((par * 2 + 0) * 8 + v) * 64 + 32 * cb + r32], Bv = CMP[((par * 2 + 1) * 8 + v) * 64 + 32 * cb + r32];
                    hin = (v == wave) ? h : hin; h = Av * h + Bv; }
                Ht[cb] = h;
                float hc = hin;
#pragma unroll
                for (int q = 0; q < 4; ++q) {
                    const float c0 = hc; hc = A0[cb][q] * hc + B0[cb][q]; const float c1 = hc; hc = A1[cb][q] * hc + B1[cb][q];
                    float hv = hh ? c1 : c0;
#pragma unroll
                    for (int i = 0; i < 4; ++i) { const int e = 4 * q + i; hv = acc[0][cb][e] * hv + acc[1][cb][e];
                        const int tl = (e & 3) + 8 * (e >> 2) + 4 * hh;
                        LAS bf16* gp = (LAS bf16*)(wt + tl * 128 + (32 * cb + r32) * 2);
                        *gp = (bf16)f2bf(hv * bf2f(*gp)); }
                }
            }
#pragma unroll
            for (int i = 0; i < 4; ++i) { const v4u w = *(const LAS v4u*)(wt + (8 * i + grow) * 128 + gch * 16);
                *(v4u*)(Y + (unsigned)(((int)tok0 + 8 * i + grow) * DRNN + n * 128 + 64 * half + gch * 8)) = w; }
        }
#undef RM_LOADU
#undef RM_LOADG
    }
    const int nitems = BATCH * NBLK * 2;
    if (C.G > nitems) { if ((int)blockIdx.x >= nitems) convert_mats(C, a, 4, 7, ((int)blockIdx.x - nitems) * NWAVES + wave, (C.G - nitems) * NWAVES); }
    else { __syncthreads(); convert_mats(C, a, 4, 7, (int)blockIdx.x * NWAVES + wave, C.G * NWAVES); }
}
constexpr int AT_EXT = 0, AT_VT = 48 * 192 * 4;
struct AttnUnit { bf16* qbase; const bf16* kres; const bf16* vres; int l0, kb_lo, eoff, g, bh, llin0; };
__device__ __forceinline__ AttnUnit attn_unit(bf16* QKV, int it, int wave) {
    AttnUnit u; const size_t SLAB = (size_t)M * 1024;
    const int g = it >> 9, rem = it & 511, bh = rem >> 2, c4 = (rem + (it >> 8)) & 3, l2d = 2 * g, L = SEQ >> l2d;
    u.g = g; u.bh = bh; u.llin0 = c4 * 512 + wave * 64; u.l0 = u.llin0 & (L - 1); u.kb_lo = (u.l0 - 128) > 0 ? (u.l0 - 128) : 0; u.eoff = (g * 16 + (bh & 15)) * 192;
    u.qbase = QKV + (size_t)g * SLAB + ((size_t)bh * SEQ + u.llin0) * HD;
    u.kres = u.qbase + 3 * SLAB - (size_t)u.l0 * HD; u.vres = u.qbase + 6 * SLAB - (size_t)u.l0 * HD;
    return u;
}
typedef __bf16 bf16x2n __attribute__((ext_vector_type(2)));
__device__ __forceinline__ unsigned cvtpk_n(float lo, float hi) { const f32x2 v = {lo, hi}; return __builtin_bit_cast(unsigned, __builtin_convertvector(v, bf16x2n)); }
#define AT_QBLOCK(QF, O0, O1, MROW, LSUM, EB) do { \
        f32x16 p_; _Pragma("unroll") for (int e = 0; e < 16; ++e) p_[e] = 0.f; \
        _Pragma("unroll") for (int s_ = 0; s_ < 4; ++s_) p_ = __builtin_amdgcn_mfma_f32_32x32x16_bf16(kf[s_], QF[s_], p_, 0, 0, 0); \
        float bm_ = -1e30f; \
        _Pragma("unroll") for (int e = 0; e < 16; ++e) { p_[e] += ext[(EB) - ((e & 3) + 8 * (e >> 2))]; bm_ = fmaxf(bm_, p_[e]); } \
        bm_ = fmaxf(bm_, __shfl_xor(bm_, 32)); \
        const float mn_ = fmaxf(MROW, bm_), alpha_ = __builtin_amdgcn_exp2f(MROW - mn_); MROW = mn_; \
        float ps_ = 0.f; \
        _Pragma("unroll") for (int e = 0; e < 16; ++e) { p_[e] = __builtin_amdgcn_exp2f(p_[e] - mn_); ps_ += p_[e]; } \
        LSUM = LSUM * alpha_ + ps_; \
        _Pragma("unroll") for (int e = 0; e < 16; ++e) { O0[e] *= alpha_; O1[e] *= alpha_; } \
        _Pragma("unroll") for (int s_ = 0; s_ < 2; ++s_) { \
            v4u w_; w_.x = cvtpk_n(p_[8 * s_], p_[8 * s_ + 1]); w_.y = cvtpk_n(p_[8 * s_ + 2], p_[8 * s_ + 3]); w_.z = cvtpk_n(p_[8 * s_ + 4], p_[8 * s_ + 5]); w_.w = cvtpk_n(p_[8 * s_ + 6], p_[8 * s_ + 7]); \
            const bf16x8v pf_ = __builtin_bit_cast(bf16x8v, w_); \
            const v4i16_t a00_ = vtr16(vt + (16 * s_) * 64 + vtr_off), a01_ = vtr16(vt + (16 * s_ + 8) * 64 + vtr_off), a10_ = vtr16(vt + 2048 + (16 * s_) * 64 + vtr_off), a11_ = vtr16(vt + 2048 + (16 * s_ + 8) * 64 + vtr_off); \
            O0 = __builtin_amdgcn_mfma_f32_32x32x16_bf16((bf16x8v){a00_[0], a00_[1], a00_[2], a00_[3], a01_[0], a01_[1], a01_[2], a01_[3]}, pf_, O0, 0, 0, 0); \
            O1 = __builtin_amdgcn_mfma_f32_32x32x16_bf16((bf16x8v){a10_[0], a10_[1], a10_[2], a10_[3], a11_[0], a11_[1], a11_[2], a11_[3]}, pf_, O1, 0, 0, 0); } \
    } while (0)
#define AT_FINISH(O0, O1, MROW, LSUM, QROW0) do { \
        const float ltot_ = LSUM + __shfl_xor(LSUM, 32), inv_ = 1.f / ltot_; \
        _Pragma("unroll") for (int q = 0; q < 4; ++q) { v2u w0_, w1_; \
            w0_.x = cvtpk_n(O0[4 * q] * inv_, O0[4 * q + 1] * inv_); w0_.y = cvtpk_n(O0[4 * q + 2] * inv_, O0[4 * q + 3] * inv_); \
            w1_.x = cvtpk_n(O1[4 * q] * inv_, O1[4 * q + 1] * inv_); w1_.y = cvtpk_n(O1[4 * q + 2] * inv_, O1[4 * q + 3] * inv_); \
            *(LAS v2u*)(kt + r32 * 128 + ((q ^ (r32 & 7)) << 4) + 8 * hh) = w0_; *(LAS v2u*)(kt + r32 * 128 + (((4 + q) ^ (r32 & 7)) << 4) + 8 * hh) = w1_; } \
        if (!dry) { _Pragma("unroll") for (int i = 0; i < 4; ++i) { const v4u w_ = *(const LAS v4u*)(kt + (8 * i + crow8) * 128 + ((cch ^ crow8) << 4)); *(v4u*)(cu.qbase + ((QROW0) + 8 * i + crow8) * HD + cch * 8) = w_; } } \
        if (hh == 0) { const int l2d_ = 2 * cu.g, L_ = SEQ >> l2d_, llin_ = cu.llin0 + (QROW0) + r32, rres_ = llin_ >> (11 - l2d_), l_ = llin_ & (L_ - 1), t_ = (l_ << l2d_) + rres_, row_ = (cu.bh >> 4) * SEQ + t_; \
            LSE[((size_t)cu.g * M + row_) * 16 + (cu.bh & 15)] = MROW + log2f(ltot_); } \
    } while (0)
__device__ __forceinline__ void p_attn(const Ctx& C, const bool dry) {
    bf16* QKV = (bf16*)(C.ws + WS_QKV); float* LSE = (float*)(C.ws + WS_LSE); const float* bt = (const float*)(C.ws + WS_BIAS);
    LAS float* ext = (LAS float*)(C.lds + AT_EXT);
    LAS unsigned char* vt = C.lds + AT_VT + C.wave * 8192; LAS unsigned char* kt = vt + 4096;
    const int lane = C.lane, r32 = lane & 31, hh = lane >> 5, wave = C.wave, tid = C.tid;
    const int crow8 = lane >> 3, cch = lane & 7;
    const int vtr_off = (4 * hh + ((lane & 15) >> 2)) * 64 + ((lane >> 4) & 1) * 32 + (lane & 3) * 8;
    for (int i = tid; i < 48 * 192; i += 512) { const int gh = i / 192, dist = i - gh * 192 - 32; ext[i] = (dist >= 0 && dist <= 128) ? bt[gh * 132 + dist] : -1e30f; }
    __syncthreads();
    const int total = NGRP * BATCH * NHEAD * 4;
    int it = blockIdx.x;
    if (it >= total) return;
    AttnUnit cu = attn_unit(QKV, it, wave), nu = cu;
    v4u kfn[4], vvn[4];
#define AT_LOADKV(U, KB) do { const bf16* kblk_ = (U).kres + (size_t)(KB) * HD; const bf16* vblk_ = (U).vres + (size_t)(KB) * HD; \
        _Pragma("unroll") for (int i_ = 0; i_ < 4; ++i_) { vvn[i_] = *(const v4u*)(vblk_ + (8 * i_ + crow8) * HD + cch * 8); kfn[i_] = *(const v4u*)(kblk_ + (8 * i_ + crow8) * HD + cch * 8); } } while (0)
#define AT_LOADQ(U) do { _Pragma("unroll") for (int i_ = 0; i_ < 8; ++i_) qfn[i_] = *(const v4u*)((U).qbase + (8 * i_ + crow8) * HD + cch * 8); } while (0)
#define AT_TILE2FRAG(RAW, OFS, FR) do { _Pragma("unroll") for (int i_ = 0; i_ < 4; ++i_) *(LAS v4u*)(kt + (8 * i_ + crow8) * 128 + ((cch ^ crow8) << 4)) = RAW[(OFS) + i_]; \
        _Pragma("unroll") for (int s_ = 0; s_ < 4; ++s_) FR[s_] = *(const LAS bf16x8v*)(kt + r32 * 128 + (((2 * s_ + hh) ^ (r32 & 7)) << 4)); } while (0)
    AT_LOADKV(cu, cu.l0 + 32);
    for (;;) {
        bf16x8v qfA[4], qfB[4];
        { v4u qfn[8]; AT_LOADQ(cu); AT_TILE2FRAG(qfn, 0, qfA); AT_TILE2FRAG(qfn, 4, qfB); }
        f32x16 oA0, oA1, oB0, oB1;
#pragma unroll
        for (int e = 0; e < 16; ++e) { oA0[e] = 0.f; oA1[e] = 0.f; oB0[e] = 0.f; oB1[e] = 0.f; }
        float mA = -1e30f, lA = 0.f, mB = -1e30f, lB = 0.f;
        const bool has_next = (it + C.G) < total;
#define AT_STEP(KB, USEA, USEB) do { const int kb_ = (KB); \
            v4u vv[4], kraw[4]; bf16x8v kf[4]; \
            _Pragma("unroll") for (int i = 0; i < 4; ++i) { vv[i] = vvn[i]; kraw[i] = kfn[i]; } \
              \
            if (kb_ - 32 >= cu.kb_lo) { AT_LOADKV(cu, kb_ - 32); } \
            else if (has_next) { nu = attn_unit(QKV, it + C.G, wave); AT_LOADKV(nu, nu.l0 + 32); } \
            _Pragma("unroll") for (int i = 0; i < 4; ++i) *(LAS v4u*)(vt + (cch >> 2) * 2048 + (8 * i + crow8) * 64 + (cch & 3) * 16) = vv[i]; \
            AT_TILE2FRAG(kraw, 0, kf); \
            const int ebA = cu.eoff + cu.l0 + r32 - kb_ - 4 * hh + 32;            \
            if (USEB) { AT_QBLOCK(qfB, oB0, oB1, mB, lB, ebA + 32); } \
            if (USEA) { AT_QBLOCK(qfA, oA0, oA1, mA, lA, ebA); } \
        } while (0)
        AT_STEP(cu.l0 + 32, false, true);
        { const int kb_both_lo = (cu.l0 - 96) > cu.kb_lo ? (cu.l0 - 96) : cu.kb_lo;
          for (int kb = cu.l0; kb >= kb_both_lo; kb -= 32) AT_STEP(kb, true, true); }
        if (cu.l0 >= 128) AT_STEP(cu.l0 - 128, true, false);
#undef AT_STEP
        AT_FINISH(oA0, oA1, mA, lA, 0);
        AT_FINISH(oB0, oB1, mB, lB, 32);
        if (!has_next) break;
        it += C.G; cu = nu;
    }
#undef AT_LOADKV
#undef AT_LOADQ
#undef AT_TILE2FRAG
}
#undef AT_QBLOCK
#undef AT_FINISH
__device__ __forceinline__ void p_merge(const Ctx& C, const Args& a) {
    const bf16* QKV = (const bf16*)(C.ws + WS_QKV); const float* LSE = (const float*)(C.ws + WS_LSE); bf16* ATT = (bf16*)(C.ws + WS_ATT);
    for (int idx = blockIdx.x * 512 + C.tid; idx < M * 16 * 8; idx += C.G * 512) {
        const int ch = idx & 7, h = (idx >> 3) & 15, row = idx >> 7, b = row >> 11, t = row & 2047;
        float ls[3], mxl = -INFINITY;
#pragma unroll
        for (int g = 0; g < 3; ++g) { ls[g] = LSE[((size_t)g * M + row) * 16 + h]; mxl = fmaxf(mxl, ls[g]); }
        float acc[8], wsum = 0.f;
#pragma unroll
        for (int e = 0; e < 8; ++e) acc[e] = 0.f;
#pragma unroll
        for (int g = 0; g < 3; ++g) { const float w = exp2f(ls[g] - mxl); wsum += w; const int l2d = 2 * g, rres = t & ((1 << l2d) - 1), l = t >> l2d, L = SEQ >> l2d;
            const v4u v = *(const v4u*)(QKV + (size_t)g * ((size_t)M * 1024) + ((size_t)(b * 16 + h) * SEQ + rres * L + l) * HD + 8 * ch);
            acc[0] += w * bf_lo(v.x); acc[1] += w * bf_hi(v.x); acc[2] += w * bf_lo(v.y); acc[3] += w * bf_hi(v.y); acc[4] += w * bf_lo(v.z); acc[5] += w * bf_hi(v.z); acc[6] += w * bf_lo(v.w); acc[7] += w * bf_hi(v.w); }
        const float inv = 1.f / wsum; v4u o; o.x = pk2(acc[0] * inv, acc[1] * inv); o.y = pk2(acc[2] * inv, acc[3] * inv); o.z = pk2(acc[4] * inv, acc[5] * inv); o.w = pk2(acc[6] * inv, acc[7] * inv);
        *(v4u*)(ATT + (size_t)row * 1024 + h * 64 + 8 * ch) = o;
    }
}

enum { PH_PROLOGUE = 0, PH_FFN_IN_0, PH_FFN_OUT_0, PH_RNN_IN, PH_RNN_MID, PH_RNN_OUT, PH_FFN_IN_1, PH_FFN_OUT_1,
       PH_FFN_IN_2, PH_FFN_OUT_2, PH_QKV, PH_ATTN, PH_MERGE, PH_WO, PH_FFN_IN_3, PH_FFN_OUT_3, NPHASE };

__global__ void __launch_bounds__(NWAVES * 64, 2) fwd_kernel(Args args) {
    extern __shared__ __attribute__((aligned(16))) unsigned char lds_raw[];
    Ctx C; C.lds = (LAS unsigned char*)lds_raw; C.tid = threadIdx.x; C.lane = C.tid & 63; C.wave = __builtin_amdgcn_readfirstlane(C.tid >> 6);
    C.G = gridDim.x; { const int bx = blockIdx.x; C.vcu = (C.G % 8 == 0) ? (bx % 8) * (C.G / 8) + bx / 8 : bx; }
    C.ws = args.ws;
    volatile LAS unsigned* MISC = (volatile LAS unsigned*)(C.lds + MISC_OFF);
    for (int u = C.tid; u < (LDS_BYTES - LDSCTL_OFF) / 4; u += NWAVES * 64) ((LAS unsigned*)(C.lds + LDSCTL_OFF))[u] = 0u;
    __syncthreads();
    unsigned* ctl = (unsigned*)args.ws;
    XcdBarrier bar; bar.bar = ctl + CW_BAR; bar.x = 0; bar.st = nullptr;
    const bool multi = (args.ph_hi - args.ph_lo) > 1;
    if (multi) bar = xcd_barrier_post(ctl + CW_BAR, MISC + 8);
    for (int ph = args.ph_lo; ph < args.ph_hi; ++ph) {
        for (int rep = ((DUP_MASK >> ph) & 1u) ? DUP_N : 0; rep >= 0; --rep) {
        const bool dry = rep > 0;
        { int t_ = threadIdx.x; asm volatile("" : "+v"(t_)); C.tid = t_; C.lane = t_ & 63; }
        unsigned char* ws = args.ws;
        C.ws = ws; float* ssq = (float*)(ws + WS_SSQ); bf16* xb = (bf16*)(ws + WS_XB);
        switch (ph) {
        case PH_PROLOGUE: p_prologue(C, args); break;
        case PH_FFN_IN_0: case PH_FFN_IN_1: case PH_FFN_IN_2: case PH_FFN_IN_3: {
            if (!dry && ph != PH_FFN_IN_3) { const int f = (ph == PH_FFN_IN_0) ? 1 : (ph == PH_FFN_IN_1) ? 8 : 10, l = (ph == PH_FFN_IN_0) ? 4 : (ph == PH_FFN_IN_1) ? 10 : 12; spare_convert(C, args, f, l, (M / 256) * (2 * FF / 256)); }
            const bf16* Bt = (ph == PH_FFN_IN_3) ? (const bf16*)args.out : (const bf16*)(ws + (ph == PH_FFN_IN_0 ? WS_WIN0 : ph == PH_FFN_IN_1 ? WS_WIN1 : WS_WIN2));
            bf16* act = (bf16*)(ws + (ph == PH_FFN_IN_3 ? WS_ACT3 : WS_ACT));
            pg8::Gemm g{xb, Bt, M, 2 * FF, D}; pg8::StaticOrder S; S.init(M, 2 * FF, C.G, (int)blockIdx.x);
            fill_rstd(C.lds, S, ssq, C.tid);
            EpiSwiGLU E{(const LAS float*)(C.lds + RSTD_OFF), act, dry ? DUP_SKIP_EPI : 0};
            pg8::gemm_phase<EpiSwiGLU, pg8::StaticOrder, true, true>(C.lds, g, S, E);
        } break;
        case PH_FFN_OUT_0: case PH_FFN_OUT_1: case PH_FFN_OUT_2: case PH_FFN_OUT_3: case PH_RNN_OUT: case PH_WO: {
            const bf16* A; const bf16* Bt; int K; float scale = 0.5f; const float* xin = args.out;
            if (ph == PH_FFN_OUT_0) { A = (const bf16*)(ws + WS_ACT); Bt = (const bf16*)(ws + WS_WOUT0); K = FF; xin = args.in[I_X]; }
            else if (ph == PH_FFN_OUT_1) { A = (const bf16*)(ws + WS_ACT); Bt = (const bf16*)(ws + WS_WOUT1); K = FF; }
            else if (ph == PH_FFN_OUT_2) { A = (const bf16*)(ws + WS_ACT); Bt = (const bf16*)(ws + WS_WOUT2); K = FF; }
            else if (ph == PH_FFN_OUT_3) { A = (const bf16*)(ws + WS_ACT3); Bt = (const bf16*)(ws + WS_WOUT3); K = FF; }
            else if (ph == PH_RNN_OUT) { A = (const bf16*)(ws + WS_Y); Bt = (const bf16*)(ws + WS_WROUT); K = DRNN; scale = 1.f; }
            else { A = (const bf16*)(ws + WS_ATT); Bt = (const bf16*)(ws + WS_WO); K = D; scale = 1.f; }
            if (dry && ph != PH_FFN_OUT_0) scale = 0.f;
            float* xo = args.out;
#if RESID_BF16
            if (ph != PH_FFN_OUT_0) xin = nullptr;
            if (ph != PH_FFN_OUT_3 || dry) xo = nullptr;
#endif
            pg8::Gemm g{A, Bt, M, D, K}; pg8::StaticOrder S; S.init(M, D, C.G, (int)blockIdx.x);
            EpiRes E{xin, xo, xb, ssq, scale, dry && DUP_SKIP_EPI};
            pg8::gemm_phase<EpiRes, pg8::StaticOrder, false, true>(C.lds, g, S, E);
        } break;
        case PH_RNN_IN: {
            if (!dry) spare_convert(C, args, 7, 8, (M / 256) * (2 * DRNN / 256));
            pg8::Gemm g{xb, (const bf16*)(ws + WS_WRIN), M, 2 * DRNN, D}; pg8::StaticOrder S; S.init(M, 2 * DRNN, C.G, (int)blockIdx.x);
            fill_rstd(C.lds, S, ssq, C.tid);
            EpiRnnIn E{(const LAS float*)(C.lds + RSTD_OFF), (bf16*)(ws + WS_G), (bf16*)(ws + WS_U)};
            pg8::gemm_phase<EpiRnnIn, pg8::StaticOrder, true, true>(C.lds, g, S, E);
        } break;
        case PH_RNN_MID: p_rnn_mid(C, args); break;
        case PH_QKV: {
            pg8::Gemm g{xb, (const bf16*)(ws + WS_WQKV), M, NQKV, D}; pg8::StaticOrder S; S.init(M, NQKV, C.G, (int)blockIdx.x);
            if (C.tid < 128) ((LAS float*)(C.lds + GAIN_OFF))[C.tid] = (C.tid < 64) ? args.in[I_QGAIN][C.tid] * (0.125f * LOG2E) : args.in[I_KGAIN][C.tid - 64];
            fill_rstd(C.lds, S, ssq, C.tid);
            EpiQKV E{(const LAS float*)(C.lds + RSTD_OFF), (const LAS float*)(C.lds + GAIN_OFF), (bf16*)(ws + WS_QKV), dry && DUP_SKIP_EPI};
            pg8::gemm_phase<EpiQKV, pg8::StaticOrder, true, true>(C.lds, g, S, E);
        } break;
        case PH_ATTN: p_attn(C, dry); break;
        case PH_MERGE: p_merge(C, args); break;
        default: break;
        }
        if (dry || ph + 1 < args.ph_hi) xcd_barrier(bar);
        if (ph == 0 && !dry) for (int eb = 0; eb < DUP_EXTRA_BARRIERS; ++eb) xcd_barrier(bar);
        }
    }
}

extern "C" void kernel_launch(void* const* d_in, const int* in_sizes, int n_in, void* d_out, int out_size, void* d_ws, size_t ws_size, hipStream_t stream) {
    static int grid = 0;
    if (grid == 0) {
        if (n_in != 18 || in_sizes[0] != M * D || out_size != M * D || ws_size < WS_END) { fprintf(stderr, "kernel_launch: unexpected shapes (n_in %d, in0 %d, out %d, ws %zu)\n", n_in, n_in > 0 ? in_sizes[0] : -1, out_size, ws_size); grid = -1; return; }
        int dev = 0, cus = 0, per_cu = 0;
        if (hipGetDevice(&dev) != hipSuccess || hipDeviceGetAttribute(&cus, hipDeviceAttributeMultiprocessorCount, dev) != hipSuccess) { fprintf(stderr, "kernel_launch: device query failed\n"); grid = -1; return; }
        if (hipFuncSetAttribute((const void*)fwd_kernel, hipFuncAttributeMaxDynamicSharedMemorySize, LDS_BYTES) != hipSuccess) { fprintf(stderr, "kernel_launch: hipFuncSetAttribute failed\n"); grid = -1; return; }
        if (hipOccupancyMaxActiveBlocksPerMultiprocessor(&per_cu, (const void*)fwd_kernel, NWAVES * 64, LDS_BYTES) != hipSuccess || per_cu < 1) { fprintf(stderr, "kernel_launch: occupancy query says %d blocks per CU\n", per_cu); (void)hipGetLastError(); grid = -1; return; }
        grid = cus;
    }
    if (grid < 0) return;
    if (hipMemsetAsync(d_ws, 0, CTL_ZERO_BYTES, stream) != hipSuccess) { fprintf(stderr, "kernel_launch: memset failed\n"); return; }
    Args a{};
    for (int i = 0; i < 18; ++i) a.in[i] = (const float*)d_in[i];
    a.out = (float*)d_out; a.ws = (unsigned char*)d_ws;
#if SINGLE_LAUNCH
    a.ph_lo = 0; a.ph_hi = NPHASE;
    hipLaunchKernelGGL(fwd_kernel, dim3(grid), dim3(NWAVES * 64), LDS_BYTES, stream, a);
#else
    for (int ph = 0; ph < NPHASE; ++ph) { a.ph_lo = ph; a.ph_hi = ph + 1; hipLaunchKernelGGL(fwd_kernel, dim3(grid), dim3(NWAVES * 64), LDS_BYTES, stream, a); }
#endif
}
```

```cpp
#include <hip/hip_runtime.h>
#include <cstdio>
#include <cstdint>

#ifndef SINGLE_LAUNCH
#define SINGLE_LAUNCH 1
#define DUP_MASK 0u
#define DUP_N 1
#define DUP_EXTRA_BARRIERS 0
#define DUP_SKIP_EPI 0
#endif

namespace pg8 {
#define PG8_LAS __attribute__((address_space(3)))
typedef unsigned short bf16_t;
typedef short bf16x8 __attribute__((ext_vector_type(8)));
typedef float f32x4 __attribute__((ext_vector_type(4)));
typedef unsigned u32x4 __attribute__((ext_vector_type(4)));
constexpr int BM = 256, BK = 64, HALF = 128, HTB = HALF * BK * 2, STAGE_BYTES = 8 * HTB, NXCD = 8, WGM = 8;

__host__ __device__ __forceinline__ int lds_byte(int r, int c) { return (r >> 3) * 1024 + (r & 7) * 128 + ((((c >> 3) ^ (r & 7)) & 7) << 4) + (c & 7) * 2; }
__host__ __device__ __forceinline__ void stage_rc(int b, int& R, int& C) { const int sidx = b / 1024, w = b % 1024, rowin = w / 128, pch = (w % 128) / 16; R = sidx * 8 + rowin; C = ((pch ^ rowin) & 7) * 8; }
__host__ __device__ __forceinline__ int perm32(int rho) { const int n = rho >> 4, i = rho & 15; return 8 * (i >> 2) + 4 * n + (i & 3); }

struct Unit { int pm, pn; };
struct Gemm { const bf16_t* A; const bf16_t* Bt; int M, N, K; };

struct StaticOrder {
    int nM, nN, nwg, G, c;
    __host__ __device__ void init(int M, int N, int G_, int c_) { nM = M / BM; nN = N / BM; nwg = nM * nN; G = G_; c = c_; }
    __host__ __device__ bool next(int i, Unit& u) const {
        const long L = (long)i * G + c; if (L >= nwg) return false;
        int wgid = (int)L; { const int q = nwg / NXCD, r = nwg % NXCD, xcd = wgid % NXCD, off = wgid / NXCD; wgid = (xcd < r ? xcd * (q + 1) : r * (q + 1) + (xcd - r) * q) + off; }
        const int nig = WGM * nN, gid = wgid / nig, fm = gid * WGM, gsz = (nM - fm) < WGM ? (nM - fm) : WGM;
        u.pm = fm + ((wgid % nig) % gsz); u.pn = (wgid % nig) / gsz; return true;
    }
    __device__ __forceinline__ void a_ready(const Unit&) const {}
    __device__ __forceinline__ void done(const Unit&) const {}
};

__device__ __forceinline__ unsigned cvt_pk_bf16(float lo, float hi) { unsigned r; asm volatile("v_cvt_pk_bf16_f32 %0, %1, %2" : "=v"(r) : "v"(lo), "v"(hi)); return r; }

template <class Epi, class Sched, bool ALIGN_EPI = false, bool SP2 = false>
__device__ __forceinline__ void gemm_phase(PG8_LAS unsigned char* lds, const Gemm g, const Sched& S, const Epi& E) {
    int tid_ = threadIdx.x; asm volatile("" : "+v"(tid_));
    const int tid = tid_, wid = __builtin_amdgcn_readfirstlane(tid >> 6), lane = tid & 63, wr = wid >> 2, wc = wid & 3, fr = lane & 15, fq = lane >> 4;
    const int K = g.K, nt = K / BK;
    unsigned voffA, voffB;
    { int R, C; stage_rc(tid * 16, R, C); const int Rb = Epi::PERM ? ((R & ~31) + perm32(R & 31)) : R; voffA = (unsigned)(R * K + C) * 2u; voffB = (unsigned)(Rb * K + C) * 2u; }
    const size_t pstep = (size_t)64 * K * 2;
    const size_t kstep = (size_t)(BK * 2);
    const size_t hstep = (size_t)HALF * K * 2;
    const size_t tstep = 2 * hstep;
    const unsigned ldsw = (unsigned)wid * 1024u;
    const int aoff = lds_byte(wr * 64 + fr, fq * 8), boff = lds_byte(wc * 32 + fr, fq * 8);
#define PG8_SA(b, h) (((b) * 2 + (h)) * HTB)
#define PG8_SB(b, h) ((4 + (b) * 2 + (h)) * HTB)
#define PG8_STAGE(bufoff, gbase, voff) do { _Pragma("unroll") for (int _i = 0; _i < 2; ++_i) \
        __builtin_amdgcn_global_load_lds((const unsigned*)((const char*)(gbase) + _i * pstep + (voff)), (PG8_LAS unsigned*)(lds + (bufoff) + ldsw + _i * 8192), 16, 0, 0); } while (0)
#define PG8_LDA(dst, b, h) do { _Pragma("unroll") for (int m = 0; m < 4; ++m) _Pragma("unroll") for (int k = 0; k < 2; ++k) dst[m][k] = *(const PG8_LAS bf16x8*)(lds + PG8_SA(b, h) + (aoff ^ (k * 64)) + m * 2048); } while (0)
#define PG8_LDB(dst, b, h) do { _Pragma("unroll") for (int n = 0; n < 2; ++n) _Pragma("unroll") for (int k = 0; k < 2; ++k) dst[n][k] = *(const PG8_LAS bf16x8*)(lds + PG8_SB(b, h) + (boff ^ (k * 64)) + n * 2048); } while (0)
#define PG8_MMA(ai, bj, At, Bt) do { __builtin_amdgcn_s_setprio(1); _Pragma("unroll") for (int m = 0; m < 4; ++m) _Pragma("unroll") for (int n = 0; n < 2; ++n) _Pragma("unroll") for (int k = 0; k < 2; ++k) \
        acc[ai][bj][m][n] = __builtin_amdgcn_mfma_f32_16x16x32_bf16(Bt[n][k], At[m][k], acc[ai][bj][m][n], 0, 0, 0); __builtin_amdgcn_s_setprio(0); } while (0)
#define PG8_WAIT_V(n) asm volatile("s_waitcnt vmcnt(" #n ")" ::: "memory")
#define PG8_WAIT_L(n) asm volatile("s_waitcnt lgkmcnt(" #n ")" ::: "memory")
#define PG8_BAR __builtin_amdgcn_s_barrier()
#define PG8_SCHED __builtin_amdgcn_sched_barrier(0)
    Unit cur, nxt; int ui = 0;
    if (!S.next(0, cur)) return;
    f32x4 acc[2][2][4][2];
#pragma unroll
    for (int a = 0; a < 2; ++a)
#pragma unroll
        for (int b = 0; b < 2; ++b)
#pragma unroll
            for (int m = 0; m < 4; ++m)
#pragma unroll
                for (int n = 0; n < 2; ++n) acc[a][b][m][n] = (f32x4){0.f, 0.f, 0.f, 0.f};
    bf16x8 At[4][2], B0[2][2], B1[2][2];
    const char* cA = (const char*)g.A + (size_t)cur.pm * tstep; const char* cB = (const char*)g.Bt + (size_t)cur.pn * tstep;
    S.a_ready(cur);
    if constexpr (SP2) {
        PG8_STAGE(PG8_SB(0, 0), cB, voffB); PG8_STAGE(PG8_SB(0, 1), cB + hstep, voffB); PG8_STAGE(PG8_SA(0, 0), cA, voffA); PG8_STAGE(PG8_SA(0, 1), cA + hstep, voffA);
        if (wr == 1) PG8_BAR;
        PG8_WAIT_V(2); PG8_BAR;
        PG8_STAGE(PG8_SB(1, 0), cB + kstep, voffB); PG8_STAGE(PG8_SA(1, 0), cA + kstep, voffA); PG8_STAGE(PG8_SB(1, 1), cB + hstep + kstep, voffB);
        PG8_WAIT_V(6); PG8_BAR;
    } else {
        PG8_STAGE(PG8_SB(0, 0), cB, voffB); PG8_STAGE(PG8_SA(0, 0), cA, voffA); PG8_STAGE(PG8_SB(0, 1), cB + hstep, voffB); PG8_STAGE(PG8_SA(0, 1), cA + hstep, voffA);
        if (wr == 1) PG8_BAR;
        PG8_WAIT_V(4); PG8_BAR;
        PG8_STAGE(PG8_SB(1, 0), cB + kstep, voffB); PG8_STAGE(PG8_SA(1, 0), cA + kstep, voffA); PG8_STAGE(PG8_SB(1, 1), cB + hstep + kstep, voffB);
        PG8_WAIT_V(6); PG8_BAR;
    }
    for (;;) {
        const bool has_next = S.next(ui + 1, nxt);
        const char* nA = has_next ? (const char*)g.A + (size_t)nxt.pm * tstep : cA; const char* nB = has_next ? (const char*)g.Bt + (size_t)nxt.pn * tstep : cB;
        for (int t = 0; t < nt; t += 2) {
            const bool last = (t == nt - 2);
            const char* a1 = cA + (size_t)(t + 1) * kstep;
            const char* a2 = last ? nA : cA + (size_t)(t + 2) * kstep; const char* b2 = last ? nB : cB + (size_t)(t + 2) * kstep;
            const char* a3 = a2 + kstep; const char* b3 = b2 + kstep;
            if (last && has_next) S.a_ready(nxt);
            if constexpr (SP2) {
            PG8_LDB(B0, 0, 0); PG8_LDB(B1, 0, 1); PG8_SCHED; PG8_LDA(At, 0, 0); PG8_STAGE(PG8_SA(1, 1), a1 + hstep, voffA);
            PG8_WAIT_V(8); PG8_WAIT_L(0); PG8_BAR; PG8_MMA(0, 0, At, B0); PG8_MMA(0, 1, At, B1); PG8_BAR; PG8_SCHED;
            PG8_LDA(At, 0, 1); PG8_STAGE(PG8_SB(0, 0), b2, voffB); PG8_STAGE(PG8_SB(0, 1), b2 + hstep, voffB); PG8_STAGE(PG8_SA(0, 0), a2, voffA);
            PG8_WAIT_V(8); PG8_WAIT_L(0); PG8_BAR; PG8_MMA(1, 0, At, B0); PG8_MMA(1, 1, At, B1); PG8_BAR; PG8_SCHED;
            PG8_LDB(B0, 1, 0); PG8_LDB(B1, 1, 1); PG8_SCHED; PG8_LDA(At, 1, 0); PG8_STAGE(PG8_SA(0, 1), a2 + hstep, voffA);
            PG8_WAIT_V(8); PG8_WAIT_L(0); PG8_BAR; PG8_MMA(0, 0, At, B0); PG8_MMA(0, 1, At, B1); PG8_BAR; PG8_SCHED;
            PG8_LDA(At, 1, 1); PG8_STAGE(PG8_SB(1, 0), b3, voffB); PG8_STAGE(PG8_SB(1, 1), b3 + hstep, voffB); PG8_STAGE(PG8_SA(1, 0), a3, voffA);
            PG8_WAIT_V(8); PG8_WAIT_L(0); PG8_BAR; PG8_MMA(1, 0, At, B0); PG8_MMA(1, 1, At, B1); PG8_BAR; PG8_SCHED;
            } else {
            PG8_LDB(B0, 0, 0); PG8_SCHED; PG8_LDA(At, 0, 0); PG8_STAGE(PG8_SA(1, 1), a1 + hstep, voffA);
            PG8_WAIT_L(8); PG8_BAR; PG8_WAIT_L(0); PG8_MMA(0, 0, At, B0); PG8_BAR; PG8_SCHED;
            PG8_LDB(B1, 0, 1); PG8_STAGE(PG8_SB(0, 0), b2, voffB);
            PG8_BAR; PG8_WAIT_L(0); PG8_MMA(0, 1, At, B1); PG8_BAR;
            PG8_LDA(At, 0, 1); PG8_STAGE(PG8_SA(0, 0), a2, voffA);
            PG8_BAR; PG8_WAIT_L(0); PG8_MMA(1, 0, At, B0); PG8_BAR; PG8_SCHED;
            PG8_STAGE(PG8_SB(0, 1), b2 + hstep, voffB);
            PG8_WAIT_V(6); PG8_BAR; PG8_MMA(1, 1, At, B1); PG8_BAR;
            PG8_LDB(B0, 1, 0); PG8_SCHED; PG8_LDA(At, 1, 0); PG8_STAGE(PG8_SA(0, 1), a2 + hstep, voffA);
            PG8_WAIT_L(8); PG8_BAR; PG8_WAIT_L(0); PG8_MMA(0, 0, At, B0); PG8_BAR; PG8_SCHED;
            PG8_LDB(B1, 1, 1); PG8_STAGE(PG8_SB(1, 0), b3, voffB);
            PG8_BAR; PG8_WAIT_L(0); PG8_MMA(0, 1, At, B1); PG8_BAR;
            PG8_LDA(At, 1, 1); PG8_STAGE(PG8_SA(1, 0), a3, voffA);
            PG8_BAR; PG8_WAIT_L(0); PG8_MMA(1, 0, At, B0); PG8_BAR; PG8_SCHED;
            PG8_STAGE(PG8_SB(1, 1), b3 + hstep, voffB);
            PG8_WAIT_V(6); PG8_BAR; PG8_MMA(1, 1, At, B1); PG8_BAR;
            }
        }
        if constexpr (ALIGN_EPI) { if (wr == 0) PG8_BAR; }
        E(acc, cur, ui, wr, wc, fr, fq); S.done(cur);
        if (!has_next) break;
#pragma unroll
        for (int a = 0; a < 2; ++a)
#pragma unroll
            for (int b = 0; b < 2; ++b)
#pragma unroll
                for (int m = 0; m < 4; ++m)
#pragma unroll
                    for (int n = 0; n < 2; ++n) acc[a][b][m][n] = (f32x4){0.f, 0.f, 0.f, 0.f};
        cur = nxt; cA = nA; cB = nB; ++ui;
        if constexpr (ALIGN_EPI) { if (wr == 1) PG8_BAR; }
    }
    PG8_WAIT_V(0);
    if constexpr (!ALIGN_EPI) { if (wr == 0) PG8_BAR; }
    PG8_BAR;
#undef PG8_SA
#undef PG8_SB
#undef PG8_STAGE
#undef PG8_LDA
#undef PG8_LDB
#undef PG8_MMA
#undef PG8_WAIT_V
#undef PG8_WAIT_L
#undef PG8_BAR
#undef PG8_SCHED
}
}

constexpr int BATCH = 8, SEQ = 2048, D = 1024, M = BATCH * SEQ;
constexpr int FF = 2816, DRNN = 1280, NBLK = 10, RBLK = 128, CONVW = 4;
constexpr int NHEAD = 16, HD = 64, NGRP = 3, NQKV = 9216;
constexpr float RMS_EPS = 1e-6f;
constexpr float LOG2E = 1.4426950408889634f;
constexpr int NWAVES = 8;

typedef unsigned short bf16;
typedef unsigned v4u __attribute__((ext_vector_type(4)));
typedef unsigned v2u __attribute__((ext_vector_type(2)));
typedef float f32x4 __attribute__((ext_vector_type(4)));
#define GAS __attribute__((address_space(1)))
#define LAS __attribute__((address_space(3)))
typedef GAS unsigned gu32;
#define RLX_AGENT __ATOMIC_RELAXED, __HIP_MEMORY_SCOPE_AGENT
#define LDS_WAIT() asm volatile("s_waitcnt lgkmcnt(0)" ::: "memory")

#ifndef RESID_BF16
#define RESID_BF16 1
#endif
constexpr size_t MiB = 1u << 20;
constexpr size_t WS_CTL = 0, CTL_ZERO_BYTES = 1 * MiB;
constexpr size_t WS_SSQ = 1 * MiB;
constexpr size_t WS_BIAS = 2 * MiB;
constexpr size_t WS_XB = 3 * MiB;
constexpr size_t WS_WO = 35 * MiB;
constexpr size_t WS_WQKV = 37 * MiB;
constexpr size_t WS_QKV = 55 * MiB;
constexpr size_t QKV_SLAB = (size_t)M * 1024 * 2;
constexpr size_t WS_LSE = 343 * MiB;
constexpr size_t WS_END = 352 * MiB;
constexpr size_t WS_WIN0 = 55 * MiB, WS_WOUT0 = 66 * MiB, WS_WIN1 = 72 * MiB, WS_WOUT1 = 83 * MiB, WS_WIN2 = 89 * MiB, WS_WOUT2 = 100 * MiB;
constexpr size_t WS_WRIN = 106 * MiB, WS_WROUT = 111 * MiB, WS_WA = 114 * MiB, WS_WX = 114 * MiB + 512 * 1024;
constexpr size_t WS_ACT = 115 * MiB;
constexpr size_t WS_G = 203 * MiB, WS_U = 243 * MiB, WS_Y = 283 * MiB;
constexpr size_t WS_ATT = WS_QKV + 3 * QKV_SLAB;
constexpr size_t WS_WOUT3 = 346 * MiB;
constexpr size_t WS_ACT3 = WS_QKV;
static_assert(WS_Y + (size_t)M * DRNN * 2 <= WS_LSE && WS_ACT + (size_t)M * FF * 2 <= WS_G && WS_WX + 327680 <= WS_ACT, "ws map");
static_assert(WS_QKV + 9 * QKV_SLAB == WS_LSE && WS_LSE + (size_t)3 * M * 16 * 4 <= WS_WOUT3 && WS_WOUT3 + (size_t)D * FF * 2 <= WS_END && RESID_BF16 == 1, "ws map");
constexpr int CW_BAR = 4096;

constexpr int RING_BYTES = 131072;
constexpr int RSTD_OFF = RING_BYTES + 1024, RSTD_MAX_UNITS = 9, GAIN_OFF = RSTD_OFF + RSTD_MAX_UNITS * 256 * 4;
constexpr int LDS_BYTES = 147456;
constexpr int MISC_OFF = LDS_BYTES - 128;
static_assert(GAIN_OFF + 512 <= LDS_BYTES - 128, "LDS map");

#define XB_TMO      128
#define XB_XCNT(j)  (256  + 64 * (j))
#define XB_XSUB(j)  (1280 + 64 * (j))
#define XB_XGEN(j)  (2304 + 64 * (j))
#define XB_TOP      3328
#define XB_TOPGEN   3392
#define XCD_BAR_WORDS 3456
#define XB_SPIN_CAP (1u << 18)
__device__ __forceinline__ unsigned xb_ld(unsigned* p)              { return __hip_atomic_load(p, __ATOMIC_RELAXED, __HIP_MEMORY_SCOPE_AGENT); }
__device__ __forceinline__ unsigned xb_add(unsigned* p, unsigned v) { return __hip_atomic_fetch_add(p, v, __ATOMIC_RELAXED, __HIP_MEMORY_SCOPE_AGENT); }
__device__ __forceinline__ unsigned xb_xcc_id() { return (unsigned)__builtin_amdgcn_s_getreg((3 << 11) | 20) & 0xFu; }
#define XB_SPIN(cond, bar) do { unsigned _sp = 0; while (cond) { __builtin_amdgcn_s_sleep(1); \
    if ((++_sp & 255u) == 0u) { if (xb_ld(&(bar)[XB_TMO])) break; if (_sp > XB_SPIN_CAP) { atomicAdd(&(bar)[XB_TMO], 1u); break; } } } } while (0)
struct XcdBarrier { unsigned* bar; unsigned x; volatile LAS unsigned* st; };
__device__ __forceinline__ XcdBarrier xcd_barrier_post(unsigned* bar, volatile LAS unsigned* st) {
    XcdBarrier b; b.bar = bar; b.x = xb_xcc_id(); b.st = st;
    if (threadIdx.x == 0) (void)xb_add(&bar[XB_XCNT(b.x)], 1u);
    return b;
}
__device__ __forceinline__ void xcd_barrier_complete(unsigned* bar, unsigned x, unsigned& nloc, unsigned& nx) {
    const unsigned G = gridDim.x * gridDim.y * gridDim.z;
    unsigned sum, cnt, mine, sp = 0u;
    for (;;) {
        sum = 0u; cnt = 0u; mine = 0u;
#pragma unroll
        for (unsigned j = 0; j < 16; ++j) { const unsigned c = xb_ld(&bar[XB_XCNT(j)]); sum += c; cnt += (c > 0u) ? 1u : 0u; mine = (j == x) ? c : mine; }
        if (sum == G) break;
        __builtin_amdgcn_s_sleep(1);
        if ((++sp & 255u) == 0u) { if (xb_ld(&bar[XB_TMO])) break; if (sp > XB_SPIN_CAP) { atomicAdd(&bar[XB_TMO], 1u); break; } }
    }
    nloc = mine > 0u ? mine : 1u; nx = cnt > 0u ? cnt : 1u;
}
__device__ __forceinline__ void xcd_barrier(const XcdBarrier& b) {
    asm volatile("s_waitcnt vmcnt(0)" ::: "memory");
    __syncthreads();
    if (threadIdx.x == 0) {
        unsigned* bar = b.bar;
        __builtin_amdgcn_s_waitcnt(0);
        unsigned nloc = b.st[0], nx = b.st[1];
        if (nloc == 0u) { xcd_barrier_complete(bar, b.x, nloc, nx); b.st[0] = nloc; b.st[1] = nx; }
        const unsigned old = xb_add(&bar[XB_XSUB(b.x)], 1u);
        const unsigned gen = old / nloc;
        if (old + 1u == (gen + 1u) * nloc) {
            __builtin_amdgcn_fence(__ATOMIC_RELEASE, "agent");
            asm volatile("s_waitcnt vmcnt(0)" ::: "memory");
            const unsigned og = xb_add(&bar[XB_TOP], 1u);
            const unsigned tg = og / nx;
            if (og + 1u == (tg + 1u) * nx) xb_add(&bar[XB_TOPGEN], 1u);
            else XB_SPIN(xb_ld(&bar[XB_TOPGEN]) == tg, bar);
            __builtin_amdgcn_fence(__ATOMIC_ACQUIRE, "agent");
            xb_add(&bar[XB_XGEN(b.x)], 1u);
            asm volatile("s_waitcnt vmcnt(0)" ::: "memory");
        } else {
            XB_SPIN(xb_ld(&bar[XB_XGEN(b.x)]) == gen, bar);
            __builtin_amdgcn_fence(__ATOMIC_ACQUIRE, "agent");
            asm volatile("s_waitcnt vmcnt(0)" ::: "memory");
        }
    }
    __syncthreads();
}

__device__ __forceinline__ unsigned f2bf(float f) { unsigned u = __builtin_bit_cast(unsigned, f); return (u + 0x7fffu + ((u >> 16) & 1u)) >> 16; }
__device__ __forceinline__ unsigned pk2(float lo, float hi) { return f2bf(lo) | (f2bf(hi) << 16); }
__device__ __forceinline__ float bf_lo(unsigned w) { return __builtin_bit_cast(float, w << 16); }
__device__ __forceinline__ float bf_hi(unsigned w) { return __builtin_bit_cast(float, w & 0xffff0000u); }
__device__ __forceinline__ float bf2f(bf16 v) { return __builtin_bit_cast(float, (unsigned)v << 16); }
__device__ __forceinline__ float wave_sum(float v) {
#pragma unroll
    for (int o = 1; o < 64; o <<= 1) v += __shfl_xor(v, o);
    return v;
}
__device__ __forceinline__ float fast_sigmoid(float x) { return __builtin_amdgcn_rcpf(1.f + __builtin_amdgcn_exp2f(-LOG2E * x)); }
__device__ __forceinline__ float row_rstd(const float* ssq, int row) {
    const f32x4* p = (const f32x4*)(ssq + (size_t)row * 16); const f32x4 a = p[0], b = p[1], c = p[2], d = p[3];
    const float s = ((a.x + a.y) + (a.z + a.w)) + ((b.x + b.y) + (b.z + b.w)) + ((c.x + c.y) + (c.z + c.w)) + ((d.x + d.y) + (d.z + d.w));
    return rsqrtf(s * (1.0f / D) + RMS_EPS);
}

typedef float f32x2 __attribute__((ext_vector_type(2)));
template <class Sched> __device__ __forceinline__ void fill_rstd(LAS unsigned char* lds, const Sched& S, const float* ssq, int tid) {
    LAS float* rt = (LAS float*)(lds + RSTD_OFF); pg8::Unit u;
    for (int i = 0; i < RSTD_MAX_UNITS && S.next(i, u); ++i)
        if ((tid >> 8) == (i & 1)) { const int r = tid & 255; rt[i * 256 + r] = row_rstd(ssq, u.pm * 256 + r); }
    __syncthreads();
}
using pg8::Unit;
__device__ __forceinline__ f32x2 silu_mul_pk(f32x2 g, f32x2 up) {
    const f32x2 t = g * (-LOG2E); f32x2 e; e.x = __builtin_amdgcn_exp2f(t.x); e.y = __builtin_amdgcn_exp2f(t.y);
    const f32x2 d = e + 1.0f; f32x2 r; r.x = __builtin_amdgcn_rcpf(d.x); r.y = __builtin_amdgcn_rcpf(d.y);
    return (g * r) * up;
}
struct EpiSwiGLU {
    static constexpr bool PERM = true;
    const LAS float* rtab; bf16* act; int skip;
    __device__ __forceinline__ void operator()(const f32x4 (&acc)[2][2][4][2], const Unit& u, int ui, int wr, int wc, int fr, int fq) const {
        if (skip == 1) return;
#pragma unroll
        for (int ai = 0; ai < 2; ++ai)
#pragma unroll
            for (int m = 0; m < 4; ++m) {
                const int rl = ai * 128 + wr * 64 + m * 16 + fr, row = u.pm * 256 + rl;
                const float rs = rtab[ui * 256 + rl];
                f32x2 v[4];
#pragma unroll
                for (int n = 0; n < 2; ++n)
#pragma unroll
                    for (int e = 0; e < 2; ++e) { const f32x2 g = (f32x2){acc[ai][0][m][n][2 * e], acc[ai][0][m][n][2 * e + 1]} * rs, up = (f32x2){acc[ai][1][m][n][2 * e], acc[ai][1][m][n][2 * e + 1]} * rs;
                        v[n * 2 + e] = silu_mul_pk(g, up); }
                v4u w; w.x = pg8::cvt_pk_bf16(v[0].x, v[0].y); w.y = pg8::cvt_pk_bf16(v[1].x, v[1].y); w.z = pg8::cvt_pk_bf16(v[2].x, v[2].y); w.w = pg8::cvt_pk_bf16(v[3].x, v[3].y);
                if (skip != 2 || w.x == 0x7fc17fc1u) *(v4u*)(act + (size_t)row * FF + u.pn * 128 + wc * 32 + 8 * fq) = w;
            }
    }
};
#ifndef RESID_BF16
#define RESID_BF16 1
#endif
struct EpiRes {
    static constexpr bool PERM = true;
    const float* xin; float* xout; bf16* xb; float* ssq; float scale; bool skip;
    __device__ __forceinline__ void operator()(const f32x4 (&acc)[2][2][4][2], const Unit& u, int ui, int wr, int wc, int fr, int fq) const {
        if (skip) return;
        if (xin) run<true>(acc, u, wr, wc, fr, fq); else run<false>(acc, u, wr, wc, fr, fq);
    }
    template <bool F32IN> __device__ __forceinline__ void run(const f32x4 (&acc)[2][2][4][2], const Unit& u, int wr, int wc, int fr, int fq) const {
#pragma unroll
        for (int ai = 0; ai < 2; ++ai) {
            f32x4 xv[4][2][2];
#pragma unroll
            for (int m = 0; m < 4; ++m)
#pragma unroll
                for (int bj = 0; bj < 2; ++bj) { const size_t off = (size_t)(u.pm * 256 + ai * 128 + wr * 64 + m * 16 + fr) * D + u.pn * 256 + bj * 128 + wc * 32 + 8 * fq;
                    if (F32IN) { xv[m][bj][0] = *(const f32x4*)(xin + off); xv[m][bj][1] = *(const f32x4*)(xin + off + 4); }
                    else { const v4u w = *(const v4u*)(xb + off); xv[m][bj][0] = (f32x4){bf_lo(w.x), bf_hi(w.x), bf_lo(w.y), bf_hi(w.y)}; xv[m][bj][1] = (f32x4){bf_lo(w.z), bf_hi(w.z), bf_lo(w.w), bf_hi(w.w)}; } }
#pragma unroll
            for (int m = 0; m < 4; ++m) {
                const int row = u.pm * 256 + ai * 128 + wr * 64 + m * 16 + fr;
                float ss = 0.f;
#pragma unroll
                for (int bj = 0; bj < 2; ++bj) {
                    const size_t off = (size_t)row * D + u.pn * 256 + bj * 128 + wc * 32 + 8 * fq;
                    const f32x4 y0 = xv[m][bj][0] + acc[ai][bj][m][0] * scale, y1 = xv[m][bj][1] + acc[ai][bj][m][1] * scale;
                    if (xout) { *(f32x4*)(xout + off) = y0; *(f32x4*)(xout + off + 4) = y1; }
                    v4u w; w.x = pg8::cvt_pk_bf16(y0[0], y0[1]); w.y = pg8::cvt_pk_bf16(y0[2], y0[3]); w.z = pg8::cvt_pk_bf16(y1[0], y1[1]); w.w = pg8::cvt_pk_bf16(y1[2], y1[3]);
                    *(v4u*)(xb + off) = w;
                    ss += (y0[0] * y0[0] + y0[1] * y0[1]) + (y0[2] * y0[2] + y0[3] * y0[3]) + (y1[0] * y1[0] + y1[1] * y1[1]) + (y1[2] * y1[2] + y1[3] * y1[3]);
                }
                ss += __shfl_xor(ss, 16); ss += __shfl_xor(ss, 32);
                if (fq == 0) ssq[(size_t)row * 16 + u.pn * 4 + wc] = ss;
            }
            asm volatile("" ::: "memory");
        }
    }
};
struct EpiRnnIn {
    static constexpr bool PERM = true;
    const LAS float* rtab; bf16* Gb; bf16* Ub;
    template <bool GATE> __device__ __forceinline__ void run(const f32x4 (&acc)[2][2][4][2], const Unit& u, int ui, int wr, int wc, int fr, int fq, bf16* dstb, int pc) const {
#pragma unroll
        for (int ai = 0; ai < 2; ++ai)
#pragma unroll
            for (int m = 0; m < 4; ++m) {
                const int rl = ai * 128 + wr * 64 + m * 16 + fr, row = u.pm * 256 + rl;
                const float rs = rtab[ui * 256 + rl];
#pragma unroll
                for (int bj = 0; bj < 2; ++bj) {
                    f32x2 v[4];
#pragma unroll
                    for (int n = 0; n < 2; ++n)
#pragma unroll
                        for (int e = 0; e < 2; ++e) { f32x2 x = (f32x2){acc[ai][bj][m][n][2 * e], acc[ai][bj][m][n][2 * e + 1]} * rs;
                            if (GATE) {
                                const f32x2 t = (x * x * 0.044715f + 1.0f) * x * (-1.5957691216057308f * LOG2E); f32x2 ex; ex.x = __builtin_amdgcn_exp2f(t.x); ex.y = __builtin_amdgcn_exp2f(t.y);
                                const f32x2 d = ex + 1.0f; f32x2 r; r.x = __builtin_amdgcn_rcpf(d.x); r.y = __builtin_amdgcn_rcpf(d.y); x = x * r; }
                            v[n * 2 + e] = x; }
                    v4u w; w.x = pg8::cvt_pk_bf16(v[0].x, v[0].y); w.y = pg8::cvt_pk_bf16(v[1].x, v[1].y); w.z = pg8::cvt_pk_bf16(v[2].x, v[2].y); w.w = pg8::cvt_pk_bf16(v[3].x, v[3].y);
                    *(v4u*)(dstb + (size_t)row * DRNN + pc * 256 + bj * 128 + wc * 32 + 8 * fq) = w;
                }
            }
    }
    __device__ __forceinline__ void operator()(const f32x4 (&acc)[2][2][4][2], const Unit& u, int ui, int wr, int wc, int fr, int fq) const {
        if (u.pn < 5) run<true>(acc, u, ui, wr, wc, fr, fq, Gb, u.pn); else run<false>(acc, u, ui, wr, wc, fr, fq, Ub, u.pn - 5);
    }
};
struct EpiQKV {
    static constexpr bool PERM = true;
    const LAS float* rtab; const LAS float* gtab; bf16* qkv; bool skip;
    __device__ __forceinline__ void operator()(const f32x4 (&acc)[2][2][4][2], const Unit& u, int ui, int wr, int wc, int fr, int fq) const {
        if (skip) return;
        const int hs = u.pn * 4 + wc, kind = hs / 48, gh = hs - kind * 48, g = gh >> 4, h = gh & 15, l2d = 2 * g;
        bf16* slab = qkv + (size_t)(kind * 3 + g) * ((size_t)M * 1024);
        f32x4 gv[2][2];
#pragma unroll
        for (int bj = 0; bj < 2; ++bj)
#pragma unroll
            for (int n = 0; n < 2; ++n) { gv[bj][n] = (f32x4){1.f, 1.f, 1.f, 1.f}; if (kind < 2) gv[bj][n] = *(const LAS f32x4*)(gtab + kind * 64 + 32 * bj + 8 * fq + 4 * n); }
#pragma unroll
        for (int ai = 0; ai < 2; ++ai)
#pragma unroll
            for (int m = 0; m < 4; ++m) {
                const int rl = ai * 128 + wr * 64 + m * 16 + fr, row = u.pm * 256 + rl;
                const float rs = rtab[ui * 256 + rl];
                f32x4 v[2][2]; float ss = 0.f;
#pragma unroll
                for (int bj = 0; bj < 2; ++bj)
#pragma unroll
                    for (int n = 0; n < 2; ++n) { v[bj][n] = acc[ai][bj][m][n] * rs; const f32x4 t = v[bj][n] * v[bj][n]; ss += (t[0] + t[1]) + (t[2] + t[3]); }
                float rn = 1.f;
                if (kind < 2) { ss += __shfl_xor(ss, 16); ss += __shfl_xor(ss, 32); rn = rsqrtf(ss * (1.0f / HD) + RMS_EPS); }
                const int b = row >> 11, t = row & 2047, rres = t & ((1 << l2d) - 1), l = t >> l2d, L = 2048 >> l2d;
                bf16* dst = slab + ((size_t)(b * 16 + h) * 2048 + rres * L + l) * 64 + 8 * fq;
#pragma unroll
                for (int bj = 0; bj < 2; ++bj) {
                    const f32x4 a0 = v[bj][0] * gv[bj][0] * rn, a1 = v[bj][1] * gv[bj][1] * rn;
                    v4u w; w.x = pg8::cvt_pk_bf16(a0[0], a0[1]); w.y = pg8::cvt_pk_bf16(a0[2], a0[3]); w.z = pg8::cvt_pk_bf16(a1[0], a1[1]); w.w = pg8::cvt_pk_bf16(a1[2], a1[3]);
                    *(v4u*)(dst + 32 * bj) = w;
                }
            }
    }
};

struct Args { const float* in[18]; float* out; unsigned char* ws; int ph_lo, ph_hi; };
enum { I_X = 0, I_NORMG, I_FFN_WIN, I_FFN_WOUT, I_RNN_WIN, I_CONV_W, I_CONV_B, I_WA, I_BA, I_WX, I_BX, I_LAM, I_RNN_WOUT, I_WQKV, I_QGAIN, I_KGAIN, I_WO, I_RELB };

struct Ctx { LAS unsigned char* lds; int tid, lane, wave, G, vcu; unsigned char* ws; };

typedef short v4i16_t __attribute__((ext_vector_type(4)));
__device__ __forceinline__ v4i16_t vtr16(const LAS unsigned char* p) { return __builtin_amdgcn_ds_read_tr16_b64_v4i16((LAS v4i16_t*)p); }
enum { CM_NONE = 0, CM_FFN = 1, CM_QKV = 2 };
__device__ __forceinline__ int colmap(int mode, int vr) {
    if (mode == CM_FFN) { const int pn = vr >> 8, w = vr & 255; return (w >> 7) * FF + 128 * pn + (w & 127); }
    if (mode == CM_QKV) { const int pn = vr >> 8, w = vr & 255, bj = w >> 7, wc = (w >> 5) & 3, j = w & 31; return 256 * pn + 64 * wc + 32 * bj + j; }
    return vr;
}
__device__ __forceinline__ void transpose_item(const float* W, int K, int N, const float* gvec, bf16* WT, int mode, LAS unsigned char* scr, int item, int lane) {
    const int nblk = N / 64, kb = item / nblk, nb = item - kb * nblk, k0 = 64 * kb, vr0 = 64 * nb;
    const int col4 = lane & 15, rsub = lane >> 4, nsrc = colmap(mode, vr0 + 32 * (col4 >> 3)) + (col4 & 7) * 4;
    const float* src = W + (size_t)(k0 + rsub) * N + nsrc;
    f32x4 w[16];
#pragma unroll
    for (int i = 0; i < 16; ++i) w[i] = __builtin_nontemporal_load((const GAS f32x4*)(src + (size_t)(4 * i) * N));
    if (gvec) {
#pragma unroll
        for (int i = 0; i < 16; ++i) w[i] = w[i] * gvec[k0 + 4 * i + rsub];
    }
#pragma unroll
    for (int i = 0; i < 16; ++i) { v2u p; p.x = pg8::cvt_pk_bf16(w[i][0], w[i][1]); p.y = pg8::cvt_pk_bf16(w[i][2], w[i][3]);
        *(LAS v2u*)(scr + (col4 >> 3) * 4096 + (4 * i + rsub) * 64 + (col4 & 7) * 8) = p; }
    const int q = (lane & 15) >> 2, p4 = lane & 3, gidx = lane >> 4;
#pragma unroll
    for (int r = 0; r < 8; ++r) { const int nb16 = r >> 1, kh = r & 1, kbase = 32 * kh + 8 * gidx;
        const LAS unsigned char* a = scr + (nb16 >> 1) * 4096 + (kbase + q) * 64 + ((nb16 & 1) * 16 + 4 * p4) * 2;
        const v4i16_t lo = vtr16(a), hi = vtr16(a + 4 * 64);
        v4u o; { const v2u l2 = __builtin_bit_cast(v2u, lo), h2 = __builtin_bit_cast(v2u, hi); o.x = l2.x; o.y = l2.y; o.z = h2.x; o.w = h2.y; }
        *(GAS v4u*)(WT + (size_t)(vr0 + nb16 * 16 + (lane & 15)) * K + k0 + kbase) = o; }
}
struct MatJob { const float* W; int K, N; const float* g; bf16* WT; int mode; };
__device__ __forceinline__ MatJob mat_job(const Ctx& C, const Args& a, int idx) {
    unsigned char* ws = C.ws; const float* ng = a.in[I_NORMG]; MatJob j;
    switch (idx) {
    case 0: j = MatJob{a.in[I_FFN_WIN] + (size_t)0 * D * 2 * FF, D, 2 * FF, ng + 0 * D, (bf16*)(ws + WS_WIN0), CM_FFN}; break;
    case 1: j = MatJob{a.in[I_FFN_WOUT] + (size_t)0 * FF * D, FF, D, nullptr, (bf16*)(ws + WS_WOUT0), CM_NONE}; break;
    case 2: j = MatJob{a.in[I_RNN_WIN], D, 2 * DRNN, ng + 1 * D, (bf16*)(ws + WS_WRIN), CM_NONE}; break;
    case 3: j = MatJob{a.in[I_RNN_WOUT], DRNN, D, nullptr, (bf16*)(ws + WS_WROUT), CM_NONE}; break;
    case 4: j = MatJob{a.in[I_FFN_WIN] + (size_t)1 * D * 2 * FF, D, 2 * FF, ng + 2 * D, (bf16*)(ws + WS_WIN1), CM_FFN}; break;
    case 5: j = MatJob{a.in[I_FFN_WOUT] + (size_t)1 * FF * D, FF, D, nullptr, (bf16*)(ws + WS_WOUT1), CM_NONE}; break;
    case 6: j = MatJob{a.in[I_WQKV], D, NQKV, ng + 4 * D, (bf16*)(ws + WS_WQKV), CM_QKV}; break;
    case 7: j = MatJob{a.in[I_WO], D, D, nullptr, (bf16*)(ws + WS_WO), CM_NONE}; break;
    case 8: j = MatJob{a.in[I_FFN_WIN] + (size_t)2 * D * 2 * FF, D, 2 * FF, ng + 3 * D, (bf16*)(ws + WS_WIN2), CM_FFN}; break;
    case 9: j = MatJob{a.in[I_FFN_WOUT] + (size_t)2 * FF * D, FF, D, nullptr, (bf16*)(ws + WS_WOUT2), CM_NONE}; break;
    case 10: j = MatJob{a.in[I_FFN_WIN] + (size_t)3 * D * 2 * FF, D, 2 * FF, ng + 5 * D, (bf16*)a.out, CM_FFN}; break;
    default: j = MatJob{a.in[I_FFN_WOUT] + (size_t)3 * FF * D, FF, D, nullptr, (bf16*)(ws + WS_WOUT3), CM_NONE}; break;
    }
    return j;
}
__device__ __forceinline__ void convert_mats(const Ctx& C, const Args& a, int first, int last, int gw, int NGW) {
    LAS unsigned char* scr = C.lds + C.wave * 8192;
    int base = 0;
    for (int mi = first; mi < last; ++mi) {
        const MatJob j = mat_job(C, a, mi); const int cnt = (j.K / 64) * (j.N / 64);
        int it = (gw - base) % NGW; if (it < 0) it += NGW;
        for (; it < cnt; it += NGW) transpose_item(j.W, j.K, j.N, j.g, j.WT, j.mode, scr, it, C.lane);
        base += cnt;
    }
}
__device__ __forceinline__ void spare_convert(const Ctx& C, const Args& a, int first, int last, int nwg) {
    const int R = (nwg + C.G - 1) / C.G, first_spare = nwg - (R - 1) * C.G, nspare = C.G - first_spare, c = (int)blockIdx.x;
    if (nspare > 0) { if (c >= first_spare) convert_mats(C, a, first, last, (c - first_spare) * NWAVES + C.wave, nspare * NWAVES); }
    else convert_mats(C, a, first, last, c * NWAVES + C.wave, C.G * NWAVES);
    __syncthreads();
}
__device__ __forceinline__ int t5_bucket(int n) {
    if (n < 16) return n;
    int b = 16;
    b += (n >= 22) + (n >= 30) + (n >= 40) + (n >= 54) + (n >= 73) + (n >= 99) + (n >= 134) + (n >= 182) + (n >= 246) + (n >= 332) + (n >= 450) + (n >= 609) + (n >= 825) + (n >= 1117) + (n >= 1513);
    return b;
}
__device__ __forceinline__ void p_prologue(const Ctx& C, const Args& a) {
    const int gw = C.vcu * NWAVES + C.wave, NGW = C.G * NWAVES;
    convert_mats(C, a, 0, 1, gw, NGW);
    {   LAS unsigned char* scr = C.lds + C.wave * 8192;
        for (int it = gw; it < 2 * NBLK * 4; it += NGW) { const int which = it / (NBLK * 4), r = it % (NBLK * 4), blk = r >> 2, sub = r & 3;
            const float* W = (which ? a.in[I_WX] : a.in[I_WA]) + (size_t)blk * RBLK * RBLK; bf16* WT = (bf16*)(C.ws + (which ? WS_WX : WS_WA)) + (size_t)blk * RBLK * RBLK;
            transpose_item(W, RBLK, RBLK, nullptr, WT, CM_NONE, scr, sub, C.lane); } }
    const float* x = a.in[I_X]; bf16* xb = (bf16*)(C.ws + WS_XB); float* ssq = (float*)(C.ws + WS_SSQ);
    for (int m = gw; m < M; m += NGW) {
        const GAS f32x4* xr = (const GAS f32x4*)(x + (size_t)m * D) + C.lane; f32x4 v[4]; float s = 0.f;
#pragma unroll
        for (int j = 0; j < 4; ++j) { v[j] = __builtin_nontemporal_load(xr + 64 * j); s += (v[j].x * v[j].x + v[j].y * v[j].y) + (v[j].z * v[j].z + v[j].w * v[j].w); }
        s = wave_sum(s);
        GAS v2u* o8 = (GAS v2u*)(xb + (size_t)m * D) + C.lane;
#pragma unroll
        for (int j = 0; j < 4; ++j) { v2u w; w.x = pk2(v[j].x, v[j].y); w.y = pk2(v[j].z, v[j].w); o8[64 * j] = w; }
        if (C.lane < 16) ssq[(size_t)m * 16 + C.lane] = (C.lane == 0) ? s : 0.f;
    }
    float* bt = (float*)(C.ws + WS_BIAS); const float* rb = a.in[I_RELB];
    for (int i = blockIdx.x * 512 + C.tid; i < 48 * 129; i += C.G * 512) { const int gh = i / 129, dist = i - gh * 129, g = gh >> 4;
        bt[gh * 132 + dist] = rb[t5_bucket(dist << (2 * g)) * 48 + gh] * LOG2E; }
}

typedef float f32x16 __attribute__((ext_vector_type(16)));
typedef short bf16x8v __attribute__((ext_vector_type(8)));
constexpr int RM_WB = 0, RM_WB_GATE = 64 * 272, RM_CW = 36864, RM_CMP = RM_CW + 2560, RM_TILE = 49152, RM_TILE_BYTES = 36 * 256, RM_END = RM_TILE + 8 * RM_TILE_BYTES;
static_assert(RM_WB + 2 * RM_WB_GATE <= RM_CW && RM_CMP + 2 * 2 * 8 * 64 * 4 <= RM_TILE && RM_END <= RING_BYTES, "rnn-mid LDS map");
__device__ __forceinline__ bf16x8v pack8(const float (&v)[8]) {
    v4u w; w.x = pg8::cvt_pk_bf16(v[0], v[1]); w.y = pg8::cvt_pk_bf16(v[2], v[3]); w.z = pg8::cvt_pk_bf16(v[4], v[5]); w.w = pg8::cvt_pk_bf16(v[6], v[7]);
    return __builtin_bit_cast(bf16x8v, w);
}
__device__ __forceinline__ void p_rnn_mid(const Ctx& C, const Args& a) {
    const bf16* U = (const bf16*)(C.ws + WS_U); const bf16* Gb = (const bf16*)(C.ws + WS_G); bf16* Y = (bf16*)(C.ws + WS_Y);
    const bf16* WAb = (const bf16*)(C.ws + WS_WA); const bf16* WXb = (const bf16*)(C.ws + WS_WX);
    LAS unsigned char* L = C.lds;
    LAS float* CW = (LAS float*)(L + RM_CW); LAS float* CMP = (LAS float*)(L + RM_CMP);
    const int wave = C.wave;
    LAS unsigned char* wt = L + RM_TILE + wave * RM_TILE_BYTES;
    for (int item = blockIdx.x; item < BATCH * NBLK * 2; item += C.G) {
        const int b = item / (NBLK * 2), n = (item % (NBLK * 2)) >> 1, half = item & 1;
        int tid = C.tid; asm volatile("" : "+v"(tid));
        const int lane = tid & 63, r32 = lane & 31, hh = lane >> 5;
        __syncthreads();
#pragma unroll
        for (int p = 0; p < 4; ++p) { const int idx = p * 512 + tid, gate = idx >> 10, rem = idx & 1023, row = rem >> 4, c16 = rem & 15;
            const v4u w = *(const v4u*)((gate ? WXb : WAb) + (size_t)(n * 128 + 64 * half + row) * 128 + c16 * 8);
            *(LAS v4u*)(L + RM_WB + gate * RM_WB_GATE + row * 272 + c16 * 16) = w; }
        CW[tid] = a.in[I_CONV_W][(tid >> 7) * DRNN + n * 128 + (tid & 127)];
        if (tid < 128) CW[512 + tid] = a.in[I_CONV_B][n * 128 + tid];
        __syncthreads();
        float ba[2], bx[2], spl[2], Ht[2];
#pragma unroll
        for (int cb = 0; cb < 2; ++cb) { const int ch = n * 128 + 64 * half + 32 * cb + r32; ba[cb] = a.in[I_BA][ch]; bx[cb] = a.in[I_BX][ch];
            spl[cb] = -8.0f * LOG2E * log1pf(expf(-a.in[I_LAM][ch])); Ht[cb] = 0.f; }
        bf16x8v idf[2];
#pragma unroll
        for (int sp = 0; sp < 2; ++sp)
#pragma unroll
            for (int j = 0; j < 8; ++j) idf[sp][j] = (16 * sp + 8 * hh + j == r32) ? (short)0x3F80 : (short)0;
        const int urow = lane >> 4, uch = lane & 15, grow = lane >> 3, gch = lane & 7;
        v4u uraw[9], graw[4];
#define RM_LOADU(TILE) do { const int tp_ = (TILE) * 256 + wave * 32; const int ub_ = (b * SEQ + tp_ - 3 + urow) * DRNN + n * 128 + uch * 8;        \
        _Pragma("unroll") for (int i_ = 0; i_ < 9; ++i_) uraw[i_] = *(const v4u*)(U + (ptrdiff_t)(ub_ + i_ * 4 * DRNN)); \
        if (tp_ == 0 && urow < 3) uraw[0] = (v4u){0u, 0u, 0u, 0u};         } while (0)
#define RM_LOADG(TILE) do { const int gb_ = (b * SEQ + (TILE) * 256 + wave * 32 + grow) * DRNN + n * 128 + 64 * half + gch * 8; \
        _Pragma("unroll") for (int i_ = 0; i_ < 4; ++i_) graw[i_] = *(const v4u*)(Gb + (unsigned)(gb_ + i_ * 8 * DRNN)); } while (0)
        for (int tile = 0; tile < 8; ++tile) {
            const int tposw = tile * 256 + wave * 32;
            const size_t tok0 = (size_t)b * SEQ + tposw;
            LAS float* CWt = CW; LAS unsigned char* WBt = L + RM_WB; asm volatile("" : "+v"(CWt), "+v"(WBt));
            RM_LOADU(tile); RM_LOADG(tile);
#pragma unroll
            for (int i = 0; i < 9; ++i) { const int rl = 4 * i + urow; *(LAS v4u*)(wt + rl * 256 + ((uch ^ (rl & 15)) << 4)) = uraw[i]; }
            {
                const int tg = lane >> 4, cc = lane & 15;
                f32x2 wv[4][4], bv2[4];
#pragma unroll
                for (int k = 0; k < 4; ++k) { const f32x4 w0 = *(const LAS f32x4*)(CWt + k * 128 + 8 * cc), w1 = *(const LAS f32x4*)(CWt + k * 128 + 8 * cc + 4);
                    wv[k][0] = (f32x2){w0[0], w0[1]}; wv[k][1] = (f32x2){w0[2], w0[3]}; wv[k][2] = (f32x2){w1[0], w1[1]}; wv[k][3] = (f32x2){w1[2], w1[3]}; }
                { const f32x4 b0 = *(const LAS f32x4*)(CWt + 512 + 8 * cc), b1 = *(const LAS f32x4*)(CWt + 512 + 8 * cc + 4);
                  bv2[0] = (f32x2){b0[0], b0[1]}; bv2[1] = (f32x2){b0[2], b0[3]}; bv2[2] = (f32x2){b1[0], b1[1]}; bv2[3] = (f32x2){b1[2], b1[3]}; }
                v4u ur[11];
#pragma unroll
                for (int j = 0; j < 11; ++j) { const int rl = 8 * tg + j; ur[j] = *(const LAS v4u*)(wt + rl * 256 + ((cc ^ (rl & 15)) << 4)); }
                f32x2 o[8][4];
#pragma unroll
                for (int i = 0; i < 8; ++i)
#pragma unroll
                    for (int e = 0; e < 4; ++e) o[i][e] = bv2[e];
#pragma unroll
                for (int j = 0; j < 11; ++j) {
                    const f32x2 u0 = (f32x2){bf_lo(ur[j].x), bf_hi(ur[j].x)}, u1 = (f32x2){bf_lo(ur[j].y), bf_hi(ur[j].y)}, u2 = (f32x2){bf_lo(ur[j].z), bf_hi(ur[j].z)}, u3 = (f32x2){bf_lo(ur[j].w), bf_hi(ur[j].w)};
#pragma unroll
                    for (int k = 0; k < 4; ++k) { const int i = j - k; if (i >= 0 && i < 8) {
                        o[i][0] += wv[k][0] * u0; o[i][1] += wv[k][1] * u1; o[i][2] += wv[k][2] * u2; o[i][3] += wv[k][3] * u3; } }
                }
#pragma unroll
                for (int i = 0; i < 8; ++i) { const int rl = 8 * tg + i;
                    v4u w; w.x = pg8::cvt_pk_bf16(o[i][0].x, o[i][0].y); w.y = pg8::cvt_pk_bf16(o[i][1].x, o[i][1].y); w.z = pg8::cvt_pk_bf16(o[i][2].x, o[i][2].y); w.w = pg8::cvt_pk_bf16(o[i][3].x, o[i][3].y);
                    *(LAS v4u*)(wt + rl * 256 + ((cc ^ (rl & 15)) << 4)) = w; }
            }
            bf16x8v af[8];
#pragma unroll
            for (int s = 0; s < 8; ++s) af[s] = *(const LAS bf16x8v*)(wt + r32 * 256 + (((2 * s + hh) ^ (r32 & 15)) << 4));
#pragma unroll
            for (int i = 0; i < 4; ++i) *(LAS v4u*)(wt + (8 * i + grow) * 128 + gch * 16) = graw[i];
            f32x16 acc[2][2], ufa[2];
#pragma unroll
            for (int cb = 0; cb < 2; ++cb)
#pragma unroll
                for (int e = 0; e < 16; ++e) { acc[0][cb][e] = 0.f; acc[1][cb][e] = 0.f; ufa[cb][e] = 0.f; }
            bf16x8v bq[2][4];
#define RM_LDB(S, DST) do { _Pragma("unroll") for (int g_ = 0; g_ < 2; ++g_) _Pragma("unroll") for (int c_ = 0; c_ < 2; ++c_) \
                DST[g_ * 2 + c_] = *(const LAS bf16x8v*)(WBt + g_ * RM_WB_GATE + (32 * c_ + r32) * 272 + (16 * (S) + 8 * hh) * 2); } while (0)
            RM_LDB(0, bq[0]);
#pragma unroll
            for (int s = 0; s < 8; ++s) {
                if (s < 7) RM_LDB(s + 1, bq[(s + 1) & 1]);
#pragma unroll
                for (int gt = 0; gt < 2; ++gt)
#pragma unroll
                    for (int cb = 0; cb < 2; ++cb) acc[gt][cb] = __builtin_amdgcn_mfma_f32_32x32x16_bf16(af[s], bq[s & 1][gt * 2 + cb], acc[gt][cb], 0, 0, 0);
            }
#undef RM_LDB
#pragma unroll
            for (int cb = 0; cb < 2; ++cb)
#pragma unroll
                for (int sp = 0; sp < 2; ++sp) { const bf16x8v asel = half ? af[4 + 2 * cb + sp] : af[2 * cb + sp];
                    ufa[cb] = __builtin_amdgcn_mfma_f32_32x32x16_bf16(asel, idf[sp], ufa[cb], 0, 0, 0); }
#pragma unroll
            for (int cb = 0; cb < 2; ++cb)
#pragma unroll
                for (int e = 0; e < 16; ++e) {
                    const float uf = ufa[cb][e];
                    const float r = fast_sigmoid(acc[0][cb][e] + ba[cb]), ii = fast_sigmoid(acc[1][cb][e] + bx[cb]);
                    const float av = __builtin_amdgcn_exp2f(r * spl[cb]);
                    const float bv = __builtin_amdgcn_sqrtf(fmaxf(1.f - av * av, 0.f)) * (ii * uf);
                    acc[0][cb][e] = av; acc[1][cb][e] = bv;
                }
            float A0[2][4], B0[2][4], A1[2][4], B1[2][4];
            const int par = tile & 1;
#pragma unroll
            for (int cb = 0; cb < 2; ++cb) {
                float Aw = 1.f, Bw = 0.f;
#pragma unroll
                for (int q = 0; q < 4; ++q) {
                    const float a0 = acc[0][cb][4 * q], a1 = acc[0][cb][4 * q + 1], a2 = acc[0][cb][4 * q + 2], a3 = acc[0][cb][4 * q + 3];
                    const float Ag = (a0 * a1) * (a2 * a3);
                    const float Bg = ((acc[1][cb][4 * q] * a1 + acc[1][cb][4 * q + 1]) * a2 + acc[1][cb][4 * q + 2]) * a3 + acc[1][cb][4 * q + 3];
                    const float pA = __shfl_xor(Ag, 32), pB = __shfl_xor(Bg, 32);
                    A0[cb][q] = hh ? pA : Ag; B0[cb][q] = hh ? pB : Bg; A1[cb][q] = hh ? Ag : pA; B1[cb][q] = hh ? Bg : pB;
                    Bw = Bw * A0[cb][q] + B0[cb][q]; Aw *= A0[cb][q]; Bw = Bw * A1[cb][q] + B1[cb][q]; Aw *= A1[cb][q];
                }
                if (hh == 0) { CMP[((par * 2 + 0) * 8 + wave) * 64 + 32 * cb + r32] = Aw; CMP[((par * 2 + 1) * 8 + wave) * 64 + 32 * cb + r32] = Bw; }
            }
            __syncthreads();
#pragma unroll
            for (int cb = 0; cb < 2; ++cb) {
                float h = Ht[cb], hin = 0.f;
#pragma unroll
                for (int v = 0; v < 8; ++v) { const float Av = CMP[((par * 2 + 0) * 8 + v) * 64 + 32 * cb + r32], Bv = CMP[((par * 2 + 1) * 8 + v) * 64 + 32 * cb + r32];
                    hin = (v == wave) ? h : hin; h = Av * h + Bv; }
                Ht[cb] = h;
                float hc = hin;
#pragma unroll
                for (int q = 0; q < 4; ++q) {
                    const float c0 = hc; hc = A0[cb][q] * hc + B0[cb][q]; const float c1 = hc; hc = A1[cb][q] * hc + B1[cb][q];
                    float hv = hh ? c1 : c0;
#pragma unroll
                    for (int i = 0; i < 4; ++i) { const int e = 4 * q + i; hv = acc[0][cb][e] * hv + acc[1][cb][e];
                        const int tl = (e & 3) + 8 * (e >> 2) + 4 * hh;
                        LAS bf16* gp = (LAS bf16*)(wt + tl * 128 + (32 * cb + r32) * 2);
                        *gp = (bf16)f2bf(hv * bf2f(*gp)); }
                }
            }
#pragma unroll
            for (int i = 0; i < 4; ++i) { const v4u w = *(const LAS v4u*)(wt + (8 * i + grow) * 128 + gch * 16);
                *(v4u*)(Y + (unsigned)(((int)tok0 + 8 * i + grow) * DRNN + n * 128 + 64 * half + gch * 8)) = w; }
        }
#undef RM_LOADU
#undef RM_LOADG
    }
    const int nitems = BATCH * NBLK * 2;
    if (C.G > nitems) { if ((int)blockIdx.x >= nitems) convert_mats(C, a, 4, 8, ((int)blockIdx.x - nitems) * NWAVES + wave, (C.G - nitems) * NWAVES); }
    else { __syncthreads(); convert_mats(C, a, 4, 8, (int)blockIdx.x * NWAVES + wave, C.G * NWAVES); }
}
struct AttnUnit { const bf16* qrows; const bf16* kres; const bf16* vres; int l0, kb_lo, eoff; };
__device__ __forceinline__ AttnUnit attn_unit(const bf16* QKV, int g, int bh, int llin0) {
    AttnUnit u; const size_t SLAB = (size_t)M * 1024; const int L = SEQ >> (2 * g);
    u.l0 = llin0 & (L - 1); u.kb_lo = (u.l0 - 128) > 0 ? (u.l0 - 128) : 0; u.eoff = g * 192;
    u.qrows = QKV + (size_t)g * SLAB + ((size_t)bh * SEQ + llin0) * HD;
    u.kres = u.qrows + 3 * SLAB - (size_t)u.l0 * HD; u.vres = u.qrows + 6 * SLAB - (size_t)u.l0 * HD;
    return u;
}
typedef __bf16 bf16x2n __attribute__((ext_vector_type(2)));
__device__ __forceinline__ unsigned cvtpk_n(float lo, float hi) { const f32x2 v = {lo, hi}; return __builtin_bit_cast(unsigned, __builtin_convertvector(v, bf16x2n)); }
constexpr int AT_VT = 0, AT_EXT = 8 * 8192, AT_LACC = AT_EXT + 3 * 192 * 4, AT_OACC = AT_EXT + 4608;
static_assert(AT_LACC + 512 * 4 <= AT_OACC && AT_OACC + 512 * 128 <= MISC_OFF, "attention LDS map");
#define AT_QBLOCK(QF, O0, O1, MROW, LSUM, EB) do { \
        f32x16 p_; _Pragma("unroll") for (int e = 0; e < 16; ++e) p_[e] = 0.f; \
        _Pragma("unroll") for (int s_ = 0; s_ < 4; ++s_) p_ = __builtin_amdgcn_mfma_f32_32x32x16_bf16(kf[s_], QF[s_], p_, 0, 0, 0); \
        float bm_ = -1e30f; \
        _Pragma("unroll") for (int e = 0; e < 16; ++e) { p_[e] += ext[(EB) - ((e & 3) + 8 * (e >> 2))]; bm_ = fmaxf(bm_, p_[e]); } \
        bm_ = fmaxf(bm_, __shfl_xor(bm_, 32)); \
        const float mn_ = fmaxf(MROW, bm_), alpha_ = __builtin_amdgcn_exp2f(MROW - mn_); MROW = mn_; \
        float ps_ = 0.f; \
        _Pragma("unroll") for (int e = 0; e < 16; ++e) { p_[e] = __builtin_amdgcn_exp2f(p_[e] - mn_); ps_ += p_[e]; } \
        LSUM = LSUM * alpha_ + ps_; \
        _Pragma("unroll") for (int e = 0; e < 16; ++e) { O0[e] *= alpha_; O1[e] *= alpha_; } \
        _Pragma("unroll") for (int s_ = 0; s_ < 2; ++s_) { \
            v4u w_; w_.x = cvtpk_n(p_[8 * s_], p_[8 * s_ + 1]); w_.y = cvtpk_n(p_[8 * s_ + 2], p_[8 * s_ + 3]); w_.z = cvtpk_n(p_[8 * s_ + 4], p_[8 * s_ + 5]); w_.w = cvtpk_n(p_[8 * s_ + 6], p_[8 * s_ + 7]); \
            const bf16x8v pf_ = __builtin_bit_cast(bf16x8v, w_); \
            const v4i16_t a00_ = vtr16(vt + (16 * s_) * 64 + vtr_off), a01_ = vtr16(vt + (16 * s_ + 8) * 64 + vtr_off), a10_ = vtr16(vt + 2048 + (16 * s_) * 64 + vtr_off), a11_ = vtr16(vt + 2048 + (16 * s_ + 8) * 64 + vtr_off); \
            O0 = __builtin_amdgcn_mfma_f32_32x32x16_bf16((bf16x8v){a00_[0], a00_[1], a00_[2], a00_[3], a01_[0], a01_[1], a01_[2], a01_[3]}, pf_, O0, 0, 0, 0); \
            O1 = __builtin_amdgcn_mfma_f32_32x32x16_bf16((bf16x8v){a10_[0], a10_[1], a10_[2], a10_[3], a11_[0], a11_[1], a11_[2], a11_[3]}, pf_, O1, 0, 0, 0); } \
    } while (0)
#define AT_COMBINE(MODE, O0, O1, MROW, LSUM, TL) do { \
        const float ltot_ = LSUM + __shfl_xor(LSUM, 32), inv_ = 1.f / ltot_, lse_ = MROW + log2f(ltot_); const int tl_ = (TL); \
        LAS unsigned char* orow_ = C.lds + AT_OACC + tl_ * 128; LAS float* lacc_ = (LAS float*)(C.lds + AT_LACC); \
        float wo_ = 0.f, wn_ = inv_; \
        if (MODE != 0) { const float lo_ = lacc_[tl_], mx_ = fmaxf(lo_, lse_), eo_ = __builtin_amdgcn_exp2f(lo_ - mx_), en_ = __builtin_amdgcn_exp2f(lse_ - mx_), rs_ = 1.f / (eo_ + en_); \
            wo_ = eo_ * rs_; wn_ = en_ * rs_ * inv_; if (MODE == 1 && hh == 0) lacc_[tl_] = mx_ + log2f(eo_ + en_); } \
        else if (hh == 0) lacc_[tl_] = lse_; \
        _Pragma("unroll") for (int q = 0; q < 4; ++q) { \
            LAS v2u* p0_ = (LAS v2u*)(orow_ + ((q ^ (tl_ & 7)) << 4) + 8 * hh); LAS v2u* p1_ = (LAS v2u*)(orow_ + (((4 + q) ^ (tl_ & 7)) << 4) + 8 * hh); \
            float a_[8] = {O0[4 * q] * wn_, O0[4 * q + 1] * wn_, O0[4 * q + 2] * wn_, O0[4 * q + 3] * wn_, O1[4 * q] * wn_, O1[4 * q + 1] * wn_, O1[4 * q + 2] * wn_, O1[4 * q + 3] * wn_}; \
            if (MODE != 0) { const v2u c0_ = *p0_, c1_ = *p1_; \
                a_[0] += wo_ * bf_lo(c0_.x); a_[1] += wo_ * bf_hi(c0_.x); a_[2] += wo_ * bf_lo(c0_.y); a_[3] += wo_ * bf_hi(c0_.y); \
                a_[4] += wo_ * bf_lo(c1_.x); a_[5] += wo_ * bf_hi(c1_.x); a_[6] += wo_ * bf_lo(c1_.y); a_[7] += wo_ * bf_hi(c1_.y); } \
            v2u w0_, w1_; w0_.x = cvtpk_n(a_[0], a_[1]); w0_.y = cvtpk_n(a_[2], a_[3]); w1_.x = cvtpk_n(a_[4], a_[5]); w1_.y = cvtpk_n(a_[6], a_[7]); \
            if (MODE != 2) { *p0_ = w0_; *p1_ = w1_; } \
            else { bf16* g_ = ATT + (size_t)(row0 + tl_) * 1024 + h * 64 + 8 * q + 4 * hh; *(v2u*)g_ = w0_; *(v2u*)(g_ + 32) = w1_; } } \
    } while (0)
__device__ __forceinline__ void p_attn(const Ctx& C, bf16* ATT) {
    const bf16* QKV = (const bf16*)(C.ws + WS_QKV); const float* bt = (const float*)(C.ws + WS_BIAS);
    LAS float* ext = (LAS float*)(C.lds + AT_EXT);
    LAS unsigned char* vt = C.lds + AT_VT + C.wave * 8192; LAS unsigned char* kt = vt + 4096;
    const int wave = C.wave;
    v4u kfn[4], vvn[4];
#define AT_LOADKV(U, KB) do { const bf16* kblk_ = (U).kres + (size_t)(KB) * HD; const bf16* vblk_ = (U).vres + (size_t)(KB) * HD; \
        _Pragma("unroll") for (int i_ = 0; i_ < 4; ++i_) { vvn[i_] = *(const v4u*)(vblk_ + (8 * i_ + crow8) * HD + cch * 8); kfn[i_] = *(const v4u*)(kblk_ + (8 * i_ + crow8) * HD + cch * 8); } } while (0)
#define AT_TILE2FRAG(RAW, OFS, FR) do { _Pragma("unroll") for (int i_ = 0; i_ < 4; ++i_) *(LAS v4u*)(kt + (8 * i_ + crow8) * 128 + ((cch ^ crow8) << 4)) = RAW[(OFS) + i_]; \
        _Pragma("unroll") for (int s_ = 0; s_ < 4; ++s_) FR[s_] = *(const LAS bf16x8v*)(kt + r32 * 128 + (((2 * s_ + hh) ^ (r32 & 7)) << 4)); } while (0)
#define AT_LOADQFRAG(U, ROW0, FR) do { v4u q_[4]; _Pragma("unroll") for (int i_ = 0; i_ < 4; ++i_) q_[i_] = *(const v4u*)((U).qrows + ((ROW0) + 8 * i_ + crow8) * HD + cch * 8); AT_TILE2FRAG(q_, 0, FR); } while (0)
#define AT_STEP(KB, USEA, USEB) do { const int kb_ = (KB); \
            v4u vv[4], kraw[4]; bf16x8v kf[4]; \
            _Pragma("unroll") for (int i = 0; i < 4; ++i) { vv[i] = vvn[i]; kraw[i] = kfn[i]; } \
            if (kb_ - 32 >= cu.kb_lo) { AT_LOADKV(cu, kb_ - 32); } \
            _Pragma("unroll") for (int i = 0; i < 4; ++i) *(LAS v4u*)(vt + (cch >> 2) * 2048 + (8 * i + crow8) * 64 + (cch & 3) * 16) = vv[i]; \
            AT_TILE2FRAG(kraw, 0, kf); \
            const int ebA = cu.eoff + cu.l0 + r32 - kb_ - 4 * hh + 32;            \
            if (USEA) { AT_QBLOCK(qfA, oA0, oA1, mA, lA, ebA); } \
        } while (0)
#define AT_ZERO(O0, O1, MR, LS) do { _Pragma("unroll") for (int e = 0; e < 16; ++e) { O0[e] = 0.f; O1[e] = 0.f; } MR = -1e30f; LS = 0.f; } while (0)
    for (int v = blockIdx.x; v < BATCH * NHEAD * 4; v += C.G) {
        int tid = C.tid; asm volatile("" : "+v"(tid));
        const int lane = tid & 63, r32 = lane & 31, hh = lane >> 5;
        const int crow8 = lane >> 3, cch = lane & 7;
        const int vtr_off = (4 * hh + ((lane & 15) >> 2)) * 64 + ((lane >> 4) & 1) * 32 + (lane & 3) * 8;
        const int bh = (v >> 1) & 127, sidx = ((v & 1) << 1) | (v >> 8), s = (sidx == 0) ? 0 : (sidx == 1) ? 3 : (sidx == 2) ? 1 : 2, h = bh & 15;
        const int row0 = (bh >> 4) * SEQ + 512 * s;
        __syncthreads();
        for (int i = tid; i < 3 * 192; i += 512) { const int g = i / 192, dist = i - g * 192 - 32; ext[i] = (dist >= 0 && dist <= 128) ? bt[(g * 16 + h) * 132 + dist] : -1e30f; }
        __syncthreads();
        f32x16 oA0, oA1; float mA, lA; bf16x8v qfA[4];
#pragma unroll 1
        for (int step = 0; step < 6; ++step) {
            const int g = step >> 1, j = step & 1;
            const int llin0 = (g == 0) ? 512 * s + 64 * wave + 32 * j : (g == 1) ? (wave >> 1) * 512 + 128 * s + 64 * (wave & 1) + 32 * j : (2 * wave + j) * 128 + 32 * s;
            const int tl = (g == 0) ? 64 * wave + 32 * j + r32 : (g == 1) ? 256 * (wave & 1) + (wave >> 1) + 4 * (32 * j + r32) : 16 * r32 + 2 * wave + j;
            const AttnUnit cu = attn_unit(QKV, g, bh, llin0);
            AT_LOADKV(cu, cu.l0);
            AT_LOADQFRAG(cu, 0, qfA);
            AT_ZERO(oA0, oA1, mA, lA);
            for (int kb = cu.l0; kb >= cu.kb_lo; kb -= 32) AT_STEP(kb, true, false);
            AT_COMBINE(g, oA0, oA1, mA, lA, tl);
            if (j == 1 && g < 2) __syncthreads();
        }
    }
#undef AT_LOADKV
#undef AT_TILE2FRAG
#undef AT_LOADQFRAG
#undef AT_STEP
#undef AT_ZERO
}
#undef AT_QBLOCK
#undef AT_COMBINE
enum { PH_PROLOGUE = 0, PH_FFN_IN_0, PH_FFN_OUT_0, PH_RNN_IN, PH_RNN_MID, PH_RNN_OUT, PH_FFN_IN_1, PH_FFN_OUT_1,
       PH_FFN_IN_2, PH_FFN_OUT_2, PH_QKV, PH_ATTN, PH_WO, PH_FFN_IN_3, PH_FFN_OUT_3, NPHASE };

__global__ void __launch_bounds__(NWAVES * 64, 2) fwd_kernel(Args args) {
    extern __shared__ __attribute__((aligned(16))) unsigned char lds_raw[];
    Ctx C; C.lds = (LAS unsigned char*)lds_raw; C.tid = threadIdx.x; C.lane = C.tid & 63; C.wave = __builtin_amdgcn_readfirstlane(C.tid >> 6);
    C.G = gridDim.x; { const int bx = blockIdx.x; C.vcu = (C.G % 8 == 0) ? (bx % 8) * (C.G / 8) + bx / 8 : bx; }
    C.ws = args.ws;
    volatile LAS unsigned* MISC = (volatile LAS unsigned*)(C.lds + MISC_OFF);
    if (C.tid < 32) ((LAS unsigned*)(C.lds + MISC_OFF))[C.tid] = 0u;
    __syncthreads();
    unsigned* ctl = (unsigned*)args.ws;
    XcdBarrier bar; bar.bar = ctl + CW_BAR; bar.x = 0; bar.st = nullptr;
    const bool multi = (args.ph_hi - args.ph_lo) > 1;
    if (multi) bar = xcd_barrier_post(ctl + CW_BAR, MISC + 8);
    for (int ph = args.ph_lo; ph < args.ph_hi; ++ph) {
        for (int rep = ((DUP_MASK >> ph) & 1u) ? DUP_N : 0; rep >= 0; --rep) {
        const bool dry = rep > 0;
        { int t_ = threadIdx.x; asm volatile("" : "+v"(t_)); C.tid = t_; C.lane = t_ & 63; }
        unsigned char* ws = args.ws;
        C.ws = ws; float* ssq = (float*)(ws + WS_SSQ); bf16* xb = (bf16*)(ws + WS_XB);
        switch (ph) {
        case PH_PROLOGUE: p_prologue(C, args); break;
        case PH_FFN_IN_0: case PH_FFN_IN_1: case PH_FFN_IN_2: case PH_FFN_IN_3: {
            if (!dry && ph != PH_FFN_IN_3) { const int f = (ph == PH_FFN_IN_0) ? 1 : (ph == PH_FFN_IN_1) ? 8 : 10, l = (ph == PH_FFN_IN_0) ? 4 : (ph == PH_FFN_IN_1) ? 10 : 12; spare_convert(C, args, f, l, (M / 256) * (2 * FF / 256)); }
            const bf16* Bt = (ph == PH_FFN_IN_3) ? (const bf16*)args.out : (const bf16*)(ws + (ph == PH_FFN_IN_0 ? WS_WIN0 : ph == PH_FFN_IN_1 ? WS_WIN1 : WS_WIN2));
            bf16* act = (bf16*)(ws + (ph == PH_FFN_IN_3 ? WS_ACT3 : WS_ACT));
            pg8::Gemm g{xb, Bt, M, 2 * FF, D}; pg8::StaticOrder S; S.init(M, 2 * FF, C.G, (int)blockIdx.x);
            fill_rstd(C.lds, S, ssq, C.tid);
            EpiSwiGLU E{(const LAS float*)(C.lds + RSTD_OFF), act, dry ? DUP_SKIP_EPI : 0};
            pg8::gemm_phase<EpiSwiGLU, pg8::StaticOrder, true, true>(C.lds, g, S, E);
        } break;
        case PH_FFN_OUT_0: case PH_FFN_OUT_1: case PH_FFN_OUT_2: case PH_FFN_OUT_3: case PH_RNN_OUT: case PH_WO: {
            const bf16* A; const bf16* Bt; int K; float scale = 0.5f; const float* xin = args.out;
            if (ph == PH_FFN_OUT_0) { A = (const bf16*)(ws + WS_ACT); Bt = (const bf16*)(ws + WS_WOUT0); K = FF; xin = args.in[I_X]; }
            else if (ph == PH_FFN_OUT_1) { A = (const bf16*)(ws + WS_ACT); Bt = (const bf16*)(ws + WS_WOUT1); K = FF; }
            else if (ph == PH_FFN_OUT_2) { A = (const bf16*)(ws + WS_ACT); Bt = (const bf16*)(ws + WS_WOUT2); K = FF; }
            else if (ph == PH_FFN_OUT_3) { A = (const bf16*)(ws + WS_ACT3); Bt = (const bf16*)(ws + WS_WOUT3); K = FF; }
            else if (ph == PH_RNN_OUT) { A = (const bf16*)(ws + WS_Y); Bt = (const bf16*)(ws + WS_WROUT); K = DRNN; scale = 1.f; }
            else { A = (const bf16*)args.out + (size_t)8 * 1024 * 1024; Bt = (const bf16*)(ws + WS_WO); K = D; scale = 1.f; }
            if (dry && ph != PH_FFN_OUT_0) scale = 0.f;
            float* xo = args.out;
#if RESID_BF16
            if (ph != PH_FFN_OUT_0) xin = nullptr;
            if (ph != PH_FFN_OUT_3 || dry) xo = nullptr;
#endif
            pg8::Gemm g{A, Bt, M, D, K}; pg8::StaticOrder S; S.init(M, D, C.G, (int)blockIdx.x);
            EpiRes E{xin, xo, xb, ssq, scale, dry && DUP_SKIP_EPI};
            pg8::gemm_phase<EpiRes, pg8::StaticOrder, false, true>(C.lds, g, S, E);
        } break;
        case PH_RNN_IN: {
            pg8::Gemm g{xb, (const bf16*)(ws + WS_WRIN), M, 2 * DRNN, D}; pg8::StaticOrder S; S.init(M, 2 * DRNN, C.G, (int)blockIdx.x);
            fill_rstd(C.lds, S, ssq, C.tid);
            EpiRnnIn E{(const LAS float*)(C.lds + RSTD_OFF), (bf16*)(ws + WS_G), (bf16*)(ws + WS_U)};
            pg8::gemm_phase<EpiRnnIn, pg8::StaticOrder, true, true>(C.lds, g, S, E);
        } break;
        case PH_RNN_MID: p_rnn_mid(C, args); break;
        case PH_QKV: {
            pg8::Gemm g{xb, (const bf16*)(ws + WS_WQKV), M, NQKV, D}; pg8::StaticOrder S; S.init(M, NQKV, C.G, (int)blockIdx.x);
            if (C.tid < 128) ((LAS float*)(C.lds + GAIN_OFF))[C.tid] = (C.tid < 64) ? args.in[I_QGAIN][C.tid] * (0.125f * LOG2E) : args.in[I_KGAIN][C.tid - 64];
            fill_rstd(C.lds, S, ssq, C.tid);
            EpiQKV E{(const LAS float*)(C.lds + RSTD_OFF), (const LAS float*)(C.lds + GAIN_OFF), (bf16*)(ws + WS_QKV), dry && DUP_SKIP_EPI};
            pg8::gemm_phase<EpiQKV, pg8::StaticOrder, true, true>(C.lds, g, S, E);
        } break;
        case PH_ATTN: if (!dry) p_attn(C, (bf16*)args.out + (size_t)8 * 1024 * 1024); break;
        default: break;
        }
        if (dry || ph + 1 < args.ph_hi) xcd_barrier(bar);
        if (ph == 0 && !dry) for (int eb = 0; eb < DUP_EXTRA_BARRIERS; ++eb) xcd_barrier(bar);
        }
    }
}

extern "C" void kernel_launch(void* const* d_in, const int* in_sizes, int n_in, void* d_out, int out_size, void* d_ws, size_t ws_size, hipStream_t stream) {
    static int grid = 0;
    if (grid == 0) {
        if (n_in != 18 || in_sizes[0] != M * D || out_size != M * D || ws_size < WS_END) { fprintf(stderr, "kernel_launch: unexpected shapes (n_in %d, in0 %d, out %d, ws %zu)\n", n_in, n_in > 0 ? in_sizes[0] : -1, out_size, ws_size); grid = -1; return; }
        int dev = 0, cus = 0, per_cu = 0;
        if (hipGetDevice(&dev) != hipSuccess || hipDeviceGetAttribute(&cus, hipDeviceAttributeMultiprocessorCount, dev) != hipSuccess) { fprintf(stderr, "kernel_launch: device query failed\n"); grid = -1; return; }
        if (hipFuncSetAttribute((const void*)fwd_kernel, hipFuncAttributeMaxDynamicSharedMemorySize, LDS_BYTES) != hipSuccess) { fprintf(stderr, "kernel_launch: hipFuncSetAttribute failed\n"); grid = -1; return; }
        if (hipOccupancyMaxActiveBlocksPerMultiprocessor(&per_cu, (const void*)fwd_kernel, NWAVES * 64, LDS_BYTES) != hipSuccess || per_cu < 1) { fprintf(stderr, "kernel_launch: occupancy query says %d blocks per CU\n", per_cu); (void)hipGetLastError(); grid = -1; return; }
        grid = cus;
    }
    if (grid < 0) return;
    if (hipMemsetAsync(d_ws, 0, CTL_ZERO_BYTES, stream) != hipSuccess) { fprintf(stderr, "kernel_launch: memset failed\n"); return; }
    Args a{};
    for (int i = 0; i < 18; ++i) a.in[i] = (const float*)d_in[i];
    a.out = (float*)d_out; a.ws = (unsigned char*)d_ws;
#if SINGLE_LAUNCH
    a.ph_lo = 0; a.ph_hi = NPHASE;
    hipLaunchKernelGGL(fwd_kernel, dim3(grid), dim3(NWAVES * 64), LDS_BYTES, stream, a);
#else
    for (int ph = 0; ph < NPHASE; ++ph) { a.ph_lo = ph; a.ph_hi = ph + 1; hipLaunchKernelGGL(fwd_kernel, dim3(grid), dim3(NWAVES * 64), LDS_BYTES, stream, a); }
#endif
}
```

```cpp
#include <hip/hip_runtime.h>
#include <cstdio>
#include <cstdint>

#ifndef SINGLE_LAUNCH
#define SINGLE_LAUNCH 1
#define DUP_MASK 0u
#define DUP_N 1
#define DUP_EXTRA_BARRIERS 0
#define DUP_SKIP_EPI 0
#endif

namespace pg8 {
#define PG8_LAS __attribute__((address_space(3)))
typedef unsigned short bf16_t;
typedef short bf16x8 __attribute__((ext_vector_type(8)));
typedef float f32x4 __attribute__((ext_vector_type(4)));
typedef unsigned u32x4 __attribute__((ext_vector_type(4)));
constexpr int BM = 256, BK = 64, HALF = 128, HTB = HALF * BK * 2, STAGE_BYTES = 8 * HTB, NXCD = 8, WGM = 8;

__host__ __device__ __forceinline__ int lds_byte(int r, int c) { return (r >> 3) * 1024 + (r & 7) * 128 + ((((c >> 3) ^ (r & 7)) & 7) << 4) + (c & 7) * 2; }
__host__ __device__ __forceinline__ void stage_rc(int b, int& R, int& C) { const int sidx = b / 1024, w = b % 1024, rowin = w / 128, pch = (w % 128) / 16; R = sidx * 8 + rowin; C = ((pch ^ rowin) & 7) * 8; }
__host__ __device__ __forceinline__ int perm32(int rho) { const int n = rho >> 4, i = rho & 15; return 8 * (i >> 2) + 4 * n + (i & 3); }

struct Unit { int pm, pn; };
struct Gemm { const bf16_t* A; const bf16_t* Bt; int M, N, K; };

struct StaticOrder {
    int nM, nN, nwg, G, c;
    __host__ __device__ void init(int M, int N, int G_, int c_) { nM = M / BM; nN = N / BM; nwg = nM * nN; G = G_; c = c_; }
    __host__ __device__ bool next(int i, Unit& u) const {
        const long L = (long)i * G + c; if (L >= nwg) return false;
        int wgid = (int)L; { const int q = nwg / NXCD, r = nwg % NXCD, xcd = wgid % NXCD, off = wgid / NXCD; wgid = (xcd < r ? xcd * (q + 1) : r * (q + 1) + (xcd - r) * q) + off; }
        const int nig = WGM * nN, gid = wgid / nig, fm = gid * WGM, gsz = (nM - fm) < WGM ? (nM - fm) : WGM;
        u.pm = fm + ((wgid % nig) % gsz); u.pn = (wgid % nig) / gsz; return true;
    }
    __device__ __forceinline__ void a_ready(const Unit&) const {}
    __device__ __forceinline__ void done(const Unit&) const {}
};

__device__ __forceinline__ unsigned cvt_pk_bf16(float lo, float hi) { unsigned r; asm volatile("v_cvt_pk_bf16_f32 %0, %1, %2" : "=v"(r) : "v"(lo), "v"(hi)); return r; }

template <class Epi, class Sched, bool ALIGN_EPI = false, bool SP2 = false>
__device__ __forceinline__ void gemm_phase(PG8_LAS unsigned char* lds, const Gemm g, const Sched& S, const Epi& E) {
    int tid_ = threadIdx.x; asm volatile("" : "+v"(tid_));
    const int tid = tid_, wid = __builtin_amdgcn_readfirstlane(tid >> 6), lane = tid & 63, wr = wid >> 2, wc = wid & 3, fr = lane & 15, fq = lane >> 4;
    const int K = g.K, nt = K / BK;
    unsigned voffA, voffB;
    { int R, C; stage_rc(tid * 16, R, C); const int Rb = Epi::PERM ? ((R & ~31) + perm32(R & 31)) : R; voffA = (unsigned)(R * K + C) * 2u; voffB = (unsigned)(Rb * K + C) * 2u; }
    const size_t pstep = (size_t)64 * K * 2;
    const size_t kstep = (size_t)(BK * 2);
    const size_t hstep = (size_t)HALF * K * 2;
    const size_t tstep = 2 * hstep;
    const unsigned ldsw = (unsigned)wid * 1024u;
    const int aoff = lds_byte(wr * 64 + fr, fq * 8), boff = lds_byte(wc * 32 + fr, fq * 8);
#define PG8_SA(b, h) (((b) * 2 + (h)) * HTB)
#define PG8_SB(b, h) ((4 + (b) * 2 + (h)) * HTB)
#define PG8_STAGE(bufoff, gbase, voff) do { _Pragma("unroll") for (int _i = 0; _i < 2; ++_i) \
        __builtin_amdgcn_global_load_lds((const unsigned*)((const char*)(gbase) + _i * pstep + (voff)), (PG8_LAS unsigned*)(lds + (bufoff) + ldsw + _i * 8192), 16, 0, 0); } while (0)
#define PG8_LDA(dst, b, h) do { _Pragma("unroll") for (int m = 0; m < 4; ++m) _Pragma("unroll") for (int k = 0; k < 2; ++k) dst[m][k] = *(const PG8_LAS bf16x8*)(lds + PG8_SA(b, h) + (aoff ^ (k * 64)) + m * 2048); } while (0)
#define PG8_LDB(dst, b, h) do { _Pragma("unroll") for (int n = 0; n < 2; ++n) _Pragma("unroll") for (int k = 0; k < 2; ++k) dst[n][k] = *(const PG8_LAS bf16x8*)(lds + PG8_SB(b, h) + (boff ^ (k * 64)) + n * 2048); } while (0)
#define PG8_MMA(ai, bj, At, Bt) do { __builtin_amdgcn_s_setprio(1); _Pragma("unroll") for (int m = 0; m < 4; ++m) _Pragma("unroll") for (int n = 0; n < 2; ++n) _Pragma("unroll") for (int k = 0; k < 2; ++k) \
        acc[ai][bj][m][n] = __builtin_amdgcn_mfma_f32_16x16x32_bf16(Bt[n][k], At[m][k], acc[ai][bj][m][n], 0, 0, 0); __builtin_amdgcn_s_setprio(0); } while (0)
#define PG8_WAIT_V(n) asm volatile("s_waitcnt vmcnt(" #n ")" ::: "memory")
#define PG8_WAIT_L(n) asm volatile("s_waitcnt lgkmcnt(" #n ")" ::: "memory")
#define PG8_BAR __builtin_amdgcn_s_barrier()
#define PG8_SCHED __builtin_amdgcn_sched_barrier(0)
    Unit cur, nxt; int ui = 0;
    if (!S.next(0, cur)) return;
    f32x4 acc[2][2][4][2];
#pragma unroll
    for (int a = 0; a < 2; ++a)
#pragma unroll
        for (int b = 0; b < 2; ++b)
#pragma unroll
            for (int m = 0; m < 4; ++m)
#pragma unroll
                for (int n = 0; n < 2; ++n) acc[a][b][m][n] = (f32x4){0.f, 0.f, 0.f, 0.f};
    bf16x8 At[4][2], B0[2][2], B1[2][2];
    const char* cA = (const char*)g.A + (size_t)cur.pm * tstep; const char* cB = (const char*)g.Bt + (size_t)cur.pn * tstep;
    S.a_ready(cur);
    if constexpr (SP2) {
        PG8_STAGE(PG8_SB(0, 0), cB, voffB); PG8_STAGE(PG8_SB(0, 1), cB + hstep, voffB); PG8_STAGE(PG8_SA(0, 0), cA, voffA); PG8_STAGE(PG8_SA(0, 1), cA + hstep, voffA);
        if (wr == 1) PG8_BAR;
        PG8_WAIT_V(2); PG8_BAR;
        PG8_STAGE(PG8_SB(1, 0), cB + kstep, voffB); PG8_STAGE(PG8_SA(1, 0), cA + kstep, voffA); PG8_STAGE(PG8_SB(1, 1), cB + hstep + kstep, voffB);
        PG8_WAIT_V(6); PG8_BAR;
    } else {
        PG8_STAGE(PG8_SB(0, 0), cB, voffB); PG8_STAGE(PG8_SA(0, 0), cA, voffA); PG8_STAGE(PG8_SB(0, 1), cB + hstep, voffB); PG8_STAGE(PG8_SA(0, 1), cA + hstep, voffA);
        if (wr == 1) PG8_BAR;
        PG8_WAIT_V(4); PG8_BAR;
        PG8_STAGE(PG8_SB(1, 0), cB + kstep, voffB); PG8_STAGE(PG8_SA(1, 0), cA + kstep, voffA); PG8_STAGE(PG8_SB(1, 1), cB + hstep + kstep, voffB);
        PG8_WAIT_V(6); PG8_BAR;
    }
    for (;;) {
        const bool has_next = S.next(ui + 1, nxt);
        const char* nA = has_next ? (const char*)g.A + (size_t)nxt.pm * tstep : cA; const char* nB = has_next ? (const char*)g.Bt + (size_t)nxt.pn * tstep : cB;
        for (int t = 0; t < nt; t += 2) {
            const bool last = (t == nt - 2);
            const char* a1 = cA + (size_t)(t + 1) * kstep;
            const char* a2 = last ? nA : cA + (size_t)(t + 2) * kstep; const char* b2 = last ? nB : cB + (size_t)(t + 2) * kstep;
            const char* a3 = a2 + kstep; const char* b3 = b2 + kstep;
            if (last && has_next) S.a_ready(nxt);
            if constexpr (SP2) {
            PG8_LDB(B0, 0, 0); PG8_LDB(B1, 0, 1); PG8_SCHED; PG8_LDA(At, 0, 0); PG8_STAGE(PG8_SA(1, 1), a1 + hstep, voffA);
            PG8_WAIT_V(8); PG8_WAIT_L(0); PG8_BAR; PG8_MMA(0, 0, At, B0); PG8_MMA(0, 1, At, B1); PG8_BAR; PG8_SCHED;
            PG8_LDA(At, 0, 1); PG8_STAGE(PG8_SB(0, 0), b2, voffB); PG8_STAGE(PG8_SB(0, 1), b2 + hstep, voffB); PG8_STAGE(PG8_SA(0, 0), a2, voffA);
            PG8_WAIT_V(8); PG8_WAIT_L(0); PG8_BAR; PG8_MMA(1, 0, At, B0); PG8_MMA(1, 1, At, B1); PG8_BAR; PG8_SCHED;
            PG8_LDB(B0, 1, 0); PG8_LDB(B1, 1, 1); PG8_SCHED; PG8_LDA(At, 1, 0); PG8_STAGE(PG8_SA(0, 1), a2 + hstep, voffA);
            PG8_WAIT_V(8); PG8_WAIT_L(0); PG8_BAR; PG8_MMA(0, 0, At, B0); PG8_MMA(0, 1, At, B1); PG8_BAR; PG8_SCHED;
            PG8_LDA(At, 1, 1); PG8_STAGE(PG8_SB(1, 0), b3, voffB); PG8_STAGE(PG8_SB(1, 1), b3 + hstep, voffB); PG8_STAGE(PG8_SA(1, 0), a3, voffA);
            PG8_WAIT_V(8); PG8_WAIT_L(0); PG8_BAR; PG8_MMA(1, 0, At, B0); PG8_MMA(1, 1, At, B1); PG8_BAR; PG8_SCHED;
            } else {
            PG8_LDB(B0, 0, 0); PG8_SCHED; PG8_LDA(At, 0, 0); PG8_STAGE(PG8_SA(1, 1), a1 + hstep, voffA);
            PG8_WAIT_L(8); PG8_BAR; PG8_WAIT_L(0); PG8_MMA(0, 0, At, B0); PG8_BAR; PG8_SCHED;
            PG8_LDB(B1, 0, 1); PG8_STAGE(PG8_SB(0, 0), b2, voffB);
            PG8_BAR; PG8_WAIT_L(0); PG8_MMA(0, 1, At, B1); PG8_BAR;
            PG8_LDA(At, 0, 1); PG8_STAGE(PG8_SA(0, 0), a2, voffA);
            PG8_BAR; PG8_WAIT_L(0); PG8_MMA(1, 0, At, B0); PG8_BAR; PG8_SCHED;
            PG8_STAGE(PG8_SB(0, 1), b2 + hstep, voffB);
            PG8_WAIT_V(6); PG8_BAR; PG8_MMA(1, 1, At, B1); PG8_BAR;
            PG8_LDB(B0, 1, 0); PG8_SCHED; PG8_LDA(At, 1, 0); PG8_STAGE(PG8_SA(0, 1), a2 + hstep, voffA);
            PG8_WAIT_L(8); PG8_BAR; PG8_WAIT_L(0); PG8_MMA(0, 0, At, B0); PG8_BAR; PG8_SCHED;
            PG8_LDB(B1, 1, 1); PG8_STAGE(PG8_SB(1, 0), b3, voffB);
            PG8_BAR; PG8_WAIT_L(0); PG8_MMA(0, 1, At, B1); PG8_BAR;
            PG8_LDA(At, 1, 1); PG8_STAGE(PG8_SA(1, 0), a3, voffA);
            PG8_BAR; PG8_WAIT_L(0); PG8_MMA(1, 0, At, B0); PG8_BAR; PG8_SCHED;
            PG8_STAGE(PG8_SB(1, 1), b3 + hstep, voffB);
            PG8_WAIT_V(6); PG8_BAR; PG8_MMA(1, 1, At, B1); PG8_BAR;
            }
        }
        if constexpr (ALIGN_EPI) { if (wr == 0) PG8_BAR; }
        E(acc, cur, ui, wr, wc, fr, fq); S.done(cur);
        if (!has_next) break;
#pragma unroll
        for (int a = 0; a < 2; ++a)
#pragma unroll
            for (int b = 0; b < 2; ++b)
#pragma unroll
                for (int m = 0; m < 4; ++m)
#pragma unroll
                    for (int n = 0; n < 2; ++n) acc[a][b][m][n] = (f32x4){0.f, 0.f, 0.f, 0.f};
        cur = nxt; cA = nA; cB = nB; ++ui;
        if constexpr (ALIGN_EPI) { if (wr == 1) PG8_BAR; }
    }
    PG8_WAIT_V(0);
    if constexpr (!ALIGN_EPI) { if (wr == 0) PG8_BAR; }
    PG8_BAR;
#undef PG8_SA
#undef PG8_SB
#undef PG8_STAGE
#undef PG8_LDA
#undef PG8_LDB
#undef PG8_MMA
#undef PG8_WAIT_V
#undef PG8_WAIT_L
#undef PG8_BAR
#undef PG8_SCHED
}
}

constexpr int BATCH = 8, SEQ = 2048, D = 1024, M = BATCH * SEQ;
constexpr int FF = 2816, DRNN = 1280, NBLK = 10, RBLK = 128, CONVW = 4;
constexpr int NHEAD = 16, HD = 64, NGRP = 3, NQKV = 9216;
constexpr float RMS_EPS = 1e-6f;
constexpr float LOG2E = 1.4426950408889634f;
constexpr int NWAVES = 8;

typedef unsigned short bf16;
typedef unsigned v4u __attribute__((ext_vector_type(4)));
typedef unsigned v2u __attribute__((ext_vector_type(2)));
typedef float f32x4 __attribute__((ext_vector_type(4)));
#define GAS __attribute__((address_space(1)))
#define LAS __attribute__((address_space(3)))
typedef GAS unsigned gu32;
#define RLX_AGENT __ATOMIC_RELAXED, __HIP_MEMORY_SCOPE_AGENT
#define LDS_WAIT() asm volatile("s_waitcnt lgkmcnt(0)" ::: "memory")

#ifndef RESID_BF16
#define RESID_BF16 1
#endif
constexpr size_t MiB = 1u << 20;
constexpr size_t WS_CTL = 0, CTL_ZERO_BYTES = 1 * MiB;
constexpr size_t WS_SSQ = 1 * MiB;
constexpr size_t WS_BIAS = 2 * MiB;
constexpr size_t WS_XB = 3 * MiB;
constexpr size_t WS_WO = 35 * MiB;
constexpr size_t WS_WQKV = 37 * MiB;
constexpr size_t WS_QKV = 55 * MiB;
constexpr size_t QKV_SLAB = (size_t)M * 1024 * 2;
constexpr size_t WS_LSE = 343 * MiB;
constexpr size_t WS_END = 352 * MiB;
constexpr size_t WS_WIN0 = 55 * MiB, WS_WOUT0 = 66 * MiB, WS_WIN1 = 72 * MiB, WS_WOUT1 = 83 * MiB, WS_WIN2 = 89 * MiB, WS_WOUT2 = 100 * MiB;
constexpr size_t WS_WRIN = 106 * MiB, WS_WROUT = 111 * MiB, WS_WA = 114 * MiB, WS_WX = 114 * MiB + 512 * 1024;
constexpr size_t WS_ACT = 115 * MiB;
constexpr size_t WS_G = 203 * MiB, WS_U = 243 * MiB, WS_Y = 283 * MiB;
constexpr size_t WS_ATT = WS_QKV + 3 * QKV_SLAB;
constexpr size_t WS_WOUT3 = 346 * MiB;
constexpr size_t WS_ACT3 = WS_QKV;
static_assert(WS_Y + (size_t)M * DRNN * 2 <= WS_LSE && WS_ACT + (size_t)M * FF * 2 <= WS_G && WS_WX + 327680 <= WS_ACT, "ws map");
static_assert(WS_QKV + 9 * QKV_SLAB == WS_LSE && WS_LSE + (size_t)3 * M * 16 * 4 <= WS_WOUT3 && WS_WOUT3 + (size_t)D * FF * 2 <= WS_END && RESID_BF16 == 1, "ws map");
constexpr int CW_BAR = 4096;

constexpr int RING_BYTES = 131072;
constexpr int RSTD_OFF = RING_BYTES + 1024, RSTD_MAX_UNITS = 9, GAIN_OFF = RSTD_OFF + RSTD_MAX_UNITS * 256 * 4;
constexpr int LDS_BYTES = 147456;
constexpr int MISC_OFF = LDS_BYTES - 128;
static_assert(GAIN_OFF + 512 <= LDS_BYTES - 128, "LDS map");

#define XB_TMO      128
#define XB_XCNT(j)  (256  + 64 * (j))
#define XB_XSUB(j)  (1280 + 64 * (j))
#define XB_XGEN(j)  (2304 + 64 * (j))
#define XB_TOP      3328
#define XB_TOPGEN   3392
#define XCD_BAR_WORDS 3456
#define XB_SPIN_CAP (1u << 18)
__device__ __forceinline__ unsigned xb_ld(unsigned* p)              { return __hip_atomic_load(p, __ATOMIC_RELAXED, __HIP_MEMORY_SCOPE_AGENT); }
__device__ __forceinline__ unsigned xb_add(unsigned* p, unsigned v) { return __hip_atomic_fetch_add(p, v, __ATOMIC_RELAXED, __HIP_MEMORY_SCOPE_AGENT); }
__device__ __forceinline__ unsigned xb_xcc_id() { return (unsigned)__builtin_amdgcn_s_getreg((3 << 11) | 20) & 0xFu; }
#define XB_SPIN(cond, bar) do { unsigned _sp = 0; while (cond) { __builtin_amdgcn_s_sleep(1); \
    if ((++_sp & 255u) == 0u) { if (xb_ld(&(bar)[XB_TMO])) break; if (_sp > XB_SPIN_CAP) { atomicAdd(&(bar)[XB_TMO], 1u); break; } } } } while (0)
struct XcdBarrier { unsigned* bar; unsigned x; volatile LAS unsigned* st; };
__device__ __forceinline__ XcdBarrier xcd_barrier_post(unsigned* bar, volatile LAS unsigned* st) {
    XcdBarrier b; b.bar = bar; b.x = xb_xcc_id(); b.st = st;
    if (threadIdx.x == 0) (void)xb_add(&bar[XB_XCNT(b.x)], 1u);
    return b;
}
__device__ __forceinline__ void xcd_barrier_complete(unsigned* bar, unsigned x, unsigned& nloc, unsigned& nx) {
    const unsigned G = gridDim.x * gridDim.y * gridDim.z;
    unsigned sum, cnt, mine, sp = 0u;
    for (;;) {
        sum = 0u; cnt = 0u; mine = 0u;
#pragma unroll
        for (unsigned j = 0; j < 16; ++j) { const unsigned c = xb_ld(&bar[XB_XCNT(j)]); sum += c; cnt += (c > 0u) ? 1u : 0u; mine = (j == x) ? c : mine; }
        if (sum == G) break;
        __builtin_amdgcn_s_sleep(1);
        if ((++sp & 255u) == 0u) { if (xb_ld(&bar[XB_TMO])) break; if (sp > XB_SPIN_CAP) { atomicAdd(&bar[XB_TMO], 1u); break; } }
    }
    nloc = mine > 0u ? mine : 1u; nx = cnt > 0u ? cnt : 1u;
}
__device__ __forceinline__ void xcd_barrier(const XcdBarrier& b) {
    asm volatile("s_waitcnt vmcnt(0)" ::: "memory");
    __syncthreads();
    if (threadIdx.x == 0) {
        unsigned* bar = b.bar;
        __builtin_amdgcn_s_waitcnt(0);
        unsigned nloc = b.st[0], nx = b.st[1];
        if (nloc == 0u) { xcd_barrier_complete(bar, b.x, nloc, nx); b.st[0] = nloc; b.st[1] = nx; }
        const unsigned old = xb_add(&bar[XB_XSUB(b.x)], 1u);
        const unsigned gen = old / nloc;
        if (old + 1u == (gen + 1u) * nloc) {
            __builtin_amdgcn_fence(__ATOMIC_RELEASE, "agent");
            asm volatile("s_waitcnt vmcnt(0)" ::: "memory");
            const unsigned og = xb_add(&bar[XB_TOP], 1u);
            const unsigned tg = og / nx;
            if (og + 1u == (tg + 1u) * nx) xb_add(&bar[XB_TOPGEN], 1u);
            else XB_SPIN(xb_ld(&bar[XB_TOPGEN]) == tg, bar);
            __builtin_amdgcn_fence(__ATOMIC_ACQUIRE, "agent");
            xb_add(&bar[XB_XGEN(b.x)], 1u);
            asm volatile("s_waitcnt vmcnt(0)" ::: "memory");
        } else {
            XB_SPIN(xb_ld(&bar[XB_XGEN(b.x)]) == gen, bar);
            __builtin_amdgcn_fence(__ATOMIC_ACQUIRE, "agent");
            asm volatile("s_waitcnt vmcnt(0)" ::: "memory");
        }
    }
    __syncthreads();
}

__device__ __forceinline__ unsigned f2bf(float f) { unsigned u = __builtin_bit_cast(unsigned, f); return (u + 0x7fffu + ((u >> 16) & 1u)) >> 16; }
__device__ __forceinline__ unsigned pk2(float lo, float hi) { return f2bf(lo) | (f2bf(hi) << 16); }
__device__ __forceinline__ float bf_lo(unsigned w) { return __builtin_bit_cast(float, w << 16); }
__device__ __forceinline__ float bf_hi(unsigned w) { return __builtin_bit_cast(float, w & 0xffff0000u); }
__device__ __forceinline__ float bf2f(bf16 v) { return __builtin_bit_cast(float, (unsigned)v << 16); }
__device__ __forceinline__ float wave_sum(float v) {
#pragma unroll
    for (int o = 1; o < 64; o <<= 1) v += __shfl_xor(v, o);
    return v;
}
__device__ __forceinline__ float fast_sigmoid(float x) { return __builtin_amdgcn_rcpf(1.f + __builtin_amdgcn_exp2f(-LOG2E * x)); }
__device__ __forceinline__ float row_rstd(const float* ssq, int row) {
    const f32x4* p = (const f32x4*)(ssq + (size_t)row * 16); const f32x4 a = p[0], b = p[1], c = p[2], d = p[3];
    const float s = ((a.x + a.y) + (a.z + a.w)) + ((b.x + b.y) + (b.z + b.w)) + ((c.x + c.y) + (c.z + c.w)) + ((d.x + d.y) + (d.z + d.w));
    return rsqrtf(s * (1.0f / D) + RMS_EPS);
}

typedef float f32x2 __attribute__((ext_vector_type(2)));
template <class Sched> __device__ __forceinline__ void fill_rstd(LAS unsigned char* lds, const Sched& S, const float* ssq, int tid) {
    LAS float* rt = (LAS float*)(lds + RSTD_OFF); pg8::Unit u;
    for (int i = 0; i < RSTD_MAX_UNITS && S.next(i, u); ++i)
        if ((tid >> 8) == (i & 1)) { const int r = tid & 255; rt[i * 256 + r] = row_rstd(ssq, u.pm * 256 + r); }
    __syncthreads();
}
using pg8::Unit;
__device__ __forceinline__ f32x2 silu_mul_pk(f32x2 g, f32x2 up) {
    const f32x2 t = g * (-LOG2E); f32x2 e; e.x = __builtin_amdgcn_exp2f(t.x); e.y = __builtin_amdgcn_exp2f(t.y);
    const f32x2 d = e + 1.0f; f32x2 r; r.x = __builtin_amdgcn_rcpf(d.x); r.y = __builtin_amdgcn_rcpf(d.y);
    return (g * r) * up;
}
struct EpiSwiGLU {
    static constexpr bool PERM = true;
    const LAS float* rtab; bf16* act; int skip;
    __device__ __forceinline__ void operator()(const f32x4 (&acc)[2][2][4][2], const Unit& u, int ui, int wr, int wc, int fr, int fq) const {
        if (skip == 1) return;
#pragma unroll
        for (int ai = 0; ai < 2; ++ai)
#pragma unroll
            for (int m = 0; m < 4; ++m) {
                const int rl = ai * 128 + wr * 64 + m * 16 + fr, row = u.pm * 256 + rl;
                const float rs = rtab[ui * 256 + rl];
                f32x2 v[4];
#pragma unroll
                for (int n = 0; n < 2; ++n)
#pragma unroll
                    for (int e = 0; e < 2; ++e) { const f32x2 g = (f32x2){acc[ai][0][m][n][2 * e], acc[ai][0][m][n][2 * e + 1]} * rs, up = (f32x2){acc[ai][1][m][n][2 * e], acc[ai][1][m][n][2 * e + 1]} * rs;
                        v[n * 2 + e] = silu_mul_pk(g, up); }
                v4u w; w.x = pg8::cvt_pk_bf16(v[0].x, v[0].y); w.y = pg8::cvt_pk_bf16(v[1].x, v[1].y); w.z = pg8::cvt_pk_bf16(v[2].x, v[2].y); w.w = pg8::cvt_pk_bf16(v[3].x, v[3].y);
                if (skip != 2 || w.x == 0x7fc17fc1u) *(v4u*)(act + (size_t)row * FF + u.pn * 128 + wc * 32 + 8 * fq) = w;
            }
    }
};
#ifndef RESID_BF16
#define RESID_BF16 1
#endif
struct EpiRes {
    static constexpr bool PERM = true;
    const float* xin; float* xout; bf16* xb; float* ssq; float scale; bool skip;
    __device__ __forceinline__ void operator()(const f32x4 (&acc)[2][2][4][2], const Unit& u, int ui, int wr, int wc, int fr, int fq) const {
        if (skip) return;
        if (xin) run<true>(acc, u, wr, wc, fr, fq); else run<false>(acc, u, wr, wc, fr, fq);
    }
    template <bool F32IN> __device__ __forceinline__ void run(const f32x4 (&acc)[2][2][4][2], const Unit& u, int wr, int wc, int fr, int fq) const {
#pragma unroll
        for (int ai = 0; ai < 2; ++ai) {
            f32x4 xv[4][2][2];
#pragma unroll
            for (int m = 0; m < 4; ++m)
#pragma unroll
                for (int bj = 0; bj < 2; ++bj) { const size_t off = (size_t)(u.pm * 256 + ai * 128 + wr * 64 + m * 16 + fr) * D + u.pn * 256 + bj * 128 + wc * 32 + 8 * fq;
                    if (F32IN) { xv[m][bj][0] = *(const f32x4*)(xin + off); xv[m][bj][1] = *(const f32x4*)(xin + off + 4); }
                    else { const v4u w = *(const v4u*)(xb + off); xv[m][bj][0] = (f32x4){bf_lo(w.x), bf_hi(w.x), bf_lo(w.y), bf_hi(w.y)}; xv[m][bj][1] = (f32x4){bf_lo(w.z), bf_hi(w.z), bf_lo(w.w), bf_hi(w.w)}; } }
#pragma unroll
            for (int m = 0; m < 4; ++m) {
                const int row = u.pm * 256 + ai * 128 + wr * 64 + m * 16 + fr;
                float ss = 0.f;
#pragma unroll
                for (int bj = 0; bj < 2; ++bj) {
                    const size_t off = (size_t)row * D + u.pn * 256 + bj * 128 + wc * 32 + 8 * fq;
                    const f32x4 y0 = xv[m][bj][0] + acc[ai][bj][m][0] * scale, y1 = xv[m][bj][1] + acc[ai][bj][m][1] * scale;
                    if (xout) { *(f32x4*)(xout + off) = y0; *(f32x4*)(xout + off + 4) = y1; }
                    v4u w; w.x = pg8::cvt_pk_bf16(y0[0], y0[1]); w.y = pg8::cvt_pk_bf16(y0[2], y0[3]); w.z = pg8::cvt_pk_bf16(y1[0], y1[1]); w.w = pg8::cvt_pk_bf16(y1[2], y1[3]);
                    *(v4u*)(xb + off) = w;
                    ss += (y0[0] * y0[0] + y0[1] * y0[1]) + (y0[2] * y0[2] + y0[3] * y0[3]) + (y1[0] * y1[0] + y1[1] * y1[1]) + (y1[2] * y1[2] + y1[3] * y1[3]);
                }
                ss += __shfl_xor(ss, 16); ss += __shfl_xor(ss, 32);
                if (fq == 0) ssq[(size_t)row * 16 + u.pn * 4 + wc] = ss;
            }
            asm volatile("" ::: "memory");
        }
    }
};
struct EpiRnnIn {
    static constexpr bool PERM = true;
    const LAS float* rtab; bf16* Gb; bf16* Ub;
    template <bool GATE> __device__ __forceinline__ void run(const f32x4 (&acc)[2][2][4][2], const Unit& u, int ui, int wr, int wc, int fr, int fq, bf16* dstb, int pc) const {
#pragma unroll
        for (int ai = 0; ai < 2; ++ai)
#pragma unroll
            for (int m = 0; m < 4; ++m) {
                const int rl = ai * 128 + wr * 64 + m * 16 + fr, row = u.pm * 256 + rl;
                const float rs = rtab[ui * 256 + rl];
#pragma unroll
                for (int bj = 0; bj < 2; ++bj) {
                    f32x2 v[4];
#pragma unroll
                    for (int n = 0; n < 2; ++n)
#pragma unroll
                        for (int e = 0; e < 2; ++e) { f32x2 x = (f32x2){acc[ai][bj][m][n][2 * e], acc[ai][bj][m][n][2 * e + 1]} * rs;
                            if (GATE) {
                                const f32x2 t = (x * x * 0.044715f + 1.0f) * x * (-1.5957691216057308f * LOG2E); f32x2 ex; ex.x = __builtin_amdgcn_exp2f(t.x); ex.y = __builtin_amdgcn_exp2f(t.y);
                                const f32x2 d = ex + 1.0f; f32x2 r; r.x = __builtin_amdgcn_rcpf(d.x); r.y = __builtin_amdgcn_rcpf(d.y); x = x * r; }
                            v[n * 2 + e] = x; }
                    v4u w; w.x = pg8::cvt_pk_bf16(v[0].x, v[0].y); w.y = pg8::cvt_pk_bf16(v[1].x, v[1].y); w.z = pg8::cvt_pk_bf16(v[2].x, v[2].y); w.w = pg8::cvt_pk_bf16(v[3].x, v[3].y);
                    *(v4u*)(dstb + (size_t)row * DRNN + pc * 256 + bj * 128 + wc * 32 + 8 * fq) = w;
                }
            }
    }
    __device__ __forceinline__ void operator()(const f32x4 (&acc)[2][2][4][2], const Unit& u, int ui, int wr, int wc, int fr, int fq) const {
        if (u.pn < 5) run<true>(acc, u, ui, wr, wc, fr, fq, Gb, u.pn); else run<false>(acc, u, ui, wr, wc, fr, fq, Ub, u.pn - 5);
    }
};
struct EpiQKV {
    static constexpr bool PERM = true;
    const LAS float* rtab; const LAS float* gtab; bf16* qkv; bool skip;
    __device__ __forceinline__ void operator()(const f32x4 (&acc)[2][2][4][2], const Unit& u, int ui, int wr, int wc, int fr, int fq) const {
        if (skip) return;
        const int hs = u.pn * 4 + wc, kind = hs / 48, gh = hs - kind * 48, g = gh >> 4, h = gh & 15, l2d = 2 * g;
        bf16* slab = qkv + (size_t)(kind * 3 + g) * ((size_t)M * 1024);
        f32x4 gv[2][2];
#pragma unroll
        for (int bj = 0; bj < 2; ++bj)
#pragma unroll
            for (int n = 0; n < 2; ++n) { gv[bj][n] = (f32x4){1.f, 1.f, 1.f, 1.f}; if (kind < 2) gv[bj][n] = *(const LAS f32x4*)(gtab + kind * 64 + 32 * bj + 8 * fq + 4 * n); }
#pragma unroll
        for (int ai = 0; ai < 2; ++ai)
#pragma unroll
            for (int m = 0; m < 4; ++m) {
                const int rl = ai * 128 + wr * 64 + m * 16 + fr, row = u.pm * 256 + rl;
                const float rs = rtab[ui * 256 + rl];
                f32x4 v[2][2]; float ss = 0.f;
#pragma unroll
                for (int bj = 0; bj < 2; ++bj)
#pragma unroll
                    for (int n = 0; n < 2; ++n) { v[bj][n] = acc[ai][bj][m][n] * rs; const f32x4 t = v[bj][n] * v[bj][n]; ss += (t[0] + t[1]) + (t[2] + t[3]); }
                float rn = 1.f;
                if (kind < 2) { ss += __shfl_xor(ss, 16); ss += __shfl_xor(ss, 32); rn = rsqrtf(ss * (1.0f / HD) + RMS_EPS); }
                const int b = row >> 11, t = row & 2047, rres = t & ((1 << l2d) - 1), l = t >> l2d, L = 2048 >> l2d;
                bf16* dst = slab + ((size_t)(b * 16 + h) * 2048 + rres * L + l) * 64 + 8 * fq;
#pragma unroll
                for (int bj = 0; bj < 2; ++bj) {
                    const f32x4 a0 = v[bj][0] * gv[bj][0] * rn, a1 = v[bj][1] * gv[bj][1] * rn;
                    v4u w; w.x = pg8::cvt_pk_bf16(a0[0], a0[1]); w.y = pg8::cvt_pk_bf16(a0[2], a0[3]); w.z = pg8::cvt_pk_bf16(a1[0], a1[1]); w.w = pg8::cvt_pk_bf16(a1[2], a1[3]);
                    *(v4u*)(dst + 32 * bj) = w;
                }
            }
    }
};

struct Args { const float* in[18]; float* out; unsigned char* ws; int ph_lo, ph_hi; };
enum { I_X = 0, I_NORMG, I_FFN_WIN, I_FFN_WOUT, I_RNN_WIN, I_CONV_W, I_CONV_B, I_WA, I_BA, I_WX, I_BX, I_LAM, I_RNN_WOUT, I_WQKV, I_QGAIN, I_KGAIN, I_WO, I_RELB };

struct Ctx { LAS unsigned char* lds; int tid, lane, wave, G, vcu; unsigned char* ws; };

typedef short v4i16_t __attribute__((ext_vector_type(4)));
__device__ __forceinline__ v4i16_t vtr16(const LAS unsigned char* p) { return __builtin_amdgcn_ds_read_tr16_b64_v4i16((LAS v4i16_t*)p); }
enum { CM_NONE = 0, CM_FFN = 1, CM_QKV = 2 };
__device__ __forceinline__ int colmap(int mode, int vr) {
    if (mode == CM_FFN) { const int pn = vr >> 8, w = vr & 255; return (w >> 7) * FF + 128 * pn + (w & 127); }
    if (mode == CM_QKV) { const int pn = vr >> 8, w = vr & 255, bj = w >> 7, wc = (w >> 5) & 3, j = w & 31; return 256 * pn + 64 * wc + 32 * bj + j; }
    return vr;
}
__device__ __forceinline__ void transpose_item(const float* W, int K, int N, const float* gvec, bf16* WT, int mode, LAS unsigned char* scr, int item, int lane) {
    const int nblk = N / 64, kb = item / nblk, nb = item - kb * nblk, k0 = 64 * kb, vr0 = 64 * nb;
    const int col4 = lane & 15, rsub = lane >> 4, nsrc = colmap(mode, vr0 + 32 * (col4 >> 3)) + (col4 & 7) * 4;
    const float* src = W + (size_t)(k0 + rsub) * N + nsrc;
    f32x4 w[16];
#pragma unroll
    for (int i = 0; i < 16; ++i) w[i] = __builtin_nontemporal_load((const GAS f32x4*)(src + (size_t)(4 * i) * N));
    if (gvec) {
#pragma unroll
        for (int i = 0; i < 16; ++i) w[i] = w[i] * gvec[k0 + 4 * i + rsub];
    }
#pragma unroll
    for (int i = 0; i < 16; ++i) { v2u p; p.x = pg8::cvt_pk_bf16(w[i][0], w[i][1]); p.y = pg8::cvt_pk_bf16(w[i][2], w[i][3]);
        *(LAS v2u*)(scr + (col4 >> 3) * 4096 + (4 * i + rsub) * 64 + (col4 & 7) * 8) = p; }
    const int q = (lane & 15) >> 2, p4 = lane & 3, gidx = lane >> 4;
#pragma unroll
    for (int r = 0; r < 8; ++r) { const int nb16 = r >> 1, kh = r & 1, kbase = 32 * kh + 8 * gidx;
        const LAS unsigned char* a = scr + (nb16 >> 1) * 4096 + (kbase + q) * 64 + ((nb16 & 1) * 16 + 4 * p4) * 2;
        const v4i16_t lo = vtr16(a), hi = vtr16(a + 4 * 64);
        v4u o; { const v2u l2 = __builtin_bit_cast(v2u, lo), h2 = __builtin_bit_cast(v2u, hi); o.x = l2.x; o.y = l2.y; o.z = h2.x; o.w = h2.y; }
        *(GAS v4u*)(WT + (size_t)(vr0 + nb16 * 16 + (lane & 15)) * K + k0 + kbase) = o; }
}
struct MatJob { const float* W; int K, N; const float* g; bf16* WT; int mode; };
__device__ __forceinline__ MatJob mat_job(const Ctx& C, const Args& a, int idx) {
    unsigned char* ws = C.ws; const float* ng = a.in[I_NORMG]; MatJob j;
    switch (idx) {
    case 0: j = MatJob{a.in[I_FFN_WIN] + (size_t)0 * D * 2 * FF, D, 2 * FF, ng + 0 * D, (bf16*)(ws + WS_WIN0), CM_FFN}; break;
    case 1: j = MatJob{a.in[I_FFN_WOUT] + (size_t)0 * FF * D, FF, D, nullptr, (bf16*)(ws + WS_WOUT0), CM_NONE}; break;
    case 2: j = MatJob{a.in[I_RNN_WIN], D, 2 * DRNN, ng + 1 * D, (bf16*)(ws + WS_WRIN), CM_NONE}; break;
    case 3: j = MatJob{a.in[I_RNN_WOUT], DRNN, D, nullptr, (bf16*)(ws + WS_WROUT), CM_NONE}; break;
    case 4: j = MatJob{a.in[I_FFN_WIN] + (size_t)1 * D * 2 * FF, D, 2 * FF, ng + 2 * D, (bf16*)(ws + WS_WIN1), CM_FFN}; break;
    case 5: j = MatJob{a.in[I_FFN_WOUT] + (size_t)1 * FF * D, FF, D, nullptr, (bf16*)(ws + WS_WOUT1), CM_NONE}; break;
    case 6: j = MatJob{a.in[I_WQKV], D, NQKV, ng + 4 * D, (bf16*)(ws + WS_WQKV), CM_QKV}; break;
    case 7: j = MatJob{a.in[I_WO], D, D, nullptr, (bf16*)(ws + WS_WO), CM_NONE}; break;
    case 8: j = MatJob{a.in[I_FFN_WIN] + (size_t)2 * D * 2 * FF, D, 2 * FF, ng + 3 * D, (bf16*)(ws + WS_WIN2), CM_FFN}; break;
    case 9: j = MatJob{a.in[I_FFN_WOUT] + (size_t)2 * FF * D, FF, D, nullptr, (bf16*)(ws + WS_WOUT2), CM_NONE}; break;
    case 10: j = MatJob{a.in[I_FFN_WIN] + (size_t)3 * D * 2 * FF, D, 2 * FF, ng + 5 * D, (bf16*)a.out, CM_FFN}; break;
    default: j = MatJob{a.in[I_FFN_WOUT] + (size_t)3 * FF * D, FF, D, nullptr, (bf16*)(ws + WS_WOUT3), CM_NONE}; break;
    }
    return j;
}
__device__ __forceinline__ void convert_mats(const Ctx& C, const Args& a, int first, int last, int gw, int NGW) {
    LAS unsigned char* scr = C.lds + C.wave * 8192;
    int base = 0;
    for (int mi = first; mi < last; ++mi) {
        const MatJob j = mat_job(C, a, mi); const int cnt = (j.K / 64) * (j.N / 64);
        int it = (gw - base) % NGW; if (it < 0) it += NGW;
        for (; it < cnt; it += NGW) transpose_item(j.W, j.K, j.N, j.g, j.WT, j.mode, scr, it, C.lane);
        base += cnt;
    }
}
__device__ __forceinline__ void spare_convert(const Ctx& C, const Args& a, int first, int last, int nwg) {
    const int R = (nwg + C.G - 1) / C.G, first_spare = nwg - (R - 1) * C.G, nspare = C.G - first_spare, c = (int)blockIdx.x;
    if (nspare > 0) { if (c >= first_spare) convert_mats(C, a, first, last, (c - first_spare) * NWAVES + C.wave, nspare * NWAVES); }
    else convert_mats(C, a, first, last, c * NWAVES + C.wave, C.G * NWAVES);
    __syncthreads();
}
__device__ __forceinline__ int t5_bucket(int n) {
    if (n < 16) return n;
    int b = 16;
    b += (n >= 22) + (n >= 30) + (n >= 40) + (n >= 54) + (n >= 73) + (n >= 99) + (n >= 134) + (n >= 182) + (n >= 246) + (n >= 332) + (n >= 450) + (n >= 609) + (n >= 825) + (n >= 1117) + (n >= 1513);
    return b;
}
__device__ __forceinline__ void p_prologue(const Ctx& C, const Args& a) {
    const int gw = C.vcu * NWAVES + C.wave, NGW = C.G * NWAVES;
    convert_mats(C, a, 0, 1, gw, NGW);
    {   LAS unsigned char* scr = C.lds + C.wave * 8192;
        for (int it = gw; it < 2 * NBLK * 4; it += NGW) { const int which = it / (NBLK * 4), r = it % (NBLK * 4), blk = r >> 2, sub = r & 3;
            const float* W = (which ? a.in[I_WX] : a.in[I_WA]) + (size_t)blk * RBLK * RBLK; bf16* WT = (bf16*)(C.ws + (which ? WS_WX : WS_WA)) + (size_t)blk * RBLK * RBLK;
            transpose_item(W, RBLK, RBLK, nullptr, WT, CM_NONE, scr, sub, C.lane); } }
    const float* x = a.in[I_X]; bf16* xb = (bf16*)(C.ws + WS_XB); float* ssq = (float*)(C.ws + WS_SSQ);
    for (int m = gw; m < M; m += NGW) {
        const GAS f32x4* xr = (const GAS f32x4*)(x + (size_t)m * D) + C.lane; f32x4 v[4]; float s = 0.f;
#pragma unroll
        for (int j = 0; j < 4; ++j) { v[j] = __builtin_nontemporal_load(xr + 64 * j); s += (v[j].x * v[j].x + v[j].y * v[j].y) + (v[j].z * v[j].z + v[j].w * v[j].w); }
        s = wave_sum(s);
        GAS v2u* o8 = (GAS v2u*)(xb + (size_t)m * D) + C.lane;
#pragma unroll
        for (int j = 0; j < 4; ++j) { v2u w; w.x = pk2(v[j].x, v[j].y); w.y = pk2(v[j].z, v[j].w); o8[64 * j] = w; }
        if (C.lane < 16) ssq[(size_t)m * 16 + C.lane] = (C.lane == 0) ? s : 0.f;
    }
    float* bt = (float*)(C.ws + WS_BIAS); const float* rb = a.in[I_RELB];
    for (int i = blockIdx.x * 512 + C.tid; i < 48 * 129; i += C.G * 512) { const int gh = i / 129, dist = i - gh * 129, g = gh >> 4;
        bt[gh * 132 + dist] = rb[t5_bucket(dist << (2 * g)) * 48 + gh] * LOG2E; }
}

typedef float f32x16 __attribute__((ext_vector_type(16)));
typedef short bf16x8v __attribute__((ext_vector_type(8)));
constexpr int RM_WB = 0, RM_WB_GATE = 64 * 272, RM_CW = 36864, RM_CMP = RM_CW + 2560, RM_TILE = 49152, RM_TILE_BYTES = 36 * 256, RM_END = RM_TILE + 8 * RM_TILE_BYTES;
static_assert(RM_WB + 2 * RM_WB_GATE <= RM_CW && RM_CMP + 2 * 2 * 8 * 64 * 4 <= RM_TILE && RM_END <= RING_BYTES, "rnn-mid LDS map");
__device__ __forceinline__ bf16x8v pack8(const float (&v)[8]) {
    v4u w; w.x = pg8::cvt_pk_bf16(v[0], v[1]); w.y = pg8::cvt_pk_bf16(v[2], v[3]); w.z = pg8::cvt_pk_bf16(v[4], v[5]); w.w = pg8::cvt_pk_bf16(v[6], v[7]);
    return __builtin_bit_cast(bf16x8v, w);
}
__device__ __forceinline__ void p_rnn_mid(const Ctx& C, const Args& a) {
    const bf16* U = (const bf16*)(C.ws + WS_U); const bf16* Gb = (const bf16*)(C.ws + WS_G); bf16* Y = (bf16*)(C.ws + WS_Y);
    const bf16* WAb = (const bf16*)(C.ws + WS_WA); const bf16* WXb = (const bf16*)(C.ws + WS_WX);
    LAS unsigned char* L = C.lds;
    LAS float* CW = (LAS float*)(L + RM_CW); LAS float* CMP = (LAS float*)(L + RM_CMP);
    const int wave = C.wave;
    LAS unsigned char* wt = L + RM_TILE + wave * RM_TILE_BYTES;
    for (int item = blockIdx.x; item < BATCH * NBLK * 2; item += C.G) {
        const int b = item / (NBLK * 2), n = (item % (NBLK * 2)) >> 1, half = item & 1;
        int tid = C.tid; asm volatile("" : "+v"(tid));
        const int lane = tid & 63, r32 = lane & 31, hh = lane >> 5;
        __syncthreads();
#pragma unroll
        for (int p = 0; p < 4; ++p) { const int idx = p * 512 + tid, gate = idx >> 10, rem = idx & 1023, row = rem >> 4, c16 = rem & 15;
            const v4u w = *(const v4u*)((gate ? WXb : WAb) + (size_t)(n * 128 + 64 * half + row) * 128 + c16 * 8);
            *(LAS v4u*)(L + RM_WB + gate * RM_WB_GATE + row * 272 + c16 * 16) = w; }
        CW[tid] = a.in[I_CONV_W][(tid >> 7) * DRNN + n * 128 + (tid & 127)];
        if (tid < 128) CW[512 + tid] = a.in[I_CONV_B][n * 128 + tid];
        __syncthreads();
        float ba[2], bx[2], spl[2], Ht[2];
#pragma unroll
        for (int cb = 0; cb < 2; ++cb) { const int ch = n * 128 + 64 * half + 32 * cb + r32; ba[cb] = a.in[I_BA][ch]; bx[cb] = a.in[I_BX][ch];
            spl[cb] = -8.0f * LOG2E * log1pf(expf(-a.in[I_LAM][ch])); Ht[cb] = 0.f; }
        bf16x8v idf[2];
#pragma unroll
        for (int sp = 0; sp < 2; ++sp)
#pragma unroll
            for (int j = 0; j < 8; ++j) idf[sp][j] = (16 * sp + 8 * hh + j == r32) ? (short)0x3F80 : (short)0;
        const int urow = lane >> 4, uch = lane & 15, grow = lane >> 3, gch = lane & 7;
        v4u uraw[9], graw[4];
#define RM_LOADU(TILE) do { const int tp_ = (TILE) * 256 + wave * 32; const int ub_ = (b * SEQ + tp_ - 3 + urow) * DRNN + n * 128 + uch * 8;        \
        _Pragma("unroll") for (int i_ = 0; i_ < 9; ++i_) uraw[i_] = *(const v4u*)(U + (ptrdiff_t)(ub_ + i_ * 4 * DRNN)); \
        if (tp_ == 0 && urow < 3) uraw[0] = (v4u){0u, 0u, 0u, 0u};         } while (0)
#define RM_LOADG(TILE) do { const int gb_ = (b * SEQ + (TILE) * 256 + wave * 32 + grow) * DRNN + n * 128 + 64 * half + gch * 8; \
        _Pragma("unroll") for (int i_ = 0; i_ < 4; ++i_) graw[i_] = *(const v4u*)(Gb + (unsigned)(gb_ + i_ * 8 * DRNN)); } while (0)
        for (int tile = 0; tile < 8; ++tile) {
            const int tposw = tile * 256 + wave * 32;
            const size_t tok0 = (size_t)b * SEQ + tposw;
            LAS float* CWt = CW; LAS unsigned char* WBt = L + RM_WB; asm volatile("" : "+v"(CWt), "+v"(WBt));
            RM_LOADU(tile); RM_LOADG(tile);
#pragma unroll
            for (int i = 0; i < 9; ++i) { const int rl = 4 * i + urow; *(LAS v4u*)(wt + rl * 256 + ((uch ^ (rl & 15)) << 4)) = uraw[i]; }
            {
                const int tg = lane >> 4, cc = lane & 15;
                f32x2 wv[4][4], bv2[4];
#pragma unroll
                for (int k = 0; k < 4; ++k) { const f32x4 w0 = *(const LAS f32x4*)(CWt + k * 128 + 8 * cc), w1 = *(const LAS f32x4*)(CWt + k * 128 + 8 * cc + 4);
                    wv[k][0] = (f32x2){w0[0], w0[1]}; wv[k][1] = (f32x2){w0[2], w0[3]}; wv[k][2] = (f32x2){w1[0], w1[1]}; wv[k][3] = (f32x2){w1[2], w1[3]}; }
                { const f32x4 b0 = *(const LAS f32x4*)(CWt + 512 + 8 * cc), b1 = *(const LAS f32x4*)(CWt + 512 + 8 * cc + 4);
                  bv2[0] = (f32x2){b0[0], b0[1]}; bv2[1] = (f32x2){b0[2], b0[3]}; bv2[2] = (f32x2){b1[0], b1[1]}; bv2[3] = (f32x2){b1[2], b1[3]}; }
                v4u ur[11];
#pragma unroll
                for (int j = 0; j < 11; ++j) { const int rl = 8 * tg + j; ur[j] = *(const LAS v4u*)(wt + rl * 256 + ((cc ^ (rl & 15)) << 4)); }
                f32x2 o[8][4];
#pragma unroll
                for (int i = 0; i < 8; ++i)
#pragma unroll
                    for (int e = 0; e < 4; ++e) o[i][e] = bv2[e];
#pragma unroll
                for (int j = 0; j < 11; ++j) {
                    const f32x2 u0 = (f32x2){bf_lo(ur[j].x), bf_hi(ur[j].x)}, u1 = (f32x2){bf_lo(ur[j].y), bf_hi(ur[j].y)}, u2 = (f32x2){bf_lo(ur[j].z), bf_hi(ur[j].z)}, u3 = (f32x2){bf_lo(ur[j].w), bf_hi(ur[j].w)};
#pragma unroll
                    for (int k = 0; k < 4; ++k) { const int i = j - k; if (i >= 0 && i < 8) {
                        o[i][0] += wv[k][0] * u0; o[i][1] += wv[k][1] * u1; o[i][2] += wv[k][2] * u2; o[i][3] += wv[k][3] * u3; } }
                }
#pragma unroll
                for (int i = 0; i < 8; ++i) { const int rl = 8 * tg + i;
                    v4u w; w.x = pg8::cvt_pk_bf16(o[i][0].x, o[i][0].y); w.y = pg8::cvt_pk_bf16(o[i][1].x, o[i][1].y); w.z = pg8::cvt_pk_bf16(o[i][2].x, o[i][2].y); w.w = pg8::cvt_pk_bf16(o[i][3].x, o[i][3].y);
                    *(LAS v4u*)(wt + rl * 256 + ((cc ^ (rl & 15)) << 4)) = w; }
            }
            bf16x8v af[8];
#pragma unroll
            for (int s = 0; s < 8; ++s) af[s] = *(const LAS bf16x8v*)(wt + r32 * 256 + (((2 * s + hh) ^ (r32 & 15)) << 4));
#pragma unroll
            for (int i = 0; i < 4; ++i) *(LAS v4u*)(wt + (8 * i + grow) * 128 + gch * 16) = graw[i];
            f32x16 acc[2][2], ufa[2];
#pragma unroll
            for (int cb = 0; cb < 2; ++cb)
#pragma unroll
                for (int e = 0; e < 16; ++e) { acc[0][cb][e] = 0.f; acc[1][cb][e] = 0.f; ufa[cb][e] = 0.f; }
            bf16x8v bq[2][4];
#define RM_LDB(S, DST) do { _Pragma("unroll") for (int g_ = 0; g_ < 2; ++g_) _Pragma("unroll") for (int c_ = 0; c_ < 2; ++c_) \
                DST[g_ * 2 + c_] = *(const LAS bf16x8v*)(WBt + g_ * RM_WB_GATE + (32 * c_ + r32) * 272 + (16 * (S) + 8 * hh) * 2); } while (0)
            RM_LDB(0, bq[0]);
#pragma unroll
            for (int s = 0; s < 8; ++s) {
                if (s < 7) RM_LDB(s + 1, bq[(s + 1) & 1]);
#pragma unroll
                for (int gt = 0; gt < 2; ++gt)
#pragma unroll
                    for (int cb = 0; cb < 2; ++cb) acc[gt][cb] = __builtin_amdgcn_mfma_f32_32x32x16_bf16(af[s], bq[s & 1][gt * 2 + cb], acc[gt][cb], 0, 0, 0);
            }
#undef RM_LDB
#pragma unroll
            for (int cb = 0; cb < 2; ++cb)
#pragma unroll
                for (int sp = 0; sp < 2; ++sp) { const bf16x8v asel = half ? af[4 + 2 * cb + sp] : af[2 * cb + sp];
                    ufa[cb] = __builtin_amdgcn_mfma_f32_32x32x16_bf16(asel, idf[sp], ufa[cb], 0, 0, 0); }
#pragma unroll
            for (int cb = 0; cb < 2; ++cb)
#pragma unroll
                for (int e = 0; e < 16; ++e) {
                    const float uf = ufa[cb][e];
                    const float r = fast_sigmoid(acc[0][cb][e] + ba[cb]), ii = fast_sigmoid(acc[1][cb][e] + bx[cb]);
                    const float av = __builtin_amdgcn_exp2f(r * spl[cb]);
                    const float bv = __builtin_amdgcn_sqrtf(fmaxf(1.f - av * av, 0.f)) * (ii * uf);
                    acc[0][cb][e] = av; acc[1][cb][e] = bv;
                }
            float A0[2][4], B0[2][4], A1[2][4], B1[2][4];
            const int par = tile & 1;
#pragma unroll
            for (int cb = 0; cb < 2; ++cb) {
                float Aw = 1.f, Bw = 0.f;
#pragma unroll
                for (int q = 0; q < 4; ++q) {
                    const float a0 = acc[0][cb][4 * q], a1 = acc[0][cb][4 * q + 1], a2 = acc[0][cb][4 * q + 2], a3 = acc[0][cb][4 * q + 3];
                    const float Ag = (a0 * a1) * (a2 * a3);
                    const float Bg = ((acc[1][cb][4 * q] * a1 + acc[1][cb][4 * q + 1]) * a2 + acc[1][cb][4 * q + 2]) * a3 + acc[1][cb][4 * q + 3];
                    const float pA = __shfl_xor(Ag, 32), pB = __shfl_xor(Bg, 32);
                    A0[cb][q] = hh ? pA : Ag; B0[cb][q] = hh ? pB : Bg; A1[cb][q] = hh ? Ag : pA; B1[cb][q] = hh ? Bg : pB;
                    Bw = Bw * A0[cb][q] + B0[cb][q]; Aw *= A0[cb][q]; Bw = Bw * A1[cb][q] + B1[cb][q]; Aw *= A1[cb][q];
                }
                if (hh == 0) { CMP[((par * 2 + 0) * 8 + wave) * 64 + 32 * cb + r32] = Aw; CMP[((par * 2 + 1) * 8 + wave) * 64 + 32 * cb + r32] = Bw; }
            }
            __syncthreads();
#pragma unroll
            for (int cb = 0; cb < 2; ++cb) {
                float h = Ht[cb], hin = 0.f;
#pragma unroll
                for (int v = 0; v < 8; ++v) { const float Av = CMP[((par * 2 + 0) * 8 + v) * 64 + 32 * cb + r32], Bv = CMP[((par * 2 + 1) * 8 + v) * 64 + 32 * cb + r32];
                    hin = (v == wave) ? h : hin; h = Av * h + Bv; }
                Ht[cb] = h;
                float hc = hin;
#pragma unroll
                for (int q = 0; q < 4; ++q) {
                    const float c0 = hc; hc = A0[cb][q] * hc + B0[cb][q]; const float c1 = hc; hc = A1[cb][q] * hc + B1[cb][q];
                    float hv = hh ? c1 : c0;
#pragma unroll
                    for (int i = 0; i < 4; ++i) { const int e = 4 * q + i; hv = acc[0][cb][e] * hv + acc[1][cb][e];
                        const int tl = (e & 3) + 8 * (e >> 2) + 4 * hh;
                        LAS bf16* gp = (LAS bf16*)(wt + tl * 128 + (32 * cb + r32) * 2);
                        *gp = (bf16)f2bf(hv * bf2f(*gp)); }
                }
            }
#pragma unroll
            for (int i = 0; i < 4; ++i) { const v4u w = *(const LAS v4u*)(wt + (8 * i + grow) * 128 + gch * 16);
                *(v4u*)(Y + (unsigned)(((int)tok0 + 8 * i + grow) * DRNN + n * 128 + 64 * half + gch * 8)) = w; }
        }
#undef RM_LOADU
#undef RM_LOADG
    }
    const int nitems = BATCH * NBLK * 2;
    if (C.G > nitems) { if ((int)blockIdx.x >= nitems) convert_mats(C, a, 4, 8, ((int)blockIdx.x - nitems) * NWAVES + wave, (C.G - nitems) * NWAVES); }
    else { __syncthreads(); convert_mats(C, a, 4, 8, (int)blockIdx.x * NWAVES + wave, C.G * NWAVES); }
}
struct AttnUnit { const bf16* qrows; const bf16* kres; const bf16* vres; int l0, kb_lo, eoff; };
__device__ __forceinline__ AttnUnit attn_unit(const bf16* QKV, int g, int bh, int llin0) {
    AttnUnit u; const size_t SLAB = (size_t)M * 1024; const int L = SEQ >> (2 * g);
    u.l0 = llin0 & (L - 1); u.kb_lo = (u.l0 - 128) > 0 ? (u.l0 - 128) : 0; u.eoff = g * 192;
    u.qrows = QKV + (size_t)g * SLAB + ((size_t)bh * SEQ + llin0) * HD;
    u.kres = u.qrows + 3 * SLAB - (size_t)u.l0 * HD; u.vres = u.qrows + 6 * SLAB - (size_t)u.l0 * HD;
    return u;
}
typedef __bf16 bf16x2n __attribute__((ext_vector_type(2)));
__device__ __forceinline__ unsigned cvtpk_n(float lo, float hi) { const f32x2 v = {lo, hi}; return __builtin_bit_cast(unsigned, __builtin_convertvector(v, bf16x2n)); }
constexpr int AT_VT = 0, AT_EXT = 8 * 8192, AT_LACC = AT_EXT + 3 * 192 * 4, AT_OACC = AT_EXT + 4608;
static_assert(AT_LACC + 512 * 4 <= AT_OACC && AT_OACC + 512 * 128 <= MISC_OFF, "attention LDS map");
#define AT_QBLOCK(QF, O0, O1, MROW, LSUM, EB) do { \
        f32x16 p_; _Pragma("unroll") for (int e = 0; e < 16; ++e) p_[e] = 0.f; \
        _Pragma("unroll") for (int s_ = 0; s_ < 4; ++s_) p_ = __builtin_amdgcn_mfma_f32_32x32x16_bf16(kf[s_], QF[s_], p_, 0, 0, 0); \
        float bm_ = -1e30f; \
        _Pragma("unroll") for (int e = 0; e < 16; ++e) { p_[e] += ext[(EB) - ((e & 3) + 8 * (e >> 2))]; bm_ = fmaxf(bm_, p_[e]); } \
        bm_ = fmaxf(bm_, __shfl_xor(bm_, 32)); \
        const float mn_ = fmaxf(MROW, bm_), alpha_ = __builtin_amdgcn_exp2f(MROW - mn_); MROW = mn_; \
        float ps_ = 0.f; \
        _Pragma("unroll") for (int e = 0; e < 16; ++e) { p_[e] = __builtin_amdgcn_exp2f(p_[e] - mn_); ps_ += p_[e]; } \
        LSUM = LSUM * alpha_ + ps_; \
        _Pragma("unroll") for (int e = 0; e < 16; ++e) { O0[e] *= alpha_; O1[e] *= alpha_; } \
        _Pragma("unroll") for (int s_ = 0; s_ < 2; ++s_) { \
            v4u w_; w_.x = cvtpk_n(p_[8 * s_], p_[8 * s_ + 1]); w_.y = cvtpk_n(p_[8 * s_ + 2], p_[8 * s_ + 3]); w_.z = cvtpk_n(p_[8 * s_ + 4], p_[8 * s_ + 5]); w_.w = cvtpk_n(p_[8 * s_ + 6], p_[8 * s_ + 7]); \
            const bf16x8v pf_ = __builtin_bit_cast(bf16x8v, w_); \
            const v4i16_t a00_ = vtr16(vt + (16 * s_) * 64 + vtr_off), a01_ = vtr16(vt + (16 * s_ + 8) * 64 + vtr_off), a10_ = vtr16(vt + 2048 + (16 * s_) * 64 + vtr_off), a11_ = vtr16(vt + 2048 + (16 * s_ + 8) * 64 + vtr_off); \
            O0 = __builtin_amdgcn_mfma_f32_32x32x16_bf16((bf16x8v){a00_[0], a00_[1], a00_[2], a00_[3], a01_[0], a01_[1], a01_[2], a01_[3]}, pf_, O0, 0, 0, 0); \
            O1 = __builtin_amdgcn_mfma_f32_32x32x16_bf16((bf16x8v){a10_[0], a10_[1], a10_[2], a10_[3], a11_[0], a11_[1], a11_[2], a11_[3]}, pf_, O1, 0, 0, 0); } \
    } while (0)
#define AT_COMBINE(MODE, O0, O1, MROW, LSUM, TL) do { \
        const float ltot_ = LSUM + __shfl_xor(LSUM, 32), inv_ = 1.f / ltot_, lse_ = MROW + log2f(ltot_); const int tl_ = (TL); \
        LAS unsigned char* orow_ = C.lds + AT_OACC + tl_ * 128; LAS float* lacc_ = (LAS float*)(C.lds + AT_LACC); \
        float wo_ = 0.f, wn_ = inv_; \
        if (MODE != 0) { const float lo_ = lacc_[tl_], mx_ = fmaxf(lo_, lse_), eo_ = __builtin_amdgcn_exp2f(lo_ - mx_), en_ = __builtin_amdgcn_exp2f(lse_ - mx_), rs_ = 1.f / (eo_ + en_); \
            wo_ = eo_ * rs_; wn_ = en_ * rs_ * inv_; if (MODE == 1 && hh == 0) lacc_[tl_] = mx_ + log2f(eo_ + en_); } \
        else if (hh == 0) lacc_[tl_] = lse_; \
        _Pragma("unroll") for (int q = 0; q < 4; ++q) { \
            LAS v2u* p0_ = (LAS v2u*)(orow_ + ((q ^ (tl_ & 7)) << 4) + 8 * hh); LAS v2u* p1_ = (LAS v2u*)(orow_ + (((4 + q) ^ (tl_ & 7)) << 4) + 8 * hh); \
            float a_[8] = {O0[4 * q] * wn_, O0[4 * q + 1] * wn_, O0[4 * q + 2] * wn_, O0[4 * q + 3] * wn_, O1[4 * q] * wn_, O1[4 * q + 1] * wn_, O1[4 * q + 2] * wn_, O1[4 * q + 3] * wn_}; \
            if (MODE != 0) { const v2u c0_ = *p0_, c1_ = *p1_; \
                a_[0] += wo_ * bf_lo(c0_.x); a_[1] += wo_ * bf_hi(c0_.x); a_[2] += wo_ * bf_lo(c0_.y); a_[3] += wo_ * bf_hi(c0_.y); \
                a_[4] += wo_ * bf_lo(c1_.x); a_[5] += wo_ * bf_hi(c1_.x); a_[6] += wo_ * bf_lo(c1_.y); a_[7] += wo_ * bf_hi(c1_.y); } \
            v2u w0_, w1_; w0_.x = cvtpk_n(a_[0], a_[1]); w0_.y = cvtpk_n(a_[2], a_[3]); w1_.x = cvtpk_n(a_[4], a_[5]); w1_.y = cvtpk_n(a_[6], a_[7]); \
            if (MODE != 2) { *p0_ = w0_; *p1_ = w1_; } \
            else { bf16* g_ = ATT + (size_t)(row0 + tl_) * 1024 + h * 64 + 8 * q + 4 * hh; *(v2u*)g_ = w0_; *(v2u*)(g_ + 32) = w1_; } } \
    } while (0)
__device__ __forceinline__ void p_attn(const Ctx& C, bf16* ATT) {
    const bf16* QKV = (const bf16*)(C.ws + WS_QKV); const float* bt = (const float*)(C.ws + WS_BIAS);
    LAS float* ext = (LAS float*)(C.lds + AT_EXT);
    LAS unsigned char* vt = C.lds + AT_VT + C.wave * 8192; LAS unsigned char* kt = vt + 4096;
    const int wave = C.wave;
    v4u kfn[4], vvn[4];
#define AT_LOADKV(U, KB) do { const bf16* kblk_ = (U).kres + (size_t)(KB) * HD; const bf16* vblk_ = (U).vres + (size_t)(KB) * HD; \
        _Pragma("unroll") for (int i_ = 0; i_ < 4; ++i_) { vvn[i_] = *(const v4u*)(vblk_ + (8 * i_ + crow8) * HD + cch * 8); kfn[i_] = *(const v4u*)(kblk_ + (8 * i_ + crow8) * HD + cch * 8); } } while (0)
#define AT_TILE2FRAG(RAW, OFS, FR) do { _Pragma("unroll") for (int i_ = 0; i_ < 4; ++i_) *(LAS v4u*)(kt + (8 * i_ + crow8) * 128 + ((cch ^ crow8) << 4)) = RAW[(OFS) + i_]; \
        _Pragma("unroll") for (int s_ = 0; s_ < 4; ++s_) FR[s_] = *(const LAS bf16x8v*)(kt + r32 * 128 + (((2 * s_ + hh) ^ (r32 & 7)) << 4)); } while (0)
#define AT_LOADQFRAG(U, ROW0, FR) do { v4u q_[4]; _Pragma("unroll") for (int i_ = 0; i_ < 4; ++i_) q_[i_] = *(const v4u*)((U).qrows + ((ROW0) + 8 * i_ + crow8) * HD + cch * 8); AT_TILE2FRAG(q_, 0, FR); } while (0)
#define AT_STEP(KB, USEA, USEB) do { const int kb_ = (KB); \
            v4u vv[4], kraw[4]; bf16x8v kf[4]; \
            _Pragma("unroll") for (int i = 0; i < 4; ++i) { vv[i] = vvn[i]; kraw[i] = kfn[i]; } \
            if (kb_ - 32 >= cu.kb_lo) { AT_LOADKV(cu, kb_ - 32); } else if (has_next) { AT_LOADKV(nu, nu.l0); AT_LOADQ(nu); } \
            _Pragma("unroll") for (int i = 0; i < 4; ++i) *(LAS v4u*)(vt + (cch >> 2) * 2048 + (8 * i + crow8) * 64 + (cch & 3) * 16) = vv[i]; \
            AT_TILE2FRAG(kraw, 0, kf); \
            const int ebA = cu.eoff + cu.l0 + r32 - kb_ - 4 * hh + 32;            \
            if (USEA) { AT_QBLOCK(qfA, oA0, oA1, mA, lA, ebA); } \
        } while (0)
#define AT_ZERO(O0, O1, MR, LS) do { _Pragma("unroll") for (int e = 0; e < 16; ++e) { O0[e] = 0.f; O1[e] = 0.f; } MR = -1e30f; LS = 0.f; } while (0)
#define AT_DESC(V, STEP, U) do { const int v_ = (V), st_ = (STEP), bh_ = (v_ >> 1) & 127, sx_ = ((v_ & 1) << 1) | (v_ >> 8), s_ = (sx_ == 0) ? 0 : (sx_ == 1) ? 3 : (sx_ == 2) ? 1 : 2, g_ = st_ >> 1, j_ = st_ & 1; \
        const int ll_ = (g_ == 0) ? 512 * s_ + 64 * wave + 32 * j_ : (g_ == 1) ? (wave >> 1) * 512 + 128 * s_ + 64 * (wave & 1) + 32 * j_ : (2 * wave + j_) * 128 + 32 * s_; \
        U = attn_unit(QKV, g_, bh_, ll_); } while (0)
#define AT_LOADQ(U) do { _Pragma("unroll") for (int i_ = 0; i_ < 4; ++i_) qraw[i_] = *(const v4u*)((U).qrows + (8 * i_ + crow8) * HD + cch * 8); } while (0)
    const int total = BATCH * NHEAD * 4;
    if ((int)blockIdx.x >= total) return;
    AttnUnit nu; v4u qraw[4];
    {   const int lane = C.lane, crow8 = lane >> 3, cch = lane & 7;
        AT_DESC(blockIdx.x, 0, nu); AT_LOADKV(nu, nu.l0); AT_LOADQ(nu); }
    for (int v = blockIdx.x; v < total; v += C.G) {
        int tid = C.tid; asm volatile("" : "+v"(tid));
        const int lane = tid & 63, r32 = lane & 31, hh = lane >> 5;
        const int crow8 = lane >> 3, cch = lane & 7;
        const int vtr_off = (4 * hh + ((lane & 15) >> 2)) * 64 + ((lane >> 4) & 1) * 32 + (lane & 3) * 8;
        const int bh = (v >> 1) & 127, sidx = ((v & 1) << 1) | (v >> 8), s = (sidx == 0) ? 0 : (sidx == 1) ? 3 : (sidx == 2) ? 1 : 2, h = bh & 15;
        const int row0 = (bh >> 4) * SEQ + 512 * s;
        __syncthreads();
        for (int i = tid; i < 3 * 192; i += 512) { const int g = i / 192, dist = i - g * 192 - 32; ext[i] = (dist >= 0 && dist <= 128) ? bt[(g * 16 + h) * 132 + dist] : -1e30f; }
        __syncthreads();
        f32x16 oA0, oA1; float mA, lA; bf16x8v qfA[4];
#pragma unroll 1
        for (int step = 0; step < 6; ++step) {
            const int g = step >> 1, j = step & 1;
            const int tl = (g == 0) ? 64 * wave + 32 * j + r32 : (g == 1) ? 256 * (wave & 1) + (wave >> 1) + 4 * (32 * j + r32) : 16 * r32 + 2 * wave + j;
            const AttnUnit cu = nu;
            const bool has_next = (step < 5) || (v + C.G < total);
            if (has_next) { if (step < 5) AT_DESC(v, step + 1, nu); else AT_DESC(v + C.G, 0, nu); }
            AT_TILE2FRAG(qraw, 0, qfA);
            AT_ZERO(oA0, oA1, mA, lA);
            for (int kb = cu.l0; kb >= cu.kb_lo; kb -= 32) AT_STEP(kb, true, false);
            AT_COMBINE(g, oA0, oA1, mA, lA, tl);
            if (j == 1 && g < 2) __syncthreads();
        }
    }
#undef AT_DESC
#undef AT_LOADQ
#undef AT_LOADKV
#undef AT_TILE2FRAG
#undef AT_LOADQFRAG
#undef AT_STEP
#undef AT_ZERO
}
#undef AT_QBLOCK
#undef AT_COMBINE
enum { PH_PROLOGUE = 0, PH_FFN_IN_0, PH_FFN_OUT_0, PH_RNN_IN, PH_RNN_MID, PH_RNN_OUT, PH_FFN_IN_1, PH_FFN_OUT_1,
       PH_FFN_IN_2, PH_FFN_OUT_2, PH_QKV, PH_ATTN, PH_WO, PH_FFN_IN_3, PH_FFN_OUT_3, NPHASE };

__global__ void __launch_bounds__(NWAVES * 64, 2) fwd_kernel(Args args) {
    extern __shared__ __attribute__((aligned(16))) unsigned char lds_raw[];
    Ctx C; C.lds = (LAS unsigned char*)lds_raw; C.tid = threadIdx.x; C.lane = C.tid & 63; C.wave = __builtin_amdgcn_readfirstlane(C.tid >> 6);
    C.G = gridDim.x; { const int bx = blockIdx.x; C.vcu = (C.G % 8 == 0) ? (bx % 8) * (C.G / 8) + bx / 8 : bx; }
    C.ws = args.ws;
    volatile LAS unsigned* MISC = (volatile LAS unsigned*)(C.lds + MISC_OFF);
    if (C.tid < 32) ((LAS unsigned*)(C.lds + MISC_OFF))[C.tid] = 0u;
    __syncthreads();
    unsigned* ctl = (unsigned*)args.ws;
    XcdBarrier bar; bar.bar = ctl + CW_BAR; bar.x = 0; bar.st = nullptr;
    const bool multi = (args.ph_hi - args.ph_lo) > 1;
    if (multi) bar = xcd_barrier_post(ctl + CW_BAR, MISC + 8);
    for (int ph = args.ph_lo; ph < args.ph_hi; ++ph) {
        for (int rep = ((DUP_MASK >> ph) & 1u) ? DUP_N : 0; rep >= 0; --rep) {
        const bool dry = rep > 0;
        { int t_ = threadIdx.x; asm volatile("" : "+v"(t_)); C.tid = t_; C.lane = t_ & 63; }
        unsigned char* ws = args.ws;
        C.ws = ws; float* ssq = (float*)(ws + WS_SSQ); bf16* xb = (bf16*)(ws + WS_XB);
        switch (ph) {
        case PH_PROLOGUE: p_prologue(C, args); break;
        case PH_FFN_IN_0: case PH_FFN_IN_1: case PH_FFN_IN_2: case PH_FFN_IN_3: {
            if (!dry && ph != PH_FFN_IN_3) { const int f = (ph == PH_FFN_IN_0) ? 1 : (ph == PH_FFN_IN_1) ? 8 : 10, l = (ph == PH_FFN_IN_0) ? 4 : (ph == PH_FFN_IN_1) ? 10 : 12; spare_convert(C, args, f, l, (M / 256) * (2 * FF / 256)); }
            const bf16* Bt = (ph == PH_FFN_IN_3) ? (const bf16*)args.out : (const bf16*)(ws + (ph == PH_FFN_IN_0 ? WS_WIN0 : ph == PH_FFN_IN_1 ? WS_WIN1 : WS_WIN2));
            bf16* act = (bf16*)(ws + (ph == PH_FFN_IN_3 ? WS_ACT3 : WS_ACT));
            pg8::Gemm g{xb, Bt, M, 2 * FF, D}; pg8::StaticOrder S; S.init(M, 2 * FF, C.G, (int)blockIdx.x);
            fill_rstd(C.lds, S, ssq, C.tid);
            EpiSwiGLU E{(const LAS float*)(C.lds + RSTD_OFF), act, dry ? DUP_SKIP_EPI : 0};
            pg8::gemm_phase<EpiSwiGLU, pg8::StaticOrder, true, true>(C.lds, g, S, E);
        } break;
        case PH_FFN_OUT_0: case PH_FFN_OUT_1: case PH_FFN_OUT_2: case PH_FFN_OUT_3: case PH_RNN_OUT: case PH_WO: {
            const bf16* A; const bf16* Bt; int K; float scale = 0.5f; const float* xin = args.out;
            if (ph == PH_FFN_OUT_0) { A = (const bf16*)(ws + WS_ACT); Bt = (const bf16*)(ws + WS_WOUT0); K = FF; xin = args.in[I_X]; }
            else if (ph == PH_FFN_OUT_1) { A = (const bf16*)(ws + WS_ACT); Bt = (const bf16*)(ws + WS_WOUT1); K = FF; }
            else if (ph == PH_FFN_OUT_2) { A = (const bf16*)(ws + WS_ACT); Bt = (const bf16*)(ws + WS_WOUT2); K = FF; }
            else if (ph == PH_FFN_OUT_3) { A = (const bf16*)(ws + WS_ACT3); Bt = (const bf16*)(ws + WS_WOUT3); K = FF; }
            else if (ph == PH_RNN_OUT) { A = (const bf16*)(ws + WS_Y); Bt = (const bf16*)(ws + WS_WROUT); K = DRNN; scale = 1.f; }
            else { A = (const bf16*)args.out + (size_t)8 * 1024 * 1024; Bt = (const bf16*)(ws + WS_WO); K = D; scale = 1.f; }
            if (dry && ph != PH_FFN_OUT_0) scale = 0.f;
            float* xo = args.out;
#if RESID_BF16
            if (ph != PH_FFN_OUT_0) xin = nullptr;
            if (ph != PH_FFN_OUT_3 || dry) xo = nullptr;
#endif
            pg8::Gemm g{A, Bt, M, D, K}; pg8::StaticOrder S; S.init(M, D, C.G, (int)blockIdx.x);
            EpiRes E{xin, xo, xb, ssq, scale, dry && DUP_SKIP_EPI};
            pg8::gemm_phase<EpiRes, pg8::StaticOrder, false, true>(C.lds, g, S, E);
        } break;
        case PH_RNN_IN: {
            pg8::Gemm g{xb, (const bf16*)(ws + WS_WRIN), M, 2 * DRNN, D}; pg8::StaticOrder S; S.init(M, 2 * DRNN, C.G, (int)blockIdx.x);
            fill_rstd(C.lds, S, ssq, C.tid);
            EpiRnnIn E{(const LAS float*)(C.lds + RSTD_OFF), (bf16*)(ws + WS_G), (bf16*)(ws + WS_U)};
            pg8::gemm_phase<EpiRnnIn, pg8::StaticOrder, true, true>(C.lds, g, S, E);
        } break;
        case PH_RNN_MID: p_rnn_mid(C, args); break;
        case PH_QKV: {
            pg8::Gemm g{xb, (const bf16*)(ws + WS_WQKV), M, NQKV, D}; pg8::StaticOrder S; S.init(M, NQKV, C.G, (int)blockIdx.x);
            if (C.tid < 128) ((LAS float*)(C.lds + GAIN_OFF))[C.tid] = (C.tid < 64) ? args.in[I_QGAIN][C.tid] * (0.125f * LOG2E) : args.in[I_KGAIN][C.tid - 64];
            fill_rstd(C.lds, S, ssq, C.tid);
            EpiQKV E{(const LAS float*)(C.lds + RSTD_OFF), (const LAS float*)(C.lds + GAIN_OFF), (bf16*)(ws + WS_QKV), dry && DUP_SKIP_EPI};
            pg8::gemm_phase<EpiQKV, pg8::StaticOrder, true, true>(C.lds, g, S, E);
        } break;
        case PH_ATTN: if (!dry) p_attn(C, (bf16*)args.out + (size_t)8 * 1024 * 1024); break;
        default: break;
        }
        if (dry || ph + 1 < args.ph_hi) xcd_barrier(bar);
        if (ph == 0 && !dry) for (int eb = 0; eb < DUP_EXTRA_BARRIERS; ++eb) xcd_barrier(bar);
        }
    }
}

extern "C" void kernel_launch(void* const* d_in, const int* in_sizes, int n_in, void* d_out, int out_size, void* d_ws, size_t ws_size, hipStream_t stream) {
    static int grid = 0;
    if (grid == 0) {
        if (n_in != 18 || in_sizes[0] != M * D || out_size != M * D || ws_size < WS_END) { fprintf(stderr, "kernel_launch: unexpected shapes (n_in %d, in0 %d, out %d, ws %zu)\n", n_in, n_in > 0 ? in_sizes[0] : -1, out_size, ws_size); grid = -1; return; }
        int dev = 0, cus = 0, per_cu = 0;
        if (hipGetDevice(&dev) != hipSuccess || hipDeviceGetAttribute(&cus, hipDeviceAttributeMultiprocessorCount, dev) != hipSuccess) { fprintf(stderr, "kernel_launch: device query failed\n"); grid = -1; return; }
        if (hipFuncSetAttribute((const void*)fwd_kernel, hipFuncAttributeMaxDynamicSharedMemorySize, LDS_BYTES) != hipSuccess) { fprintf(stderr, "kernel_launch: hipFuncSetAttribute failed\n"); grid = -1; return; }
        if (hipOccupancyMaxActiveBlocksPerMultiprocessor(&per_cu, (const void*)fwd_kernel, NWAVES * 64, LDS_BYTES) != hipSuccess || per_cu < 1) { fprintf(stderr, "kernel_launch: occupancy query says %d blocks per CU\n", per_cu); (void)hipGetLastError(); grid = -1; return; }
        grid = cus;
    }
    if (grid < 0) return;
    if (hipMemsetAsync(d_ws, 0, CTL_ZERO_BYTES, stream) != hipSuccess) { fprintf(stderr, "kernel_launch: memset failed\n"); return; }
    Args a{};
    for (int i = 0; i < 18; ++i) a.in[i] = (const float*)d_in[i];
    a.out = (float*)d_out; a.ws = (unsigned char*)d_ws;
#if SINGLE_LAUNCH
    a.ph_lo = 0; a.ph_hi = NPHASE;
    hipLaunchKernelGGL(fwd_kernel, dim3(grid), dim3(NWAVES * 64), LDS_BYTES, stream, a);
#else
    for (int ph = 0; ph < NPHASE; ++ph) { a.ph_lo = ph; a.ph_hi = ph + 1; hipLaunchKernelGGL(fwd_kernel, dim3(grid), dim3(NWAVES * 64), LDS_BYTES, stream, a); }
#endif
}
```

```cpp
#include <hip/hip_runtime.h>
#include <cstdio>
#include <cstdint>

#ifndef SINGLE_LAUNCH
#define SINGLE_LAUNCH 1
#define DUP_MASK 0u
#define DUP_N 1
#define DUP_EXTRA_BARRIERS 0
#define DUP_SKIP_EPI 0
#endif

namespace pg8 {
#define PG8_LAS __attribute__((address_space(3)))
typedef unsigned short bf16_t;
typedef short bf16x8 __attribute__((ext_vector_type(8)));
typedef float f32x4 __attribute__((ext_vector_type(4)));
typedef unsigned u32x4 __attribute__((ext_vector_type(4)));
constexpr int BM = 256, BK = 64, HALF = 128, HTB = HALF * BK * 2, STAGE_BYTES = 8 * HTB, NXCD = 8, WGM = 8;

__host__ __device__ __forceinline__ int lds_byte(int r, int c) { return (r >> 3) * 1024 + (r & 7) * 128 + ((((c >> 3) ^ (r & 7)) & 7) << 4) + (c & 7) * 2; }
__host__ __device__ __forceinline__ void stage_rc(int b, int& R, int& C) { const int sidx = b / 1024, w = b % 1024, rowin = w / 128, pch = (w % 128) / 16; R = sidx * 8 + rowin; C = ((pch ^ rowin) & 7) * 8; }
__host__ __device__ __forceinline__ int perm32(int rho) { const int n = rho >> 4, i = rho & 15; return 8 * (i >> 2) + 4 * n + (i & 3); }

struct Unit { int pm, pn; };
struct Gemm { const bf16_t* A; const bf16_t* Bt; int M, N, K; };

struct StaticOrder {
    int nM, nN, nwg, G, c;
    __host__ __device__ void init(int M, int N, int G_, int c_) { nM = M / BM; nN = N / BM; nwg = nM * nN; G = G_; c = c_; }
    __host__ __device__ bool next(int i, Unit& u) const {
        const long L = (long)i * G + c; if (L >= nwg) return false;
        int wgid = (int)L; { const int q = nwg / NXCD, r = nwg % NXCD, xcd = wgid % NXCD, off = wgid / NXCD; wgid = (xcd < r ? xcd * (q + 1) : r * (q + 1) + (xcd - r) * q) + off; }
        const int nig = WGM * nN, gid = wgid / nig, fm = gid * WGM, gsz = (nM - fm) < WGM ? (nM - fm) : WGM;
        u.pm = fm + ((wgid % nig) % gsz); u.pn = (wgid % nig) / gsz; return true;
    }
    __device__ __forceinline__ void a_ready(const Unit&) const {}
    __device__ __forceinline__ void done(const Unit&) const {}
};

__device__ __forceinline__ unsigned cvt_pk_bf16(float lo, float hi) { unsigned r; asm volatile("v_cvt_pk_bf16_f32 %0, %1, %2" : "=v"(r) : "v"(lo), "v"(hi)); return r; }

template <class Epi, class Sched, bool ALIGN_EPI = false, bool SP2 = false>
__device__ __forceinline__ void gemm_phase(PG8_LAS unsigned char* lds, const Gemm g, const Sched& S, const Epi& E) {
    int tid_ = threadIdx.x; asm volatile("" : "+v"(tid_));
    const int tid = tid_, wid = __builtin_amdgcn_readfirstlane(tid >> 6), lane = tid & 63, wr = wid >> 2, wc = wid & 3, fr = lane & 15, fq = lane >> 4;
    const int K = g.K, nt = K / BK;
    unsigned voffA, voffB;
    { int R, C; stage_rc(tid * 16, R, C); const int Rb = Epi::PERM ? ((R & ~31) + perm32(R & 31)) : R; voffA = (unsigned)(R * K + C) * 2u; voffB = (unsigned)(Rb * K + C) * 2u; }
    const size_t pstep = (size_t)64 * K * 2;
    const size_t kstep = (size_t)(BK * 2);
    const size_t hstep = (size_t)HALF * K * 2;
    const size_t tstep = 2 * hstep;
    const unsigned ldsw = (unsigned)wid * 1024u;
    const int aoff = lds_byte(wr * 64 + fr, fq * 8), boff = lds_byte(wc * 32 + fr, fq * 8);
#define PG8_SA(b, h) (((b) * 2 + (h)) * HTB)
#define PG8_SB(b, h) ((4 + (b) * 2 + (h)) * HTB)
#define PG8_STAGE(bufoff, gbase, voff) do { _Pragma("unroll") for (int _i = 0; _i < 2; ++_i) \
        __builtin_amdgcn_global_load_lds((const unsigned*)((const char*)(gbase) + _i * pstep + (voff)), (PG8_LAS unsigned*)(lds + (bufoff) + ldsw + _i * 8192), 16, 0, 0); } while (0)
#define PG8_LDA(dst, b, h) do { _Pragma("unroll") for (int m = 0; m < 4; ++m) _Pragma("unroll") for (int k = 0; k < 2; ++k) dst[m][k] = *(const PG8_LAS bf16x8*)(lds + PG8_SA(b, h) + (aoff ^ (k * 64)) + m * 2048); } while (0)
#define PG8_LDB(dst, b, h) do { _Pragma("unroll") for (int n = 0; n < 2; ++n) _Pragma("unroll") for (int k = 0; k < 2; ++k) dst[n][k] = *(const PG8_LAS bf16x8*)(lds + PG8_SB(b, h) + (boff ^ (k * 64)) + n * 2048); } while (0)
#define PG8_MMA(ai, bj, At, Bt) do { __builtin_amdgcn_s_setprio(1); _Pragma("unroll") for (int m = 0; m < 4; ++m) _Pragma("unroll") for (int n = 0; n < 2; ++n) _Pragma("unroll") for (int k = 0; k < 2; ++k) \
        acc[ai][bj][m][n] = __builtin_amdgcn_mfma_f32_16x16x32_bf16(Bt[n][k], At[m][k], acc[ai][bj][m][n], 0, 0, 0); __builtin_amdgcn_s_setprio(0); } while (0)
#define PG8_WAIT_V(n) asm volatile("s_waitcnt vmcnt(" #n ")" ::: "memory")
#define PG8_WAIT_L(n) asm volatile("s_waitcnt lgkmcnt(" #n ")" ::: "memory")
#define PG8_BAR __builtin_amdgcn_s_barrier()
#define PG8_SCHED __builtin_amdgcn_sched_barrier(0)
    Unit cur, nxt; int ui = 0;
    if (!S.next(0, cur)) return;
    f32x4 acc[2][2][4][2];
#pragma unroll
    for (int a = 0; a < 2; ++a)
#pragma unroll
        for (int b = 0; b < 2; ++b)
#pragma unroll
            for (int m = 0; m < 4; ++m)
#pragma unroll
                for (int n = 0; n < 2; ++n) acc[a][b][m][n] = (f32x4){0.f, 0.f, 0.f, 0.f};
    bf16x8 At[4][2], B0[2][2], B1[2][2];
    const char* cA = (const char*)g.A + (size_t)cur.pm * tstep; const char* cB = (const char*)g.Bt + (size_t)cur.pn * tstep;
    S.a_ready(cur);
    if constexpr (SP2) {
        PG8_STAGE(PG8_SB(0, 0), cB, voffB); PG8_STAGE(PG8_SB(0, 1), cB + hstep, voffB); PG8_STAGE(PG8_SA(0, 0), cA, voffA); PG8_STAGE(PG8_SA(0, 1), cA + hstep, voffA);
        if (wr == 1) PG8_BAR;
        PG8_WAIT_V(2); PG8_BAR;
        PG8_STAGE(PG8_SB(1, 0), cB + kstep, voffB); PG8_STAGE(PG8_SA(1, 0), cA + kstep, voffA); PG8_STAGE(PG8_SB(1, 1), cB + hstep + kstep, voffB);
        PG8_WAIT_V(6); PG8_BAR;
    } else {
        PG8_STAGE(PG8_SB(0, 0), cB, voffB); PG8_STAGE(PG8_SA(0, 0), cA, voffA); PG8_STAGE(PG8_SB(0, 1), cB + hstep, voffB); PG8_STAGE(PG8_SA(0, 1), cA + hstep, voffA);
        if (wr == 1) PG8_BAR;
        PG8_WAIT_V(4); PG8_BAR;
        PG8_STAGE(PG8_SB(1, 0), cB + kstep, voffB); PG8_STAGE(PG8_SA(1, 0), cA + kstep, voffA); PG8_STAGE(PG8_SB(1, 1), cB + hstep + kstep, voffB);
        PG8_WAIT_V(6); PG8_BAR;
    }
    for (;;) {
        const bool has_next = S.next(ui + 1, nxt);
        const char* nA = has_next ? (const char*)g.A + (size_t)nxt.pm * tstep : cA; const char* nB = has_next ? (const char*)g.Bt + (size_t)nxt.pn * tstep : cB;
        for (int t = 0; t < nt; t += 2) {
            const bool last = (t == nt - 2);
            const char* a1 = cA + (size_t)(t + 1) * kstep;
            const char* a2 = last ? nA : cA + (size_t)(t + 2) * kstep; const char* b2 = last ? nB : cB + (size_t)(t + 2) * kstep;
            const char* a3 = a2 + kstep; const char* b3 = b2 + kstep;
            if (last && has_next) S.a_ready(nxt);
            if constexpr (SP2) {
            PG8_LDB(B0, 0, 0); PG8_LDB(B1, 0, 1); PG8_SCHED; PG8_LDA(At, 0, 0); PG8_STAGE(PG8_SA(1, 1), a1 + hstep, voffA);
            PG8_WAIT_V(8); PG8_WAIT_L(0); PG8_BAR; PG8_MMA(0, 0, At, B0); PG8_MMA(0, 1, At, B1); PG8_BAR; PG8_SCHED;
            PG8_LDA(At, 0, 1); PG8_STAGE(PG8_SB(0, 0), b2, voffB); PG8_STAGE(PG8_SB(0, 1), b2 + hstep, voffB); PG8_STAGE(PG8_SA(0, 0), a2, voffA);
            PG8_WAIT_V(8); PG8_WAIT_L(0); PG8_BAR; PG8_MMA(1, 0, At, B0); PG8_MMA(1, 1, At, B1); PG8_BAR; PG8_SCHED;
            PG8_LDB(B0, 1, 0); PG8_LDB(B1, 1, 1); PG8_SCHED; PG8_LDA(At, 1, 0); PG8_STAGE(PG8_SA(0, 1), a2 + hstep, voffA);
            PG8_WAIT_V(8); PG8_WAIT_L(0); PG8_BAR; PG8_MMA(0, 0, At, B0); PG8_MMA(0, 1, At, B1); PG8_BAR; PG8_SCHED;
            PG8_LDA(At, 1, 1); PG8_STAGE(PG8_SB(1, 0), b3, voffB); PG8_STAGE(PG8_SB(1, 1), b3 + hstep, voffB); PG8_STAGE(PG8_SA(1, 0), a3, voffA);
            PG8_WAIT_V(8); PG8_WAIT_L(0); PG8_BAR; PG8_MMA(1, 0, At, B0); PG8_MMA(1, 1, At, B1); PG8_BAR; PG8_SCHED;
            } else {
            PG8_LDB(B0, 0, 0); PG8_SCHED; PG8_LDA(At, 0, 0); PG8_STAGE(PG8_SA(1, 1), a1 + hstep, voffA);
            PG8_WAIT_L(8); PG8_BAR; PG8_WAIT_L(0); PG8_MMA(0, 0, At, B0); PG8_BAR; PG8_SCHED;
            PG8_LDB(B1, 0, 1); PG8_STAGE(PG8_SB(0, 0), b2, voffB);
            PG8_BAR; PG8_WAIT_L(0); PG8_MMA(0, 1, At, B1); PG8_BAR;
            PG8_LDA(At, 0, 1); PG8_STAGE(PG8_SA(0, 0), a2, voffA);
            PG8_BAR; PG8_WAIT_L(0); PG8_MMA(1, 0, At, B0); PG8_BAR; PG8_SCHED;
            PG8_STAGE(PG8_SB(0, 1), b2 + hstep, voffB);
            PG8_WAIT_V(6); PG8_BAR; PG8_MMA(1, 1, At, B1); PG8_BAR;
            PG8_LDB(B0, 1, 0); PG8_SCHED; PG8_LDA(At, 1, 0); PG8_STAGE(PG8_SA(0, 1), a2 + hstep, voffA);
            PG8_WAIT_L(8); PG8_BAR; PG8_WAIT_L(0); PG8_MMA(0, 0, At, B0); PG8_BAR; PG8_SCHED;
            PG8_LDB(B1, 1, 1); PG8_STAGE(PG8_SB(1, 0), b3, voffB);
            PG8_BAR; PG8_WAIT_L(0); PG8_MMA(0, 1, At, B1); PG8_BAR;
            PG8_LDA(At, 1, 1); PG8_STAGE(PG8_SA(1, 0), a3, voffA);
            PG8_BAR; PG8_WAIT_L(0); PG8_MMA(1, 0, At, B0); PG8_BAR; PG8_SCHED;
            PG8_STAGE(PG8_SB(1, 1), b3 + hstep, voffB);
            PG8_WAIT_V(6); PG8_BAR; PG8_MMA(1, 1, At, B1); PG8_BAR;
            }
        }
        if constexpr (ALIGN_EPI) { if (wr == 0) PG8_BAR; }
        E(acc, cur, ui, wr, wc, fr, fq); S.done(cur);
        if (!has_next) break;
#pragma unroll
        for (int a = 0; a < 2; ++a)
#pragma unroll
            for (int b = 0; b < 2; ++b)
#pragma unroll
                for (int m = 0; m < 4; ++m)
#pragma unroll
                    for (int n = 0; n < 2; ++n) acc[a][b][m][n] = (f32x4){0.f, 0.f, 0.f, 0.f};
        cur = nxt; cA = nA; cB = nB; ++ui;
        if constexpr (ALIGN_EPI) { if (wr == 1) PG8_BAR; }
    }
    PG8_WAIT_V(0);
    if constexpr (!ALIGN_EPI) { if (wr == 0) PG8_BAR; }
    PG8_BAR;
#undef PG8_SA
#undef PG8_SB
#undef PG8_STAGE
#undef PG8_LDA
#undef PG8_LDB
#undef PG8_MMA
#undef PG8_WAIT_V
#undef PG8_WAIT_L
#undef PG8_BAR
#undef PG8_SCHED
}
}

constexpr int BATCH = 8, SEQ = 2048, D = 1024, M = BATCH * SEQ;
constexpr int FF = 2816, DRNN = 1280, NBLK = 10, RBLK = 128, CONVW = 4;
constexpr int NHEAD = 16, HD = 64, NGRP = 3, NQKV = 9216;
constexpr float RMS_EPS = 1e-6f;
constexpr float LOG2E = 1.4426950408889634f;
constexpr int NWAVES = 8;

typedef unsigned short bf16;
typedef unsigned v4u __attribute__((ext_vector_type(4)));
typedef unsigned v2u __attribute__((ext_vector_type(2)));
typedef float f32x4 __attribute__((ext_vector_type(4)));
#define GAS __attribute__((address_space(1)))
#define LAS __attribute__((address_space(3)))
typedef GAS unsigned gu32;
#define RLX_AGENT __ATOMIC_RELAXED, __HIP_MEMORY_SCOPE_AGENT
#define LDS_WAIT() asm volatile("s_waitcnt lgkmcnt(0)" ::: "memory")

#ifndef RESID_BF16
#define RESID_BF16 1
#endif
constexpr size_t MiB = 1u << 20;
constexpr size_t WS_CTL = 0, CTL_ZERO_BYTES = 1 * MiB;
constexpr size_t WS_SSQ = 1 * MiB;
constexpr size_t WS_BIAS = 2 * MiB;
constexpr size_t WS_XB = 3 * MiB;
constexpr size_t WS_WO = 35 * MiB;
constexpr size_t WS_WQKV = 37 * MiB;
constexpr size_t WS_QKV = 55 * MiB;
constexpr size_t QKV_SLAB = (size_t)M * 1024 * 2;
constexpr size_t WS_LSE = 343 * MiB;
constexpr size_t WS_END = 352 * MiB;
constexpr size_t WS_WIN0 = 55 * MiB, WS_WOUT0 = 66 * MiB, WS_WIN1 = 72 * MiB, WS_WOUT1 = 83 * MiB, WS_WIN2 = 89 * MiB, WS_WOUT2 = 100 * MiB;
constexpr size_t WS_WRIN = 106 * MiB, WS_WROUT = 111 * MiB, WS_WA = 114 * MiB, WS_WX = 114 * MiB + 512 * 1024;
constexpr size_t WS_ACT = 115 * MiB;
constexpr size_t WS_G = 203 * MiB, WS_U = 243 * MiB, WS_Y = 283 * MiB;
constexpr size_t WS_ATT = WS_QKV + 3 * QKV_SLAB;
constexpr size_t WS_WOUT3 = 346 * MiB;
constexpr size_t WS_ACT3 = WS_QKV;
static_assert(WS_Y + (size_t)M * DRNN * 2 <= WS_LSE && WS_ACT + (size_t)M * FF * 2 <= WS_G && WS_WX + 327680 <= WS_ACT, "ws map");
static_assert(WS_QKV + 9 * QKV_SLAB == WS_LSE && WS_LSE + (size_t)3 * M * 16 * 4 <= WS_WOUT3 && WS_WOUT3 + (size_t)D * FF * 2 <= WS_END && RESID_BF16 == 1, "ws map");
constexpr int CW_BAR = 4096;

constexpr int RING_BYTES = 131072;
constexpr int RSTD_OFF = RING_BYTES + 1024, RSTD_MAX_UNITS = 9, GAIN_OFF = RSTD_OFF + RSTD_MAX_UNITS * 256 * 4;
constexpr int LDS_BYTES = 147456;
constexpr int MISC_OFF = LDS_BYTES - 128;
static_assert(GAIN_OFF + 512 <= LDS_BYTES - 128, "LDS map");

#define XB_TMO      128
#define XB_XCNT(j)  (256  + 64 * (j))
#define XB_XSUB(j)  (1280 + 64 * (j))
#define XB_XGEN(j)  (2304 + 64 * (j))
#define XB_TOP      3328
#define XB_TOPGEN   3392
#define XCD_BAR_WORDS 3456
#define XB_SPIN_CAP (1u << 18)
__device__ __forceinline__ unsigned xb_ld(unsigned* p)              { return __hip_atomic_load(p, __ATOMIC_RELAXED, __HIP_MEMORY_SCOPE_AGENT); }
__device__ __forceinline__ unsigned xb_add(unsigned* p, unsigned v) { return __hip_atomic_fetch_add(p, v, __ATOMIC_RELAXED, __HIP_MEMORY_SCOPE_AGENT); }
__device__ __forceinline__ unsigned xb_xcc_id() { return (unsigned)__builtin_amdgcn_s_getreg((3 << 11) | 20) & 0xFu; }
#define XB_SPIN(cond, bar) do { unsigned _sp = 0; while (cond) { __builtin_amdgcn_s_sleep(1); \
    if ((++_sp & 255u) == 0u) { if (xb_ld(&(bar)[XB_TMO])) break; if (_sp > XB_SPIN_CAP) { atomicAdd(&(bar)[XB_TMO], 1u); break; } } } } while (0)
struct XcdBarrier { unsigned* bar; unsigned x; volatile LAS unsigned* st; };
__device__ __forceinline__ XcdBarrier xcd_barrier_post(unsigned* bar, volatile LAS unsigned* st) {
    XcdBarrier b; b.bar = bar; b.x = xb_xcc_id(); b.st = st;
    if (threadIdx.x == 0) (void)xb_add(&bar[XB_XCNT(b.x)], 1u);
    return b;
}
__device__ __forceinline__ void xcd_barrier_complete(unsigned* bar, unsigned x, unsigned& nloc, unsigned& nx) {
    const unsigned G = gridDim.x * gridDim.y * gridDim.z;
    unsigned sum, cnt, mine, sp = 0u;
    for (;;) {
        sum = 0u; cnt = 0u; mine = 0u;
#pragma unroll
        for (unsigned j = 0; j < 16; ++j) { const unsigned c = xb_ld(&bar[XB_XCNT(j)]); sum += c; cnt += (c > 0u) ? 1u : 0u; mine = (j == x) ? c : mine; }
        if (sum == G) break;
        __builtin_amdgcn_s_sleep(1);
        if ((++sp & 255u) == 0u) { if (xb_ld(&bar[XB_TMO])) break; if (sp > XB_SPIN_CAP) { atomicAdd(&bar[XB_TMO], 1u); break; } }
    }
    nloc = mine > 0u ? mine : 1u; nx = cnt > 0u ? cnt : 1u;
}
__device__ __forceinline__ void xcd_barrier(const XcdBarrier& b) {
    asm volatile("s_waitcnt vmcnt(0)" ::: "memory");
    __syncthreads();
    if (threadIdx.x == 0) {
        unsigned* bar = b.bar;
        __builtin_amdgcn_s_waitcnt(0);
        unsigned nloc = b.st[0], nx = b.st[1];
        if (nloc == 0u) { xcd_barrier_complete(bar, b.x, nloc, nx); b.st[0] = nloc; b.st[1] = nx; }
        const unsigned old = xb_add(&bar[XB_XSUB(b.x)], 1u);
        const unsigned gen = old / nloc;
        if (old + 1u == (gen + 1u) * nloc) {
            __builtin_amdgcn_fence(__ATOMIC_RELEASE, "agent");
            asm volatile("s_waitcnt vmcnt(0)" ::: "memory");
            const unsigned og = xb_add(&bar[XB_TOP], 1u);
            const unsigned tg = og / nx;
            if (og + 1u == (tg + 1u) * nx) xb_add(&bar[XB_TOPGEN], 1u);
            else XB_SPIN(xb_ld(&bar[XB_TOPGEN]) == tg, bar);
            __builtin_amdgcn_fence(__ATOMIC_ACQUIRE, "agent");
            xb_add(&bar[XB_XGEN(b.x)], 1u);
            asm volatile("s_waitcnt vmcnt(0)" ::: "memory");
        } else {
            XB_SPIN(xb_ld(&bar[XB_XGEN(b.x)]) == gen, bar);
            __builtin_amdgcn_fence(__ATOMIC_ACQUIRE, "agent");
            asm volatile("s_waitcnt vmcnt(0)" ::: "memory");
        }
    }
    __syncthreads();
}

__device__ __forceinline__ unsigned f2bf(float f) { unsigned u = __builtin_bit_cast(unsigned, f); return (u + 0x7fffu + ((u >> 16) & 1u)) >> 16; }
__device__ __forceinline__ unsigned pk2(float lo, float hi) { return f2bf(lo) | (f2bf(hi) << 16); }
__device__ __forceinline__ float bf_lo(unsigned w) { return __builtin_bit_cast(float, w << 16); }
__device__ __forceinline__ float bf_hi(unsigned w) { return __builtin_bit_cast(float, w & 0xffff0000u); }
__device__ __forceinline__ float bf2f(bf16 v) { return __builtin_bit_cast(float, (unsigned)v << 16); }
__device__ __forceinline__ float wave_sum(float v) {
#pragma unroll
    for (int o = 1; o < 64; o <<= 1) v += __shfl_xor(v, o);
    return v;
}
__device__ __forceinline__ float fast_sigmoid(float x) { return __builtin_amdgcn_rcpf(1.f + __builtin_amdgcn_exp2f(-LOG2E * x)); }
__device__ __forceinline__ float row_rstd(const float* ssq, int row) {
    const f32x4* p = (const f32x4*)(ssq + (size_t)row * 16); const f32x4 a = p[0], b = p[1], c = p[2], d = p[3];
    const float s = ((a.x + a.y) + (a.z + a.w)) + ((b.x + b.y) + (b.z + b.w)) + ((c.x + c.y) + (c.z + c.w)) + ((d.x + d.y) + (d.z + d.w));
    return rsqrtf(s * (1.0f / D) + RMS_EPS);
}

typedef float f32x2 __attribute__((ext_vector_type(2)));
template <class Sched> __device__ __forceinline__ void fill_rstd(LAS unsigned char* lds, const Sched& S, const float* ssq, int tid) {
    LAS float* rt = (LAS float*)(lds + RSTD_OFF); pg8::Unit u;
    for (int i = 0; i < RSTD_MAX_UNITS && S.next(i, u); ++i)
        if ((tid >> 8) == (i & 1)) { const int r = tid & 255; rt[i * 256 + r] = row_rstd(ssq, u.pm * 256 + r); }
    __syncthreads();
}
using pg8::Unit;
__device__ __forceinline__ f32x2 silu_mul_pk(f32x2 g, f32x2 up) {
    const f32x2 t = g * (-LOG2E); f32x2 e; e.x = __builtin_amdgcn_exp2f(t.x); e.y = __builtin_amdgcn_exp2f(t.y);
    const f32x2 d = e + 1.0f; f32x2 r; r.x = __builtin_amdgcn_rcpf(d.x); r.y = __builtin_amdgcn_rcpf(d.y);
    return (g * r) * up;
}
struct EpiSwiGLU {
    static constexpr bool PERM = true;
    const LAS float* rtab; bf16* act; int skip;
    __device__ __forceinline__ void operator()(const f32x4 (&acc)[2][2][4][2], const Unit& u, int ui, int wr, int wc, int fr, int fq) const {
        if (skip == 1) return;
#pragma unroll
        for (int ai = 0; ai < 2; ++ai)
#pragma unroll
            for (int m = 0; m < 4; ++m) {
                const int rl = ai * 128 + wr * 64 + m * 16 + fr, row = u.pm * 256 + rl;
                const float rs = rtab[ui * 256 + rl];
                f32x2 v[4];
#pragma unroll
                for (int n = 0; n < 2; ++n)
#pragma unroll
                    for (int e = 0; e < 2; ++e) { const f32x2 g = (f32x2){acc[ai][0][m][n][2 * e], acc[ai][0][m][n][2 * e + 1]} * rs, up = (f32x2){acc[ai][1][m][n][2 * e], acc[ai][1][m][n][2 * e + 1]} * rs;
                        v[n * 2 + e] = silu_mul_pk(g, up); }
                v4u w; w.x = pg8::cvt_pk_bf16(v[0].x, v[0].y); w.y = pg8::cvt_pk_bf16(v[1].x, v[1].y); w.z = pg8::cvt_pk_bf16(v[2].x, v[2].y); w.w = pg8::cvt_pk_bf16(v[3].x, v[3].y);
                if (skip != 2 || w.x == 0x7fc17fc1u) *(v4u*)(act + (size_t)row * FF + u.pn * 128 + wc * 32 + 8 * fq) = w;
            }
    }
};
#ifndef RESID_BF16
#define RESID_BF16 1
#endif
struct EpiRes {
    static constexpr bool PERM = true;
    const float* xin; float* xout; bf16* xb; float* ssq; float scale; bool skip;
    __device__ __forceinline__ void operator()(const f32x4 (&acc)[2][2][4][2], const Unit& u, int ui, int wr, int wc, int fr, int fq) const {
        if (skip) return;
        if (xin) run<true>(acc, u, wr, wc, fr, fq); else run<false>(acc, u, wr, wc, fr, fq);
    }
    template <bool F32IN> __device__ __forceinline__ void run(const f32x4 (&acc)[2][2][4][2], const Unit& u, int wr, int wc, int fr, int fq) const {
#pragma unroll
        for (int ai = 0; ai < 2; ++ai) {
            f32x4 xv[4][2][2];
#pragma unroll
            for (int m = 0; m < 4; ++m)
#pragma unroll
                for (int bj = 0; bj < 2; ++bj) { const size_t off = (size_t)(u.pm * 256 + ai * 128 + wr * 64 + m * 16 + fr) * D + u.pn * 256 + bj * 128 + wc * 32 + 8 * fq;
                    if (F32IN) { xv[m][bj][0] = *(const f32x4*)(xin + off); xv[m][bj][1] = *(const f32x4*)(xin + off + 4); }
                    else { const v4u w = *(const v4u*)(xb + off); xv[m][bj][0] = (f32x4){bf_lo(w.x), bf_hi(w.x), bf_lo(w.y), bf_hi(w.y)}; xv[m][bj][1] = (f32x4){bf_lo(w.z), bf_hi(w.z), bf_lo(w.w), bf_hi(w.w)}; } }
#pragma unroll
            for (int m = 0; m < 4; ++m) {
                const int row = u.pm * 256 + ai * 128 + wr * 64 + m * 16 + fr;
                float ss = 0.f;
#pragma unroll
                for (int bj = 0; bj < 2; ++bj) {
                    const size_t off = (size_t)row * D + u.pn * 256 + bj * 128 + wc * 32 + 8 * fq;
                    const f32x4 y0 = xv[m][bj][0] + acc[ai][bj][m][0] * scale, y1 = xv[m][bj][1] + acc[ai][bj][m][1] * scale;
                    if (xout) { *(f32x4*)(xout + off) = y0; *(f32x4*)(xout + off + 4) = y1; }
                    v4u w; w.x = pg8::cvt_pk_bf16(y0[0], y0[1]); w.y = pg8::cvt_pk_bf16(y0[2], y0[3]); w.z = pg8::cvt_pk_bf16(y1[0], y1[1]); w.w = pg8::cvt_pk_bf16(y1[2], y1[3]);
                    *(v4u*)(xb + off) = w;
                    ss += (y0[0] * y0[0] + y0[1] * y0[1]) + (y0[2] * y0[2] + y0[3] * y0[3]) + (y1[0] * y1[0] + y1[1] * y1[1]) + (y1[2] * y1[2] + y1[3] * y1[3]);
                }
                ss += __shfl_xor(ss, 16); ss += __shfl_xor(ss, 32);
                if (fq == 0) ssq[(size_t)row * 16 + u.pn * 4 + wc] = ss;
            }
            asm volatile("" ::: "memory");
        }
    }
};
struct EpiRnnIn {
    static constexpr bool PERM = true;
    const LAS float* rtab; bf16* Gb; bf16* Ub;
    template <bool GATE> __device__ __forceinline__ void run(const f32x4 (&acc)[2][2][4][2], const Unit& u, int ui, int wr, int wc, int fr, int fq, bf16* dstb, int pc) const {
#pragma unroll
        for (int ai = 0; ai < 2; ++ai)
#pragma unroll
            for (int m = 0; m < 4; ++m) {
                const int rl = ai * 128 + wr * 64 + m * 16 + fr, row = u.pm * 256 + rl;
                const float rs = rtab[ui * 256 + rl];
#pragma unroll
                for (int bj = 0; bj < 2; ++bj) {
                    f32x2 v[4];
#pragma unroll
                    for (int n = 0; n < 2; ++n)
#pragma unroll
                        for (int e = 0; e < 2; ++e) { f32x2 x = (f32x2){acc[ai][bj][m][n][2 * e], acc[ai][bj][m][n][2 * e + 1]} * rs;
                            if (GATE) {
                                const f32x2 t = (x * x * 0.044715f + 1.0f) * x * (-1.5957691216057308f * LOG2E); f32x2 ex; ex.x = __builtin_amdgcn_exp2f(t.x); ex.y = __builtin_amdgcn_exp2f(t.y);
                                const f32x2 d = ex + 1.0f; f32x2 r; r.x = __builtin_amdgcn_rcpf(d.x); r.y = __builtin_amdgcn_rcpf(d.y); x = x * r; }
                            v[n * 2 + e] = x; }
                    v4u w; w.x = pg8::cvt_pk_bf16(v[0].x, v[0].y); w.y = pg8::cvt_pk_bf16(v[1].x, v[1].y); w.z = pg8::cvt_pk_bf16(v[2].x, v[2].y); w.w = pg8::cvt_pk_bf16(v[3].x, v[3].y);
                    *(v4u*)(dstb + (size_t)row * DRNN + pc * 256 + bj * 128 + wc * 32 + 8 * fq) = w;
                }
            }
    }
    __device__ __forceinline__ void operator()(const f32x4 (&acc)[2][2][4][2], const Unit& u, int ui, int wr, int wc, int fr, int fq) const {
        if (u.pn < 5) run<true>(acc, u, ui, wr, wc, fr, fq, Gb, u.pn); else run<false>(acc, u, ui, wr, wc, fr, fq, Ub, u.pn - 5);
    }
};
struct EpiQKV {
    static constexpr bool PERM = true;
    const LAS float* rtab; const LAS float* gtab; bf16* qkv; bool skip;
    __device__ __forceinline__ void operator()(const f32x4 (&acc)[2][2][4][2], const Unit& u, int ui, int wr, int wc, int fr, int fq) const {
        if (skip) return;
        const int hs = u.pn * 4 + wc, kind = hs / 48, gh = hs - kind * 48, g = gh >> 4, h = gh & 15, l2d = 2 * g;
        bf16* slab = qkv + (size_t)(kind * 3 + g) * ((size_t)M * 1024);
        f32x4 gv[2][2];
#pragma unroll
        for (int bj = 0; bj < 2; ++bj)
#pragma unroll
            for (int n = 0; n < 2; ++n) { gv[bj][n] = (f32x4){1.f, 1.f, 1.f, 1.f}; if (kind < 2) gv[bj][n] = *(const LAS f32x4*)(gtab + kind * 64 + 32 * bj + 8 * fq + 4 * n); }
#pragma unroll
        for (int ai = 0; ai < 2; ++ai)
#pragma unroll
            for (int m = 0; m < 4; ++m) {
                const int rl = ai * 128 + wr * 64 + m * 16 + fr, row = u.pm * 256 + rl;
                const float rs = rtab[ui * 256 + rl];
                f32x4 v[2][2]; float ss = 0.f;
#pragma unroll
                for (int bj = 0; bj < 2; ++bj)
#pragma unroll
                    for (int n = 0; n < 2; ++n) { v[bj][n] = acc[ai][bj][m][n] * rs; const f32x4 t = v[bj][n] * v[bj][n]; ss += (t[0] + t[1]) + (t[2] + t[3]); }
                float rn = 1.f;
                if (kind < 2) { ss += __shfl_xor(ss, 16); ss += __shfl_xor(ss, 32); rn = rsqrtf(ss * (1.0f / HD) + RMS_EPS); }
                const int b = row >> 11, t = row & 2047, rres = t & ((1 << l2d) - 1), l = t >> l2d, L = 2048 >> l2d;
                bf16* dst = slab + ((size_t)(b * 16 + h) * 2048 + rres * L + l) * 64 + 8 * fq;
#pragma unroll
                for (int bj = 0; bj < 2; ++bj) {
                    const f32x4 a0 = v[bj][0] * gv[bj][0] * rn, a1 = v[bj][1] * gv[bj][1] * rn;
                    v4u w; w.x = pg8::cvt_pk_bf16(a0[0], a0[1]); w.y = pg8::cvt_pk_bf16(a0[2], a0[3]); w.z = pg8::cvt_pk_bf16(a1[0], a1[1]); w.w = pg8::cvt_pk_bf16(a1[2], a1[3]);
                    *(v4u*)(dst + 32 * bj) = w;
                }
            }
    }
};

struct Args { const float* in[18]; float* out; unsigned char* ws; int ph_lo, ph_hi; };
enum { I_X = 0, I_NORMG, I_FFN_WIN, I_FFN_WOUT, I_RNN_WIN, I_CONV_W, I_CONV_B, I_WA, I_BA, I_WX, I_BX, I_LAM, I_RNN_WOUT, I_WQKV, I_QGAIN, I_KGAIN, I_WO, I_RELB };

struct Ctx { LAS unsigned char* lds; int tid, lane, wave, G, vcu; unsigned char* ws; };

typedef short v4i16_t __attribute__((ext_vector_type(4)));
__device__ __forceinline__ v4i16_t vtr16(const LAS unsigned char* p) { return __builtin_amdgcn_ds_read_tr16_b64_v4i16((LAS v4i16_t*)p); }
enum { CM_NONE = 0, CM_FFN = 1, CM_QKV = 2 };
__device__ __forceinline__ int colmap(int mode, int vr) {
    if (mode == CM_FFN) { const int pn = vr >> 8, w = vr & 255; return (w >> 7) * FF + 128 * pn + (w & 127); }
    if (mode == CM_QKV) { const int pn = vr >> 8, w = vr & 255, bj = w >> 7, wc = (w >> 5) & 3, j = w & 31; return 256 * pn + 64 * wc + 32 * bj + j; }
    return vr;
}
__device__ __forceinline__ void transpose_item(const float* W, int K, int N, const float* gvec, bf16* WT, int mode, LAS unsigned char* scr, int item, int lane) {
    const int nblk = N / 64, kb = item / nblk, nb = item - kb * nblk, k0 = 64 * kb, vr0 = 64 * nb;
    const int col4 = lane & 15, rsub = lane >> 4, nsrc = colmap(mode, vr0 + 32 * (col4 >> 3)) + (col4 & 7) * 4;
    const float* src = W + (size_t)(k0 + rsub) * N + nsrc;
    f32x4 w[16];
#pragma unroll
    for (int i = 0; i < 16; ++i) w[i] = __builtin_nontemporal_load((const GAS f32x4*)(src + (size_t)(4 * i) * N));
    if (gvec) {
#pragma unroll
        for (int i = 0; i < 16; ++i) w[i] = w[i] * gvec[k0 + 4 * i + rsub];
    }
#pragma unroll
    for (int i = 0; i < 16; ++i) { v2u p; p.x = pg8::cvt_pk_bf16(w[i][0], w[i][1]); p.y = pg8::cvt_pk_bf16(w[i][2], w[i][3]);
        *(LAS v2u*)(scr + (col4 >> 3) * 4096 + (4 * i + rsub) * 64 + (col4 & 7) * 8) = p; }
    const int q = (lane & 15) >> 2, p4 = lane & 3, gidx = lane >> 4;
#pragma unroll
    for (int r = 0; r < 8; ++r) { const int nb16 = r >> 1, kh = r & 1, kbase = 32 * kh + 8 * gidx;
        const LAS unsigned char* a = scr + (nb16 >> 1) * 4096 + (kbase + q) * 64 + ((nb16 & 1) * 16 + 4 * p4) * 2;
        const v4i16_t lo = vtr16(a), hi = vtr16(a + 4 * 64);
        v4u o; { const v2u l2 = __builtin_bit_cast(v2u, lo), h2 = __builtin_bit_cast(v2u, hi); o.x = l2.x; o.y = l2.y; o.z = h2.x; o.w = h2.y; }
        *(GAS v4u*)(WT + (size_t)(vr0 + nb16 * 16 + (lane & 15)) * K + k0 + kbase) = o; }
}
struct MatJob { const float* W; int K, N; const float* g; bf16* WT; int mode; };
__device__ __forceinline__ MatJob mat_job(const Ctx& C, const Args& a, int idx) {
    unsigned char* ws = C.ws; const float* ng = a.in[I_NORMG]; MatJob j;
    switch (idx) {
    case 0: j = MatJob{a.in[I_FFN_WIN] + (size_t)0 * D * 2 * FF, D, 2 * FF, ng + 0 * D, (bf16*)(ws + WS_WIN0), CM_FFN}; break;
    case 1: j = MatJob{a.in[I_FFN_WOUT] + (size_t)0 * FF * D, FF, D, nullptr, (bf16*)(ws + WS_WOUT0), CM_NONE}; break;
    case 2: j = MatJob{a.in[I_RNN_WIN], D, 2 * DRNN, ng + 1 * D, (bf16*)(ws + WS_WRIN), CM_NONE}; break;
    case 3: j = MatJob{a.in[I_RNN_WOUT], DRNN, D, nullptr, (bf16*)(ws + WS_WROUT), CM_NONE}; break;
    case 4: j = MatJob{a.in[I_FFN_WIN] + (size_t)1 * D * 2 * FF, D, 2 * FF, ng + 2 * D, (bf16*)(ws + WS_WIN1), CM_FFN}; break;
    case 5: j = MatJob{a.in[I_FFN_WOUT] + (size_t)1 * FF * D, FF, D, nullptr, (bf16*)(ws + WS_WOUT1), CM_NONE}; break;
    case 6: j = MatJob{a.in[I_WO], D, D, nullptr, (bf16*)(ws + WS_WO), CM_NONE}; break;
    case 7: j = MatJob{a.in[I_WQKV], D, NQKV, ng + 4 * D, (bf16*)(ws + WS_WQKV), CM_QKV}; break;
    case 8: j = MatJob{a.in[I_FFN_WIN] + (size_t)2 * D * 2 * FF, D, 2 * FF, ng + 3 * D, (bf16*)(ws + WS_WIN2), CM_FFN}; break;
    case 9: j = MatJob{a.in[I_FFN_WOUT] + (size_t)2 * FF * D, FF, D, nullptr, (bf16*)(ws + WS_WOUT2), CM_NONE}; break;
    case 10: j = MatJob{a.in[I_FFN_WIN] + (size_t)3 * D * 2 * FF, D, 2 * FF, ng + 5 * D, (bf16*)a.out, CM_FFN}; break;
    default: j = MatJob{a.in[I_FFN_WOUT] + (size_t)3 * FF * D, FF, D, nullptr, (bf16*)(ws + WS_WOUT3), CM_NONE}; break;
    }
    return j;
}
__device__ __forceinline__ void convert_mats(const Ctx& C, const Args& a, int first, int last, int gw, int NGW) {
    LAS unsigned char* scr = C.lds + C.wave * 8192;
    int base = 0;
    for (int mi = first; mi < last; ++mi) {
        const MatJob j = mat_job(C, a, mi); const int cnt = (j.K / 64) * (j.N / 64);
        int it = (gw - base) % NGW; if (it < 0) it += NGW;
        for (; it < cnt; it += NGW) transpose_item(j.W, j.K, j.N, j.g, j.WT, j.mode, scr, it, C.lane);
        base += cnt;
    }
}
__device__ __forceinline__ void spare_convert(const Ctx& C, const Args& a, int first, int last, int nwg) {
    const int R = (nwg + C.G - 1) / C.G, first_spare = nwg - (R - 1) * C.G, nspare = C.G - first_spare, c = (int)blockIdx.x;
    if (nspare > 0) { if (c >= first_spare) convert_mats(C, a, first, last, (c - first_spare) * NWAVES + C.wave, nspare * NWAVES); }
    else convert_mats(C, a, first, last, c * NWAVES + C.wave, C.G * NWAVES);
    __syncthreads();
}
__device__ __forceinline__ int t5_bucket(int n) {
    if (n < 16) return n;
    int b = 16;
    b += (n >= 22) + (n >= 30) + (n >= 40) + (n >= 54) + (n >= 73) + (n >= 99) + (n >= 134) + (n >= 182) + (n >= 246) + (n >= 332) + (n >= 450) + (n >= 609) + (n >= 825) + (n >= 1117) + (n >= 1513);
    return b;
}
__device__ __forceinline__ void p_prologue(const Ctx& C, const Args& a) {
    const int gw = C.vcu * NWAVES + C.wave, NGW = C.G * NWAVES;
    convert_mats(C, a, 0, 1, gw, NGW);
    {   LAS unsigned char* scr = C.lds + C.wave * 8192;
        for (int it = gw; it < 2 * NBLK * 4; it += NGW) { const int which = it / (NBLK * 4), r = it % (NBLK * 4), blk = r >> 2, sub = r & 3;
            const float* W = (which ? a.in[I_WX] : a.in[I_WA]) + (size_t)blk * RBLK * RBLK; bf16* WT = (bf16*)(C.ws + (which ? WS_WX : WS_WA)) + (size_t)blk * RBLK * RBLK;
            transpose_item(W, RBLK, RBLK, nullptr, WT, CM_NONE, scr, sub, C.lane); } }
    const float* x = a.in[I_X]; bf16* xb = (bf16*)(C.ws + WS_XB); float* ssq = (float*)(C.ws + WS_SSQ);
    for (int m = gw; m < M; m += NGW) {
        const GAS f32x4* xr = (const GAS f32x4*)(x + (size_t)m * D) + C.lane; f32x4 v[4]; float s = 0.f;
#pragma unroll
        for (int j = 0; j < 4; ++j) { v[j] = __builtin_nontemporal_load(xr + 64 * j); s += (v[j].x * v[j].x + v[j].y * v[j].y) + (v[j].z * v[j].z + v[j].w * v[j].w); }
        s = wave_sum(s);
        GAS v2u* o8 = (GAS v2u*)(xb + (size_t)m * D) + C.lane;
#pragma unroll
        for (int j = 0; j < 4; ++j) { v2u w; w.x = pk2(v[j].x, v[j].y); w.y = pk2(v[j].z, v[j].w); o8[64 * j] = w; }
        if (C.lane < 16) ssq[(size_t)m * 16 + C.lane] = (C.lane == 0) ? s : 0.f;
    }
    float* bt = (float*)(C.ws + WS_BIAS); const float* rb = a.in[I_RELB];
    for (int i = blockIdx.x * 512 + C.tid; i < 48 * 129; i += C.G * 512) { const int gh = i / 129, dist = i - gh * 129, g = gh >> 4;
        bt[gh * 132 + dist] = rb[t5_bucket(dist << (2 * g)) * 48 + gh] * LOG2E; }
}

typedef float f32x16 __attribute__((ext_vector_type(16)));
typedef short bf16x8v __attribute__((ext_vector_type(8)));
constexpr int RM_WB = 0, RM_WB_GATE = 64 * 272, RM_CW = 36864, RM_CMP = RM_CW + 2560, RM_TILE = 49152, RM_TILE_BYTES = 36 * 256, RM_END = RM_TILE + 8 * RM_TILE_BYTES;
static_assert(RM_WB + 2 * RM_WB_GATE <= RM_CW && RM_CMP + 2 * 2 * 8 * 64 * 4 <= RM_TILE && RM_END <= RING_BYTES, "rnn-mid LDS map");
__device__ __forceinline__ bf16x8v pack8(const float (&v)[8]) {
    v4u w; w.x = pg8::cvt_pk_bf16(v[0], v[1]); w.y = pg8::cvt_pk_bf16(v[2], v[3]); w.z = pg8::cvt_pk_bf16(v[4], v[5]); w.w = pg8::cvt_pk_bf16(v[6], v[7]);
    return __builtin_bit_cast(bf16x8v, w);
}
__device__ __forceinline__ void p_rnn_mid(const Ctx& C, const Args& a) {
    const bf16* U = (const bf16*)(C.ws + WS_U); const bf16* Gb = (const bf16*)(C.ws + WS_G); bf16* Y = (bf16*)(C.ws + WS_Y);
    const bf16* WAb = (const bf16*)(C.ws + WS_WA); const bf16* WXb = (const bf16*)(C.ws + WS_WX);
    LAS unsigned char* L = C.lds;
    LAS float* CW = (LAS float*)(L + RM_CW); LAS float* CMP = (LAS float*)(L + RM_CMP);
    const int wave = C.wave;
    LAS unsigned char* wt = L + RM_TILE + wave * RM_TILE_BYTES;
    for (int item = blockIdx.x; item < BATCH * NBLK * 2; item += C.G) {
        const int b = item / (NBLK * 2), n = (item % (NBLK * 2)) >> 1, half = item & 1;
        int tid = C.tid; asm volatile("" : "+v"(tid));
        const int lane = tid & 63, r32 = lane & 31, hh = lane >> 5;
        __syncthreads();
#pragma unroll
        for (int p = 0; p < 4; ++p) { const int idx = p * 512 + tid, gate = idx >> 10, rem = idx & 1023, row = rem >> 4, c16 = rem & 15;
            const v4u w = *(const v4u*)((gate ? WXb : WAb) + (size_t)(n * 128 + 64 * half + row) * 128 + c16 * 8);
            *(LAS v4u*)(L + RM_WB + gate * RM_WB_GATE + row * 272 + c16 * 16) = w; }
        CW[tid] = a.in[I_CONV_W][(tid >> 7) * DRNN + n * 128 + (tid & 127)];
        if (tid < 128) CW[512 + tid] = a.in[I_CONV_B][n * 128 + tid];
        __syncthreads();
        float ba[2], bx[2], spl[2], Ht[2];
#pragma unroll
        for (int cb = 0; cb < 2; ++cb) { const int ch = n * 128 + 64 * half + 32 * cb + r32; ba[cb] = a.in[I_BA][ch]; bx[cb] = a.in[I_BX][ch];
            spl[cb] = -8.0f * LOG2E * log1pf(expf(-a.in[I_LAM][ch])); Ht[cb] = 0.f; }
        bf16x8v idf[2];
#pragma unroll
        for (int sp = 0; sp < 2; ++sp)
#pragma unroll
            for (int j = 0; j < 8; ++j) idf[sp][j] = (16 * sp + 8 * hh + j == r32) ? (short)0x3F80 : (short)0;
        const int urow = lane >> 4, uch = lane & 15, grow = lane >> 3, gch = lane & 7;
        v4u uraw[9], graw[4];
#define RM_LOADU(TILE) do { const int tp_ = (TILE) * 256 + wave * 32; const int ub_ = (b * SEQ + tp_ - 3 + urow) * DRNN + n * 128 + uch * 8;        \
        _Pragma("unroll") for (int i_ = 0; i_ < 9; ++i_) uraw[i_] = *(const v4u*)(U + (ptrdiff_t)(ub_ + i_ * 4 * DRNN)); \
        if (tp_ == 0 && urow < 3) uraw[0] = (v4u){0u, 0u, 0u, 0u};         } while (0)
#define RM_LOADG(TILE) do { const int gb_ = (b * SEQ + (TILE) * 256 + wave * 32 + grow) * DRNN + n * 128 + 64 * half + gch * 8; \
        _Pragma("unroll") for (int i_ = 0; i_ < 4; ++i_) graw[i_] = *(const v4u*)(Gb + (unsigned)(gb_ + i_ * 8 * DRNN)); } while (0)
        RM_LOADU(0);
        for (int tile = 0; tile < 8; ++tile) {
            const int tposw = tile * 256 + wave * 32;
            const size_t tok0 = (size_t)b * SEQ + tposw;
            LAS float* CWt = CW; LAS unsigned char* WBt = L + RM_WB; asm volatile("" : "+v"(CWt), "+v"(WBt));
            RM_LOADG(tile);
#pragma unroll
            for (int i = 0; i < 9; ++i) { const int rl = 4 * i + urow; *(LAS v4u*)(wt + rl * 256 + ((uch ^ (rl & 15)) << 4)) = uraw[i]; }
            {
                const int tg = lane >> 4, cc = lane & 15;
                f32x2 wv[4][4], bv2[4];
#pragma unroll
                for (int k = 0; k < 4; ++k) { const f32x4 w0 = *(const LAS f32x4*)(CWt + k * 128 + 8 * cc), w1 = *(const LAS f32x4*)(CWt + k * 128 + 8 * cc + 4);
                    wv[k][0] = (f32x2){w0[0], w0[1]}; wv[k][1] = (f32x2){w0[2], w0[3]}; wv[k][2] = (f32x2){w1[0], w1[1]}; wv[k][3] = (f32x2){w1[2], w1[3]}; }
                { const f32x4 b0 = *(const LAS f32x4*)(CWt + 512 + 8 * cc), b1 = *(const LAS f32x4*)(CWt + 512 + 8 * cc + 4);
                  bv2[0] = (f32x2){b0[0], b0[1]}; bv2[1] = (f32x2){b0[2], b0[3]}; bv2[2] = (f32x2){b1[0], b1[1]}; bv2[3] = (f32x2){b1[2], b1[3]}; }
                v4u ur[11];
#pragma unroll
                for (int j = 0; j < 11; ++j) { const int rl = 8 * tg + j; ur[j] = *(const LAS v4u*)(wt + rl * 256 + ((cc ^ (rl & 15)) << 4)); }
                f32x2 o[8][4];
#pragma unroll
                for (int i = 0; i < 8; ++i)
#pragma unroll
                    for (int e = 0; e < 4; ++e) o[i][e] = bv2[e];
#pragma unroll
                for (int j = 0; j < 11; ++j) {
                    const f32x2 u0 = (f32x2){bf_lo(ur[j].x), bf_hi(ur[j].x)}, u1 = (f32x2){bf_lo(ur[j].y), bf_hi(ur[j].y)}, u2 = (f32x2){bf_lo(ur[j].z), bf_hi(ur[j].z)}, u3 = (f32x2){bf_lo(ur[j].w), bf_hi(ur[j].w)};
#pragma unroll
                    for (int k = 0; k < 4; ++k) { const int i = j - k; if (i >= 0 && i < 8) {
                        o[i][0] += wv[k][0] * u0; o[i][1] += wv[k][1] * u1; o[i][2] += wv[k][2] * u2; o[i][3] += wv[k][3] * u3; } }
                }
#pragma unroll
                for (int i = 0; i < 8; ++i) { const int rl = 8 * tg + i;
                    v4u w; w.x = pg8::cvt_pk_bf16(o[i][0].x, o[i][0].y); w.y = pg8::cvt_pk_bf16(o[i][1].x, o[i][1].y); w.z = pg8::cvt_pk_bf16(o[i][2].x, o[i][2].y); w.w = pg8::cvt_pk_bf16(o[i][3].x, o[i][3].y);
                    *(LAS v4u*)(wt + rl * 256 + ((cc ^ (rl & 15)) << 4)) = w; }
            }
            bf16x8v af[8];
#pragma unroll
            for (int s = 0; s < 8; ++s) af[s] = *(const LAS bf16x8v*)(wt + r32 * 256 + (((2 * s + hh) ^ (r32 & 15)) << 4));
#pragma unroll
            for (int i = 0; i < 4; ++i) *(LAS v4u*)(wt + (8 * i + grow) * 128 + gch * 16) = graw[i];
            f32x16 acc[2][2], ufa[2];
#pragma unroll
            for (int cb = 0; cb < 2; ++cb)
#pragma unroll
                for (int e = 0; e < 16; ++e) { acc[0][cb][e] = 0.f; acc[1][cb][e] = 0.f; ufa[cb][e] = 0.f; }
            bf16x8v bq[2][4];
#define RM_LDB(S, DST) do { _Pragma("unroll") for (int g_ = 0; g_ < 2; ++g_) _Pragma("unroll") for (int c_ = 0; c_ < 2; ++c_) \
                DST[g_ * 2 + c_] = *(const LAS bf16x8v*)(WBt + g_ * RM_WB_GATE + (32 * c_ + r32) * 272 + (16 * (S) + 8 * hh) * 2); } while (0)
            RM_LDB(0, bq[0]);
#pragma unroll
            for (int s = 0; s < 8; ++s) {
                if (s < 7) RM_LDB(s + 1, bq[(s + 1) & 1]);
#pragma unroll
                for (int gt = 0; gt < 2; ++gt)
#pragma unroll
                    for (int cb = 0; cb < 2; ++cb) acc[gt][cb] = __builtin_amdgcn_mfma_f32_32x32x16_bf16(af[s], bq[s & 1][gt * 2 + cb], acc[gt][cb], 0, 0, 0);
            }
#undef RM_LDB
#pragma unroll
            for (int cb = 0; cb < 2; ++cb)
#pragma unroll
                for (int sp = 0; sp < 2; ++sp) { const bf16x8v asel = half ? af[4 + 2 * cb + sp] : af[2 * cb + sp];
                    ufa[cb] = __builtin_amdgcn_mfma_f32_32x32x16_bf16(asel, idf[sp], ufa[cb], 0, 0, 0); }
#pragma unroll
            for (int cb = 0; cb < 2; ++cb)
#pragma unroll
                for (int e = 0; e < 16; ++e) {
                    const float uf = ufa[cb][e];
                    const float r = fast_sigmoid(acc[0][cb][e] + ba[cb]), ii = fast_sigmoid(acc[1][cb][e] + bx[cb]);
                    const float av = __builtin_amdgcn_exp2f(r * spl[cb]);
                    const float bv = __builtin_amdgcn_sqrtf(fmaxf(1.f - av * av, 0.f)) * (ii * uf);
                    acc[0][cb][e] = av; acc[1][cb][e] = bv;
                }
            float A0[2][4], B0[2][4], A1[2][4], B1[2][4];
            const int par = tile & 1;
#pragma unroll
            for (int cb = 0; cb < 2; ++cb) {
                float Aw = 1.f, Bw = 0.f;
#pragma unroll
                for (int q = 0; q < 4; ++q) {
                    const float a0 = acc[0][cb][4 * q], a1 = acc[0][cb][4 * q + 1], a2 = acc[0][cb][4 * q + 2], a3 = acc[0][cb][4 * q + 3];
                    const float Ag = (a0 * a1) * (a2 * a3);
                    const float Bg = ((acc[1][cb][4 * q] * a1 + acc[1][cb][4 * q + 1]) * a2 + acc[1][cb][4 * q + 2]) * a3 + acc[1][cb][4 * q + 3];
                    const float pA = __shfl_xor(Ag, 32), pB = __shfl_xor(Bg, 32);
                    A0[cb][q] = hh ? pA : Ag; B0[cb][q] = hh ? pB : Bg; A1[cb][q] = hh ? Ag : pA; B1[cb][q] = hh ? Bg : pB;
                    Bw = Bw * A0[cb][q] + B0[cb][q]; Aw *= A0[cb][q]; Bw = Bw * A1[cb][q] + B1[cb][q]; Aw *= A1[cb][q];
                }
                if (hh == 0) { CMP[((par * 2 + 0) * 8 + wave) * 64 + 32 * cb + r32] = Aw; CMP[((par * 2 + 1) * 8 + wave) * 64 + 32 * cb + r32] = Bw; }
            }
            __syncthreads();
            if (tile < 7) RM_LOADU(tile + 1);
#pragma unroll
            for (int cb = 0; cb < 2; ++cb) {
                float h = Ht[cb], hin = 0.f;
#pragma unroll
                for (int v = 0; v < 8; ++v) { const float Av = CMP[((par * 2 + 0) * 8 + v) * 64 + 32 * cb + r32], Bv = CMP[((par * 2 + 1) * 8 + v) * 64 + 32 * cb + r32];
                    hin = (v == wave) ? h : hin; h = Av * h + Bv; }
                Ht[cb] = h;
                float hc = hin;
#pragma unroll
                for (int q = 0; q < 4; ++q) {
                    const float c0 = hc; hc = A0[cb][q] * hc + B0[cb][q]; const float c1 = hc; hc = A1[cb][q] * hc + B1[cb][q];
                    float hv = hh ? c1 : c0;
#pragma unroll
                    for (int i = 0; i < 4; ++i) { const int e = 4 * q + i; hv = acc[0][cb][e] * hv + acc[1][cb][e];
                        const int tl = (e & 3) + 8 * (e >> 2) + 4 * hh;
                        LAS bf16* gp = (LAS bf16*)(wt + tl * 128 + (32 * cb + r32) * 2);
                        *gp = (bf16)f2bf(hv * bf2f(*gp)); }
                }
            }
#pragma unroll
            for (int i = 0; i < 4; ++i) { const v4u w = *(const LAS v4u*)(wt + (8 * i + grow) * 128 + gch * 16);
                *(v4u*)(Y + (unsigned)(((int)tok0 + 8 * i + grow) * DRNN + n * 128 + 64 * half + gch * 8)) = w; }
        }
#undef RM_LOADU
#undef RM_LOADG
    }
    const int nitems = BATCH * NBLK * 2;
    if (C.G > nitems) { if ((int)blockIdx.x >= nitems) convert_mats(C, a, 4, 7, ((int)blockIdx.x - nitems) * NWAVES + wave, (C.G - nitems) * NWAVES); }
    else { __syncthreads(); convert_mats(C, a, 4, 7, (int)blockIdx.x * NWAVES + wave, C.G * NWAVES); }
}
struct AttnUnit { const bf16* qrows; const bf16* kres; const bf16* vres; int l0, kb_lo, eoff; };
__device__ __forceinline__ AttnUnit attn_unit(const bf16* QKV, int g, int bh, int llin0) {
    AttnUnit u; const size_t SLAB = (size_t)M * 1024; const int L = SEQ >> (2 * g);
    u.l0 = llin0 & (L - 1); u.kb_lo = (u.l0 - 128) > 0 ? (u.l0 - 128) : 0; u.eoff = g * 192;
    u.qrows = QKV + (size_t)g * SLAB + ((size_t)bh * SEQ + llin0) * HD;
    u.kres = u.qrows + 3 * SLAB - (size_t)u.l0 * HD; u.vres = u.qrows + 6 * SLAB - (size_t)u.l0 * HD;
    return u;
}
typedef __bf16 bf16x2n __attribute__((ext_vector_type(2)));
__device__ __forceinline__ unsigned cvtpk_n(float lo, float hi) { const f32x2 v = {lo, hi}; return __builtin_bit_cast(unsigned, __builtin_convertvector(v, bf16x2n)); }
constexpr int AT_VT = 0, AT_EXT = 8 * 8192, AT_LACC = AT_EXT + 3 * 192 * 4, AT_OACC = AT_EXT + 4608;
static_assert(AT_LACC + 512 * 4 <= AT_OACC && AT_OACC + 512 * 128 <= MISC_OFF, "attention LDS map");
#define AT_QBLOCK(QF, O0, O1, MROW, LSUM, EB) do { \
        f32x16 p_; _Pragma("unroll") for (int e = 0; e < 16; ++e) p_[e] = 0.f; \
        _Pragma("unroll") for (int s_ = 0; s_ < 4; ++s_) p_ = __builtin_amdgcn_mfma_f32_32x32x16_bf16(kf[s_], QF[s_], p_, 0, 0, 0); \
        float bm_ = -1e30f; \
        _Pragma("unroll") for (int e = 0; e < 16; ++e) { p_[e] += ext[(EB) - ((e & 3) + 8 * (e >> 2))]; bm_ = fmaxf(bm_, p_[e]); } \
        bm_ = fmaxf(bm_, __shfl_xor(bm_, 32)); \
        const float mn_ = fmaxf(MROW, bm_), alpha_ = __builtin_amdgcn_exp2f(MROW - mn_); MROW = mn_; \
        float ps_ = 0.f; \
        _Pragma("unroll") for (int e = 0; e < 16; ++e) { p_[e] = __builtin_amdgcn_exp2f(p_[e] - mn_); ps_ += p_[e]; } \
        LSUM = LSUM * alpha_ + ps_; \
        _Pragma("unroll") for (int e = 0; e < 16; ++e) { O0[e] *= alpha_; O1[e] *= alpha_; } \
        _Pragma("unroll") for (int s_ = 0; s_ < 2; ++s_) { \
            v4u w_; w_.x = cvtpk_n(p_[8 * s_], p_[8 * s_ + 1]); w_.y = cvtpk_n(p_[8 * s_ + 2], p_[8 * s_ + 3]); w_.z = cvtpk_n(p_[8 * s_ + 4], p_[8 * s_ + 5]); w_.w = cvtpk_n(p_[8 * s_ + 6], p_[8 * s_ + 7]); \
            const bf16x8v pf_ = __builtin_bit_cast(bf16x8v, w_); \
            const v4i16_t a00_ = vtr16(vt + (16 * s_) * 64 + vtr_off), a01_ = vtr16(vt + (16 * s_ + 8) * 64 + vtr_off), a10_ = vtr16(vt + 2048 + (16 * s_) * 64 + vtr_off), a11_ = vtr16(vt + 2048 + (16 * s_ + 8) * 64 + vtr_off); \
            O0 = __builtin_amdgcn_mfma_f32_32x32x16_bf16((bf16x8v){a00_[0], a00_[1], a00_[2], a00_[3], a01_[0], a01_[1], a01_[2], a01_[3]}, pf_, O0, 0, 0, 0); \
            O1 = __builtin_amdgcn_mfma_f32_32x32x16_bf16((bf16x8v){a10_[0], a10_[1], a10_[2], a10_[3], a11_[0], a11_[1], a11_[2], a11_[3]}, pf_, O1, 0, 0, 0); } \
    } while (0)
#define AT_COMBINE(MODE, O0, O1, MROW, LSUM, TL) do { \
        const float ltot_ = LSUM + __shfl_xor(LSUM, 32), inv_ = 1.f / ltot_, lse_ = MROW + log2f(ltot_); const int tl_ = (TL); \
        LAS unsigned char* orow_ = C.lds + AT_OACC + tl_ * 128; LAS float* lacc_ = (LAS float*)(C.lds + AT_LACC); \
        float wo_ = 0.f, wn_ = inv_; \
        if (MODE != 0) { const float lo_ = lacc_[tl_], mx_ = fmaxf(lo_, lse_), eo_ = __builtin_amdgcn_exp2f(lo_ - mx_), en_ = __builtin_amdgcn_exp2f(lse_ - mx_), rs_ = 1.f / (eo_ + en_); \
            wo_ = eo_ * rs_; wn_ = en_ * rs_ * inv_; if (MODE == 1 && hh == 0) lacc_[tl_] = mx_ + log2f(eo_ + en_); } \
        else if (hh == 0) lacc_[tl_] = lse_; \
        _Pragma("unroll") for (int q = 0; q < 4; ++q) { \
            LAS v2u* p0_ = (LAS v2u*)(orow_ + ((q ^ (tl_ & 7)) << 4) + 8 * hh); LAS v2u* p1_ = (LAS v2u*)(orow_ + (((4 + q) ^ (tl_ & 7)) << 4) + 8 * hh); \
            float a_[8] = {O0[4 * q] * wn_, O0[4 * q + 1] * wn_, O0[4 * q + 2] * wn_, O0[4 * q + 3] * wn_, O1[4 * q] * wn_, O1[4 * q + 1] * wn_, O1[4 * q + 2] * wn_, O1[4 * q + 3] * wn_}; \
            if (MODE != 0) { const v2u c0_ = *p0_, c1_ = *p1_; \
                a_[0] += wo_ * bf_lo(c0_.x); a_[1] += wo_ * bf_hi(c0_.x); a_[2] += wo_ * bf_lo(c0_.y); a_[3] += wo_ * bf_hi(c0_.y); \
                a_[4] += wo_ * bf_lo(c1_.x); a_[5] += wo_ * bf_hi(c1_.x); a_[6] += wo_ * bf_lo(c1_.y); a_[7] += wo_ * bf_hi(c1_.y); } \
            v2u w0_, w1_; w0_.x = cvtpk_n(a_[0], a_[1]); w0_.y = cvtpk_n(a_[2], a_[3]); w1_.x = cvtpk_n(a_[4], a_[5]); w1_.y = cvtpk_n(a_[6], a_[7]); \
            if (MODE != 2) { *p0_ = w0_; *p1_ = w1_; } \
            else { bf16* g_ = ATT + (size_t)(row0 + tl_) * 1024 + h * 64 + 8 * q + 4 * hh; *(v2u*)g_ = w0_; *(v2u*)(g_ + 32) = w1_; } } \
    } while (0)
__device__ __forceinline__ void p_attn(const Ctx& C, bf16* ATT) {
    const bf16* QKV = (const bf16*)(C.ws + WS_QKV); const float* bt = (const float*)(C.ws + WS_BIAS);
    LAS float* ext = (LAS float*)(C.lds + AT_EXT);
    LAS unsigned char* vt = C.lds + AT_VT + C.wave * 8192; LAS unsigned char* kt = vt + 4096;
    const int wave = C.wave;
    v4u kfn[4], vvn[4];
#define AT_LOADKV(U, KB) do { const bf16* kblk_ = (U).kres + (size_t)(KB) * HD; const bf16* vblk_ = (U).vres + (size_t)(KB) * HD; \
        _Pragma("unroll") for (int i_ = 0; i_ < 4; ++i_) { vvn[i_] = *(const v4u*)(vblk_ + (8 * i_ + crow8) * HD + cch * 8); kfn[i_] = *(const v4u*)(kblk_ + (8 * i_ + crow8) * HD + cch * 8); } } while (0)
#define AT_TILE2FRAG(RAW, OFS, FR) do { _Pragma("unroll") for (int i_ = 0; i_ < 4; ++i_) *(LAS v4u*)(kt + (8 * i_ + crow8) * 128 + ((cch ^ crow8) << 4)) = RAW[(OFS) + i_]; \
        _Pragma("unroll") for (int s_ = 0; s_ < 4; ++s_) FR[s_] = *(const LAS bf16x8v*)(kt + r32 * 128 + (((2 * s_ + hh) ^ (r32 & 7)) << 4)); } while (0)
#define AT_LOADQFRAG(U, ROW0, FR) do { v4u q_[4]; _Pragma("unroll") for (int i_ = 0; i_ < 4; ++i_) q_[i_] = *(const v4u*)((U).qrows + ((ROW0) + 8 * i_ + crow8) * HD + cch * 8); AT_TILE2FRAG(q_, 0, FR); } while (0)
#define AT_STEP(KB, USEA, USEB) do { const int kb_ = (KB); \
            v4u vv[4], kraw[4]; bf16x8v kf[4]; \
            _Pragma("unroll") for (int i = 0; i < 4; ++i) { vv[i] = vvn[i]; kraw[i] = kfn[i]; } \
            if (kb_ - 32 >= cu.kb_lo) { AT_LOADKV(cu, kb_ - 32); } else if (has_next) { AT_LOADKV(nu, nu.l0); AT_LOADQ(nu); } \
            _Pragma("unroll") for (int i = 0; i < 4; ++i) *(LAS v4u*)(vt + (cch >> 2) * 2048 + (8 * i + crow8) * 64 + (cch & 3) * 16) = vv[i]; \
            AT_TILE2FRAG(kraw, 0, kf); \
            const int ebA = cu.eoff + cu.l0 + r32 - kb_ - 4 * hh + 32;            \
            if (USEA) { AT_QBLOCK(qfA, oA0, oA1, mA, lA, ebA); } \
        } while (0)
#define AT_ZERO(O0, O1, MR, LS) do { _Pragma("unroll") for (int e = 0; e < 16; ++e) { O0[e] = 0.f; O1[e] = 0.f; } MR = -1e30f; LS = 0.f; } while (0)
#define AT_DESC(V, STEP, U) do { const int v_ = (V), st_ = (STEP), bh_ = (v_ >> 1) & 127, sx_ = ((v_ & 1) << 1) | (v_ >> 8), s_ = (sx_ == 0) ? 0 : (sx_ == 1) ? 3 : (sx_ == 2) ? 1 : 2, g_ = st_ >> 1, j_ = st_ & 1; \
        const int ll_ = (g_ == 0) ? 512 * s_ + 64 * wave + 32 * j_ : (g_ == 1) ? (wave >> 1) * 512 + 128 * s_ + 64 * (wave & 1) + 32 * j_ : (2 * wave + j_) * 128 + 32 * s_; \
        U = attn_unit(QKV, g_, bh_, ll_); } while (0)
#define AT_LOADQ(U) do { _Pragma("unroll") for (int i_ = 0; i_ < 4; ++i_) qraw[i_] = *(const v4u*)((U).qrows + (8 * i_ + crow8) * HD + cch * 8); } while (0)
    const int total = BATCH * NHEAD * 4;
    if ((int)blockIdx.x >= total) return;
    AttnUnit nu; v4u qraw[4];
    {   const int lane = C.lane, crow8 = lane >> 3, cch = lane & 7;
        AT_DESC(blockIdx.x, 0, nu); AT_LOADKV(nu, nu.l0); AT_LOADQ(nu); }
    for (int v = blockIdx.x; v < total; v += C.G) {
        int tid = C.tid; asm volatile("" : "+v"(tid));
        const int lane = tid & 63, r32 = lane & 31, hh = lane >> 5;
        const int crow8 = lane >> 3, cch = lane & 7;
        const int vtr_off = (4 * hh + ((lane & 15) >> 2)) * 64 + ((lane >> 4) & 1) * 32 + (lane & 3) * 8;
        const int bh = (v >> 1) & 127, sidx = ((v & 1) << 1) | (v >> 8), s = (sidx == 0) ? 0 : (sidx == 1) ? 3 : (sidx == 2) ? 1 : 2, h = bh & 15;
        const int row0 = (bh >> 4) * SEQ + 512 * s;
        __syncthreads();
        for (int i = tid; i < 3 * 192; i += 512) { const int g = i / 192, dist = i - g * 192 - 32; ext[i] = (dist >= 0 && dist <= 128) ? bt[(g * 16 + h) * 132 + dist] : -1e30f; }
        __syncthreads();
        f32x16 oA0, oA1; float mA, lA; bf16x8v qfA[4];
#pragma unroll 1
        for (int step = 0; step < 6; ++step) {
            const int g = step >> 1, j = step & 1;
            const int tl = (g == 0) ? 64 * wave + 32 * j + r32 : (g == 1) ? 256 * (wave & 1) + (wave >> 1) + 4 * (32 * j + r32) : 16 * r32 + 2 * wave + j;
            const AttnUnit cu = nu;
            const bool has_next = (step < 5) || (v + C.G < total);
            if (has_next) { if (step < 5) AT_DESC(v, step + 1, nu); else AT_DESC(v + C.G, 0, nu); }
            AT_TILE2FRAG(qraw, 0, qfA);
            AT_ZERO(oA0, oA1, mA, lA);
            for (int kb = cu.l0; kb >= cu.kb_lo; kb -= 32) AT_STEP(kb, true, false);
            AT_COMBINE(g, oA0, oA1, mA, lA, tl);
            if (j == 1 && g < 2) __syncthreads();
        }
    }
#undef AT_DESC
#undef AT_LOADQ
#undef AT_LOADKV
#undef AT_TILE2FRAG
#undef AT_LOADQFRAG
#undef AT_STEP
#undef AT_ZERO
}
#undef AT_QBLOCK
#undef AT_COMBINE
enum { PH_PROLOGUE = 0, PH_FFN_IN_0, PH_FFN_OUT_0, PH_RNN_IN, PH_RNN_MID, PH_RNN_OUT, PH_FFN_IN_1, PH_FFN_OUT_1,
       PH_FFN_IN_2, PH_FFN_OUT_2, PH_QKV, PH_ATTN, PH_WO, PH_FFN_IN_3, PH_FFN_OUT_3, NPHASE };

__global__ void __launch_bounds__(NWAVES * 64, 2) fwd_kernel(Args args) {
    extern __shared__ __attribute__((aligned(16))) unsigned char lds_raw[];
    Ctx C; C.lds = (LAS unsigned char*)lds_raw; C.tid = threadIdx.x; C.lane = C.tid & 63; C.wave = __builtin_amdgcn_readfirstlane(C.tid >> 6);
    C.G = gridDim.x; { const int bx = blockIdx.x; C.vcu = (C.G % 8 == 0) ? (bx % 8) * (C.G / 8) + bx / 8 : bx; }
    C.ws = args.ws;
    volatile LAS unsigned* MISC = (volatile LAS unsigned*)(C.lds + MISC_OFF);
    if (C.tid < 32) ((LAS unsigned*)(C.lds + MISC_OFF))[C.tid] = 0u;
    __syncthreads();
    unsigned* ctl = (unsigned*)args.ws;
    XcdBarrier bar; bar.bar = ctl + CW_BAR; bar.x = 0; bar.st = nullptr;
    const bool multi = (args.ph_hi - args.ph_lo) > 1;
    if (multi) bar = xcd_barrier_post(ctl + CW_BAR, MISC + 8);
    for (int ph = args.ph_lo; ph < args.ph_hi; ++ph) {
        for (int rep = ((DUP_MASK >> ph) & 1u) ? DUP_N : 0; rep >= 0; --rep) {
        const bool dry = rep > 0;
        { int t_ = threadIdx.x; asm volatile("" : "+v"(t_)); C.tid = t_; C.lane = t_ & 63; }
        unsigned char* ws = args.ws;
        C.ws = ws; float* ssq = (float*)(ws + WS_SSQ); bf16* xb = (bf16*)(ws + WS_XB);
        switch (ph) {
        case PH_PROLOGUE: p_prologue(C, args); break;
        case PH_FFN_IN_0: case PH_FFN_IN_1: case PH_FFN_IN_2: case PH_FFN_IN_3: {
            if (!dry && ph != PH_FFN_IN_3) { const int f = (ph == PH_FFN_IN_0) ? 1 : (ph == PH_FFN_IN_1) ? 8 : 10, l = (ph == PH_FFN_IN_0) ? 4 : (ph == PH_FFN_IN_1) ? 10 : 12; spare_convert(C, args, f, l, (M / 256) * (2 * FF / 256)); }
            const bf16* Bt = (ph == PH_FFN_IN_3) ? (const bf16*)args.out : (const bf16*)(ws + (ph == PH_FFN_IN_0 ? WS_WIN0 : ph == PH_FFN_IN_1 ? WS_WIN1 : WS_WIN2));
            bf16* act = (bf16*)(ws + (ph == PH_FFN_IN_3 ? WS_ACT3 : WS_ACT));
            pg8::Gemm g{xb, Bt, M, 2 * FF, D}; pg8::StaticOrder S; S.init(M, 2 * FF, C.G, (int)blockIdx.x);
            fill_rstd(C.lds, S, ssq, C.tid);
            EpiSwiGLU E{(const LAS float*)(C.lds + RSTD_OFF), act, dry ? DUP_SKIP_EPI : 0};
            pg8::gemm_phase<EpiSwiGLU, pg8::StaticOrder, true, true>(C.lds, g, S, E);
        } break;
        case PH_FFN_OUT_0: case PH_FFN_OUT_1: case PH_FFN_OUT_2: case PH_FFN_OUT_3: case PH_RNN_OUT: case PH_WO: {
            const bf16* A; const bf16* Bt; int K; float scale = 0.5f; const float* xin = args.out;
            if (ph == PH_FFN_OUT_0) { A = (const bf16*)(ws + WS_ACT); Bt = (const bf16*)(ws + WS_WOUT0); K = FF; xin = args.in[I_X]; }
            else if (ph == PH_FFN_OUT_1) { A = (const bf16*)(ws + WS_ACT); Bt = (const bf16*)(ws + WS_WOUT1); K = FF; }
            else if (ph == PH_FFN_OUT_2) { A = (const bf16*)(ws + WS_ACT); Bt = (const bf16*)(ws + WS_WOUT2); K = FF; }
            else if (ph == PH_FFN_OUT_3) { A = (const bf16*)(ws + WS_ACT3); Bt = (const bf16*)(ws + WS_WOUT3); K = FF; }
            else if (ph == PH_RNN_OUT) { A = (const bf16*)(ws + WS_Y); Bt = (const bf16*)(ws + WS_WROUT); K = DRNN; scale = 1.f; }
            else { A = (const bf16*)args.out + (size_t)8 * 1024 * 1024; Bt = (const bf16*)(ws + WS_WO); K = D; scale = 1.f; }
            if (dry && ph != PH_FFN_OUT_0) scale = 0.f;
            float* xo = args.out;
#if RESID_BF16
            if (ph != PH_FFN_OUT_0) xin = nullptr;
            if (ph != PH_FFN_OUT_3 || dry) xo = nullptr;
#endif
            pg8::Gemm g{A, Bt, M, D, K}; pg8::StaticOrder S; S.init(M, D, C.G, (int)blockIdx.x);
            EpiRes E{xin, xo, xb, ssq, scale, dry && DUP_SKIP_EPI};
            pg8::gemm_phase<EpiRes, pg8::StaticOrder, false, true>(C.lds, g, S, E);
        } break;
        case PH_RNN_IN: {
            if (!dry) spare_convert(C, args, 7, 8, (M / 256) * (2 * DRNN / 256));
            pg8::Gemm g{xb, (const bf16*)(ws + WS_WRIN), M, 2 * DRNN, D}; pg8::StaticOrder S; S.init(M, 2 * DRNN, C.G, (int)blockIdx.x);
            fill_rstd(C.lds, S, ssq, C.tid);
            EpiRnnIn E{(const LAS float*)(C.lds + RSTD_OFF), (bf16*)(ws + WS_G), (bf16*)(ws + WS_U)};
            pg8::gemm_phase<EpiRnnIn, pg8::StaticOrder, true, true>(C.lds, g, S, E);
        } break;
        case PH_RNN_MID: p_rnn_mid(C, args); break;
        case PH_QKV: {
            pg8::Gemm g{xb, (const bf16*)(ws + WS_WQKV), M, NQKV, D}; pg8::StaticOrder S; S.init(M, NQKV, C.G, (int)blockIdx.x);
            if (C.tid < 128) ((LAS float*)(C.lds + GAIN_OFF))[C.tid] = (C.tid < 64) ? args.in[I_QGAIN][C.tid] * (0.125f * LOG2E) : args.in[I_KGAIN][C.tid - 64];
            fill_rstd(C.lds, S, ssq, C.tid);
            EpiQKV E{(const LAS float*)(C.lds + RSTD_OFF), (const LAS float*)(C.lds + GAIN_OFF), (bf16*)(ws + WS_QKV), dry && DUP_SKIP_EPI};
            pg8::gemm_phase<EpiQKV, pg8::StaticOrder, true, true>(C.lds, g, S, E);
        } break;
        case PH_ATTN: if (!dry) p_attn(C, (bf16*)args.out + (size_t)8 * 1024 * 1024); break;
        default: break;
        }
        if (dry || ph + 1 < args.ph_hi) xcd_barrier(bar);
        if (ph == 0 && !dry) for (int eb = 0; eb < DUP_EXTRA_BARRIERS; ++eb) xcd_barrier(bar);
        }
    }
}

extern "C" void kernel_launch(void* const* d_in, const int* in_sizes, int n_in, void* d_out, int out_size, void* d_ws, size_t ws_size, hipStream_t stream) {
    static int grid = 0;
    if (grid == 0) {
        if (n_in != 18 || in_sizes[0] != M * D || out_size != M * D || ws_size < WS_END) { fprintf(stderr, "kernel_launch: unexpected shapes (n_in %d, in0 %d, out %d, ws %zu)\n", n_in, n_in > 0 ? in_sizes[0] : -1, out_size, ws_size); grid = -1; return; }
        int dev = 0, cus = 0, per_cu = 0;
        if (hipGetDevice(&dev) != hipSuccess || hipDeviceGetAttribute(&cus, hipDeviceAttributeMultiprocessorCount, dev) != hipSuccess) { fprintf(stderr, "kernel_launch: device query failed\n"); grid = -1; return; }
        if (hipFuncSetAttribute((const void*)fwd_kernel, hipFuncAttributeMaxDynamicSharedMemorySize, LDS_BYTES) != hipSuccess) { fprintf(stderr, "kernel_launch: hipFuncSetAttribute failed\n"); grid = -1; return; }
        if (hipOccupancyMaxActiveBlocksPerMultiprocessor(&per_cu, (const void*)fwd_kernel, NWAVES * 64, LDS_BYTES) != hipSuccess || per_cu < 1) { fprintf(stderr, "kernel_launch: occupancy query says %d blocks per CU\n", per_cu); (void)hipGetLastError(); grid = -1; return; }
        grid = cus;
    }
    if (grid < 0) return;
    if (hipMemsetAsync(d_ws, 0, CTL_ZERO_BYTES, stream) != hipSuccess) { fprintf(stderr, "kernel_launch: memset failed\n"); return; }
    Args a{};
    for (int i = 0; i < 18; ++i) a.in[i] = (const float*)d_in[i];
    a.out = (float*)d_out; a.ws = (unsigned char*)d_ws;
#if SINGLE_LAUNCH
    a.ph_lo = 0; a.ph_hi = NPHASE;
    hipLaunchKernelGGL(fwd_kernel, dim3(grid), dim3(NWAVES * 64), LDS_BYTES, stream, a);
#else
    for (int ph = 0; ph < NPHASE; ++ph) { a.ph_lo = ph; a.ph_hi = ph + 1; hipLaunchKernelGGL(fwd_kernel, dim3(grid), dim3(NWAVES * 64), LDS_BYTES, stream, a); }
#endif
}
```

```cpp
#include <hip/hip_runtime.h>
#include <cstdio>
#include <cstdint>

#ifndef SINGLE_LAUNCH
#define SINGLE_LAUNCH 1
#endif

namespace pg8 {
#define PG8_LAS __attribute__((address_space(3)))
typedef unsigned short bf16_t;
typedef short bf16x8 __attribute__((ext_vector_type(8)));
typedef float f32x4 __attribute__((ext_vector_type(4)));
typedef unsigned u32x4 __attribute__((ext_vector_type(4)));
constexpr int BM = 256, BK = 64, HALF = 128, HTB = HALF * BK * 2, STAGE_BYTES = 8 * HTB, NXCD = 8, WGM = 8;

__host__ __device__ __forceinline__ int lds_byte(int r, int c) { return (r >> 3) * 1024 + (r & 7) * 128 + ((((c >> 3) ^ (r & 7)) & 7) << 4) + (c & 7) * 2; }
__host__ __device__ __forceinline__ void stage_rc(int b, int& R, int& C) { const int sidx = b / 1024, w = b % 1024, rowin = w / 128, pch = (w % 128) / 16; R = sidx * 8 + rowin; C = ((pch ^ rowin) & 7) * 8; }
__host__ __device__ __forceinline__ int perm32(int rho) { const int n = rho >> 4, i = rho & 15; return 8 * (i >> 2) + 4 * n + (i & 3); }

struct Unit { int pm, pn; };
struct Gemm { const bf16_t* A; const bf16_t* Bt; int M, N, K; };

struct StaticOrder {
    int nM, nN, nwg, G, c;
    __host__ __device__ void init(int M, int N, int G_, int c_) { nM = M / BM; nN = N / BM; nwg = nM * nN; G = G_; c = c_; }
    __host__ __device__ bool next(int i, Unit& u) const {
        const long L = (long)i * G + c; if (L >= nwg) return false;
        int wgid = (int)L; { const int q = nwg / NXCD, r = nwg % NXCD, xcd = wgid % NXCD, off = wgid / NXCD; wgid = (xcd < r ? xcd * (q + 1) : r * (q + 1) + (xcd - r) * q) + off; }
        const int nig = WGM * nN, gid = wgid / nig, fm = gid * WGM, gsz = (nM - fm) < WGM ? (nM - fm) : WGM;
        u.pm = fm + ((wgid % nig) % gsz); u.pn = (wgid % nig) / gsz; return true;
    }
    __device__ __forceinline__ void a_ready(const Unit&) const {}
    __device__ __forceinline__ void done(const Unit&) const {}
};

__device__ __forceinline__ unsigned cvt_pk_bf16(float lo, float hi) { unsigned r; asm volatile("v_cvt_pk_bf16_f32 %0, %1, %2" : "=v"(r) : "v"(lo), "v"(hi)); return r; }

__device__ __forceinline__ int fresh_lane() { int l; asm volatile("v_mbcnt_lo_u32_b32 %0, -1, 0\n\tv_mbcnt_hi_u32_b32 %0, -1, %0" : "=v"(l)); return l; }
template <class Epi, class Sched, bool ALIGN_EPI = false, bool SP2 = false>
__device__ __forceinline__ void gemm_phase(PG8_LAS unsigned char* lds, const Gemm g, const Sched& S, const Epi& E, const int wave_) {
    int tid_ = wave_ * 64 + fresh_lane();
    const int tid = tid_, wid = wave_, lane = tid & 63, wr = wid >> 2, wc = wid & 3, fr = lane & 15, fq = lane >> 4;
    const int K = g.K, nt = K / BK;
    unsigned voffA, voffB;
    { int R, C; stage_rc(tid * 16, R, C); const int Rb = Epi::PERM ? ((R & ~31) + perm32(R & 31)) : R; voffA = (unsigned)(R * K + C) * 2u; voffB = (unsigned)(Rb * K + C) * 2u; }
    const size_t pstep = (size_t)64 * K * 2;
    const size_t kstep = (size_t)(BK * 2);
    const size_t hstep = (size_t)HALF * K * 2;
    const size_t tstep = 2 * hstep;
    const unsigned ldsw = (unsigned)wid * 1024u;
    const int aoff = lds_byte(wr * 64 + fr, fq * 8), boff = lds_byte(wc * 32 + fr, fq * 8);
#define PG8_SA(b, h) (((b) * 2 + (h)) * HTB)
#define PG8_SB(b, h) ((4 + (b) * 2 + (h)) * HTB)
#define PG8_STAGE(bufoff, gbase, voff) do { _Pragma("unroll") for (int _i = 0; _i < 2; ++_i) \
        __builtin_amdgcn_global_load_lds((const unsigned*)((const char*)(gbase) + _i * pstep + (voff)), (PG8_LAS unsigned*)(lds + (bufoff) + ldsw + _i * 8192), 16, 0, 0); } while (0)
#define PG8_LDA(dst, b, h) do { _Pragma("unroll") for (int m = 0; m < 4; ++m) _Pragma("unroll") for (int k = 0; k < 2; ++k) dst[m][k] = *(const PG8_LAS bf16x8*)(lds + PG8_SA(b, h) + (aoff ^ (k * 64)) + m * 2048); } while (0)
#define PG8_LDB(dst, b, h) do { _Pragma("unroll") for (int n = 0; n < 2; ++n) _Pragma("unroll") for (int k = 0; k < 2; ++k) dst[n][k] = *(const PG8_LAS bf16x8*)(lds + PG8_SB(b, h) + (boff ^ (k * 64)) + n * 2048); } while (0)
#define PG8_MMA(ai, bj, At, Bt) do { __builtin_amdgcn_s_setprio(1); _Pragma("unroll") for (int m = 0; m < 4; ++m) _Pragma("unroll") for (int n = 0; n < 2; ++n) _Pragma("unroll") for (int k = 0; k < 2; ++k) \
        acc[ai][bj][m][n] = __builtin_amdgcn_mfma_f32_16x16x32_bf16(Bt[n][k], At[m][k], acc[ai][bj][m][n], 0, 0, 0); __builtin_amdgcn_s_setprio(0); } while (0)
#define PG8_WAIT_V(n) asm volatile("s_waitcnt vmcnt(" #n ")" ::: "memory")
#define PG8_WAIT_L(n) asm volatile("s_waitcnt lgkmcnt(" #n ")" ::: "memory")
#define PG8_BAR __builtin_amdgcn_s_barrier()
#define PG8_SCHED __builtin_amdgcn_sched_barrier(0)
    Unit cur, nxt; int ui = 0;
    if (!S.next(0, cur)) return;
    f32x4 acc[2][2][4][2];
#pragma unroll
    for (int a = 0; a < 2; ++a)
#pragma unroll
        for (int b = 0; b < 2; ++b)
#pragma unroll
            for (int m = 0; m < 4; ++m)
#pragma unroll
                for (int n = 0; n < 2; ++n) acc[a][b][m][n] = (f32x4){0.f, 0.f, 0.f, 0.f};
    bf16x8 At[4][2], B0[2][2], B1[2][2];
    const char* cA = (const char*)g.A + (size_t)cur.pm * tstep; const char* cB = (const char*)g.Bt + (size_t)cur.pn * tstep;
    S.a_ready(cur);
    if constexpr (SP2) {
        PG8_STAGE(PG8_SB(0, 0), cB, voffB); PG8_STAGE(PG8_SB(0, 1), cB + hstep, voffB); PG8_STAGE(PG8_SA(0, 0), cA, voffA); PG8_STAGE(PG8_SA(0, 1), cA + hstep, voffA);
        if (wr == 1) PG8_BAR;
        PG8_WAIT_V(2); PG8_BAR;
        PG8_STAGE(PG8_SB(1, 0), cB + kstep, voffB); PG8_STAGE(PG8_SA(1, 0), cA + kstep, voffA); PG8_STAGE(PG8_SB(1, 1), cB + hstep + kstep, voffB);
        PG8_WAIT_V(6); PG8_BAR;
    } else {
        PG8_STAGE(PG8_SB(0, 0), cB, voffB); PG8_STAGE(PG8_SA(0, 0), cA, voffA); PG8_STAGE(PG8_SB(0, 1), cB + hstep, voffB); PG8_STAGE(PG8_SA(0, 1), cA + hstep, voffA);
        if (wr == 1) PG8_BAR;
        PG8_WAIT_V(4); PG8_BAR;
        PG8_STAGE(PG8_SB(1, 0), cB + kstep, voffB); PG8_STAGE(PG8_SA(1, 0), cA + kstep, voffA); PG8_STAGE(PG8_SB(1, 1), cB + hstep + kstep, voffB);
        PG8_WAIT_V(6); PG8_BAR;
    }
    for (;;) {
        const bool has_next = S.next(ui + 1, nxt);
        const char* nA = has_next ? (const char*)g.A + (size_t)nxt.pm * tstep : cA; const char* nB = has_next ? (const char*)g.Bt + (size_t)nxt.pn * tstep : cB;
        for (int t = 0; t < nt; t += 2) {
            const bool last = (t == nt - 2);
            const char* a1 = cA + (size_t)(t + 1) * kstep;
            const char* a2 = last ? nA : cA + (size_t)(t + 2) * kstep; const char* b2 = last ? nB : cB + (size_t)(t + 2) * kstep;
            const char* a3 = a2 + kstep; const char* b3 = b2 + kstep;
            if (last && has_next) S.a_ready(nxt);
            if constexpr (SP2) {
            PG8_LDB(B0, 0, 0); PG8_LDB(B1, 0, 1); PG8_SCHED; PG8_LDA(At, 0, 0); PG8_STAGE(PG8_SA(1, 1), a1 + hstep, voffA);
            PG8_WAIT_V(8); PG8_WAIT_L(0); PG8_BAR; PG8_MMA(0, 0, At, B0); PG8_MMA(0, 1, At, B1); PG8_BAR; PG8_SCHED;
            PG8_LDA(At, 0, 1); PG8_STAGE(PG8_SB(0, 0), b2, voffB); PG8_STAGE(PG8_SB(0, 1), b2 + hstep, voffB); PG8_STAGE(PG8_SA(0, 0), a2, voffA);
            PG8_WAIT_V(8); PG8_WAIT_L(0); PG8_BAR; PG8_MMA(1, 0, At, B0); PG8_MMA(1, 1, At, B1); PG8_BAR; PG8_SCHED;
            PG8_LDB(B0, 1, 0); PG8_LDB(B1, 1, 1); PG8_SCHED; PG8_LDA(At, 1, 0); PG8_STAGE(PG8_SA(0, 1), a2 + hstep, voffA);
            PG8_WAIT_V(8); PG8_WAIT_L(0); PG8_BAR; PG8_MMA(0, 0, At, B0); PG8_MMA(0, 1, At, B1); PG8_BAR; PG8_SCHED;
            PG8_LDA(At, 1, 1); PG8_STAGE(PG8_SB(1, 0), b3, voffB); PG8_STAGE(PG8_SB(1, 1), b3 + hstep, voffB); PG8_STAGE(PG8_SA(1, 0), a3, voffA);
            PG8_WAIT_V(8); PG8_WAIT_L(0); PG8_BAR; PG8_MMA(1, 0, At, B0); PG8_MMA(1, 1, At, B1); PG8_BAR; PG8_SCHED;
            } else {
            PG8_LDB(B0, 0, 0); PG8_SCHED; PG8_LDA(At, 0, 0); PG8_STAGE(PG8_SA(1, 1), a1 + hstep, voffA);
            PG8_WAIT_L(8); PG8_BAR; PG8_WAIT_L(0); PG8_MMA(0, 0, At, B0); PG8_BAR; PG8_SCHED;
            PG8_LDB(B1, 0, 1); PG8_STAGE(PG8_SB(0, 0), b2, voffB);
            PG8_BAR; PG8_WAIT_L(0); PG8_MMA(0, 1, At, B1); PG8_BAR;
            PG8_LDA(At, 0, 1); PG8_STAGE(PG8_SA(0, 0), a2, voffA);
            PG8_BAR; PG8_WAIT_L(0); PG8_MMA(1, 0, At, B0); PG8_BAR; PG8_SCHED;
            PG8_STAGE(PG8_SB(0, 1), b2 + hstep, voffB);
            PG8_WAIT_V(6); PG8_BAR; PG8_MMA(1, 1, At, B1); PG8_BAR;
            PG8_LDB(B0, 1, 0); PG8_SCHED; PG8_LDA(At, 1, 0); PG8_STAGE(PG8_SA(0, 1), a2 + hstep, voffA);
            PG8_WAIT_L(8); PG8_BAR; PG8_WAIT_L(0); PG8_MMA(0, 0, At, B0); PG8_BAR; PG8_SCHED;
            PG8_LDB(B1, 1, 1); PG8_STAGE(PG8_SB(1, 0), b3, voffB);
            PG8_BAR; PG8_WAIT_L(0); PG8_MMA(0, 1, At, B1); PG8_BAR;
            PG8_LDA(At, 1, 1); PG8_STAGE(PG8_SA(1, 0), a3, voffA);
            PG8_BAR; PG8_WAIT_L(0); PG8_MMA(1, 0, At, B0); PG8_BAR; PG8_SCHED;
            PG8_STAGE(PG8_SB(1, 1), b3 + hstep, voffB);
            PG8_WAIT_V(6); PG8_BAR; PG8_MMA(1, 1, At, B1); PG8_BAR;
            }
        }
        if constexpr (ALIGN_EPI) { if (wr == 0) PG8_BAR; }
        E(acc, cur, ui, wr, wc, fr, fq); S.done(cur);
        if (!has_next) break;
#pragma unroll
        for (int a = 0; a < 2; ++a)
#pragma unroll
            for (int b = 0; b < 2; ++b)
#pragma unroll
                for (int m = 0; m < 4; ++m)
#pragma unroll
                    for (int n = 0; n < 2; ++n) acc[a][b][m][n] = (f32x4){0.f, 0.f, 0.f, 0.f};
        cur = nxt; cA = nA; cB = nB; ++ui;
        if constexpr (ALIGN_EPI) { if (wr == 1) PG8_BAR; }
    }
    PG8_WAIT_V(0);
    if constexpr (!ALIGN_EPI) { if (wr == 0) PG8_BAR; }
    PG8_BAR;
#undef PG8_SA
#undef PG8_SB
#undef PG8_STAGE
#undef PG8_LDA
#undef PG8_LDB
#undef PG8_MMA
#undef PG8_WAIT_V
#undef PG8_WAIT_L
#undef PG8_BAR
#undef PG8_SCHED
}
}

constexpr int BATCH = 8, SEQ = 2048, D = 1024, M = BATCH * SEQ;
constexpr int FF = 2816, DRNN = 1280, NBLK = 10, RBLK = 128, CONVW = 4;
constexpr int NHEAD = 16, HD = 64, NGRP = 3, NQKV = 9216;
constexpr float RMS_EPS = 1e-6f;
constexpr float LOG2E = 1.4426950408889634f;
constexpr int NWAVES = 8;

typedef unsigned short bf16;
typedef unsigned v4u __attribute__((ext_vector_type(4)));
typedef unsigned v2u __attribute__((ext_vector_type(2)));
typedef float f32x4 __attribute__((ext_vector_type(4)));
#define GAS __attribute__((address_space(1)))
#define LAS __attribute__((address_space(3)))
typedef GAS unsigned gu32;
#define RLX_AGENT __ATOMIC_RELAXED, __HIP_MEMORY_SCOPE_AGENT
#define LDS_WAIT() asm volatile("s_waitcnt lgkmcnt(0)" ::: "memory")

#ifndef RESID_BF16
#define RESID_BF16 1
#endif
constexpr size_t MiB = 1u << 20;
constexpr size_t WS_CTL = 0, CTL_ZERO_BYTES = 1 * MiB;
constexpr size_t WS_SSQ = 1 * MiB;
constexpr size_t WS_BIAS = 2 * MiB;
constexpr size_t WS_XB = 3 * MiB;
constexpr size_t WS_WO = 35 * MiB;
constexpr size_t WS_WQKV = 37 * MiB;
constexpr size_t WS_QKV = 55 * MiB;
constexpr size_t QKV_SLAB = (size_t)M * 1024 * 2;
constexpr size_t WS_TAIL = 343 * MiB;
constexpr size_t WS_END = 349 * MiB;
constexpr size_t WS_WIN0 = 55 * MiB, WS_WOUT0 = 66 * MiB, WS_WIN1 = 72 * MiB, WS_WOUT1 = 83 * MiB, WS_WIN2 = 89 * MiB, WS_WOUT2 = 100 * MiB;
constexpr size_t WS_WRIN = 106 * MiB, WS_WROUT = 111 * MiB, WS_WA = 114 * MiB, WS_WX = 114 * MiB + 512 * 1024;
constexpr size_t WS_ACT = 115 * MiB;
constexpr size_t WS_G = 203 * MiB, WS_U = 243 * MiB, WS_Y = 283 * MiB;
constexpr size_t WS_ATT = WS_QKV + 3 * QKV_SLAB;
constexpr size_t WS_WOUT3 = WS_TAIL;
constexpr size_t WS_ACT3 = WS_QKV;
static_assert(WS_Y + (size_t)M * DRNN * 2 <= WS_TAIL && WS_ACT + (size_t)M * FF * 2 <= WS_G && WS_WX + 327680 <= WS_ACT, "ws map");
static_assert(WS_QKV + 9 * QKV_SLAB == WS_TAIL && WS_WOUT3 + (size_t)D * FF * 2 <= WS_END && RESID_BF16 == 1, "ws map");
constexpr int CW_BAR = 4096;

constexpr int RING_BYTES = 131072;
constexpr int RSTD_OFF = RING_BYTES + 1024, RSTD_MAX_UNITS = 9, GAIN_OFF = RSTD_OFF + RSTD_MAX_UNITS * 256 * 4;
constexpr int LDS_BYTES = 147456;
constexpr int MISC_OFF = LDS_BYTES - 128;
static_assert(GAIN_OFF + 512 <= LDS_BYTES - 128, "LDS map");

#define XB_TMO      128
#define XB_XCNT(j)  (256  + 64 * (j))
#define XB_XSUB(j)  (1280 + 64 * (j))
#define XB_XGEN(j)  (2304 + 64 * (j))
#define XB_TOP      3328
#define XB_TOPGEN   3392
#define XCD_BAR_WORDS 3456
#define XB_SPIN_CAP (1u << 18)
__device__ __forceinline__ unsigned xb_ld(unsigned* p)              { return __hip_atomic_load(p, __ATOMIC_RELAXED, __HIP_MEMORY_SCOPE_AGENT); }
__device__ __forceinline__ unsigned xb_add(unsigned* p, unsigned v) { return __hip_atomic_fetch_add(p, v, __ATOMIC_RELAXED, __HIP_MEMORY_SCOPE_AGENT); }
__device__ __forceinline__ unsigned xb_xcc_id() { return (unsigned)__builtin_amdgcn_s_getreg((3 << 11) | 20) & 0xFu; }
#define XB_SPIN(cond, bar) do { unsigned _sp = 0; while (cond) { __builtin_amdgcn_s_sleep(1); \
    if ((++_sp & 255u) == 0u) { if (xb_ld(&(bar)[XB_TMO])) break; if (_sp > XB_SPIN_CAP) { atomicAdd(&(bar)[XB_TMO], 1u); break; } } } } while (0)
struct XcdBarrier { unsigned* bar; unsigned x; volatile LAS unsigned* st; };
__device__ __forceinline__ XcdBarrier xcd_barrier_post(unsigned* bar, volatile LAS unsigned* st, const int tid) {
    XcdBarrier b; b.bar = bar; b.x = xb_xcc_id(); b.st = st;
    if (tid == 0) (void)xb_add(&bar[XB_XCNT(b.x)], 1u);
    return b;
}
__device__ __forceinline__ void xcd_barrier_complete(unsigned* bar, unsigned x, unsigned& nloc, unsigned& nx) {
    const unsigned G = gridDim.x * gridDim.y * gridDim.z;
    unsigned sum, cnt, mine, sp = 0u;
    for (;;) {
        sum = 0u; cnt = 0u; mine = 0u;
#pragma unroll
        for (unsigned j = 0; j < 16; ++j) { const unsigned c = xb_ld(&bar[XB_XCNT(j)]); sum += c; cnt += (c > 0u) ? 1u : 0u; mine = (j == x) ? c : mine; }
        if (sum == G) break;
        __builtin_amdgcn_s_sleep(1);
        if ((++sp & 255u) == 0u) { if (xb_ld(&bar[XB_TMO])) break; if (sp > XB_SPIN_CAP) { atomicAdd(&bar[XB_TMO], 1u); break; } }
    }
    nloc = mine > 0u ? mine : 1u; nx = cnt > 0u ? cnt : 1u;
}
__device__ __forceinline__ void xcd_barrier(const XcdBarrier& b, const int tid) {
    asm volatile("s_waitcnt vmcnt(0)" ::: "memory");
    __syncthreads();
    if (tid == 0) {
        unsigned* bar = b.bar;
        __builtin_amdgcn_s_waitcnt(0);
        unsigned nloc = b.st[0], nx = b.st[1];
        if (nloc == 0u) { xcd_barrier_complete(bar, b.x, nloc, nx); b.st[0] = nloc; b.st[1] = nx; }
        const unsigned old = xb_add(&bar[XB_XSUB(b.x)], 1u);
        const unsigned gen = old / nloc;
        if (old + 1u == (gen + 1u) * nloc) {
            __builtin_amdgcn_fence(__ATOMIC_RELEASE, "agent");
            asm volatile("s_waitcnt vmcnt(0)" ::: "memory");
            const unsigned og = xb_add(&bar[XB_TOP], 1u);
            const unsigned tg = og / nx;
            if (og + 1u == (tg + 1u) * nx) xb_add(&bar[XB_TOPGEN], 1u);
            else XB_SPIN(xb_ld(&bar[XB_TOPGEN]) == tg, bar);
            __builtin_amdgcn_fence(__ATOMIC_ACQUIRE, "agent");
            xb_add(&bar[XB_XGEN(b.x)], 1u);
            asm volatile("s_waitcnt vmcnt(0)" ::: "memory");
        } else {
            XB_SPIN(xb_ld(&bar[XB_XGEN(b.x)]) == gen, bar);
            __builtin_amdgcn_fence(__ATOMIC_ACQUIRE, "agent");
            asm volatile("s_waitcnt vmcnt(0)" ::: "memory");
        }
    }
    __syncthreads();
}

__device__ __forceinline__ unsigned f2bf(float f) { unsigned u = __builtin_bit_cast(unsigned, f); return (u + 0x7fffu + ((u >> 16) & 1u)) >> 16; }
__device__ __forceinline__ unsigned pk2(float lo, float hi) { return f2bf(lo) | (f2bf(hi) << 16); }
__device__ __forceinline__ float bf_lo(unsigned w) { return __builtin_bit_cast(float, w << 16); }
__device__ __forceinline__ float bf_hi(unsigned w) { return __builtin_bit_cast(float, w & 0xffff0000u); }
__device__ __forceinline__ float bf2f(bf16 v) { return __builtin_bit_cast(float, (unsigned)v << 16); }
__device__ __forceinline__ float wave_sum(float v) {
#pragma unroll
    for (int o = 1; o < 64; o <<= 1) v += __shfl_xor(v, o);
    return v;
}
__device__ __forceinline__ float fast_sigmoid(float x) { return __builtin_amdgcn_rcpf(1.f + __builtin_amdgcn_exp2f(-LOG2E * x)); }
__device__ __forceinline__ float row_rstd(const float* ssq, int row) {
    const f32x4* p = (const f32x4*)(ssq + (size_t)row * 16); const f32x4 a = p[0], b = p[1], c = p[2], d = p[3];
    const float s = ((a.x + a.y) + (a.z + a.w)) + ((b.x + b.y) + (b.z + b.w)) + ((c.x + c.y) + (c.z + c.w)) + ((d.x + d.y) + (d.z + d.w));
    return rsqrtf(s * (1.0f / D) + RMS_EPS);
}

typedef float f32x2 __attribute__((ext_vector_type(2)));
template <class Sched> __device__ __forceinline__ void fill_rstd(LAS unsigned char* lds, const Sched& S, const float* ssq, int tid) {
    LAS float* rt = (LAS float*)(lds + RSTD_OFF); pg8::Unit u;
    for (int i = 0; i < RSTD_MAX_UNITS && S.next(i, u); ++i)
        if ((tid >> 8) == (i & 1)) { const int r = tid & 255; rt[i * 256 + r] = row_rstd(ssq, u.pm * 256 + r); }
    __syncthreads();
}
using pg8::Unit;
__device__ __forceinline__ f32x2 silu_mul_pk(f32x2 g, f32x2 up) {
    const f32x2 t = g * (-LOG2E); f32x2 e; e.x = __builtin_amdgcn_exp2f(t.x); e.y = __builtin_amdgcn_exp2f(t.y);
    const f32x2 d = e + 1.0f; f32x2 r; r.x = __builtin_amdgcn_rcpf(d.x); r.y = __builtin_amdgcn_rcpf(d.y);
    return (g * r) * up;
}
struct EpiSwiGLU {
    static constexpr bool PERM = true;
    const LAS float* rtab; bf16* act;
    __device__ __forceinline__ void operator()(const f32x4 (&acc)[2][2][4][2], const Unit& u, int ui, int wr, int wc, int fr, int fq) const {
#pragma unroll
        for (int ai = 0; ai < 2; ++ai)
#pragma unroll
            for (int m = 0; m < 4; ++m) {
                const int rl = ai * 128 + wr * 64 + m * 16 + fr, row = u.pm * 256 + rl;
                const float rs = rtab[ui * 256 + rl];
                f32x2 v[4];
#pragma unroll
                for (int n = 0; n < 2; ++n)
#pragma unroll
                    for (int e = 0; e < 2; ++e) { const f32x2 g = (f32x2){acc[ai][0][m][n][2 * e], acc[ai][0][m][n][2 * e + 1]} * rs, up = (f32x2){acc[ai][1][m][n][2 * e], acc[ai][1][m][n][2 * e + 1]} * rs;
                        v[n * 2 + e] = silu_mul_pk(g, up); }
                v4u w; w.x = pg8::cvt_pk_bf16(v[0].x, v[0].y); w.y = pg8::cvt_pk_bf16(v[1].x, v[1].y); w.z = pg8::cvt_pk_bf16(v[2].x, v[2].y); w.w = pg8::cvt_pk_bf16(v[3].x, v[3].y);
                *(v4u*)(act + (size_t)row * FF + u.pn * 128 + wc * 32 + 8 * fq) = w;
            }
    }
};
#ifndef RESID_BF16
#define RESID_BF16 1
#endif
struct EpiRes {
    static constexpr bool PERM = true;
    const float* xin; float* xout; bf16* xb; float* ssq; float scale;
    __device__ __forceinline__ void operator()(const f32x4 (&acc)[2][2][4][2], const Unit& u, int ui, int wr, int wc, int fr, int fq) const {
        if (xin) run<true>(acc, u, wr, wc, fr, fq); else run<false>(acc, u, wr, wc, fr, fq);
    }
    template <bool F32IN> __device__ __forceinline__ void run(const f32x4 (&acc)[2][2][4][2], const Unit& u, int wr, int wc, int fr, int fq) const {
#pragma unroll
        for (int ai = 0; ai < 2; ++ai) {
            f32x4 xv[4][2][2];
#pragma unroll
            for (int m = 0; m < 4; ++m)
#pragma unroll
                for (int bj = 0; bj < 2; ++bj) { const size_t off = (size_t)(u.pm * 256 + ai * 128 + wr * 64 + m * 16 + fr) * D + u.pn * 256 + bj * 128 + wc * 32 + 8 * fq;
                    if (F32IN) { xv[m][bj][0] = *(const f32x4*)(xin + off); xv[m][bj][1] = *(const f32x4*)(xin + off + 4); }
                    else { const v4u w = *(const v4u*)(xb + off); xv[m][bj][0] = (f32x4){bf_lo(w.x), bf_hi(w.x), bf_lo(w.y), bf_hi(w.y)}; xv[m][bj][1] = (f32x4){bf_lo(w.z), bf_hi(w.z), bf_lo(w.w), bf_hi(w.w)}; } }
#pragma unroll
            for (int m = 0; m < 4; ++m) {
                const int row = u.pm * 256 + ai * 128 + wr * 64 + m * 16 + fr;
                float ss = 0.f;
#pragma unroll
                for (int bj = 0; bj < 2; ++bj) {
                    const size_t off = (size_t)row * D + u.pn * 256 + bj * 128 + wc * 32 + 8 * fq;
                    const f32x4 y0 = xv[m][bj][0] + acc[ai][bj][m][0] * scale, y1 = xv[m][bj][1] + acc[ai][bj][m][1] * scale;
                    if (xout) { *(f32x4*)(xout + off) = y0; *(f32x4*)(xout + off + 4) = y1; }
                    v4u w; w.x = pg8::cvt_pk_bf16(y0[0], y0[1]); w.y = pg8::cvt_pk_bf16(y0[2], y0[3]); w.z = pg8::cvt_pk_bf16(y1[0], y1[1]); w.w = pg8::cvt_pk_bf16(y1[2], y1[3]);
                    *(v4u*)(xb + off) = w;
                    ss += (y0[0] * y0[0] + y0[1] * y0[1]) + (y0[2] * y0[2] + y0[3] * y0[3]) + (y1[0] * y1[0] + y1[1] * y1[1]) + (y1[2] * y1[2] + y1[3] * y1[3]);
                }
                ss += __shfl_xor(ss, 16); ss += __shfl_xor(ss, 32);
                if (fq == 0) ssq[(size_t)row * 16 + u.pn * 4 + wc] = ss;
            }
            asm volatile("" ::: "memory");
        }
    }
};
struct EpiRnnIn {
    static constexpr bool PERM = true;
    const LAS float* rtab; bf16* Gb; bf16* Ub;
    template <bool GATE> __device__ __forceinline__ void run(const f32x4 (&acc)[2][2][4][2], const Unit& u, int ui, int wr, int wc, int fr, int fq, bf16* dstb, int pc) const {
#pragma unroll
        for (int ai = 0; ai < 2; ++ai)
#pragma unroll
            for (int m = 0; m < 4; ++m) {
                const int rl = ai * 128 + wr * 64 + m * 16 + fr, row = u.pm * 256 + rl;
                const float rs = rtab[ui * 256 + rl];
#pragma unroll
                for (int bj = 0; bj < 2; ++bj) {
                    f32x2 v[4];
#pragma unroll
                    for (int n = 0; n < 2; ++n)
#pragma unroll
                        for (int e = 0; e < 2; ++e) { f32x2 x = (f32x2){acc[ai][bj][m][n][2 * e], acc[ai][bj][m][n][2 * e + 1]} * rs;
                            if (GATE) {
                                const f32x2 t = (x * x * 0.044715f + 1.0f) * x * (-1.5957691216057308f * LOG2E); f32x2 ex; ex.x = __builtin_amdgcn_exp2f(t.x); ex.y = __builtin_amdgcn_exp2f(t.y);
                                const f32x2 d = ex + 1.0f; f32x2 r; r.x = __builtin_amdgcn_rcpf(d.x); r.y = __builtin_amdgcn_rcpf(d.y); x = x * r; }
                            v[n * 2 + e] = x; }
                    v4u w; w.x = pg8::cvt_pk_bf16(v[0].x, v[0].y); w.y = pg8::cvt_pk_bf16(v[1].x, v[1].y); w.z = pg8::cvt_pk_bf16(v[2].x, v[2].y); w.w = pg8::cvt_pk_bf16(v[3].x, v[3].y);
                    *(v4u*)(dstb + (size_t)row * DRNN + pc * 256 + bj * 128 + wc * 32 + 8 * fq) = w;
                }
            }
    }
    __device__ __forceinline__ void operator()(const f32x4 (&acc)[2][2][4][2], const Unit& u, int ui, int wr, int wc, int fr, int fq) const {
        if (u.pn < 5) run<true>(acc, u, ui, wr, wc, fr, fq, Gb, u.pn); else run<false>(acc, u, ui, wr, wc, fr, fq, Ub, u.pn - 5);
    }
};
struct EpiQKV {
    static constexpr bool PERM = true;
    const LAS float* rtab; const LAS float* gtab; bf16* qkv;
    __device__ __forceinline__ void operator()(const f32x4 (&acc)[2][2][4][2], const Unit& u, int ui, int wr, int wc, int fr, int fq) const {
        const int hs = u.pn * 4 + wc, kind = hs / 48, gh = hs - kind * 48, g = gh >> 4, h = gh & 15, l2d = 2 * g;
        bf16* slab = qkv + (size_t)(kind * 3 + g) * ((size_t)M * 1024);
        f32x4 gv[2][2];
#pragma unroll
        for (int bj = 0; bj < 2; ++bj)
#pragma unroll
            for (int n = 0; n < 2; ++n) { gv[bj][n] = (f32x4){1.f, 1.f, 1.f, 1.f}; if (kind < 2) gv[bj][n] = *(const LAS f32x4*)(gtab + kind * 64 + 32 * bj + 8 * fq + 4 * n); }
#pragma unroll
        for (int ai = 0; ai < 2; ++ai)
#pragma unroll
            for (int m = 0; m < 4; ++m) {
                const int rl = ai * 128 + wr * 64 + m * 16 + fr, row = u.pm * 256 + rl;
                const float rs = rtab[ui * 256 + rl];
                f32x4 v[2][2]; float ss = 0.f;
#pragma unroll
                for (int bj = 0; bj < 2; ++bj)
#pragma unroll
                    for (int n = 0; n < 2; ++n) { v[bj][n] = acc[ai][bj][m][n] * rs; const f32x4 t = v[bj][n] * v[bj][n]; ss += (t[0] + t[1]) + (t[2] + t[3]); }
                float rn = 1.f;
                if (kind < 2) { ss += __shfl_xor(ss, 16); ss += __shfl_xor(ss, 32); rn = rsqrtf(ss * (1.0f / HD) + RMS_EPS); }
                const int b = row >> 11, t = row & 2047, rres = t & ((1 << l2d) - 1), l = t >> l2d, L = 2048 >> l2d;
                bf16* dst = slab + ((size_t)(b * 16 + h) * 2048 + rres * L + l) * 64 + 8 * fq;
#pragma unroll
                for (int bj = 0; bj < 2; ++bj) {
                    const f32x4 a0 = v[bj][0] * gv[bj][0] * rn, a1 = v[bj][1] * gv[bj][1] * rn;
                    v4u w; w.x = pg8::cvt_pk_bf16(a0[0], a0[1]); w.y = pg8::cvt_pk_bf16(a0[2], a0[3]); w.z = pg8::cvt_pk_bf16(a1[0], a1[1]); w.w = pg8::cvt_pk_bf16(a1[2], a1[3]);
                    *(v4u*)(dst + 32 * bj) = w;
                }
            }
    }
};

struct Args { const float* in[18]; float* out; unsigned char* ws; int ph_lo, ph_hi; };
enum { I_X = 0, I_NORMG, I_FFN_WIN, I_FFN_WOUT, I_RNN_WIN, I_CONV_W, I_CONV_B, I_WA, I_BA, I_WX, I_BX, I_LAM, I_RNN_WOUT, I_WQKV, I_QGAIN, I_KGAIN, I_WO, I_RELB };

struct Ctx { LAS unsigned char* lds; int tid, lane, wave, G, vcu; unsigned char* ws; };

typedef short v4i16_t __attribute__((ext_vector_type(4)));
__device__ __forceinline__ v4i16_t vtr16(const LAS unsigned char* p) { return __builtin_amdgcn_ds_read_tr16_b64_v4i16((LAS v4i16_t*)p); }
enum { CM_NONE = 0, CM_FFN = 1, CM_QKV = 2 };
__device__ __forceinline__ int colmap(int mode, int vr) {
    if (mode == CM_FFN) { const int pn = vr >> 8, w = vr & 255; return (w >> 7) * FF + 128 * pn + (w & 127); }
    if (mode == CM_QKV) { const int pn = vr >> 8, w = vr & 255, bj = w >> 7, wc = (w >> 5) & 3, j = w & 31; return 256 * pn + 64 * wc + 32 * bj + j; }
    return vr;
}
__device__ __forceinline__ void transpose_item(const float* W, int K, int N, const float* gvec, bf16* WT, int mode, LAS unsigned char* scr, int item, int lane) {
    const int nblk = N / 64, kb = item / nblk, nb = item - kb * nblk, k0 = 64 * kb, vr0 = 64 * nb;
    const int col4 = lane & 15, rsub = lane >> 4, nsrc = colmap(mode, vr0 + 32 * (col4 >> 3)) + (col4 & 7) * 4;
    const float* src = W + (size_t)(k0 + rsub) * N + nsrc;
    f32x4 w[16];
#pragma unroll
    for (int i = 0; i < 16; ++i) w[i] = __builtin_nontemporal_load((const GAS f32x4*)(src + (size_t)(4 * i) * N));
    if (gvec) {
#pragma unroll
        for (int i = 0; i < 16; ++i) w[i] = w[i] * gvec[k0 + 4 * i + rsub];
    }
#pragma unroll
    for (int i = 0; i < 16; ++i) { v2u p; p.x = pg8::cvt_pk_bf16(w[i][0], w[i][1]); p.y = pg8::cvt_pk_bf16(w[i][2], w[i][3]);
        *(LAS v2u*)(scr + (col4 >> 3) * 4096 + (4 * i + rsub) * 64 + (col4 & 7) * 8) = p; }
    const int q = (lane & 15) >> 2, p4 = lane & 3, gidx = lane >> 4;
#pragma unroll
    for (int r = 0; r < 8; ++r) { const int nb16 = r >> 1, kh = r & 1, kbase = 32 * kh + 8 * gidx;
        const LAS unsigned char* a = scr + (nb16 >> 1) * 4096 + (kbase + q) * 64 + ((nb16 & 1) * 16 + 4 * p4) * 2;
        const v4i16_t lo = vtr16(a), hi = vtr16(a + 4 * 64);
        v4u o; { const v2u l2 = __builtin_bit_cast(v2u, lo), h2 = __builtin_bit_cast(v2u, hi); o.x = l2.x; o.y = l2.y; o.z = h2.x; o.w = h2.y; }
        *(GAS v4u*)(WT + (size_t)(vr0 + nb16 * 16 + (lane & 15)) * K + k0 + kbase) = o; }
}
struct MatJob { const float* W; int K, N; const float* g; bf16* WT; int mode; };
__device__ __forceinline__ MatJob mat_job(const Ctx& C, const Args& a, int idx) {
    unsigned char* ws = C.ws; const float* ng = a.in[I_NORMG]; MatJob j;
    switch (idx) {
    case 0: j = MatJob{a.in[I_FFN_WIN] + (size_t)0 * D * 2 * FF, D, 2 * FF, ng + 0 * D, (bf16*)(ws + WS_WIN0), CM_FFN}; break;
    case 1: j = MatJob{a.in[I_FFN_WOUT] + (size_t)0 * FF * D, FF, D, nullptr, (bf16*)(ws + WS_WOUT0), CM_NONE}; break;
    case 2: j = MatJob{a.in[I_RNN_WIN], D, 2 * DRNN, ng + 1 * D, (bf16*)(ws + WS_WRIN), CM_NONE}; break;
    case 3: j = MatJob{a.in[I_RNN_WOUT], DRNN, D, nullptr, (bf16*)(ws + WS_WROUT), CM_NONE}; break;
    case 4: j = MatJob{a.in[I_FFN_WIN] + (size_t)1 * D * 2 * FF, D, 2 * FF, ng + 2 * D, (bf16*)(ws + WS_WIN1), CM_FFN}; break;
    case 5: j = MatJob{a.in[I_FFN_WOUT] + (size_t)1 * FF * D, FF, D, nullptr, (bf16*)(ws + WS_WOUT1), CM_NONE}; break;
    case 6: j = MatJob{a.in[I_WO], D, D, nullptr, (bf16*)(ws + WS_WO), CM_NONE}; break;
    case 7: j = MatJob{a.in[I_WQKV], D, NQKV, ng + 4 * D, (bf16*)(ws + WS_WQKV), CM_QKV}; break;
    case 8: j = MatJob{a.in[I_FFN_WIN] + (size_t)2 * D * 2 * FF, D, 2 * FF, ng + 3 * D, (bf16*)(ws + WS_WIN2), CM_FFN}; break;
    case 9: j = MatJob{a.in[I_FFN_WOUT] + (size_t)2 * FF * D, FF, D, nullptr, (bf16*)(ws + WS_WOUT2), CM_NONE}; break;
    case 10: j = MatJob{a.in[I_FFN_WIN] + (size_t)3 * D * 2 * FF, D, 2 * FF, ng + 5 * D, (bf16*)a.out, CM_FFN}; break;
    default: j = MatJob{a.in[I_FFN_WOUT] + (size_t)3 * FF * D, FF, D, nullptr, (bf16*)(ws + WS_WOUT3), CM_NONE}; break;
    }
    return j;
}
__device__ __forceinline__ void convert_mats(const Ctx& C, const Args& a, int first, int last, int gw, int NGW) {
    LAS unsigned char* scr = C.lds + C.wave * 8192;
    int base = 0;
    for (int mi = first; mi < last; ++mi) {
        const MatJob j = mat_job(C, a, mi); const int cnt = (j.K / 64) * (j.N / 64);
        int it = (gw - base) % NGW; if (it < 0) it += NGW;
        for (; it < cnt; it += NGW) transpose_item(j.W, j.K, j.N, j.g, j.WT, j.mode, scr, it, C.lane);
        base += cnt;
    }
}
__device__ __forceinline__ void spare_convert(const Ctx& C, const Args& a, int first, int last, int nwg) {
    const int R = (nwg + C.G - 1) / C.G, first_spare = nwg - (R - 1) * C.G, nspare = C.G - first_spare, c = (int)blockIdx.x;
    if (nspare > 0) { if (c >= first_spare) convert_mats(C, a, first, last, (c - first_spare) * NWAVES + C.wave, nspare * NWAVES); }
    else convert_mats(C, a, first, last, c * NWAVES + C.wave, C.G * NWAVES);
    __syncthreads();
}
__device__ __forceinline__ int t5_bucket(int n) {
    if (n < 16) return n;
    int b = 16;
    b += (n >= 22) + (n >= 30) + (n >= 40) + (n >= 54) + (n >= 73) + (n >= 99) + (n >= 134) + (n >= 182) + (n >= 246) + (n >= 332) + (n >= 450) + (n >= 609) + (n >= 825) + (n >= 1117) + (n >= 1513);
    return b;
}
__device__ __forceinline__ void p_prologue(const Ctx& C, const Args& a) {
    const int gw = C.vcu * NWAVES + C.wave, NGW = C.G * NWAVES;
    convert_mats(C, a, 0, 1, gw, NGW);
    {   LAS unsigned char* scr = C.lds + C.wave * 8192;
        for (int it = gw; it < 2 * NBLK * 4; it += NGW) { const int which = it / (NBLK * 4), r = it % (NBLK * 4), blk = r >> 2, sub = r & 3;
            const float* W = (which ? a.in[I_WX] : a.in[I_WA]) + (size_t)blk * RBLK * RBLK; bf16* WT = (bf16*)(C.ws + (which ? WS_WX : WS_WA)) + (size_t)blk * RBLK * RBLK;
            transpose_item(W, RBLK, RBLK, nullptr, WT, CM_NONE, scr, sub, C.lane); } }
    const float* x = a.in[I_X]; bf16* xb = (bf16*)(C.ws + WS_XB); float* ssq = (float*)(C.ws + WS_SSQ);
    for (int m = gw; m < M; m += NGW) {
        const GAS f32x4* xr = (const GAS f32x4*)(x + (size_t)m * D) + C.lane; f32x4 v[4]; float s = 0.f;
#pragma unroll
        for (int j = 0; j < 4; ++j) { v[j] = __builtin_nontemporal_load(xr + 64 * j); s += (v[j].x * v[j].x + v[j].y * v[j].y) + (v[j].z * v[j].z + v[j].w * v[j].w); }
        s = wave_sum(s);
        GAS v2u* o8 = (GAS v2u*)(xb + (size_t)m * D) + C.lane;
#pragma unroll
        for (int j = 0; j < 4; ++j) { v2u w; w.x = pk2(v[j].x, v[j].y); w.y = pk2(v[j].z, v[j].w); o8[64 * j] = w; }
        if (C.lane < 16) ssq[(size_t)m * 16 + C.lane] = (C.lane == 0) ? s : 0.f;
    }
    float* bt = (float*)(C.ws + WS_BIAS); const float* rb = a.in[I_RELB];
    for (int i = blockIdx.x * 512 + C.tid; i < 48 * 129; i += C.G * 512) { const int gh = i / 129, dist = i - gh * 129, g = gh >> 4;
        bt[gh * 132 + dist] = rb[t5_bucket(dist << (2 * g)) * 48 + gh] * LOG2E; }
}

typedef float f32x16 __attribute__((ext_vector_type(16)));
typedef short bf16x8v __attribute__((ext_vector_type(8)));
constexpr int RM_WB = 0, RM_WB_GATE = 64 * 272, RM_CW = 36864, RM_CMP = RM_CW + 2560, RM_TILE = 49152, RM_TILE_BYTES = 36 * 256, RM_END = RM_TILE + 8 * RM_TILE_BYTES;
static_assert(RM_WB + 2 * RM_WB_GATE <= RM_CW && RM_CMP + 2 * 2 * 8 * 64 * 4 <= RM_TILE && RM_END <= RING_BYTES, "rnn-mid LDS map");
__device__ __forceinline__ bf16x8v pack8(const float (&v)[8]) {
    v4u w; w.x = pg8::cvt_pk_bf16(v[0], v[1]); w.y = pg8::cvt_pk_bf16(v[2], v[3]); w.z = pg8::cvt_pk_bf16(v[4], v[5]); w.w = pg8::cvt_pk_bf16(v[6], v[7]);
    return __builtin_bit_cast(bf16x8v, w);
}
__device__ __forceinline__ void p_rnn_mid(const Ctx& C, const Args& a) {
    const bf16* U = (const bf16*)(C.ws + WS_U); const bf16* Gb = (const bf16*)(C.ws + WS_G); bf16* Y = (bf16*)(C.ws + WS_Y);
    const bf16* WAb = (const bf16*)(C.ws + WS_WA); const bf16* WXb = (const bf16*)(C.ws + WS_WX);
    LAS unsigned char* L = C.lds;
    LAS float* CW = (LAS float*)(L + RM_CW); LAS float* CMP = (LAS float*)(L + RM_CMP);
    const int wave = C.wave;
    LAS unsigned char* wt = L + RM_TILE + wave * RM_TILE_BYTES;
    for (int item = blockIdx.x; item < BATCH * NBLK * 2; item += C.G) {
        const int b = item / (NBLK * 2), n = (item % (NBLK * 2)) >> 1, half = item & 1;
        int tid = C.tid; asm volatile("" : "+v"(tid));
        const int lane = tid & 63, r32 = lane & 31, hh = lane >> 5;
        __syncthreads();
#pragma unroll
        for (int p = 0; p < 4; ++p) { const int idx = p * 512 + tid, gate = idx >> 10, rem = idx & 1023, row = rem >> 4, c16 = rem & 15;
            const v4u w = *(const v4u*)((gate ? WXb : WAb) + (size_t)(n * 128 + 64 * half + row) * 128 + c16 * 8);
            *(LAS v4u*)(L + RM_WB + gate * RM_WB_GATE + row * 272 + c16 * 16) = w; }
        CW[tid] = a.in[I_CONV_W][(tid >> 7) * DRNN + n * 128 + (tid & 127)];
        if (tid < 128) CW[512 + tid] = a.in[I_CONV_B][n * 128 + tid];
        __syncthreads();
        float ba[2], bx[2], spl[2], Ht[2];
#pragma unroll
        for (int cb = 0; cb < 2; ++cb) { const int ch = n * 128 + 64 * half + 32 * cb + r32; ba[cb] = a.in[I_BA][ch]; bx[cb] = a.in[I_BX][ch];
            spl[cb] = -8.0f * LOG2E * log1pf(expf(-a.in[I_LAM][ch])); Ht[cb] = 0.f; }
        bf16x8v idf[2];
#pragma unroll
        for (int sp = 0; sp < 2; ++sp)
#pragma unroll
            for (int j = 0; j < 8; ++j) idf[sp][j] = (16 * sp + 8 * hh + j == r32) ? (short)0x3F80 : (short)0;
        const int urow = lane >> 4, uch = lane & 15, grow = lane >> 3, gch = lane & 7;
        v4u uraw[9], graw[4];
#define RM_LOADU(TILE) do { const int tp_ = (TILE) * 256 + wave * 32; const int ub_ = (b * SEQ + tp_ - 3 + urow) * DRNN + n * 128 + uch * 8;        \
        _Pragma("unroll") for (int i_ = 0; i_ < 9; ++i_) uraw[i_] = *(const v4u*)(U + (ptrdiff_t)(ub_ + i_ * 4 * DRNN)); \
        if (tp_ == 0 && urow < 3) uraw[0] = (v4u){0u, 0u, 0u, 0u};         } while (0)
#define RM_LOADG(TILE) do { const int gb_ = (b * SEQ + (TILE) * 256 + wave * 32 + grow) * DRNN + n * 128 + 64 * half + gch * 8; \
        _Pragma("unroll") for (int i_ = 0; i_ < 4; ++i_) graw[i_] = *(const v4u*)(Gb + (unsigned)(gb_ + i_ * 8 * DRNN)); } while (0)
        RM_LOADU(0);
        for (int tile = 0; tile < 8; ++tile) {
            const int tposw = tile * 256 + wave * 32;
            const size_t tok0 = (size_t)b * SEQ + tposw;
            LAS float* CWt = CW; LAS unsigned char* WBt = L + RM_WB; asm volatile("" : "+v"(CWt), "+v"(WBt));
            RM_LOADG(tile);
#pragma unroll
            for (int i = 0; i < 9; ++i) { const int rl = 4 * i + urow; *(LAS v4u*)(wt + rl * 256 + ((uch ^ (rl & 15)) << 4)) = uraw[i]; }
            {
                const int tg = lane >> 4, cc = lane & 15;
                f32x2 wv[4][4], bv2[4];
#pragma unroll
                for (int k = 0; k < 4; ++k) { const f32x4 w0 = *(const LAS f32x4*)(CWt + k * 128 + 8 * cc), w1 = *(const LAS f32x4*)(CWt + k * 128 + 8 * cc + 4);
                    wv[k][0] = (f32x2){w0[0], w0[1]}; wv[k][1] = (f32x2){w0[2], w0[3]}; wv[k][2] = (f32x2){w1[0], w1[1]}; wv[k][3] = (f32x2){w1[2], w1[3]}; }
                { const f32x4 b0 = *(const LAS f32x4*)(CWt + 512 + 8 * cc), b1 = *(const LAS f32x4*)(CWt + 512 + 8 * cc + 4);
                  bv2[0] = (f32x2){b0[0], b0[1]}; bv2[1] = (f32x2){b0[2], b0[3]}; bv2[2] = (f32x2){b1[0], b1[1]}; bv2[3] = (f32x2){b1[2], b1[3]}; }
                v4u ur[11];
#pragma unroll
                for (int j = 0; j < 11; ++j) { const int rl = 8 * tg + j; ur[j] = *(const LAS v4u*)(wt + rl * 256 + ((cc ^ (rl & 15)) << 4)); }
                f32x2 o[8][4];
#pragma unroll
                for (int i = 0; i < 8; ++i)
#pragma unroll
                    for (int e = 0; e < 4; ++e) o[i][e] = bv2[e];
#pragma unroll
                for (int j = 0; j < 11; ++j) {
                    const f32x2 u0 = (f32x2){bf_lo(ur[j].x), bf_hi(ur[j].x)}, u1 = (f32x2){bf_lo(ur[j].y), bf_hi(ur[j].y)}, u2 = (f32x2){bf_lo(ur[j].z), bf_hi(ur[j].z)}, u3 = (f32x2){bf_lo(ur[j].w), bf_hi(ur[j].w)};
#pragma unroll
                    for (int k = 0; k < 4; ++k) { const int i = j - k; if (i >= 0 && i < 8) {
                        o[i][0] += wv[k][0] * u0; o[i][1] += wv[k][1] * u1; o[i][2] += wv[k][2] * u2; o[i][3] += wv[k][3] * u3; } }
                }
#pragma unroll
                for (int i = 0; i < 8; ++i) { const int rl = 8 * tg + i;
                    v4u w; w.x = pg8::cvt_pk_bf16(o[i][0].x, o[i][0].y); w.y = pg8::cvt_pk_bf16(o[i][1].x, o[i][1].y); w.z = pg8::cvt_pk_bf16(o[i][2].x, o[i][2].y); w.w = pg8::cvt_pk_bf16(o[i][3].x, o[i][3].y);
                    *(LAS v4u*)(wt + rl * 256 + ((cc ^ (rl & 15)) << 4)) = w; }
            }
            bf16x8v af[8];
#pragma unroll
            for (int s = 0; s < 8; ++s) af[s] = *(const LAS bf16x8v*)(wt + r32 * 256 + (((2 * s + hh) ^ (r32 & 15)) << 4));
#pragma unroll
            for (int i = 0; i < 4; ++i) *(LAS v4u*)(wt + (8 * i + grow) * 128 + gch * 16) = graw[i];
            f32x16 acc[2][2], ufa[2];
#pragma unroll
            for (int cb = 0; cb < 2; ++cb)
#pragma unroll
                for (int e = 0; e < 16; ++e) { acc[0][cb][e] = 0.f; acc[1][cb][e] = 0.f; ufa[cb][e] = 0.f; }
            bf16x8v bq[2][4];
#define RM_LDB(S, DST) do { _Pragma("unroll") for (int g_ = 0; g_ < 2; ++g_) _Pragma("unroll") for (int c_ = 0; c_ < 2; ++c_) \
                DST[g_ * 2 + c_] = *(const LAS bf16x8v*)(WBt + g_ * RM_WB_GATE + (32 * c_ + r32) * 272 + (16 * (S) + 8 * hh) * 2); } while (0)
            RM_LDB(0, bq[0]);
#pragma unroll
            for (int s = 0; s < 8; ++s) {
                if (s < 7) RM_LDB(s + 1, bq[(s + 1) & 1]);
#pragma unroll
                for (int gt = 0; gt < 2; ++gt)
#pragma unroll
                    for (int cb = 0; cb < 2; ++cb) acc[gt][cb] = __builtin_amdgcn_mfma_f32_32x32x16_bf16(af[s], bq[s & 1][gt * 2 + cb], acc[gt][cb], 0, 0, 0);
            }
#undef RM_LDB
#pragma unroll
            for (int cb = 0; cb < 2; ++cb)
#pragma unroll
                for (int sp = 0; sp < 2; ++sp) { const bf16x8v asel = half ? af[4 + 2 * cb + sp] : af[2 * cb + sp];
                    ufa[cb] = __builtin_amdgcn_mfma_f32_32x32x16_bf16(asel, idf[sp], ufa[cb], 0, 0, 0); }
#pragma unroll
            for (int cb = 0; cb < 2; ++cb)
#pragma unroll
                for (int e = 0; e < 16; ++e) {
                    const float uf = ufa[cb][e];
                    const float r = fast_sigmoid(acc[0][cb][e] + ba[cb]), ii = fast_sigmoid(acc[1][cb][e] + bx[cb]);
                    const float av = __builtin_amdgcn_exp2f(r * spl[cb]);
                    const float bv = __builtin_amdgcn_sqrtf(fmaxf(1.f - av * av, 0.f)) * (ii * uf);
                    acc[0][cb][e] = av; acc[1][cb][e] = bv;
                }
            float A0[2][4], B0[2][4], A1[2][4], B1[2][4];
            const int par = tile & 1;
#pragma unroll
            for (int cb = 0; cb < 2; ++cb) {
                float Aw = 1.f, Bw = 0.f;
#pragma unroll
                for (int q = 0; q < 4; ++q) {
                    const float a0 = acc[0][cb][4 * q], a1 = acc[0][cb][4 * q + 1], a2 = acc[0][cb][4 * q + 2], a3 = acc[0][cb][4 * q + 3];
                    const float Ag = (a0 * a1) * (a2 * a3);
                    const float Bg = ((acc[1][cb][4 * q] * a1 + acc[1][cb][4 * q + 1]) * a2 + acc[1][cb][4 * q + 2]) * a3 + acc[1][cb][4 * q + 3];
                    const float pA = __shfl_xor(Ag, 32), pB = __shfl_xor(Bg, 32);
                    A0[cb][q] = hh ? pA : Ag; B0[cb][q] = hh ? pB : Bg; A1[cb][q] = hh ? Ag : pA; B1[cb][q] = hh ? Bg : pB;
                    Bw = Bw * A0[cb][q] + B0[cb][q]; Aw *= A0[cb][q]; Bw = Bw * A1[cb][q] + B1[cb][q]; Aw *= A1[cb][q];
                }
                if (hh == 0) { CMP[((par * 2 + 0) * 8 + wave) * 64 + 32 * cb + r32] = Aw; CMP[((par * 2 + 1) * 8 + wave) * 64 + 32 * cb + r32] = Bw; }
            }
            __syncthreads();
            if (tile < 7) RM_LOADU(tile + 1);
#pragma unroll
            for (int cb = 0; cb < 2; ++cb) {
                float h = Ht[cb], hin = 0.f;
#pragma unroll
                for (int v = 0; v < 8; ++v) { const float Av = CMP[((par * 2 + 0) * 8 + v) * 64 + 32 * cb + r32], Bv = CMP[((par * 2 + 1) * 8 + v) * 64 + 32 * cb + r32];
                    hin = (v == wave) ? h : hin; h = Av * h + Bv; }
                Ht[cb] = h;
                float hc = hin;
#pragma unroll
                for (int q = 0; q < 4; ++q) {
                    const float c0 = hc; hc = A0[cb][q] * hc + B0[cb][q]; const float c1 = hc; hc = A1[cb][q] * hc + B1[cb][q];
                    float hv = hh ? c1 : c0;
#pragma unroll
                    for (int i = 0; i < 4; ++i) { const int e = 4 * q + i; hv = acc[0][cb][e] * hv + acc[1][cb][e];
                        const int tl = (e & 3) + 8 * (e >> 2) + 4 * hh;
                        LAS bf16* gp = (LAS bf16*)(wt + tl * 128 + (32 * cb + r32) * 2);
                        *gp = (bf16)f2bf(hv * bf2f(*gp)); }
                }
            }
#pragma unroll
            for (int i = 0; i < 4; ++i) { const v4u w = *(const LAS v4u*)(wt + (8 * i + grow) * 128 + gch * 16);
                *(v4u*)(Y + (unsigned)(((int)tok0 + 8 * i + grow) * DRNN + n * 128 + 64 * half + gch * 8)) = w; }
        }
#undef RM_LOADU
#undef RM_LOADG
    }
    const int nitems = BATCH * NBLK * 2;
    if (C.G > nitems) { if ((int)blockIdx.x >= nitems) convert_mats(C, a, 4, 7, ((int)blockIdx.x - nitems) * NWAVES + wave, (C.G - nitems) * NWAVES); }
    else { __syncthreads(); convert_mats(C, a, 4, 7, (int)blockIdx.x * NWAVES + wave, C.G * NWAVES); }
}
struct AttnUnit { const bf16* qrows; const bf16* kres; const bf16* vres; int l0, kb_lo, eoff; };
__device__ __forceinline__ AttnUnit attn_unit(const bf16* QKV, int g, int bh, int llin0, bool dbl) {
    AttnUnit u; const size_t SLAB = (size_t)M * 1024; const int L = SEQ >> (2 * g);
    u.l0 = llin0 & (L - 1); { const int lo_ = u.l0 - (dbl ? 160 : 128); u.kb_lo = lo_ > 0 ? lo_ : 0; } u.eoff = g * 192;
    u.qrows = QKV + (size_t)g * SLAB + ((size_t)bh * SEQ + llin0) * HD;
    u.kres = u.qrows + 3 * SLAB - (size_t)u.l0 * HD; u.vres = u.qrows + 6 * SLAB - (size_t)u.l0 * HD;
    return u;
}
typedef __bf16 bf16x2n __attribute__((ext_vector_type(2)));
__device__ __forceinline__ unsigned cvtpk_n(float lo, float hi) { const f32x2 v = {lo, hi}; return __builtin_bit_cast(unsigned, __builtin_convertvector(v, bf16x2n)); }
__device__ __forceinline__ float xhalf_max(float x) { float a = x, b = x; asm("s_nop 1\n\tv_permlane32_swap_b32 %0, %1\n\tv_max_f32 %0, %0, %1" : "+v"(a), "+v"(b)); return a; }
__device__ __forceinline__ float xhalf_sum(float x) { float a = x, b = x; asm("s_nop 1\n\tv_permlane32_swap_b32 %0, %1\n\tv_add_f32 %0, %0, %1" : "+v"(a), "+v"(b)); return a; }
constexpr int AT_VT = 0, AT_EXT = 8 * 8192, AT_LACC = AT_EXT + 4 * 592 * 4, AT_OACC = AT_LACC + 2048;
static_assert(AT_LACC + 512 * 4 <= AT_OACC && AT_OACC + 512 * 128 <= MISC_OFF, "attention LDS map");
#define AT_QBLOCK(QF, O0, O1, MROW, LSUM, EB) do { \
        const LAS f32x4* bp_ = (const LAS f32x4*)(ext + (EB)); \
        const f32x4 bq_[4] = {bp_[0], bp_[-2], bp_[-4], bp_[-6]};               \
        f32x16 p_; _Pragma("unroll") for (int e = 0; e < 16; ++e) p_[e] = 0.f; \
        _Pragma("unroll") for (int s_ = 0; s_ < 4; ++s_) p_ = __builtin_amdgcn_mfma_f32_32x32x16_bf16(kf[s_], QF[s_], p_, 0, 0, 0); \
        float bm_ = -1e30f; \
        _Pragma("unroll") for (int e = 0; e < 16; ++e) { p_[e] += bq_[e >> 2][3 - (e & 3)]; bm_ = fmaxf(bm_, p_[e]); } \
        bm_ = xhalf_max(bm_); \
        const float mn_ = fmaxf(MROW, bm_), alpha_ = __builtin_amdgcn_exp2f(MROW - mn_); MROW = mn_; \
        float ps_ = 0.f; \
        _Pragma("unroll") for (int e = 0; e < 16; ++e) { p_[e] = __builtin_amdgcn_exp2f(p_[e] - mn_); ps_ += p_[e]; } \
        LSUM = LSUM * alpha_ + ps_; \
        _Pragma("unroll") for (int e = 0; e < 16; ++e) { O0[e] *= alpha_; O1[e] *= alpha_; } \
        _Pragma("unroll") for (int s_ = 0; s_ < 2; ++s_) { \
            v4u w_; w_.x = cvtpk_n(p_[8 * s_], p_[8 * s_ + 1]); w_.y = cvtpk_n(p_[8 * s_ + 2], p_[8 * s_ + 3]); w_.z = cvtpk_n(p_[8 * s_ + 4], p_[8 * s_ + 5]); w_.w = cvtpk_n(p_[8 * s_ + 6], p_[8 * s_ + 7]); \
            const bf16x8v pf_ = __builtin_bit_cast(bf16x8v, w_); \
            const v4i16_t a00_ = vtr16(vt + (16 * s_) * 64 + vtr_off), a01_ = vtr16(vt + (16 * s_ + 8) * 64 + vtr_off), a10_ = vtr16(vt + 2048 + (16 * s_) * 64 + vtr_off), a11_ = vtr16(vt + 2048 + (16 * s_ + 8) * 64 + vtr_off); \
            O0 = __builtin_amdgcn_mfma_f32_32x32x16_bf16((bf16x8v){a00_[0], a00_[1], a00_[2], a00_[3], a01_[0], a01_[1], a01_[2], a01_[3]}, pf_, O0, 0, 0, 0); \
            O1 = __builtin_amdgcn_mfma_f32_32x32x16_bf16((bf16x8v){a10_[0], a10_[1], a10_[2], a10_[3], a11_[0], a11_[1], a11_[2], a11_[3]}, pf_, O1, 0, 0, 0); } \
    } while (0)
#define AT_COMBINE(MODE, O0, O1, MROW, LSUM, TL) do { \
        const float ltot_ = xhalf_sum(LSUM), inv_ = 1.f / ltot_, lse_ = MROW + log2f(ltot_); const int tl_ = (TL); \
        LAS unsigned char* orow_ = C.lds + AT_OACC + tl_ * 128; LAS float* lacc_ = (LAS float*)(C.lds + AT_LACC); \
        float wo_ = 0.f, wn_ = inv_; \
        if (MODE != 0) { const float lo_ = lacc_[tl_], mx_ = fmaxf(lo_, lse_), eo_ = __builtin_amdgcn_exp2f(lo_ - mx_), en_ = __builtin_amdgcn_exp2f(lse_ - mx_), rs_ = 1.f / (eo_ + en_); \
            wo_ = eo_ * rs_; wn_ = en_ * rs_ * inv_; if (MODE == 1 && hh == 0) lacc_[tl_] = mx_ + log2f(eo_ + en_); } \
        else if (hh == 0) lacc_[tl_] = lse_; \
        _Pragma("unroll") for (int q = 0; q < 4; ++q) { \
            LAS v2u* p0_ = (LAS v2u*)(orow_ + ((q ^ (tl_ & 7)) << 4) + 8 * hh); LAS v2u* p1_ = (LAS v2u*)(orow_ + (((4 + q) ^ (tl_ & 7)) << 4) + 8 * hh); \
            float a_[8] = {O0[4 * q] * wn_, O0[4 * q + 1] * wn_, O0[4 * q + 2] * wn_, O0[4 * q + 3] * wn_, O1[4 * q] * wn_, O1[4 * q + 1] * wn_, O1[4 * q + 2] * wn_, O1[4 * q + 3] * wn_}; \
            if (MODE != 0) { const v2u c0_ = *p0_, c1_ = *p1_; \
                a_[0] += wo_ * bf_lo(c0_.x); a_[1] += wo_ * bf_hi(c0_.x); a_[2] += wo_ * bf_lo(c0_.y); a_[3] += wo_ * bf_hi(c0_.y); \
                a_[4] += wo_ * bf_lo(c1_.x); a_[5] += wo_ * bf_hi(c1_.x); a_[6] += wo_ * bf_lo(c1_.y); a_[7] += wo_ * bf_hi(c1_.y); } \
            v2u w0_, w1_; w0_.x = cvtpk_n(a_[0], a_[1]); w0_.y = cvtpk_n(a_[2], a_[3]); w1_.x = cvtpk_n(a_[4], a_[5]); w1_.y = cvtpk_n(a_[6], a_[7]); \
            if (MODE != 2) { *p0_ = w0_; *p1_ = w1_; } \
            else { bf16* g_ = ATT + (size_t)(row0 + tl_) * 1024 + h * 64 + 8 * q + 4 * hh; *(v2u*)g_ = w0_; *(v2u*)(g_ + 32) = w1_; } } \
    } while (0)
__device__ __forceinline__ void p_attn(const Ctx& C, bf16* ATT) {
    const bf16* QKV = (const bf16*)(C.ws + WS_QKV); const float* bt = (const float*)(C.ws + WS_BIAS);
    LAS float* ext = (LAS float*)(C.lds + AT_EXT);
    LAS unsigned char* vt = C.lds + AT_VT + C.wave * 8192; LAS unsigned char* kt = vt + 4096;
    const int wave = C.wave;
    v4u kfn[4], vvn[4];
#define AT_LOADKV(U, KB) do { const bf16* kblk_ = (U).kres + (size_t)(KB) * HD; const bf16* vblk_ = (U).vres + (size_t)(KB) * HD; \
        _Pragma("unroll") for (int i_ = 0; i_ < 4; ++i_) { vvn[i_] = *(const v4u*)(vblk_ + (8 * i_ + crow8) * HD + cch * 8); kfn[i_] = *(const v4u*)(kblk_ + (8 * i_ + crow8) * HD + cch * 8); } } while (0)
#define AT_TILE2FRAG(RAW, OFS, FR) do { _Pragma("unroll") for (int i_ = 0; i_ < 4; ++i_) *(LAS v4u*)(kt + (8 * i_ + crow8) * 128 + ((cch ^ crow8) << 4)) = RAW[(OFS) + i_]; \
        _Pragma("unroll") for (int s_ = 0; s_ < 4; ++s_) FR[s_] = *(const LAS bf16x8v*)(kt + r32 * 128 + (((2 * s_ + hh) ^ (r32 & 7)) << 4)); } while (0)
#define AT_LOADQFRAG(U, ROW0, FR) do { v4u q_[4]; _Pragma("unroll") for (int i_ = 0; i_ < 4; ++i_) q_[i_] = *(const v4u*)((U).qrows + ((ROW0) + 8 * i_ + crow8) * HD + cch * 8); AT_TILE2FRAG(q_, 0, FR); } while (0)
#define AT_STEP(KB) do { const int kb_ = (KB); \
            bf16x8v kf[4]; \
            if (dbl && kb_ == cu.l0 - 32) AT_TILE2FRAG(qraw, 0, qfY);            \
            _Pragma("unroll") for (int i = 0; i < 4; ++i) *(LAS v4u*)(vt + (cch >> 2) * 2048 + (8 * i + crow8) * 64 + (cch & 3) * 16) = vvn[i]; \
            AT_TILE2FRAG(kfn, 0, kf); \
            {   const bool instep_ = (kb_ - 32 >= cu.kb_lo);                     \
                const bf16* kblk_ = instep_ ? cu.kres + (size_t)(kb_ - 32) * HD : nu.kres + (size_t)nu.l0 * HD; const bf16* vblk_ = instep_ ? cu.vres + (size_t)(kb_ - 32) * HD : nu.vres + (size_t)nu.l0 * HD; \
                _Pragma("unroll") for (int i_ = 0; i_ < 4; ++i_) { vvn[i_] = *(const v4u*)(vblk_ + (8 * i_ + crow8) * HD + cch * 8); kfn[i_] = *(const v4u*)(kblk_ + (8 * i_ + crow8) * HD + cch * 8); } \
                if (!instep_) AT_LOADQ(nu, 0); else if (dbl && kb_ == cu.l0) AT_LOADQ(cu, -32); } \
            const int ebX = cu.eoff + cu.l0 + r32 - kb_ - 4 * hh + 32 - 3 + 591 * ((r32 + 1) & 3);     \
            if (kb_ >= cu.l0 - 128) { AT_QBLOCK(qfX, oX0, oX1, mX, lX, ebX); } \
            if (dbl && kb_ < cu.l0) { AT_QBLOCK(qfY, oY0, oY1, mY, lY, ebX - 32); } \
        } while (0)
#define AT_ZERO(O0, O1, MR, LS) do { _Pragma("unroll") for (int e = 0; e < 16; ++e) { O0[e] = 0.f; O1[e] = 0.f; } MR = -1e30f; LS = 0.f; } while (0)
#define AT_DESC(V, STEP, U) do { const int v_ = (V), st_ = (STEP), bh_ = (v_ >> 1) & 127, sx_ = ((v_ & 1) << 1) | (v_ >> 8), s_ = (sx_ == 0) ? 0 : (sx_ == 1) ? 3 : (sx_ == 2) ? 1 : 2, g_ = st_ < 2 ? st_ : 2, j_ = st_ < 2 ? 1 : st_ - 2; \
        const int ll_ = (g_ == 0) ? 512 * s_ + 64 * wave + 32 * j_ : (g_ == 1) ? (wave >> 1) * 512 + 128 * s_ + 64 * (wave & 1) + 32 * j_ : (2 * wave + j_) * 128 + 32 * s_; \
        U = attn_unit(QKV, g_, bh_, ll_, st_ < 2); } while (0)
#define AT_LOADQ(U, R0) do { _Pragma("unroll") for (int i_ = 0; i_ < 4; ++i_) qraw[i_] = *(const v4u*)((U).qrows + ((R0) + 8 * i_ + crow8) * HD + cch * 8); } while (0)
    const int total = BATCH * NHEAD * 4;
    if ((int)blockIdx.x >= total) return;
    AttnUnit nu; v4u qraw[4];
    {   const int lane = C.lane, crow8 = lane >> 3, cch = lane & 7;
        AT_DESC(blockIdx.x, 0, nu); AT_LOADKV(nu, nu.l0); AT_LOADQ(nu, 0); }
    for (int v = blockIdx.x; v < total; v += C.G) {
        int tid = C.tid; asm volatile("" : "+v"(tid));
        const int lane = tid & 63, r32 = lane & 31, hh = lane >> 5;
        const int crow8 = lane >> 3, cch = lane & 7;
        const int vtr_off = (4 * hh + ((lane & 15) >> 2)) * 64 + ((lane >> 4) & 1) * 32 + (lane & 3) * 8;
        const int bh = (v >> 1) & 127, sidx = ((v & 1) << 1) | (v >> 8), s = (sidx == 0) ? 0 : (sidx == 1) ? 3 : (sidx == 2) ? 1 : 2, h = bh & 15;
        const int row0 = (bh >> 4) * SEQ + 512 * s;
        __syncthreads();
        for (int i = tid; i < 4 * 576; i += 512) { const int c = i / 576, rem = i - c * 576, g = rem / 192, dist = rem - g * 192 + c - 32; ext[i + 16 * c] = (dist >= 0 && dist <= 128) ? bt[(g * 16 + h) * 132 + dist] : -1e30f; }
        __syncthreads();
        f32x16 oX0, oX1, oY0, oY1; float mX, lX, mY, lY; bf16x8v qfX[4], qfY[4];
#pragma unroll 1
        for (int step = 0; step < 4; ++step) {
            const int g = step < 2 ? step : 2, jx = step < 2 ? 1 : step - 2; const bool dbl = step < 2;
            const AttnUnit cu = nu;
            const bool has_next = (step < 3) || (v + C.G < total);
            if (has_next) { if (step < 3) AT_DESC(v, step + 1, nu); else AT_DESC(v + C.G, 0, nu); }
            AT_TILE2FRAG(qraw, 0, qfX);
            AT_ZERO(oX0, oX1, mX, lX); AT_ZERO(oY0, oY1, mY, lY);
            for (int kb = cu.l0; kb >= cu.kb_lo; kb -= 32) AT_STEP(kb);
            int t32 = tid & 31; asm volatile("" : "+v"(t32));
            const int tlX = (g == 0) ? 64 * wave + 32 * jx + t32 : (g == 1) ? 256 * (wave & 1) + (wave >> 1) + 4 * (32 * jx + t32) : 16 * t32 + 2 * wave + jx;
            const int tlY = (g == 0) ? tlX - 32 : tlX - 128;
            AT_COMBINE(g, oX0, oX1, mX, lX, tlX);
            if (dbl) { AT_COMBINE(g, oY0, oY1, mY, lY, tlY); __syncthreads(); }
        }
    }
#undef AT_DESC
#undef AT_LOADQ
#undef AT_LOADKV
#undef AT_TILE2FRAG
#undef AT_LOADQFRAG
#undef AT_STEP
#undef AT_ZERO
}
#undef AT_QBLOCK
#undef AT_COMBINE
enum { PH_PROLOGUE = 0, PH_FFN_IN_0, PH_FFN_OUT_0, PH_RNN_IN, PH_RNN_MID, PH_RNN_OUT, PH_FFN_IN_1, PH_FFN_OUT_1,
       PH_FFN_IN_2, PH_FFN_OUT_2, PH_QKV, PH_ATTN, PH_WO, PH_FFN_IN_3, PH_FFN_OUT_3, NPHASE };

__global__ void __launch_bounds__(NWAVES * 64, 2) fwd_kernel(Args args) {
    extern __shared__ __attribute__((aligned(16))) unsigned char lds_raw[];
    Ctx C; C.lds = (LAS unsigned char*)lds_raw; C.wave = __builtin_amdgcn_readfirstlane((int)threadIdx.x >> 6); C.lane = pg8::fresh_lane(); C.tid = C.wave * 64 + C.lane;
    C.G = gridDim.x; { const int bx = blockIdx.x; C.vcu = (C.G % 8 == 0) ? (bx % 8) * (C.G / 8) + bx / 8 : bx; }
    C.ws = args.ws;
    volatile LAS unsigned* MISC = (volatile LAS unsigned*)(C.lds + MISC_OFF);
    if (C.tid < 32) ((LAS unsigned*)(C.lds + MISC_OFF))[C.tid] = 0u;
    __syncthreads();
    unsigned* ctl = (unsigned*)args.ws;
    XcdBarrier bar; bar.bar = ctl + CW_BAR; bar.x = 0; bar.st = nullptr;
    const bool multi = (args.ph_hi - args.ph_lo) > 1;
    if (multi) bar = xcd_barrier_post(ctl + CW_BAR, MISC + 8, C.tid);
    for (int ph = args.ph_lo; ph < args.ph_hi; ++ph) {
        {
        { const int l_ = pg8::fresh_lane(); C.lane = l_; C.tid = C.wave * 64 + l_; }
        unsigned char* ws = args.ws;
        C.ws = ws; float* ssq = (float*)(ws + WS_SSQ); bf16* xb = (bf16*)(ws + WS_XB);
        switch (ph) {
        case PH_PROLOGUE: p_prologue(C, args); break;
        case PH_FFN_IN_0: case PH_FFN_IN_1: case PH_FFN_IN_2: case PH_FFN_IN_3: {
            if (ph != PH_FFN_IN_3) { const int f = (ph == PH_FFN_IN_0) ? 1 : (ph == PH_FFN_IN_1) ? 8 : 10, l = (ph == PH_FFN_IN_0) ? 4 : (ph == PH_FFN_IN_1) ? 10 : 12; spare_convert(C, args, f, l, (M / 256) * (2 * FF / 256)); }
            const bf16* Bt = (ph == PH_FFN_IN_3) ? (const bf16*)args.out : (const bf16*)(ws + (ph == PH_FFN_IN_0 ? WS_WIN0 : ph == PH_FFN_IN_1 ? WS_WIN1 : WS_WIN2));
            bf16* act = (bf16*)(ws + (ph == PH_FFN_IN_3 ? WS_ACT3 : WS_ACT));
            pg8::Gemm g{xb, Bt, M, 2 * FF, D}; pg8::StaticOrder S; S.init(M, 2 * FF, C.G, (int)blockIdx.x);
            fill_rstd(C.lds, S, ssq, C.tid);
            EpiSwiGLU E{(const LAS float*)(C.lds + RSTD_OFF), act};
            pg8::gemm_phase<EpiSwiGLU, pg8::StaticOrder, true, true>(C.lds, g, S, E, C.wave);
        } break;
        case PH_FFN_OUT_0: case PH_FFN_OUT_1: case PH_FFN_OUT_2: case PH_FFN_OUT_3: case PH_RNN_OUT: case PH_WO: {
            const bf16* A; const bf16* Bt; int K; float scale = 0.5f; const float* xin = args.out;
            if (ph == PH_FFN_OUT_0) { A = (const bf16*)(ws + WS_ACT); Bt = (const bf16*)(ws + WS_WOUT0); K = FF; xin = args.in[I_X]; }
            else if (ph == PH_FFN_OUT_1) { A = (const bf16*)(ws + WS_ACT); Bt = (const bf16*)(ws + WS_WOUT1); K = FF; }
            else if (ph == PH_FFN_OUT_2) { A = (const bf16*)(ws + WS_ACT); Bt = (const bf16*)(ws + WS_WOUT2); K = FF; }
            else if (ph == PH_FFN_OUT_3) { A = (const bf16*)(ws + WS_ACT3); Bt = (const bf16*)(ws + WS_WOUT3); K = FF; }
            else if (ph == PH_RNN_OUT) { A = (const bf16*)(ws + WS_Y); Bt = (const bf16*)(ws + WS_WROUT); K = DRNN; scale = 1.f; }
            else { A = (const bf16*)args.out + (size_t)8 * 1024 * 1024; Bt = (const bf16*)(ws + WS_WO); K = D; scale = 1.f; }
            float* xo = args.out;
#if RESID_BF16
            if (ph != PH_FFN_OUT_0) xin = nullptr;
            if (ph != PH_FFN_OUT_3) xo = nullptr;
#endif
            pg8::Gemm g{A, Bt, M, D, K}; pg8::StaticOrder S; S.init(M, D, C.G, (int)blockIdx.x);
            EpiRes E{xin, xo, xb, ssq, scale};
            pg8::gemm_phase<EpiRes, pg8::StaticOrder, false, true>(C.lds, g, S, E, C.wave);
        } break;
        case PH_RNN_IN: {
            spare_convert(C, args, 7, 8, (M / 256) * (2 * DRNN / 256));
            pg8::Gemm g{xb, (const bf16*)(ws + WS_WRIN), M, 2 * DRNN, D}; pg8::StaticOrder S; S.init(M, 2 * DRNN, C.G, (int)blockIdx.x);
            fill_rstd(C.lds, S, ssq, C.tid);
            EpiRnnIn E{(const LAS float*)(C.lds + RSTD_OFF), (bf16*)(ws + WS_G), (bf16*)(ws + WS_U)};
            pg8::gemm_phase<EpiRnnIn, pg8::StaticOrder, true, true>(C.lds, g, S, E, C.wave);
        } break;
        case PH_RNN_MID: p_rnn_mid(C, args); break;
        case PH_QKV: {
            pg8::Gemm g{xb, (const bf16*)(ws + WS_WQKV), M, NQKV, D}; pg8::StaticOrder S; S.init(M, NQKV, C.G, (int)blockIdx.x);
            if (C.tid < 128) ((LAS float*)(C.lds + GAIN_OFF))[C.tid] = (C.tid < 64) ? args.in[I_QGAIN][C.tid] * (0.125f * LOG2E) : args.in[I_KGAIN][C.tid - 64];
            fill_rstd(C.lds, S, ssq, C.tid);
            EpiQKV E{(const LAS float*)(C.lds + RSTD_OFF), (const LAS float*)(C.lds + GAIN_OFF), (bf16*)(ws + WS_QKV)};
            pg8::gemm_phase<EpiQKV, pg8::StaticOrder, true, true>(C.lds, g, S, E, C.wave);
        } break;
        case PH_ATTN: p_attn(C, (bf16*)args.out + (size_t)8 * 1024 * 1024); break;
        default: break;
        }
        if (ph + 1 < args.ph_hi) xcd_barrier(bar, C.wave * 64 + pg8::fresh_lane());
        }
    }
}

extern "C" void kernel_launch(void* const* d_in, const int* in_sizes, int n_in, void* d_out, int out_size, void* d_ws, size_t ws_size, hipStream_t stream) {
    static int grid = 0;
    if (grid == 0) {
        if (n_in != 18 || in_sizes[0] != M * D || out_size != M * D || ws_size < WS_END) { fprintf(stderr, "kernel_launch: unexpected shapes (n_in %d, in0 %d, out %d, ws %zu)\n", n_in, n_in > 0 ? in_sizes[0] : -1, out_size, ws_size); grid = -1; return; }
        int dev = 0, cus = 0, per_cu = 0;
        if (hipGetDevice(&dev) != hipSuccess || hipDeviceGetAttribute(&cus, hipDeviceAttributeMultiprocessorCount, dev) != hipSuccess) { fprintf(stderr, "kernel_launch: device query failed\n"); grid = -1; return; }
        if (hipFuncSetAttribute((const void*)fwd_kernel, hipFuncAttributeMaxDynamicSharedMemorySize, LDS_BYTES) != hipSuccess) { fprintf(stderr, "kernel_launch: hipFuncSetAttribute failed\n"); grid = -1; return; }
        if (hipOccupancyMaxActiveBlocksPerMultiprocessor(&per_cu, (const void*)fwd_kernel, NWAVES * 64, LDS_BYTES) != hipSuccess || per_cu < 1) { fprintf(stderr, "kernel_launch: occupancy query says %d blocks per CU\n", per_cu); (void)hipGetLastError(); grid = -1; return; }
        grid = cus;
    }
    if (grid < 0) return;
    if (hipMemsetAsync(d_ws, 0, CTL_ZERO_BYTES, stream) != hipSuccess) { fprintf(stderr, "kernel_launch: memset failed\n"); return; }
    Args a{};
    for (int i = 0; i < 18; ++i) a.in[i] = (const float*)d_in[i];
    a.out = (float*)d_out; a.ws = (unsigned char*)d_ws;
#if SINGLE_LAUNCH
    a.ph_lo = 0; a.ph_hi = NPHASE;
    hipLaunchKernelGGL(fwd_kernel, dim3(grid), dim3(NWAVES * 64), LDS_BYTES, stream, a);
#else
    for (int ph = 0; ph < NPHASE; ++ph) { a.ph_lo = ph; a.ph_hi = ph + 1; hipLaunchKernelGGL(fwd_kernel, dim3(grid), dim3(NWAVES * 64), LDS_BYTES, stream, a); }
#endif
}
```

```cpp
#include <hip/hip_runtime.h>
#include <cstdio>
#include <cstdint>

#ifndef SINGLE_LAUNCH
#define SINGLE_LAUNCH 1
#define QKV_WGM 5
#define FFNIN_WGM 3
#define FFNIN3_WGM 8
#define OUT_WGM 8
#define RNNIN_WGM 3
#endif

namespace pg8 {
#define PG8_LAS __attribute__((address_space(3)))
typedef unsigned short bf16_t;
typedef short bf16x8 __attribute__((ext_vector_type(8)));
typedef float f32x4 __attribute__((ext_vector_type(4)));
typedef unsigned u32x4 __attribute__((ext_vector_type(4)));
constexpr int BM = 256, BK = 64, HALF = 128, HTB = HALF * BK * 2, STAGE_BYTES = 8 * HTB, NXCD = 8, WGM = 8;

__host__ __device__ __forceinline__ int lds_byte(int r, int c) { return (r >> 3) * 1024 + (r & 7) * 128 + ((((c >> 3) ^ (r & 7)) & 7) << 4) + (c & 7) * 2; }
__host__ __device__ __forceinline__ void stage_rc(int b, int& R, int& C) { const int sidx = b / 1024, w = b % 1024, rowin = w / 128, pch = (w % 128) / 16; R = sidx * 8 + rowin; C = ((pch ^ rowin) & 7) * 8; }
__host__ __device__ __forceinline__ int perm32(int rho) { const int n = rho >> 4, i = rho & 15; return 8 * (i >> 2) + 4 * n + (i & 3); }

struct Unit { int pm, pn; };
struct Gemm { const bf16_t* A; const bf16_t* Bt; int M, N, K; };

struct StaticOrder {
    int nM, nN, nwg, G, c, wgm;
    __host__ __device__ void init(int M, int N, int G_, int c_, int wgm_ = WGM) { nM = M / BM; nN = N / BM; nwg = nM * nN; G = G_; c = c_; wgm = wgm_; }
    __host__ __device__ bool next(int i, Unit& u) const {
        const long L = (long)i * G + c; if (L >= nwg) return false;
        int wgid = (int)L; { const int q = nwg / NXCD, r = nwg % NXCD, xcd = wgid % NXCD, off = wgid / NXCD; wgid = (xcd < r ? xcd * (q + 1) : r * (q + 1) + (xcd - r) * q) + off; }
        const int nig = wgm * nN, gid = wgid / nig, fm = gid * wgm, gsz = (nM - fm) < wgm ? (nM - fm) : wgm;
        u.pm = fm + ((wgid % nig) % gsz); u.pn = (wgid % nig) / gsz; return true;
    }
    __device__ __forceinline__ void a_ready(const Unit&) const {}
    __device__ __forceinline__ void done(const Unit&) const {}
};

__device__ __forceinline__ unsigned cvt_pk_bf16(float lo, float hi) { unsigned r; asm volatile("v_cvt_pk_bf16_f32 %0, %1, %2" : "=v"(r) : "v"(lo), "v"(hi)); return r; }

__device__ __forceinline__ int fresh_lane() { int l; asm volatile("v_mbcnt_lo_u32_b32 %0, -1, 0\n\tv_mbcnt_hi_u32_b32 %0, -1, %0" : "=v"(l)); __builtin_assume(l >= 0 && l < 64); return l; }
template <class Epi, class Sched, bool ALIGN_EPI = false, bool SP2 = false>
__device__ __forceinline__ void gemm_phase(PG8_LAS unsigned char* lds, const Gemm g, const Sched& S, const Epi& E, const int wave_) {
    __builtin_assume(wave_ >= 0 && wave_ < 8);
    int tid_ = wave_ * 64 + fresh_lane();
    const int tid = tid_, wid = wave_, lane = tid & 63, wr = wid >> 2, wc = wid & 3, fr = lane & 15, fq = lane >> 4;
    const int K = g.K, nt = K / BK;
    unsigned voffA, voffB;
    { int R, C; stage_rc(tid * 16, R, C); const int Rb = Epi::PERM ? ((R & ~31) + perm32(R & 31)) : R; voffA = (unsigned)(R * K + C) * 2u; voffB = (unsigned)(Rb * K + C) * 2u; }
    const size_t pstep = (size_t)64 * K * 2;
    const size_t kstep = (size_t)(BK * 2);
    const size_t hstep = (size_t)HALF * K * 2;
    const size_t tstep = 2 * hstep;
    const unsigned ldsw = (unsigned)wid * 1024u;
    const int aoff = lds_byte(wr * 64 + fr, fq * 8), boff = lds_byte(wc * 32 + fr, fq * 8);
#define PG8_SA(b, h) (((b) * 2 + (h)) * HTB)
#define PG8_SB(b, h) ((4 + (b) * 2 + (h)) * HTB)
#define PG8_STAGE(bufoff, gbase, voff) do { _Pragma("unroll") for (int _i = 0; _i < 2; ++_i) \
        __builtin_amdgcn_global_load_lds((const unsigned*)((const char*)(gbase) + _i * pstep + (voff)), (PG8_LAS unsigned*)(lds + (bufoff) + ldsw + _i * 8192), 16, 0, 0); } while (0)
#define PG8_LDA(dst, b, h) do { _Pragma("unroll") for (int m = 0; m < 4; ++m) _Pragma("unroll") for (int k = 0; k < 2; ++k) dst[m][k] = *(const PG8_LAS bf16x8*)(lds + PG8_SA(b, h) + (aoff ^ (k * 64)) + m * 2048); } while (0)
#define PG8_LDB(dst, b, h) do { _Pragma("unroll") for (int n = 0; n < 2; ++n) _Pragma("unroll") for (int k = 0; k < 2; ++k) dst[n][k] = *(const PG8_LAS bf16x8*)(lds + PG8_SB(b, h) + (boff ^ (k * 64)) + n * 2048); } while (0)
#define PG8_MMA(ai, bj, At, Bt) do { __builtin_amdgcn_s_setprio(1); _Pragma("unroll") for (int m = 0; m < 4; ++m) _Pragma("unroll") for (int n = 0; n < 2; ++n) _Pragma("unroll") for (int k = 0; k < 2; ++k) \
        acc[ai][bj][m][n] = __builtin_amdgcn_mfma_f32_16x16x32_bf16(Bt[n][k], At[m][k], acc[ai][bj][m][n], 0, 0, 0); __builtin_amdgcn_s_setprio(0); } while (0)
#define PG8_WAIT_V(n) asm volatile("s_waitcnt vmcnt(" #n ")" ::: "memory")
#define PG8_WAIT_L(n) asm volatile("s_waitcnt lgkmcnt(" #n ")" ::: "memory")
#define PG8_BAR __builtin_amdgcn_s_barrier()
#define PG8_SCHED __builtin_amdgcn_sched_barrier(0)
    Unit cur, nxt; int ui = 0;
    if (!S.next(0, cur)) return;
    f32x4 acc[2][2][4][2];
#pragma unroll
    for (int a = 0; a < 2; ++a)
#pragma unroll
        for (int b = 0; b < 2; ++b)
#pragma unroll
            for (int m = 0; m < 4; ++m)
#pragma unroll
                for (int n = 0; n < 2; ++n) acc[a][b][m][n] = (f32x4){0.f, 0.f, 0.f, 0.f};
    bf16x8 At[4][2], B0[2][2], B1[2][2];
    const char* cA = (const char*)g.A + (size_t)cur.pm * tstep; const char* cB = (const char*)g.Bt + (size_t)cur.pn * tstep;
    S.a_ready(cur);
    if constexpr (SP2) {
        PG8_STAGE(PG8_SB(0, 0), cB, voffB); PG8_STAGE(PG8_SB(0, 1), cB + hstep, voffB); PG8_STAGE(PG8_SA(0, 0), cA, voffA); PG8_STAGE(PG8_SA(0, 1), cA + hstep, voffA);
        E.pre(S, tid);
        if (wr == 1) PG8_BAR;
        PG8_WAIT_V(2); PG8_BAR;
        PG8_STAGE(PG8_SB(1, 0), cB + kstep, voffB); PG8_STAGE(PG8_SA(1, 0), cA + kstep, voffA); PG8_STAGE(PG8_SB(1, 1), cB + hstep + kstep, voffB);
        PG8_WAIT_V(6); PG8_BAR;
    } else {
        PG8_STAGE(PG8_SB(0, 0), cB, voffB); PG8_STAGE(PG8_SA(0, 0), cA, voffA); PG8_STAGE(PG8_SB(0, 1), cB + hstep, voffB); PG8_STAGE(PG8_SA(0, 1), cA + hstep, voffA);
        E.pre(S, tid);
        if (wr == 1) PG8_BAR;
        PG8_WAIT_V(4); PG8_BAR;
        PG8_STAGE(PG8_SB(1, 0), cB + kstep, voffB); PG8_STAGE(PG8_SA(1, 0), cA + kstep, voffA); PG8_STAGE(PG8_SB(1, 1), cB + hstep + kstep, voffB);
        PG8_WAIT_V(6); PG8_BAR;
    }
    for (;;) {
        const bool has_next = S.next(ui + 1, nxt);
        const char* nA = has_next ? (const char*)g.A + (size_t)nxt.pm * tstep : cA; const char* nB = has_next ? (const char*)g.Bt + (size_t)nxt.pn * tstep : cB;
        for (int t = 0; t < nt; t += 2) {
            const bool last = (t == nt - 2);
            const char* a1 = cA + (size_t)(t + 1) * kstep;
            const char* a2 = last ? nA : cA + (size_t)(t + 2) * kstep; const char* b2 = last ? nB : cB + (size_t)(t + 2) * kstep;
            const char* a3 = a2 + kstep; const char* b3 = b2 + kstep;
            if (last && has_next) S.a_ready(nxt);
            if constexpr (SP2) {
            PG8_LDB(B0, 0, 0); PG8_LDB(B1, 0, 1); PG8_SCHED; PG8_LDA(At, 0, 0); PG8_STAGE(PG8_SA(1, 1), a1 + hstep, voffA);
            PG8_WAIT_V(8); PG8_WAIT_L(0); PG8_BAR; PG8_MMA(0, 0, At, B0); PG8_MMA(0, 1, At, B1); PG8_BAR; PG8_SCHED;
            PG8_LDA(At, 0, 1); PG8_STAGE(PG8_SB(0, 0), b2, voffB); PG8_STAGE(PG8_SB(0, 1), b2 + hstep, voffB); PG8_STAGE(PG8_SA(0, 0), a2, voffA);
            PG8_WAIT_V(8); PG8_WAIT_L(0); PG8_BAR; PG8_MMA(1, 0, At, B0); PG8_MMA(1, 1, At, B1); PG8_BAR; PG8_SCHED;
            PG8_LDB(B0, 1, 0); PG8_LDB(B1, 1, 1); PG8_SCHED; PG8_LDA(At, 1, 0); PG8_STAGE(PG8_SA(0, 1), a2 + hstep, voffA);
            PG8_WAIT_V(8); PG8_WAIT_L(0); PG8_BAR; PG8_MMA(0, 0, At, B0); PG8_MMA(0, 1, At, B1); PG8_BAR; PG8_SCHED;
            PG8_LDA(At, 1, 1); PG8_STAGE(PG8_SB(1, 0), b3, voffB); PG8_STAGE(PG8_SB(1, 1), b3 + hstep, voffB); PG8_STAGE(PG8_SA(1, 0), a3, voffA);
            PG8_WAIT_V(8); PG8_WAIT_L(0); PG8_BAR; PG8_MMA(1, 0, At, B0); PG8_MMA(1, 1, At, B1); PG8_BAR; PG8_SCHED;
            } else {
            PG8_LDB(B0, 0, 0); PG8_SCHED; PG8_LDA(At, 0, 0); PG8_STAGE(PG8_SA(1, 1), a1 + hstep, voffA);
            PG8_WAIT_L(8); PG8_BAR; PG8_WAIT_L(0); PG8_MMA(0, 0, At, B0); PG8_BAR; PG8_SCHED;
            PG8_LDB(B1, 0, 1); PG8_STAGE(PG8_SB(0, 0), b2, voffB);
            PG8_BAR; PG8_WAIT_L(0); PG8_MMA(0, 1, At, B1); PG8_BAR;
            PG8_LDA(At, 0, 1); PG8_STAGE(PG8_SA(0, 0), a2, voffA);
            PG8_BAR; PG8_WAIT_L(0); PG8_MMA(1, 0, At, B0); PG8_BAR; PG8_SCHED;
            PG8_STAGE(PG8_SB(0, 1), b2 + hstep, voffB);
            PG8_WAIT_V(6); PG8_BAR; PG8_MMA(1, 1, At, B1); PG8_BAR;
            PG8_LDB(B0, 1, 0); PG8_SCHED; PG8_LDA(At, 1, 0); PG8_STAGE(PG8_SA(0, 1), a2 + hstep, voffA);
            PG8_WAIT_L(8); PG8_BAR; PG8_WAIT_L(0); PG8_MMA(0, 0, At, B0); PG8_BAR; PG8_SCHED;
            PG8_LDB(B1, 1, 1); PG8_STAGE(PG8_SB(1, 0), b3, voffB);
            PG8_BAR; PG8_WAIT_L(0); PG8_MMA(0, 1, At, B1); PG8_BAR;
            PG8_LDA(At, 1, 1); PG8_STAGE(PG8_SA(1, 0), a3, voffA);
            PG8_BAR; PG8_WAIT_L(0); PG8_MMA(1, 0, At, B0); PG8_BAR; PG8_SCHED;
            PG8_STAGE(PG8_SB(1, 1), b3 + hstep, voffB);
            PG8_WAIT_V(6); PG8_BAR; PG8_MMA(1, 1, At, B1); PG8_BAR;
            }
        }
        if constexpr (ALIGN_EPI) { if (wr == 0) PG8_BAR; }
        E(acc, cur, ui, wr, wc, fr, fq); S.done(cur);
        if (!has_next) break;
#pragma unroll
        for (int a = 0; a < 2; ++a)
#pragma unroll
            for (int b = 0; b < 2; ++b)
#pragma unroll
                for (int m = 0; m < 4; ++m)
#pragma unroll
                    for (int n = 0; n < 2; ++n) acc[a][b][m][n] = (f32x4){0.f, 0.f, 0.f, 0.f};
        cur = nxt; cA = nA; cB = nB; ++ui;
        if constexpr (ALIGN_EPI) { if (wr == 1) PG8_BAR; }
    }
    PG8_WAIT_V(0);
    if constexpr (!ALIGN_EPI) { if (wr == 0) PG8_BAR; }
    PG8_BAR;
#undef PG8_SA
#undef PG8_SB
#undef PG8_STAGE
#undef PG8_LDA
#undef PG8_LDB
#undef PG8_MMA
#undef PG8_WAIT_V
#undef PG8_WAIT_L
#undef PG8_BAR
#undef PG8_SCHED
}
}

constexpr int BATCH = 8, SEQ = 2048, D = 1024, M = BATCH * SEQ;
constexpr int FF = 2816, DRNN = 1280, NBLK = 10, RBLK = 128, CONVW = 4;
constexpr int NHEAD = 16, HD = 64, NGRP = 3, NQKV = 9216;
constexpr float RMS_EPS = 1e-6f;
constexpr float LOG2E = 1.4426950408889634f;
constexpr int NWAVES = 8;

typedef unsigned short bf16;
typedef unsigned v4u __attribute__((ext_vector_type(4)));
typedef unsigned v2u __attribute__((ext_vector_type(2)));
typedef float f32x4 __attribute__((ext_vector_type(4)));
#define GAS __attribute__((address_space(1)))
#define LAS __attribute__((address_space(3)))
typedef GAS unsigned gu32;
#define RLX_AGENT __ATOMIC_RELAXED, __HIP_MEMORY_SCOPE_AGENT
#define LDS_WAIT() asm volatile("s_waitcnt lgkmcnt(0)" ::: "memory")

#ifndef RESID_BF16
#define RESID_BF16 1
#endif
constexpr size_t MiB = 1u << 20;
constexpr size_t WS_CTL = 0, CTL_ZERO_BYTES = 32 * 1024;
constexpr size_t WS_SSQ = 1 * MiB;
constexpr size_t WS_BIAS = 2 * MiB;
constexpr size_t WS_XB = 3 * MiB;
constexpr size_t WS_WO = 35 * MiB;
constexpr size_t WS_WQKV = 37 * MiB;
constexpr size_t WS_QKV = 55 * MiB;
constexpr size_t QKV_SLAB = (size_t)M * 1024 * 2;
constexpr size_t WS_TAIL = 343 * MiB;
constexpr size_t WS_END = 351 * MiB;
constexpr size_t WS_WIN0 = 55 * MiB, WS_WOUT0 = 66 * MiB, WS_WIN1 = 72 * MiB, WS_WOUT1 = 83 * MiB, WS_WIN2 = 89 * MiB, WS_WOUT2 = 100 * MiB;
constexpr size_t WS_WRIN = 106 * MiB, WS_WROUT = 111 * MiB, WS_WA = 114 * MiB, WS_WX = 114 * MiB + 512 * 1024;
constexpr size_t WS_ACT = 115 * MiB;
constexpr size_t WS_G = 203 * MiB, WS_U = 243 * MiB, WS_Y = 283 * MiB;
constexpr size_t WS_ATT = WS_QKV + 3 * QKV_SLAB;
constexpr size_t WS_WOUT3 = WS_TAIL + 2 * MiB + 192 * 1024;
constexpr size_t WS_WIN3 = 160 * MiB;
constexpr size_t WS_ACT3 = 175 * MiB;
static_assert(WS_Y + (size_t)M * DRNN * 2 <= WS_TAIL && WS_ACT + (size_t)M * FF * 2 <= WS_G && WS_WX + 327680 <= WS_ACT, "ws map");
static_assert(WS_QKV + 9 * QKV_SLAB == WS_TAIL && WS_WOUT3 + (size_t)D * FF * 2 <= WS_END && RESID_BF16 == 1, "ws map");
constexpr int CW_BAR = 4096;

constexpr int RING_BYTES = 131072;
constexpr int RSTD_OFF = RING_BYTES + 1024, RSTD_MAX_UNITS = 9, GAIN_OFF = RSTD_OFF + RSTD_MAX_UNITS * 256 * 4;
constexpr int LDS_BYTES = 163840;
constexpr int EPI_SCR_OFF = GAIN_OFF + 512, EPI_SCR_WAVE = 2048;
constexpr int MISC_OFF = LDS_BYTES - 128;
static_assert(EPI_SCR_OFF % 16 == 0 && EPI_SCR_OFF + 8 * EPI_SCR_WAVE <= LDS_BYTES - 128, "LDS map");

#define XB_TMO      128
#define XB_XCNT(j)  (256  + 64 * (j))
#define XB_XSUB(j)  (1280 + 64 * (j))
#define XB_XGEN(j)  (2304 + 64 * (j))
#define XB_TOP      3328
#define XB_TOPGEN   3392
#define XCD_BAR_WORDS 3456
#define XB_SPIN_CAP (1u << 18)
__device__ __forceinline__ unsigned xb_ld(unsigned* p)              { return __hip_atomic_load(p, __ATOMIC_RELAXED, __HIP_MEMORY_SCOPE_AGENT); }
__device__ __forceinline__ unsigned xb_add(unsigned* p, unsigned v) { return __hip_atomic_fetch_add(p, v, __ATOMIC_RELAXED, __HIP_MEMORY_SCOPE_AGENT); }
__device__ __forceinline__ unsigned xb_xcc_id() { return (unsigned)__builtin_amdgcn_s_getreg((3 << 11) | 20) & 0xFu; }
#define XB_SPIN(cond, bar) do { unsigned _sp = 0; while (cond) { __builtin_amdgcn_s_sleep(1); \
    if ((++_sp & 255u) == 0u) { if (xb_ld(&(bar)[XB_TMO])) break; if (_sp > XB_SPIN_CAP) { atomicAdd(&(bar)[XB_TMO], 1u); break; } } } } while (0)
struct XcdBarrier { unsigned* bar; unsigned x; volatile LAS unsigned* st; };
__device__ __forceinline__ XcdBarrier xcd_barrier_post(unsigned* bar, volatile LAS unsigned* st, const int tid) {
    XcdBarrier b; b.bar = bar; b.x = xb_xcc_id(); b.st = st;
    if (tid == 0) (void)xb_add(&bar[XB_XCNT(b.x)], 1u);
    return b;
}
__device__ __forceinline__ void xcd_barrier_complete(unsigned* bar, unsigned x, unsigned& nloc, unsigned& nx) {
    const unsigned G = gridDim.x * gridDim.y * gridDim.z;
    unsigned sum, cnt, mine, sp = 0u;
    for (;;) {
        sum = 0u; cnt = 0u; mine = 0u;
#pragma unroll
        for (unsigned j = 0; j < 16; ++j) { const unsigned c = xb_ld(&bar[XB_XCNT(j)]); sum += c; cnt += (c > 0u) ? 1u : 0u; mine = (j == x) ? c : mine; }
        if (sum == G) break;
        __builtin_amdgcn_s_sleep(1);
        if ((++sp & 255u) == 0u) { if (xb_ld(&bar[XB_TMO])) break; if (sp > XB_SPIN_CAP) { atomicAdd(&bar[XB_TMO], 1u); break; } }
    }
    nloc = mine > 0u ? mine : 1u; nx = cnt > 0u ? cnt : 1u;
}
__device__ __forceinline__ void xcd_barrier(const XcdBarrier& b, const int tid) {
    asm volatile("s_waitcnt vmcnt(0)" ::: "memory");
    __syncthreads();
    if (tid == 0) {
        unsigned* bar = b.bar;
        __builtin_amdgcn_s_waitcnt(0);
        unsigned nloc = b.st[0], nx = b.st[1];
        if (nloc == 0u) { xcd_barrier_complete(bar, b.x, nloc, nx); b.st[0] = nloc; b.st[1] = nx; }
        const unsigned old = xb_add(&bar[XB_XSUB(b.x)], 1u);
        const unsigned gen = old / nloc;
        if (old + 1u == (gen + 1u) * nloc) {
            __builtin_amdgcn_fence(__ATOMIC_RELEASE, "agent");
            asm volatile("s_waitcnt vmcnt(0)" ::: "memory");
            const unsigned og = xb_add(&bar[XB_TOP], 1u);
            const unsigned tg = og / nx;
            if (og + 1u == (tg + 1u) * nx) xb_add(&bar[XB_TOPGEN], 1u);
            else XB_SPIN(xb_ld(&bar[XB_TOPGEN]) == tg, bar);
            __builtin_amdgcn_fence(__ATOMIC_ACQUIRE, "agent");
            asm volatile("s_waitcnt vmcnt(0)" ::: "memory");
        } else {
            XB_SPIN(xb_ld(&bar[XB_TOPGEN]) == gen, bar);
            __builtin_amdgcn_fence(__ATOMIC_ACQUIRE, "agent");
            asm volatile("s_waitcnt vmcnt(0)" ::: "memory");
        }
    }
    __syncthreads();
}

__device__ __forceinline__ unsigned f2bf(float f) { unsigned u = __builtin_bit_cast(unsigned, f); return (u + 0x7fffu + ((u >> 16) & 1u)) >> 16; }
__device__ __forceinline__ unsigned pk2(float lo, float hi) { return f2bf(lo) | (f2bf(hi) << 16); }
__device__ __forceinline__ float bf_lo(unsigned w) { return __builtin_bit_cast(float, w << 16); }
__device__ __forceinline__ float bf_hi(unsigned w) { return __builtin_bit_cast(float, w & 0xffff0000u); }
__device__ __forceinline__ float bf2f(bf16 v) { return __builtin_bit_cast(float, (unsigned)v << 16); }
__device__ __forceinline__ float wave_sum(float v) {
#pragma unroll
    for (int o = 1; o < 64; o <<= 1) v += __shfl_xor(v, o);
    return v;
}
__device__ __forceinline__ float fast_sigmoid(float x) { return __builtin_amdgcn_rcpf(1.f + __builtin_amdgcn_exp2f(-LOG2E * x)); }
__device__ __forceinline__ float row_rstd(const float* ssq, int row) {
    const f32x4* p = (const f32x4*)(ssq + (size_t)row * 16); const f32x4 a = p[0], b = p[1], c = p[2], d = p[3];
    const float s = ((a.x + a.y) + (a.z + a.w)) + ((b.x + b.y) + (b.z + b.w)) + ((c.x + c.y) + (c.z + c.w)) + ((d.x + d.y) + (d.z + d.w));
    return rsqrtf(s * (1.0f / D) + RMS_EPS);
}

typedef float f32x2 __attribute__((ext_vector_type(2)));
template <class Sched> __device__ __forceinline__ void fill_rstd(LAS unsigned char* lds, const Sched& S, const float* ssq, int tid) {
    LAS float* rt = (LAS float*)(lds + RSTD_OFF); pg8::Unit u;
    for (int i = 0; i < RSTD_MAX_UNITS && S.next(i, u); ++i)
        if ((tid >> 8) == (i & 1)) { const int r = tid & 255; rt[i * 256 + r] = row_rstd(ssq, u.pm * 256 + r); }
    __syncthreads();
}
using pg8::Unit;
__device__ __forceinline__ f32x2 silu_mul_pk(f32x2 g, f32x2 up) {
    const f32x2 t = g * (-LOG2E); f32x2 e; e.x = __builtin_amdgcn_exp2f(t.x); e.y = __builtin_amdgcn_exp2f(t.y);
    const f32x2 d = e + 1.0f; f32x2 r; r.x = __builtin_amdgcn_rcpf(d.x); r.y = __builtin_amdgcn_rcpf(d.y);
    return (g * r) * up;
}
struct EpiSwiGLU {
    static constexpr bool PERM = true;
    const LAS float* rtab; bf16* act;
    const float* ssqsrc;
    template <class Sched> __device__ __forceinline__ void pre(const Sched& S, int tid) const {
        LAS float* rt = (LAS float*)rtab; Unit u;
        for (int i = 0; i < RSTD_MAX_UNITS && S.next(i, u); ++i) if ((tid >> 8) == (i & 1)) { const int r = tid & 255; rt[i * 256 + r] = row_rstd(ssqsrc, u.pm * 256 + r); }
    }
    __device__ __forceinline__ void operator()(const f32x4 (&acc)[2][2][4][2], const Unit& u, int ui, int wr, int wc, int fr, int fq) const {
#pragma unroll
        for (int ai = 0; ai < 2; ++ai)
#pragma unroll
            for (int m = 0; m < 4; ++m) {
                const int rl = ai * 128 + wr * 64 + m * 16 + fr, row = u.pm * 256 + rl;
                const float rs = rtab[ui * 256 + rl];
                f32x2 v[4];
#pragma unroll
                for (int n = 0; n < 2; ++n)
#pragma unroll
                    for (int e = 0; e < 2; ++e) { const f32x2 g = (f32x2){acc[ai][0][m][n][2 * e], acc[ai][0][m][n][2 * e + 1]} * rs, up = (f32x2){acc[ai][1][m][n][2 * e], acc[ai][1][m][n][2 * e + 1]} * rs;
                        v[n * 2 + e] = silu_mul_pk(g, up); }
                v4u w; w.x = pg8::cvt_pk_bf16(v[0].x, v[0].y); w.y = pg8::cvt_pk_bf16(v[1].x, v[1].y); w.z = pg8::cvt_pk_bf16(v[2].x, v[2].y); w.w = pg8::cvt_pk_bf16(v[3].x, v[3].y);
                *(v4u*)(act + (size_t)row * FF + u.pn * 128 + wc * 32 + 8 * fq) = w;
            }
    }
};
#ifndef RESID_BF16
#define RESID_BF16 1
#endif
__device__ __forceinline__ float xsum_16_32(float x) { float a = x, b = x;
    asm("s_nop 1\n\tv_permlane16_swap_b32 %0, %1\n\tv_add_f32 %0, %0, %1\n\tv_mov_b32 %1, %0\n\ts_nop 1\n\tv_permlane32_swap_b32 %0, %1\n\tv_add_f32 %0, %0, %1" : "+v"(a), "+v"(b)); return a; }
struct EpiRes {
    static constexpr bool PERM = true;
    const float* xin; float* xout; bf16* xb; float* ssq; float scale;
    template <class Sched> __device__ __forceinline__ void pre(const Sched&, int) const {}
    __device__ __forceinline__ void operator()(const f32x4 (&acc)[2][2][4][2], const Unit& u, int ui, int wr, int wc, int fr, int fq) const {
        if (xin) run<true>(acc, u, wr, wc, fr, fq); else run<false>(acc, u, wr, wc, fr, fq);
    }
    template <bool F32IN> __device__ __forceinline__ void run(const f32x4 (&acc)[2][2][4][2], const Unit& u, int wr, int wc, int fr, int fq) const {
#pragma unroll
        for (int ai = 0; ai < 2; ++ai) {
            f32x4 xv[4][2][2];
#pragma unroll
            for (int m = 0; m < 4; ++m)
#pragma unroll
                for (int bj = 0; bj < 2; ++bj) { const size_t off = (size_t)(u.pm * 256 + ai * 128 + wr * 64 + m * 16 + fr) * D + u.pn * 256 + bj * 128 + wc * 32 + 8 * fq;
                    if (F32IN) { xv[m][bj][0] = *(const f32x4*)(xin + off); xv[m][bj][1] = *(const f32x4*)(xin + off + 4); }
                    else { const v4u w = *(const v4u*)(xb + off); xv[m][bj][0] = (f32x4){bf_lo(w.x), bf_hi(w.x), bf_lo(w.y), bf_hi(w.y)}; xv[m][bj][1] = (f32x4){bf_lo(w.z), bf_hi(w.z), bf_lo(w.w), bf_hi(w.w)}; } }
#pragma unroll
            for (int m = 0; m < 4; ++m) {
                const int row = u.pm * 256 + ai * 128 + wr * 64 + m * 16 + fr;
                float ss = 0.f;
#pragma unroll
                for (int bj = 0; bj < 2; ++bj) {
                    const size_t off = (size_t)row * D + u.pn * 256 + bj * 128 + wc * 32 + 8 * fq;
                    const f32x4 y0 = xv[m][bj][0] + acc[ai][bj][m][0] * scale, y1 = xv[m][bj][1] + acc[ai][bj][m][1] * scale;
                    if (xout) { *(f32x4*)(xout + off) = y0; *(f32x4*)(xout + off + 4) = y1; }
                    else {
                        v4u w; w.x = pg8::cvt_pk_bf16(y0[0], y0[1]); w.y = pg8::cvt_pk_bf16(y0[2], y0[3]); w.z = pg8::cvt_pk_bf16(y1[0], y1[1]); w.w = pg8::cvt_pk_bf16(y1[2], y1[3]);
                        *(v4u*)(xb + off) = w;
                        ss += (y0[0] * y0[0] + y0[1] * y0[1]) + (y0[2] * y0[2] + y0[3] * y0[3]) + (y1[0] * y1[0] + y1[1] * y1[1]) + (y1[2] * y1[2] + y1[3] * y1[3]); }
                }
                if (!xout) { ss = xsum_16_32(ss); if (fq == 0) ssq[(size_t)row * 16 + u.pn * 4 + wc] = ss; }
            }
            asm volatile("" ::: "memory");
        }
    }
};
struct EpiRnnIn {
    static constexpr bool PERM = true;
    const LAS float* rtab; bf16* Gb; bf16* Ub;
    const float* ssqsrc;
    template <class Sched> __device__ __forceinline__ void pre(const Sched& S, int tid) const {
        LAS float* rt = (LAS float*)rtab; Unit u;
        for (int i = 0; i < RSTD_MAX_UNITS && S.next(i, u); ++i) if ((tid >> 8) == (i & 1)) { const int r = tid & 255; rt[i * 256 + r] = row_rstd(ssqsrc, u.pm * 256 + r); }
    }
    template <bool GATE> __device__ __forceinline__ void run(const f32x4 (&acc)[2][2][4][2], const Unit& u, int ui, int wr, int wc, int fr, int fq, bf16* dstb, int pc) const {
#pragma unroll
        for (int ai = 0; ai < 2; ++ai)
#pragma unroll
            for (int m = 0; m < 4; ++m) {
                const int rl = ai * 128 + wr * 64 + m * 16 + fr, row = u.pm * 256 + rl;
                const float rs = rtab[ui * 256 + rl];
#pragma unroll
                for (int bj = 0; bj < 2; ++bj) {
                    f32x2 v[4];
#pragma unroll
                    for (int n = 0; n < 2; ++n)
#pragma unroll
                        for (int e = 0; e < 2; ++e) { f32x2 x = (f32x2){acc[ai][bj][m][n][2 * e], acc[ai][bj][m][n][2 * e + 1]} * rs;
                            if (GATE) {
                                const f32x2 t = (x * x * 0.044715f + 1.0f) * x * (-1.5957691216057308f * LOG2E); f32x2 ex; ex.x = __builtin_amdgcn_exp2f(t.x); ex.y = __builtin_amdgcn_exp2f(t.y);
                                const f32x2 d = ex + 1.0f; f32x2 r; r.x = __builtin_amdgcn_rcpf(d.x); r.y = __builtin_amdgcn_rcpf(d.y); x = x * r; }
                            v[n * 2 + e] = x; }
                    v4u w; w.x = pg8::cvt_pk_bf16(v[0].x, v[0].y); w.y = pg8::cvt_pk_bf16(v[1].x, v[1].y); w.z = pg8::cvt_pk_bf16(v[2].x, v[2].y); w.w = pg8::cvt_pk_bf16(v[3].x, v[3].y);
                    *(v4u*)(dstb + (size_t)row * DRNN + pc * 256 + bj * 128 + wc * 32 + 8 * fq) = w;
                }
            }
    }
    __device__ __forceinline__ void operator()(const f32x4 (&acc)[2][2][4][2], const Unit& u, int ui, int wr, int wc, int fr, int fq) const {
        if (u.pn < 5) run<true>(acc, u, ui, wr, wc, fr, fq, Gb, u.pn); else run<false>(acc, u, ui, wr, wc, fr, fq, Ub, u.pn - 5);
    }
};
struct EpiQKV {
    static constexpr bool PERM = true;
    const LAS float* rtab; const LAS float* gtab; bf16* qkv; LAS unsigned char* scr;
    const float* ssqsrc;
    template <class Sched> __device__ __forceinline__ void pre(const Sched& S, int tid) const {
        LAS float* rt = (LAS float*)rtab; Unit u;
        for (int i = 0; i < RSTD_MAX_UNITS && S.next(i, u); ++i) if ((tid >> 8) == (i & 1)) { const int r = tid & 255; rt[i * 256 + r] = row_rstd(ssqsrc, u.pm * 256 + r); }
    }
    __device__ __forceinline__ void operator()(const f32x4 (&acc)[2][2][4][2], const Unit& u, int ui, int wr, int wc, int fr, int fq) const {
        const int hs = u.pn * 4 + wc, kind = hs / 48, gh = hs - kind * 48, g = gh >> 4, h = gh & 15, l2d = 2 * g;
        bf16* slab = qkv + (size_t)(kind * 3 + g) * ((size_t)M * 1024);
        LAS unsigned char* scrw = scr + (wr * 4 + wc) * EPI_SCR_WAVE;
        f32x4 gv[2][2];
#pragma unroll
        for (int bj = 0; bj < 2; ++bj)
#pragma unroll
            for (int n = 0; n < 2; ++n) { gv[bj][n] = (f32x4){1.f, 1.f, 1.f, 1.f}; if (kind < 2) gv[bj][n] = *(const LAS f32x4*)(gtab + kind * 64 + 32 * bj + 8 * fq + 4 * n); }
#pragma unroll
        for (int ai = 0; ai < 2; ++ai)
#pragma unroll
            for (int m = 0; m < 4; ++m) {
                const int rl = ai * 128 + wr * 64 + m * 16 + fr, row = u.pm * 256 + rl;
                const float rs = rtab[ui * 256 + rl];
                float f = rs;
                if (kind < 2) {
                    f32x2 s2 = {0.f, 0.f};
#pragma unroll
                    for (int bj = 0; bj < 2; ++bj)
#pragma unroll
                        for (int n = 0; n < 2; ++n) { const f32x4 a = acc[ai][bj][m][n]; const f32x2 lo = {a[0], a[1]}, hi = {a[2], a[3]}; s2 = lo * lo + s2; s2 = hi * hi + s2; }
                    const float ss = xsum_16_32(s2.x + s2.y);
                    f = rs * __builtin_amdgcn_rsqf((rs * rs) * ss * (1.0f / HD) + RMS_EPS);
                }
#pragma unroll
                for (int bj = 0; bj < 2; ++bj) {
                    f32x4 a0 = acc[ai][bj][m][0] * f, a1 = acc[ai][bj][m][1] * f;
                    if (kind < 2) { a0 *= gv[bj][0]; a1 *= gv[bj][1]; }
                    v4u w; w.x = pg8::cvt_pk_bf16(a0[0], a0[1]); w.y = pg8::cvt_pk_bf16(a0[2], a0[3]); w.z = pg8::cvt_pk_bf16(a1[0], a1[1]); w.w = pg8::cvt_pk_bf16(a1[2], a1[3]);
                    *(LAS v4u*)(scrw + fr * 128 + (((4 * bj + fq) ^ (fr & 7)) << 4)) = w;
                }
                const int r8 = (fq << 1) | (fr >> 3), c8 = fr & 7, rbase = u.pm * 256 + ai * 128 + wr * 64 + m * 16;
                const v4u dA = *(const LAS v4u*)(scrw + r8 * 128 + ((c8 ^ r8) << 4)), dB = *(const LAS v4u*)(scrw + (8 + r8) * 128 + ((c8 ^ r8) << 4));
                {   const int rowA = rbase + r8, b = rowA >> 11, t = rowA & 2047, rres = t & ((1 << l2d) - 1), l = t >> l2d, L = 2048 >> l2d;
                    *(v4u*)(slab + ((size_t)(b * 16 + h) * 2048 + rres * L + l) * 64 + 8 * c8) = dA; }
                {   const int rowB = rbase + 8 + r8, b = rowB >> 11, t = rowB & 2047, rres = t & ((1 << l2d) - 1), l = t >> l2d, L = 2048 >> l2d;
                    *(v4u*)(slab + ((size_t)(b * 16 + h) * 2048 + rres * L + l) * 64 + 8 * c8) = dB; }
            }
    }
};

struct Args { const float* in[18]; float* out; unsigned char* ws; int ph_lo, ph_hi; };
enum { I_X = 0, I_NORMG, I_FFN_WIN, I_FFN_WOUT, I_RNN_WIN, I_CONV_W, I_CONV_B, I_WA, I_BA, I_WX, I_BX, I_LAM, I_RNN_WOUT, I_WQKV, I_QGAIN, I_KGAIN, I_WO, I_RELB };

struct Ctx { LAS unsigned char* lds; int tid, lane, wave, G, vcu; unsigned char* ws; };

typedef short v4i16_t __attribute__((ext_vector_type(4)));
__device__ __forceinline__ v4i16_t vtr16(const LAS unsigned char* p) { return __builtin_amdgcn_ds_read_tr16_b64_v4i16((LAS v4i16_t*)p); }
enum { CM_NONE = 0, CM_FFN = 1, CM_QKV = 2 };
__device__ __forceinline__ int colmap(int mode, int vr) {
    if (mode == CM_FFN) { const int pn = vr >> 8, w = vr & 255; return (w >> 7) * FF + 128 * pn + (w & 127); }
    if (mode == CM_QKV) { const int pn = vr >> 8, w = vr & 255, bj = w >> 7, wc = (w >> 5) & 3, j = w & 31; return 256 * pn + 64 * wc + 32 * bj + j; }
    return vr;
}
__device__ __forceinline__ void transpose_item(const float* W, int K, int N, const float* gvec, bf16* WT, int mode, LAS unsigned char* scr, int item, int lane) {
    const int nblk = N / 64, kb = item / nblk, nb = item - kb * nblk, k0 = 64 * kb, vr0 = 64 * nb;
    const int col4 = lane & 15, rsub = lane >> 4, nsrc = colmap(mode, vr0 + 32 * (col4 >> 3)) + (col4 & 7) * 4;
    const float* src = W + (size_t)(k0 + rsub) * N + nsrc;
    f32x4 w[16];
#pragma unroll
    for (int i = 0; i < 16; ++i) w[i] = __builtin_nontemporal_load((const GAS f32x4*)(src + (size_t)(4 * i) * N));
    if (gvec) {
#pragma unroll
        for (int i = 0; i < 16; ++i) w[i] = w[i] * gvec[k0 + 4 * i + rsub];
    }
#pragma unroll
    for (int i = 0; i < 16; ++i) { v2u p; p.x = pg8::cvt_pk_bf16(w[i][0], w[i][1]); p.y = pg8::cvt_pk_bf16(w[i][2], w[i][3]);
        *(LAS v2u*)(scr + (col4 >> 3) * 4096 + (4 * i + rsub) * 64 + (col4 & 7) * 8) = p; }
    const int q = (lane & 15) >> 2, p4 = lane & 3, gidx = lane >> 4;
#pragma unroll
    for (int r = 0; r < 8; ++r) { const int nb16 = r >> 1, kh = r & 1, kbase = 32 * kh + 8 * gidx;
        const LAS unsigned char* a = scr + (nb16 >> 1) * 4096 + (kbase + q) * 64 + ((nb16 & 1) * 16 + 4 * p4) * 2;
        const v4i16_t lo = vtr16(a), hi = vtr16(a + 4 * 64);
        v4u o; { const v2u l2 = __builtin_bit_cast(v2u, lo), h2 = __builtin_bit_cast(v2u, hi); o.x = l2.x; o.y = l2.y; o.z = h2.x; o.w = h2.y; }
        *(GAS v4u*)(WT + (size_t)(vr0 + nb16 * 16 + (lane & 15)) * K + k0 + kbase) = o; }
}
struct MatJob { const float* W; int K, N; const float* g; bf16* WT; int mode; };
__device__ __forceinline__ MatJob mat_job(const Ctx& C, const Args& a, int idx) {
    unsigned char* ws = C.ws; const float* ng = a.in[I_NORMG]; MatJob j;
    switch (idx) {
    case 0: j = MatJob{a.in[I_FFN_WIN] + (size_t)0 * D * 2 * FF, D, 2 * FF, ng + 0 * D, (bf16*)(ws + WS_WIN0), CM_FFN}; break;
    case 1: j = MatJob{a.in[I_FFN_WOUT] + (size_t)0 * FF * D, FF, D, nullptr, (bf16*)(ws + WS_WOUT0), CM_NONE}; break;
    case 2: j = MatJob{a.in[I_RNN_WIN], D, 2 * DRNN, ng + 1 * D, (bf16*)(ws + WS_WRIN), CM_NONE}; break;
    case 3: j = MatJob{a.in[I_RNN_WOUT], DRNN, D, nullptr, (bf16*)(ws + WS_WROUT), CM_NONE}; break;
    case 4: j = MatJob{a.in[I_FFN_WIN] + (size_t)1 * D * 2 * FF, D, 2 * FF, ng + 2 * D, (bf16*)(ws + WS_WIN1), CM_FFN}; break;
    case 5: j = MatJob{a.in[I_FFN_WOUT] + (size_t)1 * FF * D, FF, D, nullptr, (bf16*)(ws + WS_WOUT1), CM_NONE}; break;
    case 6: j = MatJob{a.in[I_WO], D, D, nullptr, (bf16*)(ws + WS_WO), CM_NONE}; break;
    case 7: j = MatJob{a.in[I_WQKV], D, NQKV, ng + 4 * D, (bf16*)(ws + WS_WQKV), CM_QKV}; break;
    case 8: j = MatJob{a.in[I_FFN_WIN] + (size_t)2 * D * 2 * FF, D, 2 * FF, ng + 3 * D, (bf16*)(ws + WS_WIN2), CM_FFN}; break;
    case 9: j = MatJob{a.in[I_FFN_WOUT] + (size_t)2 * FF * D, FF, D, nullptr, (bf16*)(ws + WS_WOUT2), CM_NONE}; break;
    case 10: j = MatJob{a.in[I_FFN_WIN] + (size_t)3 * D * 2 * FF, D, 2 * FF, ng + 5 * D, (bf16*)a.out, CM_FFN}; break;
    default: j = MatJob{a.in[I_FFN_WOUT] + (size_t)3 * FF * D, FF, D, nullptr, (bf16*)(ws + WS_WOUT3), CM_NONE}; break;
    }
    return j;
}
__device__ __forceinline__ void convert_mats(const Ctx& C, const Args& a, int first, int last, int gw, int NGW) {
    LAS unsigned char* scr = C.lds + C.wave * 8192;
    int base = 0;
    for (int mi = first; mi < last; ++mi) {
        const MatJob j = mat_job(C, a, mi); const int cnt = (j.K / 64) * (j.N / 64);
        int it = (gw - base) % NGW; if (it < 0) it += NGW;
        for (; it < cnt; it += NGW) transpose_item(j.W, j.K, j.N, j.g, j.WT, j.mode, scr, it, C.lane);
        base += cnt;
    }
}
__device__ __forceinline__ void spare_convert(const Ctx& C, const Args& a, int first, int last, int nwg) {
    const int R = (nwg + C.G - 1) / C.G, first_spare = nwg - (R - 1) * C.G, nspare = C.G - first_spare, c = (int)blockIdx.x;
    if (nspare > 0) { if (c >= first_spare) convert_mats(C, a, first, last, (c - first_spare) * NWAVES + C.wave, nspare * NWAVES); }
    else convert_mats(C, a, first, last, c * NWAVES + C.wave, C.G * NWAVES);
    __syncthreads();
}
__device__ __forceinline__ int t5_bucket(int n) {
    if (n < 16) return n;
    int b = 16;
    b += (n >= 22) + (n >= 30) + (n >= 40) + (n >= 54) + (n >= 73) + (n >= 99) + (n >= 134) + (n >= 182) + (n >= 246) + (n >= 332) + (n >= 450) + (n >= 609) + (n >= 825) + (n >= 1117) + (n >= 1513);
    return b;
}
__device__ __forceinline__ void p_prologue(const Ctx& C, const Args& a) {
    const int gw = C.vcu * NWAVES + C.wave, NGW = C.G * NWAVES;
    convert_mats(C, a, 0, 1, gw, NGW);
    {   LAS unsigned char* scr = C.lds + C.wave * 8192;
        for (int it = gw; it < 2 * NBLK * 4; it += NGW) { const int which = it / (NBLK * 4), r = it % (NBLK * 4), blk = r >> 2, sub = r & 3;
            const float* W = (which ? a.in[I_WX] : a.in[I_WA]) + (size_t)blk * RBLK * RBLK; bf16* WT = (bf16*)(C.ws + (which ? WS_WX : WS_WA)) + (size_t)blk * RBLK * RBLK;
            transpose_item(W, RBLK, RBLK, nullptr, WT, CM_NONE, scr, sub, C.lane); } }
    const float* x = a.in[I_X]; bf16* xb = (bf16*)(C.ws + WS_XB); float* ssq = (float*)(C.ws + WS_SSQ);
    for (int m = gw; m < M; m += NGW) {
        const GAS f32x4* xr = (const GAS f32x4*)(x + (size_t)m * D) + C.lane; f32x4 v[4]; float s = 0.f;
#pragma unroll
        for (int j = 0; j < 4; ++j) { v[j] = __builtin_nontemporal_load(xr + 64 * j); s += (v[j].x * v[j].x + v[j].y * v[j].y) + (v[j].z * v[j].z + v[j].w * v[j].w); }
        s = wave_sum(s);
        GAS v2u* o8 = (GAS v2u*)(xb + (size_t)m * D) + C.lane;
#pragma unroll
        for (int j = 0; j < 4; ++j) { v2u w; w.x = pk2(v[j].x, v[j].y); w.y = pk2(v[j].z, v[j].w); o8[64 * j] = w; }
        if (C.lane < 16) ssq[(size_t)m * 16 + C.lane] = (C.lane == 0) ? s : 0.f;
    }
    float* bt = (float*)(C.ws + WS_BIAS); const float* rb = a.in[I_RELB];
    for (int i = blockIdx.x * 512 + C.tid; i < 48 * 129; i += C.G * 512) { const int gh = i / 129, dist = i - gh * 129, g = gh >> 4;
        bt[gh * 132 + dist] = rb[t5_bucket(dist << (2 * g)) * 48 + gh] * LOG2E; }
}

typedef float f32x16 __attribute__((ext_vector_type(16)));
typedef short bf16x8v __attribute__((ext_vector_type(8)));
constexpr int RM_WB = 0, RM_WB_GATE = 64 * 272, RM_CW = 36864, RM_CMP = RM_CW + 2560, RM_TILE = 49152, RM_TILE_BYTES = 36 * 256, RM_END = RM_TILE + 8 * RM_TILE_BYTES;
static_assert(RM_WB + 2 * RM_WB_GATE <= RM_CW && RM_CMP + 2 * 2 * 8 * 64 * 4 <= RM_TILE && RM_END <= RING_BYTES, "rnn-mid LDS map");
__device__ __forceinline__ bf16x8v pack8(const float (&v)[8]) {
    v4u w; w.x = pg8::cvt_pk_bf16(v[0], v[1]); w.y = pg8::cvt_pk_bf16(v[2], v[3]); w.z = pg8::cvt_pk_bf16(v[4], v[5]); w.w = pg8::cvt_pk_bf16(v[6], v[7]);
    return __builtin_bit_cast(bf16x8v, w);
}
__device__ __forceinline__ void p_rnn_mid(const Ctx& C, const Args& a) {
    const bf16* U = (const bf16*)(C.ws + WS_U); const bf16* Gb = (const bf16*)(C.ws + WS_G); bf16* Y = (bf16*)(C.ws + WS_Y);
    const bf16* WAb = (const bf16*)(C.ws + WS_WA); const bf16* WXb = (const bf16*)(C.ws + WS_WX);
    LAS unsigned char* L = C.lds;
    LAS float* CW = (LAS float*)(L + RM_CW); LAS float* CMP = (LAS float*)(L + RM_CMP);
    const int wave = C.wave;
    LAS unsigned char* wt = L + RM_TILE + wave * RM_TILE_BYTES;
    for (int item = blockIdx.x; item < BATCH * NBLK * 2; item += C.G) {
        const int b = item / (NBLK * 2), n = (item % (NBLK * 2)) >> 1, half = item & 1;
        int tid = C.tid; asm volatile("" : "+v"(tid));
        const int lane = tid & 63, r32 = lane & 31, hh = lane >> 5;
        __syncthreads();
#pragma unroll
        for (int p = 0; p < 4; ++p) { const int idx = p * 512 + tid, gate = idx >> 10, rem = idx & 1023, row = rem >> 4, c16 = rem & 15;
            const v4u w = *(const v4u*)((gate ? WXb : WAb) + (size_t)(n * 128 + 64 * half + row) * 128 + c16 * 8);
            *(LAS v4u*)(L + RM_WB + gate * RM_WB_GATE + row * 272 + c16 * 16) = w; }
        CW[tid] = a.in[I_CONV_W][(tid >> 7) * DRNN + n * 128 + (tid & 127)];
        if (tid < 128) CW[512 + tid] = a.in[I_CONV_B][n * 128 + tid];
        __syncthreads();
        float ba[2], bx[2], spl[2], Ht[2];
#pragma unroll
        for (int cb = 0; cb < 2; ++cb) { const int ch = n * 128 + 64 * half + 32 * cb + r32; ba[cb] = a.in[I_BA][ch]; bx[cb] = a.in[I_BX][ch];
            spl[cb] = -8.0f * LOG2E * log1pf(expf(-a.in[I_LAM][ch])); Ht[cb] = 0.f; }
        bf16x8v idf[2];
#pragma unroll
        for (int sp = 0; sp < 2; ++sp)
#pragma unroll
            for (int j = 0; j < 8; ++j) idf[sp][j] = (16 * sp + 8 * hh + j == r32) ? (short)0x3F80 : (short)0;
        const int urow = lane >> 4, uch = lane & 15, grow = lane >> 3, gch = lane & 7;
        v4u uraw[9], graw[4];
#define RM_LOADU(TILE) do { const int tp_ = (TILE) * 256 + wave * 32; const int ub_ = (b * SEQ + tp_ - 3 + urow) * DRNN + n * 128 + uch * 8;        \
        _Pragma("unroll") for (int i_ = 0; i_ < 9; ++i_) uraw[i_] = *(const v4u*)(U + (ptrdiff_t)(ub_ + i_ * 4 * DRNN)); \
        if (tp_ == 0 && urow < 3) uraw[0] = (v4u){0u, 0u, 0u, 0u};         } while (0)
#define RM_LOADG(TILE) do { const int gb_ = (b * SEQ + (TILE) * 256 + wave * 32 + grow) * DRNN + n * 128 + 64 * half + gch * 8; \
        _Pragma("unroll") for (int i_ = 0; i_ < 4; ++i_) graw[i_] = *(const v4u*)(Gb + (unsigned)(gb_ + i_ * 8 * DRNN)); } while (0)
        RM_LOADU(0);
        for (int tile = 0; tile < 8; ++tile) {
            const int tposw = tile * 256 + wave * 32;
            const size_t tok0 = (size_t)b * SEQ + tposw;
            LAS float* CWt = CW; LAS unsigned char* WBt = L + RM_WB; asm volatile("" : "+v"(CWt), "+v"(WBt));
            RM_LOADG(tile);
#pragma unroll
            for (int i = 0; i < 9; ++i) { const int rl = 4 * i + urow; *(LAS v4u*)(wt + rl * 256 + ((uch ^ (rl & 15)) << 4)) = uraw[i]; }
            {
                const int tg = lane >> 4, cc = lane & 15;
                f32x2 wv[4][4], bv2[4];
#pragma unroll
                for (int k = 0; k < 4; ++k) { const f32x4 w0 = *(const LAS f32x4*)(CWt + k * 128 + 8 * cc), w1 = *(const LAS f32x4*)(CWt + k * 128 + 8 * cc + 4);
                    wv[k][0] = (f32x2){w0[0], w0[1]}; wv[k][1] = (f32x2){w0[2], w0[3]}; wv[k][2] = (f32x2){w1[0], w1[1]}; wv[k][3] = (f32x2){w1[2], w1[3]}; }
                { const f32x4 b0 = *(const LAS f32x4*)(CWt + 512 + 8 * cc), b1 = *(const LAS f32x4*)(CWt + 512 + 8 * cc + 4);
                  bv2[0] = (f32x2){b0[0], b0[1]}; bv2[1] = (f32x2){b0[2], b0[3]}; bv2[2] = (f32x2){b1[0], b1[1]}; bv2[3] = (f32x2){b1[2], b1[3]}; }
                v4u ur[11];
#pragma unroll
                for (int j = 0; j < 11; ++j) { const int rl = 8 * tg + j; ur[j] = *(const LAS v4u*)(wt + rl * 256 + ((cc ^ (rl & 15)) << 4)); }
                f32x2 o[8][4];
#pragma unroll
                for (int i = 0; i < 8; ++i)
#pragma unroll
                    for (int e = 0; e < 4; ++e) o[i][e] = bv2[e];
#pragma unroll
                for (int j = 0; j < 11; ++j) {
                    const f32x2 u0 = (f32x2){bf_lo(ur[j].x), bf_hi(ur[j].x)}, u1 = (f32x2){bf_lo(ur[j].y), bf_hi(ur[j].y)}, u2 = (f32x2){bf_lo(ur[j].z), bf_hi(ur[j].z)}, u3 = (f32x2){bf_lo(ur[j].w), bf_hi(ur[j].w)};
#pragma unroll
                    for (int k = 0; k < 4; ++k) { const int i = j - k; if (i >= 0 && i < 8) {
                        o[i][0] += wv[k][0] * u0; o[i][1] += wv[k][1] * u1; o[i][2] += wv[k][2] * u2; o[i][3] += wv[k][3] * u3; } }
                }
#pragma unroll
                for (int i = 0; i < 8; ++i) { const int rl = 8 * tg + i;
                    v4u w; w.x = pg8::cvt_pk_bf16(o[i][0].x, o[i][0].y); w.y = pg8::cvt_pk_bf16(o[i][1].x, o[i][1].y); w.z = pg8::cvt_pk_bf16(o[i][2].x, o[i][2].y); w.w = pg8::cvt_pk_bf16(o[i][3].x, o[i][3].y);
                    *(LAS v4u*)(wt + rl * 256 + ((cc ^ (rl & 15)) << 4)) = w; }
            }
            bf16x8v af[8];
#pragma unroll
            for (int s = 0; s < 8; ++s) af[s] = *(const LAS bf16x8v*)(wt + r32 * 256 + (((2 * s + hh) ^ (r32 & 15)) << 4));
#pragma unroll
            for (int i = 0; i < 4; ++i) *(LAS v4u*)(wt + (8 * i + grow) * 128 + gch * 16) = graw[i];
            f32x16 acc[2][2], ufa[2];
#pragma unroll
            for (int cb = 0; cb < 2; ++cb)
#pragma unroll
                for (int e = 0; e < 16; ++e) { acc[0][cb][e] = 0.f; acc[1][cb][e] = 0.f; ufa[cb][e] = 0.f; }
            bf16x8v bq[2][4];
#define RM_LDB(S, DST) do { _Pragma("unroll") for (int g_ = 0; g_ < 2; ++g_) _Pragma("unroll") for (int c_ = 0; c_ < 2; ++c_) \
                DST[g_ * 2 + c_] = *(const LAS bf16x8v*)(WBt + g_ * RM_WB_GATE + (32 * c_ + r32) * 272 + (16 * (S) + 8 * hh) * 2); } while (0)
            RM_LDB(0, bq[0]);
#pragma unroll
            for (int s = 0; s < 8; ++s) {
                if (s < 7) RM_LDB(s + 1, bq[(s + 1) & 1]);
#pragma unroll
                for (int gt = 0; gt < 2; ++gt)
#pragma unroll
                    for (int cb = 0; cb < 2; ++cb) acc[gt][cb] = __builtin_amdgcn_mfma_f32_32x32x16_bf16(af[s], bq[s & 1][gt * 2 + cb], acc[gt][cb], 0, 0, 0);
            }
#undef RM_LDB
#pragma unroll
            for (int cb = 0; cb < 2; ++cb)
#pragma unroll
                for (int sp = 0; sp < 2; ++sp) { const bf16x8v asel = half ? af[4 + 2 * cb + sp] : af[2 * cb + sp];
                    ufa[cb] = __builtin_amdgcn_mfma_f32_32x32x16_bf16(asel, idf[sp], ufa[cb], 0, 0, 0); }
            const float nba[2] = {-LOG2E * ba[0], -LOG2E * ba[1]}, nbx[2] = {-LOG2E * bx[0], -LOG2E * bx[1]};
#pragma unroll
            for (int cb = 0; cb < 2; ++cb)
#pragma unroll
                for (int e = 0; e < 16; ++e) {
                    const float uf = ufa[cb][e];
                    const float r = __builtin_amdgcn_rcpf(1.f + __builtin_amdgcn_exp2f(__builtin_fmaf(acc[0][cb][e], -LOG2E, nba[cb]))), ii = __builtin_amdgcn_rcpf(1.f + __builtin_amdgcn_exp2f(__builtin_fmaf(acc[1][cb][e], -LOG2E, nbx[cb])));
                    const float av = __builtin_amdgcn_exp2f(r * spl[cb]);
                    const float bv = __builtin_amdgcn_sqrtf(fmaxf(1.f - av * av, 0.f)) * (ii * uf);
                    acc[0][cb][e] = av; acc[1][cb][e] = bv;
                }
            float A0[2][4], B0[2][4], A1[2][4], B1[2][4];
            const int par = tile & 1;
#pragma unroll
            for (int cb = 0; cb < 2; ++cb) {
                float Aw = 1.f, Bw = 0.f;
#pragma unroll
                for (int q = 0; q < 4; ++q) {
                    const float a0 = acc[0][cb][4 * q], a1 = acc[0][cb][4 * q + 1], a2 = acc[0][cb][4 * q + 2], a3 = acc[0][cb][4 * q + 3];
                    const float Ag = (a0 * a1) * (a2 * a3);
                    const float Bg = ((acc[1][cb][4 * q] * a1 + acc[1][cb][4 * q + 1]) * a2 + acc[1][cb][4 * q + 2]) * a3 + acc[1][cb][4 * q + 3];
                    const float pA = __shfl_xor(Ag, 32), pB = __shfl_xor(Bg, 32);
                    A0[cb][q] = hh ? pA : Ag; B0[cb][q] = hh ? pB : Bg; A1[cb][q] = hh ? Ag : pA; B1[cb][q] = hh ? Bg : pB;
                    Bw = Bw * A0[cb][q] + B0[cb][q]; Aw *= A0[cb][q]; Bw = Bw * A1[cb][q] + B1[cb][q]; Aw *= A1[cb][q];
                }
                if (hh == 0) { CMP[((par * 2 + 0) * 8 + wave) * 64 + 32 * cb + r32] = Aw; CMP[((par * 2 + 1) * 8 + wave) * 64 + 32 * cb + r32] = Bw; }
            }
            __syncthreads();
            if (tile < 7) RM_LOADU(tile + 1);
#pragma unroll
            for (int cb = 0; cb < 2; ++cb) {
                float h = Ht[cb], hin = 0.f;
#pragma unroll
                for (int v = 0; v < 8; ++v) { const float Av = CMP[((par * 2 + 0) * 8 + v) * 64 + 32 * cb + r32], Bv = CMP[((par * 2 + 1) * 8 + v) * 64 + 32 * cb + r32];
                    hin = (v == wave) ? h : hin; h = Av * h + Bv; }
                Ht[cb] = h;
                float hc = hin;
#pragma unroll
                for (int q = 0; q < 4; ++q) {
                    const float c0 = hc; hc = A0[cb][q] * hc + B0[cb][q]; const float c1 = hc; hc = A1[cb][q] * hc + B1[cb][q];
                    float hv = hh ? c1 : c0;
#pragma unroll
                    for (int i = 0; i < 4; ++i) { const int e = 4 * q + i; hv = acc[0][cb][e] * hv + acc[1][cb][e];
                        const int tl = (e & 3) + 8 * (e >> 2) + 4 * hh;
                        LAS bf16* gp = (LAS bf16*)(wt + tl * 128 + (32 * cb + r32) * 2);
                        *gp = (bf16)f2bf(hv * bf2f(*gp)); }
                }
            }
#pragma unroll
            for (int i = 0; i < 4; ++i) { const v4u w = *(const LAS v4u*)(wt + (8 * i + grow) * 128 + gch * 16);
                *(v4u*)(Y + (unsigned)(((int)tok0 + 8 * i + grow) * DRNN + n * 128 + 64 * half + gch * 8)) = w; }
        }
#undef RM_LOADU
#undef RM_LOADG
    }
    const int nitems = BATCH * NBLK * 2;
    if (C.G > nitems) { if ((int)blockIdx.x >= nitems) convert_mats(C, a, 4, 7, ((int)blockIdx.x - nitems) * NWAVES + wave, (C.G - nitems) * NWAVES); }
    else { __syncthreads(); convert_mats(C, a, 4, 7, (int)blockIdx.x * NWAVES + wave, C.G * NWAVES); }
}
struct AttnUnit { const bf16* qrows; const bf16* kres; const bf16* vres; int l0, kb_lo, eoff; };
__device__ __forceinline__ AttnUnit attn_unit(const bf16* QKV, int g, int bh, int llin0, bool dbl) {
    AttnUnit u; const size_t SLAB = (size_t)M * 1024; const int L = SEQ >> (2 * g);
    u.l0 = llin0 & (L - 1); { const int lo_ = u.l0 - (dbl ? 160 : 128); u.kb_lo = lo_ > 0 ? lo_ : 0; } u.eoff = g * 192;
    u.qrows = QKV + (size_t)g * SLAB + ((size_t)bh * SEQ + llin0) * HD;
    u.kres = u.qrows + 3 * SLAB - (size_t)u.l0 * HD; u.vres = u.qrows + 6 * SLAB - (size_t)u.l0 * HD;
    return u;
}
typedef __bf16 bf16x2n __attribute__((ext_vector_type(2)));
__device__ __forceinline__ unsigned cvtpk_n(float lo, float hi) { const f32x2 v = {lo, hi}; return __builtin_bit_cast(unsigned, __builtin_convertvector(v, bf16x2n)); }
__device__ __forceinline__ float xhalf_max(float x) { float a = x, b = x; asm("s_nop 1\n\tv_permlane32_swap_b32 %0, %1\n\tv_max_f32 %0, %0, %1" : "+v"(a), "+v"(b)); return a; }
__device__ __forceinline__ float xhalf_sum(float x) { float a = x, b = x; asm("s_nop 1\n\tv_permlane32_swap_b32 %0, %1\n\tv_add_f32 %0, %0, %1" : "+v"(a), "+v"(b)); return a; }
constexpr int AT_VT = 0, AT_EXT = 8 * 8192, AT_LACC = AT_EXT + 4 * 592 * 4, AT_OACC = AT_LACC + 2048;
static_assert(AT_LACC + 512 * 4 <= AT_OACC && AT_OACC + 512 * 128 <= MISC_OFF, "attention LDS map");
#define AT_QBLOCK(QF, O0, O1, MROW, LSUM, EB) do { \
        const LAS f32x4* bp_ = (const LAS f32x4*)(ext + (EB)); \
        const f32x4 bq_[4] = {bp_[0], bp_[-2], bp_[-4], bp_[-6]};               \
        f32x16 p_; _Pragma("unroll") for (int e = 0; e < 16; ++e) p_[e] = 0.f; \
        _Pragma("unroll") for (int s_ = 0; s_ < 4; ++s_) p_ = __builtin_amdgcn_mfma_f32_32x32x16_bf16(kf[s_], QF[s_], p_, 0, 0, 0); \
        float bm_ = -1e30f; \
        _Pragma("unroll") for (int e = 0; e < 16; ++e) { p_[e] += bq_[e >> 2][3 - (e & 3)]; bm_ = fmaxf(bm_, p_[e]); } \
        bm_ = xhalf_max(bm_); \
        const float mn_ = fmaxf(MROW, bm_), alpha_ = __builtin_amdgcn_exp2f(MROW - mn_); MROW = mn_; \
        float ps_ = 0.f; \
        _Pragma("unroll") for (int e = 0; e < 16; ++e) { p_[e] = __builtin_amdgcn_exp2f(p_[e] - mn_); ps_ += p_[e]; } \
        LSUM = LSUM * alpha_ + ps_; \
        _Pragma("unroll") for (int e = 0; e < 16; ++e) { O0[e] *= alpha_; O1[e] *= alpha_; } \
        _Pragma("unroll") for (int s_ = 0; s_ < 2; ++s_) { \
            v4u w_; w_.x = cvtpk_n(p_[8 * s_], p_[8 * s_ + 1]); w_.y = cvtpk_n(p_[8 * s_ + 2], p_[8 * s_ + 3]); w_.z = cvtpk_n(p_[8 * s_ + 4], p_[8 * s_ + 5]); w_.w = cvtpk_n(p_[8 * s_ + 6], p_[8 * s_ + 7]); \
            const bf16x8v pf_ = __builtin_bit_cast(bf16x8v, w_); \
            const v4i16_t a00_ = vtr16(vt + (16 * s_) * 64 + vtr_off), a01_ = vtr16(vt + (16 * s_ + 8) * 64 + vtr_off), a10_ = vtr16(vt + 2048 + (16 * s_) * 64 + vtr_off), a11_ = vtr16(vt + 2048 + (16 * s_ + 8) * 64 + vtr_off); \
            O0 = __builtin_amdgcn_mfma_f32_32x32x16_bf16((bf16x8v){a00_[0], a00_[1], a00_[2], a00_[3], a01_[0], a01_[1], a01_[2], a01_[3]}, pf_, O0, 0, 0, 0); \
            O1 = __builtin_amdgcn_mfma_f32_32x32x16_bf16((bf16x8v){a10_[0], a10_[1], a10_[2], a10_[3], a11_[0], a11_[1], a11_[2], a11_[3]}, pf_, O1, 0, 0, 0); } \
    } while (0)
#define AT_COMBINE(MODE, O0, O1, MROW, LSUM, TL) do { \
        const float ltot_ = xhalf_sum(LSUM), inv_ = 1.f / ltot_, lse_ = MROW + log2f(ltot_); const int tl_ = (TL); \
        LAS unsigned char* orow_ = C.lds + AT_OACC + tl_ * 128; LAS float* lacc_ = (LAS float*)(C.lds + AT_LACC); \
        float wo_ = 0.f, wn_ = inv_; \
        if (MODE != 0) { const float lo_ = lacc_[tl_], mx_ = fmaxf(lo_, lse_), eo_ = __builtin_amdgcn_exp2f(lo_ - mx_), en_ = __builtin_amdgcn_exp2f(lse_ - mx_), rs_ = 1.f / (eo_ + en_); \
            wo_ = eo_ * rs_; wn_ = en_ * rs_ * inv_; if (MODE == 1 && hh == 0) lacc_[tl_] = mx_ + log2f(eo_ + en_); } \
        else if (hh == 0) lacc_[tl_] = lse_; \
        _Pragma("unroll") for (int q = 0; q < 4; ++q) { \
            LAS v2u* p0_ = (LAS v2u*)(orow_ + ((q ^ (tl_ & 7)) << 4) + 8 * hh); LAS v2u* p1_ = (LAS v2u*)(orow_ + (((4 + q) ^ (tl_ & 7)) << 4) + 8 * hh); \
            float a_[8] = {O0[4 * q] * wn_, O0[4 * q + 1] * wn_, O0[4 * q + 2] * wn_, O0[4 * q + 3] * wn_, O1[4 * q] * wn_, O1[4 * q + 1] * wn_, O1[4 * q + 2] * wn_, O1[4 * q + 3] * wn_}; \
            if (MODE != 0) { const v2u c0_ = *p0_, c1_ = *p1_; \
                a_[0] += wo_ * bf_lo(c0_.x); a_[1] += wo_ * bf_hi(c0_.x); a_[2] += wo_ * bf_lo(c0_.y); a_[3] += wo_ * bf_hi(c0_.y); \
                a_[4] += wo_ * bf_lo(c1_.x); a_[5] += wo_ * bf_hi(c1_.x); a_[6] += wo_ * bf_lo(c1_.y); a_[7] += wo_ * bf_hi(c1_.y); } \
            v2u w0_, w1_; w0_.x = cvtpk_n(a_[0], a_[1]); w0_.y = cvtpk_n(a_[2], a_[3]); w1_.x = cvtpk_n(a_[4], a_[5]); w1_.y = cvtpk_n(a_[6], a_[7]); \
            if (MODE != 2) { *p0_ = w0_; *p1_ = w1_; } \
            else { bf16* g_ = ATT + (size_t)(row0 + tl_) * 1024 + h * 64 + 8 * q + 4 * hh; *(v2u*)g_ = w0_; *(v2u*)(g_ + 32) = w1_; } } \
    } while (0)
__device__ __forceinline__ void p_attn(const Ctx& C, bf16* ATT) {
    const bf16* QKV = (const bf16*)(C.ws + WS_QKV); const float* bt = (const float*)(C.ws + WS_BIAS);
    LAS float* ext = (LAS float*)(C.lds + AT_EXT);
    LAS unsigned char* vt = C.lds + AT_VT + C.wave * 8192; LAS unsigned char* kt = vt + 4096;
    const int wave = C.wave;
    v4u kfn[4], vvn[4];
#define AT_LOADKV(U, KB) do { const bf16* kblk_ = (U).kres + (size_t)(KB) * HD; const bf16* vblk_ = (U).vres + (size_t)(KB) * HD; \
        _Pragma("unroll") for (int i_ = 0; i_ < 4; ++i_) { vvn[i_] = *(const v4u*)(vblk_ + (8 * i_ + crow8) * HD + cch * 8); kfn[i_] = *(const v4u*)(kblk_ + (8 * i_ + crow8) * HD + cch * 8); } } while (0)
#define AT_TILE2FRAG(RAW, OFS, FR) do { _Pragma("unroll") for (int i_ = 0; i_ < 4; ++i_) *(LAS v4u*)(kt + (8 * i_ + crow8) * 128 + ((cch ^ crow8) << 4)) = RAW[(OFS) + i_]; \
        _Pragma("unroll") for (int s_ = 0; s_ < 4; ++s_) FR[s_] = *(const LAS bf16x8v*)(kt + r32 * 128 + (((2 * s_ + hh) ^ (r32 & 7)) << 4)); } while (0)
#define AT_LOADQFRAG(U, ROW0, FR) do { v4u q_[4]; _Pragma("unroll") for (int i_ = 0; i_ < 4; ++i_) q_[i_] = *(const v4u*)((U).qrows + ((ROW0) + 8 * i_ + crow8) * HD + cch * 8); AT_TILE2FRAG(q_, 0, FR); } while (0)
#define AT_STEP(KB) do { const int kb_ = (KB); \
            bf16x8v kf[4]; \
            __builtin_amdgcn_s_setprio(3);                                     \
            if (dbl && kb_ == cu.l0 - 32) AT_TILE2FRAG(qraw, 0, qfY);            \
            _Pragma("unroll") for (int i = 0; i < 4; ++i) *(LAS v4u*)(vt + (cch >> 2) * 2048 + (8 * i + crow8) * 64 + (cch & 3) * 16) = vvn[i]; \
            AT_TILE2FRAG(kfn, 0, kf); \
            {   const bool instep_ = (kb_ - 32 >= cu.kb_lo);                     \
                const bf16* kblk_ = instep_ ? cu.kres + (size_t)(kb_ - 32) * HD : nu.kres + (size_t)nu.l0 * HD; const bf16* vblk_ = instep_ ? cu.vres + (size_t)(kb_ - 32) * HD : nu.vres + (size_t)nu.l0 * HD; \
                _Pragma("unroll") for (int i_ = 0; i_ < 4; ++i_) { vvn[i_] = *(const v4u*)(vblk_ + (8 * i_ + crow8) * HD + cch * 8); kfn[i_] = *(const v4u*)(kblk_ + (8 * i_ + crow8) * HD + cch * 8); } \
                if (!instep_) AT_LOADQ(nu, 0); else if (dbl && kb_ == cu.l0) AT_LOADQ(cu, -32); } \
            __builtin_amdgcn_s_setprio(0); \
            const int ebX = cu.eoff + cu.l0 + r32 - kb_ - 4 * hh + 32 - 3 + 591 * ((r32 + 1) & 3);     \
            if (kb_ >= cu.l0 - 128) { AT_QBLOCK(qfX, oX0, oX1, mX, lX, ebX); } \
            if (dbl && kb_ < cu.l0) { AT_QBLOCK(qfY, oY0, oY1, mY, lY, ebX - 32); } \
        } while (0)
#define AT_ZERO(O0, O1, MR, LS) do { _Pragma("unroll") for (int e = 0; e < 16; ++e) { O0[e] = 0.f; O1[e] = 0.f; } MR = -1e30f; LS = 0.f; } while (0)
#define AT_DESC(V, STEP, U) do { const int v_ = (V), st_ = (STEP), bh_ = (v_ >> 1) & 127, sx_ = ((v_ & 1) << 1) | (v_ >> 8), s_ = (sx_ == 0) ? 0 : (sx_ == 1) ? 3 : (sx_ == 2) ? 1 : 2, g_ = st_ < 2 ? st_ : 2, j_ = st_ < 2 ? 1 : st_ - 2; \
        const int ll_ = (g_ == 0) ? 512 * s_ + 64 * wave + 32 * j_ : (g_ == 1) ? (wave >> 1) * 512 + 128 * s_ + 64 * (wave & 1) + 32 * j_ : (2 * wave + j_) * 128 + 32 * s_; \
        U = attn_unit(QKV, g_, bh_, ll_, st_ < 2); } while (0)
#define AT_LOADQ(U, R0) do { _Pragma("unroll") for (int i_ = 0; i_ < 4; ++i_) qraw[i_] = *(const v4u*)((U).qrows + ((R0) + 8 * i_ + crow8) * HD + cch * 8); } while (0)
    const int total = BATCH * NHEAD * 4;
    if (C.vcu >= total) return;
    AttnUnit nu; v4u qraw[4];
    {   const int lane = C.lane, crow8 = lane >> 3, cch = lane & 7;
        AT_DESC(C.vcu, 0, nu); AT_LOADKV(nu, nu.l0); AT_LOADQ(nu, 0); }
    for (int v = C.vcu; v < total; v += C.G) {
        int tid = C.tid; asm volatile("" : "+v"(tid));
        const int lane = tid & 63, r32 = lane & 31, hh = lane >> 5;
        const int crow8 = lane >> 3, cch = lane & 7;
        const int vtr_off = (4 * hh + ((lane & 15) >> 2)) * 64 + ((lane >> 4) & 1) * 32 + (lane & 3) * 8;
        const int bh = (v >> 1) & 127, sidx = ((v & 1) << 1) | (v >> 8), s = (sidx == 0) ? 0 : (sidx == 1) ? 3 : (sidx == 2) ? 1 : 2, h = bh & 15;
        const int row0 = (bh >> 4) * SEQ + 512 * s;
        __syncthreads();
        for (int i = tid; i < 4 * 576; i += 512) { const int c = i / 576, rem = i - c * 576, g = rem / 192, dist = rem - g * 192 + c - 32; ext[i + 16 * c] = (dist >= 0 && dist <= 128) ? bt[(g * 16 + h) * 132 + dist] : -1e30f; }
        __syncthreads();
        f32x16 oX0, oX1, oY0, oY1; float mX, lX, mY, lY; bf16x8v qfX[4], qfY[4];
#pragma unroll 1
        for (int step = 0; step < 4; ++step) {
            const int g = step < 2 ? step : 2, jx = step < 2 ? 1 : step - 2; const bool dbl = step < 2;
            const AttnUnit cu = nu;
            const bool has_next = (step < 3) || (v + C.G < total);
            if (has_next) { if (step < 3) AT_DESC(v, step + 1, nu); else AT_DESC(v + C.G, 0, nu); }
            AT_TILE2FRAG(qraw, 0, qfX);
            AT_ZERO(oX0, oX1, mX, lX); AT_ZERO(oY0, oY1, mY, lY);
            for (int kb = cu.l0; kb >= cu.kb_lo; kb -= 32) AT_STEP(kb);
            int t32 = tid & 31; asm volatile("" : "+v"(t32));
            const int tlX = (g == 0) ? 64 * wave + 32 * jx + t32 : (g == 1) ? 256 * (wave & 1) + (wave >> 1) + 4 * (32 * jx + t32) : 16 * t32 + 2 * wave + jx;
            const int tlY = (g == 0) ? tlX - 32 : tlX - 128;
            AT_COMBINE(g, oX0, oX1, mX, lX, tlX);
            if (dbl) { AT_COMBINE(g, oY0, oY1, mY, lY, tlY); __syncthreads(); }
        }
    }
#undef AT_DESC
#undef AT_LOADQ
#undef AT_LOADKV
#undef AT_TILE2FRAG
#undef AT_LOADQFRAG
#undef AT_STEP
#undef AT_ZERO
}
#undef AT_QBLOCK
#undef AT_COMBINE
enum { PH_PROLOGUE = 0, PH_FFN_IN_0, PH_FFN_OUT_0, PH_RNN_IN, PH_RNN_MID, PH_RNN_OUT, PH_FFN_IN_1, PH_FFN_OUT_1,
       PH_FFN_IN_2, PH_FFN_OUT_2, PH_QKV, PH_ATTN, PH_WO, PH_FFN_IN_3, PH_FFN_OUT_3, NPHASE };

__global__ void __launch_bounds__(NWAVES * 64, 2) fwd_kernel(Args args) {
    extern __shared__ __attribute__((aligned(16))) unsigned char lds_raw[];
    Ctx C; C.lds = (LAS unsigned char*)lds_raw; C.wave = __builtin_amdgcn_readfirstlane((int)threadIdx.x >> 6); C.lane = pg8::fresh_lane(); C.tid = C.wave * 64 + C.lane;
    C.G = gridDim.x; { const int bx = blockIdx.x; C.vcu = (C.G % 8 == 0) ? (bx % 8) * (C.G / 8) + bx / 8 : bx; }
    C.ws = args.ws;
    volatile LAS unsigned* MISC = (volatile LAS unsigned*)(C.lds + MISC_OFF);
    if (C.tid < 32) ((LAS unsigned*)(C.lds + MISC_OFF))[C.tid] = 0u;
    __syncthreads();
    unsigned* ctl = (unsigned*)args.ws;
    XcdBarrier bar; bar.bar = ctl + CW_BAR; bar.x = 0; bar.st = nullptr;
    const bool multi = (args.ph_hi - args.ph_lo) > 1;
    if (multi) bar = xcd_barrier_post(ctl + CW_BAR, MISC + 8, C.tid);
    for (int ph = args.ph_lo; ph < args.ph_hi; ++ph) {
        {
        { const int l_ = pg8::fresh_lane(); C.lane = l_; C.tid = C.wave * 64 + l_; }
        unsigned char* ws = args.ws;
        C.ws = ws; float* ssq = (float*)(ws + WS_SSQ); bf16* xb = (bf16*)(ws + WS_XB);
        switch (ph) {
        case PH_PROLOGUE: p_prologue(C, args); break;
        case PH_FFN_IN_0: case PH_FFN_IN_1: case PH_FFN_IN_2: case PH_FFN_IN_3: {
            if (ph != PH_FFN_IN_3) { const int f = (ph == PH_FFN_IN_0) ? 1 : (ph == PH_FFN_IN_1) ? 8 : 10, l = (ph == PH_FFN_IN_0) ? 4 : (ph == PH_FFN_IN_1) ? 10 : 12; spare_convert(C, args, f, l, (M / 256) * (2 * FF / 256)); }
            const bf16* Bt = (ph == PH_FFN_IN_3) ? (const bf16*)(ws + WS_WIN3) : (const bf16*)(ws + (ph == PH_FFN_IN_0 ? WS_WIN0 : ph == PH_FFN_IN_1 ? WS_WIN1 : WS_WIN2));
            bf16* act = (bf16*)(ws + (ph == PH_FFN_IN_3 ? WS_ACT3 : WS_ACT));
            pg8::Gemm g{xb, Bt, M, 2 * FF, D}; pg8::StaticOrder S; S.init(M, 2 * FF, C.G, (int)blockIdx.x, (ph == PH_FFN_IN_3) ? FFNIN3_WGM : FFNIN_WGM);
            EpiSwiGLU E{(const LAS float*)(C.lds + RSTD_OFF), act, ssq};
            pg8::gemm_phase<EpiSwiGLU, pg8::StaticOrder, true, true>(C.lds, g, S, E, C.wave);
        } break;
        case PH_FFN_OUT_0: case PH_FFN_OUT_1: case PH_FFN_OUT_2: case PH_FFN_OUT_3: case PH_RNN_OUT: case PH_WO: {
            const bf16* A; const bf16* Bt; int K; float scale = 0.5f; const float* xin = args.out;
            if (ph == PH_FFN_OUT_0) { A = (const bf16*)(ws + WS_ACT); Bt = (const bf16*)(ws + WS_WOUT0); K = FF; xin = args.in[I_X]; }
            else if (ph == PH_FFN_OUT_1) { A = (const bf16*)(ws + WS_ACT); Bt = (const bf16*)(ws + WS_WOUT1); K = FF; }
            else if (ph == PH_FFN_OUT_2) { A = (const bf16*)(ws + WS_ACT); Bt = (const bf16*)(ws + WS_WOUT2); K = FF; }
            else if (ph == PH_FFN_OUT_3) { A = (const bf16*)(ws + WS_ACT3); Bt = (const bf16*)(ws + WS_WOUT3); K = FF; }
            else if (ph == PH_RNN_OUT) { A = (const bf16*)(ws + WS_Y); Bt = (const bf16*)(ws + WS_WROUT); K = DRNN; scale = 1.f; }
            else { A = (const bf16*)args.out + (size_t)8 * 1024 * 1024; Bt = (const bf16*)(ws + WS_WO); K = D; scale = 1.f; }
            if (ph == PH_WO) { const v4u* src_ = (const v4u*)args.out; v4u* dst_ = (v4u*)(ws + WS_WIN3); for (int i = (int)blockIdx.x * 512 + C.tid; i < (2 * FF * D * 2) / 16; i += C.G * 512) dst_[i] = __builtin_nontemporal_load(src_ + i); }
            float* xo = args.out;
#if RESID_BF16
            xin = nullptr;
            if (ph != PH_FFN_OUT_3) xo = nullptr;
#endif
            pg8::Gemm g{A, Bt, M, D, K}; pg8::StaticOrder S; S.init(M, D, C.G, (int)blockIdx.x, OUT_WGM);
            EpiRes E{xin, xo, xb, ssq, scale};
            pg8::gemm_phase<EpiRes, pg8::StaticOrder, false, true>(C.lds, g, S, E, C.wave);
        } break;
        case PH_RNN_IN: {
            spare_convert(C, args, 7, 8, (M / 256) * (2 * DRNN / 256));
            pg8::Gemm g{xb, (const bf16*)(ws + WS_WRIN), M, 2 * DRNN, D}; pg8::StaticOrder S; S.init(M, 2 * DRNN, C.G, (int)blockIdx.x, RNNIN_WGM);
            EpiRnnIn E{(const LAS float*)(C.lds + RSTD_OFF), (bf16*)(ws + WS_G), (bf16*)(ws + WS_U), ssq};
            pg8::gemm_phase<EpiRnnIn, pg8::StaticOrder, true, true>(C.lds, g, S, E, C.wave);
        } break;
        case PH_RNN_MID: p_rnn_mid(C, args); break;
        case PH_QKV: {
            pg8::Gemm g{xb, (const bf16*)(ws + WS_WQKV), M, NQKV, D}; pg8::StaticOrder S; S.init(M, NQKV, C.G, (int)blockIdx.x, QKV_WGM);
            if (C.tid < 128) ((LAS float*)(C.lds + GAIN_OFF))[C.tid] = (C.tid < 64) ? args.in[I_QGAIN][C.tid] * (0.125f * LOG2E) : args.in[I_KGAIN][C.tid - 64];
            EpiQKV E{(const LAS float*)(C.lds + RSTD_OFF), (const LAS float*)(C.lds + GAIN_OFF), (bf16*)(ws + WS_QKV), C.lds + EPI_SCR_OFF, ssq};
            pg8::gemm_phase<EpiQKV, pg8::StaticOrder, true, true>(C.lds, g, S, E, C.wave);
        } break;
        case PH_ATTN: p_attn(C, (bf16*)args.out + (size_t)8 * 1024 * 1024); break;
        default: break;
        }
        if (ph + 1 < args.ph_hi) xcd_barrier(bar, C.wave * 64 + pg8::fresh_lane());
        }
    }
}

extern "C" void kernel_launch(void* const* d_in, const int* in_sizes, int n_in, void* d_out, int out_size, void* d_ws, size_t ws_size, hipStream_t stream) {
    static int grid = 0;
    if (grid == 0) {
        if (n_in != 18 || in_sizes[0] != M * D || out_size != M * D || ws_size < WS_END) { fprintf(stderr, "kernel_launch: unexpected shapes (n_in %d, in0 %d, out %d, ws %zu)\n", n_in, n_in > 0 ? in_sizes[0] : -1, out_size, ws_size); grid = -1; return; }
        int dev = 0, cus = 0, per_cu = 0;
        if (hipGetDevice(&dev) != hipSuccess || hipDeviceGetAttribute(&cus, hipDeviceAttributeMultiprocessorCount, dev) != hipSuccess) { fprintf(stderr, "kernel_launch: device query failed\n"); grid = -1; return; }
        if (hipFuncSetAttribute((const void*)fwd_kernel, hipFuncAttributeMaxDynamicSharedMemorySize, LDS_BYTES) != hipSuccess) { fprintf(stderr, "kernel_launch: hipFuncSetAttribute failed\n"); grid = -1; return; }
        if (hipOccupancyMaxActiveBlocksPerMultiprocessor(&per_cu, (const void*)fwd_kernel, NWAVES * 64, LDS_BYTES) != hipSuccess || per_cu < 1) { fprintf(stderr, "kernel_launch: occupancy query says %d blocks per CU\n", per_cu); (void)hipGetLastError(); grid = -1; return; }
        grid = cus;
    }
    if (grid < 0) return;
    if (hipMemsetAsync(d_ws, 0, CTL_ZERO_BYTES, stream) != hipSuccess) { fprintf(stderr, "kernel_launch: memset failed\n"); return; }
    Args a{};
    for (int i = 0; i < 18; ++i) a.in[i] = (const float*)d_in[i];
    a.out = (float*)d_out; a.ws = (unsigned char*)d_ws;
#if SINGLE_LAUNCH
    a.ph_lo = 0; a.ph_hi = NPHASE;
    hipLaunchKernelGGL(fwd_kernel, dim3(grid), dim3(NWAVES * 64), LDS_BYTES, stream, a);
#else
    for (int ph = 0; ph < NPHASE; ++ph) { a.ph_lo = ph; a.ph_hi = ph + 1; hipLaunchKernelGGL(fwd_kernel, dim3(grid), dim3(NWAVES * 64), LDS_BYTES, stream, a); }
#endif
}
```
